# Optimizing an MI355X kernel written in HIP

```python
import jax
import jax.numpy as jnp
from jax import lax
import numpy as np

D_MODEL = 1024
BATCH = 4
SEQ = 8192
DEPTH = 1

RET_HEADS = 4
RET_DK = 256
RET_DV = 512
RET_QK = RET_HEADS * RET_DK
RET_V = RET_HEADS * RET_DV
RET_CHUNK = 128
ROPE_BASE = 10000.0

LRU_WIDTH = 1536
LRU_BLOCKS = 8
LRU_BLOCK = LRU_WIDTH // LRU_BLOCKS
CONV_WIDTH = 4
LRU_C = 8.0

N_GROUPS = 4
EXPERTS_PER_GROUP = 8
N_EXPERTS = N_GROUPS * EXPERTS_PER_GROUP
TOP_K = 2
D_EXPERT = 512
MOE_ROWS = 128

IN_WIDTHS = (RET_QK, RET_QK, RET_V, RET_V, LRU_WIDTH, LRU_WIDTH, 2 * D_MODEL)

LN_EPS = 1e-5
DEEPNORM_ALPHA = (2.0 * DEPTH) ** 0.25
DEEPNORM_BETA = (8.0 * DEPTH) ** -0.25

kernel_name = 'hybrid_retention_rglru_hmoe_deepnorm'


def _layer_norm(x, g, b):
    xf = x.astype(jnp.float32)
    mu = xf.mean(-1, keepdims=True)
    var = jnp.square(xf - mu).mean(-1, keepdims=True)
    return ((xf - mu) * lax.rsqrt(var + LN_EPS) * g + b).astype(x.dtype)


def _head_norm(t):
    mu = t.mean(-1, keepdims=True)
    var = jnp.square(t - mu).mean(-1, keepdims=True)
    return (t - mu) * lax.rsqrt(var + LN_EPS)


def _rotary(t):
    S = t.shape[1]
    half = t.shape[-1] // 2
    inv = ROPE_BASE ** (-jnp.arange(half, dtype=jnp.float32) / half)
    ang = jnp.arange(S, dtype=jnp.float32)[:, None] * inv[None, :]
    cos = jnp.cos(ang)[None, :, None, :]
    sin = jnp.sin(ang)[None, :, None, :]
    t1, t2 = t[..., :half], t[..., half:]
    return jnp.concatenate([t1 * cos - t2 * sin, t1 * sin + t2 * cos], axis=-1)


def _retention(q, k, v):
    B, S, H, DK = q.shape
    DV = v.shape[-1]
    C = RET_CHUNK
    NC = S // C
    log_g = jnp.log1p(-(2.0 ** (-5.0 - jnp.arange(H, dtype=jnp.float32))))
    pos = jnp.arange(C, dtype=jnp.float32)
    diff = pos[:, None] - pos[None, :]
    causal = diff >= 0
    d_mask = jnp.where(causal[None], jnp.exp(log_g[:, None, None] * jnp.where(causal, diff, 0.0)[None]), 0.0)
    xi = jnp.exp(log_g[:, None] * (pos + 1.0)[None])
    zeta = jnp.exp(log_g[:, None] * (C - 1.0 - pos)[None])
    chunk_decay = jnp.exp(log_g * C)
    k = k * (DK ** -0.5)

    def to_chunks(t):
        return t.reshape(B, NC, C, H, t.shape[-1]).transpose(1, 0, 3, 2, 4)

    qc, kc, vc = to_chunks(q), to_chunks(k), to_chunks(v)

    def step(state, inp):
        qi, ki, vi = inp
        scores = jnp.einsum('bhnd,bhmd->bhnm', qi, ki) * d_mask
        inner = jnp.einsum('bhnm,bhme->bhne', scores, vi)
        cross = jnp.einsum('bhnd,bhde->bhne', qi, state) * xi[None, :, :, None]
        new_state = state * chunk_decay[None, :, None, None] + jnp.einsum(
            'bhmd,bhme->bhde', ki * zeta[None, :, :, None], vi)
        return new_state, inner + cross

    state0 = jnp.zeros((B, H, DK, DV), jnp.float32)
    _, out = lax.scan(step, state0, (qc, kc, vc))
    return out.transpose(1, 0, 3, 2, 4).reshape(B, S, H, DV)


def _causal_conv(u, w, b):
    out = lax.conv_general_dilated(
        u, w[:, None, :].astype(u.dtype), window_strides=(1,), padding=[(CONV_WIDTH - 1, 0)],
        dimension_numbers=('NWC', 'WIO', 'NWC'), feature_group_count=u.shape[-1])
    return out + b


def _rg_lru(u, w_r, b_r, w_i, b_i, lam):
    B, S, W = u.shape
    ub = u.reshape(B, S, LRU_BLOCKS, LRU_BLOCK)
    r = jax.nn.sigmoid(jnp.einsum('bsnc,ncd->bsnd', ub, w_r).reshape(B, S, W) + b_r)
    i = jax.nn.sigmoid(jnp.einsum('bsnc,ncd->bsnd', ub, w_i).reshape(B, S, W) + b_i)
    log_a = -LRU_C * r * jax.nn.softplus(-lam.astype(jnp.float32))
    a = jnp.exp(log_a)
    inp = jnp.sqrt(-jnp.expm1(2.0 * log_a)) * (i * u)

    def combine(left, right):
        a1, b1 = left
        a2, b2 = right
        return a1 * a2, a2 * b1 + b2

    _, h = lax.associative_scan(combine, (a, inp), axis=1)
    return h


def _hier_moe(x, w_group, b_group, w_exp_router, b_exp_router, w_e_gate, w_e_up, w_e_down):
    B, S, D = x.shape
    N = B * S
    xt = x.reshape(N, D)
    rows = jnp.arange(N)
    g_logits = (xt @ w_group + b_group).astype(jnp.float32)
    g_prob = jax.nn.softmax(g_logits, axis=-1)
    g_idx = jnp.argmax(g_logits, axis=-1)
    g_w = g_prob[rows, g_idx]
    e_logits = (xt @ w_exp_router + b_exp_router).astype(jnp.float32)
    e_logits = e_logits.reshape(N, N_GROUPS, EXPERTS_PER_GROUP)[rows, g_idx]
    top_v, top_i = lax.top_k(e_logits, TOP_K)
    weights = g_w[:, None] * jax.nn.softmax(top_v, axis=-1)
    expert = g_idx[:, None] * EXPERTS_PER_GROUP + top_i

    M = N * TOP_K
    flat_e = expert.reshape(M)
    flat_w = weights.reshape(M)
    flat_tok = jnp.repeat(rows, TOP_K)
    order = jnp.argsort(flat_e)
    se = flat_e[order]
    counts = jnp.zeros((N_EXPERTS,), jnp.int32).at[flat_e].add(1)
    padded = (counts + MOE_ROWS - 1) // MOE_ROWS * MOE_ROWS
    starts = jnp.cumsum(counts) - counts
    pad_ends = jnp.cumsum(padded)
    pad_starts = pad_ends - padded
    dest = pad_starts[se] + jnp.arange(M) - starts[se]
    n_groups_rows = -(-(M + N_EXPERTS * (MOE_ROWS - 1)) // MOE_ROWS)
    m_pad = n_groups_rows * MOE_ROWS
    row_tok = jnp.full((m_pad,), N, jnp.int32).at[dest].set(flat_tok[order])
    row_w = jnp.zeros((m_pad,), jnp.float32).at[dest].set(flat_w[order])
    group_e = jnp.minimum(
        jnp.searchsorted(pad_ends, jnp.arange(n_groups_rows) * MOE_ROWS, side='right'), N_EXPERTS - 1)
    x_rows = jnp.concatenate([xt, jnp.zeros((1, D), xt.dtype)], axis=0)[row_tok]
    x_rows = x_rows.reshape(n_groups_rows, MOE_ROWS, D)

    def expert_rows(args):
        xb, e = args
        h = jax.nn.silu(xb @ w_e_gate[e]) * (xb @ w_e_up[e])
        return h @ w_e_down[e]

    y_rows = lax.map(expert_rows, (x_rows, group_e)).reshape(m_pad, D)
    y = jax.ops.segment_sum(y_rows * row_w[:, None].astype(y_rows.dtype), row_tok, num_segments=N + 1)[:N]
    return y.reshape(B, S, D)


def _layer(x, w_in, b_merge, conv_w, conv_b, w_rg_r, b_rg_r, w_rg_i, b_rg_i, lru_lambda,
           w_ret_o, w_lru_o, w_out, ln1_g, ln1_b, w_group, b_group, w_exp_router, b_exp_router,
           w_e_gate, w_e_up, w_e_down, ln2_g, ln2_b):
    B, S, D = x.shape
    f32 = jnp.float32
    splits = [int(s) for s in np.cumsum(IN_WIDTHS)[:-1]]
    q, k, v, g, u_lru, gate_lru, gate_logits = jnp.split(x @ w_in, splits, axis=-1)

    q = _rotary(q.astype(f32).reshape(B, S, RET_HEADS, RET_DK))
    k = _rotary(k.astype(f32).reshape(B, S, RET_HEADS, RET_DK))
    v = v.astype(f32).reshape(B, S, RET_HEADS, RET_DV)
    ret = _head_norm(_retention(q, k, v)).reshape(B, S, RET_V)
    ret = (jax.nn.silu(g.astype(f32)) * ret).astype(x.dtype)

    u = _causal_conv(u_lru, conv_w, conv_b)
    h = _rg_lru(u.astype(f32), w_rg_r, b_rg_r, w_rg_i, b_rg_i, lru_lambda)
    lru = (jax.nn.gelu(gate_lru.astype(f32)) * h).astype(x.dtype)

    gates = jax.nn.sigmoid((gate_logits + b_merge).astype(f32)).astype(x.dtype)
    gate_ret, gate_rec = jnp.split(gates, 2, axis=-1)
    merged = gate_ret * (ret @ w_ret_o) + gate_rec * (lru @ w_lru_o)
    x = _layer_norm(DEEPNORM_ALPHA * x + merged @ w_out, ln1_g, ln1_b)

    moe = _hier_moe(x, w_group, b_group, w_exp_router, b_exp_router, w_e_gate, w_e_up, w_e_down)
    return _layer_norm(DEEPNORM_ALPHA * x + moe, ln2_g, ln2_b)


def setup_inputs(seed: int = 0) -> dict:
    key = jax.random.key(seed)
    ks = jax.random.split(key, 32)
    f32 = jnp.float32
    D = D_MODEL
    L = DEPTH
    sd = D ** -0.5
    beta = DEEPNORM_BETA

    def nrm(k, shape, scale):
        return jax.random.normal(k, shape, f32) * scale

    x = nrm(ks[0], (BATCH, SEQ, D), 1.0)
    w_in = jnp.concatenate([
        nrm(ks[1], (L, D, RET_QK), sd),
        nrm(ks[2], (L, D, RET_QK), sd),
        nrm(ks[3], (L, D, RET_V), sd * beta),
        nrm(ks[4], (L, D, RET_V), sd),
        nrm(ks[5], (L, D, LRU_WIDTH), sd),
        nrm(ks[6], (L, D, LRU_WIDTH), sd),
        nrm(ks[7], (L, D, 2 * D), sd)], axis=-1)
    b_merge = nrm(ks[8], (L, 2 * D), 0.01)
    conv_w = nrm(ks[9], (L, CONV_WIDTH, LRU_WIDTH), CONV_WIDTH ** -0.5)
    conv_b = nrm(ks[10], (L, LRU_WIDTH), 0.01)
    w_rg_r = nrm(ks[11], (L, LRU_BLOCKS, LRU_BLOCK, LRU_BLOCK), LRU_BLOCK ** -0.5)
    b_rg_r = nrm(ks[12], (L, LRU_WIDTH), 0.01)
    w_rg_i = nrm(ks[13], (L, LRU_BLOCKS, LRU_BLOCK, LRU_BLOCK), LRU_BLOCK ** -0.5)
    b_rg_i = nrm(ks[14], (L, LRU_WIDTH), 0.01)
    a_c = jax.random.uniform(ks[15], (L, LRU_WIDTH), f32, 0.9, 0.999)
    a0 = a_c ** (1.0 / LRU_C)
    lru_lambda = jnp.log(a0) - jnp.log1p(-a0)
    w_ret_o = nrm(ks[16], (L, RET_V, D), beta * RET_V ** -0.5)
    w_lru_o = nrm(ks[17], (L, LRU_WIDTH, D), beta * LRU_WIDTH ** -0.5)
    w_out = nrm(ks[18], (L, D, D), beta * sd)
    ln1_g = 1.0 + nrm(ks[19], (L, D), 0.01)
    ln1_b = nrm(ks[20], (L, D), 0.01)
    w_group = nrm(ks[21], (L, D, N_GROUPS), sd)
    b_group = nrm(ks[22], (L, N_GROUPS), 0.01)
    w_exp_router = nrm(ks[23], (L, D, N_EXPERTS), sd)
    b_exp_router = nrm(ks[24], (L, N_EXPERTS), 0.01)
    w_e_gate = nrm(ks[25], (L, N_EXPERTS, D, D_EXPERT), sd)
    w_e_up = nrm(ks[26], (L, N_EXPERTS, D, D_EXPERT), beta * sd)
    w_e_down = nrm(ks[27], (L, N_EXPERTS, D_EXPERT, D), beta * D_EXPERT ** -0.5)
    ln2_g = 1.0 + nrm(ks[28], (L, D), 0.01)
    ln2_b = nrm(ks[29], (L, D), 0.01)
    return {'x': x, 'w_in': w_in, 'b_merge': b_merge, 'conv_w': conv_w, 'conv_b': conv_b,
            'w_rg_r': w_rg_r, 'b_rg_r': b_rg_r, 'w_rg_i': w_rg_i, 'b_rg_i': b_rg_i,
            'lru_lambda': lru_lambda, 'w_ret_o': w_ret_o, 'w_lru_o': w_lru_o, 'w_out': w_out,
            'ln1_g': ln1_g, 'ln1_b': ln1_b, 'w_group': w_group, 'b_group': b_group,
            'w_exp_router': w_exp_router, 'b_exp_router': b_exp_router, 'w_e_gate': w_e_gate,
            'w_e_up': w_e_up, 'w_e_down': w_e_down, 'ln2_g': ln2_g, 'ln2_b': ln2_b}


def reference(x, w_in, b_merge, conv_w, conv_b, w_rg_r, b_rg_r, w_rg_i, b_rg_i, lru_lambda,
              w_ret_o, w_lru_o, w_out, ln1_g, ln1_b, w_group, b_group, w_exp_router, b_exp_router,
              w_e_gate, w_e_up, w_e_down, ln2_g, ln2_b):
    for l in range(DEPTH):
        x = _layer(x, w_in[l], b_merge[l], conv_w[l], conv_b[l], w_rg_r[l], b_rg_r[l], w_rg_i[l],
                   b_rg_i[l], lru_lambda[l], w_ret_o[l], w_lru_o[l], w_out[l], ln1_g[l], ln1_b[l],
                   w_group[l], b_group[l], w_exp_router[l], b_exp_router[l], w_e_gate[l], w_e_up[l],
                   w_e_down[l], ln2_g[l], ln2_b[l])
    return x
```

```cpp
#include <hip/hip_runtime.h>
#include <cstdio>
#include <cstdint>

typedef unsigned short bf16_t;
#define DEV __device__ __forceinline__

DEV float bf2f(bf16_t h) { return __uint_as_float(((unsigned)h) << 16); }
DEV bf16_t f2bf(float f) { unsigned u = __float_as_uint(f); return (bf16_t)((u + 0x7fffu + ((u >> 16) & 1u)) >> 16); }
DEV float sigm(float x) { return 1.f / (1.f + expf(-x)); }
DEV float silu(float x) { return x * sigm(x); }
DEV float gelu_tanh(float x) { const float c = 0.7978845608028654f; return 0.5f * x * (1.f + tanhf(c * (x + 0.044715f * x * x * x))); }

constexpr int NTOK = 32768, DM = 1024, SEQ = 8192;
constexpr int WIN_N = 11264;
constexpr int C_Q = 0, C_K = 1024, C_V = 2048, C_G = 4096, C_U = 6144, C_GL = 7680, C_GATE = 9216;
constexpr float ALPHA = 1.189207115002721f;
constexpr float LN_EPS = 1e-5f;
constexpr size_t MiB = 1u << 20;
constexpr size_t WS_CTL = 0;
constexpr size_t WS_ROPE = 1 * MiB;
constexpr size_t WS_ROUTE_E = 9 * MiB;
constexpr size_t WS_ROUTE_W = 9 * MiB + 512 * 1024;
constexpr size_t WS_LIST = 10 * MiB;
constexpr size_t WS_XB = 32 * MiB;
constexpr size_t WS_GL = 96 * MiB;
constexpr size_t WS_ULRU = 192 * MiB;
constexpr size_t WS_Q = 192 * MiB;
constexpr size_t WS_K = 256 * MiB;
constexpr size_t WS_GATES = 192 * MiB;
constexpr size_t WS_UCONV = 288 * MiB;
constexpr size_t WS_P = 320 * MiB;
constexpr size_t WS_V = 352 * MiB;
constexpr size_t WS_EPS = 384 * MiB;
constexpr size_t WS_HRAW = 192 * MiB;
constexpr size_t WS_YSLOT = 32 * MiB;
constexpr size_t WS_END = 512 * MiB;

template <class AL, class BL, class Epi>
__global__ __launch_bounds__(256) void gemm64(int K, AL A, BL B, Epi epi) {
    __shared__ float As[16][68];
    __shared__ float Bs[16][68];
    const int tid = threadIdx.x, tx = tid & 15, ty = tid >> 4, g = blockIdx.z;
    const int row0 = blockIdx.y * 64, col0 = blockIdx.x * 64;
    const int Mg = A.rows(g);
    if (row0 >= Mg) return;
    float acc[4][4];
#pragma unroll
    for (int i = 0; i < 4; ++i)
#pragma unroll
        for (int j = 0; j < 4; ++j) acc[i][j] = 0.f;
    for (int k0 = 0; k0 < K; k0 += 16) {
        {
            const int r = tid >> 2, kk = (tid & 3) * 4;
#pragma unroll
            for (int i = 0; i < 4; ++i) As[kk + i][r] = (row0 + r < Mg) ? A(g, row0 + r, k0 + kk + i) : 0.f;
        }
        {
            const int kk = tid >> 4, c = (tid & 15) * 4;
#pragma unroll
            for (int i = 0; i < 4; ++i) Bs[kk][c + i] = B(g, k0 + kk, col0 + c + i);
        }
        __syncthreads();
#pragma unroll
        for (int kk = 0; kk < 16; ++kk) {
            float a[4], b[4];
#pragma unroll
            for (int i = 0; i < 4; ++i) { a[i] = As[kk][ty * 4 + i]; b[i] = Bs[kk][tx * 4 + i]; }
#pragma unroll
            for (int i = 0; i < 4; ++i)
#pragma unroll
                for (int j = 0; j < 4; ++j) acc[i][j] += a[i] * b[j];
        }
        __syncthreads();
    }
#pragma unroll
    for (int i = 0; i < 4; ++i) {
        const int r = row0 + ty * 4 + i;
        if (r < Mg) { float v[4] = {acc[i][0], acc[i][1], acc[i][2], acc[i][3]}; epi(g, r, col0 + tx * 4, v); }
    }
}

struct ABf { const bf16_t* p; int ld; int M; DEV int rows(int) const { return M; } DEV float operator()(int, int r, int k) const { return bf2f(p[(size_t)r * ld + k]); } };
struct BW { const float* p; int ld; int c0; DEV float operator()(int, int k, int c) const { return p[(size_t)k * ld + c0 + c]; } };

__global__ void k_cvt_x(const float* x, bf16_t* xb, size_t n) {
    size_t i = (size_t)blockIdx.x * 256 + threadIdx.x;
    for (; i < n; i += (size_t)gridDim.x * 256) xb[i] = f2bf(x[i]);
}
__global__ void k_rope_table(float2* tab) {
    const int i = blockIdx.x * 256 + threadIdx.x; if (i >= 8192 * 128) return;
    const int s = i >> 7, j = i & 127;
    const double r = 0.93057204092969897;
    double inv = 1.0; for (int t = 0; t < j; ++t) inv *= r;
    const double ang = (double)s * inv;
    const double twopi_hi = 6.283185307179586232, twopi_lo = 2.4492935982947064e-16;
    const double n = rint(ang / twopi_hi);
    double x = (ang - n * twopi_hi) - n * twopi_lo;
    const double x2 = x * x;
    double sn = 0.0, cs = 0.0;
    {
        double t = 1.0 / (22.0 * 23.0);
        double acc = 1.0 - x2 * t;
        for (int k = 21; k >= 3; k -= 2) acc = 1.0 - x2 / ((double)(k - 1) * (double)k) * acc;
        sn = x * acc;
        double acc2 = 1.0 - x2 / (21.0 * 22.0);
        for (int k = 20; k >= 2; k -= 2) acc2 = 1.0 - x2 / ((double)(k - 1) * (double)k) * acc2;
        cs = acc2;
    }
    tab[i] = make_float2((float)cs, (float)sn);
}

struct EpiLruIn { bf16_t* u; bf16_t* gl;
    DEV void operator()(int, int r, int c, const float (&v)[4]) const {
#pragma unroll
        for (int j = 0; j < 4; ++j) { const int cc = c + j; if (cc < 1536) u[(size_t)r * 1536 + cc] = f2bf(v[j]); else gl[(size_t)r * 1536 + cc - 1536] = f2bf(gelu_tanh(v[j])); }
    } };
__global__ void k_conv(const bf16_t* u, const float* cw, const float* cb, bf16_t* uc) {
    const size_t i = (size_t)blockIdx.x * 256 + threadIdx.x;
    const int r = (int)(i / 1536), c = (int)(i % 1536), s = r & (SEQ - 1);
    float acc = cb[c];
#pragma unroll
    for (int j = 0; j < 4; ++j) { const int ss = s - 3 + j; if (ss >= 0) acc += cw[j * 1536 + c] * bf2f(u[(size_t)(r - 3 + j) * 1536 + c]); }
    uc[i] = f2bf(acc);
}
struct ABlk { const bf16_t* p; DEV int rows(int) const { return NTOK; } DEV float operator()(int g, int r, int k) const { return bf2f(p[(size_t)r * 1536 + g * 192 + k]); } };
struct BBlk { const float* p; DEV float operator()(int g, int k, int c) const { return p[(size_t)g * 192 * 192 + k * 192 + c]; } };
struct EpiR { const float* b_r; const float* lam; bf16_t* eps; bf16_t* mult;
    DEV void operator()(int g, int r, int c, const float (&v)[4]) const {
#pragma unroll
        for (int j = 0; j < 4; ++j) { const int ch = g * 192 + c + j; const float rr = sigm(v[j] + b_r[ch]);
            const float sp = log1pf(expf(-lam[ch])); const float la = -8.f * rr * sp;
            eps[(size_t)r * 1536 + ch] = f2bf(-expm1f(la)); mult[(size_t)r * 1536 + ch] = f2bf(sqrtf(-expm1f(2.f * la))); }
    } };
struct EpiI { const float* b_i; const bf16_t* uc; bf16_t* inp;
    DEV void operator()(int g, int r, int c, const float (&v)[4]) const {
#pragma unroll
        for (int j = 0; j < 4; ++j) { const int ch = g * 192 + c + j; const size_t o = (size_t)r * 1536 + ch; const float ii = sigm(v[j] + b_i[ch]);
            inp[o] = f2bf(bf2f(inp[o]) * ii * bf2f(uc[o])); }
    } };
__global__ void k_scan(const bf16_t* eps, const bf16_t* inp, bf16_t* gl) {
    const int i = blockIdx.x * 256 + threadIdx.x; if (i >= 4 * 1536) return;
    const int b = i / 1536, c = i % 1536;
    float h = 0.f; size_t o = (size_t)b * SEQ * 1536 + c;
    for (int t = 0; t < SEQ; ++t, o += 1536) { const float a = 1.f - bf2f(eps[o]); h = a * h + bf2f(inp[o]); gl[o] = f2bf(bf2f(gl[o]) * h); }
}

struct EpiRetIn { bf16_t* q; bf16_t* k; bf16_t* v; bf16_t* g;
    DEV void operator()(int, int r, int c, const float (&x)[4]) const {
#pragma unroll
        for (int j = 0; j < 4; ++j) { const int cc = c + j;
            if (cc < 1024) q[(size_t)r * 1024 + cc] = f2bf(x[j]);
            else if (cc < 2048) k[(size_t)r * 1024 + cc - 1024] = f2bf(x[j]);
            else if (cc < 4096) v[(size_t)r * 2048 + cc - 2048] = f2bf(x[j]);
            else g[(size_t)r * 2048 + cc - 4096] = f2bf(silu(x[j])); }
    } };
__global__ void k_rope(bf16_t* q, bf16_t* k, const float2* tab) {
    const size_t i = (size_t)blockIdx.x * 256 + threadIdx.x;
    const int j = (int)(i & 127), h = (int)((i >> 7) & 3), r = (int)(i >> 9), s = r & (SEQ - 1), n = s & 127;
    const float2 cs = tab[s * 128 + j];
    const double gam = 1.0 - exp2(-5.0 - (double)h);
    const float lg = (float)log2(gam);
    const float sq = exp2f((float)n * lg), sk = exp2f(-(float)n * lg) * 0.0625f;
    const size_t o1 = (size_t)r * 1024 + h * 256 + j, o2 = o1 + 128;
    { const float t1 = bf2f(q[o1]), t2 = bf2f(q[o2]); q[o1] = f2bf((t1 * cs.x - t2 * cs.y) * sq); q[o2] = f2bf((t1 * cs.y + t2 * cs.x) * sq); }
    { const float t1 = bf2f(k[o1]), t2 = bf2f(k[o2]); k[o1] = f2bf((t1 * cs.x - t2 * cs.y) * sk); k[o2] = f2bf((t1 * cs.y + t2 * cs.x) * sk); }
}
struct AQc { const bf16_t* q; DEV int rows(int) const { return 128; }
    DEV float operator()(int g, int r, int k) const { const int c = g & 63, bh = g >> 6, b = bh >> 2, h = bh & 3; return bf2f(q[(size_t)(b * SEQ + c * 128 + r) * 1024 + h * 256 + k]); } };
struct BKc { const bf16_t* kk; DEV float operator()(int g, int k, int col) const { const int c = g & 63, bh = g >> 6, b = bh >> 2, h = bh & 3; return bf2f(kk[(size_t)(b * SEQ + c * 128 + col) * 1024 + h * 256 + k]); } };
struct EpiP { bf16_t* P; DEV void operator()(int g, int r, int c, const float (&v)[4]) const {
#pragma unroll
        for (int j = 0; j < 4; ++j) P[(size_t)g * 16384 + r * 128 + c + j] = f2bf((c + j <= r) ? v[j] : 0.f); } };

__global__ __launch_bounds__(256) void k_ret_seq(const bf16_t* q, const bf16_t* k, bf16_t* v, const bf16_t* P) {
    __shared__ float U[256][32];
    const int tid = threadIdx.x, e = tid & 31, ng = tid >> 5;
    const int sl = blockIdx.x & 15, bh = blockIdx.x >> 4, b = bh >> 2, h = bh & 3;
    const double gam = 1.0 - exp2(-5.0 - (double)h);
    const float g128 = (float)exp2(128.0 * log2(gam));
    for (int i = tid; i < 256 * 32; i += 256) ((float*)U)[i] = 0.f;
    __syncthreads();
    for (int c = 0; c < 64; ++c) {
        const size_t tok0 = (size_t)b * SEQ + c * 128;
        const bf16_t* qc = q + tok0 * 1024 + h * 256;
        const bf16_t* kc = k + tok0 * 1024 + h * 256;
        bf16_t* vc = v + tok0 * 2048 + h * 512 + sl * 32;
        const bf16_t* Pc = P + (size_t)(bh * 64 + c) * 16384;
        float outs[16];
#pragma unroll
        for (int i = 0; i < 16; ++i) {
            const int n = ng * 16 + i; float acc = 0.f;
            for (int d = 0; d < 256; ++d) acc += bf2f(qc[(size_t)n * 1024 + d]) * U[d][e];
            for (int m = 0; m <= n; ++m) acc += bf2f(Pc[n * 128 + m]) * bf2f(vc[(size_t)m * 2048 + e]);
            outs[i] = acc;
        }
        __syncthreads();
        for (int i = 0; i < 32; ++i) {
            const int d = ng * 32 + i; float acc = U[d][e];
            for (int m = 0; m < 128; ++m) acc += bf2f(kc[(size_t)m * 1024 + d]) * bf2f(vc[(size_t)m * 2048 + e]);
            U[d][e] = g128 * acc;
        }
        __syncthreads();
#pragma unroll
        for (int i = 0; i < 16; ++i) vc[(size_t)(ng * 16 + i) * 2048 + e] = f2bf(outs[i]);
        __syncthreads();
    }
}
__global__ void k_headnorm(bf16_t* ret, const bf16_t* g) {
    const int w = (blockIdx.x * 256 + threadIdx.x) >> 6, lane = threadIdx.x & 63;
    const size_t o = (size_t)w * 512 + lane * 8;
    float x[8]; float s = 0.f;
#pragma unroll
    for (int j = 0; j < 8; ++j) { x[j] = bf2f(ret[o + j]); s += x[j]; }
#pragma unroll
    for (int m = 1; m < 64; m <<= 1) s += __shfl_xor(s, m);
    const float mu = s * (1.f / 512.f); float q = 0.f;
#pragma unroll
    for (int j = 0; j < 8; ++j) { x[j] -= mu; q += x[j] * x[j]; }
#pragma unroll
    for (int m = 1; m < 64; m <<= 1) q += __shfl_xor(q, m);
    const float rstd = rsqrtf(q * (1.f / 512.f) + LN_EPS);
#pragma unroll
    for (int j = 0; j < 8; ++j) ret[o + j] = f2bf(x[j] * rstd * bf2f(g[o + j]));
}

struct EpiGates { const float* bm; bf16_t* gates; DEV void operator()(int, int r, int c, const float (&v)[4]) const {
#pragma unroll
        for (int j = 0; j < 4; ++j) gates[(size_t)r * 2048 + c + j] = f2bf(sigm(v[j] + bm[c + j])); } };
struct EpiM1 { const bf16_t* gates; bf16_t* m1; DEV void operator()(int, int r, int c, const float (&v)[4]) const {
#pragma unroll
        for (int j = 0; j < 4; ++j) m1[(size_t)r * 1024 + c + j] = f2bf(v[j] * bf2f(gates[(size_t)r * 2048 + c + j])); } };
struct EpiM2 { const bf16_t* gates; const bf16_t* m1; bf16_t* mg; DEV void operator()(int, int r, int c, const float (&v)[4]) const {
#pragma unroll
        for (int j = 0; j < 4; ++j) mg[(size_t)r * 1024 + c + j] = f2bf(bf2f(m1[(size_t)r * 1024 + c + j]) + v[j] * bf2f(gates[(size_t)r * 2048 + 1024 + c + j])); } };
struct EpiO { const float* x; float* y; DEV void operator()(int, int r, int c, const float (&v)[4]) const {
#pragma unroll
        for (int j = 0; j < 4; ++j) y[(size_t)r * 1024 + c + j] = ALPHA * x[(size_t)r * 1024 + c + j] + v[j]; } };

__global__ __launch_bounds__(256) void k_ln1_route(float* y, bf16_t* x1b, const float* g1, const float* b1, const float* wg, const float* bg,
                                                   const float* we, const float* be, int2* route_e, float2* route_w, int* cnt, int* list) {
    __shared__ float red[4][64][37];
    const int wv = threadIdx.x >> 6, lane = threadIdx.x & 63, r = blockIdx.x * 4 + wv;
    float x[16]; float s = 0.f;
#pragma unroll
    for (int j = 0; j < 4; ++j) { const float4 t = *(const float4*)(y + (size_t)r * 1024 + j * 256 + lane * 4); x[4 * j] = t.x; x[4 * j + 1] = t.y; x[4 * j + 2] = t.z; x[4 * j + 3] = t.w; s += (t.x + t.y) + (t.z + t.w); }
#pragma unroll
    for (int m = 1; m < 64; m <<= 1) s += __shfl_xor(s, m);
    const float mu = s * (1.f / 1024.f); float q = 0.f;
#pragma unroll
    for (int j = 0; j < 16; ++j) { x[j] -= mu; q += x[j] * x[j]; }
#pragma unroll
    for (int m = 1; m < 64; m <<= 1) q += __shfl_xor(q, m);
    const float rstd = rsqrtf(q * (1.f / 1024.f) + LN_EPS);
    float part[36];
#pragma unroll
    for (int c = 0; c < 36; ++c) part[c] = 0.f;
#pragma unroll
    for (int j = 0; j < 4; ++j)
#pragma unroll
        for (int i = 0; i < 4; ++i) { const int col = j * 256 + lane * 4 + i; const float v = x[4 * j + i] * rstd * g1[col] + b1[col]; x[4 * j + i] = v;
#pragma unroll
            for (int c = 0; c < 32; ++c) part[c] += v * we[(size_t)col * 32 + c];
#pragma unroll
            for (int c = 0; c < 4; ++c) part[32 + c] += v * wg[(size_t)col * 4 + c]; }
#pragma unroll
    for (int j = 0; j < 4; ++j) { *(float4*)(y + (size_t)r * 1024 + j * 256 + lane * 4) = make_float4(x[4 * j], x[4 * j + 1], x[4 * j + 2], x[4 * j + 3]);
        ushort4 o; o.x = f2bf(x[4 * j]); o.y = f2bf(x[4 * j + 1]); o.z = f2bf(x[4 * j + 2]); o.w = f2bf(x[4 * j + 3]); *(ushort4*)(x1b + (size_t)r * 1024 + j * 256 + lane * 4) = o; }
#pragma unroll
    for (int c = 0; c < 36; ++c) red[wv][lane][c] = part[c];
    __syncthreads();
    float tot = 0.f;
    if (lane < 36) { for (int l = 0; l < 64; ++l) tot += red[wv][l][lane]; tot += (lane < 32) ? be[lane] : bg[lane - 32]; }
    const float g0 = __shfl(tot, 32), g1v = __shfl(tot, 33), g2 = __shfl(tot, 34), g3 = __shfl(tot, 35);
    int gi = 0; float gm = g0; if (g1v > gm) { gm = g1v; gi = 1; } if (g2 > gm) { gm = g2; gi = 2; } if (g3 > gm) { gm = g3; gi = 3; }
    const float gw = 1.f / (expf(g0 - gm) + expf(g1v - gm) + expf(g2 - gm) + expf(g3 - gm));
    float ev[8];
#pragma unroll
    for (int j = 0; j < 8; ++j) ev[j] = __shfl(tot, gi * 8 + j);
    int i1 = 0; float v1 = ev[0];
#pragma unroll
    for (int j = 1; j < 8; ++j) if (ev[j] > v1) { v1 = ev[j]; i1 = j; }
    int i2 = -1; float v2 = -INFINITY;
#pragma unroll
    for (int j = 0; j < 8; ++j) if (j != i1 && ev[j] > v2) { v2 = ev[j]; i2 = j; }
    const float w1 = 1.f / (1.f + expf(v2 - v1)), w2 = 1.f - w1;
    if (lane == 0) {
        const int e1 = gi * 8 + i1, e2 = gi * 8 + i2;
        route_e[r] = make_int2(e1, e2); route_w[r] = make_float2(gw * w1, gw * w2);
        const int p1 = atomicAdd(&cnt[e1], 1); list[e1 * 32768 + p1] = r * 2;
        const int p2 = atomicAdd(&cnt[e2], 1); list[e2 * 32768 + p2] = r * 2 + 1;
    }
}

struct AGather { const bf16_t* x1b; const int* cnt; const int* list; DEV int rows(int g) const { return cnt[g]; }
    DEV float operator()(int g, int r, int k) const { const int tok = list[g * 32768 + r] >> 1; return bf2f(x1b[(size_t)tok * 1024 + k]); } };
struct BGU { const float* wgate; const float* wup;
    DEV float operator()(int g, int k, int c) const { const float* w = (c & 1) ? wup : wgate; return w[((size_t)g * 1024 + k) * 512 + (c >> 1)]; } };
DEV int expert_base(const int* cnt, int g) { int b = 0; for (int i = 0; i < g; ++i) b += cnt[i]; return b; }
struct EpiH { const int* cnt; bf16_t* h; DEV void operator()(int g, int r, int c, const float (&v)[4]) const {
        const size_t row = (size_t)expert_base(cnt, g) + r; h[row * 512 + (c >> 1)] = f2bf(silu(v[0]) * v[1]); h[row * 512 + (c >> 1) + 1] = f2bf(silu(v[2]) * v[3]); } };
struct AH { const bf16_t* h; const int* cnt; DEV int rows(int g) const { return cnt[g]; }
    DEV float operator()(int g, int r, int k) const { return bf2f(h[((size_t)expert_base(cnt, g) + r) * 512 + k]); } };
struct BDown { const float* w; DEV float operator()(int g, int k, int c) const { return w[((size_t)g * 512 + k) * 1024 + c]; } };
struct EpiY { const int* list; const float2* rw; bf16_t* ys; DEV void operator()(int g, int r, int c, const float (&v)[4]) const {
        const int slot = list[g * 32768 + r]; const float2 w2 = rw[slot >> 1]; const float w = (slot & 1) ? w2.y : w2.x;
#pragma unroll
        for (int j = 0; j < 4; ++j) ys[(size_t)slot * 1024 + c + j] = f2bf(w * v[j]); } };
__global__ __launch_bounds__(256) void k_final(float* out, const bf16_t* ys, const float* g2, const float* b2) {
    const int wv = threadIdx.x >> 6, lane = threadIdx.x & 63, r = blockIdx.x * 4 + wv;
    float x[16]; float s = 0.f;
#pragma unroll
    for (int j = 0; j < 4; ++j) { const int col = j * 256 + lane * 4; const float4 t = *(const float4*)(out + (size_t)r * 1024 + col);
        const ushort4 a = *(const ushort4*)(ys + (size_t)(2 * r) * 1024 + col), b = *(const ushort4*)(ys + (size_t)(2 * r + 1) * 1024 + col);
        x[4 * j] = ALPHA * t.x + bf2f(a.x) + bf2f(b.x); x[4 * j + 1] = ALPHA * t.y + bf2f(a.y) + bf2f(b.y); x[4 * j + 2] = ALPHA * t.z + bf2f(a.z) + bf2f(b.z); x[4 * j + 3] = ALPHA * t.w + bf2f(a.w) + bf2f(b.w);
        s += (x[4 * j] + x[4 * j + 1]) + (x[4 * j + 2] + x[4 * j + 3]); }
#pragma unroll
    for (int m = 1; m < 64; m <<= 1) s += __shfl_xor(s, m);
    const float mu = s * (1.f / 1024.f); float q = 0.f;
#pragma unroll
    for (int j = 0; j < 16; ++j) { x[j] -= mu; q += x[j] * x[j]; }
#pragma unroll
    for (int m = 1; m < 64; m <<= 1) q += __shfl_xor(q, m);
    const float rstd = rsqrtf(q * (1.f / 1024.f) + LN_EPS);
#pragma unroll
    for (int j = 0; j < 4; ++j) { const int col = j * 256 + lane * 4; const float4 gg = *(const float4*)(g2 + col), bb = *(const float4*)(b2 + col);
        *(float4*)(out + (size_t)r * 1024 + col) = make_float4(x[4 * j] * rstd * gg.x + bb.x, x[4 * j + 1] * rstd * gg.y + bb.y, x[4 * j + 2] * rstd * gg.z + bb.z, x[4 * j + 3] * rstd * gg.w + bb.w); }
}

extern "C" void kernel_launch(void* const* d_in, const int* in_sizes, int n_in, void* d_out, int out_size, void* d_ws, size_t ws_size, hipStream_t stream) {
    if (n_in != 24 || in_sizes[0] != NTOK * DM || out_size != NTOK * DM || ws_size < WS_END) {
        fprintf(stderr, "kernel_launch: unexpected shapes (n_in %d, in0 %d, out %d, ws %zu)\n", n_in, n_in > 0 ? in_sizes[0] : -1, out_size, ws_size); return; }
    const float* x = (const float*)d_in[0]; const float* w_in = (const float*)d_in[1]; const float* b_merge = (const float*)d_in[2];
    const float* conv_w = (const float*)d_in[3]; const float* conv_b = (const float*)d_in[4];
    const float* w_rg_r = (const float*)d_in[5]; const float* b_rg_r = (const float*)d_in[6]; const float* w_rg_i = (const float*)d_in[7]; const float* b_rg_i = (const float*)d_in[8];
    const float* lam = (const float*)d_in[9]; const float* w_ret_o = (const float*)d_in[10]; const float* w_lru_o = (const float*)d_in[11]; const float* w_out = (const float*)d_in[12];
    const float* ln1_g = (const float*)d_in[13]; const float* ln1_b = (const float*)d_in[14]; const float* w_group = (const float*)d_in[15]; const float* b_group = (const float*)d_in[16];
    const float* w_er = (const float*)d_in[17]; const float* b_er = (const float*)d_in[18]; const float* w_eg = (const float*)d_in[19]; const float* w_eu = (const float*)d_in[20];
    const float* w_ed = (const float*)d_in[21]; const float* ln2_g = (const float*)d_in[22]; const float* ln2_b = (const float*)d_in[23];
    char* ws = (char*)d_ws; float* out = (float*)d_out;
    int* cnt = (int*)(ws + WS_CTL); float2* rope = (float2*)(ws + WS_ROPE); int2* route_e = (int2*)(ws + WS_ROUTE_E); float2* route_w = (float2*)(ws + WS_ROUTE_W); int* list = (int*)(ws + WS_LIST);
    bf16_t* xb = (bf16_t*)(ws + WS_XB); bf16_t* gl = (bf16_t*)(ws + WS_GL); bf16_t* ulru = (bf16_t*)(ws + WS_ULRU); bf16_t* uconv = (bf16_t*)(ws + WS_UCONV);
    bf16_t* epsb = (bf16_t*)(ws + WS_EPS); bf16_t* inp = (bf16_t*)d_out;
    bf16_t* q = (bf16_t*)(ws + WS_Q); bf16_t* k = (bf16_t*)(ws + WS_K); bf16_t* v = (bf16_t*)(ws + WS_V); bf16_t* gbuf = (bf16_t*)d_out;
    bf16_t* P = (bf16_t*)(ws + WS_P); bf16_t* gates = (bf16_t*)(ws + WS_GATES); bf16_t* m1 = (bf16_t*)d_out; bf16_t* merged = xb;
    bf16_t* x1b = gl; bf16_t* hbuf = (bf16_t*)(ws + WS_HRAW); bf16_t* ys = (bf16_t*)(ws + WS_YSLOT);

    (void)hipMemsetAsync(cnt, 0, 4096, stream);
    k_cvt_x<<<4096, 256, 0, stream>>>(x, xb, (size_t)NTOK * DM);
    k_rope_table<<<8192 * 128 / 256, 256, 0, stream>>>(rope);
    gemm64<<<dim3(3072 / 64, NTOK / 64, 1), 256, 0, stream>>>(1024, ABf{xb, 1024, NTOK}, BW{w_in, WIN_N, C_U}, EpiLruIn{ulru, gl});
    k_conv<<<NTOK * 1536 / 256, 256, 0, stream>>>(ulru, conv_w, conv_b, uconv);
    gemm64<<<dim3(3, NTOK / 64, 8), 256, 0, stream>>>(192, ABlk{uconv}, BBlk{w_rg_r}, EpiR{b_rg_r, lam, epsb, inp});
    gemm64<<<dim3(3, NTOK / 64, 8), 256, 0, stream>>>(192, ABlk{uconv}, BBlk{w_rg_i}, EpiI{b_rg_i, uconv, inp});
    k_scan<<<24, 256, 0, stream>>>(epsb, inp, gl);
    gemm64<<<dim3(6144 / 64, NTOK / 64, 1), 256, 0, stream>>>(1024, ABf{xb, 1024, NTOK}, BW{w_in, WIN_N, C_Q}, EpiRetIn{q, k, v, gbuf});
    k_rope<<<NTOK * 512 / 256, 256, 0, stream>>>(q, k, rope);
    gemm64<<<dim3(2, 2, 1024), 256, 0, stream>>>(256, AQc{q}, BKc{k}, EpiP{P});
    k_ret_seq<<<256, 256, 0, stream>>>(q, k, v, P);
    k_headnorm<<<NTOK * 4 / 4, 256, 0, stream>>>(v, gbuf);
    gemm64<<<dim3(2048 / 64, NTOK / 64, 1), 256, 0, stream>>>(1024, ABf{xb, 1024, NTOK}, BW{w_in, WIN_N, C_GATE}, EpiGates{b_merge, gates});
    gemm64<<<dim3(16, NTOK / 64, 1), 256, 0, stream>>>(2048, ABf{v, 2048, NTOK}, BW{w_ret_o, 1024, 0}, EpiM1{gates, m1});
    gemm64<<<dim3(16, NTOK / 64, 1), 256, 0, stream>>>(1536, ABf{gl, 1536, NTOK}, BW{w_lru_o, 1024, 0}, EpiM2{gates, m1, merged});
    gemm64<<<dim3(16, NTOK / 64, 1), 256, 0, stream>>>(1024, ABf{merged, 1024, NTOK}, BW{w_out, 1024, 0}, EpiO{x, out});
    k_ln1_route<<<NTOK / 4, 256, 0, stream>>>(out, x1b, ln1_g, ln1_b, w_group, b_group, w_er, b_er, route_e, route_w, cnt, list);
    gemm64<<<dim3(1024 / 64, NTOK / 64, 32), 256, 0, stream>>>(1024, AGather{x1b, cnt, list}, BGU{w_eg, w_eu}, EpiH{cnt, hbuf});
    gemm64<<<dim3(1024 / 64, NTOK / 64, 32), 256, 0, stream>>>(512, AH{hbuf, cnt}, BDown{w_ed}, EpiY{list, route_w, ys});
    k_final<<<NTOK / 4, 256, 0, stream>>>(out, ys, ln2_g, ln2_b);
}
```

```cpp
#include <hip/hip_runtime.h>
#include <cstdio>
#include <cstdint>

typedef unsigned short bf16_t;
#define DEV __device__ __forceinline__
#define LAS __attribute__((address_space(3)))

DEV float bf2f(bf16_t h) { return __uint_as_float(((unsigned)h) << 16); }
DEV bf16_t f2bf(float f) { unsigned u = __float_as_uint(f); return (bf16_t)((u + 0x7fffu + ((u >> 16) & 1u)) >> 16); }

constexpr int NTHR = 512;
constexpr int NTOK = 32768, DM = 1024, SEQ = 8192;
constexpr int WIN_N = 11264;
constexpr int C_Q = 0, C_K = 1024, C_V = 2048, C_G = 4096, C_U = 6144, C_GL = 7680, C_GATE = 9216;
constexpr float ALPHA = 1.189207115002721f;
constexpr float LN_EPS = 1e-5f;
constexpr size_t MiB = 1u << 20;
constexpr size_t WS_CTL = 0;
constexpr size_t CTL_ZERO_BYTES = 1 * MiB;
constexpr int CW_BAR = 4096;
constexpr size_t WS_ROPE = 1 * MiB;
constexpr size_t WS_ROUTE_E = 9 * MiB;
constexpr size_t WS_ROUTE_W = 9 * MiB + 512 * 1024;
constexpr size_t WS_LIST = 10 * MiB;
constexpr size_t WS_WRG_T = 14 * MiB;
constexpr size_t WS_RSB = 15 * MiB + 512 * 1024;
constexpr size_t WS_SEGA = 16 * MiB;
constexpr size_t WS_SEGH = 18 * MiB;
constexpr size_t WS_CARRY = 20 * MiB;
constexpr size_t WS_XB = 32 * MiB;
constexpr size_t WS_GL = 96 * MiB;
constexpr size_t WS_ULRU = 192 * MiB;
constexpr size_t WS_Q = 192 * MiB;
constexpr size_t WS_K = 256 * MiB;
constexpr size_t WS_GATES = 192 * MiB;
constexpr size_t WS_UCONV = 288 * MiB;
constexpr size_t WS_P = 320 * MiB;
constexpr size_t WS_V = 352 * MiB;
constexpr size_t WS_EPS = 384 * MiB;
constexpr size_t WS_H = 192 * MiB;
constexpr size_t WS_YSLOT = 264 * MiB;
constexpr size_t WS_WGU_T = 352 * MiB;
constexpr size_t WS_WD_T = 416 * MiB;
constexpr int LDS_TAB = 131072;
constexpr size_t WS_WIN_T = 480 * MiB;
constexpr size_t WS_WRO_T = 502 * MiB;
constexpr size_t WS_WLO_T = 506 * MiB;
constexpr size_t WS_WOUT_T = 509 * MiB;
constexpr size_t WS_END = 512 * MiB;
constexpr int LDS_BYTES = 163840;
constexpr int LDS_MISC = 163840 - 512;

#define XB_TMO      128
#define XB_XCNT(j)  (256  + 64 * (j))
#define XB_XSUB(j)  (1280 + 64 * (j))
#define XB_XGEN(j)  (2304 + 64 * (j))
#define XB_TOP      3328
#define XB_TOPGEN   3392
#define XCD_BAR_WORDS 3456
#define XB_SPIN_CAP (1u << 22)
DEV unsigned xb_ld(unsigned* p)              { return __hip_atomic_load(p, __ATOMIC_RELAXED, __HIP_MEMORY_SCOPE_AGENT); }
DEV unsigned xb_add(unsigned* p, unsigned v) { return __hip_atomic_fetch_add(p, v, __ATOMIC_RELAXED, __HIP_MEMORY_SCOPE_AGENT); }
DEV unsigned xb_xcc_id() { return (unsigned)__builtin_amdgcn_s_getreg((3 << 11) | 20) & 0xFu; }
#define XB_SPIN(cond, bar) do { unsigned _sp = 0; while (cond) { __builtin_amdgcn_s_sleep(1); \
    if ((++_sp & 255u) == 0u) { if (xb_ld(&(bar)[XB_TMO])) break; if (_sp > XB_SPIN_CAP) { atomicAdd(&(bar)[XB_TMO], 1u); break; } } } } while (0)
struct XcdBarrier { unsigned* bar; unsigned x; volatile LAS unsigned* st; };
DEV XcdBarrier xcd_barrier_post(unsigned* bar, volatile LAS unsigned* st) {
    XcdBarrier b; b.bar = bar; b.x = xb_xcc_id(); b.st = st;
    if (threadIdx.x == 0) (void)xb_add(&bar[XB_XCNT(b.x)], 1u);
    return b;
}
DEV void xcd_barrier_complete(unsigned* bar, unsigned x, unsigned& nloc, unsigned& nx) {
    const unsigned G = gridDim.x * gridDim.y * gridDim.z;
    unsigned sum, cnt, mine, sp = 0u;
    for (;;) {
        sum = 0u; cnt = 0u; mine = 0u;
#pragma unroll
        for (unsigned j = 0; j < 16; ++j) { const unsigned c = xb_ld(&bar[XB_XCNT(j)]); sum += c; cnt += (c > 0u) ? 1u : 0u; mine = (j == x) ? c : mine; }
        if (sum == G) break;
        __builtin_amdgcn_s_sleep(1);
        if ((++sp & 255u) == 0u) { if (xb_ld(&bar[XB_TMO])) break; if (sp > XB_SPIN_CAP) { atomicAdd(&bar[XB_TMO], 1u); break; } }
    }
    nloc = mine > 0u ? mine : 1u; nx = cnt > 0u ? cnt : 1u;
}
DEV void xcd_barrier(const XcdBarrier& b) {
    asm volatile("s_waitcnt vmcnt(0)" ::: "memory");
    __syncthreads();
    if (threadIdx.x == 0) {
        unsigned* bar = b.bar;
        __builtin_amdgcn_s_waitcnt(0);
        unsigned nloc = b.st[0], nx = b.st[1];
        if (nloc == 0u) { xcd_barrier_complete(bar, b.x, nloc, nx); b.st[0] = nloc; b.st[1] = nx; }
        const unsigned old = xb_add(&bar[XB_XSUB(b.x)], 1u);
        const unsigned gen = old / nloc;
        if (old + 1u == (gen + 1u) * nloc) {
            __builtin_amdgcn_fence(__ATOMIC_RELEASE, "agent");
            asm volatile("s_waitcnt vmcnt(0)" ::: "memory");
            const unsigned og = xb_add(&bar[XB_TOP], 1u);
            const unsigned tg = og / nx;
            if (og + 1u == (tg + 1u) * nx) xb_add(&bar[XB_TOPGEN], 1u);
            else XB_SPIN(xb_ld(&bar[XB_TOPGEN]) == tg, bar);
            __builtin_amdgcn_fence(__ATOMIC_ACQUIRE, "agent");
            xb_add(&bar[XB_XGEN(b.x)], 1u);
            asm volatile("s_waitcnt vmcnt(0)" ::: "memory");
        } else {
            XB_SPIN(xb_ld(&bar[XB_XGEN(b.x)]) == gen, bar);
            __builtin_amdgcn_fence(__ATOMIC_ACQUIRE, "agent");
            asm volatile("s_waitcnt vmcnt(0)" ::: "memory");
        }
    }
    __syncthreads();
}

namespace pg8 {
#define PG8_LAS __attribute__((address_space(3)))
typedef unsigned short bf16_t;
typedef short bf16x8 __attribute__((ext_vector_type(8)));
typedef float f32x4 __attribute__((ext_vector_type(4)));
typedef unsigned u32x4 __attribute__((ext_vector_type(4)));
constexpr int BM = 256, BK = 64, HALF = 128, HTB = HALF * BK * 2  , STAGE_BYTES = 8 * HTB, NXCD = 8, WGM = 8;

__host__ __device__ __forceinline__ int lds_byte(int r, int c) { const int st = (r >> 4) * 2 + (c >> 5), rr = r & 15, cc = c & 31, ob = rr * 64 + cc * 2; return st * 1024 + (ob ^ (((ob >> 9) & 1) << 5)); }
__host__ __device__ __forceinline__ void stage_rc(int b, int& R, int& C) { const int st = b / 1024, sb = b % 1024, swz = sb ^ (((sb >> 9) & 1) << 5); R = (st >> 1) * 16 + swz / 64; C = (st & 1) * 32 + (swz % 64) / 2; }
__host__ __device__ __forceinline__ int perm32(int rho) { const int n = rho >> 4, i = rho & 15; return 8 * (i >> 2) + 4 * n + (i & 3); }

struct Unit { int pm, pn; };
struct Gemm { const bf16_t* A; const bf16_t* Bt; int M, N, K; };

struct StaticOrder {
    int nM, nN, nwg, G, c;
    __host__ __device__ void init(int M, int N, int G_, int c_) { nM = M / BM; nN = N / BM; nwg = nM * nN; G = G_; c = c_; }
    __host__ __device__ bool next(int i, Unit& u) const {
        const long L = (long)i * G + c; if (L >= nwg) return false;
        int wgid = (int)L; { const int q = nwg / NXCD, r = nwg % NXCD, xcd = wgid % NXCD, off = wgid / NXCD; wgid = (xcd < r ? xcd * (q + 1) : r * (q + 1) + (xcd - r) * q) + off; }
        const int nig = WGM * nN, gid = wgid / nig, fm = gid * WGM, gsz = (nM - fm) < WGM ? (nM - fm) : WGM;
        u.pm = fm + ((wgid % nig) % gsz); u.pn = (wgid % nig) / gsz; return true;
    }
    __device__ __forceinline__ void a_ready(const Unit&) const {}
    __device__ __forceinline__ void done(const Unit&) const {}
    __device__ __forceinline__ const char* a_base(const Gemm& g, const Unit& u) const { return (const char*)g.A + (size_t)u.pm * (size_t)(BM * g.K * 2); }
    __device__ __forceinline__ void a_off(const Gemm& g, const Unit&, const int (&R)[2], const int (&C)[2], unsigned (&v)[2][2]) const {
        _Pragma("unroll") for (int hh = 0; hh < 2; ++hh) _Pragma("unroll") for (int i = 0; i < 2; ++i) v[hh][i] = (unsigned)((hh * HALF + R[i]) * g.K + C[i]) * 2u; }
};
typedef __bf16 bf16x2_t __attribute__((ext_vector_type(2)));
typedef float f32x2_t __attribute__((ext_vector_type(2)));
__device__ __forceinline__ unsigned cvt_pk_bf16(float lo, float hi) { f32x2_t v = {lo, hi}; return __builtin_bit_cast(unsigned, __builtin_convertvector(v, bf16x2_t)); }
template <class Epi, class Sched, bool ALIGN_EPI = false, bool SP2 = false>
__device__ __forceinline__ void gemm_phase(PG8_LAS unsigned char* lds, const Gemm g, const Sched& S, const Epi& E) {
    int tid_ = threadIdx.x; asm volatile("" : "+v"(tid_));
    const int tid = tid_, wid = __builtin_amdgcn_readfirstlane(tid >> 6), lane = tid & 63, wr = wid >> 2, wc = wid & 3, fr = lane & 15, fq = lane >> 4;
    const int K = g.K, nt = K / BK;
    unsigned voffB[2], vA[2][2], vN[2][2]; int sR[2], sC[2];
#pragma unroll
    for (int i = 0; i < 2; ++i) { int R, C; stage_rc(tid * 16 + i * 8192, R, C); const int Rb = Epi::PERM ? ((R & ~31) + perm32(R & 31)) : R;
        sR[i] = R; sC[i] = C; voffB[i] = (unsigned)(Rb * K + C) * 2u; }
    const size_t kstep = (size_t)(BK * 2);
    const size_t hstep = (size_t)HALF * K * 2;
    const size_t tstep = 2 * hstep;
    const unsigned ldsw = (unsigned)wid * 1024u;
    const int aoff = lds_byte(wr * 64 + fr, fq * 8), boff = lds_byte(wc * 32 + fr, fq * 8);
#define PG8_SA(b, h) (((b) * 2 + (h)) * HTB)
#define PG8_SB(b, h) ((4 + (b) * 2 + (h)) * HTB)
#define PG8_STAGE(bufoff, gbase, voff) do { _Pragma("unroll") for (int _i = 0; _i < 2; ++_i) \
        __builtin_amdgcn_global_load_lds((const unsigned*)((const char*)(gbase) + (voff)[_i]), (PG8_LAS unsigned*)(lds + (bufoff) + ldsw + _i * 8192), 16, 0, 0); } while (0)
#define PG8_LDA(dst, b, h) do { _Pragma("unroll") for (int m = 0; m < 4; ++m) _Pragma("unroll") for (int k = 0; k < 2; ++k) dst[m][k] = *(const PG8_LAS bf16x8*)(lds + PG8_SA(b, h) + aoff + m * 2048 + k * 1024); } while (0)
#define PG8_LDB(dst, b, h) do { _Pragma("unroll") for (int n = 0; n < 2; ++n) _Pragma("unroll") for (int k = 0; k < 2; ++k) dst[n][k] = *(const PG8_LAS bf16x8*)(lds + PG8_SB(b, h) + boff + n * 2048 + k * 1024); } while (0)
#define PG8_MMA(ai, bj, At, Bt) do { __builtin_amdgcn_s_setprio(1); _Pragma("unroll") for (int m = 0; m < 4; ++m) _Pragma("unroll") for (int n = 0; n < 2; ++n) _Pragma("unroll") for (int k = 0; k < 2; ++k) \
        acc[ai][bj][m][n] = __builtin_amdgcn_mfma_f32_16x16x32_bf16(Bt[n][k], At[m][k], acc[ai][bj][m][n], 0, 0, 0); __builtin_amdgcn_s_setprio(0); } while (0)
#define PG8_WAIT_V(n) asm volatile("s_waitcnt vmcnt(" #n ")" ::: "memory")
#define PG8_WAIT_L(n) asm volatile("s_waitcnt lgkmcnt(" #n ")" ::: "memory")
#define PG8_BAR __builtin_amdgcn_s_barrier()
#define PG8_SCHED __builtin_amdgcn_sched_barrier(0)
    Unit cur, nxt; int ui = 0;
    if (!S.next(0, cur)) return;
    f32x4 acc[2][2][4][2];
#pragma unroll
    for (int a = 0; a < 2; ++a)
#pragma unroll
        for (int b = 0; b < 2; ++b)
#pragma unroll
            for (int m = 0; m < 4; ++m)
#pragma unroll
                for (int n = 0; n < 2; ++n) acc[a][b][m][n] = (f32x4){0.f, 0.f, 0.f, 0.f};
    bf16x8 At[4][2], B0[2][2], B1[2][2];
    const char* cA = S.a_base(g, cur); const char* cB = (const char*)g.Bt + (size_t)cur.pn * tstep;
    S.a_ready(cur); S.a_off(g, cur, sR, sC, vA);
    if constexpr (SP2) {
        PG8_STAGE(PG8_SB(0, 0), cB, voffB); PG8_STAGE(PG8_SB(0, 1), cB + hstep, voffB); PG8_STAGE(PG8_SA(0, 0), cA, vA[0]); PG8_STAGE(PG8_SA(0, 1), cA, vA[1]);
        if (wr == 1) PG8_BAR;
        PG8_WAIT_V(2); PG8_BAR;
        PG8_STAGE(PG8_SB(1, 0), cB + kstep, voffB); PG8_STAGE(PG8_SA(1, 0), cA + kstep, vA[0]); PG8_STAGE(PG8_SB(1, 1), cB + hstep + kstep, voffB);
        PG8_WAIT_V(6); PG8_BAR;
    } else { static_assert(SP2, "only the SP2 K-loop is kept in this file"); }
    for (;;) {
        const bool has_next = S.next(ui + 1, nxt);
        const char* nA = has_next ? S.a_base(g, nxt) : cA; const char* nB = has_next ? (const char*)g.Bt + (size_t)nxt.pn * tstep : cB;
        if (has_next) S.a_off(g, nxt, sR, sC, vN); else { vN[0][0] = vA[0][0]; vN[0][1] = vA[0][1]; vN[1][0] = vA[1][0]; vN[1][1] = vA[1][1]; }
        for (int t = 0; t < nt; t += 2) {
            const bool last = (t == nt - 2);
            const char* a1 = cA + (size_t)(t + 1) * kstep;
            const char* a2 = last ? nA : cA + (size_t)(t + 2) * kstep; const char* b2 = last ? nB : cB + (size_t)(t + 2) * kstep;
            const char* a3 = a2 + kstep; const char* b3 = b2 + kstep;
            unsigned v2[2][2]; v2[0][0] = last ? vN[0][0] : vA[0][0]; v2[0][1] = last ? vN[0][1] : vA[0][1]; v2[1][0] = last ? vN[1][0] : vA[1][0]; v2[1][1] = last ? vN[1][1] : vA[1][1];
            if (last && has_next) S.a_ready(nxt);
            if constexpr (SP2) {
            PG8_LDB(B0, 0, 0); PG8_LDB(B1, 0, 1); PG8_SCHED; PG8_LDA(At, 0, 0); PG8_STAGE(PG8_SA(1, 1), a1, vA[1]);
            PG8_WAIT_V(8); PG8_WAIT_L(0); PG8_BAR; PG8_MMA(0, 0, At, B0); PG8_MMA(0, 1, At, B1); PG8_BAR; PG8_SCHED;
            PG8_LDA(At, 0, 1); PG8_STAGE(PG8_SB(0, 0), b2, voffB); PG8_STAGE(PG8_SB(0, 1), b2 + hstep, voffB); PG8_STAGE(PG8_SA(0, 0), a2, v2[0]);
            PG8_WAIT_V(8); PG8_WAIT_L(0); PG8_BAR; PG8_MMA(1, 0, At, B0); PG8_MMA(1, 1, At, B1); PG8_BAR; PG8_SCHED;
            PG8_LDB(B0, 1, 0); PG8_LDB(B1, 1, 1); PG8_SCHED; PG8_LDA(At, 1, 0); PG8_STAGE(PG8_SA(0, 1), a2, v2[1]);
            PG8_WAIT_V(8); PG8_WAIT_L(0); PG8_BAR; PG8_MMA(0, 0, At, B0); PG8_MMA(0, 1, At, B1); PG8_BAR; PG8_SCHED;
            PG8_LDA(At, 1, 1); PG8_STAGE(PG8_SB(1, 0), b3, voffB); PG8_STAGE(PG8_SB(1, 1), b3 + hstep, voffB); PG8_STAGE(PG8_SA(1, 0), a3, v2[0]);
            PG8_WAIT_V(8); PG8_WAIT_L(0); PG8_BAR; PG8_MMA(1, 0, At, B0); PG8_MMA(1, 1, At, B1); PG8_BAR; PG8_SCHED;
            }
        }
        if constexpr (ALIGN_EPI) { if (wr == 0) PG8_BAR; }
        if constexpr (!Epi::AFTER_DRAIN) { E(acc, cur, wr, wc, fr, fq); S.done(cur); }
        if (!has_next) break;
#pragma unroll
        for (int a = 0; a < 2; ++a)
#pragma unroll
            for (int b = 0; b < 2; ++b)
#pragma unroll
                for (int m = 0; m < 4; ++m)
#pragma unroll
                    for (int n = 0; n < 2; ++n) acc[a][b][m][n] = (f32x4){0.f, 0.f, 0.f, 0.f};
        cur = nxt; cA = nA; cB = nB; ++ui; vA[0][0] = vN[0][0]; vA[0][1] = vN[0][1]; vA[1][0] = vN[1][0]; vA[1][1] = vN[1][1];
        if constexpr (ALIGN_EPI) { if (wr == 1) PG8_BAR; }
    }
    PG8_WAIT_V(0);
    if constexpr (!ALIGN_EPI) { if (wr == 0) PG8_BAR; }
    PG8_BAR;
    if constexpr (Epi::AFTER_DRAIN) { E.fused(acc, cur, wr, wc, fr, fq, lds, wid, lane); S.done(cur); }
#undef PG8_SA
#undef PG8_SB
#undef PG8_STAGE
#undef PG8_LDA
#undef PG8_LDB
#undef PG8_MMA
#undef PG8_WAIT_V
#undef PG8_WAIT_L
#undef PG8_BAR
#undef PG8_SCHED
}

__device__ __forceinline__ float fsig(float x) { return __builtin_amdgcn_rcpf(1.f + __expf(-x)); }
__device__ __forceinline__ float fsilu(float x) { return x * fsig(x); }
__device__ __forceinline__ float fgelu(float x) { return x * fsig(1.5957691216057308f * (x + 0.044715f * x * x * x)); }
__device__ __forceinline__ u32x4 pack8(const f32x4& v0, const f32x4& v1) { u32x4 w; w.x = cvt_pk_bf16(v0[0], v0[1]); w.y = cvt_pk_bf16(v0[2], v0[3]); w.z = cvt_pk_bf16(v1[0], v1[1]); w.w = cvt_pk_bf16(v1[2], v1[3]); return w; }
__device__ __forceinline__ void unpack8(const u32x4& w, f32x4& v0, f32x4& v1) {
    v0[0] = __uint_as_float(w.x << 16); v0[1] = __uint_as_float(w.x & 0xffff0000u); v0[2] = __uint_as_float(w.y << 16); v0[3] = __uint_as_float(w.y & 0xffff0000u);
    v1[0] = __uint_as_float(w.z << 16); v1[1] = __uint_as_float(w.z & 0xffff0000u); v1[2] = __uint_as_float(w.w << 16); v1[3] = __uint_as_float(w.w & 0xffff0000u); }

struct EpiLruIn {
    static constexpr bool PERM = true, AFTER_DRAIN = false;
    bf16_t* u; bf16_t* gl;
    __device__ __forceinline__ void operator()(const f32x4 (&acc)[2][2][4][2], const Unit& un, int wr, int wc, int fr, int fq) const {
        const int row0 = un.pm * BM + wr * 64 + fr; const bool isg = un.pn >= 6;
        bf16_t* base = (isg ? gl : u) + (isg ? un.pn - 6 : un.pn) * BM + wc * 32 + 8 * fq;
#pragma unroll
        for (int ai = 0; ai < 2; ++ai)
#pragma unroll
            for (int m = 0; m < 4; ++m) { bf16_t* rowp = base + (size_t)(row0 + ai * HALF + m * 16) * 1536;
#pragma unroll
                for (int bj = 0; bj < 2; ++bj) { f32x4 v0 = acc[ai][bj][m][0], v1 = acc[ai][bj][m][1];
                    if (isg) {
#pragma unroll
                        for (int e = 0; e < 4; ++e) { v0[e] = fgelu(v0[e]); v1[e] = fgelu(v1[e]); } }
                    *(u32x4*)(rowp + bj * HALF) = pack8(v0, v1); } }
    }
};
struct EpiRetIn {
    static constexpr bool PERM = true, AFTER_DRAIN = false;
    bf16_t* q; bf16_t* k; bf16_t* v; bf16_t* g; const float* rope;
    __device__ __forceinline__ void operator()(const f32x4 (&acc)[2][2][4][2], const Unit& un, int wr, int wc, int fr, int fq) const {
        const int row0 = un.pm * BM + wr * 64 + fr;
        if (un.pn < 8) {
            const bool isk = un.pn >= 4; const int h = un.pn & 3;
            const float lg = __log2f(1.f - __builtin_amdgcn_exp2f(-5.f - (float)h));
            const int jb = wc * 32 + 8 * fq;
            bf16_t* base = (isk ? k : q) + h * 256 + jb;
#pragma unroll
            for (int ai = 0; ai < 2; ++ai)
#pragma unroll
                for (int m = 0; m < 4; ++m) { const int r = row0 + ai * HALF + m * 16, s = r & 8191, n = s & 127;
                    const float sc = isk ? __builtin_amdgcn_exp2f(-(float)n * lg) * 0.0625f : __builtin_amdgcn_exp2f((float)n * lg);
                    const f32x4* tp = (const f32x4*)(rope + ((size_t)s * 128 + jb) * 2);
                    f32x4 o1[2], o2[2];
#pragma unroll
                    for (int nn = 0; nn < 2; ++nn) { const f32x4 ta = tp[2 * nn], tb = tp[2 * nn + 1]; const f32x4 a = acc[ai][0][m][nn], b = acc[ai][1][m][nn];
                        o1[nn][0] = (a[0] * ta[0] - b[0] * ta[1]) * sc; o2[nn][0] = (a[0] * ta[1] + b[0] * ta[0]) * sc;
                        o1[nn][1] = (a[1] * ta[2] - b[1] * ta[3]) * sc; o2[nn][1] = (a[1] * ta[3] + b[1] * ta[2]) * sc;
                        o1[nn][2] = (a[2] * tb[0] - b[2] * tb[1]) * sc; o2[nn][2] = (a[2] * tb[1] + b[2] * tb[0]) * sc;
                        o1[nn][3] = (a[3] * tb[2] - b[3] * tb[3]) * sc; o2[nn][3] = (a[3] * tb[3] + b[3] * tb[2]) * sc; }
                    bf16_t* rowp = base + (size_t)r * 1024;
                    *(u32x4*)(rowp) = pack8(o1[0], o1[1]); *(u32x4*)(rowp + HALF) = pack8(o2[0], o2[1]);
                    asm volatile("" ::: "memory"); }
        } else {
            const bool isg = un.pn >= 16;
            bf16_t* base = (isg ? g : v) + ((un.pn - 8) & 7) * BM + wc * 32 + 8 * fq;
#pragma unroll
            for (int ai = 0; ai < 2; ++ai)
#pragma unroll
                for (int m = 0; m < 4; ++m) { bf16_t* rowp = base + (size_t)(row0 + ai * HALF + m * 16) * 2048;
#pragma unroll
                    for (int bj = 0; bj < 2; ++bj) { f32x4 v0 = acc[ai][bj][m][0], v1 = acc[ai][bj][m][1];
                        if (isg) {
#pragma unroll
                            for (int e = 0; e < 4; ++e) { v0[e] = fsilu(v0[e]); v1[e] = fsilu(v1[e]); } }
                        *(u32x4*)(rowp + bj * HALF) = pack8(v0, v1); } }
        }
    }
};
struct EpiGates {
    static constexpr bool PERM = true, AFTER_DRAIN = false;
    const float* bm; bf16_t* gates;
    __device__ __forceinline__ void operator()(const f32x4 (&acc)[2][2][4][2], const Unit& un, int wr, int wc, int fr, int fq) const {
        const int row0 = un.pm * BM + wr * 64 + fr, col0 = un.pn * BM + wc * 32 + 8 * fq;
        f32x4 bv[2][2];
#pragma unroll
        for (int bj = 0; bj < 2; ++bj)
#pragma unroll
            for (int n = 0; n < 2; ++n) bv[bj][n] = *(const f32x4*)(bm + col0 + bj * HALF + 4 * n);
#pragma unroll
        for (int ai = 0; ai < 2; ++ai)
#pragma unroll
            for (int m = 0; m < 4; ++m) { bf16_t* rowp = gates + (size_t)(row0 + ai * HALF + m * 16) * 2048 + col0;
#pragma unroll
                for (int bj = 0; bj < 2; ++bj) { f32x4 v0 = acc[ai][bj][m][0] + bv[bj][0], v1 = acc[ai][bj][m][1] + bv[bj][1];
#pragma unroll
                    for (int e = 0; e < 4; ++e) { v0[e] = fsig(v0[e]); v1[e] = fsig(v1[e]); }
                    *(u32x4*)(rowp + bj * HALF) = pack8(v0, v1); } }
    }
};
template <int MODE> struct EpiMerge {
    static constexpr bool PERM = true, AFTER_DRAIN = false;
    const bf16_t* gates; const bf16_t* m1in; bf16_t* o;
    __device__ __forceinline__ void operator()(const f32x4 (&acc)[2][2][4][2], const Unit& un, int wr, int wc, int fr, int fq) const {
        const int row0 = un.pm * BM + wr * 64 + fr, col0 = un.pn * BM + wc * 32 + 8 * fq;
#pragma unroll
        for (int ai = 0; ai < 2; ++ai)
#pragma unroll
            for (int m = 0; m < 4; ++m) { const size_t r = (size_t)(row0 + ai * HALF + m * 16);
#pragma unroll
                for (int bj = 0; bj < 2; ++bj) { const int c = col0 + bj * HALF;
                    f32x4 g0, g1; unpack8(*(const u32x4*)(gates + r * 2048 + MODE * 1024 + c), g0, g1);
                    f32x4 v0 = acc[ai][bj][m][0] * g0, v1 = acc[ai][bj][m][1] * g1;
                    if (MODE == 1) { f32x4 p0, p1; unpack8(*(const u32x4*)(m1in + r * 1024 + c), p0, p1); v0 += p0; v1 += p1; }
                    *(u32x4*)(o + r * 1024 + c) = pack8(v0, v1); } }
    }
};
struct EpiOut {
    static constexpr bool PERM = true, AFTER_DRAIN = false;
    const float* x; bf16_t* y; float alpha;
    __device__ __forceinline__ void operator()(const f32x4 (&acc)[2][2][4][2], const Unit& un, int wr, int wc, int fr, int fq) const {
        const int row0 = un.pm * BM + wr * 64 + fr, col0 = un.pn * BM + wc * 32 + 8 * fq;
#pragma unroll
        for (int ai = 0; ai < 2; ++ai)
#pragma unroll
            for (int m = 0; m < 4; ++m) { const size_t off = (size_t)(row0 + ai * HALF + m * 16) * 1024 + col0;
#pragma unroll
                for (int bj = 0; bj < 2; ++bj) { const f32x4 x0 = *(const f32x4*)(x + off + bj * HALF), x1 = *(const f32x4*)(x + off + bj * HALF + 4);
                    *(u32x4*)(y + off + bj * HALF) = pack8(x0 * alpha + acc[ai][bj][m][0], x1 * alpha + acc[ai][bj][m][1]); } }
    }
};
struct MoeTab { int tileStart[33]; int cnt[32]; int pad_[3]; int tileExp[320]; };
__device__ __forceinline__ void moe_build_tab(PG8_LAS MoeTab* tab, const int* cnt) {
    if (threadIdx.x == 0) { int t = 0; for (int e = 0; e < 32; ++e) { const int c = cnt[e * 64], nt = (c + 255) >> 8; tab->tileStart[e] = t; tab->cnt[e] = c; for (int i = 0; i < nt; ++i) tab->tileExp[t + i] = e; t += nt; } tab->tileStart[32] = t; }
    __syncthreads();
}
template <bool GATHER> struct MoeOrder {
    int U, G, c; const PG8_LAS MoeTab* tab; const int* list;
    __device__ __forceinline__ bool next(int i, Unit& u) const {
        const long L = (long)i * G + c; if (L >= U) return false;
        int wgid = (int)L; { const int q = U / NXCD, r = U % NXCD, xcd = wgid % NXCD, off = wgid / NXCD; wgid = (xcd < r ? xcd * (q + 1) : r * (q + 1) + (xcd - r) * q) + off; }
        u.pm = wgid >> 2; u.pn = tab->tileExp[u.pm] * 4 + (wgid & 3); return true;
    }
    __device__ __forceinline__ void a_ready(const Unit&) const {}
    __device__ __forceinline__ void done(const Unit&) const {}
    __device__ __forceinline__ const char* a_base(const Gemm& g, const Unit& u) const { return GATHER ? (const char*)g.A : (const char*)g.A + (size_t)u.pm * (size_t)(BM * g.K * 2); }
    __device__ __forceinline__ void a_off(const Gemm& g, const Unit& u, const int (&R)[2], const int (&C)[2], unsigned (&v)[2][2]) const {
        if (!GATHER) { _Pragma("unroll") for (int hh = 0; hh < 2; ++hh) _Pragma("unroll") for (int i = 0; i < 2; ++i) v[hh][i] = (unsigned)((hh * HALF + R[i]) * g.K + C[i]) * 2u; }
        else { const int e = u.pn >> 2, base = (u.pm - tab->tileStart[e]) * BM, ce = tab->cnt[e];
            _Pragma("unroll") for (int hh = 0; hh < 2; ++hh) _Pragma("unroll") for (int i = 0; i < 2; ++i) { const int lr = base + hh * HALF + R[i]; const int tok = (lr < ce) ? (list[e * 32768 + lr] >> 1) : 0; v[hh][i] = (unsigned)(tok * g.K + C[i]) * 2u; } }
    }
};
struct EpiSwiGLU {
    static constexpr bool PERM = true, AFTER_DRAIN = false;
    bf16_t* h;
    __device__ __forceinline__ void operator()(const f32x4 (&acc)[2][2][4][2], const Unit& un, int wr, int wc, int fr, int fq) const {
        const int row0 = un.pm * BM + wr * 64 + fr, col0 = (un.pn & 3) * 128 + wc * 32 + 8 * fq;
#pragma unroll
        for (int ai = 0; ai < 2; ++ai)
#pragma unroll
            for (int m = 0; m < 4; ++m) { f32x4 v0, v1;
#pragma unroll
                for (int e = 0; e < 4; ++e) { v0[e] = fsilu(acc[ai][0][m][0][e]) * acc[ai][1][m][0][e]; v1[e] = fsilu(acc[ai][0][m][1][e]) * acc[ai][1][m][1][e]; }
                *(u32x4*)(h + (size_t)(row0 + ai * HALF + m * 16) * 512 + col0) = pack8(v0, v1); }
    }
};
struct EpiMoeOut {
    static constexpr bool PERM = true, AFTER_DRAIN = false;
    const PG8_LAS MoeTab* tab; const int* list; const float* rw; bf16_t* ys;
    __device__ __forceinline__ void operator()(const f32x4 (&acc)[2][2][4][2], const Unit& un, int wr, int wc, int fr, int fq) const {
        const int e = un.pn >> 2, lrow0 = (un.pm - tab->tileStart[e]) * BM + wr * 64 + fr, ce = tab->cnt[e], col0 = (un.pn & 3) * BM + wc * 32 + 8 * fq;
        int slot[8]; float wgt[8];
#pragma unroll
        for (int i = 0; i < 8; ++i) { const int lr = lrow0 + (i >> 2) * HALF + (i & 3) * 16; slot[i] = (lr < ce) ? list[e * 32768 + lr] : -1; }
#pragma unroll
        for (int i = 0; i < 8; ++i) wgt[i] = (slot[i] >= 0) ? rw[slot[i]] : 0.f;
#pragma unroll
        for (int ai = 0; ai < 2; ++ai)
#pragma unroll
            for (int m = 0; m < 4; ++m) { const int i = ai * 4 + m;
                if (slot[i] >= 0) { const float w = wgt[i]; bf16_t* rowp = ys + (size_t)slot[i] * 1024 + col0;
#pragma unroll
                    for (int bj = 0; bj < 2; ++bj) *(u32x4*)(rowp + bj * HALF) = pack8(acc[ai][bj][m][0] * w, acc[ai][bj][m][1] * w); } }
    }
};
}

DEV unsigned pk2(float lo, float hi) { return (unsigned)f2bf(lo) | ((unsigned)f2bf(hi) << 16); }
typedef unsigned v4u __attribute__((ext_vector_type(4)));
DEV void transpose_item(const float* W, int K, int N, bf16_t* WT, int row_off, float* scr, int item, int lane) {
    const int nblk = N / 32, kb = item / nblk, nb = item % nblk, k0 = 64 * kb, n0 = 32 * nb;
    float wv[32];
#pragma unroll
    for (int i = 0; i < 32; ++i) wv[i] = W[(size_t)(k0 + 2 * i + (lane >> 5)) * N + n0 + (lane & 31)];
#pragma unroll
    for (int i = 0; i < 32; ++i) scr[(2 * i + (lane >> 5)) * 33 + (lane & 31)] = wv[i];
    asm volatile("s_waitcnt lgkmcnt(0)" ::: "memory");
    const int c = lane & 7;
#pragma unroll
    for (int j = 0; j < 4; ++j) { const int n = (lane >> 3) + 8 * j; const float* s = scr + (8 * c) * 33 + n;
        v4u o; o.x = pk2(s[0 * 33], s[1 * 33]); o.y = pk2(s[2 * 33], s[3 * 33]); o.z = pk2(s[4 * 33], s[5 * 33]); o.w = pk2(s[6 * 33], s[7 * 33]);
        *(v4u*)(WT + (size_t)(row_off + n0 + n) * K + k0 + 8 * c) = o; }
    asm volatile("s_waitcnt lgkmcnt(0)" ::: "memory");
}
DEV void p_weights(float* lds, const float* w_in, const float* w_ret_o, const float* w_lru_o, const float* w_out, const float* w_rg_r, const float* w_rg_i, bf16_t* w_in_t, bf16_t* w_ro_t, bf16_t* w_lo_t, bf16_t* w_out_t, bf16_t* wrg_t) {
    const int wave = threadIdx.x >> 6, lane = threadIdx.x & 63;
    float* scr = lds + wave * 2304;
    constexpr int I0 = 16 * (WIN_N / 32), I1 = 32 * 32, I2 = 24 * 32, I3 = 16 * 32, I4 = 16 * 18;
    for (int it = blockIdx.x * 8 + wave; it < I0 + I1 + I2 + I3 + I4; it += gridDim.x * 8) {
        int r = it;
        if (r < I0) { transpose_item(w_in, 1024, WIN_N, w_in_t, 0, scr, r, lane); continue; } r -= I0;
        if (r < I1) { transpose_item(w_ret_o, 2048, 1024, w_ro_t, 0, scr, r, lane); continue; } r -= I1;
        if (r < I2) { transpose_item(w_lru_o, 1536, 1024, w_lo_t, 0, scr, r, lane); continue; } r -= I2;
        if (r < I3) { transpose_item(w_out, 1024, 1024, w_out_t, 0, scr, r, lane); continue; } r -= I3;
        { const int mi = r / 18, sub = r - mi * 18; const float* W = (mi < 8 ? w_rg_r + (size_t)mi * 192 * 192 : w_rg_i + (size_t)(mi - 8) * 192 * 192);
          transpose_item(W, 192, 192, wrg_t + (size_t)mi * 192 * 192, 0, scr, sub, lane); }
    }
}

DEV void p_expert_weights(float* lds, const float* w_eg, const float* w_eu, const float* w_ed, bf16_t* wgu_t, bf16_t* wd_t) {
    const int wave = threadIdx.x >> 6, lane = threadIdx.x & 63;
    float* scr = lds + wave * 2304;
    for (int it = blockIdx.x * 8 + wave; it < 3 * 8192; it += gridDim.x * 8) {
        const int kind = it >> 13, r = it & 8191, e = r >> 8, sub = r & 255;
        if (kind < 2) { const int nb = sub & 15; transpose_item((kind ? w_eu : w_eg) + (size_t)e * 1024 * 512, 1024, 512, wgu_t + (size_t)e * 1024 * 1024, (nb >> 2) * 128 + kind * 128, scr, sub, lane); }
        else transpose_item(w_ed + (size_t)e * 512 * 1024, 512, 1024, wd_t + (size_t)e * 1024 * 512, 0, scr, sub, lane);
    }
}

DEV void p_router_consts(float* lds, const float* g1, const float* b1, const float* wg, const float* bg, const float* we, const float* be, float* sb) {
    if (blockIdx.x != 0) return;
    const int t = threadIdx.x, wv = t >> 6, lane = t & 63;
    float s[36], q[36];
#pragma unroll
    for (int c = 0; c < 36; ++c) { s[c] = 0.f; q[c] = 0.f; }
#pragma unroll
    for (int kk = 0; kk < 2; ++kk) { const int k = t + 512 * kk; const float gk = g1[k], bk = b1[k];
#pragma unroll
        for (int c4 = 0; c4 < 9; ++c4) { const float4 w = (c4 < 8) ? *(const float4*)(we + (size_t)k * 32 + c4 * 4) : *(const float4*)(wg + (size_t)k * 4);
            s[4 * c4] += gk * w.x; s[4 * c4 + 1] += gk * w.y; s[4 * c4 + 2] += gk * w.z; s[4 * c4 + 3] += gk * w.w;
            q[4 * c4] += bk * w.x; q[4 * c4 + 1] += bk * w.y; q[4 * c4 + 2] += bk * w.z; q[4 * c4 + 3] += bk * w.w; } }
#pragma unroll
    for (int m = 1; m < 64; m <<= 1) {
#pragma unroll
        for (int c = 0; c < 36; ++c) { s[c] += __shfl_xor(s[c], m); q[c] += __shfl_xor(q[c], m); } }
    if (lane == 0) {
#pragma unroll
        for (int c = 0; c < 36; ++c) { lds[wv * 96 + c] = s[c]; lds[wv * 96 + 48 + c] = q[c]; } }
    __syncthreads();
    if (t < 96) { const int cc = t % 48; float v = 0.f;
        if (cc < 36) { for (int p = 0; p < 8; ++p) v += lds[p * 96 + t]; if (t >= 48) v += (cc < 32) ? be[cc] : bg[cc - 32]; }
        sb[t] = v; }
    __syncthreads();
}
DEV void p_cvt_x(const float* x, bf16_t* xb) {
    const size_t n4 = (size_t)NTOK * DM / 4, stride = (size_t)gridDim.x * NTHR;
    for (size_t i0 = (size_t)blockIdx.x * NTHR + threadIdx.x; i0 < n4; i0 += 8 * stride) {
        float4 t[8];
#pragma unroll
        for (int u = 0; u < 8; ++u) { const size_t i = i0 + u * stride; t[u] = (i < n4) ? ((const float4*)x)[i] : make_float4(0.f, 0.f, 0.f, 0.f); }
#pragma unroll
        for (int u = 0; u < 8; ++u) { const size_t i = i0 + u * stride; if (i < n4) { uint2 o; o.x = pg8::cvt_pk_bf16(t[u].x, t[u].y); o.y = pg8::cvt_pk_bf16(t[u].z, t[u].w); ((uint2*)xb)[i] = o; } }
    }
}
DEV void p_rope_table(float2* tab) {
    for (int i = blockIdx.x * NTHR + threadIdx.x; i < 8192 * 128; i += gridDim.x * NTHR) {
        const int s = i >> 7, j = i & 127;
        const double r = 0.93057204092969897;
        double inv = 1.0; for (int t = 0; t < j; ++t) inv *= r;
        const double ang = (double)s * inv;
        const double twopi_hi = 6.283185307179586232, twopi_lo = 2.4492935982947064e-16;
        const double n = rint(ang / twopi_hi);
        const double x = (ang - n * twopi_hi) - n * twopi_lo;
        const double x2 = x * x;
        double acc = 1.0 - x2 * (1.0 / (22.0 * 23.0));
        for (int k = 21; k >= 3; k -= 2) acc = 1.0 - x2 / ((double)(k - 1) * (double)k) * acc;
        double acc2 = 1.0 - x2 / (21.0 * 22.0);
        for (int k = 20; k >= 2; k -= 2) acc2 = 1.0 - x2 / ((double)(k - 1) * (double)k) * acc2;
        tab[i] = make_float2((float)acc2, (float)(x * acc));
    }
}

typedef short bf16x8_t __attribute__((ext_vector_type(8)));
typedef float f32x4_t __attribute__((ext_vector_type(4)));
typedef short s16x4_t __attribute__((ext_vector_type(4)));
typedef unsigned u32x4_t __attribute__((ext_vector_type(4)));
constexpr int LRU_ROWB = 400;
DEV void p_lru_compute(unsigned char* lds, const bf16_t* ulru, const float* cw, const float* cb, const bf16_t* wrg_t,
                       const float* b_r, const float* b_i, const float* lam, bf16_t* epsb, bf16_t* xinb, float* segA, float* segH) {
    int tid_ = threadIdx.x; asm volatile("" : "+v"(tid_));
    const int tid = tid_, wave = tid >> 6, lane = tid & 63, fr = lane & 15, fq = lane >> 4, wr = wave >> 2, wc = wave & 3;
    unsigned char* stg = lds + 256 * LRU_ROWB + wave * 4096;
    for (int item = blockIdx.x; item < 1024; item += gridDim.x) {
        const int n = item & 7, b = (item >> 3) & 3, seg = item >> 5;
        const size_t t0 = (size_t)b * SEQ + seg * 256;
#pragma unroll 4
        for (int idx = tid; idx < 256 * 24; idx += NTHR) {
            const int r = idx / 24, c8 = idx - r * 24, ch0 = n * 192 + c8 * 8;
            float acc[8];
            { const float4 c0 = *(const float4*)(cb + ch0), c1 = *(const float4*)(cb + ch0 + 4); acc[0] = c0.x; acc[1] = c0.y; acc[2] = c0.z; acc[3] = c0.w; acc[4] = c1.x; acc[5] = c1.y; acc[6] = c1.z; acc[7] = c1.w; }
#pragma unroll
            for (int j = 0; j < 4; ++j) {
                if (seg * 256 + r - 3 + j >= 0) {
                    const uint4 uv = *(const uint4*)(ulru + (t0 + r - 3 + j) * 1536 + ch0);
                    const float4 w0 = *(const float4*)(cw + j * 1536 + ch0), w1 = *(const float4*)(cw + j * 1536 + ch0 + 4);
                    acc[0] += w0.x * __uint_as_float(uv.x << 16); acc[1] += w0.y * __uint_as_float(uv.x & 0xffff0000u);
                    acc[2] += w0.z * __uint_as_float(uv.y << 16); acc[3] += w0.w * __uint_as_float(uv.y & 0xffff0000u);
                    acc[4] += w1.x * __uint_as_float(uv.z << 16); acc[5] += w1.y * __uint_as_float(uv.z & 0xffff0000u);
                    acc[6] += w1.z * __uint_as_float(uv.w << 16); acc[7] += w1.w * __uint_as_float(uv.w & 0xffff0000u);
                }
            }
            uint4 o; o.x = pg8::cvt_pk_bf16(acc[0], acc[1]); o.y = pg8::cvt_pk_bf16(acc[2], acc[3]); o.z = pg8::cvt_pk_bf16(acc[4], acc[5]); o.w = pg8::cvt_pk_bf16(acc[6], acc[7]);
            *(uint4*)(lds + r * LRU_ROWB + c8 * 16) = o;
        }
        __syncthreads();
        float cbr[3], cbi[3], csp[3], hrun[3], atot[3];
        const int sub = seg * 2 + wr;
#pragma unroll
        for (int tc = 0; tc < 3; ++tc) { const int ch = n * 192 + 48 * wc + 16 * tc + fr; cbr[tc] = b_r[ch]; cbi[tc] = b_i[ch]; csp[tc] = 8.f * 1.4426950408889634f * log1pf(__expf(-lam[ch])); atot[tc] = 1.f; hrun[tc] = 0.f; }
        const bf16_t* wrb = wrg_t + ((size_t)n * 192 + 48 * wc + fr) * 192 + fq * 8;
        const bf16_t* wib = wrb + (size_t)8 * 192 * 192;
#pragma unroll
        for (int tc = 0; tc < 3; ++tc) {
            bf16x8_t bfr[6][2];
#pragma unroll
            for (int ks = 0; ks < 6; ++ks) { bfr[ks][0] = *(const bf16x8_t*)(wrb + tc * 16 * 192 + ks * 32); bfr[ks][1] = *(const bf16x8_t*)(wib + tc * 16 * 192 + ks * 32); }
#pragma unroll
            for (int p = 0; p < 2; ++p) {
                const int rowb = 128 * wr + 64 * p;
                f32x4_t acc[4][2];
#pragma unroll
                for (int m = 0; m < 4; ++m) { acc[m][0] = (f32x4_t){0.f, 0.f, 0.f, 0.f}; acc[m][1] = (f32x4_t){0.f, 0.f, 0.f, 0.f}; }
#pragma unroll
                for (int ks = 0; ks < 6; ++ks) {
                    bf16x8_t afr[4];
#pragma unroll
                    for (int m = 0; m < 4; ++m) afr[m] = *(const bf16x8_t*)(lds + (rowb + 16 * (fr >> 2) + 4 * m + (fr & 3)) * LRU_ROWB + ks * 64 + fq * 16);
#pragma unroll
                    for (int m = 0; m < 4; ++m) { acc[m][0] = __builtin_amdgcn_mfma_f32_16x16x32_bf16(afr[m], bfr[ks][0], acc[m][0], 0, 0, 0); acc[m][1] = __builtin_amdgcn_mfma_f32_16x16x32_bf16(afr[m], bfr[ks][1], acc[m][1], 0, 0, 0); }
                }
                const int coff = (48 * wc + 16 * tc + fr) * 2;
                const unsigned char* up = lds + (rowb + 16 * fq) * LRU_ROWB + coff;
                float Al = 1.f, Bl = 0.f;
                unsigned pe[8], px[8];
#pragma unroll
                for (int m = 0; m < 4; ++m) {
                    float ee[4], xx[4];
#pragma unroll
                    for (int j = 0; j < 4; ++j) {
                        const float rr = pg8::fsig(acc[m][0][j] + cbr[tc]), ii = pg8::fsig(acc[m][1][j] + cbi[tc]);
                        const float aa = __builtin_amdgcn_exp2f(-csp[tc] * rr);
                        const float u = bf2f(*(const bf16_t*)(up + (4 * m + j) * LRU_ROWB));
                        const float om = 1.f - aa;
                        const float x = __builtin_amdgcn_sqrtf(fmaxf(om * (1.f + aa), 0.f)) * ii * u;
                        ee[j] = om; xx[j] = x; Bl = aa * Bl + x; Al *= aa;
                    }
                    pe[2 * m] = pg8::cvt_pk_bf16(ee[0], ee[1]); pe[2 * m + 1] = pg8::cvt_pk_bf16(ee[2], ee[3]);
                    px[2 * m] = pg8::cvt_pk_bf16(xx[0], xx[1]); px[2 * m + 1] = pg8::cvt_pk_bf16(xx[2], xx[3]);
                }
                { float h = hrun[tc], ap = 1.f;
#pragma unroll
                  for (int q = 0; q < 4; ++q) { const float Aq = __shfl(Al, fr + 16 * q), Bq = __shfl(Bl, fr + 16 * q); h = Aq * h + Bq; ap *= Aq; }
                  hrun[tc] = h; atot[tc] *= ap; }
#pragma unroll
                for (int m = 0; m < 4; ++m)
#pragma unroll
                    for (int j = 0; j < 4; ++j) { const int tk = 16 * fq + 4 * m + j; const unsigned we = pe[2 * m + (j >> 1)], wx = px[2 * m + (j >> 1)];
                        *(bf16_t*)(stg + tk * 32 + fr * 2) = (bf16_t)((j & 1) ? (we >> 16) : (we & 0xffff));
                        *(bf16_t*)(stg + 2048 + tk * 32 + fr * 2) = (bf16_t)((j & 1) ? (wx >> 16) : (wx & 0xffff)); }
                asm volatile("s_waitcnt lgkmcnt(0)" ::: "memory");
#pragma unroll
                for (int i = 0; i < 2; ++i) { const int piece = lane + 64 * i, tk = piece >> 1, hf = piece & 1;
                    const size_t go = (t0 + rowb + tk) * 1536 + n * 192 + 48 * wc + 16 * tc + 8 * hf;
                    *(u32x4_t*)(epsb + go) = *(const u32x4_t*)(stg + tk * 32 + hf * 16);
                    *(u32x4_t*)(xinb + go) = *(const u32x4_t*)(stg + 2048 + tk * 32 + hf * 16); }
                asm volatile("s_waitcnt lgkmcnt(0)" ::: "memory");
            }
        }
        if (fq == 0) {
#pragma unroll
            for (int tc = 0; tc < 3; ++tc) { const size_t o = ((size_t)b * 64 + sub) * 1536 + n * 192 + 48 * wc + 16 * tc + fr; segA[o] = atot[tc]; segH[o] = hrun[tc]; }
        }
        __syncthreads();
    }
}
DEV void p_lru_scan(const bf16_t* epsb, const bf16_t* xinb, bf16_t* gl, const float* carry) {
    const int tid = threadIdx.x;
    if (tid >= 384) return;
    for (int item = blockIdx.x; item < 256; item += gridDim.x) {
        const int b = item >> 6, sub = item & 63;
        const size_t base = ((size_t)b * SEQ + sub * 128) * 1536 + tid * 4;
        const float4 cin = *(const float4*)(carry + ((size_t)b * 64 + sub) * 1536 + tid * 4);
        float h0 = cin.x, h1 = cin.y, h2 = cin.z, h3 = cin.w;
#pragma unroll 8
        for (int t = 0; t < 128; ++t) {
            const size_t o = base + (size_t)t * 1536;
            const uint2 ev = *(const uint2*)(epsb + o), xv = *(const uint2*)(xinb + o), gv = *(const uint2*)(gl + o);
            h0 = (1.f - __uint_as_float(ev.x << 16)) * h0 + __uint_as_float(xv.x << 16);
            h1 = (1.f - __uint_as_float(ev.x & 0xffff0000u)) * h1 + __uint_as_float(xv.x & 0xffff0000u);
            h2 = (1.f - __uint_as_float(ev.y << 16)) * h2 + __uint_as_float(xv.y << 16);
            h3 = (1.f - __uint_as_float(ev.y & 0xffff0000u)) * h3 + __uint_as_float(xv.y & 0xffff0000u);
            uint2 ov; ov.x = pg8::cvt_pk_bf16(h0 * __uint_as_float(gv.x << 16), h1 * __uint_as_float(gv.x & 0xffff0000u)); ov.y = pg8::cvt_pk_bf16(h2 * __uint_as_float(gv.y << 16), h3 * __uint_as_float(gv.y & 0xffff0000u));
            *(uint2*)(gl + o) = ov;
        }
    }
}
DEV void p_lru_carry(float* lds, const float* segA, const float* segH, float* carry) {
    float* tA = lds; float* tH = lds + 64 * 65;
    for (int item = blockIdx.x; item < 96; item += gridDim.x) {
        const int b = item / 24, c0 = (item % 24) * 64;
        for (int i = threadIdx.x; i < 64 * 64; i += NTHR) { const int s = i >> 6, c = i & 63; const size_t o = ((size_t)b * 64 + s) * 1536 + c0 + c; tA[s * 65 + c] = segA[o]; tH[s * 65 + c] = segH[o]; }
        __syncthreads();
        if (threadIdx.x < 64) { const int c = threadIdx.x; float h = 0.f;
            for (int s = 0; s < 64; ++s) { const float a = tA[s * 65 + c], hh = tH[s * 65 + c]; tA[s * 65 + c] = h; h = a * h + hh; } }
        __syncthreads();
        for (int i = threadIdx.x; i < 64 * 64; i += NTHR) { const int s = i >> 6, c = i & 63; carry[((size_t)b * 64 + s) * 1536 + c0 + c] = tA[s * 65 + c]; }
        __syncthreads();
    }
}
#define LDS_BARRIER() do { asm volatile("s_waitcnt lgkmcnt(0)" ::: "memory"); __builtin_amdgcn_s_barrier(); asm volatile("" ::: "memory"); } while (0)
DEV void p_scores(unsigned char* lds, const bf16_t* q, const bf16_t* k, bf16_t* P) {
    int tid_ = threadIdx.x; asm volatile("" : "+v"(tid_));
    const int tid = tid_, w = tid >> 6, lane = tid & 63, fr = lane & 15, fq = lane >> 4;
    const int krow = tid >> 5, kch = tid & 31;
    u32x4_t kreg[8]; bf16x8_t qa[8];
    int g = blockIdx.x;
    if (g < 1024) { const int c = g & 63, bh = g >> 6, b = bh >> 2, h = bh & 3; const size_t tok0 = (size_t)b * SEQ + c * 128;
        const bf16_t* kc = k + tok0 * 1024 + h * 256;
#pragma unroll
        for (int ii = 0; ii < 8; ++ii) kreg[ii] = *(const u32x4_t*)(kc + (size_t)(krow + 16 * ii) * 1024 + kch * 8);
        const bf16_t* qp = q + (tok0 + 16 * w + fr) * 1024 + h * 256 + fq * 8;
#pragma unroll
        for (int ks = 0; ks < 8; ++ks) qa[ks] = *(const bf16x8_t*)(qp + ks * 32); }
    for (; g < 1024; g += gridDim.x) {
#pragma unroll
        for (int ii = 0; ii < 8; ++ii) *(u32x4_t*)(lds + (krow + 16 * ii) * 528 + kch * 16) = kreg[ii];
        bf16x8_t qc[8];
#pragma unroll
        for (int ks = 0; ks < 8; ++ks) qc[ks] = qa[ks];
        const int gn = g + gridDim.x;
        if (gn < 1024) { const int c = gn & 63, bh = gn >> 6, b = bh >> 2, h = bh & 3; const size_t tok0 = (size_t)b * SEQ + c * 128;
            const bf16_t* kc = k + tok0 * 1024 + h * 256;
#pragma unroll
            for (int ii = 0; ii < 8; ++ii) kreg[ii] = *(const u32x4_t*)(kc + (size_t)(krow + 16 * ii) * 1024 + kch * 8);
            const bf16_t* qp = q + (tok0 + 16 * w + fr) * 1024 + h * 256 + fq * 8;
#pragma unroll
            for (int ks = 0; ks < 8; ++ks) qa[ks] = *(const bf16x8_t*)(qp + ks * 32); }
        LDS_BARRIER();
        f32x4_t acc[8];
#pragma unroll
        for (int nt = 0; nt < 8; ++nt) acc[nt] = (f32x4_t){0.f, 0.f, 0.f, 0.f};
#pragma unroll
        for (int ks = 0; ks < 8; ++ks)
#pragma unroll
            for (int nt = 0; nt < 8; ++nt) { const bf16x8_t bb = *(const bf16x8_t*)(lds + (16 * nt + fr) * 528 + ks * 64 + fq * 16); acc[nt] = __builtin_amdgcn_mfma_f32_16x16x32_bf16(qc[ks], bb, acc[nt], 0, 0, 0); }
        LDS_BARRIER();
        bf16_t* Pg = P + (size_t)g * 16384 + (16 * w + 4 * fq) * 128 + fr;
        int nrow = 16 * w + 4 * fq - fr; asm volatile("" : "+v"(nrow));
#pragma unroll
        for (int nt = 0; nt < 8; ++nt)
#pragma unroll
            for (int j = 0; j < 4; ++j) Pg[j * 128 + 16 * nt] = (16 * nt <= nrow + j) ? f2bf(acc[nt][j]) : (bf16_t)0;
    }
    __syncthreads();
}
constexpr int RT_KS = 528, RT_VS = 272, RT_K = 0, RT_V = 128 * RT_KS, RT_U = RT_V + 32 * RT_VS;
DEV void p_ret_mfma(unsigned char* lds, const bf16_t* q, const bf16_t* k, bf16_t* v, const bf16_t* P) {
    int tid_ = threadIdx.x; asm volatile("" : "+v"(tid_));
    const int tid = tid_, w = tid >> 6, lane = tid & 63, fr = lane & 15, fq = lane >> 4;
    for (int wk = blockIdx.x; wk < 256; wk += gridDim.x) {
        const int xcd = wk & 7, idx = wk >> 3, bh = xcd * 2 + (idx >> 4), sl = idx & 15, b = bh >> 2, h = bh & 3;
        float g128; { const double gam = 1.0 - exp2(-5.0 - (double)h); g128 = (float)exp2(128.0 * log2(gam)); }
        asm volatile("" : "+v"(g128));
        f32x4_t accU[2][2];
#pragma unroll
        for (int et = 0; et < 2; ++et)
#pragma unroll
            for (int di = 0; di < 2; ++di) accU[et][di] = (f32x4_t){0.f, 0.f, 0.f, 0.f};
        for (int i = tid; i < 32 * RT_KS / 4; i += NTHR) ((unsigned*)(lds + RT_U))[i] = 0u;
        const size_t tokb = (size_t)b * SEQ;
        u32x4_t kreg[8], vreg;
        const int krow = tid >> 5, kch = tid & 31, vm = tid >> 2, ve = (tid & 3) * 8;
        {
            const bf16_t* kc = k + tokb * 1024 + h * 256;
#pragma unroll
            for (int ii = 0; ii < 8; ++ii) kreg[ii] = *(const u32x4_t*)(kc + (size_t)(krow + 16 * ii) * 1024 + kch * 8);
            vreg = *(const u32x4_t*)(v + (tokb + vm) * 2048 + h * 512 + sl * 32 + ve);
        }
        bf16x8_t qa[8], pa[4];
        {
            const bf16_t* qp = q + (tokb + 16 * w + fr) * 1024 + h * 256 + fq * 8;
#pragma unroll
            for (int ks = 0; ks < 8; ++ks) qa[ks] = *(const bf16x8_t*)(qp + ks * 32);
            const bf16_t* pp = P + (size_t)(bh * 64) * 16384 + (16 * w + fr) * 128 + fq * 8;
#pragma unroll
            for (int ks = 0; ks < 4; ++ks) pa[ks] = *(const bf16x8_t*)(pp + ks * 32);
        }
#pragma unroll 1
        for (int c = 0; c < 64; ++c) {
            const size_t tok0 = tokb + c * 128;
#pragma unroll
            for (int ii = 0; ii < 8; ++ii) *(u32x4_t*)(lds + RT_K + (krow + 16 * ii) * RT_KS + kch * 16) = kreg[ii];
            {
                unsigned char* vp = lds + RT_V + ve * RT_VS + vm * 2;
                *(bf16_t*)(vp + 0 * RT_VS) = (bf16_t)(vreg.x & 0xffff); *(bf16_t*)(vp + 1 * RT_VS) = (bf16_t)(vreg.x >> 16);
                *(bf16_t*)(vp + 2 * RT_VS) = (bf16_t)(vreg.y & 0xffff); *(bf16_t*)(vp + 3 * RT_VS) = (bf16_t)(vreg.y >> 16);
                *(bf16_t*)(vp + 4 * RT_VS) = (bf16_t)(vreg.z & 0xffff); *(bf16_t*)(vp + 5 * RT_VS) = (bf16_t)(vreg.z >> 16);
                *(bf16_t*)(vp + 6 * RT_VS) = (bf16_t)(vreg.w & 0xffff); *(bf16_t*)(vp + 7 * RT_VS) = (bf16_t)(vreg.w >> 16);
            }
            if (c + 1 < 64) {
                const bf16_t* kc = k + (tok0 + 128) * 1024 + h * 256;
#pragma unroll
                for (int ii = 0; ii < 8; ++ii) kreg[ii] = *(const u32x4_t*)(kc + (size_t)(krow + 16 * ii) * 1024 + kch * 8);
                vreg = *(const u32x4_t*)(v + (tok0 + 128 + vm) * 2048 + h * 512 + sl * 32 + ve);
            }
            LDS_BARRIER();
            f32x4_t ao[2] = {(f32x4_t){0.f, 0.f, 0.f, 0.f}, (f32x4_t){0.f, 0.f, 0.f, 0.f}};
            {
                bf16x8_t bu[8];
#pragma unroll
                for (int nt = 0; nt < 2; ++nt) {
#pragma unroll
                    for (int ks = 0; ks < 8; ++ks) bu[ks] = *(const bf16x8_t*)(lds + RT_U + (16 * nt + fr) * RT_KS + ks * 64 + fq * 16);
#pragma unroll
                    for (int ks = 0; ks < 8; ++ks) ao[nt] = __builtin_amdgcn_mfma_f32_16x16x32_bf16(qa[ks], bu[ks], ao[nt], 0, 0, 0);
                }
            }
            bf16x8_t bv[2][4];
#pragma unroll
            for (int nt = 0; nt < 2; ++nt)
#pragma unroll
                for (int ks = 0; ks < 4; ++ks) bv[nt][ks] = *(const bf16x8_t*)(lds + RT_V + (16 * nt + fr) * RT_VS + ks * 64 + fq * 16);
#pragma unroll
            for (int ks = 0; ks < 4; ++ks)
#pragma unroll
                for (int nt = 0; nt < 2; ++nt) ao[nt] = __builtin_amdgcn_mfma_f32_16x16x32_bf16(pa[ks], bv[nt][ks], ao[nt], 0, 0, 0);
            if (c + 1 < 64) {
                const bf16_t* qp = q + (tok0 + 128 + 16 * w + fr) * 1024 + h * 256 + fq * 8;
#pragma unroll
                for (int ks = 0; ks < 8; ++ks) qa[ks] = *(const bf16x8_t*)(qp + ks * 32);
                const bf16_t* pp = P + (size_t)(bh * 64 + c + 1) * 16384 + (16 * w + fr) * 128 + fq * 8;
#pragma unroll
                for (int ks = 0; ks < 4; ++ks) pa[ks] = *(const bf16x8_t*)(pp + ks * 32);
            }
#pragma unroll
            for (int kh = 0; kh < 2; ++kh) {
                s16x4_t tk[2][2][2];
#pragma unroll
                for (int k2 = 0; k2 < 2; ++k2)
#pragma unroll
                    for (int di = 0; di < 2; ++di) {
                        const unsigned char* kp = lds + RT_K + (32 * (2 * kh + k2) + 8 * fq + (fr >> 2)) * RT_KS + (16 * (2 * w + di) + 4 * (fr & 3)) * 2;
                        tk[k2][di][0] = __builtin_amdgcn_ds_read_tr16_b64_v4i16((LAS s16x4_t*)(kp));
                        tk[k2][di][1] = __builtin_amdgcn_ds_read_tr16_b64_v4i16((LAS s16x4_t*)(kp + 4 * RT_KS));
                    }
#pragma unroll
                for (int k2 = 0; k2 < 2; ++k2)
#pragma unroll
                    for (int di = 0; di < 2; ++di) {
                        const bf16x8_t kb = (bf16x8_t){tk[k2][di][0][0], tk[k2][di][0][1], tk[k2][di][0][2], tk[k2][di][0][3], tk[k2][di][1][0], tk[k2][di][1][1], tk[k2][di][1][2], tk[k2][di][1][3]};
#pragma unroll
                        for (int et = 0; et < 2; ++et) accU[et][di] = __builtin_amdgcn_mfma_f32_16x16x32_bf16(bv[et][2 * kh + k2], kb, accU[et][di], 0, 0, 0);
                    }
            }
#pragma unroll
            for (int et = 0; et < 2; ++et)
#pragma unroll
                for (int di = 0; di < 2; ++di) accU[et][di] = accU[et][di] * g128;
            LDS_BARRIER();
            {
                bf16_t* vc = v + (tok0 + 16 * w + 4 * fq) * 2048 + h * 512 + sl * 32 + fr;
#pragma unroll
                for (int nt = 0; nt < 2; ++nt)
#pragma unroll
                    for (int j = 0; j < 4; ++j) vc[(size_t)j * 2048 + 16 * nt] = f2bf(ao[nt][j]);
#pragma unroll
                for (int et = 0; et < 2; ++et)
#pragma unroll
                    for (int di = 0; di < 2; ++di)
#pragma unroll
                        for (int j = 0; j < 4; ++j) *(bf16_t*)(lds + RT_U + (16 * et + 4 * fq + j) * RT_KS + (16 * (2 * w + di) + fr) * 2) = f2bf(accU[et][di][j]);
            }
        }
        __syncthreads();
    }
}
DEV void p_headnorm(bf16_t* ret, const bf16_t* g) {
    const int lane = threadIdx.x & 63;
    for (int w = (blockIdx.x * NTHR + threadIdx.x) >> 6; w < NTOK * 4; w += gridDim.x * (NTHR / 64)) {
        const size_t o = (size_t)w * 512 + lane * 8;
        const u32x4_t rv = *(const u32x4_t*)(ret + o), gv = *(const u32x4_t*)(g + o);
        float x[8], gg[8]; float s = 0.f;
#pragma unroll
        for (int j = 0; j < 4; ++j) { x[2 * j] = __uint_as_float(rv[j] << 16); x[2 * j + 1] = __uint_as_float(rv[j] & 0xffff0000u); gg[2 * j] = __uint_as_float(gv[j] << 16); gg[2 * j + 1] = __uint_as_float(gv[j] & 0xffff0000u); }
#pragma unroll
        for (int j = 0; j < 8; ++j) s += x[j];
#pragma unroll
        for (int m = 1; m < 64; m <<= 1) s += __shfl_xor(s, m);
        const float mu = s * (1.f / 512.f); float q = 0.f;
#pragma unroll
        for (int j = 0; j < 8; ++j) { x[j] -= mu; q += x[j] * x[j]; }
#pragma unroll
        for (int m = 1; m < 64; m <<= 1) q += __shfl_xor(q, m);
        const float rstd = rsqrtf(q * (1.f / 512.f) + LN_EPS);
        u32x4_t ov;
#pragma unroll
        for (int j = 0; j < 4; ++j) ov[j] = pg8::cvt_pk_bf16(x[2 * j] * rstd * gg[2 * j], x[2 * j + 1] * rstd * gg[2 * j + 1]);
        *(u32x4_t*)(ret + o) = ov;
    }
}

typedef float f32x4v __attribute__((ext_vector_type(4)));
DEV void p_ln1_route(float* lds, const bf16_t* y, bf16_t* x1b, const float* g1, const float* b1, const float* wg, const float* bg,
                     const float* we, const float* be, int2* route_e, float2* route_w, int* cnt, int* list, const float* sb) {
    const int wv = threadIdx.x >> 6, lane = threadIdx.x & 63, r16 = lane & 15, kq = lane >> 4;
    float* Wp = lds;
    float* Sc = lds + 1024 * 36;
    float* Bc = Sc + 48;
    int* lcnt = (int*)(Bc + 48);
    int* rowE = lcnt + 32;
    int* rowP = rowE + 256;
    for (int i = threadIdx.x; i < 1024 * 9; i += NTHR) { const int k = i / 9, c4 = i - k * 9; const float gk = g1[k];
        float4 w = (c4 < 8) ? *(const float4*)(we + (size_t)k * 32 + c4 * 4) : *(const float4*)(wg + (size_t)k * 4);
        w.x *= gk; w.y *= gk; w.z *= gk; w.w *= gk; *(float4*)(Wp + k * 36 + c4 * 4) = w; }
    if (threadIdx.x < 32) lcnt[threadIdx.x] = 0;
    __syncthreads();
    if (threadIdx.x < 96) Sc[threadIdx.x] = sb[threadIdx.x];
    __syncthreads();
    constexpr int rows_per_wg = 128;
    for (int blk = blockIdx.x; blk < NTOK / rows_per_wg; blk += gridDim.x) {
    { const int tile = wv;
        const int lrow0 = tile * 16, row0 = blk * rows_per_wg + lrow0;
        const bf16_t* yp = y + (size_t)(row0 + r16) * 1024 + 4 * kq;
        f32x4v acc[3] = {(f32x4v){0.f, 0.f, 0.f, 0.f}, (f32x4v){0.f, 0.f, 0.f, 0.f}, (f32x4v){0.f, 0.f, 0.f, 0.f}};
        float s1 = 0.f, s2 = 0.f; const float m2 = (r16 < 4) ? 1.f : 0.f;
#pragma unroll 8
        for (int t = 0; t < 64; ++t) {
            const uint2 yr = *(const uint2*)(yp + 16 * t); const float4 yv = make_float4(__uint_as_float(yr.x << 16), __uint_as_float(yr.x & 0xffff0000u), __uint_as_float(yr.y << 16), __uint_as_float(yr.y & 0xffff0000u));
            s1 += (yv.x + yv.y) + (yv.z + yv.w); s2 += (yv.x * yv.x + yv.y * yv.y) + (yv.z * yv.z + yv.w * yv.w);
            const float* wrow = Wp + (16 * t + 4 * kq) * 36 + r16;
            const float ye[4] = {yv.x, yv.y, yv.z, yv.w};
#pragma unroll
            for (int j = 0; j < 4; ++j)
#pragma unroll
                for (int nt = 0; nt < 3; ++nt) { const float wv = (nt < 2) ? wrow[j * 36 + 16 * nt] : wrow[j * 36 + 32 - (r16 & 12)] * m2;
                    acc[nt] = __builtin_amdgcn_mfma_f32_16x16x4f32(ye[j], wv, acc[nt], 0, 0, 0); }
        }
        s1 += __shfl_xor(s1, 16); s1 += __shfl_xor(s1, 32); s2 += __shfl_xor(s2, 16); s2 += __shfl_xor(s2, 32);
        const float mu = s1 * (1.f / 1024.f), rstd = rsqrtf(fmaxf(s2 * (1.f / 1024.f) - mu * mu, 0.f) + LN_EPS);
#pragma unroll 8
        for (int t = 0; t < 64; ++t) {
            const uint2 yr = *(const uint2*)(yp + 16 * t); const float4 yv = make_float4(__uint_as_float(yr.x << 16), __uint_as_float(yr.x & 0xffff0000u), __uint_as_float(yr.y << 16), __uint_as_float(yr.y & 0xffff0000u));
            const float4 gv = *(const float4*)(g1 + 16 * t + 4 * kq), bv = *(const float4*)(b1 + 16 * t + 4 * kq);
            const float4 o = make_float4((yv.x - mu) * rstd * gv.x + bv.x, (yv.y - mu) * rstd * gv.y + bv.y, (yv.z - mu) * rstd * gv.z + bv.z, (yv.w - mu) * rstd * gv.w + bv.w);
            uint2 ob; ob.x = pg8::cvt_pk_bf16(o.x, o.y); ob.y = pg8::cvt_pk_bf16(o.z, o.w);
            *(uint2*)(x1b + (size_t)(row0 + r16) * 1024 + 16 * t + 4 * kq) = ob;
        }
#pragma unroll
        for (int j = 0; j < 4; ++j) {
            const int rl = 4 * kq + j;
            const float mur = __shfl(mu, rl), rsr = __shfl(rstd, rl);
            float lg[3];
#pragma unroll
            for (int nt = 0; nt < 3; ++nt) lg[nt] = rsr * (acc[nt][j] - mur * Sc[16 * nt + r16]) + Bc[16 * nt + r16];
            const int gb = 16 * kq;
            const float g0 = __shfl(lg[2], gb + 0), g1v = __shfl(lg[2], gb + 1), g2 = __shfl(lg[2], gb + 2), g3 = __shfl(lg[2], gb + 3);
            int gi = 0; float gm = g0; if (g1v > gm) { gm = g1v; gi = 1; } if (g2 > gm) { gm = g2; gi = 2; } if (g3 > gm) { gm = g3; gi = 3; }
            const float gw = 1.f / (expf(g0 - gm) + expf(g1v - gm) + expf(g2 - gm) + expf(g3 - gm));
            const float lsel = (gi & 2) ? lg[1] : lg[0];
            float ev[8];
#pragma unroll
            for (int t = 0; t < 8; ++t) ev[t] = __shfl(lsel, gb + (gi & 1) * 8 + t);
            int i1 = 0; float v1 = ev[0];
#pragma unroll
            for (int t = 1; t < 8; ++t) if (ev[t] > v1) { v1 = ev[t]; i1 = t; }
            int i2 = -1; float v2 = -INFINITY;
#pragma unroll
            for (int t = 0; t < 8; ++t) if (t != i1 && ev[t] > v2) { v2 = ev[t]; i2 = t; }
            const float w1 = 1.f / (1.f + expf(v2 - v1)), w2 = 1.f - w1;
            if (r16 == 0) {
                const int lr = lrow0 + rl, r = row0 + rl, e1 = gi * 8 + i1, e2 = gi * 8 + i2;
                route_e[r] = make_int2(e1, e2); route_w[r] = make_float2(gw * w1, gw * w2);
                rowE[2 * lr] = e1; rowP[2 * lr] = atomicAdd(&lcnt[e1], 1);
                rowE[2 * lr + 1] = e2; rowP[2 * lr + 1] = atomicAdd(&lcnt[e2], 1);
            }
        }
    }
    __syncthreads();
    if (threadIdx.x < 32) lcnt[threadIdx.x] = atomicAdd(&cnt[threadIdx.x * 64], lcnt[threadIdx.x]);
    __syncthreads();
    for (int i = threadIdx.x; i < 2 * rows_per_wg; i += NTHR) { const int e = rowE[i]; list[e * 32768 + lcnt[e] + rowP[i]] = (blk * rows_per_wg + (i >> 1)) * 2 + (i & 1); }
    __syncthreads();
    if (threadIdx.x < 32) lcnt[threadIdx.x] = 0;
    __syncthreads();
    }
}

DEV void p_final(float* out, const bf16_t* x1b, const bf16_t* ys, const float* g2, const float* b2) {
    const int lane = threadIdx.x & 63;
    for (int r = (blockIdx.x * NTHR + threadIdx.x) >> 6; r < NTOK; r += gridDim.x * (NTHR / 64)) {
        float x[16]; float s = 0.f;
#pragma unroll
        for (int j = 0; j < 4; ++j) { const int col = j * 256 + lane * 4; const ushort4 tb = *(const ushort4*)(x1b + (size_t)r * 1024 + col); const float4 t = make_float4(bf2f(tb.x), bf2f(tb.y), bf2f(tb.z), bf2f(tb.w));
            const ushort4 a = *(const ushort4*)(ys + (size_t)(2 * r) * 1024 + col), b = *(const ushort4*)(ys + (size_t)(2 * r + 1) * 1024 + col);
            x[4 * j] = ALPHA * t.x + bf2f(a.x) + bf2f(b.x); x[4 * j + 1] = ALPHA * t.y + bf2f(a.y) + bf2f(b.y); x[4 * j + 2] = ALPHA * t.z + bf2f(a.z) + bf2f(b.z); x[4 * j + 3] = ALPHA * t.w + bf2f(a.w) + bf2f(b.w);
            s += (x[4 * j] + x[4 * j + 1]) + (x[4 * j + 2] + x[4 * j + 3]); }
#pragma unroll
        for (int m = 1; m < 64; m <<= 1) s += __shfl_xor(s, m);
        const float mu = s * (1.f / 1024.f); float q = 0.f;
#pragma unroll
        for (int j = 0; j < 16; ++j) { x[j] -= mu; q += x[j] * x[j]; }
#pragma unroll
        for (int m = 1; m < 64; m <<= 1) q += __shfl_xor(q, m);
        const float rstd = rsqrtf(q * (1.f / 1024.f) + LN_EPS);
#pragma unroll
        for (int j = 0; j < 4; ++j) { const int col = j * 256 + lane * 4; const float4 gg = *(const float4*)(g2 + col), bb = *(const float4*)(b2 + col);
            *(float4*)(out + (size_t)r * 1024 + col) = make_float4(x[4 * j] * rstd * gg.x + bb.x, x[4 * j + 1] * rstd * gg.y + bb.y, x[4 * j + 2] * rstd * gg.z + bb.z, x[4 * j + 3] * rstd * gg.w + bb.w); }
    }
}

struct Args { const float* in[24]; float* out; unsigned char* ws; };
__global__ void __launch_bounds__(NTHR, 2) mega_fwd(Args a) {
    extern __shared__ __attribute__((aligned(16))) unsigned char lds_raw[];
    float* ldsf = (float*)lds_raw;
    PG8_LAS unsigned char* ldsl = (PG8_LAS unsigned char*)lds_raw;
    volatile LAS unsigned* MISC = (volatile LAS unsigned*)((LAS unsigned char*)lds_raw + LDS_MISC);
    for (int u = threadIdx.x; u < 128; u += NTHR) MISC[u] = 0u;
    __syncthreads();
    unsigned char* ws = a.ws;
    XcdBarrier bar = xcd_barrier_post((unsigned*)(ws + WS_CTL) + CW_BAR, MISC + 8);
#define GRID_BAR() xcd_barrier(bar)
    const float* x = a.in[0]; const float* w_in = a.in[1]; const float* b_merge = a.in[2];
    const float* conv_w = a.in[3]; const float* conv_b = a.in[4];
    const float* w_rg_r = a.in[5]; const float* b_rg_r = a.in[6]; const float* w_rg_i = a.in[7]; const float* b_rg_i = a.in[8];
    const float* lam = a.in[9]; const float* w_ret_o = a.in[10]; const float* w_lru_o = a.in[11]; const float* w_out = a.in[12];
    const float* ln1_g = a.in[13]; const float* ln1_b = a.in[14]; const float* w_group = a.in[15]; const float* b_group = a.in[16];
    const float* w_er = a.in[17]; const float* b_er = a.in[18]; const float* w_eg = a.in[19]; const float* w_eu = a.in[20];
    const float* w_ed = a.in[21]; const float* ln2_g = a.in[22]; const float* ln2_b = a.in[23];
    float* out = a.out;
    int* cnt = (int*)(ws + WS_CTL); float2* rope = (float2*)(ws + WS_ROPE); int2* route_e = (int2*)(ws + WS_ROUTE_E); float2* route_w = (float2*)(ws + WS_ROUTE_W); int* list = (int*)(ws + WS_LIST);
    bf16_t* xb = (bf16_t*)(ws + WS_XB); bf16_t* gl = (bf16_t*)(ws + WS_GL); bf16_t* ulru = (bf16_t*)(ws + WS_ULRU); bf16_t* uconv = (bf16_t*)(ws + WS_UCONV);
    bf16_t* epsb = (bf16_t*)(ws + WS_EPS); bf16_t* inp = (bf16_t*)out;
    bf16_t* q = (bf16_t*)(ws + WS_Q); bf16_t* k = (bf16_t*)(ws + WS_K); bf16_t* v = (bf16_t*)(ws + WS_V); bf16_t* gbuf = (bf16_t*)out;
    bf16_t* P = (bf16_t*)(ws + WS_P); bf16_t* gates = (bf16_t*)(ws + WS_GATES); bf16_t* m1 = (bf16_t*)out; bf16_t* merged = xb;
    bf16_t* w_in_t = (bf16_t*)(ws + WS_WIN_T); bf16_t* w_ro_t = (bf16_t*)(ws + WS_WRO_T); bf16_t* w_lo_t = (bf16_t*)(ws + WS_WLO_T); bf16_t* w_out_t = (bf16_t*)(ws + WS_WOUT_T);
    bf16_t* wrg_t = (bf16_t*)(ws + WS_WRG_T); float* segA = (float*)(ws + WS_SEGA); float* segH = (float*)(ws + WS_SEGH); float* carry = (float*)(ws + WS_CARRY);
    float* rsb = (float*)(ws + WS_RSB);
    bf16_t* wgu_t = (bf16_t*)(ws + WS_WGU_T); bf16_t* wd_t = (bf16_t*)(ws + WS_WD_T);
    bf16_t* x1b = gl; bf16_t* hbuf = (bf16_t*)(ws + WS_H); bf16_t* ys = (bf16_t*)(ws + WS_YSLOT);

    p_router_consts(ldsf, ln1_g, ln1_b, w_group, b_group, w_er, b_er, rsb); p_cvt_x(x, xb); p_rope_table(rope); p_weights(ldsf, w_in, w_ret_o, w_lru_o, w_out, w_rg_r, w_rg_i, w_in_t, w_ro_t, w_lo_t, w_out_t, wrg_t);
    GRID_BAR();
    { pg8::Gemm g{xb, w_in_t + (size_t)C_U * 1024, NTOK, 3072, 1024}; pg8::StaticOrder S; S.init(NTOK, 3072, (int)gridDim.x, (int)blockIdx.x);
      pg8::gemm_phase<pg8::EpiLruIn, pg8::StaticOrder, true, true>(ldsl, g, S, pg8::EpiLruIn{ulru, gl}); }
    GRID_BAR();
    p_lru_compute(lds_raw, ulru, conv_w, conv_b, wrg_t, b_rg_r, b_rg_i, lam, uconv, epsb, segA, segH);
    GRID_BAR();
    p_lru_carry(ldsf, segA, segH, carry);
    GRID_BAR();
    p_lru_scan(uconv, epsb, gl, carry);
    GRID_BAR();
    { pg8::Gemm g{xb, w_in_t, NTOK, 6144, 1024}; pg8::StaticOrder S; S.init(NTOK, 6144, (int)gridDim.x, (int)blockIdx.x);
      pg8::gemm_phase<pg8::EpiRetIn, pg8::StaticOrder, true, true>(ldsl, g, S, pg8::EpiRetIn{q, k, v, gbuf, (const float*)rope}); }
    GRID_BAR();
    p_scores(lds_raw, q, k, P);
    GRID_BAR();
    p_ret_mfma(lds_raw, q, k, v, P);
    GRID_BAR();
    p_headnorm(v, gbuf);
    { pg8::Gemm g{xb, w_in_t + (size_t)C_GATE * 1024, NTOK, 2048, 1024}; pg8::StaticOrder S; S.init(NTOK, 2048, (int)gridDim.x, (int)blockIdx.x);
      pg8::gemm_phase<pg8::EpiGates, pg8::StaticOrder, true, true>(ldsl, g, S, pg8::EpiGates{b_merge, gates}); }
    GRID_BAR();
    { pg8::Gemm g{v, w_ro_t, NTOK, 1024, 2048}; pg8::StaticOrder S; S.init(NTOK, 1024, (int)gridDim.x, (int)blockIdx.x);
      pg8::gemm_phase<pg8::EpiMerge<0>, pg8::StaticOrder, true, true>(ldsl, g, S, pg8::EpiMerge<0>{gates, nullptr, m1}); }
    GRID_BAR();
    { pg8::Gemm g{gl, w_lo_t, NTOK, 1024, 1536}; pg8::StaticOrder S; S.init(NTOK, 1024, (int)gridDim.x, (int)blockIdx.x);
      pg8::gemm_phase<pg8::EpiMerge<1>, pg8::StaticOrder, true, true>(ldsl, g, S, pg8::EpiMerge<1>{gates, m1, merged}); }
    GRID_BAR();
    { pg8::Gemm g{merged, w_out_t, NTOK, 1024, 1024}; pg8::StaticOrder S; S.init(NTOK, 1024, (int)gridDim.x, (int)blockIdx.x);
      pg8::gemm_phase<pg8::EpiOut, pg8::StaticOrder, true, true>(ldsl, g, S, pg8::EpiOut{x, (bf16_t*)out, ALPHA}); }
    GRID_BAR();
    p_ln1_route(ldsf, (const bf16_t*)out, x1b, ln1_g, ln1_b, w_group, b_group, w_er, b_er, route_e, route_w, cnt, list, rsb);
    p_expert_weights(ldsf, w_eg, w_eu, w_ed, wgu_t, wd_t);
    GRID_BAR();
    {
        PG8_LAS pg8::MoeTab* tab = (PG8_LAS pg8::MoeTab*)(ldsl + LDS_TAB);
        pg8::moe_build_tab(tab, cnt);
        const int T = tab->tileStart[32];
        { pg8::Gemm g{x1b, wgu_t, T * 256, 32 * 1024, 1024}; pg8::MoeOrder<true> S{T * 4, (int)gridDim.x, (int)blockIdx.x, tab, list};
          pg8::gemm_phase<pg8::EpiSwiGLU, pg8::MoeOrder<true>, true, true>(ldsl, g, S, pg8::EpiSwiGLU{hbuf}); }
        GRID_BAR();
        { pg8::Gemm g{hbuf, wd_t, T * 256, 32 * 1024, 512}; pg8::MoeOrder<false> S{T * 4, (int)gridDim.x, (int)blockIdx.x, tab, list};
          pg8::gemm_phase<pg8::EpiMoeOut, pg8::MoeOrder<false>, true, true>(ldsl, g, S, pg8::EpiMoeOut{tab, list, (const float*)route_w, ys}); }
    }
    GRID_BAR();
    p_final(out, x1b, ys, ln2_g, ln2_b);
}

extern "C" void kernel_launch(void* const* d_in, const int* in_sizes, int n_in, void* d_out, int out_size, void* d_ws, size_t ws_size, hipStream_t stream) {
    static int grid = 0;
    if (grid == 0) {
        if (n_in != 24 || in_sizes[0] != NTOK * DM || out_size != NTOK * DM || ws_size < WS_END) {
            fprintf(stderr, "kernel_launch: unexpected shapes (n_in %d, in0 %d, out %d, ws %zu)\n", n_in, n_in > 0 ? in_sizes[0] : -1, out_size, ws_size); grid = -1; return; }
        int dev = 0, cus = 0, per_cu = 0;
        if (hipGetDevice(&dev) != hipSuccess || hipDeviceGetAttribute(&cus, hipDeviceAttributeMultiprocessorCount, dev) != hipSuccess) { fprintf(stderr, "kernel_launch: device query failed\n"); grid = -1; return; }
        if (hipFuncSetAttribute((const void*)mega_fwd, hipFuncAttributeMaxDynamicSharedMemorySize, LDS_BYTES) != hipSuccess) { fprintf(stderr, "kernel_launch: hipFuncSetAttribute failed\n"); grid = -1; return; }
        if (hipOccupancyMaxActiveBlocksPerMultiprocessor(&per_cu, (const void*)mega_fwd, NTHR, LDS_BYTES) != hipSuccess || per_cu < 1) {
            fprintf(stderr, "kernel_launch: occupancy query reports %d workgroups per CU\n", per_cu); (void)hipGetLastError(); grid = -1; return; }
        grid = cus;
    }
    if (grid < 0) return;
    if (hipMemsetAsync((char*)d_ws + WS_CTL, 0, CTL_ZERO_BYTES, stream) != hipSuccess) { fprintf(stderr, "kernel_launch: memset failed\n"); return; }
    Args a{};
    for (int i = 0; i < 24; ++i) a.in[i] = (const float*)d_in[i];
    a.out = (float*)d_out; a.ws = (unsigned char*)d_ws;
    hipLaunchKernelGGL(mega_fwd, dim3(grid), dim3(NTHR), LDS_BYTES, stream, a);
    const hipError_t le = hipPeekAtLastError();
    if (le != hipSuccess) fprintf(stderr, "kernel_launch: launch failed: %s\n", hipGetErrorName(le));
}
```

```cpp
#include <hip/hip_runtime.h>
#include <cstdio>
#include <cstdint>

typedef unsigned short bf16_t;
#define DEV __device__ __forceinline__
#define LAS __attribute__((address_space(3)))

DEV float bf2f(bf16_t h) { return __uint_as_float(((unsigned)h) << 16); }
DEV bf16_t f2bf(float f) { unsigned u = __float_as_uint(f); return (bf16_t)((u + 0x7fffu + ((u >> 16) & 1u)) >> 16); }

constexpr int NTHR = 512;
constexpr int NTOK = 32768, DM = 1024, SEQ = 8192;
constexpr int WIN_N = 11264;
constexpr int C_Q = 0, C_K = 1024, C_V = 2048, C_G = 4096, C_U = 6144, C_GL = 7680, C_GATE = 9216;
constexpr float ALPHA = 1.189207115002721f;
constexpr float LN_EPS = 1e-5f;
constexpr size_t MiB = 1u << 20;
constexpr size_t WS_CTL = 0;
constexpr size_t CTL_ZERO_BYTES = 1 * MiB;
constexpr int CW_BAR = 4096;
constexpr size_t WS_ROPE = 1 * MiB;
constexpr size_t WS_ROUTE_E = 9 * MiB;
constexpr size_t WS_ROUTE_W = 9 * MiB + 512 * 1024;
constexpr size_t WS_LIST = 10 * MiB;
constexpr size_t WS_WRG_T = 14 * MiB;
constexpr size_t WS_RSB = 15 * MiB + 512 * 1024;
constexpr size_t WS_SEGA = 16 * MiB;
constexpr size_t WS_SEGH = 18 * MiB;
constexpr size_t WS_CARRY = 20 * MiB;
constexpr size_t WS_XB = 32 * MiB;
constexpr size_t WS_GL = 96 * MiB;
constexpr size_t WS_ULRU = 192 * MiB;
constexpr size_t WS_Q = 192 * MiB;
constexpr size_t WS_K = 256 * MiB;
constexpr size_t WS_GATES = 192 * MiB;
constexpr size_t WS_UCONV = 288 * MiB;
constexpr size_t WS_P = 320 * MiB;
constexpr size_t WS_V = 352 * MiB;
constexpr size_t WS_EPS = 384 * MiB;
constexpr size_t WS_H = 192 * MiB;
constexpr size_t WS_YSLOT = 264 * MiB;
constexpr size_t WS_WGU_T = 352 * MiB;
constexpr size_t WS_WD_T = 416 * MiB;
constexpr int LDS_TAB = 131072;
constexpr size_t WS_WIN_T = 480 * MiB;
constexpr size_t WS_WRO_T = 502 * MiB;
constexpr size_t WS_WLO_T = 506 * MiB;
constexpr size_t WS_WOUT_T = 509 * MiB;
constexpr size_t WS_END = 512 * MiB;
constexpr int LDS_BYTES = 163840;
constexpr int LDS_MISC = 163840 - 512;

#define XB_TMO      128
#define XB_XCNT(j)  (256  + 64 * (j))
#define XB_XSUB(j)  (1280 + 64 * (j))
#define XB_XGEN(j)  (2304 + 64 * (j))
#define XB_TOP      3328
#define XB_TOPGEN   3392
#define XCD_BAR_WORDS 3456
#define XB_SPIN_CAP (1u << 22)
DEV unsigned xb_ld(unsigned* p)              { return __hip_atomic_load(p, __ATOMIC_RELAXED, __HIP_MEMORY_SCOPE_AGENT); }
DEV unsigned xb_add(unsigned* p, unsigned v) { return __hip_atomic_fetch_add(p, v, __ATOMIC_RELAXED, __HIP_MEMORY_SCOPE_AGENT); }
DEV unsigned xb_xcc_id() { return (unsigned)__builtin_amdgcn_s_getreg((3 << 11) | 20) & 0xFu; }
#define XB_SPIN(cond, bar) do { unsigned _sp = 0; while (cond) { __builtin_amdgcn_s_sleep(1); \
    if ((++_sp & 255u) == 0u) { if (xb_ld(&(bar)[XB_TMO])) break; if (_sp > XB_SPIN_CAP) { atomicAdd(&(bar)[XB_TMO], 1u); break; } } } } while (0)
struct XcdBarrier { unsigned* bar; unsigned x; volatile LAS unsigned* st; };
DEV XcdBarrier xcd_barrier_post(unsigned* bar, volatile LAS unsigned* st) {
    XcdBarrier b; b.bar = bar; b.x = xb_xcc_id(); b.st = st;
    if (threadIdx.x == 0) (void)xb_add(&bar[XB_XCNT(b.x)], 1u);
    return b;
}
DEV void xcd_barrier_complete(unsigned* bar, unsigned x, unsigned& nloc, unsigned& nx) {
    const unsigned G = gridDim.x * gridDim.y * gridDim.z;
    unsigned sum, cnt, mine, sp = 0u;
    for (;;) {
        sum = 0u; cnt = 0u; mine = 0u;
#pragma unroll
        for (unsigned j = 0; j < 16; ++j) { const unsigned c = xb_ld(&bar[XB_XCNT(j)]); sum += c; cnt += (c > 0u) ? 1u : 0u; mine = (j == x) ? c : mine; }
        if (sum == G) break;
        __builtin_amdgcn_s_sleep(1);
        if ((++sp & 255u) == 0u) { if (xb_ld(&bar[XB_TMO])) break; if (sp > XB_SPIN_CAP) { atomicAdd(&bar[XB_TMO], 1u); break; } }
    }
    nloc = mine > 0u ? mine : 1u; nx = cnt > 0u ? cnt : 1u;
}
DEV void xcd_barrier(const XcdBarrier& b) {
    asm volatile("s_waitcnt vmcnt(0)" ::: "memory");
    __syncthreads();
    if (threadIdx.x == 0) {
        unsigned* bar = b.bar;
        __builtin_amdgcn_s_waitcnt(0);
        unsigned nloc = b.st[0], nx = b.st[1];
        if (nloc == 0u) { xcd_barrier_complete(bar, b.x, nloc, nx); b.st[0] = nloc; b.st[1] = nx; }
        const unsigned old = xb_add(&bar[XB_XSUB(b.x)], 1u);
        const unsigned gen = old / nloc;
        if (old + 1u == (gen + 1u) * nloc) {
            __builtin_amdgcn_fence(__ATOMIC_RELEASE, "agent");
            asm volatile("s_waitcnt vmcnt(0)" ::: "memory");
            const unsigned og = xb_add(&bar[XB_TOP], 1u);
            const unsigned tg = og / nx;
            if (og + 1u == (tg + 1u) * nx) xb_add(&bar[XB_TOPGEN], 1u);
            else XB_SPIN(xb_ld(&bar[XB_TOPGEN]) == tg, bar);
            __builtin_amdgcn_fence(__ATOMIC_ACQUIRE, "agent");
            xb_add(&bar[XB_XGEN(b.x)], 1u);
            asm volatile("s_waitcnt vmcnt(0)" ::: "memory");
        } else {
            XB_SPIN(xb_ld(&bar[XB_XGEN(b.x)]) == gen, bar);
            __builtin_amdgcn_fence(__ATOMIC_ACQUIRE, "agent");
            asm volatile("s_waitcnt vmcnt(0)" ::: "memory");
        }
    }
    __syncthreads();
}

namespace pg8 {
#define PG8_LAS __attribute__((address_space(3)))
typedef unsigned short bf16_t;
typedef short bf16x8 __attribute__((ext_vector_type(8)));
typedef float f32x4 __attribute__((ext_vector_type(4)));
typedef unsigned u32x4 __attribute__((ext_vector_type(4)));
constexpr int BM = 256, BK = 64, HALF = 128, HTB = HALF * BK * 2  , STAGE_BYTES = 8 * HTB, NXCD = 8, WGM = 8;

__host__ __device__ __forceinline__ int lds_byte(int r, int c) { const int st = (r >> 4) * 2 + (c >> 5), rr = r & 15, cc = c & 31, ob = rr * 64 + cc * 2; return st * 1024 + (ob ^ (((ob >> 9) & 1) << 5)); }
__host__ __device__ __forceinline__ void stage_rc(int b, int& R, int& C) { const int st = b / 1024, sb = b % 1024, swz = sb ^ (((sb >> 9) & 1) << 5); R = (st >> 1) * 16 + swz / 64; C = (st & 1) * 32 + (swz % 64) / 2; }
__host__ __device__ __forceinline__ int perm32(int rho) { const int n = rho >> 4, i = rho & 15; return 8 * (i >> 2) + 4 * n + (i & 3); }

struct Unit { int pm, pn; };
struct Gemm { const bf16_t* A; const bf16_t* Bt; int M, N, K; };

struct StaticOrder {
    int nM, nN, nwg, G, c;
    __host__ __device__ void init(int M, int N, int G_, int c_) { nM = M / BM; nN = N / BM; nwg = nM * nN; G = G_; c = c_; }
    __host__ __device__ bool next(int i, Unit& u) const {
        const long L = (long)i * G + c; if (L >= nwg) return false;
        int wgid = (int)L; { const int q = nwg / NXCD, r = nwg % NXCD, xcd = wgid % NXCD, off = wgid / NXCD; wgid = (xcd < r ? xcd * (q + 1) : r * (q + 1) + (xcd - r) * q) + off; }
        const int nig = WGM * nN, gid = wgid / nig, fm = gid * WGM, gsz = (nM - fm) < WGM ? (nM - fm) : WGM;
        u.pm = fm + ((wgid % nig) % gsz); u.pn = (wgid % nig) / gsz; return true;
    }
    __device__ __forceinline__ void a_ready(const Unit&) const {}
    __device__ __forceinline__ void done(const Unit&) const {}
    __device__ __forceinline__ const char* a_base(const Gemm& g, const Unit& u) const { return (const char*)g.A + (size_t)u.pm * (size_t)(BM * g.K * 2); }
    __device__ __forceinline__ void a_off(const Gemm& g, const Unit&, const int (&R)[2], const int (&C)[2], unsigned (&v)[2][2]) const {
        _Pragma("unroll") for (int hh = 0; hh < 2; ++hh) _Pragma("unroll") for (int i = 0; i < 2; ++i) v[hh][i] = (unsigned)((hh * HALF + R[i]) * g.K + C[i]) * 2u; }
};
typedef __bf16 bf16x2_t __attribute__((ext_vector_type(2)));
typedef float f32x2_t __attribute__((ext_vector_type(2)));
__device__ __forceinline__ unsigned cvt_pk_bf16(float lo, float hi) { f32x2_t v = {lo, hi}; return __builtin_bit_cast(unsigned, __builtin_convertvector(v, bf16x2_t)); }
template <class Epi, class Sched, bool ALIGN_EPI = false, bool SP2 = false>
__device__ __forceinline__ void gemm_phase(PG8_LAS unsigned char* lds, const Gemm g, const Sched& S, const Epi& E) {
    int tid_ = threadIdx.x; asm volatile("" : "+v"(tid_));
    const int tid = tid_, wid = __builtin_amdgcn_readfirstlane(tid >> 6), lane = tid & 63, wr = wid >> 2, wc = wid & 3, fr = lane & 15, fq = lane >> 4;
    const int K = g.K, nt = K / BK;
    unsigned voffB[2], vA[2][2], vN[2][2]; int sR[2], sC[2];
#pragma unroll
    for (int i = 0; i < 2; ++i) { int R, C; stage_rc(tid * 16 + i * 8192, R, C); const int Rb = Epi::PERM ? ((R & ~31) + perm32(R & 31)) : R;
        sR[i] = R; sC[i] = C; voffB[i] = (unsigned)(Rb * K + C) * 2u; }
    const size_t kstep = (size_t)(BK * 2);
    const size_t hstep = (size_t)HALF * K * 2;
    const size_t tstep = 2 * hstep;
    const unsigned ldsw = (unsigned)wid * 1024u;
    const int aoff = lds_byte(wr * 64 + fr, fq * 8), boff = lds_byte(wc * 32 + fr, fq * 8);
#define PG8_SA(b, h) (((b) * 2 + (h)) * HTB)
#define PG8_SB(b, h) ((4 + (b) * 2 + (h)) * HTB)
#define PG8_STAGE(bufoff, gbase, voff) do { _Pragma("unroll") for (int _i = 0; _i < 2; ++_i) \
        __builtin_amdgcn_global_load_lds((const unsigned*)((const char*)(gbase) + (voff)[_i]), (PG8_LAS unsigned*)(lds + (bufoff) + ldsw + _i * 8192), 16, 0, 0); } while (0)
#define PG8_LDA(dst, b, h) do { _Pragma("unroll") for (int m = 0; m < 4; ++m) _Pragma("unroll") for (int k = 0; k < 2; ++k) dst[m][k] = *(const PG8_LAS bf16x8*)(lds + PG8_SA(b, h) + aoff + m * 2048 + k * 1024); } while (0)
#define PG8_LDB(dst, b, h) do { _Pragma("unroll") for (int n = 0; n < 2; ++n) _Pragma("unroll") for (int k = 0; k < 2; ++k) dst[n][k] = *(const PG8_LAS bf16x8*)(lds + PG8_SB(b, h) + boff + n * 2048 + k * 1024); } while (0)
#define PG8_MMA(ai, bj, At, Bt) do { __builtin_amdgcn_s_setprio(1); _Pragma("unroll") for (int m = 0; m < 4; ++m) _Pragma("unroll") for (int n = 0; n < 2; ++n) _Pragma("unroll") for (int k = 0; k < 2; ++k) \
        acc[ai][bj][m][n] = __builtin_amdgcn_mfma_f32_16x16x32_bf16(Bt[n][k], At[m][k], acc[ai][bj][m][n], 0, 0, 0); __builtin_amdgcn_s_setprio(0); } while (0)
#define PG8_WAIT_V(n) asm volatile("s_waitcnt vmcnt(" #n ")" ::: "memory")
#define PG8_WAIT_L(n) asm volatile("s_waitcnt lgkmcnt(" #n ")" ::: "memory")
#define PG8_BAR __builtin_amdgcn_s_barrier()
#define PG8_SCHED __builtin_amdgcn_sched_barrier(0)
    Unit cur, nxt; int ui = 0;
    if (!S.next(0, cur)) return;
    f32x4 acc[2][2][4][2];
#pragma unroll
    for (int a = 0; a < 2; ++a)
#pragma unroll
        for (int b = 0; b < 2; ++b)
#pragma unroll
            for (int m = 0; m < 4; ++m)
#pragma unroll
                for (int n = 0; n < 2; ++n) acc[a][b][m][n] = (f32x4){0.f, 0.f, 0.f, 0.f};
    bf16x8 At[4][2], B0[2][2], B1[2][2];
    const char* cA = S.a_base(g, cur); const char* cB = (const char*)g.Bt + (size_t)cur.pn * tstep;
    S.a_ready(cur); S.a_off(g, cur, sR, sC, vA);
    if constexpr (SP2) {
        PG8_STAGE(PG8_SB(0, 0), cB, voffB); PG8_STAGE(PG8_SB(0, 1), cB + hstep, voffB); PG8_STAGE(PG8_SA(0, 0), cA, vA[0]); PG8_STAGE(PG8_SA(0, 1), cA, vA[1]);
        if (wr == 1) PG8_BAR;
        PG8_WAIT_V(2); PG8_BAR;
        PG8_STAGE(PG8_SB(1, 0), cB + kstep, voffB); PG8_STAGE(PG8_SA(1, 0), cA + kstep, vA[0]); PG8_STAGE(PG8_SB(1, 1), cB + hstep + kstep, voffB);
        PG8_WAIT_V(6); PG8_BAR;
    } else { static_assert(SP2, "only the SP2 K-loop is kept in this file"); }
    for (;;) {
        const bool has_next = S.next(ui + 1, nxt);
        const char* nA = has_next ? S.a_base(g, nxt) : cA; const char* nB = has_next ? (const char*)g.Bt + (size_t)nxt.pn * tstep : cB;
        if (has_next) S.a_off(g, nxt, sR, sC, vN); else { vN[0][0] = vA[0][0]; vN[0][1] = vA[0][1]; vN[1][0] = vA[1][0]; vN[1][1] = vA[1][1]; }
        for (int t = 0; t < nt; t += 2) {
            const bool last = (t == nt - 2);
            const char* a1 = cA + (size_t)(t + 1) * kstep;
            const char* a2 = last ? nA : cA + (size_t)(t + 2) * kstep; const char* b2 = last ? nB : cB + (size_t)(t + 2) * kstep;
            const char* a3 = a2 + kstep; const char* b3 = b2 + kstep;
            unsigned v2[2][2]; v2[0][0] = last ? vN[0][0] : vA[0][0]; v2[0][1] = last ? vN[0][1] : vA[0][1]; v2[1][0] = last ? vN[1][0] : vA[1][0]; v2[1][1] = last ? vN[1][1] : vA[1][1];
            if (last && has_next) S.a_ready(nxt);
            if constexpr (SP2) {
            PG8_LDB(B0, 0, 0); PG8_LDB(B1, 0, 1); PG8_SCHED; PG8_LDA(At, 0, 0); PG8_STAGE(PG8_SA(1, 1), a1, vA[1]);
            PG8_WAIT_V(8); PG8_WAIT_L(0); PG8_BAR; PG8_MMA(0, 0, At, B0); PG8_MMA(0, 1, At, B1); PG8_BAR; PG8_SCHED;
            PG8_LDA(At, 0, 1); PG8_STAGE(PG8_SB(0, 0), b2, voffB); PG8_STAGE(PG8_SB(0, 1), b2 + hstep, voffB); PG8_STAGE(PG8_SA(0, 0), a2, v2[0]);
            PG8_WAIT_V(8); PG8_WAIT_L(0); PG8_BAR; PG8_MMA(1, 0, At, B0); PG8_MMA(1, 1, At, B1); PG8_BAR; PG8_SCHED;
            PG8_LDB(B0, 1, 0); PG8_LDB(B1, 1, 1); PG8_SCHED; PG8_LDA(At, 1, 0); PG8_STAGE(PG8_SA(0, 1), a2, v2[1]);
            PG8_WAIT_V(8); PG8_WAIT_L(0); PG8_BAR; PG8_MMA(0, 0, At, B0); PG8_MMA(0, 1, At, B1); PG8_BAR; PG8_SCHED;
            PG8_LDA(At, 1, 1); PG8_STAGE(PG8_SB(1, 0), b3, voffB); PG8_STAGE(PG8_SB(1, 1), b3 + hstep, voffB); PG8_STAGE(PG8_SA(1, 0), a3, v2[0]);
            PG8_WAIT_V(8); PG8_WAIT_L(0); PG8_BAR; PG8_MMA(1, 0, At, B0); PG8_MMA(1, 1, At, B1); PG8_BAR; PG8_SCHED;
            }
        }
        if constexpr (ALIGN_EPI) { if (wr == 0) PG8_BAR; }
        if constexpr (!Epi::AFTER_DRAIN) { E(acc, cur, wr, wc, fr, fq); S.done(cur); }
        if (!has_next) break;
#pragma unroll
        for (int a = 0; a < 2; ++a)
#pragma unroll
            for (int b = 0; b < 2; ++b)
#pragma unroll
                for (int m = 0; m < 4; ++m)
#pragma unroll
                    for (int n = 0; n < 2; ++n) acc[a][b][m][n] = (f32x4){0.f, 0.f, 0.f, 0.f};
        cur = nxt; cA = nA; cB = nB; ++ui; vA[0][0] = vN[0][0]; vA[0][1] = vN[0][1]; vA[1][0] = vN[1][0]; vA[1][1] = vN[1][1];
        if constexpr (ALIGN_EPI) { if (wr == 1) PG8_BAR; }
    }
    PG8_WAIT_V(0);
    if constexpr (!ALIGN_EPI) { if (wr == 0) PG8_BAR; }
    PG8_BAR;
    if constexpr (Epi::AFTER_DRAIN) { E.fused(acc, cur, wr, wc, fr, fq, lds, wid, lane); S.done(cur); }
#undef PG8_SA
#undef PG8_SB
#undef PG8_STAGE
#undef PG8_LDA
#undef PG8_LDB
#undef PG8_MMA
#undef PG8_WAIT_V
#undef PG8_WAIT_L
#undef PG8_BAR
#undef PG8_SCHED
}

__device__ __forceinline__ float fsig(float x) { return __builtin_amdgcn_rcpf(1.f + __expf(-x)); }
__device__ __forceinline__ float fsilu(float x) { return x * fsig(x); }
__device__ __forceinline__ float fgelu(float x) { return x * fsig(1.5957691216057308f * (x + 0.044715f * x * x * x)); }
__device__ __forceinline__ u32x4 pack8(const f32x4& v0, const f32x4& v1) { u32x4 w; w.x = cvt_pk_bf16(v0[0], v0[1]); w.y = cvt_pk_bf16(v0[2], v0[3]); w.z = cvt_pk_bf16(v1[0], v1[1]); w.w = cvt_pk_bf16(v1[2], v1[3]); return w; }
__device__ __forceinline__ void unpack8(const u32x4& w, f32x4& v0, f32x4& v1) {
    v0[0] = __uint_as_float(w.x << 16); v0[1] = __uint_as_float(w.x & 0xffff0000u); v0[2] = __uint_as_float(w.y << 16); v0[3] = __uint_as_float(w.y & 0xffff0000u);
    v1[0] = __uint_as_float(w.z << 16); v1[1] = __uint_as_float(w.z & 0xffff0000u); v1[2] = __uint_as_float(w.w << 16); v1[3] = __uint_as_float(w.w & 0xffff0000u); }

struct EpiLruIn {
    static constexpr bool PERM = true, AFTER_DRAIN = false;
    bf16_t* u; bf16_t* gl;
    __device__ __forceinline__ void operator()(const f32x4 (&acc)[2][2][4][2], const Unit& un, int wr, int wc, int fr, int fq) const {
        const int row0 = un.pm * BM + wr * 64 + fr; const bool isg = un.pn >= 6;
        bf16_t* base = (isg ? gl : u) + (isg ? un.pn - 6 : un.pn) * BM + wc * 32 + 8 * fq;
#pragma unroll
        for (int ai = 0; ai < 2; ++ai)
#pragma unroll
            for (int m = 0; m < 4; ++m) { bf16_t* rowp = base + (size_t)(row0 + ai * HALF + m * 16) * 1536;
#pragma unroll
                for (int bj = 0; bj < 2; ++bj) { f32x4 v0 = acc[ai][bj][m][0], v1 = acc[ai][bj][m][1];
                    if (isg) {
#pragma unroll
                        for (int e = 0; e < 4; ++e) { v0[e] = fgelu(v0[e]); v1[e] = fgelu(v1[e]); } }
                    *(u32x4*)(rowp + bj * HALF) = pack8(v0, v1); } }
    }
};
struct EpiRetIn {
    static constexpr bool PERM = true, AFTER_DRAIN = false;
    bf16_t* q; bf16_t* k; bf16_t* v; bf16_t* g; const float* rope;
    __device__ __forceinline__ void operator()(const f32x4 (&acc)[2][2][4][2], const Unit& un, int wr, int wc, int fr, int fq) const {
        const int row0 = un.pm * BM + wr * 64 + fr;
        if (un.pn < 8) {
            const bool isk = un.pn >= 4; const int h = un.pn & 3;
            const float lg = __log2f(1.f - __builtin_amdgcn_exp2f(-5.f - (float)h));
            const int jb = wc * 32 + 8 * fq;
            bf16_t* base = (isk ? k : q) + h * 256 + jb;
#pragma unroll
            for (int ai = 0; ai < 2; ++ai)
#pragma unroll
                for (int m = 0; m < 4; ++m) { const int r = row0 + ai * HALF + m * 16, s = r & 8191, n = s & 127;
                    const float sc = isk ? __builtin_amdgcn_exp2f(-(float)n * lg) * 0.0625f : __builtin_amdgcn_exp2f((float)n * lg);
                    const f32x4* tp = (const f32x4*)(rope + ((size_t)s * 128 + jb) * 2);
                    f32x4 o1[2], o2[2];
#pragma unroll
                    for (int nn = 0; nn < 2; ++nn) { const f32x4 ta = tp[2 * nn], tb = tp[2 * nn + 1]; const f32x4 a = acc[ai][0][m][nn], b = acc[ai][1][m][nn];
                        o1[nn][0] = (a[0] * ta[0] - b[0] * ta[1]) * sc; o2[nn][0] = (a[0] * ta[1] + b[0] * ta[0]) * sc;
                        o1[nn][1] = (a[1] * ta[2] - b[1] * ta[3]) * sc; o2[nn][1] = (a[1] * ta[3] + b[1] * ta[2]) * sc;
                        o1[nn][2] = (a[2] * tb[0] - b[2] * tb[1]) * sc; o2[nn][2] = (a[2] * tb[1] + b[2] * tb[0]) * sc;
                        o1[nn][3] = (a[3] * tb[2] - b[3] * tb[3]) * sc; o2[nn][3] = (a[3] * tb[3] + b[3] * tb[2]) * sc; }
                    bf16_t* rowp = base + (size_t)r * 1024;
                    *(u32x4*)(rowp) = pack8(o1[0], o1[1]); *(u32x4*)(rowp + HALF) = pack8(o2[0], o2[1]);
                    asm volatile("" ::: "memory"); }
        } else {
            const bool isg = un.pn >= 16;
            bf16_t* base = (isg ? g : v) + ((un.pn - 8) & 7) * BM + wc * 32 + 8 * fq;
#pragma unroll
            for (int ai = 0; ai < 2; ++ai)
#pragma unroll
                for (int m = 0; m < 4; ++m) { bf16_t* rowp = base + (size_t)(row0 + ai * HALF + m * 16) * 2048;
#pragma unroll
                    for (int bj = 0; bj < 2; ++bj) { f32x4 v0 = acc[ai][bj][m][0], v1 = acc[ai][bj][m][1];
                        if (isg) {
#pragma unroll
                            for (int e = 0; e < 4; ++e) { v0[e] = fsilu(v0[e]); v1[e] = fsilu(v1[e]); } }
                        *(u32x4*)(rowp + bj * HALF) = pack8(v0, v1); } }
        }
    }
};
struct EpiGates {
    static constexpr bool PERM = true, AFTER_DRAIN = false;
    const float* bm; bf16_t* gates;
    __device__ __forceinline__ void operator()(const f32x4 (&acc)[2][2][4][2], const Unit& un, int wr, int wc, int fr, int fq) const {
        const int row0 = un.pm * BM + wr * 64 + fr, col0 = un.pn * BM + wc * 32 + 8 * fq;
        f32x4 bv[2][2];
#pragma unroll
        for (int bj = 0; bj < 2; ++bj)
#pragma unroll
            for (int n = 0; n < 2; ++n) bv[bj][n] = *(const f32x4*)(bm + col0 + bj * HALF + 4 * n);
#pragma unroll
        for (int ai = 0; ai < 2; ++ai)
#pragma unroll
            for (int m = 0; m < 4; ++m) { bf16_t* rowp = gates + (size_t)(row0 + ai * HALF + m * 16) * 2048 + col0;
#pragma unroll
                for (int bj = 0; bj < 2; ++bj) { f32x4 v0 = acc[ai][bj][m][0] + bv[bj][0], v1 = acc[ai][bj][m][1] + bv[bj][1];
#pragma unroll
                    for (int e = 0; e < 4; ++e) { v0[e] = fsig(v0[e]); v1[e] = fsig(v1[e]); }
                    *(u32x4*)(rowp + bj * HALF) = pack8(v0, v1); } }
    }
};
template <int MODE> struct EpiMerge {
    static constexpr bool PERM = true, AFTER_DRAIN = false;
    const bf16_t* gates; const bf16_t* m1in; bf16_t* o;
    __device__ __forceinline__ void operator()(const f32x4 (&acc)[2][2][4][2], const Unit& un, int wr, int wc, int fr, int fq) const {
        const int row0 = un.pm * BM + wr * 64 + fr, col0 = un.pn * BM + wc * 32 + 8 * fq;
#pragma unroll
        for (int ai = 0; ai < 2; ++ai)
#pragma unroll
            for (int m = 0; m < 4; ++m) { const size_t r = (size_t)(row0 + ai * HALF + m * 16);
#pragma unroll
                for (int bj = 0; bj < 2; ++bj) { const int c = col0 + bj * HALF;
                    f32x4 g0, g1; unpack8(*(const u32x4*)(gates + r * 2048 + MODE * 1024 + c), g0, g1);
                    f32x4 v0 = acc[ai][bj][m][0] * g0, v1 = acc[ai][bj][m][1] * g1;
                    if (MODE == 1) { f32x4 p0, p1; unpack8(*(const u32x4*)(m1in + r * 1024 + c), p0, p1); v0 += p0; v1 += p1; }
                    *(u32x4*)(o + r * 1024 + c) = pack8(v0, v1); } }
    }
};
struct EpiOut {
    static constexpr bool PERM = true, AFTER_DRAIN = false;
    const float* x; bf16_t* y; float alpha;
    __device__ __forceinline__ void operator()(const f32x4 (&acc)[2][2][4][2], const Unit& un, int wr, int wc, int fr, int fq) const {
        const int row0 = un.pm * BM + wr * 64 + fr, col0 = un.pn * BM + wc * 32 + 8 * fq;
#pragma unroll
        for (int ai = 0; ai < 2; ++ai)
#pragma unroll
            for (int m = 0; m < 4; ++m) { const size_t off = (size_t)(row0 + ai * HALF + m * 16) * 1024 + col0;
#pragma unroll
                for (int bj = 0; bj < 2; ++bj) { const f32x4 x0 = *(const f32x4*)(x + off + bj * HALF), x1 = *(const f32x4*)(x + off + bj * HALF + 4);
                    *(u32x4*)(y + off + bj * HALF) = pack8(x0 * alpha + acc[ai][bj][m][0], x1 * alpha + acc[ai][bj][m][1]); } }
    }
};
struct MoeTab { int tileStart[33]; int cnt[32]; int pad_[3]; int tileExp[320]; };
__device__ __forceinline__ void moe_build_tab(PG8_LAS MoeTab* tab, const int* cnt) {
    if (threadIdx.x == 0) { int t = 0; for (int e = 0; e < 32; ++e) { const int c = cnt[e * 64], nt = (c + 255) >> 8; tab->tileStart[e] = t; tab->cnt[e] = c; for (int i = 0; i < nt; ++i) tab->tileExp[t + i] = e; t += nt; } tab->tileStart[32] = t; }
    __syncthreads();
}
template <bool GATHER> struct MoeOrder {
    int U, G, c; const PG8_LAS MoeTab* tab; const int* list;
    __device__ __forceinline__ bool next(int i, Unit& u) const {
        const long L = (long)i * G + c; if (L >= U) return false;
        int wgid = (int)L; { const int q = U / NXCD, r = U % NXCD, xcd = wgid % NXCD, off = wgid / NXCD; wgid = (xcd < r ? xcd * (q + 1) : r * (q + 1) + (xcd - r) * q) + off; }
        u.pm = wgid >> 2; u.pn = tab->tileExp[u.pm] * 4 + (wgid & 3); return true;
    }
    __device__ __forceinline__ void a_ready(const Unit&) const {}
    __device__ __forceinline__ void done(const Unit&) const {}
    __device__ __forceinline__ const char* a_base(const Gemm& g, const Unit& u) const { return GATHER ? (const char*)g.A : (const char*)g.A + (size_t)u.pm * (size_t)(BM * g.K * 2); }
    __device__ __forceinline__ void a_off(const Gemm& g, const Unit& u, const int (&R)[2], const int (&C)[2], unsigned (&v)[2][2]) const {
        if (!GATHER) { _Pragma("unroll") for (int hh = 0; hh < 2; ++hh) _Pragma("unroll") for (int i = 0; i < 2; ++i) v[hh][i] = (unsigned)((hh * HALF + R[i]) * g.K + C[i]) * 2u; }
        else { const int e = u.pn >> 2, base = (u.pm - tab->tileStart[e]) * BM, ce = tab->cnt[e];
            _Pragma("unroll") for (int hh = 0; hh < 2; ++hh) _Pragma("unroll") for (int i = 0; i < 2; ++i) { const int lr = base + hh * HALF + R[i]; const int tok = (lr < ce) ? (list[e * 32768 + lr] >> 1) : 0; v[hh][i] = (unsigned)(tok * g.K + C[i]) * 2u; } }
    }
};
struct EpiSwiGLU {
    static constexpr bool PERM = true, AFTER_DRAIN = false;
    bf16_t* h;
    __device__ __forceinline__ void operator()(const f32x4 (&acc)[2][2][4][2], const Unit& un, int wr, int wc, int fr, int fq) const {
        const int row0 = un.pm * BM + wr * 64 + fr, col0 = (un.pn & 3) * 128 + wc * 32 + 8 * fq;
#pragma unroll
        for (int ai = 0; ai < 2; ++ai)
#pragma unroll
            for (int m = 0; m < 4; ++m) { f32x4 v0, v1;
#pragma unroll
                for (int e = 0; e < 4; ++e) { v0[e] = fsilu(acc[ai][0][m][0][e]) * acc[ai][1][m][0][e]; v1[e] = fsilu(acc[ai][0][m][1][e]) * acc[ai][1][m][1][e]; }
                *(u32x4*)(h + (size_t)(row0 + ai * HALF + m * 16) * 512 + col0) = pack8(v0, v1); }
    }
};
struct EpiMoeOut {
    static constexpr bool PERM = true, AFTER_DRAIN = false;
    const PG8_LAS MoeTab* tab; const int* list; const float* rw; bf16_t* ys;
    __device__ __forceinline__ void operator()(const f32x4 (&acc)[2][2][4][2], const Unit& un, int wr, int wc, int fr, int fq) const {
        const int e = un.pn >> 2, lrow0 = (un.pm - tab->tileStart[e]) * BM + wr * 64 + fr, ce = tab->cnt[e], col0 = (un.pn & 3) * BM + wc * 32 + 8 * fq;
        int slot[8]; float wgt[8];
#pragma unroll
        for (int i = 0; i < 8; ++i) { const int lr = lrow0 + (i >> 2) * HALF + (i & 3) * 16; slot[i] = (lr < ce) ? list[e * 32768 + lr] : -1; }
#pragma unroll
        for (int i = 0; i < 8; ++i) wgt[i] = (slot[i] >= 0) ? rw[slot[i]] : 0.f;
#pragma unroll
        for (int ai = 0; ai < 2; ++ai)
#pragma unroll
            for (int m = 0; m < 4; ++m) { const int i = ai * 4 + m;
                if (slot[i] >= 0) { const float w = wgt[i]; bf16_t* rowp = ys + (size_t)slot[i] * 1024 + col0;
#pragma unroll
                    for (int bj = 0; bj < 2; ++bj) *(u32x4*)(rowp + bj * HALF) = pack8(acc[ai][bj][m][0] * w, acc[ai][bj][m][1] * w); } }
    }
};
}

DEV unsigned pk2(float lo, float hi) { return (unsigned)f2bf(lo) | ((unsigned)f2bf(hi) << 16); }
typedef unsigned v4u __attribute__((ext_vector_type(4)));
DEV void transpose_item(const float* W, int K, int N, bf16_t* WT, int row_off, float* scr, int item, int lane) {
    const int nblk = N / 32, kb = item / nblk, nb = item % nblk, k0 = 64 * kb, n0 = 32 * nb;
    float wv[32];
#pragma unroll
    for (int i = 0; i < 32; ++i) wv[i] = W[(size_t)(k0 + 2 * i + (lane >> 5)) * N + n0 + (lane & 31)];
#pragma unroll
    for (int i = 0; i < 32; ++i) scr[(2 * i + (lane >> 5)) * 33 + (lane & 31)] = wv[i];
    asm volatile("s_waitcnt lgkmcnt(0)" ::: "memory");
    const int c = lane & 7;
#pragma unroll
    for (int j = 0; j < 4; ++j) { const int n = (lane >> 3) + 8 * j; const float* s = scr + (8 * c) * 33 + n;
        v4u o; o.x = pk2(s[0 * 33], s[1 * 33]); o.y = pk2(s[2 * 33], s[3 * 33]); o.z = pk2(s[4 * 33], s[5 * 33]); o.w = pk2(s[6 * 33], s[7 * 33]);
        *(v4u*)(WT + (size_t)(row_off + n0 + n) * K + k0 + 8 * c) = o; }
    asm volatile("s_waitcnt lgkmcnt(0)" ::: "memory");
}
DEV void p_weights(float* lds, const float* w_in, const float* w_ret_o, const float* w_lru_o, const float* w_out, const float* w_rg_r, const float* w_rg_i, bf16_t* w_in_t, bf16_t* w_ro_t, bf16_t* w_lo_t, bf16_t* w_out_t, bf16_t* wrg_t) {
    const int wave = threadIdx.x >> 6, lane = threadIdx.x & 63;
    float* scr = lds + wave * 2304;
    constexpr int I0 = 16 * (WIN_N / 32), I1 = 32 * 32, I2 = 24 * 32, I3 = 16 * 32, I4 = 16 * 18;
    for (int it = blockIdx.x * 8 + wave; it < I0 + I1 + I2 + I3 + I4; it += gridDim.x * 8) {
        int r = it;
        if (r < I0) { transpose_item(w_in, 1024, WIN_N, w_in_t, 0, scr, r, lane); continue; } r -= I0;
        if (r < I1) { transpose_item(w_ret_o, 2048, 1024, w_ro_t, 0, scr, r, lane); continue; } r -= I1;
        if (r < I2) { transpose_item(w_lru_o, 1536, 1024, w_lo_t, 0, scr, r, lane); continue; } r -= I2;
        if (r < I3) { transpose_item(w_out, 1024, 1024, w_out_t, 0, scr, r, lane); continue; } r -= I3;
        { const int mi = r / 18, sub = r - mi * 18; const float* W = (mi < 8 ? w_rg_r + (size_t)mi * 192 * 192 : w_rg_i + (size_t)(mi - 8) * 192 * 192);
          transpose_item(W, 192, 192, wrg_t + (size_t)mi * 192 * 192, 0, scr, sub, lane); }
    }
}

DEV void p_expert_weights(float* lds, const float* w_eg, const float* w_eu, const float* w_ed, bf16_t* wgu_t, bf16_t* wd_t) {
    const int wave = threadIdx.x >> 6, lane = threadIdx.x & 63;
    float* scr = lds + wave * 2304;
    for (int it = blockIdx.x * 8 + wave; it < 3 * 8192; it += gridDim.x * 8) {
        const int kind = it >> 13, r = it & 8191, e = r >> 8, sub = r & 255;
        if (kind < 2) { const int nb = sub & 15; transpose_item((kind ? w_eu : w_eg) + (size_t)e * 1024 * 512, 1024, 512, wgu_t + (size_t)e * 1024 * 1024, (nb >> 2) * 128 + kind * 128, scr, sub, lane); }
        else transpose_item(w_ed + (size_t)e * 512 * 1024, 512, 1024, wd_t + (size_t)e * 1024 * 512, 0, scr, sub, lane);
    }
}

DEV void p_router_consts(float* lds, const float* g1, const float* b1, const float* wg, const float* bg, const float* we, const float* be, float* sb) {
    if (blockIdx.x != 0) return;
    const int t = threadIdx.x, wv = t >> 6, lane = t & 63;
    float s[36], q[36];
#pragma unroll
    for (int c = 0; c < 36; ++c) { s[c] = 0.f; q[c] = 0.f; }
#pragma unroll
    for (int kk = 0; kk < 2; ++kk) { const int k = t + 512 * kk; const float gk = g1[k], bk = b1[k];
#pragma unroll
        for (int c4 = 0; c4 < 9; ++c4) { const float4 w = (c4 < 8) ? *(const float4*)(we + (size_t)k * 32 + c4 * 4) : *(const float4*)(wg + (size_t)k * 4);
            s[4 * c4] += gk * w.x; s[4 * c4 + 1] += gk * w.y; s[4 * c4 + 2] += gk * w.z; s[4 * c4 + 3] += gk * w.w;
            q[4 * c4] += bk * w.x; q[4 * c4 + 1] += bk * w.y; q[4 * c4 + 2] += bk * w.z; q[4 * c4 + 3] += bk * w.w; } }
#pragma unroll
    for (int m = 1; m < 64; m <<= 1) {
#pragma unroll
        for (int c = 0; c < 36; ++c) { s[c] += __shfl_xor(s[c], m); q[c] += __shfl_xor(q[c], m); } }
    if (lane == 0) {
#pragma unroll
        for (int c = 0; c < 36; ++c) { lds[wv * 96 + c] = s[c]; lds[wv * 96 + 48 + c] = q[c]; } }
    __syncthreads();
    if (t < 96) { const int cc = t % 48; float v = 0.f;
        if (cc < 36) { for (int p = 0; p < 8; ++p) v += lds[p * 96 + t]; if (t >= 48) v += (cc < 32) ? be[cc] : bg[cc - 32]; }
        sb[t] = v; }
    __syncthreads();
}
DEV void p_cvt_x(const float* x, bf16_t* xb) {
    const size_t n4 = (size_t)NTOK * DM / 4, stride = (size_t)gridDim.x * NTHR;
    for (size_t i0 = (size_t)blockIdx.x * NTHR + threadIdx.x; i0 < n4; i0 += 8 * stride) {
        float4 t[8];
#pragma unroll
        for (int u = 0; u < 8; ++u) { const size_t i = i0 + u * stride; t[u] = (i < n4) ? ((const float4*)x)[i] : make_float4(0.f, 0.f, 0.f, 0.f); }
#pragma unroll
        for (int u = 0; u < 8; ++u) { const size_t i = i0 + u * stride; if (i < n4) { uint2 o; o.x = pg8::cvt_pk_bf16(t[u].x, t[u].y); o.y = pg8::cvt_pk_bf16(t[u].z, t[u].w); ((uint2*)xb)[i] = o; } }
    }
}
DEV void p_rope_table(float2* tab) {
    for (int i = blockIdx.x * NTHR + threadIdx.x; i < 8192 * 128; i += gridDim.x * NTHR) {
        const int s = i >> 7, j = i & 127;
        const double r = 0.93057204092969897;
        double inv = 1.0; for (int t = 0; t < j; ++t) inv *= r;
        const double ang = (double)s * inv;
        const double twopi_hi = 6.283185307179586232, twopi_lo = 2.4492935982947064e-16;
        const double n = rint(ang / twopi_hi);
        const double x = (ang - n * twopi_hi) - n * twopi_lo;
        const double x2 = x * x;
        double acc = 1.0 - x2 * (1.0 / (22.0 * 23.0));
#pragma unroll
        for (int k = 21; k >= 3; k -= 2) acc = 1.0 - x2 * (1.0 / ((double)(k - 1) * (double)k)) * acc;
        double acc2 = 1.0 - x2 * (1.0 / (21.0 * 22.0));
#pragma unroll
        for (int k = 20; k >= 2; k -= 2) acc2 = 1.0 - x2 * (1.0 / ((double)(k - 1) * (double)k)) * acc2;
        tab[i] = make_float2((float)acc2, (float)(x * acc));
    }
}

typedef short bf16x8_t __attribute__((ext_vector_type(8)));
typedef float f32x4_t __attribute__((ext_vector_type(4)));
typedef short s16x4_t __attribute__((ext_vector_type(4)));
typedef unsigned u32x4_t __attribute__((ext_vector_type(4)));
constexpr int LRU_ROWB = 400;
DEV void p_lru_compute(unsigned char* lds, const bf16_t* ulru, const float* cw, const float* cb, const bf16_t* wrg_t,
                       const float* b_r, const float* b_i, const float* lam, bf16_t* epsb, bf16_t* xinb, float* segA, float* segH) {
    int tid_ = threadIdx.x; asm volatile("" : "+v"(tid_));
    const int tid = tid_, wave = tid >> 6, lane = tid & 63, fr = lane & 15, fq = lane >> 4, wr = wave >> 2, wc = wave & 3;
    unsigned char* stg = lds + 256 * LRU_ROWB + wave * 4096;
    for (int item = blockIdx.x; item < 1024; item += gridDim.x) {
        const int n = item & 7, b = (item >> 3) & 3, seg = item >> 5;
        const size_t t0 = (size_t)b * SEQ + seg * 256;
#pragma unroll 4
        for (int idx = tid; idx < 256 * 24; idx += NTHR) {
            const int r = idx / 24, c8 = idx - r * 24, ch0 = n * 192 + c8 * 8;
            float acc[8];
            { const float4 c0 = *(const float4*)(cb + ch0), c1 = *(const float4*)(cb + ch0 + 4); acc[0] = c0.x; acc[1] = c0.y; acc[2] = c0.z; acc[3] = c0.w; acc[4] = c1.x; acc[5] = c1.y; acc[6] = c1.z; acc[7] = c1.w; }
#pragma unroll
            for (int j = 0; j < 4; ++j) {
                if (seg * 256 + r - 3 + j >= 0) {
                    const uint4 uv = *(const uint4*)(ulru + (t0 + r - 3 + j) * 1536 + ch0);
                    const float4 w0 = *(const float4*)(cw + j * 1536 + ch0), w1 = *(const float4*)(cw + j * 1536 + ch0 + 4);
                    acc[0] += w0.x * __uint_as_float(uv.x << 16); acc[1] += w0.y * __uint_as_float(uv.x & 0xffff0000u);
                    acc[2] += w0.z * __uint_as_float(uv.y << 16); acc[3] += w0.w * __uint_as_float(uv.y & 0xffff0000u);
                    acc[4] += w1.x * __uint_as_float(uv.z << 16); acc[5] += w1.y * __uint_as_float(uv.z & 0xffff0000u);
                    acc[6] += w1.z * __uint_as_float(uv.w << 16); acc[7] += w1.w * __uint_as_float(uv.w & 0xffff0000u);
                }
            }
            uint4 o; o.x = pg8::cvt_pk_bf16(acc[0], acc[1]); o.y = pg8::cvt_pk_bf16(acc[2], acc[3]); o.z = pg8::cvt_pk_bf16(acc[4], acc[5]); o.w = pg8::cvt_pk_bf16(acc[6], acc[7]);
            *(uint4*)(lds + r * LRU_ROWB + c8 * 16) = o;
        }
        __syncthreads();
        float cbr[3], cbi[3], csp[3], hrun[3], atot[3];
        const int sub = seg * 2 + wr;
#pragma unroll
        for (int tc = 0; tc < 3; ++tc) { const int ch = n * 192 + 48 * wc + 16 * tc + fr; cbr[tc] = b_r[ch]; cbi[tc] = b_i[ch]; csp[tc] = 8.f * 1.4426950408889634f * log1pf(__expf(-lam[ch])); atot[tc] = 1.f; hrun[tc] = 0.f; }
        const bf16_t* wrb = wrg_t + ((size_t)n * 192 + 48 * wc + fr) * 192 + fq * 8;
        const bf16_t* wib = wrb + (size_t)8 * 192 * 192;
#pragma unroll
        for (int tc = 0; tc < 3; ++tc) {
            bf16x8_t bfr[6][2];
#pragma unroll
            for (int ks = 0; ks < 6; ++ks) { bfr[ks][0] = *(const bf16x8_t*)(wrb + tc * 16 * 192 + ks * 32); bfr[ks][1] = *(const bf16x8_t*)(wib + tc * 16 * 192 + ks * 32); }
#pragma unroll
            for (int p = 0; p < 2; ++p) {
                const int rowb = 128 * wr + 64 * p;
                f32x4_t acc[4][2];
#pragma unroll
                for (int m = 0; m < 4; ++m) { acc[m][0] = (f32x4_t){0.f, 0.f, 0.f, 0.f}; acc[m][1] = (f32x4_t){0.f, 0.f, 0.f, 0.f}; }
#pragma unroll
                for (int ks = 0; ks < 6; ++ks) {
                    bf16x8_t afr[4];
#pragma unroll
                    for (int m = 0; m < 4; ++m) afr[m] = *(const bf16x8_t*)(lds + (rowb + 16 * (fr >> 2) + 4 * m + (fr & 3)) * LRU_ROWB + ks * 64 + fq * 16);
#pragma unroll
                    for (int m = 0; m < 4; ++m) { acc[m][0] = __builtin_amdgcn_mfma_f32_16x16x32_bf16(afr[m], bfr[ks][0], acc[m][0], 0, 0, 0); acc[m][1] = __builtin_amdgcn_mfma_f32_16x16x32_bf16(afr[m], bfr[ks][1], acc[m][1], 0, 0, 0); }
                }
                const int coff = (48 * wc + 16 * tc + fr) * 2;
                const unsigned char* up = lds + (rowb + 16 * fq) * LRU_ROWB + coff;
                float Al = 1.f, Bl = 0.f;
                unsigned pe[8], px[8];
#pragma unroll
                for (int m = 0; m < 4; ++m) {
                    float ee[4], xx[4];
#pragma unroll
                    for (int j = 0; j < 4; ++j) {
                        const float rr = pg8::fsig(acc[m][0][j] + cbr[tc]), ii = pg8::fsig(acc[m][1][j] + cbi[tc]);
                        const float aa = __builtin_amdgcn_exp2f(-csp[tc] * rr);
                        const float u = bf2f(*(const bf16_t*)(up + (4 * m + j) * LRU_ROWB));
                        const float om = 1.f - aa;
                        const float x = __builtin_amdgcn_sqrtf(fmaxf(om * (1.f + aa), 0.f)) * ii * u;
                        ee[j] = om; xx[j] = x; Bl = aa * Bl + x; Al *= aa;
                    }
                    pe[2 * m] = pg8::cvt_pk_bf16(ee[0], ee[1]); pe[2 * m + 1] = pg8::cvt_pk_bf16(ee[2], ee[3]);
                    px[2 * m] = pg8::cvt_pk_bf16(xx[0], xx[1]); px[2 * m + 1] = pg8::cvt_pk_bf16(xx[2], xx[3]);
                }
                { float h = hrun[tc], ap = 1.f;
#pragma unroll
                  for (int q = 0; q < 4; ++q) { const float Aq = __shfl(Al, fr + 16 * q), Bq = __shfl(Bl, fr + 16 * q); h = Aq * h + Bq; ap *= Aq; }
                  hrun[tc] = h; atot[tc] *= ap; }
#pragma unroll
                for (int m = 0; m < 4; ++m)
#pragma unroll
                    for (int j = 0; j < 4; ++j) { const int tk = 16 * fq + 4 * m + j; const unsigned we = pe[2 * m + (j >> 1)], wx = px[2 * m + (j >> 1)];
                        *(bf16_t*)(stg + tk * 32 + fr * 2) = (bf16_t)((j & 1) ? (we >> 16) : (we & 0xffff));
                        *(bf16_t*)(stg + 2048 + tk * 32 + fr * 2) = (bf16_t)((j & 1) ? (wx >> 16) : (wx & 0xffff)); }
                asm volatile("s_waitcnt lgkmcnt(0)" ::: "memory");
#pragma unroll
                for (int i = 0; i < 2; ++i) { const int piece = lane + 64 * i, tk = piece >> 1, hf = piece & 1;
                    const size_t go = (t0 + rowb + tk) * 1536 + n * 192 + 48 * wc + 16 * tc + 8 * hf;
                    *(u32x4_t*)(epsb + go) = *(const u32x4_t*)(stg + tk * 32 + hf * 16);
                    *(u32x4_t*)(xinb + go) = *(const u32x4_t*)(stg + 2048 + tk * 32 + hf * 16); }
                asm volatile("s_waitcnt lgkmcnt(0)" ::: "memory");
            }
        }
        if (fq == 0) {
#pragma unroll
            for (int tc = 0; tc < 3; ++tc) { const size_t o = ((size_t)b * 64 + sub) * 1536 + n * 192 + 48 * wc + 16 * tc + fr; segA[o] = atot[tc]; segH[o] = hrun[tc]; }
        }
        __syncthreads();
    }
}
DEV void p_lru_scan(const bf16_t* epsb, const bf16_t* xinb, bf16_t* gl, const float* carry) {
    const int tid = threadIdx.x;
    if (tid >= 384) return;
    for (int item = blockIdx.x; item < 256; item += gridDim.x) {
        const int b = item >> 6, sub = item & 63;
        const size_t base = ((size_t)b * SEQ + sub * 128) * 1536 + tid * 4;
        const float4 cin = *(const float4*)(carry + ((size_t)b * 64 + sub) * 1536 + tid * 4);
        float h0 = cin.x, h1 = cin.y, h2 = cin.z, h3 = cin.w;
#pragma unroll 8
        for (int t = 0; t < 128; ++t) {
            const size_t o = base + (size_t)t * 1536;
            const uint2 ev = *(const uint2*)(epsb + o), xv = *(const uint2*)(xinb + o), gv = *(const uint2*)(gl + o);
            h0 = (1.f - __uint_as_float(ev.x << 16)) * h0 + __uint_as_float(xv.x << 16);
            h1 = (1.f - __uint_as_float(ev.x & 0xffff0000u)) * h1 + __uint_as_float(xv.x & 0xffff0000u);
            h2 = (1.f - __uint_as_float(ev.y << 16)) * h2 + __uint_as_float(xv.y << 16);
            h3 = (1.f - __uint_as_float(ev.y & 0xffff0000u)) * h3 + __uint_as_float(xv.y & 0xffff0000u);
            uint2 ov; ov.x = pg8::cvt_pk_bf16(h0 * __uint_as_float(gv.x << 16), h1 * __uint_as_float(gv.x & 0xffff0000u)); ov.y = pg8::cvt_pk_bf16(h2 * __uint_as_float(gv.y << 16), h3 * __uint_as_float(gv.y & 0xffff0000u));
            *(uint2*)(gl + o) = ov;
        }
    }
}
DEV void p_lru_carry(float* lds, const float* segA, const float* segH, float* carry) {
    float* tA = lds; float* tH = lds + 64 * 65;
    for (int item = blockIdx.x; item < 96; item += gridDim.x) {
        const int b = item / 24, c0 = (item % 24) * 64;
        for (int i = threadIdx.x; i < 64 * 64; i += NTHR) { const int s = i >> 6, c = i & 63; const size_t o = ((size_t)b * 64 + s) * 1536 + c0 + c; tA[s * 65 + c] = segA[o]; tH[s * 65 + c] = segH[o]; }
        __syncthreads();
        if (threadIdx.x < 64) { const int c = threadIdx.x; float h = 0.f;
            for (int s = 0; s < 64; ++s) { const float a = tA[s * 65 + c], hh = tH[s * 65 + c]; tA[s * 65 + c] = h; h = a * h + hh; } }
        __syncthreads();
        for (int i = threadIdx.x; i < 64 * 64; i += NTHR) { const int s = i >> 6, c = i & 63; carry[((size_t)b * 64 + s) * 1536 + c0 + c] = tA[s * 65 + c]; }
        __syncthreads();
    }
}
#define LDS_BARRIER() do { asm volatile("s_waitcnt lgkmcnt(0)" ::: "memory"); __builtin_amdgcn_s_barrier(); asm volatile("" ::: "memory"); } while (0)
DEV void p_scores(unsigned char* lds, const bf16_t* q, const bf16_t* k, bf16_t* P) {
    int tid_ = threadIdx.x; asm volatile("" : "+v"(tid_));
    const int tid = tid_, w = tid >> 6, lane = tid & 63, fr = lane & 15, fq = lane >> 4;
    const int krow = tid >> 5, kch = tid & 31;
    u32x4_t kreg[8]; bf16x8_t qa[8];
    int g = blockIdx.x;
    if (g < 1024) { const int c = g & 63, bh = g >> 6, b = bh >> 2, h = bh & 3; const size_t tok0 = (size_t)b * SEQ + c * 128;
        const bf16_t* kc = k + tok0 * 1024 + h * 256;
#pragma unroll
        for (int ii = 0; ii < 8; ++ii) kreg[ii] = *(const u32x4_t*)(kc + (size_t)(krow + 16 * ii) * 1024 + kch * 8);
        const bf16_t* qp = q + (tok0 + 16 * w + fr) * 1024 + h * 256 + fq * 8;
#pragma unroll
        for (int ks = 0; ks < 8; ++ks) qa[ks] = *(const bf16x8_t*)(qp + ks * 32); }
    for (; g < 1024; g += gridDim.x) {
#pragma unroll
        for (int ii = 0; ii < 8; ++ii) *(u32x4_t*)(lds + (krow + 16 * ii) * 528 + kch * 16) = kreg[ii];
        bf16x8_t qc[8];
#pragma unroll
        for (int ks = 0; ks < 8; ++ks) qc[ks] = qa[ks];
        const int gn = g + gridDim.x;
        if (gn < 1024) { const int c = gn & 63, bh = gn >> 6, b = bh >> 2, h = bh & 3; const size_t tok0 = (size_t)b * SEQ + c * 128;
            const bf16_t* kc = k + tok0 * 1024 + h * 256;
#pragma unroll
            for (int ii = 0; ii < 8; ++ii) kreg[ii] = *(const u32x4_t*)(kc + (size_t)(krow + 16 * ii) * 1024 + kch * 8);
            const bf16_t* qp = q + (tok0 + 16 * w + fr) * 1024 + h * 256 + fq * 8;
#pragma unroll
            for (int ks = 0; ks < 8; ++ks) qa[ks] = *(const bf16x8_t*)(qp + ks * 32); }
        LDS_BARRIER();
        f32x4_t acc[8];
#pragma unroll
        for (int nt = 0; nt < 8; ++nt) acc[nt] = (f32x4_t){0.f, 0.f, 0.f, 0.f};
#pragma unroll
        for (int ks = 0; ks < 8; ++ks)
#pragma unroll
            for (int nt = 0; nt < 8; ++nt) { const bf16x8_t bb = *(const bf16x8_t*)(lds + (16 * nt + fr) * 528 + ks * 64 + fq * 16); acc[nt] = __builtin_amdgcn_mfma_f32_16x16x32_bf16(qc[ks], bb, acc[nt], 0, 0, 0); }
        LDS_BARRIER();
        bf16_t* Pg = P + (size_t)g * 16384 + (16 * w + 4 * fq) * 128 + fr;
        int nrow = 16 * w + 4 * fq - fr; asm volatile("" : "+v"(nrow));
#pragma unroll
        for (int nt = 0; nt < 8; ++nt)
#pragma unroll
            for (int j = 0; j < 4; ++j) Pg[j * 128 + 16 * nt] = (16 * nt <= nrow + j) ? f2bf(acc[nt][j]) : (bf16_t)0;
    }
    __syncthreads();
}
constexpr int RT_KS = 528, RT_VS = 272, RT_K = 0, RT_V = 128 * RT_KS, RT_U = RT_V + 32 * RT_VS;
DEV void p_ret_mfma(unsigned char* lds, const bf16_t* q, const bf16_t* k, bf16_t* v, const bf16_t* P) {
    int tid_ = threadIdx.x; asm volatile("" : "+v"(tid_));
    const int tid = tid_, w = tid >> 6, lane = tid & 63, fr = lane & 15, fq = lane >> 4;
    for (int wk = blockIdx.x; wk < 256; wk += gridDim.x) {
        const int xcd = wk & 7, idx = wk >> 3, bh = xcd * 2 + (idx >> 4), sl = idx & 15, b = bh >> 2, h = bh & 3;
        float g128; { const double gam = 1.0 - exp2(-5.0 - (double)h); g128 = (float)exp2(128.0 * log2(gam)); }
        asm volatile("" : "+v"(g128));
        f32x4_t accU[2][2];
#pragma unroll
        for (int et = 0; et < 2; ++et)
#pragma unroll
            for (int di = 0; di < 2; ++di) accU[et][di] = (f32x4_t){0.f, 0.f, 0.f, 0.f};
        for (int i = tid; i < 32 * RT_KS / 4; i += NTHR) ((unsigned*)(lds + RT_U))[i] = 0u;
        const size_t tokb = (size_t)b * SEQ;
        u32x4_t kreg[8], vreg;
        const int krow = tid >> 5, kch = tid & 31, vm = tid >> 2, ve = (tid & 3) * 8;
        {
            const bf16_t* kc = k + tokb * 1024 + h * 256;
#pragma unroll
            for (int ii = 0; ii < 8; ++ii) kreg[ii] = *(const u32x4_t*)(kc + (size_t)(krow + 16 * ii) * 1024 + kch * 8);
            vreg = *(const u32x4_t*)(v + (tokb + vm) * 2048 + h * 512 + sl * 32 + ve);
        }
        bf16x8_t qa[8], pa[4];
        {
            const bf16_t* qp = q + (tokb + 16 * w + fr) * 1024 + h * 256 + fq * 8;
#pragma unroll
            for (int ks = 0; ks < 8; ++ks) qa[ks] = *(const bf16x8_t*)(qp + ks * 32);
            const bf16_t* pp = P + (size_t)(bh * 64) * 16384 + (16 * w + fr) * 128 + fq * 8;
#pragma unroll
            for (int ks = 0; ks < 4; ++ks) pa[ks] = *(const bf16x8_t*)(pp + ks * 32);
        }
#pragma unroll 1
        for (int c = 0; c < 64; ++c) {
            const size_t tok0 = tokb + c * 128;
#pragma unroll
            for (int ii = 0; ii < 8; ++ii) *(u32x4_t*)(lds + RT_K + (krow + 16 * ii) * RT_KS + kch * 16) = kreg[ii];
            {
                unsigned char* vp = lds + RT_V + ve * RT_VS + vm * 2;
                *(bf16_t*)(vp + 0 * RT_VS) = (bf16_t)(vreg.x & 0xffff); *(bf16_t*)(vp + 1 * RT_VS) = (bf16_t)(vreg.x >> 16);
                *(bf16_t*)(vp + 2 * RT_VS) = (bf16_t)(vreg.y & 0xffff); *(bf16_t*)(vp + 3 * RT_VS) = (bf16_t)(vreg.y >> 16);
                *(bf16_t*)(vp + 4 * RT_VS) = (bf16_t)(vreg.z & 0xffff); *(bf16_t*)(vp + 5 * RT_VS) = (bf16_t)(vreg.z >> 16);
                *(bf16_t*)(vp + 6 * RT_VS) = (bf16_t)(vreg.w & 0xffff); *(bf16_t*)(vp + 7 * RT_VS) = (bf16_t)(vreg.w >> 16);
            }
            if (c + 1 < 64) {
                const bf16_t* kc = k + (tok0 + 128) * 1024 + h * 256;
#pragma unroll
                for (int ii = 0; ii < 8; ++ii) kreg[ii] = *(const u32x4_t*)(kc + (size_t)(krow + 16 * ii) * 1024 + kch * 8);
                vreg = *(const u32x4_t*)(v + (tok0 + 128 + vm) * 2048 + h * 512 + sl * 32 + ve);
            }
            LDS_BARRIER();
            f32x4_t ao[2] = {(f32x4_t){0.f, 0.f, 0.f, 0.f}, (f32x4_t){0.f, 0.f, 0.f, 0.f}};
            {
                bf16x8_t bu[8];
#pragma unroll
                for (int nt = 0; nt < 2; ++nt) {
#pragma unroll
                    for (int ks = 0; ks < 8; ++ks) bu[ks] = *(const bf16x8_t*)(lds + RT_U + (16 * nt + fr) * RT_KS + ks * 64 + fq * 16);
#pragma unroll
                    for (int ks = 0; ks < 8; ++ks) ao[nt] = __builtin_amdgcn_mfma_f32_16x16x32_bf16(qa[ks], bu[ks], ao[nt], 0, 0, 0);
                }
            }
            bf16x8_t bv[2][4];
#pragma unroll
            for (int nt = 0; nt < 2; ++nt)
#pragma unroll
                for (int ks = 0; ks < 4; ++ks) bv[nt][ks] = *(const bf16x8_t*)(lds + RT_V + (16 * nt + fr) * RT_VS + ks * 64 + fq * 16);
#pragma unroll
            for (int ks = 0; ks < 4; ++ks)
#pragma unroll
                for (int nt = 0; nt < 2; ++nt) ao[nt] = __builtin_amdgcn_mfma_f32_16x16x32_bf16(pa[ks], bv[nt][ks], ao[nt], 0, 0, 0);
            if (c + 1 < 64) {
                const bf16_t* qp = q + (tok0 + 128 + 16 * w + fr) * 1024 + h * 256 + fq * 8;
#pragma unroll
                for (int ks = 0; ks < 8; ++ks) qa[ks] = *(const bf16x8_t*)(qp + ks * 32);
                const bf16_t* pp = P + (size_t)(bh * 64 + c + 1) * 16384 + (16 * w + fr) * 128 + fq * 8;
#pragma unroll
                for (int ks = 0; ks < 4; ++ks) pa[ks] = *(const bf16x8_t*)(pp + ks * 32);
            }
#pragma unroll
            for (int kh = 0; kh < 2; ++kh) {
                s16x4_t tk[2][2][2];
#pragma unroll
                for (int k2 = 0; k2 < 2; ++k2)
#pragma unroll
                    for (int di = 0; di < 2; ++di) {
                        const unsigned char* kp = lds + RT_K + (32 * (2 * kh + k2) + 8 * fq + (fr >> 2)) * RT_KS + (16 * (2 * w + di) + 4 * (fr & 3)) * 2;
                        tk[k2][di][0] = __builtin_amdgcn_ds_read_tr16_b64_v4i16((LAS s16x4_t*)(kp));
                        tk[k2][di][1] = __builtin_amdgcn_ds_read_tr16_b64_v4i16((LAS s16x4_t*)(kp + 4 * RT_KS));
                    }
#pragma unroll
                for (int k2 = 0; k2 < 2; ++k2)
#pragma unroll
                    for (int di = 0; di < 2; ++di) {
                        const bf16x8_t kb = (bf16x8_t){tk[k2][di][0][0], tk[k2][di][0][1], tk[k2][di][0][2], tk[k2][di][0][3], tk[k2][di][1][0], tk[k2][di][1][1], tk[k2][di][1][2], tk[k2][di][1][3]};
#pragma unroll
                        for (int et = 0; et < 2; ++et) accU[et][di] = __builtin_amdgcn_mfma_f32_16x16x32_bf16(bv[et][2 * kh + k2], kb, accU[et][di], 0, 0, 0);
                    }
            }
#pragma unroll
            for (int et = 0; et < 2; ++et)
#pragma unroll
                for (int di = 0; di < 2; ++di) accU[et][di] = accU[et][di] * g128;
            LDS_BARRIER();
            {
                bf16_t* vc = v + (tok0 + 16 * w + 4 * fq) * 2048 + h * 512 + sl * 32 + fr;
#pragma unroll
                for (int nt = 0; nt < 2; ++nt)
#pragma unroll
                    for (int j = 0; j < 4; ++j) vc[(size_t)j * 2048 + 16 * nt] = f2bf(ao[nt][j]);
#pragma unroll
                for (int et = 0; et < 2; ++et)
#pragma unroll
                    for (int di = 0; di < 2; ++di)
#pragma unroll
                        for (int j = 0; j < 4; ++j) *(bf16_t*)(lds + RT_U + (16 * et + 4 * fq + j) * RT_KS + (16 * (2 * w + di) + fr) * 2) = f2bf(accU[et][di][j]);
            }
        }
        __syncthreads();
    }
}
DEV void p_headnorm(bf16_t* ret, const bf16_t* g) {
    const int lane = threadIdx.x & 63;
    for (int w = (blockIdx.x * NTHR + threadIdx.x) >> 6; w < NTOK * 4; w += gridDim.x * (NTHR / 64)) {
        const size_t o = (size_t)w * 512 + lane * 8;
        const u32x4_t rv = *(const u32x4_t*)(ret + o), gv = *(const u32x4_t*)(g + o);
        float x[8], gg[8]; float s = 0.f;
#pragma unroll
        for (int j = 0; j < 4; ++j) { x[2 * j] = __uint_as_float(rv[j] << 16); x[2 * j + 1] = __uint_as_float(rv[j] & 0xffff0000u); gg[2 * j] = __uint_as_float(gv[j] << 16); gg[2 * j + 1] = __uint_as_float(gv[j] & 0xffff0000u); }
#pragma unroll
        for (int j = 0; j < 8; ++j) s += x[j];
#pragma unroll
        for (int m = 1; m < 64; m <<= 1) s += __shfl_xor(s, m);
        const float mu = s * (1.f / 512.f); float q = 0.f;
#pragma unroll
        for (int j = 0; j < 8; ++j) { x[j] -= mu; q += x[j] * x[j]; }
#pragma unroll
        for (int m = 1; m < 64; m <<= 1) q += __shfl_xor(q, m);
        const float rstd = rsqrtf(q * (1.f / 512.f) + LN_EPS);
        u32x4_t ov;
#pragma unroll
        for (int j = 0; j < 4; ++j) ov[j] = pg8::cvt_pk_bf16(x[2 * j] * rstd * gg[2 * j], x[2 * j + 1] * rstd * gg[2 * j + 1]);
        *(u32x4_t*)(ret + o) = ov;
    }
}

typedef float f32x4v __attribute__((ext_vector_type(4)));
DEV void p_ln1_route(float* lds, const bf16_t* y, bf16_t* x1b, const float* g1, const float* b1, const float* wg, const float* bg,
                     const float* we, const float* be, int2* route_e, float2* route_w, int* cnt, int* list, const float* sb) {
    const int wv = threadIdx.x >> 6, lane = threadIdx.x & 63, r16 = lane & 15, kq = lane >> 4;
    float* Wp = lds;
    float* Sc = lds + 1024 * 36;
    float* Bc = Sc + 48;
    int* lcnt = (int*)(Bc + 48);
    int* rowE = lcnt + 32;
    int* rowP = rowE + 256;
    for (int i = threadIdx.x; i < 1024 * 9; i += NTHR) { const int k = i / 9, c4 = i - k * 9; const float gk = g1[k];
        float4 w = (c4 < 8) ? *(const float4*)(we + (size_t)k * 32 + c4 * 4) : *(const float4*)(wg + (size_t)k * 4);
        w.x *= gk; w.y *= gk; w.z *= gk; w.w *= gk; *(float4*)(Wp + k * 36 + c4 * 4) = w; }
    if (threadIdx.x < 32) lcnt[threadIdx.x] = 0;
    __syncthreads();
    if (threadIdx.x < 96) Sc[threadIdx.x] = sb[threadIdx.x];
    __syncthreads();
    constexpr int rows_per_wg = 128;
    for (int blk = blockIdx.x; blk < NTOK / rows_per_wg; blk += gridDim.x) {
    { const int tile = wv;
        const int lrow0 = tile * 16, row0 = blk * rows_per_wg + lrow0;
        const bf16_t* yp = y + (size_t)(row0 + r16) * 1024 + 4 * kq;
        f32x4v acc[3] = {(f32x4v){0.f, 0.f, 0.f, 0.f}, (f32x4v){0.f, 0.f, 0.f, 0.f}, (f32x4v){0.f, 0.f, 0.f, 0.f}};
        float s1 = 0.f, s2 = 0.f; const float m2 = (r16 < 4) ? 1.f : 0.f;
#pragma unroll 8
        for (int t = 0; t < 64; ++t) {
            const uint2 yr = *(const uint2*)(yp + 16 * t); const float4 yv = make_float4(__uint_as_float(yr.x << 16), __uint_as_float(yr.x & 0xffff0000u), __uint_as_float(yr.y << 16), __uint_as_float(yr.y & 0xffff0000u));
            s1 += (yv.x + yv.y) + (yv.z + yv.w); s2 += (yv.x * yv.x + yv.y * yv.y) + (yv.z * yv.z + yv.w * yv.w);
            const float* wrow = Wp + (16 * t + 4 * kq) * 36 + r16;
            const float ye[4] = {yv.x, yv.y, yv.z, yv.w};
#pragma unroll
            for (int j = 0; j < 4; ++j)
#pragma unroll
                for (int nt = 0; nt < 3; ++nt) { const float wv = (nt < 2) ? wrow[j * 36 + 16 * nt] : wrow[j * 36 + 32 - (r16 & 12)] * m2;
                    acc[nt] = __builtin_amdgcn_mfma_f32_16x16x4f32(ye[j], wv, acc[nt], 0, 0, 0); }
        }
        s1 += __shfl_xor(s1, 16); s1 += __shfl_xor(s1, 32); s2 += __shfl_xor(s2, 16); s2 += __shfl_xor(s2, 32);
        const float mu = s1 * (1.f / 1024.f), rstd = rsqrtf(fmaxf(s2 * (1.f / 1024.f) - mu * mu, 0.f) + LN_EPS);
#pragma unroll 8
        for (int t = 0; t < 64; ++t) {
            const uint2 yr = *(const uint2*)(yp + 16 * t); const float4 yv = make_float4(__uint_as_float(yr.x << 16), __uint_as_float(yr.x & 0xffff0000u), __uint_as_float(yr.y << 16), __uint_as_float(yr.y & 0xffff0000u));
            const float4 gv = *(const float4*)(g1 + 16 * t + 4 * kq), bv = *(const float4*)(b1 + 16 * t + 4 * kq);
            const float4 o = make_float4((yv.x - mu) * rstd * gv.x + bv.x, (yv.y - mu) * rstd * gv.y + bv.y, (yv.z - mu) * rstd * gv.z + bv.z, (yv.w - mu) * rstd * gv.w + bv.w);
            uint2 ob; ob.x = pg8::cvt_pk_bf16(o.x, o.y); ob.y = pg8::cvt_pk_bf16(o.z, o.w);
            *(uint2*)(x1b + (size_t)(row0 + r16) * 1024 + 16 * t + 4 * kq) = ob;
        }
#pragma unroll
        for (int j = 0; j < 4; ++j) {
            const int rl = 4 * kq + j;
            const float mur = __shfl(mu, rl), rsr = __shfl(rstd, rl);
            float lg[3];
#pragma unroll
            for (int nt = 0; nt < 3; ++nt) lg[nt] = rsr * (acc[nt][j] - mur * Sc[16 * nt + r16]) + Bc[16 * nt + r16];
            const int gb = 16 * kq;
            const float g0 = __shfl(lg[2], gb + 0), g1v = __shfl(lg[2], gb + 1), g2 = __shfl(lg[2], gb + 2), g3 = __shfl(lg[2], gb + 3);
            int gi = 0; float gm = g0; if (g1v > gm) { gm = g1v; gi = 1; } if (g2 > gm) { gm = g2; gi = 2; } if (g3 > gm) { gm = g3; gi = 3; }
            const float gw = 1.f / (expf(g0 - gm) + expf(g1v - gm) + expf(g2 - gm) + expf(g3 - gm));
            const float lsel = (gi & 2) ? lg[1] : lg[0];
            float ev[8];
#pragma unroll
            for (int t = 0; t < 8; ++t) ev[t] = __shfl(lsel, gb + (gi & 1) * 8 + t);
            int i1 = 0; float v1 = ev[0];
#pragma unroll
            for (int t = 1; t < 8; ++t) if (ev[t] > v1) { v1 = ev[t]; i1 = t; }
            int i2 = -1; float v2 = -INFINITY;
#pragma unroll
            for (int t = 0; t < 8; ++t) if (t != i1 && ev[t] > v2) { v2 = ev[t]; i2 = t; }
            const float w1 = 1.f / (1.f + expf(v2 - v1)), w2 = 1.f - w1;
            if (r16 == 0) {
                const int lr = lrow0 + rl, r = row0 + rl, e1 = gi * 8 + i1, e2 = gi * 8 + i2;
                route_e[r] = make_int2(e1, e2); route_w[r] = make_float2(gw * w1, gw * w2);
                rowE[2 * lr] = e1; rowP[2 * lr] = atomicAdd(&lcnt[e1], 1);
                rowE[2 * lr + 1] = e2; rowP[2 * lr + 1] = atomicAdd(&lcnt[e2], 1);
            }
        }
    }
    __syncthreads();
    if (threadIdx.x < 32) lcnt[threadIdx.x] = atomicAdd(&cnt[threadIdx.x * 64], lcnt[threadIdx.x]);
    __syncthreads();
    for (int i = threadIdx.x; i < 2 * rows_per_wg; i += NTHR) { const int e = rowE[i]; list[e * 32768 + lcnt[e] + rowP[i]] = (blk * rows_per_wg + (i >> 1)) * 2 + (i & 1); }
    __syncthreads();
    if (threadIdx.x < 32) lcnt[threadIdx.x] = 0;
    __syncthreads();
    }
}

DEV void p_final(float* out, const bf16_t* x1b, const bf16_t* ys, const float* g2, const float* b2) {
    const int lane = threadIdx.x & 63;
    for (int r = (blockIdx.x * NTHR + threadIdx.x) >> 6; r < NTOK; r += gridDim.x * (NTHR / 64)) {
        float x[16]; float s = 0.f;
#pragma unroll
        for (int j = 0; j < 4; ++j) { const int col = j * 256 + lane * 4; const ushort4 tb = *(const ushort4*)(x1b + (size_t)r * 1024 + col); const float4 t = make_float4(bf2f(tb.x), bf2f(tb.y), bf2f(tb.z), bf2f(tb.w));
            const ushort4 a = *(const ushort4*)(ys + (size_t)(2 * r) * 1024 + col), b = *(const ushort4*)(ys + (size_t)(2 * r + 1) * 1024 + col);
            x[4 * j] = ALPHA * t.x + bf2f(a.x) + bf2f(b.x); x[4 * j + 1] = ALPHA * t.y + bf2f(a.y) + bf2f(b.y); x[4 * j + 2] = ALPHA * t.z + bf2f(a.z) + bf2f(b.z); x[4 * j + 3] = ALPHA * t.w + bf2f(a.w) + bf2f(b.w);
            s += (x[4 * j] + x[4 * j + 1]) + (x[4 * j + 2] + x[4 * j + 3]); }
#pragma unroll
        for (int m = 1; m < 64; m <<= 1) s += __shfl_xor(s, m);
        const float mu = s * (1.f / 1024.f); float q = 0.f;
#pragma unroll
        for (int j = 0; j < 16; ++j) { x[j] -= mu; q += x[j] * x[j]; }
#pragma unroll
        for (int m = 1; m < 64; m <<= 1) q += __shfl_xor(q, m);
        const float rstd = rsqrtf(q * (1.f / 1024.f) + LN_EPS);
#pragma unroll
        for (int j = 0; j < 4; ++j) { const int col = j * 256 + lane * 4; const float4 gg = *(const float4*)(g2 + col), bb = *(const float4*)(b2 + col);
            *(float4*)(out + (size_t)r * 1024 + col) = make_float4(x[4 * j] * rstd * gg.x + bb.x, x[4 * j + 1] * rstd * gg.y + bb.y, x[4 * j + 2] * rstd * gg.z + bb.z, x[4 * j + 3] * rstd * gg.w + bb.w); }
    }
}

struct Args { const float* in[24]; float* out; unsigned char* ws; };
__global__ void __launch_bounds__(NTHR, 2) mega_fwd(Args a) {
    extern __shared__ __attribute__((aligned(16))) unsigned char lds_raw[];
    float* ldsf = (float*)lds_raw;
    PG8_LAS unsigned char* ldsl = (PG8_LAS unsigned char*)lds_raw;
    volatile LAS unsigned* MISC = (volatile LAS unsigned*)((LAS unsigned char*)lds_raw + LDS_MISC);
    for (int u = threadIdx.x; u < 128; u += NTHR) MISC[u] = 0u;
    __syncthreads();
    unsigned char* ws = a.ws;
    XcdBarrier bar = xcd_barrier_post((unsigned*)(ws + WS_CTL) + CW_BAR, MISC + 8);
#define GRID_BAR() xcd_barrier(bar)
    const float* x = a.in[0]; const float* w_in = a.in[1]; const float* b_merge = a.in[2];
    const float* conv_w = a.in[3]; const float* conv_b = a.in[4];
    const float* w_rg_r = a.in[5]; const float* b_rg_r = a.in[6]; const float* w_rg_i = a.in[7]; const float* b_rg_i = a.in[8];
    const float* lam = a.in[9]; const float* w_ret_o = a.in[10]; const float* w_lru_o = a.in[11]; const float* w_out = a.in[12];
    const float* ln1_g = a.in[13]; const float* ln1_b = a.in[14]; const float* w_group = a.in[15]; const float* b_group = a.in[16];
    const float* w_er = a.in[17]; const float* b_er = a.in[18]; const float* w_eg = a.in[19]; const float* w_eu = a.in[20];
    const float* w_ed = a.in[21]; const float* ln2_g = a.in[22]; const float* ln2_b = a.in[23];
    float* out = a.out;
    int* cnt = (int*)(ws + WS_CTL); float2* rope = (float2*)(ws + WS_ROPE); int2* route_e = (int2*)(ws + WS_ROUTE_E); float2* route_w = (float2*)(ws + WS_ROUTE_W); int* list = (int*)(ws + WS_LIST);
    bf16_t* xb = (bf16_t*)(ws + WS_XB); bf16_t* gl = (bf16_t*)(ws + WS_GL); bf16_t* ulru = (bf16_t*)(ws + WS_ULRU); bf16_t* uconv = (bf16_t*)(ws + WS_UCONV);
    bf16_t* epsb = (bf16_t*)(ws + WS_EPS); bf16_t* inp = (bf16_t*)out;
    bf16_t* q = (bf16_t*)(ws + WS_Q); bf16_t* k = (bf16_t*)(ws + WS_K); bf16_t* v = (bf16_t*)(ws + WS_V); bf16_t* gbuf = (bf16_t*)out;
    bf16_t* P = (bf16_t*)(ws + WS_P); bf16_t* gates = (bf16_t*)(ws + WS_GATES); bf16_t* m1 = (bf16_t*)out; bf16_t* merged = xb;
    bf16_t* w_in_t = (bf16_t*)(ws + WS_WIN_T); bf16_t* w_ro_t = (bf16_t*)(ws + WS_WRO_T); bf16_t* w_lo_t = (bf16_t*)(ws + WS_WLO_T); bf16_t* w_out_t = (bf16_t*)(ws + WS_WOUT_T);
    bf16_t* wrg_t = (bf16_t*)(ws + WS_WRG_T); float* segA = (float*)(ws + WS_SEGA); float* segH = (float*)(ws + WS_SEGH); float* carry = (float*)(ws + WS_CARRY);
    float* rsb = (float*)(ws + WS_RSB);
    bf16_t* wgu_t = (bf16_t*)(ws + WS_WGU_T); bf16_t* wd_t = (bf16_t*)(ws + WS_WD_T);
    bf16_t* x1b = gl; bf16_t* hbuf = (bf16_t*)(ws + WS_H); bf16_t* ys = (bf16_t*)(ws + WS_YSLOT);

    p_router_consts(ldsf, ln1_g, ln1_b, w_group, b_group, w_er, b_er, rsb); p_cvt_x(x, xb); p_rope_table(rope); p_weights(ldsf, w_in, w_ret_o, w_lru_o, w_out, w_rg_r, w_rg_i, w_in_t, w_ro_t, w_lo_t, w_out_t, wrg_t);
    GRID_BAR();
    { pg8::Gemm g{xb, w_in_t + (size_t)C_U * 1024, NTOK, 3072, 1024}; pg8::StaticOrder S; S.init(NTOK, 3072, (int)gridDim.x, (int)blockIdx.x);
      pg8::gemm_phase<pg8::EpiLruIn, pg8::StaticOrder, true, true>(ldsl, g, S, pg8::EpiLruIn{ulru, gl}); }
    GRID_BAR();
    p_lru_compute(lds_raw, ulru, conv_w, conv_b, wrg_t, b_rg_r, b_rg_i, lam, uconv, epsb, segA, segH);
    GRID_BAR();
    p_lru_carry(ldsf, segA, segH, carry);
    GRID_BAR();
    p_lru_scan(uconv, epsb, gl, carry);
    GRID_BAR();
    { pg8::Gemm g{xb, w_in_t, NTOK, 6144, 1024}; pg8::StaticOrder S; S.init(NTOK, 6144, (int)gridDim.x, (int)blockIdx.x);
      pg8::gemm_phase<pg8::EpiRetIn, pg8::StaticOrder, true, true>(ldsl, g, S, pg8::EpiRetIn{q, k, v, gbuf, (const float*)rope}); }
    GRID_BAR();
    p_scores(lds_raw, q, k, P);
    GRID_BAR();
    p_ret_mfma(lds_raw, q, k, v, P);
    GRID_BAR();
    p_headnorm(v, gbuf);
    { pg8::Gemm g{xb, w_in_t + (size_t)C_GATE * 1024, NTOK, 2048, 1024}; pg8::StaticOrder S; S.init(NTOK, 2048, (int)gridDim.x, (int)blockIdx.x);
      pg8::gemm_phase<pg8::EpiGates, pg8::StaticOrder, true, true>(ldsl, g, S, pg8::EpiGates{b_merge, gates}); }
    GRID_BAR();
    { pg8::Gemm g{v, w_ro_t, NTOK, 1024, 2048}; pg8::StaticOrder S; S.init(NTOK, 1024, (int)gridDim.x, (int)blockIdx.x);
      pg8::gemm_phase<pg8::EpiMerge<0>, pg8::StaticOrder, true, true>(ldsl, g, S, pg8::EpiMerge<0>{gates, nullptr, m1}); }
    GRID_BAR();
    { pg8::Gemm g{gl, w_lo_t, NTOK, 1024, 1536}; pg8::StaticOrder S; S.init(NTOK, 1024, (int)gridDim.x, (int)blockIdx.x);
      pg8::gemm_phase<pg8::EpiMerge<1>, pg8::StaticOrder, true, true>(ldsl, g, S, pg8::EpiMerge<1>{gates, m1, merged}); }
    GRID_BAR();
    { pg8::Gemm g{merged, w_out_t, NTOK, 1024, 1024}; pg8::StaticOrder S; S.init(NTOK, 1024, (int)gridDim.x, (int)blockIdx.x);
      pg8::gemm_phase<pg8::EpiOut, pg8::StaticOrder, true, true>(ldsl, g, S, pg8::EpiOut{x, (bf16_t*)out, ALPHA}); }
    GRID_BAR();
    p_ln1_route(ldsf, (const bf16_t*)out, x1b, ln1_g, ln1_b, w_group, b_group, w_er, b_er, route_e, route_w, cnt, list, rsb);
    p_expert_weights(ldsf, w_eg, w_eu, w_ed, wgu_t, wd_t);
    GRID_BAR();
    {
        PG8_LAS pg8::MoeTab* tab = (PG8_LAS pg8::MoeTab*)(ldsl + LDS_TAB);
        pg8::moe_build_tab(tab, cnt);
        const int T = tab->tileStart[32];
        { pg8::Gemm g{x1b, wgu_t, T * 256, 32 * 1024, 1024}; pg8::MoeOrder<true> S{T * 4, (int)gridDim.x, (int)blockIdx.x, tab, list};
          pg8::gemm_phase<pg8::EpiSwiGLU, pg8::MoeOrder<true>, true, true>(ldsl, g, S, pg8::EpiSwiGLU{hbuf}); }
        GRID_BAR();
        { pg8::Gemm g{hbuf, wd_t, T * 256, 32 * 1024, 512}; pg8::MoeOrder<false> S{T * 4, (int)gridDim.x, (int)blockIdx.x, tab, list};
          pg8::gemm_phase<pg8::EpiMoeOut, pg8::MoeOrder<false>, true, true>(ldsl, g, S, pg8::EpiMoeOut{tab, list, (const float*)route_w, ys}); }
    }
    GRID_BAR();
    p_final(out, x1b, ys, ln2_g, ln2_b);
}

extern "C" void kernel_launch(void* const* d_in, const int* in_sizes, int n_in, void* d_out, int out_size, void* d_ws, size_t ws_size, hipStream_t stream) {
    static int grid = 0;
    if (grid == 0) {
        if (n_in != 24 || in_sizes[0] != NTOK * DM || out_size != NTOK * DM || ws_size < WS_END) {
            fprintf(stderr, "kernel_launch: unexpected shapes (n_in %d, in0 %d, out %d, ws %zu)\n", n_in, n_in > 0 ? in_sizes[0] : -1, out_size, ws_size); grid = -1; return; }
        int dev = 0, cus = 0, per_cu = 0;
        if (hipGetDevice(&dev) != hipSuccess || hipDeviceGetAttribute(&cus, hipDeviceAttributeMultiprocessorCount, dev) != hipSuccess) { fprintf(stderr, "kernel_launch: device query failed\n"); grid = -1; return; }
        if (hipFuncSetAttribute((const void*)mega_fwd, hipFuncAttributeMaxDynamicSharedMemorySize, LDS_BYTES) != hipSuccess) { fprintf(stderr, "kernel_launch: hipFuncSetAttribute failed\n"); grid = -1; return; }
        if (hipOccupancyMaxActiveBlocksPerMultiprocessor(&per_cu, (const void*)mega_fwd, NTHR, LDS_BYTES) != hipSuccess || per_cu < 1) {
            fprintf(stderr, "kernel_launch: occupancy query reports %d workgroups per CU\n", per_cu); (void)hipGetLastError(); grid = -1; return; }
        grid = cus;
    }
    if (grid < 0) return;
    if (hipMemsetAsync((char*)d_ws + WS_CTL, 0, CTL_ZERO_BYTES, stream) != hipSuccess) { fprintf(stderr, "kernel_launch: memset failed\n"); return; }
    Args a{};
    for (int i = 0; i < 24; ++i) a.in[i] = (const float*)d_in[i];
    a.out = (float*)d_out; a.ws = (unsigned char*)d_ws;
    hipLaunchKernelGGL(mega_fwd, dim3(grid), dim3(NTHR), LDS_BYTES, stream, a);
    const hipError_t le = hipPeekAtLastError();
    if (le != hipSuccess) fprintf(stderr, "kernel_launch: launch failed: %s\n", hipGetErrorName(le));
}
```

```cpp
#include <hip/hip_runtime.h>
#include <cstdio>
#include <cstdint>

typedef unsigned short bf16_t;
#define DEV __device__ __forceinline__
#define LAS __attribute__((address_space(3)))

DEV float bf2f(bf16_t h) { return __uint_as_float(((unsigned)h) << 16); }
DEV bf16_t f2bf(float f) { unsigned u = __float_as_uint(f); return (bf16_t)((u + 0x7fffu + ((u >> 16) & 1u)) >> 16); }

constexpr int NTHR = 512;
constexpr int NTOK = 32768, DM = 1024, SEQ = 8192;
constexpr int WIN_N = 11264;
constexpr int C_Q = 0, C_K = 1024, C_V = 2048, C_G = 4096, C_U = 6144, C_GL = 7680, C_GATE = 9216;
constexpr float ALPHA = 1.189207115002721f;
constexpr float LN_EPS = 1e-5f;
constexpr size_t MiB = 1u << 20;
constexpr size_t WS_CTL = 0;
constexpr size_t CTL_ZERO_BYTES = 1 * MiB;
constexpr int CW_BAR = 4096;
constexpr size_t WS_ROPE = 1 * MiB;
constexpr size_t WS_ROUTE_E = 9 * MiB;
constexpr size_t WS_ROUTE_W = 9 * MiB + 512 * 1024;
constexpr size_t WS_LIST = 10 * MiB;
constexpr size_t WS_WRG_T = 14 * MiB;
constexpr size_t WS_RSB = 15 * MiB + 512 * 1024;
constexpr size_t WS_SEGA = 16 * MiB;
constexpr size_t WS_SEGH = 18 * MiB;
constexpr size_t WS_CARRY = 20 * MiB;
constexpr size_t WS_XB = 32 * MiB;
constexpr size_t WS_GL = 96 * MiB;
constexpr size_t WS_ULRU = 192 * MiB;
constexpr size_t WS_Q = 192 * MiB;
constexpr size_t WS_K = 256 * MiB;
constexpr size_t WS_GATES = 192 * MiB;
constexpr size_t WS_UCONV = 288 * MiB;
constexpr size_t WS_P = 320 * MiB;
constexpr size_t WS_V = 352 * MiB;
constexpr size_t WS_EPS = 384 * MiB;
constexpr size_t WS_H = 192 * MiB;
constexpr size_t WS_YSLOT = 264 * MiB;
constexpr size_t WS_WGU_T = 352 * MiB;
constexpr size_t WS_WD_T = 416 * MiB;
constexpr size_t WS_X1Q = 160 * MiB;
constexpr int LDS_TAB = 131072;
constexpr size_t WS_WIN_T = 480 * MiB;
constexpr size_t WS_WRO_T = 502 * MiB;
constexpr size_t WS_WLO_T = 506 * MiB;
constexpr size_t WS_WOUT_T = 509 * MiB;
constexpr size_t WS_END = 512 * MiB;
constexpr int LDS_BYTES = 163840;
constexpr int LDS_MISC = 163840 - 512;

#define XB_TMO      128
#define XB_XCNT(j)  (256  + 64 * (j))
#define XB_XSUB(j)  (1280 + 64 * (j))
#define XB_XGEN(j)  (2304 + 64 * (j))
#define XB_TOP      3328
#define XB_TOPGEN   3392
#define XCD_BAR_WORDS 3456
#define XB_SPIN_CAP (1u << 22)
DEV unsigned xb_ld(unsigned* p)              { return __hip_atomic_load(p, __ATOMIC_RELAXED, __HIP_MEMORY_SCOPE_AGENT); }
DEV unsigned xb_add(unsigned* p, unsigned v) { return __hip_atomic_fetch_add(p, v, __ATOMIC_RELAXED, __HIP_MEMORY_SCOPE_AGENT); }
DEV unsigned xb_xcc_id() { return (unsigned)__builtin_amdgcn_s_getreg((3 << 11) | 20) & 0xFu; }
#define XB_SPIN(cond, bar) do { unsigned _sp = 0; while (cond) { __builtin_amdgcn_s_sleep(1); \
    if ((++_sp & 255u) == 0u) { if (xb_ld(&(bar)[XB_TMO])) break; if (_sp > XB_SPIN_CAP) { atomicAdd(&(bar)[XB_TMO], 1u); break; } } } } while (0)
struct XcdBarrier { unsigned* bar; unsigned x; volatile LAS unsigned* st; };
DEV XcdBarrier xcd_barrier_post(unsigned* bar, volatile LAS unsigned* st) {
    XcdBarrier b; b.bar = bar; b.x = xb_xcc_id(); b.st = st;
    if (threadIdx.x == 0) (void)xb_add(&bar[XB_XCNT(b.x)], 1u);
    return b;
}
DEV void xcd_barrier_complete(unsigned* bar, unsigned x, unsigned& nloc, unsigned& nx) {
    const unsigned G = gridDim.x * gridDim.y * gridDim.z;
    unsigned sum, cnt, mine, sp = 0u;
    for (;;) {
        sum = 0u; cnt = 0u; mine = 0u;
#pragma unroll
        for (unsigned j = 0; j < 16; ++j) { const unsigned c = xb_ld(&bar[XB_XCNT(j)]); sum += c; cnt += (c > 0u) ? 1u : 0u; mine = (j == x) ? c : mine; }
        if (sum == G) break;
        __builtin_amdgcn_s_sleep(1);
        if ((++sp & 255u) == 0u) { if (xb_ld(&bar[XB_TMO])) break; if (sp > XB_SPIN_CAP) { atomicAdd(&bar[XB_TMO], 1u); break; } }
    }
    nloc = mine > 0u ? mine : 1u; nx = cnt > 0u ? cnt : 1u;
}
DEV void xcd_barrier(const XcdBarrier& b) {
    asm volatile("s_waitcnt vmcnt(0)" ::: "memory");
    __syncthreads();
    if (threadIdx.x == 0) {
        unsigned* bar = b.bar;
        __builtin_amdgcn_s_waitcnt(0);
        unsigned nloc = b.st[0], nx = b.st[1];
        if (nloc == 0u) { xcd_barrier_complete(bar, b.x, nloc, nx); b.st[0] = nloc; b.st[1] = nx; }
        const unsigned old = xb_add(&bar[XB_XSUB(b.x)], 1u);
        const unsigned gen = old / nloc;
        if (old + 1u == (gen + 1u) * nloc) {
            __builtin_amdgcn_fence(__ATOMIC_RELEASE, "agent");
            asm volatile("s_waitcnt vmcnt(0)" ::: "memory");
            const unsigned og = xb_add(&bar[XB_TOP], 1u);
            const unsigned tg = og / nx;
            if (og + 1u == (tg + 1u) * nx) xb_add(&bar[XB_TOPGEN], 1u);
            else XB_SPIN(xb_ld(&bar[XB_TOPGEN]) == tg, bar);
            __builtin_amdgcn_fence(__ATOMIC_ACQUIRE, "agent");
            xb_add(&bar[XB_XGEN(b.x)], 1u);
            asm volatile("s_waitcnt vmcnt(0)" ::: "memory");
        } else {
            XB_SPIN(xb_ld(&bar[XB_XGEN(b.x)]) == gen, bar);
            __builtin_amdgcn_fence(__ATOMIC_ACQUIRE, "agent");
            asm volatile("s_waitcnt vmcnt(0)" ::: "memory");
        }
    }
    __syncthreads();
}

namespace pg8 {
#define PG8_LAS __attribute__((address_space(3)))
typedef unsigned short bf16_t;
typedef short bf16x8 __attribute__((ext_vector_type(8)));
typedef float f32x4 __attribute__((ext_vector_type(4)));
typedef unsigned u32x4 __attribute__((ext_vector_type(4)));
constexpr int BM = 256, BK = 64, HALF = 128, HTB = HALF * BK * 2  , STAGE_BYTES = 8 * HTB, NXCD = 8, WGM = 8;

__host__ __device__ __forceinline__ int lds_byte(int r, int c) { const int st = (r >> 4) * 2 + (c >> 5), rr = r & 15, cc = c & 31, ob = rr * 64 + cc * 2; return st * 1024 + (ob ^ (((ob >> 9) & 1) << 5)); }
__host__ __device__ __forceinline__ void stage_rc(int b, int& R, int& C) { const int st = b / 1024, sb = b % 1024, swz = sb ^ (((sb >> 9) & 1) << 5); R = (st >> 1) * 16 + swz / 64; C = (st & 1) * 32 + (swz % 64) / 2; }
__host__ __device__ __forceinline__ int perm32(int rho) { const int n = rho >> 4, i = rho & 15; return 8 * (i >> 2) + 4 * n + (i & 3); }

struct Unit { int pm, pn; };
struct Gemm { const bf16_t* A; const bf16_t* Bt; int M, N, K; };

struct StaticOrder {
    int nM, nN, nwg, G, c;
    __host__ __device__ void init(int M, int N, int G_, int c_) { nM = M / BM; nN = N / BM; nwg = nM * nN; G = G_; c = c_; }
    __host__ __device__ bool next(int i, Unit& u) const {
        const long L = (long)i * G + c; if (L >= nwg) return false;
        int wgid = (int)L; { const int q = nwg / NXCD, r = nwg % NXCD, xcd = wgid % NXCD, off = wgid / NXCD; wgid = (xcd < r ? xcd * (q + 1) : r * (q + 1) + (xcd - r) * q) + off; }
        const int nig = WGM * nN, gid = wgid / nig, fm = gid * WGM, gsz = (nM - fm) < WGM ? (nM - fm) : WGM;
        u.pm = fm + ((wgid % nig) % gsz); u.pn = (wgid % nig) / gsz; return true;
    }
    __device__ __forceinline__ void a_ready(const Unit&) const {}
    __device__ __forceinline__ void done(const Unit&) const {}
    __device__ __forceinline__ const char* a_base(const Gemm& g, const Unit& u) const { return (const char*)g.A + (size_t)u.pm * (size_t)(BM * g.K * 2); }
    __device__ __forceinline__ void a_off(const Gemm& g, const Unit&, const int (&R)[2], const int (&C)[2], unsigned (&v)[2][2]) const {
        _Pragma("unroll") for (int hh = 0; hh < 2; ++hh) _Pragma("unroll") for (int i = 0; i < 2; ++i) v[hh][i] = (unsigned)((hh * HALF + R[i]) * g.K + C[i]) * 2u; }
};
typedef __bf16 bf16x2_t __attribute__((ext_vector_type(2)));
typedef float f32x2_t __attribute__((ext_vector_type(2)));
__device__ __forceinline__ unsigned cvt_pk_bf16(float lo, float hi) { f32x2_t v = {lo, hi}; return __builtin_bit_cast(unsigned, __builtin_convertvector(v, bf16x2_t)); }
typedef int i32x4 __attribute__((ext_vector_type(4)));
typedef int i32x8 __attribute__((ext_vector_type(8)));
template <bool MX8> struct Frag { struct A4 { bf16x8 v[4][2]; }; struct B2 { bf16x8 v[2][2]; }; };
template <> struct Frag<true> { struct A4 { i32x8 v[4]; }; struct B2 { i32x8 v[2]; }; };
__device__ __forceinline__ i32x8 ld32(const PG8_LAS unsigned char* p0, const PG8_LAS unsigned char* p1) { const i32x4 a = *(const PG8_LAS i32x4*)p0, b = *(const PG8_LAS i32x4*)p1; return __builtin_shufflevector(a, b, 0, 1, 2, 3, 4, 5, 6, 7); }
template <class Epi, class Sched, bool ALIGN_EPI = false, bool SP2 = false, bool MX8 = false>
__device__ __forceinline__ void gemm_phase(PG8_LAS unsigned char* lds, const Gemm g, const Sched& S, const Epi& E) {
    int tid_ = threadIdx.x; asm volatile("" : "+v"(tid_));
    const int tid = tid_, wid = __builtin_amdgcn_readfirstlane(tid >> 6), lane = tid & 63, wr = wid >> 2, wc = wid & 3, fr = lane & 15, fq = lane >> 4;
    const int K = g.K, nt = K / BK;
    unsigned voffB[2], vA[2][2], vN[2][2]; int sR[2], sC[2];
#pragma unroll
    for (int i = 0; i < 2; ++i) { int R, C; stage_rc(tid * 16 + i * 8192, R, C); const int Rb = Epi::PERM ? ((R & ~31) + perm32(R & 31)) : R;
        sR[i] = R; sC[i] = C; voffB[i] = (unsigned)(Rb * K + C) * 2u; }
    const size_t kstep = (size_t)(BK * 2);
    const size_t hstep = (size_t)HALF * K * 2;
    const size_t tstep = 2 * hstep;
    const unsigned ldsw = (unsigned)wid * 1024u;
    const int aoff = lds_byte(wr * 64 + fr, fq * 8), boff = lds_byte(wc * 32 + fr, fq * 8);
#define PG8_SA(b, h) (((b) * 2 + (h)) * HTB)
#define PG8_SB(b, h) ((4 + (b) * 2 + (h)) * HTB)
#define PG8_STAGE(bufoff, gbase, voff) do { _Pragma("unroll") for (int _i = 0; _i < 2; ++_i) \
        __builtin_amdgcn_global_load_lds((const unsigned*)((const char*)(gbase) + (voff)[_i]), (PG8_LAS unsigned*)(lds + (bufoff) + ldsw + _i * 8192), 16, 0, 0); } while (0)
#define PG8_LDA(dst, b, h) do { if constexpr (MX8) { _Pragma("unroll") for (int m = 0; m < 4; ++m) dst.v[m] = ld32(lds + PG8_SA(b, h) + aoff + m * 2048, lds + PG8_SA(b, h) + aoff + m * 2048 + 1024); } \
        else { _Pragma("unroll") for (int m = 0; m < 4; ++m) _Pragma("unroll") for (int k = 0; k < 2; ++k) dst.v[m][k] = *(const PG8_LAS bf16x8*)(lds + PG8_SA(b, h) + aoff + m * 2048 + k * 1024); } } while (0)
#define PG8_LDB(dst, b, h) do { if constexpr (MX8) { _Pragma("unroll") for (int n = 0; n < 2; ++n) dst.v[n] = ld32(lds + PG8_SB(b, h) + boff + n * 2048, lds + PG8_SB(b, h) + boff + n * 2048 + 1024); } \
        else { _Pragma("unroll") for (int n = 0; n < 2; ++n) _Pragma("unroll") for (int k = 0; k < 2; ++k) dst.v[n][k] = *(const PG8_LAS bf16x8*)(lds + PG8_SB(b, h) + boff + n * 2048 + k * 1024); } } while (0)
#define PG8_MMA(ai, bj, At, Bt) do { __builtin_amdgcn_s_setprio(1); \
        if constexpr (MX8) { _Pragma("unroll") for (int m = 0; m < 4; ++m) _Pragma("unroll") for (int n = 0; n < 2; ++n) \
            { acc[ai][bj][m][n] = __builtin_amdgcn_mfma_scale_f32_16x16x128_f8f6f4(Bt.v[n], At.v[m], acc[ai][bj][m][n], 0, 0, 0, 0x7f7f7f7f, 0, 0x7f7f7f7f); asm volatile("" : "+v"(acc[ai][bj][m][n])); } } \
        else { _Pragma("unroll") for (int m = 0; m < 4; ++m) _Pragma("unroll") for (int n = 0; n < 2; ++n) _Pragma("unroll") for (int k = 0; k < 2; ++k) \
            acc[ai][bj][m][n] = __builtin_amdgcn_mfma_f32_16x16x32_bf16(Bt.v[n][k], At.v[m][k], acc[ai][bj][m][n], 0, 0, 0); } \
        __builtin_amdgcn_s_setprio(0); } while (0)
#define PG8_WAIT_V(n) asm volatile("s_waitcnt vmcnt(" #n ")" ::: "memory")
#define PG8_WAIT_L(n) asm volatile("s_waitcnt lgkmcnt(" #n ")" ::: "memory")
#define PG8_BAR __builtin_amdgcn_s_barrier()
#define PG8_SCHED __builtin_amdgcn_sched_barrier(0)
    Unit cur, nxt; int ui = 0;
    if (!S.next(0, cur)) return;
    f32x4 acc[2][2][4][2];
#pragma unroll
    for (int a = 0; a < 2; ++a)
#pragma unroll
        for (int b = 0; b < 2; ++b)
#pragma unroll
            for (int m = 0; m < 4; ++m)
#pragma unroll
                for (int n = 0; n < 2; ++n) acc[a][b][m][n] = (f32x4){0.f, 0.f, 0.f, 0.f};
    typename Frag<MX8>::A4 At; typename Frag<MX8>::B2 B0, B1;
    const char* cA = S.a_base(g, cur); const char* cB = (const char*)g.Bt + (size_t)cur.pn * tstep;
    S.a_ready(cur); S.a_off(g, cur, sR, sC, vA);
    if constexpr (SP2) {
        PG8_STAGE(PG8_SB(0, 0), cB, voffB); PG8_STAGE(PG8_SB(0, 1), cB + hstep, voffB); PG8_STAGE(PG8_SA(0, 0), cA, vA[0]); PG8_STAGE(PG8_SA(0, 1), cA, vA[1]);
        if (wr == 1) PG8_BAR;
        PG8_WAIT_V(2); PG8_BAR;
        PG8_STAGE(PG8_SB(1, 0), cB + kstep, voffB); PG8_STAGE(PG8_SA(1, 0), cA + kstep, vA[0]); PG8_STAGE(PG8_SB(1, 1), cB + hstep + kstep, voffB);
        PG8_WAIT_V(6); PG8_BAR;
    } else { static_assert(SP2, "only the SP2 K-loop is kept in this file"); }
    for (;;) {
        const bool has_next = S.next(ui + 1, nxt);
        const char* nA = has_next ? S.a_base(g, nxt) : cA; const char* nB = has_next ? (const char*)g.Bt + (size_t)nxt.pn * tstep : cB;
        if (has_next) S.a_off(g, nxt, sR, sC, vN); else { vN[0][0] = vA[0][0]; vN[0][1] = vA[0][1]; vN[1][0] = vA[1][0]; vN[1][1] = vA[1][1]; }
#pragma unroll 1
        for (int t = 0; t < nt; t += 2) {
            const bool last = (t == nt - 2);
            const char* a1 = cA + (size_t)(t + 1) * kstep;
            const char* a2 = last ? nA : cA + (size_t)(t + 2) * kstep; const char* b2 = last ? nB : cB + (size_t)(t + 2) * kstep;
            const char* a3 = a2 + kstep; const char* b3 = b2 + kstep;
            unsigned v2[2][2]; v2[0][0] = last ? vN[0][0] : vA[0][0]; v2[0][1] = last ? vN[0][1] : vA[0][1]; v2[1][0] = last ? vN[1][0] : vA[1][0]; v2[1][1] = last ? vN[1][1] : vA[1][1];
            if (last && has_next) S.a_ready(nxt);
            if constexpr (SP2) {
            PG8_LDB(B0, 0, 0); PG8_LDB(B1, 0, 1); PG8_SCHED; PG8_LDA(At, 0, 0); PG8_STAGE(PG8_SA(1, 1), a1, vA[1]);
            PG8_WAIT_V(8); PG8_WAIT_L(0); PG8_BAR; PG8_MMA(0, 0, At, B0); PG8_MMA(0, 1, At, B1); PG8_BAR; PG8_SCHED;
            PG8_LDA(At, 0, 1); PG8_STAGE(PG8_SB(0, 0), b2, voffB); PG8_STAGE(PG8_SB(0, 1), b2 + hstep, voffB); PG8_STAGE(PG8_SA(0, 0), a2, v2[0]);
            PG8_WAIT_V(8); PG8_WAIT_L(0); PG8_BAR; PG8_MMA(1, 0, At, B0); PG8_MMA(1, 1, At, B1); PG8_BAR; PG8_SCHED;
            PG8_LDB(B0, 1, 0); PG8_LDB(B1, 1, 1); PG8_SCHED; PG8_LDA(At, 1, 0); PG8_STAGE(PG8_SA(0, 1), a2, v2[1]);
            PG8_WAIT_V(8); PG8_WAIT_L(0); PG8_BAR; PG8_MMA(0, 0, At, B0); PG8_MMA(0, 1, At, B1); PG8_BAR; PG8_SCHED;
            PG8_LDA(At, 1, 1); PG8_STAGE(PG8_SB(1, 0), b3, voffB); PG8_STAGE(PG8_SB(1, 1), b3 + hstep, voffB); PG8_STAGE(PG8_SA(1, 0), a3, v2[0]);
            PG8_WAIT_V(8); PG8_WAIT_L(0); PG8_BAR; PG8_MMA(1, 0, At, B0); PG8_MMA(1, 1, At, B1); PG8_BAR; PG8_SCHED;
            }
        }
        if constexpr (ALIGN_EPI) { if (wr == 0) PG8_BAR; }
        if constexpr (!Epi::AFTER_DRAIN) { E(acc, cur, wr, wc, fr, fq); S.done(cur); }
        if (!has_next) break;
#pragma unroll
        for (int a = 0; a < 2; ++a)
#pragma unroll
            for (int b = 0; b < 2; ++b)
#pragma unroll
                for (int m = 0; m < 4; ++m)
#pragma unroll
                    for (int n = 0; n < 2; ++n) acc[a][b][m][n] = (f32x4){0.f, 0.f, 0.f, 0.f};
        cur = nxt; cA = nA; cB = nB; ++ui; vA[0][0] = vN[0][0]; vA[0][1] = vN[0][1]; vA[1][0] = vN[1][0]; vA[1][1] = vN[1][1];
        if constexpr (ALIGN_EPI) { if (wr == 1) PG8_BAR; }
    }
    PG8_WAIT_V(0);
    if constexpr (!ALIGN_EPI) { if (wr == 0) PG8_BAR; }
    PG8_BAR;
    if constexpr (Epi::AFTER_DRAIN) { E.fused(acc, cur, wr, wc, fr, fq, lds, wid, lane); S.done(cur); }
#undef PG8_SA
#undef PG8_SB
#undef PG8_STAGE
#undef PG8_LDA
#undef PG8_LDB
#undef PG8_MMA
#undef PG8_WAIT_V
#undef PG8_WAIT_L
#undef PG8_BAR
#undef PG8_SCHED
}

__device__ __forceinline__ float fsig(float x) { return __builtin_amdgcn_rcpf(1.f + __expf(-x)); }
__device__ __forceinline__ float fsilu(float x) { return x * fsig(x); }
__device__ __forceinline__ float fgelu(float x) { return x * fsig(1.5957691216057308f * (x + 0.044715f * x * x * x)); }
__device__ __forceinline__ u32x4 pack8(const f32x4& v0, const f32x4& v1) { u32x4 w; w.x = cvt_pk_bf16(v0[0], v0[1]); w.y = cvt_pk_bf16(v0[2], v0[3]); w.z = cvt_pk_bf16(v1[0], v1[1]); w.w = cvt_pk_bf16(v1[2], v1[3]); return w; }
__device__ __forceinline__ void unpack8(const u32x4& w, f32x4& v0, f32x4& v1) {
    v0[0] = __uint_as_float(w.x << 16); v0[1] = __uint_as_float(w.x & 0xffff0000u); v0[2] = __uint_as_float(w.y << 16); v0[3] = __uint_as_float(w.y & 0xffff0000u);
    v1[0] = __uint_as_float(w.z << 16); v1[1] = __uint_as_float(w.z & 0xffff0000u); v1[2] = __uint_as_float(w.w << 16); v1[3] = __uint_as_float(w.w & 0xffff0000u); }

struct EpiLruIn {
    static constexpr bool PERM = true, AFTER_DRAIN = false;
    bf16_t* u; bf16_t* gl;
    __device__ __forceinline__ void operator()(const f32x4 (&acc)[2][2][4][2], const Unit& un, int wr, int wc, int fr, int fq) const {
        const int row0 = un.pm * BM + wr * 64 + fr; const bool isg = un.pn >= 6;
        bf16_t* base = (isg ? gl : u) + (isg ? un.pn - 6 : un.pn) * BM + wc * 32 + 8 * fq;
#pragma unroll
        for (int ai = 0; ai < 2; ++ai)
#pragma unroll
            for (int m = 0; m < 4; ++m) { bf16_t* rowp = base + (size_t)(row0 + ai * HALF + m * 16) * 1536;
#pragma unroll
                for (int bj = 0; bj < 2; ++bj) { f32x4 v0 = acc[ai][bj][m][0], v1 = acc[ai][bj][m][1];
                    if (isg) {
#pragma unroll
                        for (int e = 0; e < 4; ++e) { v0[e] = fgelu(v0[e]); v1[e] = fgelu(v1[e]); } }
                    *(u32x4*)(rowp + bj * HALF) = pack8(v0, v1); } }
    }
};
struct EpiRetIn {
    static constexpr bool PERM = true, AFTER_DRAIN = false;
    bf16_t* q; bf16_t* k; bf16_t* v; bf16_t* g; const float* rope;
    __device__ __forceinline__ void operator()(const f32x4 (&acc)[2][2][4][2], const Unit& un, int wr, int wc, int fr, int fq) const {
        const int row0 = un.pm * BM + wr * 64 + fr;
        if (un.pn < 8) {
            const bool isk = un.pn >= 4; const int h = un.pn & 3;
            const float lg = __log2f(1.f - __builtin_amdgcn_exp2f(-5.f - (float)h));
            const int jb = wc * 32 + 8 * fq;
            bf16_t* base = (isk ? k : q) + h * 256 + jb;
#pragma unroll
            for (int ai = 0; ai < 2; ++ai)
#pragma unroll
                for (int m = 0; m < 4; ++m) { const int r = row0 + ai * HALF + m * 16, s = r & 8191, n = s & 127;
                    const float sc = isk ? __builtin_amdgcn_exp2f(-(float)n * lg) * 0.0625f : __builtin_amdgcn_exp2f((float)n * lg);
                    const f32x4* tp = (const f32x4*)(rope + ((size_t)s * 128 + jb) * 2);
                    f32x4 o1[2], o2[2];
#pragma unroll
                    for (int nn = 0; nn < 2; ++nn) { const f32x4 ta = tp[2 * nn], tb = tp[2 * nn + 1]; const f32x4 a = acc[ai][0][m][nn], b = acc[ai][1][m][nn];
                        o1[nn][0] = (a[0] * ta[0] - b[0] * ta[1]) * sc; o2[nn][0] = (a[0] * ta[1] + b[0] * ta[0]) * sc;
                        o1[nn][1] = (a[1] * ta[2] - b[1] * ta[3]) * sc; o2[nn][1] = (a[1] * ta[3] + b[1] * ta[2]) * sc;
                        o1[nn][2] = (a[2] * tb[0] - b[2] * tb[1]) * sc; o2[nn][2] = (a[2] * tb[1] + b[2] * tb[0]) * sc;
                        o1[nn][3] = (a[3] * tb[2] - b[3] * tb[3]) * sc; o2[nn][3] = (a[3] * tb[3] + b[3] * tb[2]) * sc; }
                    bf16_t* rowp = base + (size_t)r * 1024;
                    *(u32x4*)(rowp) = pack8(o1[0], o1[1]); *(u32x4*)(rowp + HALF) = pack8(o2[0], o2[1]);
                    asm volatile("" ::: "memory"); }
        } else {
            const bool isg = un.pn >= 16;
            bf16_t* base = (isg ? g : v) + ((un.pn - 8) & 7) * BM + wc * 32 + 8 * fq;
#pragma unroll
            for (int ai = 0; ai < 2; ++ai)
#pragma unroll
                for (int m = 0; m < 4; ++m) { bf16_t* rowp = base + (size_t)(row0 + ai * HALF + m * 16) * 2048;
#pragma unroll
                    for (int bj = 0; bj < 2; ++bj) { f32x4 v0 = acc[ai][bj][m][0], v1 = acc[ai][bj][m][1];
                        if (isg) {
#pragma unroll
                            for (int e = 0; e < 4; ++e) { v0[e] = fsilu(v0[e]); v1[e] = fsilu(v1[e]); } }
                        *(u32x4*)(rowp + bj * HALF) = pack8(v0, v1); } }
        }
    }
};
struct EpiGates {
    static constexpr bool PERM = true, AFTER_DRAIN = false;
    const float* bm; bf16_t* gates;
    __device__ __forceinline__ void operator()(const f32x4 (&acc)[2][2][4][2], const Unit& un, int wr, int wc, int fr, int fq) const {
        const int row0 = un.pm * BM + wr * 64 + fr, col0 = un.pn * BM + wc * 32 + 8 * fq;
        f32x4 bv[2][2];
#pragma unroll
        for (int bj = 0; bj < 2; ++bj)
#pragma unroll
            for (int n = 0; n < 2; ++n) bv[bj][n] = *(const f32x4*)(bm + col0 + bj * HALF + 4 * n);
#pragma unroll
        for (int ai = 0; ai < 2; ++ai)
#pragma unroll
            for (int m = 0; m < 4; ++m) { bf16_t* rowp = gates + (size_t)(row0 + ai * HALF + m * 16) * 2048 + col0;
#pragma unroll
                for (int bj = 0; bj < 2; ++bj) { f32x4 v0 = acc[ai][bj][m][0] + bv[bj][0], v1 = acc[ai][bj][m][1] + bv[bj][1];
#pragma unroll
                    for (int e = 0; e < 4; ++e) { v0[e] = fsig(v0[e]); v1[e] = fsig(v1[e]); }
                    *(u32x4*)(rowp + bj * HALF) = pack8(v0, v1); } }
    }
};
template <int MODE> struct EpiMerge {
    static constexpr bool PERM = true, AFTER_DRAIN = false;
    const bf16_t* gates; const bf16_t* m1in; bf16_t* o;
    __device__ __forceinline__ void operator()(const f32x4 (&acc)[2][2][4][2], const Unit& un, int wr, int wc, int fr, int fq) const {
        const int row0 = un.pm * BM + wr * 64 + fr, col0 = un.pn * BM + wc * 32 + 8 * fq;
#pragma unroll
        for (int ai = 0; ai < 2; ++ai)
#pragma unroll
            for (int m = 0; m < 4; ++m) { const size_t r = (size_t)(row0 + ai * HALF + m * 16);
#pragma unroll
                for (int bj = 0; bj < 2; ++bj) { const int c = col0 + bj * HALF;
                    f32x4 g0, g1; unpack8(*(const u32x4*)(gates + r * 2048 + MODE * 1024 + c), g0, g1);
                    f32x4 v0 = acc[ai][bj][m][0] * g0, v1 = acc[ai][bj][m][1] * g1;
                    if (MODE == 1) { f32x4 p0, p1; unpack8(*(const u32x4*)(m1in + r * 1024 + c), p0, p1); v0 += p0; v1 += p1; }
                    *(u32x4*)(o + r * 1024 + c) = pack8(v0, v1); } }
    }
};
struct EpiOut {
    static constexpr bool PERM = true, AFTER_DRAIN = false;
    const float* x; bf16_t* y; float alpha;
    __device__ __forceinline__ void operator()(const f32x4 (&acc)[2][2][4][2], const Unit& un, int wr, int wc, int fr, int fq) const {
        const int row0 = un.pm * BM + wr * 64 + fr, col0 = un.pn * BM + wc * 32 + 8 * fq;
#pragma unroll
        for (int ai = 0; ai < 2; ++ai)
#pragma unroll
            for (int m = 0; m < 4; ++m) { const size_t off = (size_t)(row0 + ai * HALF + m * 16) * 1024 + col0;
#pragma unroll
                for (int bj = 0; bj < 2; ++bj) { const f32x4 x0 = *(const f32x4*)(x + off + bj * HALF), x1 = *(const f32x4*)(x + off + bj * HALF + 4);
                    *(u32x4*)(y + off + bj * HALF) = pack8(x0 * alpha + acc[ai][bj][m][0], x1 * alpha + acc[ai][bj][m][1]); } }
    }
};
struct MoeTab { int tileStart[33]; int cnt[32]; int pad_[3]; int tileExp[320]; };
__device__ __forceinline__ void moe_build_tab(PG8_LAS MoeTab* tab, const int* cnt) {
    if (threadIdx.x == 0) { int t = 0; for (int e = 0; e < 32; ++e) { const int c = cnt[e * 64], nt = (c + 255) >> 8; tab->tileStart[e] = t; tab->cnt[e] = c; for (int i = 0; i < nt; ++i) tab->tileExp[t + i] = e; t += nt; } tab->tileStart[32] = t; }
    __syncthreads();
}
template <bool GATHER> struct MoeOrder {
    int U, G, c; const PG8_LAS MoeTab* tab; const int* list;
    __device__ __forceinline__ bool next(int i, Unit& u) const {
        const long L = (long)i * G + c; if (L >= U) return false;
        int wgid = (int)L; { const int q = U / NXCD, r = U % NXCD, xcd = wgid % NXCD, off = wgid / NXCD; wgid = (xcd < r ? xcd * (q + 1) : r * (q + 1) + (xcd - r) * q) + off; }
        u.pm = wgid >> 2; u.pn = tab->tileExp[u.pm] * 4 + (wgid & 3); return true;
    }
    __device__ __forceinline__ void a_ready(const Unit&) const {}
    __device__ __forceinline__ void done(const Unit&) const {}
    __device__ __forceinline__ const char* a_base(const Gemm& g, const Unit& u) const { return GATHER ? (const char*)g.A : (const char*)g.A + (size_t)u.pm * (size_t)(BM * g.K * 2); }
    __device__ __forceinline__ void a_off(const Gemm& g, const Unit& u, const int (&R)[2], const int (&C)[2], unsigned (&v)[2][2]) const {
        if (!GATHER) { _Pragma("unroll") for (int hh = 0; hh < 2; ++hh) _Pragma("unroll") for (int i = 0; i < 2; ++i) v[hh][i] = (unsigned)((hh * HALF + R[i]) * g.K + C[i]) * 2u; }
        else { const int e = u.pn >> 2, base = (u.pm - tab->tileStart[e]) * BM, ce = tab->cnt[e];
            _Pragma("unroll") for (int hh = 0; hh < 2; ++hh) _Pragma("unroll") for (int i = 0; i < 2; ++i) { const int lr = base + hh * HALF + R[i]; const int tok = (lr < ce) ? (list[e * 32768 + lr] >> 1) : 0; v[hh][i] = (unsigned)(tok * g.K + C[i]) * 2u; } }
    }
};
struct EpiSwiGLU {
    static constexpr bool PERM = true, AFTER_DRAIN = false;
    bf16_t* h;
    __device__ __forceinline__ void operator()(const f32x4 (&acc)[2][2][4][2], const Unit& un, int wr, int wc, int fr, int fq) const {
        const int row0 = un.pm * BM + wr * 64 + fr, col0 = (un.pn & 3) * 128 + wc * 32 + 8 * fq;
#pragma unroll
        for (int ai = 0; ai < 2; ++ai)
#pragma unroll
            for (int m = 0; m < 4; ++m) { f32x4 v0, v1;
#pragma unroll
                for (int e = 0; e < 4; ++e) { v0[e] = fsilu(acc[ai][0][m][0][e]) * acc[ai][1][m][0][e]; v1[e] = fsilu(acc[ai][0][m][1][e]) * acc[ai][1][m][1][e]; }
                *(u32x4*)(h + (size_t)(row0 + ai * HALF + m * 16) * 512 + col0) = pack8(v0, v1); }
    }
};
struct EpiMoeOut {
    static constexpr bool PERM = true, AFTER_DRAIN = false;
    const PG8_LAS MoeTab* tab; const int* list; const float* rw; bf16_t* ys;
    __device__ __forceinline__ void operator()(const f32x4 (&acc)[2][2][4][2], const Unit& un, int wr, int wc, int fr, int fq) const {
        const int e = un.pn >> 2, lrow0 = (un.pm - tab->tileStart[e]) * BM + wr * 64 + fr, ce = tab->cnt[e], col0 = (un.pn & 3) * BM + wc * 32 + 8 * fq;
        int slot[8]; float wgt[8];
#pragma unroll
        for (int i = 0; i < 8; ++i) { const int lr = lrow0 + (i >> 2) * HALF + (i & 3) * 16; slot[i] = (lr < ce) ? list[e * 32768 + lr] : -1; }
#pragma unroll
        for (int i = 0; i < 8; ++i) wgt[i] = (slot[i] >= 0) ? rw[slot[i]] : 0.f;
#pragma unroll
        for (int ai = 0; ai < 2; ++ai)
#pragma unroll
            for (int m = 0; m < 4; ++m) { const int i = ai * 4 + m;
                if (slot[i] >= 0) { const float w = wgt[i]; bf16_t* rowp = ys + (size_t)slot[i] * 1024 + col0;
#pragma unroll
                    for (int bj = 0; bj < 2; ++bj) *(u32x4*)(rowp + bj * HALF) = pack8(acc[ai][bj][m][0] * w, acc[ai][bj][m][1] * w); } }
    }
};

__device__ __forceinline__ float clamp448(float v) { return fminf(fmaxf(v, -448.f), 448.f); }
__device__ __forceinline__ unsigned pk4_fp8(float a, float b, float c, float d) { int p = __builtin_amdgcn_cvt_pk_fp8_f32(clamp448(a), clamp448(b), 0, false); p = __builtin_amdgcn_cvt_pk_fp8_f32(clamp448(c), clamp448(d), p, true); return (unsigned)p; }
constexpr float FP8_SX = 4.f, FP8_SW = 64.f, FP8_SH = 8.f;
struct EpiSwiGLU8 {
    static constexpr bool PERM = true, AFTER_DRAIN = false;
    unsigned char* h;
    __device__ __forceinline__ void operator()(const f32x4 (&acc)[2][2][4][2], const Unit& un, int wr, int wc, int fr, int fq) const {
        const int row0 = un.pm * BM + wr * 64 + fr, col0 = (un.pn & 3) * 128 + wc * 32 + 8 * fq; const float ds = 1.f / (FP8_SX * FP8_SW);
#pragma unroll
        for (int ai = 0; ai < 2; ++ai)
#pragma unroll
            for (int m = 0; m < 4; ++m) { float v[8];
#pragma unroll
                for (int e = 0; e < 4; ++e) { v[e] = FP8_SH * fsilu(acc[ai][0][m][0][e] * ds) * (acc[ai][1][m][0][e] * ds); v[4 + e] = FP8_SH * fsilu(acc[ai][0][m][1][e] * ds) * (acc[ai][1][m][1][e] * ds); }
                uint2 o; o.x = pk4_fp8(v[0], v[1], v[2], v[3]); o.y = pk4_fp8(v[4], v[5], v[6], v[7]);
                *(uint2*)(h + (size_t)(row0 + ai * HALF + m * 16) * 512 + col0) = o; }
    }
};
struct EpiMoeOut8 {
    static constexpr bool PERM = true, AFTER_DRAIN = false;
    const PG8_LAS MoeTab* tab; const int* list; const float* rw; bf16_t* ys;
    __device__ __forceinline__ void operator()(const f32x4 (&acc)[2][2][4][2], const Unit& un, int wr, int wc, int fr, int fq) const {
        const int e = un.pn >> 2, lrow0 = (un.pm - tab->tileStart[e]) * BM + wr * 64 + fr, ce = tab->cnt[e], col0 = (un.pn & 3) * BM + wc * 32 + 8 * fq;
#pragma unroll
        for (int ai = 0; ai < 2; ++ai)
#pragma unroll
            for (int m = 0; m < 4; ++m) { const int lr = lrow0 + ai * HALF + m * 16;
                if (lr < ce) { const int slot = list[e * 32768 + lr]; const float w = rw[slot] * (1.f / (FP8_SH * FP8_SW)); bf16_t* rowp = ys + (size_t)slot * 1024 + col0;
#pragma unroll
                    for (int bj = 0; bj < 2; ++bj) *(u32x4*)(rowp + bj * HALF) = pack8(acc[ai][bj][m][0] * w, acc[ai][bj][m][1] * w); }
                asm volatile("" ::: "memory"); }
    }
};
}

DEV unsigned pk2(float lo, float hi) { return (unsigned)f2bf(lo) | ((unsigned)f2bf(hi) << 16); }
typedef unsigned v4u __attribute__((ext_vector_type(4)));
DEV void transpose_item(const float* W, int K, int N, bf16_t* WT, int row_off, float* scr, int item, int lane) {
    const int nblk = N / 32, kb = item / nblk, nb = item % nblk, k0 = 64 * kb, n0 = 32 * nb;
    float wv[32];
#pragma unroll
    for (int i = 0; i < 32; ++i) wv[i] = W[(size_t)(k0 + 2 * i + (lane >> 5)) * N + n0 + (lane & 31)];
#pragma unroll
    for (int i = 0; i < 32; ++i) scr[(2 * i + (lane >> 5)) * 33 + (lane & 31)] = wv[i];
    asm volatile("s_waitcnt lgkmcnt(0)" ::: "memory");
    const int c = lane & 7;
#pragma unroll
    for (int j = 0; j < 4; ++j) { const int n = (lane >> 3) + 8 * j; const float* s = scr + (8 * c) * 33 + n;
        v4u o; o.x = pk2(s[0 * 33], s[1 * 33]); o.y = pk2(s[2 * 33], s[3 * 33]); o.z = pk2(s[4 * 33], s[5 * 33]); o.w = pk2(s[6 * 33], s[7 * 33]);
        *(v4u*)(WT + (size_t)(row_off + n0 + n) * K + k0 + 8 * c) = o; }
    asm volatile("s_waitcnt lgkmcnt(0)" ::: "memory");
}
DEV void p_weights(float* lds, const float* w_in, const float* w_ret_o, const float* w_lru_o, const float* w_out, const float* w_rg_r, const float* w_rg_i, bf16_t* w_in_t, bf16_t* w_ro_t, bf16_t* w_lo_t, bf16_t* w_out_t, bf16_t* wrg_t) {
    const int wave = threadIdx.x >> 6, lane = threadIdx.x & 63;
    float* scr = lds + wave * 2304;
    constexpr int I0 = 16 * (WIN_N / 32), I1 = 32 * 32, I2 = 24 * 32, I3 = 16 * 32, I4 = 16 * 18;
    for (int it = blockIdx.x * 8 + wave; it < I0 + I1 + I2 + I3 + I4; it += gridDim.x * 8) {
        int r = it;
        if (r < I0) { transpose_item(w_in, 1024, WIN_N, w_in_t, 0, scr, r, lane); continue; } r -= I0;
        if (r < I1) { transpose_item(w_ret_o, 2048, 1024, w_ro_t, 0, scr, r, lane); continue; } r -= I1;
        if (r < I2) { transpose_item(w_lru_o, 1536, 1024, w_lo_t, 0, scr, r, lane); continue; } r -= I2;
        if (r < I3) { transpose_item(w_out, 1024, 1024, w_out_t, 0, scr, r, lane); continue; } r -= I3;
        { const int mi = r / 18, sub = r - mi * 18; const float* W = (mi < 8 ? w_rg_r + (size_t)mi * 192 * 192 : w_rg_i + (size_t)(mi - 8) * 192 * 192);
          transpose_item(W, 192, 192, wrg_t + (size_t)mi * 192 * 192, 0, scr, sub, lane); }
    }
}


DEV void transpose_item_fp8(const float* W, int K, int N, unsigned char* WT, int row_off, float scale, float* scr, int item, int lane) {
    const int nblk = N / 32, kb = item / nblk, nb = item % nblk, k0 = 64 * kb, n0 = 32 * nb;
    float wv[32];
#pragma unroll
    for (int i = 0; i < 32; ++i) wv[i] = W[(size_t)(k0 + 2 * i + (lane >> 5)) * N + n0 + (lane & 31)];
#pragma unroll
    for (int i = 0; i < 32; ++i) scr[(2 * i + (lane >> 5)) * 33 + (lane & 31)] = wv[i] * scale;
    asm volatile("s_waitcnt lgkmcnt(0)" ::: "memory");
    const int c = lane & 3;
#pragma unroll
    for (int j = 0; j < 2; ++j) { const int n = (lane >> 2) + 16 * j; const float* s = scr + (16 * c) * 33 + n;
        v4u o; o.x = pg8::pk4_fp8(s[0 * 33], s[1 * 33], s[2 * 33], s[3 * 33]); o.y = pg8::pk4_fp8(s[4 * 33], s[5 * 33], s[6 * 33], s[7 * 33]);
        o.z = pg8::pk4_fp8(s[8 * 33], s[9 * 33], s[10 * 33], s[11 * 33]); o.w = pg8::pk4_fp8(s[12 * 33], s[13 * 33], s[14 * 33], s[15 * 33]);
        *(v4u*)(WT + (size_t)(row_off + n0 + n) * K + k0 + 16 * c) = o; }
    asm volatile("s_waitcnt lgkmcnt(0)" ::: "memory");
}
DEV void p_expert_weights(float* lds, const float* w_eg, const float* w_eu, const float* w_ed, unsigned char* wgu8, unsigned char* wd8) {
    const int wave = threadIdx.x >> 6, lane = threadIdx.x & 63;
    float* scr = lds + wave * 2304;
    for (int it = blockIdx.x * 8 + wave; it < 3 * 8192; it += gridDim.x * 8) {
        const int kind = it >> 13, r = it & 8191, e = r >> 8, sub = r & 255;
        if (kind < 2) { const int nb = sub & 15; transpose_item_fp8((kind ? w_eu : w_eg) + (size_t)e * 1024 * 512, 1024, 512, wgu8 + (size_t)e * 1024 * 1024, (nb >> 2) * 128 + kind * 128, pg8::FP8_SW, scr, sub, lane); }
        else transpose_item_fp8(w_ed + (size_t)e * 512 * 1024, 512, 1024, wd8 + (size_t)e * 1024 * 512, 0, pg8::FP8_SW, scr, sub, lane);
    }
}

DEV void p_router_consts(float* lds, const float* g1, const float* b1, const float* wg, const float* bg, const float* we, const float* be, float* sb) {
    if (blockIdx.x != 0) return;
    const int t = threadIdx.x, wv = t >> 6, lane = t & 63;
    float s[36], q[36];
#pragma unroll
    for (int c = 0; c < 36; ++c) { s[c] = 0.f; q[c] = 0.f; }
#pragma unroll
    for (int kk = 0; kk < 2; ++kk) { const int k = t + 512 * kk; const float gk = g1[k], bk = b1[k];
#pragma unroll
        for (int c4 = 0; c4 < 9; ++c4) { const float4 w = (c4 < 8) ? *(const float4*)(we + (size_t)k * 32 + c4 * 4) : *(const float4*)(wg + (size_t)k * 4);
            s[4 * c4] += gk * w.x; s[4 * c4 + 1] += gk * w.y; s[4 * c4 + 2] += gk * w.z; s[4 * c4 + 3] += gk * w.w;
            q[4 * c4] += bk * w.x; q[4 * c4 + 1] += bk * w.y; q[4 * c4 + 2] += bk * w.z; q[4 * c4 + 3] += bk * w.w; } }
#pragma unroll
    for (int m = 1; m < 64; m <<= 1) {
#pragma unroll
        for (int c = 0; c < 36; ++c) { s[c] += __shfl_xor(s[c], m); q[c] += __shfl_xor(q[c], m); } }
    if (lane == 0) {
#pragma unroll
        for (int c = 0; c < 36; ++c) { lds[wv * 96 + c] = s[c]; lds[wv * 96 + 48 + c] = q[c]; } }
    __syncthreads();
    if (t < 96) { const int cc = t % 48; float v = 0.f;
        if (cc < 36) { for (int p = 0; p < 8; ++p) v += lds[p * 96 + t]; if (t >= 48) v += (cc < 32) ? be[cc] : bg[cc - 32]; }
        sb[t] = v; }
    __syncthreads();
}
DEV void p_cvt_x(const float* x, bf16_t* xb) {
    const size_t n4 = (size_t)NTOK * DM / 4, stride = (size_t)gridDim.x * NTHR;
    for (size_t i0 = (size_t)blockIdx.x * NTHR + threadIdx.x; i0 < n4; i0 += 8 * stride) {
        float4 t[8];
#pragma unroll
        for (int u = 0; u < 8; ++u) { const size_t i = i0 + u * stride; t[u] = (i < n4) ? ((const float4*)x)[i] : make_float4(0.f, 0.f, 0.f, 0.f); }
#pragma unroll
        for (int u = 0; u < 8; ++u) { const size_t i = i0 + u * stride; if (i < n4) { uint2 o; o.x = pg8::cvt_pk_bf16(t[u].x, t[u].y); o.y = pg8::cvt_pk_bf16(t[u].z, t[u].w); ((uint2*)xb)[i] = o; } }
    }
}
DEV void p_rope_table(float2* tab) {
    for (int i = blockIdx.x * NTHR + threadIdx.x; i < 8192 * 128; i += gridDim.x * NTHR) {
        const int s = i >> 7, j = i & 127;
        const double r = 0.93057204092969897;
        double inv = 1.0; for (int t = 0; t < j; ++t) inv *= r;
        const double ang = (double)s * inv;
        const double twopi_hi = 6.283185307179586232, twopi_lo = 2.4492935982947064e-16;
        const double n = rint(ang / twopi_hi);
        const double x = (ang - n * twopi_hi) - n * twopi_lo;
        const double x2 = x * x;
        double acc = 1.0 - x2 * (1.0 / (22.0 * 23.0));
#pragma unroll
        for (int k = 21; k >= 3; k -= 2) acc = 1.0 - x2 * (1.0 / ((double)(k - 1) * (double)k)) * acc;
        double acc2 = 1.0 - x2 * (1.0 / (21.0 * 22.0));
#pragma unroll
        for (int k = 20; k >= 2; k -= 2) acc2 = 1.0 - x2 * (1.0 / ((double)(k - 1) * (double)k)) * acc2;
        tab[i] = make_float2((float)acc2, (float)(x * acc));
    }
}

typedef short bf16x8_t __attribute__((ext_vector_type(8)));
typedef float f32x4_t __attribute__((ext_vector_type(4)));
typedef short s16x4_t __attribute__((ext_vector_type(4)));
typedef unsigned u32x4_t __attribute__((ext_vector_type(4)));
constexpr int LRU_ROWB = 400;
DEV void p_lru_compute(unsigned char* lds, const bf16_t* ulru, const float* cw, const float* cb, const bf16_t* wrg_t,
                       const float* b_r, const float* b_i, const float* lam, bf16_t* epsb, bf16_t* xinb, float* segA, float* segH) {
    int tid_ = threadIdx.x; asm volatile("" : "+v"(tid_));
    const int tid = tid_, wave = tid >> 6, lane = tid & 63, fr = lane & 15, fq = lane >> 4, wr = wave >> 2, wc = wave & 3;
    unsigned char* stg = lds + 256 * LRU_ROWB + wave * 4096;
    for (int item = blockIdx.x; item < 1024; item += gridDim.x) {
        const int n = item & 7, b = (item >> 3) & 3, seg = item >> 5;
        const size_t t0 = (size_t)b * SEQ + seg * 256;
#pragma unroll 4
        for (int idx = tid; idx < 256 * 24; idx += NTHR) {
            const int r = idx / 24, c8 = idx - r * 24, ch0 = n * 192 + c8 * 8;
            float acc[8];
            { const float4 c0 = *(const float4*)(cb + ch0), c1 = *(const float4*)(cb + ch0 + 4); acc[0] = c0.x; acc[1] = c0.y; acc[2] = c0.z; acc[3] = c0.w; acc[4] = c1.x; acc[5] = c1.y; acc[6] = c1.z; acc[7] = c1.w; }
#pragma unroll
            for (int j = 0; j < 4; ++j) {
                if (seg * 256 + r - 3 + j >= 0) {
                    const uint4 uv = *(const uint4*)(ulru + (t0 + r - 3 + j) * 1536 + ch0);
                    const float4 w0 = *(const float4*)(cw + j * 1536 + ch0), w1 = *(const float4*)(cw + j * 1536 + ch0 + 4);
                    acc[0] += w0.x * __uint_as_float(uv.x << 16); acc[1] += w0.y * __uint_as_float(uv.x & 0xffff0000u);
                    acc[2] += w0.z * __uint_as_float(uv.y << 16); acc[3] += w0.w * __uint_as_float(uv.y & 0xffff0000u);
                    acc[4] += w1.x * __uint_as_float(uv.z << 16); acc[5] += w1.y * __uint_as_float(uv.z & 0xffff0000u);
                    acc[6] += w1.z * __uint_as_float(uv.w << 16); acc[7] += w1.w * __uint_as_float(uv.w & 0xffff0000u);
                }
            }
            uint4 o; o.x = pg8::cvt_pk_bf16(acc[0], acc[1]); o.y = pg8::cvt_pk_bf16(acc[2], acc[3]); o.z = pg8::cvt_pk_bf16(acc[4], acc[5]); o.w = pg8::cvt_pk_bf16(acc[6], acc[7]);
            *(uint4*)(lds + r * LRU_ROWB + c8 * 16) = o;
        }
        __syncthreads();
        float cbr[3], cbi[3], csp[3], hrun[3], atot[3];
        const int sub = seg * 2 + wr;
#pragma unroll
        for (int tc = 0; tc < 3; ++tc) { const int ch = n * 192 + 48 * wc + 16 * tc + fr; cbr[tc] = b_r[ch]; cbi[tc] = b_i[ch]; csp[tc] = 8.f * 1.4426950408889634f * log1pf(__expf(-lam[ch])); atot[tc] = 1.f; hrun[tc] = 0.f; }
        const bf16_t* wrb = wrg_t + ((size_t)n * 192 + 48 * wc + fr) * 192 + fq * 8;
        const bf16_t* wib = wrb + (size_t)8 * 192 * 192;
#pragma unroll
        for (int tc = 0; tc < 3; ++tc) {
            bf16x8_t bfr[6][2];
#pragma unroll
            for (int ks = 0; ks < 6; ++ks) { bfr[ks][0] = *(const bf16x8_t*)(wrb + tc * 16 * 192 + ks * 32); bfr[ks][1] = *(const bf16x8_t*)(wib + tc * 16 * 192 + ks * 32); }
#pragma unroll
            for (int p = 0; p < 2; ++p) {
                const int rowb = 128 * wr + 64 * p;
                f32x4_t acc[4][2];
#pragma unroll
                for (int m = 0; m < 4; ++m) { acc[m][0] = (f32x4_t){0.f, 0.f, 0.f, 0.f}; acc[m][1] = (f32x4_t){0.f, 0.f, 0.f, 0.f}; }
#pragma unroll
                for (int ks = 0; ks < 6; ++ks) {
                    bf16x8_t afr[4];
#pragma unroll
                    for (int m = 0; m < 4; ++m) afr[m] = *(const bf16x8_t*)(lds + (rowb + 16 * (fr >> 2) + 4 * m + (fr & 3)) * LRU_ROWB + ks * 64 + fq * 16);
#pragma unroll
                    for (int m = 0; m < 4; ++m) { acc[m][0] = __builtin_amdgcn_mfma_f32_16x16x32_bf16(afr[m], bfr[ks][0], acc[m][0], 0, 0, 0); acc[m][1] = __builtin_amdgcn_mfma_f32_16x16x32_bf16(afr[m], bfr[ks][1], acc[m][1], 0, 0, 0); }
                }
                const int coff = (48 * wc + 16 * tc + fr) * 2;
                const unsigned char* up = lds + (rowb + 16 * fq) * LRU_ROWB + coff;
                float Al = 1.f, Bl = 0.f;
                unsigned pe[8], px[8];
#pragma unroll
                for (int m = 0; m < 4; ++m) {
                    float ee[4], xx[4];
#pragma unroll
                    for (int j = 0; j < 4; ++j) {
                        const float rr = pg8::fsig(acc[m][0][j] + cbr[tc]), ii = pg8::fsig(acc[m][1][j] + cbi[tc]);
                        const float aa = __builtin_amdgcn_exp2f(-csp[tc] * rr);
                        const float u = bf2f(*(const bf16_t*)(up + (4 * m + j) * LRU_ROWB));
                        const float om = 1.f - aa;
                        const float x = __builtin_amdgcn_sqrtf(fmaxf(om * (1.f + aa), 0.f)) * ii * u;
                        ee[j] = om; xx[j] = x; Bl = aa * Bl + x; Al *= aa;
                    }
                    pe[2 * m] = pg8::cvt_pk_bf16(ee[0], ee[1]); pe[2 * m + 1] = pg8::cvt_pk_bf16(ee[2], ee[3]);
                    px[2 * m] = pg8::cvt_pk_bf16(xx[0], xx[1]); px[2 * m + 1] = pg8::cvt_pk_bf16(xx[2], xx[3]);
                }
                { float h = hrun[tc], ap = 1.f;
#pragma unroll
                  for (int q = 0; q < 4; ++q) { const float Aq = __shfl(Al, fr + 16 * q), Bq = __shfl(Bl, fr + 16 * q); h = Aq * h + Bq; ap *= Aq; }
                  hrun[tc] = h; atot[tc] *= ap; }
#pragma unroll
                for (int m = 0; m < 4; ++m)
#pragma unroll
                    for (int j = 0; j < 4; ++j) { const int tk = 16 * fq + 4 * m + j; const unsigned we = pe[2 * m + (j >> 1)], wx = px[2 * m + (j >> 1)];
                        *(bf16_t*)(stg + tk * 32 + fr * 2) = (bf16_t)((j & 1) ? (we >> 16) : (we & 0xffff));
                        *(bf16_t*)(stg + 2048 + tk * 32 + fr * 2) = (bf16_t)((j & 1) ? (wx >> 16) : (wx & 0xffff)); }
                asm volatile("s_waitcnt lgkmcnt(0)" ::: "memory");
#pragma unroll
                for (int i = 0; i < 2; ++i) { const int piece = lane + 64 * i, tk = piece >> 1, hf = piece & 1;
                    const size_t go = (t0 + rowb + tk) * 1536 + n * 192 + 48 * wc + 16 * tc + 8 * hf;
                    *(u32x4_t*)(epsb + go) = *(const u32x4_t*)(stg + tk * 32 + hf * 16);
                    *(u32x4_t*)(xinb + go) = *(const u32x4_t*)(stg + 2048 + tk * 32 + hf * 16); }
                asm volatile("s_waitcnt lgkmcnt(0)" ::: "memory");
            }
        }
        if (fq == 0) {
#pragma unroll
            for (int tc = 0; tc < 3; ++tc) { const size_t o = ((size_t)b * 64 + sub) * 1536 + n * 192 + 48 * wc + 16 * tc + fr; segA[o] = atot[tc]; segH[o] = hrun[tc]; }
        }
        __syncthreads();
    }
}
DEV void p_lru_scan(const bf16_t* epsb, const bf16_t* xinb, bf16_t* gl, const float* carry) {
    const int tid = threadIdx.x;
    if (tid >= 384) return;
    for (int item = blockIdx.x; item < 256; item += gridDim.x) {
        const int b = item >> 6, sub = item & 63;
        const size_t base = ((size_t)b * SEQ + sub * 128) * 1536 + tid * 4;
        const float4 cin = *(const float4*)(carry + ((size_t)b * 64 + sub) * 1536 + tid * 4);
        float h0 = cin.x, h1 = cin.y, h2 = cin.z, h3 = cin.w;
#pragma unroll 8
        for (int t = 0; t < 128; ++t) {
            const size_t o = base + (size_t)t * 1536;
            const uint2 ev = *(const uint2*)(epsb + o), xv = *(const uint2*)(xinb + o), gv = *(const uint2*)(gl + o);
            h0 = (1.f - __uint_as_float(ev.x << 16)) * h0 + __uint_as_float(xv.x << 16);
            h1 = (1.f - __uint_as_float(ev.x & 0xffff0000u)) * h1 + __uint_as_float(xv.x & 0xffff0000u);
            h2 = (1.f - __uint_as_float(ev.y << 16)) * h2 + __uint_as_float(xv.y << 16);
            h3 = (1.f - __uint_as_float(ev.y & 0xffff0000u)) * h3 + __uint_as_float(xv.y & 0xffff0000u);
            uint2 ov; ov.x = pg8::cvt_pk_bf16(h0 * __uint_as_float(gv.x << 16), h1 * __uint_as_float(gv.x & 0xffff0000u)); ov.y = pg8::cvt_pk_bf16(h2 * __uint_as_float(gv.y << 16), h3 * __uint_as_float(gv.y & 0xffff0000u));
            *(uint2*)(gl + o) = ov;
        }
    }
}
DEV void p_lru_carry(float* lds, const float* segA, const float* segH, float* carry) {
    float* tA = lds; float* tH = lds + 64 * 65;
    for (int item = blockIdx.x; item < 96; item += gridDim.x) {
        const int b = item / 24, c0 = (item % 24) * 64;
        for (int i = threadIdx.x; i < 64 * 64; i += NTHR) { const int s = i >> 6, c = i & 63; const size_t o = ((size_t)b * 64 + s) * 1536 + c0 + c; tA[s * 65 + c] = segA[o]; tH[s * 65 + c] = segH[o]; }
        __syncthreads();
        if (threadIdx.x < 64) { const int c = threadIdx.x; float h = 0.f;
            for (int s = 0; s < 64; ++s) { const float a = tA[s * 65 + c], hh = tH[s * 65 + c]; tA[s * 65 + c] = h; h = a * h + hh; } }
        __syncthreads();
        for (int i = threadIdx.x; i < 64 * 64; i += NTHR) { const int s = i >> 6, c = i & 63; carry[((size_t)b * 64 + s) * 1536 + c0 + c] = tA[s * 65 + c]; }
        __syncthreads();
    }
}
#define LDS_BARRIER() do { asm volatile("s_waitcnt lgkmcnt(0)" ::: "memory"); __builtin_amdgcn_s_barrier(); asm volatile("" ::: "memory"); } while (0)
DEV void p_scores(unsigned char* lds, const bf16_t* q, const bf16_t* k, bf16_t* P) {
    int tid_ = threadIdx.x; asm volatile("" : "+v"(tid_));
    const int tid = tid_, w = tid >> 6, lane = tid & 63, fr = lane & 15, fq = lane >> 4;
    const int krow = tid >> 5, kch = tid & 31;
    u32x4_t kreg[8]; bf16x8_t qa[8];
    int g = blockIdx.x;
    if (g < 1024) { const int c = g & 63, bh = g >> 6, b = bh >> 2, h = bh & 3; const size_t tok0 = (size_t)b * SEQ + c * 128;
        const bf16_t* kc = k + tok0 * 1024 + h * 256;
#pragma unroll
        for (int ii = 0; ii < 8; ++ii) kreg[ii] = *(const u32x4_t*)(kc + (size_t)(krow + 16 * ii) * 1024 + kch * 8);
        const bf16_t* qp = q + (tok0 + 16 * w + fr) * 1024 + h * 256 + fq * 8;
#pragma unroll
        for (int ks = 0; ks < 8; ++ks) qa[ks] = *(const bf16x8_t*)(qp + ks * 32); }
    for (; g < 1024; g += gridDim.x) {
#pragma unroll
        for (int ii = 0; ii < 8; ++ii) *(u32x4_t*)(lds + (krow + 16 * ii) * 528 + kch * 16) = kreg[ii];
        bf16x8_t qc[8];
#pragma unroll
        for (int ks = 0; ks < 8; ++ks) qc[ks] = qa[ks];
        const int gn = g + gridDim.x;
        if (gn < 1024) { const int c = gn & 63, bh = gn >> 6, b = bh >> 2, h = bh & 3; const size_t tok0 = (size_t)b * SEQ + c * 128;
            const bf16_t* kc = k + tok0 * 1024 + h * 256;
#pragma unroll
            for (int ii = 0; ii < 8; ++ii) kreg[ii] = *(const u32x4_t*)(kc + (size_t)(krow + 16 * ii) * 1024 + kch * 8);
            const bf16_t* qp = q + (tok0 + 16 * w + fr) * 1024 + h * 256 + fq * 8;
#pragma unroll
            for (int ks = 0; ks < 8; ++ks) qa[ks] = *(const bf16x8_t*)(qp + ks * 32); }
        LDS_BARRIER();
        f32x4_t acc[8];
#pragma unroll
        for (int nt = 0; nt < 8; ++nt) acc[nt] = (f32x4_t){0.f, 0.f, 0.f, 0.f};
#pragma unroll
        for (int ks = 0; ks < 8; ++ks)
#pragma unroll
            for (int nt = 0; nt < 8; ++nt) { const bf16x8_t bb = *(const bf16x8_t*)(lds + (16 * nt + fr) * 528 + ks * 64 + fq * 16); acc[nt] = __builtin_amdgcn_mfma_f32_16x16x32_bf16(qc[ks], bb, acc[nt], 0, 0, 0); }
        LDS_BARRIER();
        bf16_t* Pg = P + (size_t)g * 16384 + (16 * w + 4 * fq) * 128 + fr;
        int nrow = 16 * w + 4 * fq - fr; asm volatile("" : "+v"(nrow));
#pragma unroll
        for (int nt = 0; nt < 8; ++nt)
#pragma unroll
            for (int j = 0; j < 4; ++j) Pg[j * 128 + 16 * nt] = (16 * nt <= nrow + j) ? f2bf(acc[nt][j]) : (bf16_t)0;
    }
    __syncthreads();
}
constexpr int RT_KS = 528, RT_VS = 272, RT_K = 0, RT_V = 128 * RT_KS, RT_U = RT_V + 32 * RT_VS;
DEV void p_ret_mfma(unsigned char* lds, const bf16_t* q, const bf16_t* k, bf16_t* v, const bf16_t* P) {
    int tid_ = threadIdx.x; asm volatile("" : "+v"(tid_));
    const int tid = tid_, w = tid >> 6, lane = tid & 63, fr = lane & 15, fq = lane >> 4;
    for (int wk = blockIdx.x; wk < 256; wk += gridDim.x) {
        const int xcd = wk & 7, idx = wk >> 3, bh = xcd * 2 + (idx >> 4), sl = idx & 15, b = bh >> 2, h = bh & 3;
        float g128; { const double gam = 1.0 - exp2(-5.0 - (double)h); g128 = (float)exp2(128.0 * log2(gam)); }
        asm volatile("" : "+v"(g128));
        f32x4_t accU[2][2];
#pragma unroll
        for (int et = 0; et < 2; ++et)
#pragma unroll
            for (int di = 0; di < 2; ++di) accU[et][di] = (f32x4_t){0.f, 0.f, 0.f, 0.f};
        for (int i = tid; i < 32 * RT_KS / 4; i += NTHR) ((unsigned*)(lds + RT_U))[i] = 0u;
        const size_t tokb = (size_t)b * SEQ;
        u32x4_t kreg[8], vreg;
        const int krow = tid >> 5, kch = tid & 31, vm = tid >> 2, ve = (tid & 3) * 8;
        {
            const bf16_t* kc = k + tokb * 1024 + h * 256;
#pragma unroll
            for (int ii = 0; ii < 8; ++ii) kreg[ii] = *(const u32x4_t*)(kc + (size_t)(krow + 16 * ii) * 1024 + kch * 8);
            vreg = *(const u32x4_t*)(v + (tokb + vm) * 2048 + h * 512 + sl * 32 + ve);
        }
        bf16x8_t qa[8], pa[4];
        {
            const bf16_t* qp = q + (tokb + 16 * w + fr) * 1024 + h * 256 + fq * 8;
#pragma unroll
            for (int ks = 0; ks < 8; ++ks) qa[ks] = *(const bf16x8_t*)(qp + ks * 32);
            const bf16_t* pp = P + (size_t)(bh * 64) * 16384 + (16 * w + fr) * 128 + fq * 8;
#pragma unroll
            for (int ks = 0; ks < 4; ++ks) pa[ks] = *(const bf16x8_t*)(pp + ks * 32);
        }
#pragma unroll 1
        for (int c = 0; c < 64; ++c) {
            const size_t tok0 = tokb + c * 128;
#pragma unroll
            for (int ii = 0; ii < 8; ++ii) *(u32x4_t*)(lds + RT_K + (krow + 16 * ii) * RT_KS + kch * 16) = kreg[ii];
            {
                unsigned char* vp = lds + RT_V + ve * RT_VS + vm * 2;
                *(bf16_t*)(vp + 0 * RT_VS) = (bf16_t)(vreg.x & 0xffff); *(bf16_t*)(vp + 1 * RT_VS) = (bf16_t)(vreg.x >> 16);
                *(bf16_t*)(vp + 2 * RT_VS) = (bf16_t)(vreg.y & 0xffff); *(bf16_t*)(vp + 3 * RT_VS) = (bf16_t)(vreg.y >> 16);
                *(bf16_t*)(vp + 4 * RT_VS) = (bf16_t)(vreg.z & 0xffff); *(bf16_t*)(vp + 5 * RT_VS) = (bf16_t)(vreg.z >> 16);
                *(bf16_t*)(vp + 6 * RT_VS) = (bf16_t)(vreg.w & 0xffff); *(bf16_t*)(vp + 7 * RT_VS) = (bf16_t)(vreg.w >> 16);
            }
            if (c + 1 < 64) {
                const bf16_t* kc = k + (tok0 + 128) * 1024 + h * 256;
#pragma unroll
                for (int ii = 0; ii < 8; ++ii) kreg[ii] = *(const u32x4_t*)(kc + (size_t)(krow + 16 * ii) * 1024 + kch * 8);
                vreg = *(const u32x4_t*)(v + (tok0 + 128 + vm) * 2048 + h * 512 + sl * 32 + ve);
            }
            LDS_BARRIER();
            f32x4_t ao[2] = {(f32x4_t){0.f, 0.f, 0.f, 0.f}, (f32x4_t){0.f, 0.f, 0.f, 0.f}};
            {
                bf16x8_t bu[8];
#pragma unroll
                for (int nt = 0; nt < 2; ++nt) {
#pragma unroll
                    for (int ks = 0; ks < 8; ++ks) bu[ks] = *(const bf16x8_t*)(lds + RT_U + (16 * nt + fr) * RT_KS + ks * 64 + fq * 16);
#pragma unroll
                    for (int ks = 0; ks < 8; ++ks) ao[nt] = __builtin_amdgcn_mfma_f32_16x16x32_bf16(qa[ks], bu[ks], ao[nt], 0, 0, 0);
                }
            }
            bf16x8_t bv[2][4];
#pragma unroll
            for (int nt = 0; nt < 2; ++nt)
#pragma unroll
                for (int ks = 0; ks < 4; ++ks) bv[nt][ks] = *(const bf16x8_t*)(lds + RT_V + (16 * nt + fr) * RT_VS + ks * 64 + fq * 16);
#pragma unroll
            for (int ks = 0; ks < 4; ++ks)
#pragma unroll
                for (int nt = 0; nt < 2; ++nt) ao[nt] = __builtin_amdgcn_mfma_f32_16x16x32_bf16(pa[ks], bv[nt][ks], ao[nt], 0, 0, 0);
            if (c + 1 < 64) {
                const bf16_t* qp = q + (tok0 + 128 + 16 * w + fr) * 1024 + h * 256 + fq * 8;
#pragma unroll
                for (int ks = 0; ks < 8; ++ks) qa[ks] = *(const bf16x8_t*)(qp + ks * 32);
                const bf16_t* pp = P + (size_t)(bh * 64 + c + 1) * 16384 + (16 * w + fr) * 128 + fq * 8;
#pragma unroll
                for (int ks = 0; ks < 4; ++ks) pa[ks] = *(const bf16x8_t*)(pp + ks * 32);
            }
#pragma unroll
            for (int kh = 0; kh < 2; ++kh) {
                s16x4_t tk[2][2][2];
#pragma unroll
                for (int k2 = 0; k2 < 2; ++k2)
#pragma unroll
                    for (int di = 0; di < 2; ++di) {
                        const unsigned char* kp = lds + RT_K + (32 * (2 * kh + k2) + 8 * fq + (fr >> 2)) * RT_KS + (16 * (2 * w + di) + 4 * (fr & 3)) * 2;
                        tk[k2][di][0] = __builtin_amdgcn_ds_read_tr16_b64_v4i16((LAS s16x4_t*)(kp));
                        tk[k2][di][1] = __builtin_amdgcn_ds_read_tr16_b64_v4i16((LAS s16x4_t*)(kp + 4 * RT_KS));
                    }
#pragma unroll
                for (int k2 = 0; k2 < 2; ++k2)
#pragma unroll
                    for (int di = 0; di < 2; ++di) {
                        const bf16x8_t kb = (bf16x8_t){tk[k2][di][0][0], tk[k2][di][0][1], tk[k2][di][0][2], tk[k2][di][0][3], tk[k2][di][1][0], tk[k2][di][1][1], tk[k2][di][1][2], tk[k2][di][1][3]};
#pragma unroll
                        for (int et = 0; et < 2; ++et) accU[et][di] = __builtin_amdgcn_mfma_f32_16x16x32_bf16(bv[et][2 * kh + k2], kb, accU[et][di], 0, 0, 0);
                    }
            }
#pragma unroll
            for (int et = 0; et < 2; ++et)
#pragma unroll
                for (int di = 0; di < 2; ++di) accU[et][di] = accU[et][di] * g128;
            LDS_BARRIER();
            {
                bf16_t* vc = v + (tok0 + 16 * w + 4 * fq) * 2048 + h * 512 + sl * 32 + fr;
#pragma unroll
                for (int nt = 0; nt < 2; ++nt)
#pragma unroll
                    for (int j = 0; j < 4; ++j) vc[(size_t)j * 2048 + 16 * nt] = f2bf(ao[nt][j]);
#pragma unroll
                for (int et = 0; et < 2; ++et)
#pragma unroll
                    for (int di = 0; di < 2; ++di)
#pragma unroll
                        for (int j = 0; j < 4; ++j) *(bf16_t*)(lds + RT_U + (16 * et + 4 * fq + j) * RT_KS + (16 * (2 * w + di) + fr) * 2) = f2bf(accU[et][di][j]);
            }
        }
        __syncthreads();
    }
}
DEV void p_headnorm(bf16_t* ret, const bf16_t* g) {
    const int lane = threadIdx.x & 63;
    for (int w = (blockIdx.x * NTHR + threadIdx.x) >> 6; w < NTOK * 4; w += gridDim.x * (NTHR / 64)) {
        const size_t o = (size_t)w * 512 + lane * 8;
        const u32x4_t rv = *(const u32x4_t*)(ret + o), gv = *(const u32x4_t*)(g + o);
        float x[8], gg[8]; float s = 0.f;
#pragma unroll
        for (int j = 0; j < 4; ++j) { x[2 * j] = __uint_as_float(rv[j] << 16); x[2 * j + 1] = __uint_as_float(rv[j] & 0xffff0000u); gg[2 * j] = __uint_as_float(gv[j] << 16); gg[2 * j + 1] = __uint_as_float(gv[j] & 0xffff0000u); }
#pragma unroll
        for (int j = 0; j < 8; ++j) s += x[j];
#pragma unroll
        for (int m = 1; m < 64; m <<= 1) s += __shfl_xor(s, m);
        const float mu = s * (1.f / 512.f); float q = 0.f;
#pragma unroll
        for (int j = 0; j < 8; ++j) { x[j] -= mu; q += x[j] * x[j]; }
#pragma unroll
        for (int m = 1; m < 64; m <<= 1) q += __shfl_xor(q, m);
        const float rstd = rsqrtf(q * (1.f / 512.f) + LN_EPS);
        u32x4_t ov;
#pragma unroll
        for (int j = 0; j < 4; ++j) ov[j] = pg8::cvt_pk_bf16(x[2 * j] * rstd * gg[2 * j], x[2 * j + 1] * rstd * gg[2 * j + 1]);
        *(u32x4_t*)(ret + o) = ov;
    }
}

typedef float f32x4v __attribute__((ext_vector_type(4)));
DEV void p_ln1_route(float* lds, const bf16_t* y, bf16_t* x1b, unsigned char* x1q, const float* g1, const float* b1, const float* wg, const float* bg,
                     const float* we, const float* be, int2* route_e, float2* route_w, int* cnt, int* list, const float* sb) {
    const int wv = threadIdx.x >> 6, lane = threadIdx.x & 63, r16 = lane & 15, kq = lane >> 4;
    float* Wp = lds;
    float* Sc = lds + 1024 * 36;
    float* Bc = Sc + 48;
    int* lcnt = (int*)(Bc + 48);
    int* rowE = lcnt + 32;
    int* rowP = rowE + 256;
    for (int i = threadIdx.x; i < 1024 * 9; i += NTHR) { const int k = i / 9, c4 = i - k * 9; const float gk = g1[k];
        float4 w = (c4 < 8) ? *(const float4*)(we + (size_t)k * 32 + c4 * 4) : *(const float4*)(wg + (size_t)k * 4);
        w.x *= gk; w.y *= gk; w.z *= gk; w.w *= gk; *(float4*)(Wp + k * 36 + c4 * 4) = w; }
    if (threadIdx.x < 32) lcnt[threadIdx.x] = 0;
    __syncthreads();
    if (threadIdx.x < 96) Sc[threadIdx.x] = sb[threadIdx.x];
    __syncthreads();
    constexpr int rows_per_wg = 128;
    for (int blk = blockIdx.x; blk < NTOK / rows_per_wg; blk += gridDim.x) {
    { const int tile = wv;
        const int lrow0 = tile * 16, row0 = blk * rows_per_wg + lrow0;
        const bf16_t* yp = y + (size_t)(row0 + r16) * 1024 + 4 * kq;
        f32x4v acc[3] = {(f32x4v){0.f, 0.f, 0.f, 0.f}, (f32x4v){0.f, 0.f, 0.f, 0.f}, (f32x4v){0.f, 0.f, 0.f, 0.f}};
        float s1 = 0.f, s2 = 0.f; const float m2 = (r16 < 4) ? 1.f : 0.f;
#pragma unroll 8
        for (int t = 0; t < 64; ++t) {
            const uint2 yr = *(const uint2*)(yp + 16 * t); const float4 yv = make_float4(__uint_as_float(yr.x << 16), __uint_as_float(yr.x & 0xffff0000u), __uint_as_float(yr.y << 16), __uint_as_float(yr.y & 0xffff0000u));
            s1 += (yv.x + yv.y) + (yv.z + yv.w); s2 += (yv.x * yv.x + yv.y * yv.y) + (yv.z * yv.z + yv.w * yv.w);
            const float* wrow = Wp + (16 * t + 4 * kq) * 36 + r16;
            const float ye[4] = {yv.x, yv.y, yv.z, yv.w};
#pragma unroll
            for (int j = 0; j < 4; ++j)
#pragma unroll
                for (int nt = 0; nt < 3; ++nt) { const float wv = (nt < 2) ? wrow[j * 36 + 16 * nt] : wrow[j * 36 + 32 - (r16 & 12)] * m2;
                    acc[nt] = __builtin_amdgcn_mfma_f32_16x16x4f32(ye[j], wv, acc[nt], 0, 0, 0); }
        }
        s1 += __shfl_xor(s1, 16); s1 += __shfl_xor(s1, 32); s2 += __shfl_xor(s2, 16); s2 += __shfl_xor(s2, 32);
        const float mu = s1 * (1.f / 1024.f), rstd = rsqrtf(fmaxf(s2 * (1.f / 1024.f) - mu * mu, 0.f) + LN_EPS);
#pragma unroll 8
        for (int t = 0; t < 64; ++t) {
            const uint2 yr = *(const uint2*)(yp + 16 * t); const float4 yv = make_float4(__uint_as_float(yr.x << 16), __uint_as_float(yr.x & 0xffff0000u), __uint_as_float(yr.y << 16), __uint_as_float(yr.y & 0xffff0000u));
            const float4 gv = *(const float4*)(g1 + 16 * t + 4 * kq), bv = *(const float4*)(b1 + 16 * t + 4 * kq);
            const float4 o = make_float4((yv.x - mu) * rstd * gv.x + bv.x, (yv.y - mu) * rstd * gv.y + bv.y, (yv.z - mu) * rstd * gv.z + bv.z, (yv.w - mu) * rstd * gv.w + bv.w);
            uint2 ob; ob.x = pg8::cvt_pk_bf16(o.x, o.y); ob.y = pg8::cvt_pk_bf16(o.z, o.w);
            *(uint2*)(x1b + (size_t)(row0 + r16) * 1024 + 16 * t + 4 * kq) = ob;
            *(unsigned*)(x1q + (size_t)(row0 + r16) * 1024 + 16 * t + 4 * kq) = pg8::pk4_fp8(o.x * pg8::FP8_SX, o.y * pg8::FP8_SX, o.z * pg8::FP8_SX, o.w * pg8::FP8_SX);
        }
#pragma unroll
        for (int j = 0; j < 4; ++j) {
            const int rl = 4 * kq + j;
            const float mur = __shfl(mu, rl), rsr = __shfl(rstd, rl);
            float lg[3];
#pragma unroll
            for (int nt = 0; nt < 3; ++nt) lg[nt] = rsr * (acc[nt][j] - mur * Sc[16 * nt + r16]) + Bc[16 * nt + r16];
            const int gb = 16 * kq;
            const float g0 = __shfl(lg[2], gb + 0), g1v = __shfl(lg[2], gb + 1), g2 = __shfl(lg[2], gb + 2), g3 = __shfl(lg[2], gb + 3);
            int gi = 0; float gm = g0; if (g1v > gm) { gm = g1v; gi = 1; } if (g2 > gm) { gm = g2; gi = 2; } if (g3 > gm) { gm = g3; gi = 3; }
            const float gw = 1.f / (expf(g0 - gm) + expf(g1v - gm) + expf(g2 - gm) + expf(g3 - gm));
            const float lsel = (gi & 2) ? lg[1] : lg[0];
            float ev[8];
#pragma unroll
            for (int t = 0; t < 8; ++t) ev[t] = __shfl(lsel, gb + (gi & 1) * 8 + t);
            int i1 = 0; float v1 = ev[0];
#pragma unroll
            for (int t = 1; t < 8; ++t) if (ev[t] > v1) { v1 = ev[t]; i1 = t; }
            int i2 = -1; float v2 = -INFINITY;
#pragma unroll
            for (int t = 0; t < 8; ++t) if (t != i1 && ev[t] > v2) { v2 = ev[t]; i2 = t; }
            const float w1 = 1.f / (1.f + expf(v2 - v1)), w2 = 1.f - w1;
            if (r16 == 0) {
                const int lr = lrow0 + rl, r = row0 + rl, e1 = gi * 8 + i1, e2 = gi * 8 + i2;
                route_e[r] = make_int2(e1, e2); route_w[r] = make_float2(gw * w1, gw * w2);
                rowE[2 * lr] = e1; rowP[2 * lr] = atomicAdd(&lcnt[e1], 1);
                rowE[2 * lr + 1] = e2; rowP[2 * lr + 1] = atomicAdd(&lcnt[e2], 1);
            }
        }
    }
    __syncthreads();
    if (threadIdx.x < 32) lcnt[threadIdx.x] = atomicAdd(&cnt[threadIdx.x * 64], lcnt[threadIdx.x]);
    __syncthreads();
    for (int i = threadIdx.x; i < 2 * rows_per_wg; i += NTHR) { const int e = rowE[i]; list[e * 32768 + lcnt[e] + rowP[i]] = (blk * rows_per_wg + (i >> 1)) * 2 + (i & 1); }
    __syncthreads();
    if (threadIdx.x < 32) lcnt[threadIdx.x] = 0;
    __syncthreads();
    }
}

DEV void p_final(float* out, const bf16_t* x1b, const bf16_t* ys, const float* g2, const float* b2) {
    const int lane = threadIdx.x & 63;
    for (int r = (blockIdx.x * NTHR + threadIdx.x) >> 6; r < NTOK; r += gridDim.x * (NTHR / 64)) {
        float x[16]; float s = 0.f;
#pragma unroll
        for (int j = 0; j < 4; ++j) { const int col = j * 256 + lane * 4; const ushort4 tb = *(const ushort4*)(x1b + (size_t)r * 1024 + col); const float4 t = make_float4(bf2f(tb.x), bf2f(tb.y), bf2f(tb.z), bf2f(tb.w));
            const ushort4 a = *(const ushort4*)(ys + (size_t)(2 * r) * 1024 + col), b = *(const ushort4*)(ys + (size_t)(2 * r + 1) * 1024 + col);
            x[4 * j] = ALPHA * t.x + bf2f(a.x) + bf2f(b.x); x[4 * j + 1] = ALPHA * t.y + bf2f(a.y) + bf2f(b.y); x[4 * j + 2] = ALPHA * t.z + bf2f(a.z) + bf2f(b.z); x[4 * j + 3] = ALPHA * t.w + bf2f(a.w) + bf2f(b.w);
            s += (x[4 * j] + x[4 * j + 1]) + (x[4 * j + 2] + x[4 * j + 3]); }
#pragma unroll
        for (int m = 1; m < 64; m <<= 1) s += __shfl_xor(s, m);
        const float mu = s * (1.f / 1024.f); float q = 0.f;
#pragma unroll
        for (int j = 0; j < 16; ++j) { x[j] -= mu; q += x[j] * x[j]; }
#pragma unroll
        for (int m = 1; m < 64; m <<= 1) q += __shfl_xor(q, m);
        const float rstd = rsqrtf(q * (1.f / 1024.f) + LN_EPS);
#pragma unroll
        for (int j = 0; j < 4; ++j) { const int col = j * 256 + lane * 4; const float4 gg = *(const float4*)(g2 + col), bb = *(const float4*)(b2 + col);
            *(float4*)(out + (size_t)r * 1024 + col) = make_float4(x[4 * j] * rstd * gg.x + bb.x, x[4 * j + 1] * rstd * gg.y + bb.y, x[4 * j + 2] * rstd * gg.z + bb.z, x[4 * j + 3] * rstd * gg.w + bb.w); }
    }
}

struct Args { const float* in[24]; float* out; unsigned char* ws; };
__global__ void __launch_bounds__(NTHR, 2) mega_fwd(Args a) {
    extern __shared__ __attribute__((aligned(16))) unsigned char lds_raw[];
    float* ldsf = (float*)lds_raw;
    PG8_LAS unsigned char* ldsl = (PG8_LAS unsigned char*)lds_raw;
    volatile LAS unsigned* MISC = (volatile LAS unsigned*)((LAS unsigned char*)lds_raw + LDS_MISC);
    for (int u = threadIdx.x; u < 128; u += NTHR) MISC[u] = 0u;
    __syncthreads();
    unsigned char* ws = a.ws;
    XcdBarrier bar = xcd_barrier_post((unsigned*)(ws + WS_CTL) + CW_BAR, MISC + 8);
#define GRID_BAR() xcd_barrier(bar)
    const float* x = a.in[0]; const float* w_in = a.in[1]; const float* b_merge = a.in[2];
    const float* conv_w = a.in[3]; const float* conv_b = a.in[4];
    const float* w_rg_r = a.in[5]; const float* b_rg_r = a.in[6]; const float* w_rg_i = a.in[7]; const float* b_rg_i = a.in[8];
    const float* lam = a.in[9]; const float* w_ret_o = a.in[10]; const float* w_lru_o = a.in[11]; const float* w_out = a.in[12];
    const float* ln1_g = a.in[13]; const float* ln1_b = a.in[14]; const float* w_group = a.in[15]; const float* b_group = a.in[16];
    const float* w_er = a.in[17]; const float* b_er = a.in[18]; const float* w_eg = a.in[19]; const float* w_eu = a.in[20];
    const float* w_ed = a.in[21]; const float* ln2_g = a.in[22]; const float* ln2_b = a.in[23];
    float* out = a.out;
    int* cnt = (int*)(ws + WS_CTL); float2* rope = (float2*)(ws + WS_ROPE); int2* route_e = (int2*)(ws + WS_ROUTE_E); float2* route_w = (float2*)(ws + WS_ROUTE_W); int* list = (int*)(ws + WS_LIST);
    bf16_t* xb = (bf16_t*)(ws + WS_XB); bf16_t* gl = (bf16_t*)(ws + WS_GL); bf16_t* ulru = (bf16_t*)(ws + WS_ULRU); bf16_t* uconv = (bf16_t*)(ws + WS_UCONV);
    bf16_t* epsb = (bf16_t*)(ws + WS_EPS); bf16_t* inp = (bf16_t*)out;
    bf16_t* q = (bf16_t*)(ws + WS_Q); bf16_t* k = (bf16_t*)(ws + WS_K); bf16_t* v = (bf16_t*)(ws + WS_V); bf16_t* gbuf = (bf16_t*)out;
    bf16_t* P = (bf16_t*)(ws + WS_P); bf16_t* gates = (bf16_t*)(ws + WS_GATES); bf16_t* m1 = (bf16_t*)out; bf16_t* merged = xb;
    bf16_t* w_in_t = (bf16_t*)(ws + WS_WIN_T); bf16_t* w_ro_t = (bf16_t*)(ws + WS_WRO_T); bf16_t* w_lo_t = (bf16_t*)(ws + WS_WLO_T); bf16_t* w_out_t = (bf16_t*)(ws + WS_WOUT_T);
    bf16_t* wrg_t = (bf16_t*)(ws + WS_WRG_T); float* segA = (float*)(ws + WS_SEGA); float* segH = (float*)(ws + WS_SEGH); float* carry = (float*)(ws + WS_CARRY);
    float* rsb = (float*)(ws + WS_RSB);
    unsigned char* wgu8 = ws + WS_WGU_T; unsigned char* wd8 = ws + WS_WD_T; unsigned char* x1q = ws + WS_X1Q;
    bf16_t* x1b = gl; bf16_t* hbuf = (bf16_t*)(ws + WS_H); bf16_t* ys = (bf16_t*)(ws + WS_YSLOT);

    p_router_consts(ldsf, ln1_g, ln1_b, w_group, b_group, w_er, b_er, rsb); p_cvt_x(x, xb); p_rope_table(rope); p_weights(ldsf, w_in, w_ret_o, w_lru_o, w_out, w_rg_r, w_rg_i, w_in_t, w_ro_t, w_lo_t, w_out_t, wrg_t);
    GRID_BAR();
    { pg8::Gemm g{xb, w_in_t + (size_t)C_U * 1024, NTOK, 3072, 1024}; pg8::StaticOrder S; S.init(NTOK, 3072, (int)gridDim.x, (int)blockIdx.x);
      pg8::gemm_phase<pg8::EpiLruIn, pg8::StaticOrder, true, true>(ldsl, g, S, pg8::EpiLruIn{ulru, gl}); }
    GRID_BAR();
    p_lru_compute(lds_raw, ulru, conv_w, conv_b, wrg_t, b_rg_r, b_rg_i, lam, uconv, epsb, segA, segH);
    GRID_BAR();
    p_lru_carry(ldsf, segA, segH, carry);
    GRID_BAR();
    p_lru_scan(uconv, epsb, gl, carry);
    GRID_BAR();
    { pg8::Gemm g{xb, w_in_t, NTOK, 6144, 1024}; pg8::StaticOrder S; S.init(NTOK, 6144, (int)gridDim.x, (int)blockIdx.x);
      pg8::gemm_phase<pg8::EpiRetIn, pg8::StaticOrder, true, true>(ldsl, g, S, pg8::EpiRetIn{q, k, v, gbuf, (const float*)rope}); }
    GRID_BAR();
    p_scores(lds_raw, q, k, P);
    GRID_BAR();
    p_ret_mfma(lds_raw, q, k, v, P);
    GRID_BAR();
    p_headnorm(v, gbuf);
    { pg8::Gemm g{xb, w_in_t + (size_t)C_GATE * 1024, NTOK, 2048, 1024}; pg8::StaticOrder S; S.init(NTOK, 2048, (int)gridDim.x, (int)blockIdx.x);
      pg8::gemm_phase<pg8::EpiGates, pg8::StaticOrder, true, true>(ldsl, g, S, pg8::EpiGates{b_merge, gates}); }
    GRID_BAR();
    { pg8::Gemm g{v, w_ro_t, NTOK, 1024, 2048}; pg8::StaticOrder S; S.init(NTOK, 1024, (int)gridDim.x, (int)blockIdx.x);
      pg8::gemm_phase<pg8::EpiMerge<0>, pg8::StaticOrder, true, true>(ldsl, g, S, pg8::EpiMerge<0>{gates, nullptr, m1}); }
    GRID_BAR();
    { pg8::Gemm g{gl, w_lo_t, NTOK, 1024, 1536}; pg8::StaticOrder S; S.init(NTOK, 1024, (int)gridDim.x, (int)blockIdx.x);
      pg8::gemm_phase<pg8::EpiMerge<1>, pg8::StaticOrder, true, true>(ldsl, g, S, pg8::EpiMerge<1>{gates, m1, merged}); }
    GRID_BAR();
    { pg8::Gemm g{merged, w_out_t, NTOK, 1024, 1024}; pg8::StaticOrder S; S.init(NTOK, 1024, (int)gridDim.x, (int)blockIdx.x);
      pg8::gemm_phase<pg8::EpiOut, pg8::StaticOrder, true, true>(ldsl, g, S, pg8::EpiOut{x, (bf16_t*)out, ALPHA}); }
    GRID_BAR();
    p_ln1_route(ldsf, (const bf16_t*)out, x1b, x1q, ln1_g, ln1_b, w_group, b_group, w_er, b_er, route_e, route_w, cnt, list, rsb);
    p_expert_weights(ldsf, w_eg, w_eu, w_ed, wgu8, wd8);
    GRID_BAR();
    {
        PG8_LAS pg8::MoeTab* tab = (PG8_LAS pg8::MoeTab*)(ldsl + LDS_TAB);
        pg8::moe_build_tab(tab, cnt);
        const int T = tab->tileStart[32];
        { pg8::Gemm g{(const bf16_t*)x1q, (const bf16_t*)wgu8, T * 256, 32 * 1024, 512}; pg8::MoeOrder<true> S{T * 4, (int)gridDim.x, (int)blockIdx.x, tab, list};
          pg8::gemm_phase<pg8::EpiSwiGLU8, pg8::MoeOrder<true>, true, true, true>(ldsl, g, S, pg8::EpiSwiGLU8{(unsigned char*)hbuf}); }
        GRID_BAR();
        { pg8::Gemm g{hbuf, (const bf16_t*)wd8, T * 256, 32 * 1024, 256}; pg8::MoeOrder<false> S{T * 4, (int)gridDim.x, (int)blockIdx.x, tab, list};
          pg8::gemm_phase<pg8::EpiMoeOut8, pg8::MoeOrder<false>, true, true, true>(ldsl, g, S, pg8::EpiMoeOut8{tab, list, (const float*)route_w, ys}); }
    }
    GRID_BAR();
    p_final(out, x1b, ys, ln2_g, ln2_b);
}

extern "C" void kernel_launch(void* const* d_in, const int* in_sizes, int n_in, void* d_out, int out_size, void* d_ws, size_t ws_size, hipStream_t stream) {
    static int grid = 0;
    if (grid == 0) {
        if (n_in != 24 || in_sizes[0] != NTOK * DM || out_size != NTOK * DM || ws_size < WS_END) {
            fprintf(stderr, "kernel_launch: unexpected shapes (n_in %d, in0 %d, out %d, ws %zu)\n", n_in, n_in > 0 ? in_sizes[0] : -1, out_size, ws_size); grid = -1; return; }
        int dev = 0, cus = 0, per_cu = 0;
        if (hipGetDevice(&dev) != hipSuccess || hipDeviceGetAttribute(&cus, hipDeviceAttributeMultiprocessorCount, dev) != hipSuccess) { fprintf(stderr, "kernel_launch: device query failed\n"); grid = -1; return; }
        if (hipFuncSetAttribute((const void*)mega_fwd, hipFuncAttributeMaxDynamicSharedMemorySize, LDS_BYTES) != hipSuccess) { fprintf(stderr, "kernel_launch: hipFuncSetAttribute failed\n"); grid = -1; return; }
        if (hipOccupancyMaxActiveBlocksPerMultiprocessor(&per_cu, (const void*)mega_fwd, NTHR, LDS_BYTES) != hipSuccess || per_cu < 1) {
            fprintf(stderr, "kernel_launch: occupancy query reports %d workgroups per CU\n", per_cu); (void)hipGetLastError(); grid = -1; return; }
        grid = cus;
    }
    if (grid < 0) return;
    if (hipMemsetAsync((char*)d_ws + WS_CTL, 0, CTL_ZERO_BYTES, stream) != hipSuccess) { fprintf(stderr, "kernel_launch: memset failed\n"); return; }
    Args a{};
    for (int i = 0; i < 24; ++i) a.in[i] = (const float*)d_in[i];
    a.out = (float*)d_out; a.ws = (unsigned char*)d_ws;
    hipLaunchKernelGGL(mega_fwd, dim3(grid), dim3(NTHR), LDS_BYTES, stream, a);
    const hipError_t le = hipPeekAtLastError();
    if (le != hipSuccess) fprintf(stderr, "kernel_launch: launch failed: %s\n", hipGetErrorName(le));
}
```

```cpp
#include <hip/hip_runtime.h>
#include <cstdio>
#include <cstdint>

typedef unsigned short bf16_t;
#define DEV __device__ __forceinline__
#define LAS __attribute__((address_space(3)))

DEV float bf2f(bf16_t h) { return __uint_as_float(((unsigned)h) << 16); }
DEV bf16_t f2bf(float f) { unsigned u = __float_as_uint(f); return (bf16_t)((u + 0x7fffu + ((u >> 16) & 1u)) >> 16); }

constexpr int NTHR = 512;
constexpr int NTOK = 32768, DM = 1024, SEQ = 8192;
constexpr int WIN_N = 11264;
constexpr int C_Q = 0, C_K = 1024, C_V = 2048, C_G = 4096, C_U = 6144, C_GL = 7680, C_GATE = 9216;
constexpr float ALPHA = 1.189207115002721f;
constexpr float LN_EPS = 1e-5f;
constexpr size_t MiB = 1u << 20;
constexpr size_t WS_CTL = 0;
constexpr size_t CTL_ZERO_BYTES = 1 * MiB;
constexpr int CW_BAR = 4096;
constexpr size_t WS_ROPE = 1 * MiB;
constexpr size_t WS_ROUTE_E = 9 * MiB;
constexpr size_t WS_ROUTE_W = 9 * MiB + 512 * 1024;
constexpr size_t WS_LIST = 10 * MiB;
constexpr size_t WS_WRG_T = 14 * MiB;
constexpr size_t WS_RSB = 15 * MiB + 512 * 1024;
constexpr size_t WS_SEGA = 16 * MiB;
constexpr size_t WS_SEGH = 18 * MiB;
constexpr size_t WS_CARRY = 20 * MiB;
constexpr size_t WS_XB = 32 * MiB;
constexpr size_t WS_GL = 96 * MiB;
constexpr size_t WS_ULRU = 192 * MiB;
constexpr size_t WS_Q = 192 * MiB;
constexpr size_t WS_K = 256 * MiB;
constexpr size_t WS_GATES = 192 * MiB;
constexpr size_t WS_UCONV = 288 * MiB;
constexpr size_t WS_P = 320 * MiB;
constexpr size_t WS_V = 352 * MiB;
constexpr size_t WS_EPS = 384 * MiB;
constexpr size_t WS_H = 192 * MiB;
constexpr size_t WS_YSLOT = 264 * MiB;
constexpr size_t WS_WGU_T = 352 * MiB;
constexpr size_t WS_WD_T = 416 * MiB;
constexpr size_t WS_X1Q = 160 * MiB;
constexpr int LDS_TAB = 131072;
constexpr size_t WS_WIN_T = 480 * MiB;
constexpr size_t WS_WRO_T = 502 * MiB;
constexpr size_t WS_WLO_T = 506 * MiB;
constexpr size_t WS_WOUT_T = 509 * MiB;
constexpr size_t WS_END = 512 * MiB;
constexpr int LDS_BYTES = 163840;
constexpr int LDS_MISC = 163840 - 512;

#define XB_TMO      128
#define XB_XCNT(j)  (256  + 64 * (j))
#define XB_XSUB(j)  (1280 + 64 * (j))
#define XB_XGEN(j)  (2304 + 64 * (j))
#define XB_TOP      3328
#define XB_TOPGEN   3392
#define XCD_BAR_WORDS 3456
#define XB_SPIN_CAP (1u << 22)
DEV unsigned xb_ld(unsigned* p)              { return __hip_atomic_load(p, __ATOMIC_RELAXED, __HIP_MEMORY_SCOPE_AGENT); }
DEV unsigned xb_add(unsigned* p, unsigned v) { return __hip_atomic_fetch_add(p, v, __ATOMIC_RELAXED, __HIP_MEMORY_SCOPE_AGENT); }
DEV unsigned xb_xcc_id() { return (unsigned)__builtin_amdgcn_s_getreg((3 << 11) | 20) & 0xFu; }
#define XB_SPIN(cond, bar) do { unsigned _sp = 0; while (cond) { __builtin_amdgcn_s_sleep(1); \
    if ((++_sp & 255u) == 0u) { if (xb_ld(&(bar)[XB_TMO])) break; if (_sp > XB_SPIN_CAP) { atomicAdd(&(bar)[XB_TMO], 1u); break; } } } } while (0)
struct XcdBarrier { unsigned* bar; unsigned x; volatile LAS unsigned* st; };
DEV XcdBarrier xcd_barrier_post(unsigned* bar, volatile LAS unsigned* st) {
    XcdBarrier b; b.bar = bar; b.x = xb_xcc_id(); b.st = st;
    if (threadIdx.x == 0) (void)xb_add(&bar[XB_XCNT(b.x)], 1u);
    return b;
}
DEV void xcd_barrier_complete(unsigned* bar, unsigned x, unsigned& nloc, unsigned& nx) {
    const unsigned G = gridDim.x * gridDim.y * gridDim.z;
    unsigned sum, cnt, mine, sp = 0u;
    for (;;) {
        sum = 0u; cnt = 0u; mine = 0u;
#pragma unroll
        for (unsigned j = 0; j < 16; ++j) { const unsigned c = xb_ld(&bar[XB_XCNT(j)]); sum += c; cnt += (c > 0u) ? 1u : 0u; mine = (j == x) ? c : mine; }
        if (sum == G) break;
        __builtin_amdgcn_s_sleep(1);
        if ((++sp & 255u) == 0u) { if (xb_ld(&bar[XB_TMO])) break; if (sp > XB_SPIN_CAP) { atomicAdd(&bar[XB_TMO], 1u); break; } }
    }
    nloc = mine > 0u ? mine : 1u; nx = cnt > 0u ? cnt : 1u;
}
DEV void xcd_barrier(const XcdBarrier& b) {
    asm volatile("s_waitcnt vmcnt(0)" ::: "memory");
    __syncthreads();
    if (threadIdx.x == 0) {
        unsigned* bar = b.bar;
        __builtin_amdgcn_s_waitcnt(0);
        unsigned nloc = b.st[0], nx = b.st[1];
        if (nloc == 0u) { xcd_barrier_complete(bar, b.x, nloc, nx); b.st[0] = nloc; b.st[1] = nx; }
        const unsigned old = xb_add(&bar[XB_XSUB(b.x)], 1u);
        const unsigned gen = old / nloc;
        if (old + 1u == (gen + 1u) * nloc) {
            __builtin_amdgcn_fence(__ATOMIC_RELEASE, "agent");
            asm volatile("s_waitcnt vmcnt(0)" ::: "memory");
            const unsigned og = xb_add(&bar[XB_TOP], 1u);
            const unsigned tg = og / nx;
            if (og + 1u == (tg + 1u) * nx) xb_add(&bar[XB_TOPGEN], 1u);
            else XB_SPIN(xb_ld(&bar[XB_TOPGEN]) == tg, bar);
            __builtin_amdgcn_fence(__ATOMIC_ACQUIRE, "agent");
            xb_add(&bar[XB_XGEN(b.x)], 1u);
            asm volatile("s_waitcnt vmcnt(0)" ::: "memory");
        } else {
            XB_SPIN(xb_ld(&bar[XB_XGEN(b.x)]) == gen, bar);
            __builtin_amdgcn_fence(__ATOMIC_ACQUIRE, "agent");
            asm volatile("s_waitcnt vmcnt(0)" ::: "memory");
        }
    }
    __syncthreads();
}

namespace pg8 {
#define PG8_LAS __attribute__((address_space(3)))
typedef unsigned short bf16_t;
typedef short bf16x8 __attribute__((ext_vector_type(8)));
typedef float f32x4 __attribute__((ext_vector_type(4)));
typedef unsigned u32x4 __attribute__((ext_vector_type(4)));
constexpr int BM = 256, BK = 64, HALF = 128, HTB = HALF * BK * 2  , STAGE_BYTES = 8 * HTB, NXCD = 8, WGM = 8;

__host__ __device__ __forceinline__ int lds_byte(int r, int c) { const int st = (r >> 4) * 2 + (c >> 5), rr = r & 15, cc = c & 31, ob = rr * 64 + cc * 2; return st * 1024 + (ob ^ (((ob >> 9) & 1) << 5)); }
__host__ __device__ __forceinline__ void stage_rc(int b, int& R, int& C) { const int st = b / 1024, sb = b % 1024, swz = sb ^ (((sb >> 9) & 1) << 5); R = (st >> 1) * 16 + swz / 64; C = (st & 1) * 32 + (swz % 64) / 2; }
__host__ __device__ __forceinline__ int perm32(int rho) { const int n = rho >> 4, i = rho & 15; return 8 * (i >> 2) + 4 * n + (i & 3); }

struct Unit { int pm, pn; };
struct Gemm { const bf16_t* A; const bf16_t* Bt; int M, N, K; };

struct StaticOrder {
    int nM, nN, nwg, G, c;
    __host__ __device__ void init(int M, int N, int G_, int c_) { nM = M / BM; nN = N / BM; nwg = nM * nN; G = G_; c = c_; }
    __host__ __device__ bool next(int i, Unit& u) const {
        const long L = (long)i * G + c; if (L >= nwg) return false;
        int wgid = (int)L; { const int q = nwg / NXCD, r = nwg % NXCD, xcd = wgid % NXCD, off = wgid / NXCD; wgid = (xcd < r ? xcd * (q + 1) : r * (q + 1) + (xcd - r) * q) + off; }
        const int nig = WGM * nN, gid = wgid / nig, fm = gid * WGM, gsz = (nM - fm) < WGM ? (nM - fm) : WGM;
        u.pm = fm + ((wgid % nig) % gsz); u.pn = (wgid % nig) / gsz; return true;
    }
    __device__ __forceinline__ void a_ready(const Unit&) const {}
    __device__ __forceinline__ void done(const Unit&) const {}
    __device__ __forceinline__ const char* a_base(const Gemm& g, const Unit& u) const { return (const char*)g.A + (size_t)u.pm * (size_t)(BM * g.K * 2); }
    __device__ __forceinline__ void a_off(const Gemm& g, const Unit&, const int (&R)[2], const int (&C)[2], unsigned (&v)[2][2]) const {
        _Pragma("unroll") for (int hh = 0; hh < 2; ++hh) _Pragma("unroll") for (int i = 0; i < 2; ++i) v[hh][i] = (unsigned)((hh * HALF + R[i]) * g.K + C[i]) * 2u; }
};
typedef __bf16 bf16x2_t __attribute__((ext_vector_type(2)));
typedef float f32x2_t __attribute__((ext_vector_type(2)));
__device__ __forceinline__ unsigned cvt_pk_bf16(float lo, float hi) { f32x2_t v = {lo, hi}; return __builtin_bit_cast(unsigned, __builtin_convertvector(v, bf16x2_t)); }
typedef int i32x4 __attribute__((ext_vector_type(4)));
typedef int i32x8 __attribute__((ext_vector_type(8)));
template <bool MX8> struct Frag { struct A4 { bf16x8 v[4][2]; }; struct B2 { bf16x8 v[2][2]; }; };
template <> struct Frag<true> { struct A4 { i32x8 v[4]; }; struct B2 { i32x8 v[2]; }; };
__device__ __forceinline__ i32x8 ld32(const PG8_LAS unsigned char* p0, const PG8_LAS unsigned char* p1) { const i32x4 a = *(const PG8_LAS i32x4*)p0, b = *(const PG8_LAS i32x4*)p1; return __builtin_shufflevector(a, b, 0, 1, 2, 3, 4, 5, 6, 7); }
template <class Epi, class Sched, bool ALIGN_EPI = false, bool SP2 = false, bool MX8 = false>
__device__ __forceinline__ void gemm_phase(PG8_LAS unsigned char* lds, const Gemm g, const Sched& S, const Epi& E) {
    int tid_ = threadIdx.x; asm volatile("" : "+v"(tid_));
    const int tid = tid_, wid = __builtin_amdgcn_readfirstlane(tid >> 6), lane = tid & 63, wr = wid >> 2, wc = wid & 3, fr = lane & 15, fq = lane >> 4;
    const int K = g.K, nt = K / BK;
    unsigned voffB[2], vA[2][2], vN[2][2]; int sR[2], sC[2];
#pragma unroll
    for (int i = 0; i < 2; ++i) { int R, C; stage_rc(tid * 16 + i * 8192, R, C); const int Rb = Epi::PERM ? ((R & ~31) + perm32(R & 31)) : R;
        sR[i] = R; sC[i] = C; voffB[i] = (unsigned)(Rb * K + C) * 2u; }
    const size_t kstep = (size_t)(BK * 2);
    const size_t hstep = (size_t)HALF * K * 2;
    const size_t tstep = 2 * hstep;
    const unsigned ldsw = (unsigned)wid * 1024u;
    const int aoff = lds_byte(wr * 64 + fr, fq * 8), boff = lds_byte(wc * 32 + fr, fq * 8);
#define PG8_SA(b, h) (((b) * 2 + (h)) * HTB)
#define PG8_SB(b, h) ((4 + (b) * 2 + (h)) * HTB)
#define PG8_STAGE(bufoff, gbase, voff) do { _Pragma("unroll") for (int _i = 0; _i < 2; ++_i) \
        __builtin_amdgcn_global_load_lds((const unsigned*)((const char*)(gbase) + (voff)[_i]), (PG8_LAS unsigned*)(lds + (bufoff) + ldsw + _i * 8192), 16, 0, 0); } while (0)
#define PG8_LDA(dst, b, h) do { if constexpr (MX8) { _Pragma("unroll") for (int m = 0; m < 4; ++m) dst.v[m] = ld32(lds + PG8_SA(b, h) + aoff + m * 2048, lds + PG8_SA(b, h) + aoff + m * 2048 + 1024); } \
        else { _Pragma("unroll") for (int m = 0; m < 4; ++m) _Pragma("unroll") for (int k = 0; k < 2; ++k) dst.v[m][k] = *(const PG8_LAS bf16x8*)(lds + PG8_SA(b, h) + aoff + m * 2048 + k * 1024); } } while (0)
#define PG8_LDB(dst, b, h) do { if constexpr (MX8) { _Pragma("unroll") for (int n = 0; n < 2; ++n) dst.v[n] = ld32(lds + PG8_SB(b, h) + boff + n * 2048, lds + PG8_SB(b, h) + boff + n * 2048 + 1024); } \
        else { _Pragma("unroll") for (int n = 0; n < 2; ++n) _Pragma("unroll") for (int k = 0; k < 2; ++k) dst.v[n][k] = *(const PG8_LAS bf16x8*)(lds + PG8_SB(b, h) + boff + n * 2048 + k * 1024); } } while (0)
#define PG8_MMA(ai, bj, At, Bt) do { __builtin_amdgcn_s_setprio(1); \
        if constexpr (MX8) { _Pragma("unroll") for (int m = 0; m < 4; ++m) _Pragma("unroll") for (int n = 0; n < 2; ++n) \
            { acc[ai][bj][m][n] = __builtin_amdgcn_mfma_scale_f32_16x16x128_f8f6f4(Bt.v[n], At.v[m], acc[ai][bj][m][n], 0, 0, 0, 0x7f7f7f7f, 0, 0x7f7f7f7f); asm volatile("" : "+v"(acc[ai][bj][m][n])); } } \
        else { _Pragma("unroll") for (int m = 0; m < 4; ++m) _Pragma("unroll") for (int n = 0; n < 2; ++n) _Pragma("unroll") for (int k = 0; k < 2; ++k) \
            acc[ai][bj][m][n] = __builtin_amdgcn_mfma_f32_16x16x32_bf16(Bt.v[n][k], At.v[m][k], acc[ai][bj][m][n], 0, 0, 0); } \
        __builtin_amdgcn_s_setprio(0); } while (0)
#define PG8_WAIT_V(n) asm volatile("s_waitcnt vmcnt(" #n ")" ::: "memory")
#define PG8_WAIT_L(n) asm volatile("s_waitcnt lgkmcnt(" #n ")" ::: "memory")
#define PG8_BAR __builtin_amdgcn_s_barrier()
#define PG8_SCHED __builtin_amdgcn_sched_barrier(0)
    Unit cur, nxt; int ui = 0;
    if (!S.next(0, cur)) return;
    f32x4 acc[2][2][4][2];
#pragma unroll
    for (int a = 0; a < 2; ++a)
#pragma unroll
        for (int b = 0; b < 2; ++b)
#pragma unroll
            for (int m = 0; m < 4; ++m)
#pragma unroll
                for (int n = 0; n < 2; ++n) acc[a][b][m][n] = (f32x4){0.f, 0.f, 0.f, 0.f};
    typename Frag<MX8>::A4 At; typename Frag<MX8>::B2 B0, B1;
    const char* cA = S.a_base(g, cur); const char* cB = (const char*)g.Bt + (size_t)cur.pn * tstep;
    S.a_ready(cur); S.a_off(g, cur, sR, sC, vA);
    if constexpr (SP2) {
        PG8_STAGE(PG8_SB(0, 0), cB, voffB); PG8_STAGE(PG8_SB(0, 1), cB + hstep, voffB); PG8_STAGE(PG8_SA(0, 0), cA, vA[0]); PG8_STAGE(PG8_SA(0, 1), cA, vA[1]);
        if (wr == 1) PG8_BAR;
        PG8_WAIT_V(2); PG8_BAR;
        PG8_STAGE(PG8_SB(1, 0), cB + kstep, voffB); PG8_STAGE(PG8_SA(1, 0), cA + kstep, vA[0]); PG8_STAGE(PG8_SB(1, 1), cB + hstep + kstep, voffB);
        PG8_WAIT_V(6); PG8_BAR;
    } else { static_assert(SP2, "only the SP2 K-loop is kept in this file"); }
    for (;;) {
        const bool has_next = S.next(ui + 1, nxt);
        const char* nA = has_next ? S.a_base(g, nxt) : cA; const char* nB = has_next ? (const char*)g.Bt + (size_t)nxt.pn * tstep : cB;
        if (has_next) S.a_off(g, nxt, sR, sC, vN); else { vN[0][0] = vA[0][0]; vN[0][1] = vA[0][1]; vN[1][0] = vA[1][0]; vN[1][1] = vA[1][1]; }
#pragma unroll 1
        for (int t = 0; t < nt; t += 2) {
            const bool last = (t == nt - 2);
            const char* a1 = cA + (size_t)(t + 1) * kstep;
            const char* a2 = last ? nA : cA + (size_t)(t + 2) * kstep; const char* b2 = last ? nB : cB + (size_t)(t + 2) * kstep;
            const char* a3 = a2 + kstep; const char* b3 = b2 + kstep;
            unsigned v2[2][2]; v2[0][0] = last ? vN[0][0] : vA[0][0]; v2[0][1] = last ? vN[0][1] : vA[0][1]; v2[1][0] = last ? vN[1][0] : vA[1][0]; v2[1][1] = last ? vN[1][1] : vA[1][1];
            if (last && has_next) S.a_ready(nxt);
            if constexpr (SP2) {
            PG8_LDB(B0, 0, 0); PG8_LDB(B1, 0, 1); PG8_SCHED; PG8_LDA(At, 0, 0); PG8_STAGE(PG8_SA(1, 1), a1, vA[1]);
            PG8_WAIT_V(8); PG8_WAIT_L(0); PG8_BAR; PG8_MMA(0, 0, At, B0); PG8_MMA(0, 1, At, B1); PG8_BAR; PG8_SCHED;
            PG8_LDA(At, 0, 1); PG8_STAGE(PG8_SB(0, 0), b2, voffB); PG8_STAGE(PG8_SB(0, 1), b2 + hstep, voffB); PG8_STAGE(PG8_SA(0, 0), a2, v2[0]);
            PG8_WAIT_V(8); PG8_WAIT_L(0); PG8_BAR; PG8_MMA(1, 0, At, B0); PG8_MMA(1, 1, At, B1); PG8_BAR; PG8_SCHED;
            PG8_LDB(B0, 1, 0); PG8_LDB(B1, 1, 1); PG8_SCHED; PG8_LDA(At, 1, 0); PG8_STAGE(PG8_SA(0, 1), a2, v2[1]);
            PG8_WAIT_V(8); PG8_WAIT_L(0); PG8_BAR; PG8_MMA(0, 0, At, B0); PG8_MMA(0, 1, At, B1); PG8_BAR; PG8_SCHED;
            PG8_LDA(At, 1, 1); PG8_STAGE(PG8_SB(1, 0), b3, voffB); PG8_STAGE(PG8_SB(1, 1), b3 + hstep, voffB); PG8_STAGE(PG8_SA(1, 0), a3, v2[0]);
            PG8_WAIT_V(8); PG8_WAIT_L(0); PG8_BAR; PG8_MMA(1, 0, At, B0); PG8_MMA(1, 1, At, B1); PG8_BAR; PG8_SCHED;
            }
        }
        if constexpr (ALIGN_EPI) { if (wr == 0) PG8_BAR; }
        if constexpr (!Epi::AFTER_DRAIN) { E(acc, cur, wr, wc, fr, fq); S.done(cur); }
        if (!has_next) break;
#pragma unroll
        for (int a = 0; a < 2; ++a)
#pragma unroll
            for (int b = 0; b < 2; ++b)
#pragma unroll
                for (int m = 0; m < 4; ++m)
#pragma unroll
                    for (int n = 0; n < 2; ++n) acc[a][b][m][n] = (f32x4){0.f, 0.f, 0.f, 0.f};
        cur = nxt; cA = nA; cB = nB; ++ui; vA[0][0] = vN[0][0]; vA[0][1] = vN[0][1]; vA[1][0] = vN[1][0]; vA[1][1] = vN[1][1];
        if constexpr (ALIGN_EPI) { if (wr == 1) PG8_BAR; }
    }
    PG8_WAIT_V(0);
    if constexpr (!ALIGN_EPI) { if (wr == 0) PG8_BAR; }
    PG8_BAR;
    if constexpr (Epi::AFTER_DRAIN) { E.fused(acc, cur, wr, wc, fr, fq, lds, wid, lane); S.done(cur); }
#undef PG8_SA
#undef PG8_SB
#undef PG8_STAGE
#undef PG8_LDA
#undef PG8_LDB
#undef PG8_MMA
#undef PG8_WAIT_V
#undef PG8_WAIT_L
#undef PG8_BAR
#undef PG8_SCHED
}

__device__ __forceinline__ float fsig(float x) { return __builtin_amdgcn_rcpf(1.f + __expf(-x)); }
__device__ __forceinline__ float fsilu(float x) { return x * fsig(x); }
__device__ __forceinline__ float fgelu(float x) { return x * fsig(1.5957691216057308f * (x + 0.044715f * x * x * x)); }
__device__ __forceinline__ u32x4 pack8(const f32x4& v0, const f32x4& v1) { u32x4 w; w.x = cvt_pk_bf16(v0[0], v0[1]); w.y = cvt_pk_bf16(v0[2], v0[3]); w.z = cvt_pk_bf16(v1[0], v1[1]); w.w = cvt_pk_bf16(v1[2], v1[3]); return w; }
__device__ __forceinline__ void unpack8(const u32x4& w, f32x4& v0, f32x4& v1) {
    v0[0] = __uint_as_float(w.x << 16); v0[1] = __uint_as_float(w.x & 0xffff0000u); v0[2] = __uint_as_float(w.y << 16); v0[3] = __uint_as_float(w.y & 0xffff0000u);
    v1[0] = __uint_as_float(w.z << 16); v1[1] = __uint_as_float(w.z & 0xffff0000u); v1[2] = __uint_as_float(w.w << 16); v1[3] = __uint_as_float(w.w & 0xffff0000u); }

struct EpiLruIn {
    static constexpr bool PERM = true, AFTER_DRAIN = false;
    bf16_t* u; bf16_t* gl;
    __device__ __forceinline__ void operator()(const f32x4 (&acc)[2][2][4][2], const Unit& un, int wr, int wc, int fr, int fq) const {
        const int row0 = un.pm * BM + wr * 64 + fr; const bool isg = un.pn >= 6;
        bf16_t* base = (isg ? gl : u) + (isg ? un.pn - 6 : un.pn) * BM + wc * 32 + 8 * fq;
#pragma unroll
        for (int ai = 0; ai < 2; ++ai)
#pragma unroll
            for (int m = 0; m < 4; ++m) { bf16_t* rowp = base + (size_t)(row0 + ai * HALF + m * 16) * 1536;
#pragma unroll
                for (int bj = 0; bj < 2; ++bj) { f32x4 v0 = acc[ai][bj][m][0], v1 = acc[ai][bj][m][1];
                    if (isg) {
#pragma unroll
                        for (int e = 0; e < 4; ++e) { v0[e] = fgelu(v0[e]); v1[e] = fgelu(v1[e]); } }
                    *(u32x4*)(rowp + bj * HALF) = pack8(v0, v1); } }
    }
};
struct EpiRetIn {
    static constexpr bool PERM = true, AFTER_DRAIN = false;
    bf16_t* q; bf16_t* k; bf16_t* v; bf16_t* g; const float* rope;
    __device__ __forceinline__ void operator()(const f32x4 (&acc)[2][2][4][2], const Unit& un, int wr, int wc, int fr, int fq) const {
        const int row0 = un.pm * BM + wr * 64 + fr;
        if (un.pn < 8) {
            const bool isk = un.pn >= 4; const int h = un.pn & 3;
            const float lg = __log2f(1.f - __builtin_amdgcn_exp2f(-5.f - (float)h));
            const int jb = wc * 32 + 8 * fq;
            bf16_t* base = (isk ? k : q) + h * 256 + jb;
#pragma unroll
            for (int ai = 0; ai < 2; ++ai)
#pragma unroll
                for (int m = 0; m < 4; ++m) { const int r = row0 + ai * HALF + m * 16, s = r & 8191, n = s & 127;
                    const float sc = isk ? __builtin_amdgcn_exp2f(-(float)n * lg) * 0.0625f : __builtin_amdgcn_exp2f((float)n * lg);
                    const f32x4* tp = (const f32x4*)(rope + ((size_t)s * 128 + jb) * 2);
                    f32x4 o1[2], o2[2];
#pragma unroll
                    for (int nn = 0; nn < 2; ++nn) { const f32x4 ta = tp[2 * nn], tb = tp[2 * nn + 1]; const f32x4 a = acc[ai][0][m][nn], b = acc[ai][1][m][nn];
                        o1[nn][0] = (a[0] * ta[0] - b[0] * ta[1]) * sc; o2[nn][0] = (a[0] * ta[1] + b[0] * ta[0]) * sc;
                        o1[nn][1] = (a[1] * ta[2] - b[1] * ta[3]) * sc; o2[nn][1] = (a[1] * ta[3] + b[1] * ta[2]) * sc;
                        o1[nn][2] = (a[2] * tb[0] - b[2] * tb[1]) * sc; o2[nn][2] = (a[2] * tb[1] + b[2] * tb[0]) * sc;
                        o1[nn][3] = (a[3] * tb[2] - b[3] * tb[3]) * sc; o2[nn][3] = (a[3] * tb[3] + b[3] * tb[2]) * sc; }
                    bf16_t* rowp = isk ? base + (size_t)r * 1024 : q + ((size_t)(r >> 7) * 4 + h) * 32768 + ((wc * 4 + fq) * 128 + n) * 8;
                    *(u32x4*)(rowp) = pack8(o1[0], o1[1]); *(u32x4*)(rowp + (isk ? HALF : 16384)) = pack8(o2[0], o2[1]);
                    asm volatile("" ::: "memory"); }
        } else {
            const bool isg = un.pn >= 16;
            bf16_t* base = (isg ? g : v) + ((un.pn - 8) & 7) * BM + wc * 32 + 8 * fq;
#pragma unroll
            for (int ai = 0; ai < 2; ++ai)
#pragma unroll
                for (int m = 0; m < 4; ++m) { bf16_t* rowp = base + (size_t)(row0 + ai * HALF + m * 16) * 2048;
#pragma unroll
                    for (int bj = 0; bj < 2; ++bj) { f32x4 v0 = acc[ai][bj][m][0], v1 = acc[ai][bj][m][1];
                        if (isg) {
#pragma unroll
                            for (int e = 0; e < 4; ++e) { v0[e] = fsilu(v0[e]); v1[e] = fsilu(v1[e]); } }
                        *(u32x4*)(rowp + bj * HALF) = pack8(v0, v1); } }
        }
    }
};
struct EpiGates {
    static constexpr bool PERM = true, AFTER_DRAIN = false;
    const float* bm; bf16_t* gates;
    __device__ __forceinline__ void operator()(const f32x4 (&acc)[2][2][4][2], const Unit& un, int wr, int wc, int fr, int fq) const {
        const int row0 = un.pm * BM + wr * 64 + fr, col0 = un.pn * BM + wc * 32 + 8 * fq;
        f32x4 bv[2][2];
#pragma unroll
        for (int bj = 0; bj < 2; ++bj)
#pragma unroll
            for (int n = 0; n < 2; ++n) bv[bj][n] = *(const f32x4*)(bm + col0 + bj * HALF + 4 * n);
#pragma unroll
        for (int ai = 0; ai < 2; ++ai)
#pragma unroll
            for (int m = 0; m < 4; ++m) { bf16_t* rowp = gates + (size_t)(row0 + ai * HALF + m * 16) * 2048 + col0;
#pragma unroll
                for (int bj = 0; bj < 2; ++bj) { f32x4 v0 = acc[ai][bj][m][0] + bv[bj][0], v1 = acc[ai][bj][m][1] + bv[bj][1];
#pragma unroll
                    for (int e = 0; e < 4; ++e) { v0[e] = fsig(v0[e]); v1[e] = fsig(v1[e]); }
                    *(u32x4*)(rowp + bj * HALF) = pack8(v0, v1); } }
    }
};
template <int MODE> struct EpiMerge {
    static constexpr bool PERM = true, AFTER_DRAIN = false;
    const bf16_t* gates; const bf16_t* m1in; bf16_t* o;
    __device__ __forceinline__ void operator()(const f32x4 (&acc)[2][2][4][2], const Unit& un, int wr, int wc, int fr, int fq) const {
        const int row0 = un.pm * BM + wr * 64 + fr, col0 = un.pn * BM + wc * 32 + 8 * fq;
#pragma unroll
        for (int ai = 0; ai < 2; ++ai)
#pragma unroll
            for (int m = 0; m < 4; ++m) { const size_t r = (size_t)(row0 + ai * HALF + m * 16);
#pragma unroll
                for (int bj = 0; bj < 2; ++bj) { const int c = col0 + bj * HALF;
                    f32x4 g0, g1; unpack8(*(const u32x4*)(gates + r * 2048 + MODE * 1024 + c), g0, g1);
                    f32x4 v0 = acc[ai][bj][m][0] * g0, v1 = acc[ai][bj][m][1] * g1;
                    if (MODE == 1) { f32x4 p0, p1; unpack8(*(const u32x4*)(m1in + r * 1024 + c), p0, p1); v0 += p0; v1 += p1; }
                    *(u32x4*)(o + r * 1024 + c) = pack8(v0, v1); } }
    }
};
struct EpiOut {
    static constexpr bool PERM = true, AFTER_DRAIN = false;
    const float* x; bf16_t* y; float alpha;
    __device__ __forceinline__ void operator()(const f32x4 (&acc)[2][2][4][2], const Unit& un, int wr, int wc, int fr, int fq) const {
        const int row0 = un.pm * BM + wr * 64 + fr, col0 = un.pn * BM + wc * 32 + 8 * fq;
#pragma unroll
        for (int ai = 0; ai < 2; ++ai)
#pragma unroll
            for (int m = 0; m < 4; ++m) { const size_t off = (size_t)(row0 + ai * HALF + m * 16) * 1024 + col0;
#pragma unroll
                for (int bj = 0; bj < 2; ++bj) { const f32x4 x0 = *(const f32x4*)(x + off + bj * HALF), x1 = *(const f32x4*)(x + off + bj * HALF + 4);
                    *(u32x4*)(y + off + bj * HALF) = pack8(x0 * alpha + acc[ai][bj][m][0], x1 * alpha + acc[ai][bj][m][1]); } }
    }
};
struct MoeTab { int tileStart[33]; int cnt[32]; int pad_[3]; int tileExp[320]; };
__device__ __forceinline__ void moe_build_tab(PG8_LAS MoeTab* tab, const int* cnt) {
    if (threadIdx.x == 0) { int t = 0; for (int e = 0; e < 32; ++e) { const int c = cnt[e * 64], nt = (c + 255) >> 8; tab->tileStart[e] = t; tab->cnt[e] = c; for (int i = 0; i < nt; ++i) tab->tileExp[t + i] = e; t += nt; } tab->tileStart[32] = t; }
    __syncthreads();
}
template <bool GATHER> struct MoeOrder {
    int U, G, c; const PG8_LAS MoeTab* tab; const int* list;
    __device__ __forceinline__ bool next(int i, Unit& u) const {
        const long L = (long)i * G + c; if (L >= U) return false;
        int wgid = (int)L; { const int q = U / NXCD, r = U % NXCD, xcd = wgid % NXCD, off = wgid / NXCD; wgid = (xcd < r ? xcd * (q + 1) : r * (q + 1) + (xcd - r) * q) + off; }
        u.pm = wgid >> 2; u.pn = tab->tileExp[u.pm] * 4 + (wgid & 3); return true;
    }
    __device__ __forceinline__ void a_ready(const Unit&) const {}
    __device__ __forceinline__ void done(const Unit&) const {}
    __device__ __forceinline__ const char* a_base(const Gemm& g, const Unit& u) const { return GATHER ? (const char*)g.A : (const char*)g.A + (size_t)u.pm * (size_t)(BM * g.K * 2); }
    __device__ __forceinline__ void a_off(const Gemm& g, const Unit& u, const int (&R)[2], const int (&C)[2], unsigned (&v)[2][2]) const {
        if (!GATHER) { _Pragma("unroll") for (int hh = 0; hh < 2; ++hh) _Pragma("unroll") for (int i = 0; i < 2; ++i) v[hh][i] = (unsigned)((hh * HALF + R[i]) * g.K + C[i]) * 2u; }
        else { const int e = u.pn >> 2, base = (u.pm - tab->tileStart[e]) * BM, ce = tab->cnt[e];
            _Pragma("unroll") for (int hh = 0; hh < 2; ++hh) _Pragma("unroll") for (int i = 0; i < 2; ++i) { const int lr = base + hh * HALF + R[i]; const int tok = (lr < ce) ? (list[e * 32768 + lr] >> 1) : 0; v[hh][i] = (unsigned)(tok * g.K + C[i]) * 2u; } }
    }
};
struct EpiSwiGLU {
    static constexpr bool PERM = true, AFTER_DRAIN = false;
    bf16_t* h;
    __device__ __forceinline__ void operator()(const f32x4 (&acc)[2][2][4][2], const Unit& un, int wr, int wc, int fr, int fq) const {
        const int row0 = un.pm * BM + wr * 64 + fr, col0 = (un.pn & 3) * 128 + wc * 32 + 8 * fq;
#pragma unroll
        for (int ai = 0; ai < 2; ++ai)
#pragma unroll
            for (int m = 0; m < 4; ++m) { f32x4 v0, v1;
#pragma unroll
                for (int e = 0; e < 4; ++e) { v0[e] = fsilu(acc[ai][0][m][0][e]) * acc[ai][1][m][0][e]; v1[e] = fsilu(acc[ai][0][m][1][e]) * acc[ai][1][m][1][e]; }
                *(u32x4*)(h + (size_t)(row0 + ai * HALF + m * 16) * 512 + col0) = pack8(v0, v1); }
    }
};
struct EpiMoeOut {
    static constexpr bool PERM = true, AFTER_DRAIN = false;
    const PG8_LAS MoeTab* tab; const int* list; const float* rw; bf16_t* ys;
    __device__ __forceinline__ void operator()(const f32x4 (&acc)[2][2][4][2], const Unit& un, int wr, int wc, int fr, int fq) const {
        const int e = un.pn >> 2, lrow0 = (un.pm - tab->tileStart[e]) * BM + wr * 64 + fr, ce = tab->cnt[e], col0 = (un.pn & 3) * BM + wc * 32 + 8 * fq;
        int slot[8]; float wgt[8];
#pragma unroll
        for (int i = 0; i < 8; ++i) { const int lr = lrow0 + (i >> 2) * HALF + (i & 3) * 16; slot[i] = (lr < ce) ? list[e * 32768 + lr] : -1; }
#pragma unroll
        for (int i = 0; i < 8; ++i) wgt[i] = (slot[i] >= 0) ? rw[slot[i]] : 0.f;
#pragma unroll
        for (int ai = 0; ai < 2; ++ai)
#pragma unroll
            for (int m = 0; m < 4; ++m) { const int i = ai * 4 + m;
                if (slot[i] >= 0) { const float w = wgt[i]; bf16_t* rowp = ys + (size_t)slot[i] * 1024 + col0;
#pragma unroll
                    for (int bj = 0; bj < 2; ++bj) *(u32x4*)(rowp + bj * HALF) = pack8(acc[ai][bj][m][0] * w, acc[ai][bj][m][1] * w); } }
    }
};

__device__ __forceinline__ float clamp448(float v) { return fminf(fmaxf(v, -448.f), 448.f); }
__device__ __forceinline__ unsigned pk4_fp8(float a, float b, float c, float d) { int p = __builtin_amdgcn_cvt_pk_fp8_f32(clamp448(a), clamp448(b), 0, false); p = __builtin_amdgcn_cvt_pk_fp8_f32(clamp448(c), clamp448(d), p, true); return (unsigned)p; }
constexpr float FP8_SX = 4.f, FP8_SW = 64.f, FP8_SH = 8.f;
struct EpiSwiGLU8 {
    static constexpr bool PERM = true, AFTER_DRAIN = false;
    unsigned char* h;
    __device__ __forceinline__ void operator()(const f32x4 (&acc)[2][2][4][2], const Unit& un, int wr, int wc, int fr, int fq) const {
        const int row0 = un.pm * BM + wr * 64 + fr, col0 = (un.pn & 3) * 128 + wc * 32 + 8 * fq; const float ds = 1.f / (FP8_SX * FP8_SW);
#pragma unroll
        for (int ai = 0; ai < 2; ++ai)
#pragma unroll
            for (int m = 0; m < 4; ++m) { float v[8];
#pragma unroll
                for (int e = 0; e < 4; ++e) { v[e] = FP8_SH * fsilu(acc[ai][0][m][0][e] * ds) * (acc[ai][1][m][0][e] * ds); v[4 + e] = FP8_SH * fsilu(acc[ai][0][m][1][e] * ds) * (acc[ai][1][m][1][e] * ds); }
                uint2 o; o.x = pk4_fp8(v[0], v[1], v[2], v[3]); o.y = pk4_fp8(v[4], v[5], v[6], v[7]);
                *(uint2*)(h + (size_t)(row0 + ai * HALF + m * 16) * 512 + col0) = o; }
    }
};
struct EpiMoeOut8 {
    static constexpr bool PERM = true, AFTER_DRAIN = false;
    const PG8_LAS MoeTab* tab; const int* list; const float* rw; bf16_t* ys;
    __device__ __forceinline__ void operator()(const f32x4 (&acc)[2][2][4][2], const Unit& un, int wr, int wc, int fr, int fq) const {
        const int e = un.pn >> 2, lrow0 = (un.pm - tab->tileStart[e]) * BM + wr * 64 + fr, ce = tab->cnt[e], col0 = (un.pn & 3) * BM + wc * 32 + 8 * fq;
#pragma unroll
        for (int ai = 0; ai < 2; ++ai)
#pragma unroll
            for (int m = 0; m < 4; ++m) { const int lr = lrow0 + ai * HALF + m * 16;
                if (lr < ce) { const int slot = list[e * 32768 + lr]; const float w = rw[slot] * (1.f / (FP8_SH * FP8_SW)); bf16_t* rowp = ys + (size_t)slot * 1024 + col0;
#pragma unroll
                    for (int bj = 0; bj < 2; ++bj) *(u32x4*)(rowp + bj * HALF) = pack8(acc[ai][bj][m][0] * w, acc[ai][bj][m][1] * w); }
                asm volatile("" ::: "memory"); }
    }
};
}

DEV unsigned pk2(float lo, float hi) { return (unsigned)f2bf(lo) | ((unsigned)f2bf(hi) << 16); }
typedef unsigned v4u __attribute__((ext_vector_type(4)));
DEV void transpose_item(const float* W, int K, int N, bf16_t* WT, int row_off, float* scr, int item, int lane) {
    const int nblk = N / 32, kb = item / nblk, nb = item % nblk, k0 = 64 * kb, n0 = 32 * nb;
    float wv[32];
#pragma unroll
    for (int i = 0; i < 32; ++i) wv[i] = W[(size_t)(k0 + 2 * i + (lane >> 5)) * N + n0 + (lane & 31)];
#pragma unroll
    for (int i = 0; i < 32; ++i) scr[(2 * i + (lane >> 5)) * 33 + (lane & 31)] = wv[i];
    asm volatile("s_waitcnt lgkmcnt(0)" ::: "memory");
    const int c = lane & 7;
#pragma unroll
    for (int j = 0; j < 4; ++j) { const int n = (lane >> 3) + 8 * j; const float* s = scr + (8 * c) * 33 + n;
        v4u o; o.x = pk2(s[0 * 33], s[1 * 33]); o.y = pk2(s[2 * 33], s[3 * 33]); o.z = pk2(s[4 * 33], s[5 * 33]); o.w = pk2(s[6 * 33], s[7 * 33]);
        *(v4u*)(WT + (size_t)(row_off + n0 + n) * K + k0 + 8 * c) = o; }
    asm volatile("s_waitcnt lgkmcnt(0)" ::: "memory");
}
DEV void p_weights(float* lds, const float* w_in, const float* w_ret_o, const float* w_lru_o, const float* w_out, const float* w_rg_r, const float* w_rg_i, bf16_t* w_in_t, bf16_t* w_ro_t, bf16_t* w_lo_t, bf16_t* w_out_t, bf16_t* wrg_t) {
    const int wave = threadIdx.x >> 6, lane = threadIdx.x & 63;
    float* scr = lds + wave * 2304;
    constexpr int I0 = 16 * (WIN_N / 32), I1 = 32 * 32, I2 = 24 * 32, I3 = 16 * 32, I4 = 16 * 18;
    for (int it = blockIdx.x * 8 + wave; it < I0 + I1 + I2 + I3 + I4; it += gridDim.x * 8) {
        int r = it;
        if (r < I0) { transpose_item(w_in, 1024, WIN_N, w_in_t, 0, scr, r, lane); continue; } r -= I0;
        if (r < I1) { transpose_item(w_ret_o, 2048, 1024, w_ro_t, 0, scr, r, lane); continue; } r -= I1;
        if (r < I2) { transpose_item(w_lru_o, 1536, 1024, w_lo_t, 0, scr, r, lane); continue; } r -= I2;
        if (r < I3) { transpose_item(w_out, 1024, 1024, w_out_t, 0, scr, r, lane); continue; } r -= I3;
        { const int mi = r / 18, sub = r - mi * 18; const float* W = (mi < 8 ? w_rg_r + (size_t)mi * 192 * 192 : w_rg_i + (size_t)(mi - 8) * 192 * 192);
          transpose_item(W, 192, 192, wrg_t + (size_t)mi * 192 * 192, 0, scr, sub, lane); }
    }
}


DEV void transpose_item_fp8(const float* W, int K, int N, unsigned char* WT, int row_off, float scale, float* scr, int item, int lane) {
    const int nblk = N / 32, kb = item / nblk, nb = item % nblk, k0 = 64 * kb, n0 = 32 * nb;
    float wv[32];
#pragma unroll
    for (int i = 0; i < 32; ++i) wv[i] = W[(size_t)(k0 + 2 * i + (lane >> 5)) * N + n0 + (lane & 31)];
#pragma unroll
    for (int i = 0; i < 32; ++i) scr[(2 * i + (lane >> 5)) * 33 + (lane & 31)] = wv[i] * scale;
    asm volatile("s_waitcnt lgkmcnt(0)" ::: "memory");
    const int c = lane & 3;
#pragma unroll
    for (int j = 0; j < 2; ++j) { const int n = (lane >> 2) + 16 * j; const float* s = scr + (16 * c) * 33 + n;
        v4u o; o.x = pg8::pk4_fp8(s[0 * 33], s[1 * 33], s[2 * 33], s[3 * 33]); o.y = pg8::pk4_fp8(s[4 * 33], s[5 * 33], s[6 * 33], s[7 * 33]);
        o.z = pg8::pk4_fp8(s[8 * 33], s[9 * 33], s[10 * 33], s[11 * 33]); o.w = pg8::pk4_fp8(s[12 * 33], s[13 * 33], s[14 * 33], s[15 * 33]);
        *(v4u*)(WT + (size_t)(row_off + n0 + n) * K + k0 + 16 * c) = o; }
    asm volatile("s_waitcnt lgkmcnt(0)" ::: "memory");
}
DEV void p_expert_weights(float* lds, const float* w_eg, const float* w_eu, const float* w_ed, unsigned char* wgu8, unsigned char* wd8) {
    const int wave = threadIdx.x >> 6, lane = threadIdx.x & 63;
    float* scr = lds + wave * 2304;
    for (int it = blockIdx.x * 8 + wave; it < 3 * 8192; it += gridDim.x * 8) {
        const int kind = it >> 13, r = it & 8191, e = r >> 8, sub = r & 255;
        if (kind < 2) { const int nb = sub & 15; transpose_item_fp8((kind ? w_eu : w_eg) + (size_t)e * 1024 * 512, 1024, 512, wgu8 + (size_t)e * 1024 * 1024, (nb >> 2) * 128 + kind * 128, pg8::FP8_SW, scr, sub, lane); }
        else transpose_item_fp8(w_ed + (size_t)e * 512 * 1024, 512, 1024, wd8 + (size_t)e * 1024 * 512, 0, pg8::FP8_SW, scr, sub, lane);
    }
}

DEV void p_router_consts(float* lds, const float* g1, const float* b1, const float* wg, const float* bg, const float* we, const float* be, float* sb) {
    if (blockIdx.x != 0) return;
    const int t = threadIdx.x, wv = t >> 6, lane = t & 63;
    float s[36], q[36];
#pragma unroll
    for (int c = 0; c < 36; ++c) { s[c] = 0.f; q[c] = 0.f; }
#pragma unroll
    for (int kk = 0; kk < 2; ++kk) { const int k = t + 512 * kk; const float gk = g1[k], bk = b1[k];
#pragma unroll
        for (int c4 = 0; c4 < 9; ++c4) { const float4 w = (c4 < 8) ? *(const float4*)(we + (size_t)k * 32 + c4 * 4) : *(const float4*)(wg + (size_t)k * 4);
            s[4 * c4] += gk * w.x; s[4 * c4 + 1] += gk * w.y; s[4 * c4 + 2] += gk * w.z; s[4 * c4 + 3] += gk * w.w;
            q[4 * c4] += bk * w.x; q[4 * c4 + 1] += bk * w.y; q[4 * c4 + 2] += bk * w.z; q[4 * c4 + 3] += bk * w.w; } }
#pragma unroll
    for (int m = 1; m < 64; m <<= 1) {
#pragma unroll
        for (int c = 0; c < 36; ++c) { s[c] += __shfl_xor(s[c], m); q[c] += __shfl_xor(q[c], m); } }
    if (lane == 0) {
#pragma unroll
        for (int c = 0; c < 36; ++c) { lds[wv * 96 + c] = s[c]; lds[wv * 96 + 48 + c] = q[c]; } }
    __syncthreads();
    if (t < 96) { const int cc = t % 48; float v = 0.f;
        if (cc < 36) { for (int p = 0; p < 8; ++p) v += lds[p * 96 + t]; if (t >= 48) v += (cc < 32) ? be[cc] : bg[cc - 32]; }
        sb[t] = v; }
    __syncthreads();
}
DEV void p_cvt_x(const float* x, bf16_t* xb) {
    const size_t n4 = (size_t)NTOK * DM / 4, stride = (size_t)gridDim.x * NTHR;
    for (size_t i0 = (size_t)blockIdx.x * NTHR + threadIdx.x; i0 < n4; i0 += 8 * stride) {
        float4 t[8];
#pragma unroll
        for (int u = 0; u < 8; ++u) { const size_t i = i0 + u * stride; t[u] = (i < n4) ? ((const float4*)x)[i] : make_float4(0.f, 0.f, 0.f, 0.f); }
#pragma unroll
        for (int u = 0; u < 8; ++u) { const size_t i = i0 + u * stride; if (i < n4) { uint2 o; o.x = pg8::cvt_pk_bf16(t[u].x, t[u].y); o.y = pg8::cvt_pk_bf16(t[u].z, t[u].w); ((uint2*)xb)[i] = o; } }
    }
}
DEV void p_rope_table(float2* tab) {
    for (int i = blockIdx.x * NTHR + threadIdx.x; i < 8192 * 128; i += gridDim.x * NTHR) {
        const int s = i >> 7, j = i & 127;
        const double r = 0.93057204092969897;
        double inv = 1.0; for (int t = 0; t < j; ++t) inv *= r;
        const double ang = (double)s * inv;
        const double twopi_hi = 6.283185307179586232, twopi_lo = 2.4492935982947064e-16;
        const double n = rint(ang / twopi_hi);
        const double x = (ang - n * twopi_hi) - n * twopi_lo;
        const double x2 = x * x;
        double acc = 1.0 - x2 * (1.0 / (22.0 * 23.0));
#pragma unroll
        for (int k = 21; k >= 3; k -= 2) acc = 1.0 - x2 * (1.0 / ((double)(k - 1) * (double)k)) * acc;
        double acc2 = 1.0 - x2 * (1.0 / (21.0 * 22.0));
#pragma unroll
        for (int k = 20; k >= 2; k -= 2) acc2 = 1.0 - x2 * (1.0 / ((double)(k - 1) * (double)k)) * acc2;
        tab[i] = make_float2((float)acc2, (float)(x * acc));
    }
}

typedef short bf16x8_t __attribute__((ext_vector_type(8)));
typedef float f32x4_t __attribute__((ext_vector_type(4)));
typedef short s16x4_t __attribute__((ext_vector_type(4)));
typedef unsigned u32x4_t __attribute__((ext_vector_type(4)));
constexpr int LRU_ROWB = 400;
DEV void p_lru_compute(unsigned char* lds, const bf16_t* ulru, const float* cw, const float* cb, const bf16_t* wrg_t,
                       const float* b_r, const float* b_i, const float* lam, bf16_t* epsb, bf16_t* xinb, float* segA, float* segH) {
    int tid_ = threadIdx.x; asm volatile("" : "+v"(tid_));
    const int tid = tid_, wave = tid >> 6, lane = tid & 63, fr = lane & 15, fq = lane >> 4, wr = wave >> 2, wc = wave & 3;
    unsigned char* stg = lds + 256 * LRU_ROWB + wave * 4096;
    for (int item = blockIdx.x; item < 1024; item += gridDim.x) {
        const int n = item & 7, b = (item >> 3) & 3, seg = item >> 5;
        const size_t t0 = (size_t)b * SEQ + seg * 256;
#pragma unroll 4
        for (int idx = tid; idx < 256 * 24; idx += NTHR) {
            const int r = idx / 24, c8 = idx - r * 24, ch0 = n * 192 + c8 * 8;
            float acc[8];
            { const float4 c0 = *(const float4*)(cb + ch0), c1 = *(const float4*)(cb + ch0 + 4); acc[0] = c0.x; acc[1] = c0.y; acc[2] = c0.z; acc[3] = c0.w; acc[4] = c1.x; acc[5] = c1.y; acc[6] = c1.z; acc[7] = c1.w; }
#pragma unroll
            for (int j = 0; j < 4; ++j) {
                if (seg * 256 + r - 3 + j >= 0) {
                    const uint4 uv = *(const uint4*)(ulru + (t0 + r - 3 + j) * 1536 + ch0);
                    const float4 w0 = *(const float4*)(cw + j * 1536 + ch0), w1 = *(const float4*)(cw + j * 1536 + ch0 + 4);
                    acc[0] += w0.x * __uint_as_float(uv.x << 16); acc[1] += w0.y * __uint_as_float(uv.x & 0xffff0000u);
                    acc[2] += w0.z * __uint_as_float(uv.y << 16); acc[3] += w0.w * __uint_as_float(uv.y & 0xffff0000u);
                    acc[4] += w1.x * __uint_as_float(uv.z << 16); acc[5] += w1.y * __uint_as_float(uv.z & 0xffff0000u);
                    acc[6] += w1.z * __uint_as_float(uv.w << 16); acc[7] += w1.w * __uint_as_float(uv.w & 0xffff0000u);
                }
            }
            uint4 o; o.x = pg8::cvt_pk_bf16(acc[0], acc[1]); o.y = pg8::cvt_pk_bf16(acc[2], acc[3]); o.z = pg8::cvt_pk_bf16(acc[4], acc[5]); o.w = pg8::cvt_pk_bf16(acc[6], acc[7]);
            *(uint4*)(lds + r * LRU_ROWB + c8 * 16) = o;
        }
        __syncthreads();
        float cbr[3], cbi[3], csp[3], hrun[3], atot[3];
        const int sub = seg * 2 + wr;
#pragma unroll
        for (int tc = 0; tc < 3; ++tc) { const int ch = n * 192 + 48 * wc + 16 * tc + fr; cbr[tc] = b_r[ch]; cbi[tc] = b_i[ch]; csp[tc] = 8.f * 1.4426950408889634f * log1pf(__expf(-lam[ch])); atot[tc] = 1.f; hrun[tc] = 0.f; }
        const bf16_t* wrb = wrg_t + ((size_t)n * 192 + 48 * wc + fr) * 192 + fq * 8;
        const bf16_t* wib = wrb + (size_t)8 * 192 * 192;
#pragma unroll
        for (int tc = 0; tc < 3; ++tc) {
            bf16x8_t bfr[6][2];
#pragma unroll
            for (int ks = 0; ks < 6; ++ks) { bfr[ks][0] = *(const bf16x8_t*)(wrb + tc * 16 * 192 + ks * 32); bfr[ks][1] = *(const bf16x8_t*)(wib + tc * 16 * 192 + ks * 32); }
#pragma unroll
            for (int p = 0; p < 2; ++p) {
                const int rowb = 128 * wr + 64 * p;
                f32x4_t acc[4][2];
#pragma unroll
                for (int m = 0; m < 4; ++m) { acc[m][0] = (f32x4_t){0.f, 0.f, 0.f, 0.f}; acc[m][1] = (f32x4_t){0.f, 0.f, 0.f, 0.f}; }
#pragma unroll
                for (int ks = 0; ks < 6; ++ks) {
                    bf16x8_t afr[4];
#pragma unroll
                    for (int m = 0; m < 4; ++m) afr[m] = *(const bf16x8_t*)(lds + (rowb + 16 * (fr >> 2) + 4 * m + (fr & 3)) * LRU_ROWB + ks * 64 + fq * 16);
#pragma unroll
                    for (int m = 0; m < 4; ++m) { acc[m][0] = __builtin_amdgcn_mfma_f32_16x16x32_bf16(afr[m], bfr[ks][0], acc[m][0], 0, 0, 0); acc[m][1] = __builtin_amdgcn_mfma_f32_16x16x32_bf16(afr[m], bfr[ks][1], acc[m][1], 0, 0, 0); }
                }
                const int coff = (48 * wc + 16 * tc + fr) * 2;
                const unsigned char* up = lds + (rowb + 16 * fq) * LRU_ROWB + coff;
                float Al = 1.f, Bl = 0.f;
                unsigned pe[8], px[8];
#pragma unroll
                for (int m = 0; m < 4; ++m) {
                    float ee[4], xx[4];
#pragma unroll
                    for (int j = 0; j < 4; ++j) {
                        const float rr = pg8::fsig(acc[m][0][j] + cbr[tc]), ii = pg8::fsig(acc[m][1][j] + cbi[tc]);
                        const float aa = __builtin_amdgcn_exp2f(-csp[tc] * rr);
                        const float u = bf2f(*(const bf16_t*)(up + (4 * m + j) * LRU_ROWB));
                        const float om = 1.f - aa;
                        const float x = __builtin_amdgcn_sqrtf(fmaxf(om * (1.f + aa), 0.f)) * ii * u;
                        ee[j] = om; xx[j] = x; Bl = aa * Bl + x; Al *= aa;
                    }
                    pe[2 * m] = pg8::cvt_pk_bf16(ee[0], ee[1]); pe[2 * m + 1] = pg8::cvt_pk_bf16(ee[2], ee[3]);
                    px[2 * m] = pg8::cvt_pk_bf16(xx[0], xx[1]); px[2 * m + 1] = pg8::cvt_pk_bf16(xx[2], xx[3]);
                }
                { float h = hrun[tc], ap = 1.f;
#pragma unroll
                  for (int q = 0; q < 4; ++q) { const float Aq = __shfl(Al, fr + 16 * q), Bq = __shfl(Bl, fr + 16 * q); h = Aq * h + Bq; ap *= Aq; }
                  hrun[tc] = h; atot[tc] *= ap; }
#pragma unroll
                for (int m = 0; m < 4; ++m)
#pragma unroll
                    for (int j = 0; j < 4; ++j) { const int tk = 16 * fq + 4 * m + j; const unsigned we = pe[2 * m + (j >> 1)], wx = px[2 * m + (j >> 1)];
                        *(bf16_t*)(stg + tk * 32 + fr * 2) = (bf16_t)((j & 1) ? (we >> 16) : (we & 0xffff));
                        *(bf16_t*)(stg + 2048 + tk * 32 + fr * 2) = (bf16_t)((j & 1) ? (wx >> 16) : (wx & 0xffff)); }
                asm volatile("s_waitcnt lgkmcnt(0)" ::: "memory");
#pragma unroll
                for (int i = 0; i < 2; ++i) { const int piece = lane + 64 * i, tk = piece >> 1, hf = piece & 1;
                    const size_t go = (t0 + rowb + tk) * 1536 + n * 192 + 48 * wc + 16 * tc + 8 * hf;
                    *(u32x4_t*)(epsb + go) = *(const u32x4_t*)(stg + tk * 32 + hf * 16);
                    *(u32x4_t*)(xinb + go) = *(const u32x4_t*)(stg + 2048 + tk * 32 + hf * 16); }
                asm volatile("s_waitcnt lgkmcnt(0)" ::: "memory");
            }
        }
        if (fq == 0) {
#pragma unroll
            for (int tc = 0; tc < 3; ++tc) { const size_t o = ((size_t)b * 64 + sub) * 1536 + n * 192 + 48 * wc + 16 * tc + fr; segA[o] = atot[tc]; segH[o] = hrun[tc]; }
        }
        __syncthreads();
    }
}
DEV void p_lru_scan(const bf16_t* epsb, const bf16_t* xinb, bf16_t* gl, const float* carry) {
    const int tid = threadIdx.x;
    if (tid >= 384) return;
    for (int item = blockIdx.x; item < 256; item += gridDim.x) {
        const int b = item >> 6, sub = item & 63;
        const size_t base = ((size_t)b * SEQ + sub * 128) * 1536 + tid * 4;
        const float4 cin = *(const float4*)(carry + ((size_t)b * 64 + sub) * 1536 + tid * 4);
        float h0 = cin.x, h1 = cin.y, h2 = cin.z, h3 = cin.w;
#pragma unroll 8
        for (int t = 0; t < 128; ++t) {
            const size_t o = base + (size_t)t * 1536;
            const uint2 ev = *(const uint2*)(epsb + o), xv = *(const uint2*)(xinb + o), gv = *(const uint2*)(gl + o);
            h0 = (1.f - __uint_as_float(ev.x << 16)) * h0 + __uint_as_float(xv.x << 16);
            h1 = (1.f - __uint_as_float(ev.x & 0xffff0000u)) * h1 + __uint_as_float(xv.x & 0xffff0000u);
            h2 = (1.f - __uint_as_float(ev.y << 16)) * h2 + __uint_as_float(xv.y << 16);
            h3 = (1.f - __uint_as_float(ev.y & 0xffff0000u)) * h3 + __uint_as_float(xv.y & 0xffff0000u);
            uint2 ov; ov.x = pg8::cvt_pk_bf16(h0 * __uint_as_float(gv.x << 16), h1 * __uint_as_float(gv.x & 0xffff0000u)); ov.y = pg8::cvt_pk_bf16(h2 * __uint_as_float(gv.y << 16), h3 * __uint_as_float(gv.y & 0xffff0000u));
            *(uint2*)(gl + o) = ov;
        }
    }
}
DEV void p_lru_carry(float* lds, const float* segA, const float* segH, float* carry) {
    float* tA = lds; float* tH = lds + 64 * 65;
    for (int item = blockIdx.x; item < 96; item += gridDim.x) {
        const int b = item / 24, c0 = (item % 24) * 64;
        for (int i = threadIdx.x; i < 64 * 64; i += NTHR) { const int s = i >> 6, c = i & 63; const size_t o = ((size_t)b * 64 + s) * 1536 + c0 + c; tA[s * 65 + c] = segA[o]; tH[s * 65 + c] = segH[o]; }
        __syncthreads();
        if (threadIdx.x < 64) { const int c = threadIdx.x; float h = 0.f;
            for (int s = 0; s < 64; ++s) { const float a = tA[s * 65 + c], hh = tH[s * 65 + c]; tA[s * 65 + c] = h; h = a * h + hh; } }
        __syncthreads();
        for (int i = threadIdx.x; i < 64 * 64; i += NTHR) { const int s = i >> 6, c = i & 63; carry[((size_t)b * 64 + s) * 1536 + c0 + c] = tA[s * 65 + c]; }
        __syncthreads();
    }
}
#define LDS_BARRIER() do { asm volatile("s_waitcnt lgkmcnt(0)" ::: "memory"); __builtin_amdgcn_s_barrier(); asm volatile("" ::: "memory"); } while (0)
DEV void p_scores(unsigned char* lds, const bf16_t* q, const bf16_t* k, bf16_t* P) {
    int tid_ = threadIdx.x; asm volatile("" : "+v"(tid_));
    const int tid = tid_, w = tid >> 6, lane = tid & 63, fr = lane & 15, fq = lane >> 4;
    const int krow = tid >> 5, kch = tid & 31;
    u32x4_t kreg[8]; bf16x8_t qa[8];
    int g = blockIdx.x;
    if (g < 1024) { const int c = g & 63, bh = g >> 6, b = bh >> 2, h = bh & 3; const size_t tok0 = (size_t)b * SEQ + c * 128;
        const bf16_t* kc = k + tok0 * 1024 + h * 256;
#pragma unroll
        for (int ii = 0; ii < 8; ++ii) kreg[ii] = *(const u32x4_t*)(kc + (size_t)(krow + 16 * ii) * 1024 + kch * 8);
        const bf16_t* qp = q + ((tok0 >> 7) * 4 + h) * 32768 + (fq * 128 + 16 * w + fr) * 8;
#pragma unroll
        for (int ks = 0; ks < 8; ++ks) qa[ks] = *(const bf16x8_t*)(qp + ks * 4096); }
    for (; g < 1024; g += gridDim.x) {
#pragma unroll
        for (int ii = 0; ii < 8; ++ii) *(u32x4_t*)(lds + (krow + 16 * ii) * 528 + kch * 16) = kreg[ii];
        bf16x8_t qc[8];
#pragma unroll
        for (int ks = 0; ks < 8; ++ks) qc[ks] = qa[ks];
        const int gn = g + gridDim.x;
        if (gn < 1024) { const int c = gn & 63, bh = gn >> 6, b = bh >> 2, h = bh & 3; const size_t tok0 = (size_t)b * SEQ + c * 128;
            const bf16_t* kc = k + tok0 * 1024 + h * 256;
#pragma unroll
            for (int ii = 0; ii < 8; ++ii) kreg[ii] = *(const u32x4_t*)(kc + (size_t)(krow + 16 * ii) * 1024 + kch * 8);
            const bf16_t* qp = q + ((tok0 >> 7) * 4 + h) * 32768 + (fq * 128 + 16 * w + fr) * 8;
#pragma unroll
            for (int ks = 0; ks < 8; ++ks) qa[ks] = *(const bf16x8_t*)(qp + ks * 4096); }
        LDS_BARRIER();
        f32x4_t acc[8];
#pragma unroll
        for (int nt = 0; nt < 8; ++nt) acc[nt] = (f32x4_t){0.f, 0.f, 0.f, 0.f};
#pragma unroll
        for (int ks = 0; ks < 8; ++ks)
#pragma unroll
            for (int nt = 0; nt < 8; ++nt) { const bf16x8_t bb = *(const bf16x8_t*)(lds + (16 * nt + fr) * 528 + ks * 64 + fq * 16); acc[nt] = __builtin_amdgcn_mfma_f32_16x16x32_bf16(bb, qc[ks], acc[nt], 0, 0, 0); }
        LDS_BARRIER();
        bf16_t* Pg = P + (size_t)g * 16384 + ((fq >> 1) * 128 + 16 * w + fr) * 8 + 4 * (fq & 1);
        int mrow = 16 * w + fr - 4 * fq; asm volatile("" : "+v"(mrow));
#pragma unroll
        for (int nt = 0; nt < 8; ++nt) {
            uint2 o; o.x = pg8::cvt_pk_bf16((16 * nt <= mrow) ? acc[nt][0] : 0.f, (16 * nt + 1 <= mrow) ? acc[nt][1] : 0.f);
            o.y = pg8::cvt_pk_bf16((16 * nt + 2 <= mrow) ? acc[nt][2] : 0.f, (16 * nt + 3 <= mrow) ? acc[nt][3] : 0.f);
            *(uint2*)(Pg + ((nt >> 1) * 4 + 2 * (nt & 1)) * 1024) = o; }
    }
    __syncthreads();
}
constexpr int RT_KS = 528, RT_VS = 272, RT_K = 0, RT_V = 128 * RT_KS, RT_U = RT_V + 32 * RT_VS;
DEV void p_ret_mfma(unsigned char* lds, const bf16_t* q, const bf16_t* k, bf16_t* v, const bf16_t* P) {
    int tid_ = threadIdx.x; asm volatile("" : "+v"(tid_));
    const int tid = tid_, w = tid >> 6, lane = tid & 63, fr = lane & 15, fq = lane >> 4;
    for (int wk = blockIdx.x; wk < 256; wk += gridDim.x) {
        const int xcd = wk & 7, idx = wk >> 3, bh = xcd * 2 + (idx >> 4), sl = idx & 15, b = bh >> 2, h = bh & 3;
        float g128; { const double gam = 1.0 - exp2(-5.0 - (double)h); g128 = (float)exp2(128.0 * log2(gam)); }
        asm volatile("" : "+v"(g128));
        f32x4_t accU[2][2];
#pragma unroll
        for (int et = 0; et < 2; ++et)
#pragma unroll
            for (int di = 0; di < 2; ++di) accU[et][di] = (f32x4_t){0.f, 0.f, 0.f, 0.f};
        for (int i = tid; i < 32 * RT_KS / 4; i += NTHR) ((unsigned*)(lds + RT_U))[i] = 0u;
        const size_t tokb = (size_t)b * SEQ;
        u32x4_t kreg[8], vreg;
        const int krow = tid >> 5, kch = tid & 31, vm = tid >> 2, ve = (tid & 3) * 8;
        {
            const bf16_t* kc = k + tokb * 1024 + h * 256;
#pragma unroll
            for (int ii = 0; ii < 8; ++ii) kreg[ii] = *(const u32x4_t*)(kc + (size_t)(krow + 16 * ii) * 1024 + kch * 8);
            vreg = *(const u32x4_t*)(v + (tokb + vm) * 2048 + h * 512 + sl * 32 + ve);
        }
        bf16x8_t qa[8], pa[4];
        {
            const bf16_t* qp = q + ((tokb >> 7) * 4 + h) * 32768 + (fq * 128 + 16 * w + fr) * 8;
#pragma unroll
            for (int ks = 0; ks < 8; ++ks) qa[ks] = *(const bf16x8_t*)(qp + ks * 4096);
            const bf16_t* pp = P + (size_t)(bh * 64) * 16384 + (fq * 128 + 16 * w + fr) * 8;
#pragma unroll
            for (int ks = 0; ks < 4; ++ks) pa[ks] = *(const bf16x8_t*)(pp + ks * 4096);
        }
#pragma unroll 1
        for (int c = 0; c < 64; ++c) {
            const size_t tok0 = tokb + c * 128;
#pragma unroll
            for (int ii = 0; ii < 8; ++ii) *(u32x4_t*)(lds + RT_K + (krow + 16 * ii) * RT_KS + kch * 16) = kreg[ii];
            {
                unsigned char* vp = lds + RT_V + ve * RT_VS + vm * 2;
                *(bf16_t*)(vp + 0 * RT_VS) = (bf16_t)(vreg.x & 0xffff); *(bf16_t*)(vp + 1 * RT_VS) = (bf16_t)(vreg.x >> 16);
                *(bf16_t*)(vp + 2 * RT_VS) = (bf16_t)(vreg.y & 0xffff); *(bf16_t*)(vp + 3 * RT_VS) = (bf16_t)(vreg.y >> 16);
                *(bf16_t*)(vp + 4 * RT_VS) = (bf16_t)(vreg.z & 0xffff); *(bf16_t*)(vp + 5 * RT_VS) = (bf16_t)(vreg.z >> 16);
                *(bf16_t*)(vp + 6 * RT_VS) = (bf16_t)(vreg.w & 0xffff); *(bf16_t*)(vp + 7 * RT_VS) = (bf16_t)(vreg.w >> 16);
            }
            if (c + 1 < 64) {
                const bf16_t* kc = k + (tok0 + 128) * 1024 + h * 256;
#pragma unroll
                for (int ii = 0; ii < 8; ++ii) kreg[ii] = *(const u32x4_t*)(kc + (size_t)(krow + 16 * ii) * 1024 + kch * 8);
                vreg = *(const u32x4_t*)(v + (tok0 + 128 + vm) * 2048 + h * 512 + sl * 32 + ve);
            }
            LDS_BARRIER();
            f32x4_t ao[2] = {(f32x4_t){0.f, 0.f, 0.f, 0.f}, (f32x4_t){0.f, 0.f, 0.f, 0.f}};
            {
                bf16x8_t bu[8];
#pragma unroll
                for (int nt = 0; nt < 2; ++nt) {
#pragma unroll
                    for (int ks = 0; ks < 8; ++ks) bu[ks] = *(const bf16x8_t*)(lds + RT_U + (16 * nt + fr) * RT_KS + ks * 64 + fq * 16);
#pragma unroll
                    for (int ks = 0; ks < 8; ++ks) ao[nt] = __builtin_amdgcn_mfma_f32_16x16x32_bf16(qa[ks], bu[ks], ao[nt], 0, 0, 0);
                }
            }
            bf16x8_t bv[2][4];
#pragma unroll
            for (int nt = 0; nt < 2; ++nt)
#pragma unroll
                for (int ks = 0; ks < 4; ++ks) bv[nt][ks] = *(const bf16x8_t*)(lds + RT_V + (16 * nt + fr) * RT_VS + ks * 64 + fq * 16);
#pragma unroll
            for (int ks = 0; ks < 4; ++ks)
#pragma unroll
                for (int nt = 0; nt < 2; ++nt) ao[nt] = __builtin_amdgcn_mfma_f32_16x16x32_bf16(pa[ks], bv[nt][ks], ao[nt], 0, 0, 0);
            if (c + 1 < 64) {
                const bf16_t* qp = q + (((tok0 >> 7) + 1) * 4 + h) * 32768 + (fq * 128 + 16 * w + fr) * 8;
#pragma unroll
                for (int ks = 0; ks < 8; ++ks) qa[ks] = *(const bf16x8_t*)(qp + ks * 4096);
                const bf16_t* pp = P + (size_t)(bh * 64 + c + 1) * 16384 + (fq * 128 + 16 * w + fr) * 8;
#pragma unroll
                for (int ks = 0; ks < 4; ++ks) pa[ks] = *(const bf16x8_t*)(pp + ks * 4096);
            }
#pragma unroll
            for (int kh = 0; kh < 2; ++kh) {
                s16x4_t tk[2][2][2];
#pragma unroll
                for (int k2 = 0; k2 < 2; ++k2)
#pragma unroll
                    for (int di = 0; di < 2; ++di) {
                        const unsigned char* kp = lds + RT_K + (32 * (2 * kh + k2) + 8 * fq + (fr >> 2)) * RT_KS + (16 * (2 * w + di) + 4 * (fr & 3)) * 2;
                        tk[k2][di][0] = __builtin_amdgcn_ds_read_tr16_b64_v4i16((LAS s16x4_t*)(kp));
                        tk[k2][di][1] = __builtin_amdgcn_ds_read_tr16_b64_v4i16((LAS s16x4_t*)(kp + 4 * RT_KS));
                    }
#pragma unroll
                for (int k2 = 0; k2 < 2; ++k2)
#pragma unroll
                    for (int di = 0; di < 2; ++di) {
                        const bf16x8_t kb = (bf16x8_t){tk[k2][di][0][0], tk[k2][di][0][1], tk[k2][di][0][2], tk[k2][di][0][3], tk[k2][di][1][0], tk[k2][di][1][1], tk[k2][di][1][2], tk[k2][di][1][3]};
#pragma unroll
                        for (int et = 0; et < 2; ++et) accU[et][di] = __builtin_amdgcn_mfma_f32_16x16x32_bf16(bv[et][2 * kh + k2], kb, accU[et][di], 0, 0, 0);
                    }
            }
#pragma unroll
            for (int et = 0; et < 2; ++et)
#pragma unroll
                for (int di = 0; di < 2; ++di) accU[et][di] = accU[et][di] * g128;
            LDS_BARRIER();
            {
                bf16_t* vc = v + (tok0 + 16 * w + 4 * fq) * 2048 + h * 512 + sl * 32 + fr;
#pragma unroll
                for (int nt = 0; nt < 2; ++nt)
#pragma unroll
                    for (int j = 0; j < 4; ++j) vc[(size_t)j * 2048 + 16 * nt] = f2bf(ao[nt][j]);
#pragma unroll
                for (int et = 0; et < 2; ++et)
#pragma unroll
                    for (int di = 0; di < 2; ++di)
#pragma unroll
                        for (int j = 0; j < 4; ++j) *(bf16_t*)(lds + RT_U + (16 * et + 4 * fq + j) * RT_KS + (16 * (2 * w + di) + fr) * 2) = f2bf(accU[et][di][j]);
            }
        }
        __syncthreads();
    }
}
DEV void p_headnorm(bf16_t* ret, const bf16_t* g) {
    const int lane = threadIdx.x & 63;
    for (int w = (blockIdx.x * NTHR + threadIdx.x) >> 6; w < NTOK * 4; w += gridDim.x * (NTHR / 64)) {
        const size_t o = (size_t)w * 512 + lane * 8;
        const u32x4_t rv = *(const u32x4_t*)(ret + o), gv = *(const u32x4_t*)(g + o);
        float x[8], gg[8]; float s = 0.f;
#pragma unroll
        for (int j = 0; j < 4; ++j) { x[2 * j] = __uint_as_float(rv[j] << 16); x[2 * j + 1] = __uint_as_float(rv[j] & 0xffff0000u); gg[2 * j] = __uint_as_float(gv[j] << 16); gg[2 * j + 1] = __uint_as_float(gv[j] & 0xffff0000u); }
#pragma unroll
        for (int j = 0; j < 8; ++j) s += x[j];
#pragma unroll
        for (int m = 1; m < 64; m <<= 1) s += __shfl_xor(s, m);
        const float mu = s * (1.f / 512.f); float q = 0.f;
#pragma unroll
        for (int j = 0; j < 8; ++j) { x[j] -= mu; q += x[j] * x[j]; }
#pragma unroll
        for (int m = 1; m < 64; m <<= 1) q += __shfl_xor(q, m);
        const float rstd = rsqrtf(q * (1.f / 512.f) + LN_EPS);
        u32x4_t ov;
#pragma unroll
        for (int j = 0; j < 4; ++j) ov[j] = pg8::cvt_pk_bf16(x[2 * j] * rstd * gg[2 * j], x[2 * j + 1] * rstd * gg[2 * j + 1]);
        *(u32x4_t*)(ret + o) = ov;
    }
}

typedef float f32x4v __attribute__((ext_vector_type(4)));
DEV void p_ln1_route(float* lds, const bf16_t* y, bf16_t* x1b, unsigned char* x1q, const float* g1, const float* b1, const float* wg, const float* bg,
                     const float* we, const float* be, int2* route_e, float2* route_w, int* cnt, int* list, const float* sb) {
    const int wv = threadIdx.x >> 6, lane = threadIdx.x & 63, r16 = lane & 15, kq = lane >> 4;
    float* Wp = lds;
    float* Sc = lds + 1024 * 36;
    float* Bc = Sc + 48;
    int* lcnt = (int*)(Bc + 48);
    int* rowE = lcnt + 32;
    int* rowP = rowE + 256;
    for (int i = threadIdx.x; i < 1024 * 9; i += NTHR) { const int k = i / 9, c4 = i - k * 9; const float gk = g1[k];
        float4 w = (c4 < 8) ? *(const float4*)(we + (size_t)k * 32 + c4 * 4) : *(const float4*)(wg + (size_t)k * 4);
        w.x *= gk; w.y *= gk; w.z *= gk; w.w *= gk; *(float4*)(Wp + k * 36 + c4 * 4) = w; }
    if (threadIdx.x < 32) lcnt[threadIdx.x] = 0;
    __syncthreads();
    if (threadIdx.x < 96) Sc[threadIdx.x] = sb[threadIdx.x];
    __syncthreads();
    constexpr int rows_per_wg = 128;
    for (int blk = blockIdx.x; blk < NTOK / rows_per_wg; blk += gridDim.x) {
    { const int tile = wv;
        const int lrow0 = tile * 16, row0 = blk * rows_per_wg + lrow0;
        const bf16_t* yp = y + (size_t)(row0 + r16) * 1024 + 4 * kq;
        f32x4v acc[3] = {(f32x4v){0.f, 0.f, 0.f, 0.f}, (f32x4v){0.f, 0.f, 0.f, 0.f}, (f32x4v){0.f, 0.f, 0.f, 0.f}};
        float s1 = 0.f, s2 = 0.f; const float m2 = (r16 < 4) ? 1.f : 0.f;
#pragma unroll 8
        for (int t = 0; t < 64; ++t) {
            const uint2 yr = *(const uint2*)(yp + 16 * t); const float4 yv = make_float4(__uint_as_float(yr.x << 16), __uint_as_float(yr.x & 0xffff0000u), __uint_as_float(yr.y << 16), __uint_as_float(yr.y & 0xffff0000u));
            s1 += (yv.x + yv.y) + (yv.z + yv.w); s2 += (yv.x * yv.x + yv.y * yv.y) + (yv.z * yv.z + yv.w * yv.w);
            const float* wrow = Wp + (16 * t + 4 * kq) * 36 + r16;
            const float ye[4] = {yv.x, yv.y, yv.z, yv.w};
#pragma unroll
            for (int j = 0; j < 4; ++j)
#pragma unroll
                for (int nt = 0; nt < 3; ++nt) { const float wv = (nt < 2) ? wrow[j * 36 + 16 * nt] : wrow[j * 36 + 32 - (r16 & 12)] * m2;
                    acc[nt] = __builtin_amdgcn_mfma_f32_16x16x4f32(ye[j], wv, acc[nt], 0, 0, 0); }
        }
        s1 += __shfl_xor(s1, 16); s1 += __shfl_xor(s1, 32); s2 += __shfl_xor(s2, 16); s2 += __shfl_xor(s2, 32);
        const float mu = s1 * (1.f / 1024.f), rstd = rsqrtf(fmaxf(s2 * (1.f / 1024.f) - mu * mu, 0.f) + LN_EPS);
#pragma unroll 8
        for (int t = 0; t < 64; ++t) {
            const uint2 yr = *(const uint2*)(yp + 16 * t); const float4 yv = make_float4(__uint_as_float(yr.x << 16), __uint_as_float(yr.x & 0xffff0000u), __uint_as_float(yr.y << 16), __uint_as_float(yr.y & 0xffff0000u));
            const float4 gv = *(const float4*)(g1 + 16 * t + 4 * kq), bv = *(const float4*)(b1 + 16 * t + 4 * kq);
            const float4 o = make_float4((yv.x - mu) * rstd * gv.x + bv.x, (yv.y - mu) * rstd * gv.y + bv.y, (yv.z - mu) * rstd * gv.z + bv.z, (yv.w - mu) * rstd * gv.w + bv.w);
            uint2 ob; ob.x = pg8::cvt_pk_bf16(o.x, o.y); ob.y = pg8::cvt_pk_bf16(o.z, o.w);
            *(uint2*)(x1b + (size_t)(row0 + r16) * 1024 + 16 * t + 4 * kq) = ob;
            *(unsigned*)(x1q + (size_t)(row0 + r16) * 1024 + 16 * t + 4 * kq) = pg8::pk4_fp8(o.x * pg8::FP8_SX, o.y * pg8::FP8_SX, o.z * pg8::FP8_SX, o.w * pg8::FP8_SX);
        }
#pragma unroll
        for (int j = 0; j < 4; ++j) {
            const int rl = 4 * kq + j;
            const float mur = __shfl(mu, rl), rsr = __shfl(rstd, rl);
            float lg[3];
#pragma unroll
            for (int nt = 0; nt < 3; ++nt) lg[nt] = rsr * (acc[nt][j] - mur * Sc[16 * nt + r16]) + Bc[16 * nt + r16];
            const int gb = 16 * kq;
            const float g0 = __shfl(lg[2], gb + 0), g1v = __shfl(lg[2], gb + 1), g2 = __shfl(lg[2], gb + 2), g3 = __shfl(lg[2], gb + 3);
            int gi = 0; float gm = g0; if (g1v > gm) { gm = g1v; gi = 1; } if (g2 > gm) { gm = g2; gi = 2; } if (g3 > gm) { gm = g3; gi = 3; }
            const float gw = 1.f / (expf(g0 - gm) + expf(g1v - gm) + expf(g2 - gm) + expf(g3 - gm));
            const float lsel = (gi & 2) ? lg[1] : lg[0];
            float ev[8];
#pragma unroll
            for (int t = 0; t < 8; ++t) ev[t] = __shfl(lsel, gb + (gi & 1) * 8 + t);
            int i1 = 0; float v1 = ev[0];
#pragma unroll
            for (int t = 1; t < 8; ++t) if (ev[t] > v1) { v1 = ev[t]; i1 = t; }
            int i2 = -1; float v2 = -INFINITY;
#pragma unroll
            for (int t = 0; t < 8; ++t) if (t != i1 && ev[t] > v2) { v2 = ev[t]; i2 = t; }
            const float w1 = 1.f / (1.f + expf(v2 - v1)), w2 = 1.f - w1;
            if (r16 == 0) {
                const int lr = lrow0 + rl, r = row0 + rl, e1 = gi * 8 + i1, e2 = gi * 8 + i2;
                route_e[r] = make_int2(e1, e2); route_w[r] = make_float2(gw * w1, gw * w2);
                rowE[2 * lr] = e1; rowP[2 * lr] = atomicAdd(&lcnt[e1], 1);
                rowE[2 * lr + 1] = e2; rowP[2 * lr + 1] = atomicAdd(&lcnt[e2], 1);
            }
        }
    }
    __syncthreads();
    if (threadIdx.x < 32) lcnt[threadIdx.x] = atomicAdd(&cnt[threadIdx.x * 64], lcnt[threadIdx.x]);
    __syncthreads();
    for (int i = threadIdx.x; i < 2 * rows_per_wg; i += NTHR) { const int e = rowE[i]; list[e * 32768 + lcnt[e] + rowP[i]] = (blk * rows_per_wg + (i >> 1)) * 2 + (i & 1); }
    __syncthreads();
    if (threadIdx.x < 32) lcnt[threadIdx.x] = 0;
    __syncthreads();
    }
}

DEV void p_final(float* out, const bf16_t* x1b, const bf16_t* ys, const float* g2, const float* b2) {
    const int lane = threadIdx.x & 63;
    for (int r = (blockIdx.x * NTHR + threadIdx.x) >> 6; r < NTOK; r += gridDim.x * (NTHR / 64)) {
        float x[16]; float s = 0.f;
#pragma unroll
        for (int j = 0; j < 4; ++j) { const int col = j * 256 + lane * 4; const ushort4 tb = *(const ushort4*)(x1b + (size_t)r * 1024 + col); const float4 t = make_float4(bf2f(tb.x), bf2f(tb.y), bf2f(tb.z), bf2f(tb.w));
            const ushort4 a = *(const ushort4*)(ys + (size_t)(2 * r) * 1024 + col), b = *(const ushort4*)(ys + (size_t)(2 * r + 1) * 1024 + col);
            x[4 * j] = ALPHA * t.x + bf2f(a.x) + bf2f(b.x); x[4 * j + 1] = ALPHA * t.y + bf2f(a.y) + bf2f(b.y); x[4 * j + 2] = ALPHA * t.z + bf2f(a.z) + bf2f(b.z); x[4 * j + 3] = ALPHA * t.w + bf2f(a.w) + bf2f(b.w);
            s += (x[4 * j] + x[4 * j + 1]) + (x[4 * j + 2] + x[4 * j + 3]); }
#pragma unroll
        for (int m = 1; m < 64; m <<= 1) s += __shfl_xor(s, m);
        const float mu = s * (1.f / 1024.f); float q = 0.f;
#pragma unroll
        for (int j = 0; j < 16; ++j) { x[j] -= mu; q += x[j] * x[j]; }
#pragma unroll
        for (int m = 1; m < 64; m <<= 1) q += __shfl_xor(q, m);
        const float rstd = rsqrtf(q * (1.f / 1024.f) + LN_EPS);
#pragma unroll
        for (int j = 0; j < 4; ++j) { const int col = j * 256 + lane * 4; const float4 gg = *(const float4*)(g2 + col), bb = *(const float4*)(b2 + col);
            *(float4*)(out + (size_t)r * 1024 + col) = make_float4(x[4 * j] * rstd * gg.x + bb.x, x[4 * j + 1] * rstd * gg.y + bb.y, x[4 * j + 2] * rstd * gg.z + bb.z, x[4 * j + 3] * rstd * gg.w + bb.w); }
    }
}

struct Args { const float* in[24]; float* out; unsigned char* ws; };
__global__ void __launch_bounds__(NTHR, 2) mega_fwd(Args a) {
    extern __shared__ __attribute__((aligned(16))) unsigned char lds_raw[];
    float* ldsf = (float*)lds_raw;
    PG8_LAS unsigned char* ldsl = (PG8_LAS unsigned char*)lds_raw;
    volatile LAS unsigned* MISC = (volatile LAS unsigned*)((LAS unsigned char*)lds_raw + LDS_MISC);
    for (int u = threadIdx.x; u < 128; u += NTHR) MISC[u] = 0u;
    __syncthreads();
    unsigned char* ws = a.ws;
    XcdBarrier bar = xcd_barrier_post((unsigned*)(ws + WS_CTL) + CW_BAR, MISC + 8);
#define GRID_BAR() xcd_barrier(bar)
    const float* x = a.in[0]; const float* w_in = a.in[1]; const float* b_merge = a.in[2];
    const float* conv_w = a.in[3]; const float* conv_b = a.in[4];
    const float* w_rg_r = a.in[5]; const float* b_rg_r = a.in[6]; const float* w_rg_i = a.in[7]; const float* b_rg_i = a.in[8];
    const float* lam = a.in[9]; const float* w_ret_o = a.in[10]; const float* w_lru_o = a.in[11]; const float* w_out = a.in[12];
    const float* ln1_g = a.in[13]; const float* ln1_b = a.in[14]; const float* w_group = a.in[15]; const float* b_group = a.in[16];
    const float* w_er = a.in[17]; const float* b_er = a.in[18]; const float* w_eg = a.in[19]; const float* w_eu = a.in[20];
    const float* w_ed = a.in[21]; const float* ln2_g = a.in[22]; const float* ln2_b = a.in[23];
    float* out = a.out;
    int* cnt = (int*)(ws + WS_CTL); float2* rope = (float2*)(ws + WS_ROPE); int2* route_e = (int2*)(ws + WS_ROUTE_E); float2* route_w = (float2*)(ws + WS_ROUTE_W); int* list = (int*)(ws + WS_LIST);
    bf16_t* xb = (bf16_t*)(ws + WS_XB); bf16_t* gl = (bf16_t*)(ws + WS_GL); bf16_t* ulru = (bf16_t*)(ws + WS_ULRU); bf16_t* uconv = (bf16_t*)(ws + WS_UCONV);
    bf16_t* epsb = (bf16_t*)(ws + WS_EPS); bf16_t* inp = (bf16_t*)out;
    bf16_t* q = (bf16_t*)(ws + WS_Q); bf16_t* k = (bf16_t*)(ws + WS_K); bf16_t* v = (bf16_t*)(ws + WS_V); bf16_t* gbuf = (bf16_t*)out;
    bf16_t* P = (bf16_t*)(ws + WS_P); bf16_t* gates = (bf16_t*)(ws + WS_GATES); bf16_t* m1 = (bf16_t*)out; bf16_t* merged = xb;
    bf16_t* w_in_t = (bf16_t*)(ws + WS_WIN_T); bf16_t* w_ro_t = (bf16_t*)(ws + WS_WRO_T); bf16_t* w_lo_t = (bf16_t*)(ws + WS_WLO_T); bf16_t* w_out_t = (bf16_t*)(ws + WS_WOUT_T);
    bf16_t* wrg_t = (bf16_t*)(ws + WS_WRG_T); float* segA = (float*)(ws + WS_SEGA); float* segH = (float*)(ws + WS_SEGH); float* carry = (float*)(ws + WS_CARRY);
    float* rsb = (float*)(ws + WS_RSB);
    unsigned char* wgu8 = ws + WS_WGU_T; unsigned char* wd8 = ws + WS_WD_T; unsigned char* x1q = ws + WS_X1Q;
    bf16_t* x1b = gl; bf16_t* hbuf = (bf16_t*)(ws + WS_H); bf16_t* ys = (bf16_t*)(ws + WS_YSLOT);

    p_router_consts(ldsf, ln1_g, ln1_b, w_group, b_group, w_er, b_er, rsb); p_cvt_x(x, xb); p_rope_table(rope); p_weights(ldsf, w_in, w_ret_o, w_lru_o, w_out, w_rg_r, w_rg_i, w_in_t, w_ro_t, w_lo_t, w_out_t, wrg_t);
    GRID_BAR();
    { pg8::Gemm g{xb, w_in_t + (size_t)C_U * 1024, NTOK, 3072, 1024}; pg8::StaticOrder S; S.init(NTOK, 3072, (int)gridDim.x, (int)blockIdx.x);
      pg8::gemm_phase<pg8::EpiLruIn, pg8::StaticOrder, true, true>(ldsl, g, S, pg8::EpiLruIn{ulru, gl}); }
    GRID_BAR();
    p_lru_compute(lds_raw, ulru, conv_w, conv_b, wrg_t, b_rg_r, b_rg_i, lam, uconv, epsb, segA, segH);
    GRID_BAR();
    p_lru_carry(ldsf, segA, segH, carry);
    GRID_BAR();
    p_lru_scan(uconv, epsb, gl, carry);
    GRID_BAR();
    { pg8::Gemm g{xb, w_in_t, NTOK, 6144, 1024}; pg8::StaticOrder S; S.init(NTOK, 6144, (int)gridDim.x, (int)blockIdx.x);
      pg8::gemm_phase<pg8::EpiRetIn, pg8::StaticOrder, true, true>(ldsl, g, S, pg8::EpiRetIn{q, k, v, gbuf, (const float*)rope}); }
    GRID_BAR();
    p_scores(lds_raw, q, k, P);
    GRID_BAR();
    p_ret_mfma(lds_raw, q, k, v, P);
    GRID_BAR();
    p_headnorm(v, gbuf);
    { pg8::Gemm g{xb, w_in_t + (size_t)C_GATE * 1024, NTOK, 2048, 1024}; pg8::StaticOrder S; S.init(NTOK, 2048, (int)gridDim.x, (int)blockIdx.x);
      pg8::gemm_phase<pg8::EpiGates, pg8::StaticOrder, true, true>(ldsl, g, S, pg8::EpiGates{b_merge, gates}); }
    GRID_BAR();
    { pg8::Gemm g{v, w_ro_t, NTOK, 1024, 2048}; pg8::StaticOrder S; S.init(NTOK, 1024, (int)gridDim.x, (int)blockIdx.x);
      pg8::gemm_phase<pg8::EpiMerge<0>, pg8::StaticOrder, true, true>(ldsl, g, S, pg8::EpiMerge<0>{gates, nullptr, m1}); }
    GRID_BAR();
    { pg8::Gemm g{gl, w_lo_t, NTOK, 1024, 1536}; pg8::StaticOrder S; S.init(NTOK, 1024, (int)gridDim.x, (int)blockIdx.x);
      pg8::gemm_phase<pg8::EpiMerge<1>, pg8::StaticOrder, true, true>(ldsl, g, S, pg8::EpiMerge<1>{gates, m1, merged}); }
    GRID_BAR();
    { pg8::Gemm g{merged, w_out_t, NTOK, 1024, 1024}; pg8::StaticOrder S; S.init(NTOK, 1024, (int)gridDim.x, (int)blockIdx.x);
      pg8::gemm_phase<pg8::EpiOut, pg8::StaticOrder, true, true>(ldsl, g, S, pg8::EpiOut{x, (bf16_t*)out, ALPHA}); }
    GRID_BAR();
    p_ln1_route(ldsf, (const bf16_t*)out, x1b, x1q, ln1_g, ln1_b, w_group, b_group, w_er, b_er, route_e, route_w, cnt, list, rsb);
    p_expert_weights(ldsf, w_eg, w_eu, w_ed, wgu8, wd8);
    GRID_BAR();
    {
        PG8_LAS pg8::MoeTab* tab = (PG8_LAS pg8::MoeTab*)(ldsl + LDS_TAB);
        pg8::moe_build_tab(tab, cnt);
        const int T = tab->tileStart[32];
        { pg8::Gemm g{(const bf16_t*)x1q, (const bf16_t*)wgu8, T * 256, 32 * 1024, 512}; pg8::MoeOrder<true> S{T * 4, (int)gridDim.x, (int)blockIdx.x, tab, list};
          pg8::gemm_phase<pg8::EpiSwiGLU8, pg8::MoeOrder<true>, true, true, true>(ldsl, g, S, pg8::EpiSwiGLU8{(unsigned char*)hbuf}); }
        GRID_BAR();
        { pg8::Gemm g{hbuf, (const bf16_t*)wd8, T * 256, 32 * 1024, 256}; pg8::MoeOrder<false> S{T * 4, (int)gridDim.x, (int)blockIdx.x, tab, list};
          pg8::gemm_phase<pg8::EpiMoeOut8, pg8::MoeOrder<false>, true, true, true>(ldsl, g, S, pg8::EpiMoeOut8{tab, list, (const float*)route_w, ys}); }
    }
    GRID_BAR();
    p_final(out, x1b, ys, ln2_g, ln2_b);
}

extern "C" void kernel_launch(void* const* d_in, const int* in_sizes, int n_in, void* d_out, int out_size, void* d_ws, size_t ws_size, hipStream_t stream) {
    static int grid = 0;
    if (grid == 0) {
        if (n_in != 24 || in_sizes[0] != NTOK * DM || out_size != NTOK * DM || ws_size < WS_END) {
            fprintf(stderr, "kernel_launch: unexpected shapes (n_in %d, in0 %d, out %d, ws %zu)\n", n_in, n_in > 0 ? in_sizes[0] : -1, out_size, ws_size); grid = -1; return; }
        int dev = 0, cus = 0, per_cu = 0;
        if (hipGetDevice(&dev) != hipSuccess || hipDeviceGetAttribute(&cus, hipDeviceAttributeMultiprocessorCount, dev) != hipSuccess) { fprintf(stderr, "kernel_launch: device query failed\n"); grid = -1; return; }
        if (hipFuncSetAttribute((const void*)mega_fwd, hipFuncAttributeMaxDynamicSharedMemorySize, LDS_BYTES) != hipSuccess) { fprintf(stderr, "kernel_launch: hipFuncSetAttribute failed\n"); grid = -1; return; }
        if (hipOccupancyMaxActiveBlocksPerMultiprocessor(&per_cu, (const void*)mega_fwd, NTHR, LDS_BYTES) != hipSuccess || per_cu < 1) {
            fprintf(stderr, "kernel_launch: occupancy query reports %d workgroups per CU\n", per_cu); (void)hipGetLastError(); grid = -1; return; }
        grid = cus;
    }
    if (grid < 0) return;
    if (hipMemsetAsync((char*)d_ws + WS_CTL, 0, CTL_ZERO_BYTES, stream) != hipSuccess) { fprintf(stderr, "kernel_launch: memset failed\n"); return; }
    Args a{};
    for (int i = 0; i < 24; ++i) a.in[i] = (const float*)d_in[i];
    a.out = (float*)d_out; a.ws = (unsigned char*)d_ws;
    hipLaunchKernelGGL(mega_fwd, dim3(grid), dim3(NTHR), LDS_BYTES, stream, a);
    const hipError_t le = hipPeekAtLastError();
    if (le != hipSuccess) fprintf(stderr, "kernel_launch: launch failed: %s\n", hipGetErrorName(le));
}
```

```cpp
#include <hip/hip_runtime.h>
#include <cstdio>
#include <cstdint>

typedef unsigned short bf16_t;
#define DEV __device__ __forceinline__
#define LAS __attribute__((address_space(3)))

DEV float bf2f(bf16_t h) { return __uint_as_float(((unsigned)h) << 16); }
DEV bf16_t f2bf(float f) { unsigned u = __float_as_uint(f); return (bf16_t)((u + 0x7fffu + ((u >> 16) & 1u)) >> 16); }

constexpr int NTHR = 512;
constexpr int NTOK = 32768, DM = 1024, SEQ = 8192;
constexpr int WIN_N = 11264;
constexpr int C_Q = 0, C_K = 1024, C_V = 2048, C_G = 4096, C_U = 6144, C_GL = 7680, C_GATE = 9216;
constexpr float ALPHA = 1.189207115002721f;
constexpr float LN_EPS = 1e-5f;
constexpr size_t MiB = 1u << 20;
constexpr size_t WS_CTL = 0;
constexpr size_t CTL_ZERO_BYTES = 1 * MiB;
constexpr int CW_BAR = 4096;
constexpr size_t WS_ROPE = 1 * MiB;
constexpr size_t WS_ROUTE_E = 9 * MiB;
constexpr size_t WS_ROUTE_W = 9 * MiB + 512 * 1024;
constexpr size_t WS_LIST = 10 * MiB;
constexpr size_t WS_WRG_T = 14 * MiB;
constexpr size_t WS_RSB = 15 * MiB + 512 * 1024;
constexpr size_t WS_SEGA = 16 * MiB;
constexpr size_t WS_SEGH = 18 * MiB;
constexpr size_t WS_CARRY = 20 * MiB;
constexpr size_t WS_XB = 32 * MiB;
constexpr size_t WS_GL = 96 * MiB;
constexpr size_t WS_ULRU = 192 * MiB;
constexpr size_t WS_Q = 192 * MiB;
constexpr size_t WS_K = 256 * MiB;
constexpr size_t WS_GATES = 192 * MiB;
constexpr size_t WS_UCONV = 288 * MiB;
constexpr size_t WS_P = 320 * MiB;
constexpr size_t WS_V = 352 * MiB;
constexpr size_t WS_EPS = 384 * MiB;
constexpr size_t WS_H = 192 * MiB;
constexpr size_t WS_YSLOT = 264 * MiB;
constexpr size_t WS_WGU_T = 352 * MiB;
constexpr size_t WS_WD_T = 416 * MiB;
constexpr size_t WS_X1Q = 160 * MiB;
constexpr int LDS_TAB = 131072;
constexpr size_t WS_WIN_T = 480 * MiB;
constexpr size_t WS_WRO_T = 502 * MiB;
constexpr size_t WS_WLO_T = 506 * MiB;
constexpr size_t WS_WOUT_T = 509 * MiB;
constexpr size_t WS_END = 512 * MiB;
constexpr int LDS_BYTES = 163840;
constexpr int LDS_MISC = 163840 - 512;

#define XB_TMO      128
#define XB_XCNT(j)  (256  + 64 * (j))
#define XB_XSUB(j)  (1280 + 64 * (j))
#define XB_XGEN(j)  (2304 + 64 * (j))
#define XB_TOP      3328
#define XB_TOPGEN   3392
#define XCD_BAR_WORDS 3456
#define XB_SPIN_CAP (1u << 22)
DEV unsigned xb_ld(unsigned* p)              { return __hip_atomic_load(p, __ATOMIC_RELAXED, __HIP_MEMORY_SCOPE_AGENT); }
DEV unsigned xb_add(unsigned* p, unsigned v) { return __hip_atomic_fetch_add(p, v, __ATOMIC_RELAXED, __HIP_MEMORY_SCOPE_AGENT); }
DEV unsigned xb_xcc_id() { return (unsigned)__builtin_amdgcn_s_getreg((3 << 11) | 20) & 0xFu; }
#define XB_SPIN(cond, bar) do { unsigned _sp = 0; while (cond) { __builtin_amdgcn_s_sleep(1); \
    if ((++_sp & 255u) == 0u) { if (xb_ld(&(bar)[XB_TMO])) break; if (_sp > XB_SPIN_CAP) { atomicAdd(&(bar)[XB_TMO], 1u); break; } } } } while (0)
struct XcdBarrier { unsigned* bar; unsigned x; volatile LAS unsigned* st; };
DEV XcdBarrier xcd_barrier_post(unsigned* bar, volatile LAS unsigned* st) {
    XcdBarrier b; b.bar = bar; b.x = xb_xcc_id(); b.st = st;
    if (threadIdx.x == 0) (void)xb_add(&bar[XB_XCNT(b.x)], 1u);
    return b;
}
DEV void xcd_barrier_complete(unsigned* bar, unsigned x, unsigned& nloc, unsigned& nx) {
    const unsigned G = gridDim.x * gridDim.y * gridDim.z;
    unsigned sum, cnt, mine, sp = 0u;
    for (;;) {
        sum = 0u; cnt = 0u; mine = 0u;
#pragma unroll
        for (unsigned j = 0; j < 16; ++j) { const unsigned c = xb_ld(&bar[XB_XCNT(j)]); sum += c; cnt += (c > 0u) ? 1u : 0u; mine = (j == x) ? c : mine; }
        if (sum == G) break;
        __builtin_amdgcn_s_sleep(1);
        if ((++sp & 255u) == 0u) { if (xb_ld(&bar[XB_TMO])) break; if (sp > XB_SPIN_CAP) { atomicAdd(&bar[XB_TMO], 1u); break; } }
    }
    nloc = mine > 0u ? mine : 1u; nx = cnt > 0u ? cnt : 1u;
}
DEV void xcd_barrier(const XcdBarrier& b) {
    asm volatile("s_waitcnt vmcnt(0)" ::: "memory");
    __syncthreads();
    if (threadIdx.x == 0) {
        unsigned* bar = b.bar;
        __builtin_amdgcn_s_waitcnt(0);
        unsigned nloc = b.st[0], nx = b.st[1];
        if (nloc == 0u) { xcd_barrier_complete(bar, b.x, nloc, nx); b.st[0] = nloc; b.st[1] = nx; }
        const unsigned old = xb_add(&bar[XB_XSUB(b.x)], 1u);
        const unsigned gen = old / nloc;
        if (old + 1u == (gen + 1u) * nloc) {
            __builtin_amdgcn_fence(__ATOMIC_RELEASE, "agent");
            asm volatile("s_waitcnt vmcnt(0)" ::: "memory");
            const unsigned og = xb_add(&bar[XB_TOP], 1u);
            const unsigned tg = og / nx;
            if (og + 1u == (tg + 1u) * nx) xb_add(&bar[XB_TOPGEN], 1u);
            else XB_SPIN(xb_ld(&bar[XB_TOPGEN]) == tg, bar);
            __builtin_amdgcn_fence(__ATOMIC_ACQUIRE, "agent");
            xb_add(&bar[XB_XGEN(b.x)], 1u);
            asm volatile("s_waitcnt vmcnt(0)" ::: "memory");
        } else {
            XB_SPIN(xb_ld(&bar[XB_XGEN(b.x)]) == gen, bar);
            __builtin_amdgcn_fence(__ATOMIC_ACQUIRE, "agent");
            asm volatile("s_waitcnt vmcnt(0)" ::: "memory");
        }
    }
    __syncthreads();
}

namespace pg8 {
#define PG8_LAS __attribute__((address_space(3)))
typedef unsigned short bf16_t;
typedef short bf16x8 __attribute__((ext_vector_type(8)));
typedef float f32x4 __attribute__((ext_vector_type(4)));
typedef unsigned u32x4 __attribute__((ext_vector_type(4)));
constexpr int BM = 256, BK = 64, HALF = 128, HTB = HALF * BK * 2  , STAGE_BYTES = 8 * HTB, NXCD = 8, WGM = 8;

__host__ __device__ __forceinline__ int lds_byte(int r, int c) { const int st = (r >> 4) * 2 + (c >> 5), rr = r & 15, cc = c & 31, ob = rr * 64 + cc * 2; return st * 1024 + (ob ^ (((ob >> 9) & 1) << 5)); }
__host__ __device__ __forceinline__ void stage_rc(int b, int& R, int& C) { const int st = b / 1024, sb = b % 1024, swz = sb ^ (((sb >> 9) & 1) << 5); R = (st >> 1) * 16 + swz / 64; C = (st & 1) * 32 + (swz % 64) / 2; }
__host__ __device__ __forceinline__ int perm32(int rho) { const int n = rho >> 4, i = rho & 15; return 8 * (i >> 2) + 4 * n + (i & 3); }

struct Unit { int pm, pn; };
struct Gemm { const bf16_t* A; const bf16_t* Bt; int M, N, K; };

struct StaticOrder {
    int nM, nN, nwg, G, c;
    __host__ __device__ void init(int M, int N, int G_, int c_) { nM = M / BM; nN = N / BM; nwg = nM * nN; G = G_; c = c_; }
    __host__ __device__ bool next(int i, Unit& u) const {
        const long L = (long)i * G + c; if (L >= nwg) return false;
        int wgid = (int)L; { const int q = nwg / NXCD, r = nwg % NXCD, xcd = wgid % NXCD, off = wgid / NXCD; wgid = (xcd < r ? xcd * (q + 1) : r * (q + 1) + (xcd - r) * q) + off; }
        const int nig = WGM * nN, gid = wgid / nig, fm = gid * WGM, gsz = (nM - fm) < WGM ? (nM - fm) : WGM;
        u.pm = fm + ((wgid % nig) % gsz); u.pn = (wgid % nig) / gsz; return true;
    }
    __device__ __forceinline__ void a_ready(const Unit&) const {}
    __device__ __forceinline__ void done(const Unit&) const {}
    __device__ __forceinline__ const char* a_base(const Gemm& g, const Unit& u) const { return (const char*)g.A + (size_t)u.pm * (size_t)(BM * g.K * 2); }
    __device__ __forceinline__ void a_off(const Gemm& g, const Unit&, const int (&R)[2], const int (&C)[2], unsigned (&v)[2][2]) const {
        _Pragma("unroll") for (int hh = 0; hh < 2; ++hh) _Pragma("unroll") for (int i = 0; i < 2; ++i) v[hh][i] = (unsigned)((hh * HALF + R[i]) * g.K + C[i]) * 2u; }
};
typedef __bf16 bf16x2_t __attribute__((ext_vector_type(2)));
typedef float f32x2_t __attribute__((ext_vector_type(2)));
__device__ __forceinline__ unsigned cvt_pk_bf16(float lo, float hi) { f32x2_t v = {lo, hi}; return __builtin_bit_cast(unsigned, __builtin_convertvector(v, bf16x2_t)); }
typedef int i32x4 __attribute__((ext_vector_type(4)));
typedef int i32x8 __attribute__((ext_vector_type(8)));
template <bool MX8> struct Frag { struct A4 { bf16x8 v[4][2]; }; struct B2 { bf16x8 v[2][2]; }; };
template <> struct Frag<true> { struct A4 { i32x8 v[4]; }; struct B2 { i32x8 v[2]; }; };
__device__ __forceinline__ i32x8 ld32(const PG8_LAS unsigned char* p0, const PG8_LAS unsigned char* p1) { const i32x4 a = *(const PG8_LAS i32x4*)p0, b = *(const PG8_LAS i32x4*)p1; return __builtin_shufflevector(a, b, 0, 1, 2, 3, 4, 5, 6, 7); }
template <class Epi, class Sched, bool ALIGN_EPI = false, bool SP2 = false, bool MX8 = false>
__device__ __forceinline__ void gemm_phase(PG8_LAS unsigned char* lds, const Gemm g, const Sched& S, const Epi& E) {
    int tid_ = threadIdx.x; asm volatile("" : "+v"(tid_));
    const int tid = tid_, wid = __builtin_amdgcn_readfirstlane(tid >> 6), lane = tid & 63, wr = wid >> 2, wc = wid & 3, fr = lane & 15, fq = lane >> 4;
    const int K = g.K, nt = K / BK;
    unsigned voffB[2], vA[2][2], vN[2][2]; int sR[2], sC[2];
#pragma unroll
    for (int i = 0; i < 2; ++i) { int R, C; stage_rc(tid * 16 + i * 8192, R, C); const int Rb = Epi::PERM ? ((R & ~31) + perm32(R & 31)) : R;
        sR[i] = R; sC[i] = C; voffB[i] = (unsigned)(Rb * K + C) * 2u; }
    const size_t kstep = (size_t)(BK * 2);
    const size_t hstep = (size_t)HALF * K * 2;
    const size_t tstep = 2 * hstep;
    const unsigned ldsw = (unsigned)wid * 1024u;
    const int aoff = lds_byte(wr * 64 + fr, fq * 8), boff = lds_byte(wc * 32 + fr, fq * 8);
#define PG8_SA(b, h) (((b) * 2 + (h)) * HTB)
#define PG8_SB(b, h) ((4 + (b) * 2 + (h)) * HTB)
#define PG8_STAGE(bufoff, gbase, voff) do { _Pragma("unroll") for (int _i = 0; _i < 2; ++_i) \
        __builtin_amdgcn_global_load_lds((const unsigned*)((const char*)(gbase) + (voff)[_i]), (PG8_LAS unsigned*)(lds + (bufoff) + ldsw + _i * 8192), 16, 0, 0); } while (0)
#define PG8_LDA(dst, b, h) do { if constexpr (MX8) { _Pragma("unroll") for (int m = 0; m < 4; ++m) dst.v[m] = ld32(lds + PG8_SA(b, h) + aoff + m * 2048, lds + PG8_SA(b, h) + aoff + m * 2048 + 1024); } \
        else { _Pragma("unroll") for (int m = 0; m < 4; ++m) _Pragma("unroll") for (int k = 0; k < 2; ++k) dst.v[m][k] = *(const PG8_LAS bf16x8*)(lds + PG8_SA(b, h) + aoff + m * 2048 + k * 1024); } } while (0)
#define PG8_LDB(dst, b, h) do { if constexpr (MX8) { _Pragma("unroll") for (int n = 0; n < 2; ++n) dst.v[n] = ld32(lds + PG8_SB(b, h) + boff + n * 2048, lds + PG8_SB(b, h) + boff + n * 2048 + 1024); } \
        else { _Pragma("unroll") for (int n = 0; n < 2; ++n) _Pragma("unroll") for (int k = 0; k < 2; ++k) dst.v[n][k] = *(const PG8_LAS bf16x8*)(lds + PG8_SB(b, h) + boff + n * 2048 + k * 1024); } } while (0)
#define PG8_MMA(ai, bj, At, Bt) do { __builtin_amdgcn_s_setprio(1); \
        if constexpr (MX8) { _Pragma("unroll") for (int m = 0; m < 4; ++m) _Pragma("unroll") for (int n = 0; n < 2; ++n) \
            { acc[ai][bj][m][n] = __builtin_amdgcn_mfma_scale_f32_16x16x128_f8f6f4(Bt.v[n], At.v[m], acc[ai][bj][m][n], 0, 0, 0, 0x7f7f7f7f, 0, 0x7f7f7f7f); asm volatile("" : "+v"(acc[ai][bj][m][n])); } } \
        else { _Pragma("unroll") for (int m = 0; m < 4; ++m) _Pragma("unroll") for (int n = 0; n < 2; ++n) _Pragma("unroll") for (int k = 0; k < 2; ++k) \
            acc[ai][bj][m][n] = __builtin_amdgcn_mfma_f32_16x16x32_bf16(Bt.v[n][k], At.v[m][k], acc[ai][bj][m][n], 0, 0, 0); } \
        __builtin_amdgcn_s_setprio(0); } while (0)
#define PG8_WAIT_V(n) asm volatile("s_waitcnt vmcnt(" #n ")" ::: "memory")
#define PG8_WAIT_L(n) asm volatile("s_waitcnt lgkmcnt(" #n ")" ::: "memory")
#define PG8_BAR __builtin_amdgcn_s_barrier()
#define PG8_SCHED __builtin_amdgcn_sched_barrier(0)
    Unit cur, nxt; int ui = 0;
    if (!S.next(0, cur)) return;
    f32x4 acc[2][2][4][2];
#pragma unroll
    for (int a = 0; a < 2; ++a)
#pragma unroll
        for (int b = 0; b < 2; ++b)
#pragma unroll
            for (int m = 0; m < 4; ++m)
#pragma unroll
                for (int n = 0; n < 2; ++n) acc[a][b][m][n] = (f32x4){0.f, 0.f, 0.f, 0.f};
    typename Frag<MX8>::A4 At; typename Frag<MX8>::B2 B0, B1;
    const char* cA = S.a_base(g, cur); const char* cB = (const char*)g.Bt + (size_t)cur.pn * tstep;
    S.a_ready(cur); S.a_off(g, cur, sR, sC, vA);
    if constexpr (SP2) {
        PG8_STAGE(PG8_SB(0, 0), cB, voffB); PG8_STAGE(PG8_SB(0, 1), cB + hstep, voffB); PG8_STAGE(PG8_SA(0, 0), cA, vA[0]); PG8_STAGE(PG8_SA(0, 1), cA, vA[1]);
        if (wr == 1) PG8_BAR;
        PG8_WAIT_V(2); PG8_BAR;
        PG8_STAGE(PG8_SB(1, 0), cB + kstep, voffB); PG8_STAGE(PG8_SA(1, 0), cA + kstep, vA[0]); PG8_STAGE(PG8_SB(1, 1), cB + hstep + kstep, voffB);
        PG8_WAIT_V(6); PG8_BAR;
    } else { static_assert(SP2, "only the SP2 K-loop is kept in this file"); }
    for (;;) {
        const bool has_next = S.next(ui + 1, nxt);
        const char* nA = has_next ? S.a_base(g, nxt) : cA; const char* nB = has_next ? (const char*)g.Bt + (size_t)nxt.pn * tstep : cB;
        if (has_next) S.a_off(g, nxt, sR, sC, vN); else { vN[0][0] = vA[0][0]; vN[0][1] = vA[0][1]; vN[1][0] = vA[1][0]; vN[1][1] = vA[1][1]; }
#pragma unroll 1
        for (int t = 0; t < nt; t += 2) {
            const bool last = (t == nt - 2);
            const char* a1 = cA + (size_t)(t + 1) * kstep;
            const char* a2 = last ? nA : cA + (size_t)(t + 2) * kstep; const char* b2 = last ? nB : cB + (size_t)(t + 2) * kstep;
            const char* a3 = a2 + kstep; const char* b3 = b2 + kstep;
            unsigned v2[2][2]; v2[0][0] = last ? vN[0][0] : vA[0][0]; v2[0][1] = last ? vN[0][1] : vA[0][1]; v2[1][0] = last ? vN[1][0] : vA[1][0]; v2[1][1] = last ? vN[1][1] : vA[1][1];
            if (last && has_next) S.a_ready(nxt);
            if constexpr (SP2) {
            PG8_LDB(B0, 0, 0); PG8_LDB(B1, 0, 1); PG8_SCHED; PG8_LDA(At, 0, 0); PG8_STAGE(PG8_SA(1, 1), a1, vA[1]);
            PG8_WAIT_V(8); PG8_WAIT_L(0); PG8_BAR; PG8_MMA(0, 0, At, B0); PG8_MMA(0, 1, At, B1); PG8_BAR; PG8_SCHED;
            PG8_LDA(At, 0, 1); PG8_STAGE(PG8_SB(0, 0), b2, voffB); PG8_STAGE(PG8_SB(0, 1), b2 + hstep, voffB); PG8_STAGE(PG8_SA(0, 0), a2, v2[0]);
            PG8_WAIT_V(8); PG8_WAIT_L(0); PG8_BAR; PG8_MMA(1, 0, At, B0); PG8_MMA(1, 1, At, B1); PG8_BAR; PG8_SCHED;
            PG8_LDB(B0, 1, 0); PG8_LDB(B1, 1, 1); PG8_SCHED; PG8_LDA(At, 1, 0); PG8_STAGE(PG8_SA(0, 1), a2, v2[1]);
            PG8_WAIT_V(8); PG8_WAIT_L(0); PG8_BAR; PG8_MMA(0, 0, At, B0); PG8_MMA(0, 1, At, B1); PG8_BAR; PG8_SCHED;
            PG8_LDA(At, 1, 1); PG8_STAGE(PG8_SB(1, 0), b3, voffB); PG8_STAGE(PG8_SB(1, 1), b3 + hstep, voffB); PG8_STAGE(PG8_SA(1, 0), a3, v2[0]);
            PG8_WAIT_V(8); PG8_WAIT_L(0); PG8_BAR; PG8_MMA(1, 0, At, B0); PG8_MMA(1, 1, At, B1); PG8_BAR; PG8_SCHED;
            }
        }
        if constexpr (ALIGN_EPI) { if (wr == 0) PG8_BAR; }
        if constexpr (!Epi::AFTER_DRAIN) { E(acc, cur, wr, wc, fr, fq); S.done(cur); }
        if (!has_next) break;
#pragma unroll
        for (int a = 0; a < 2; ++a)
#pragma unroll
            for (int b = 0; b < 2; ++b)
#pragma unroll
                for (int m = 0; m < 4; ++m)
#pragma unroll
                    for (int n = 0; n < 2; ++n) acc[a][b][m][n] = (f32x4){0.f, 0.f, 0.f, 0.f};
        cur = nxt; cA = nA; cB = nB; ++ui; vA[0][0] = vN[0][0]; vA[0][1] = vN[0][1]; vA[1][0] = vN[1][0]; vA[1][1] = vN[1][1];
        if constexpr (ALIGN_EPI) { if (wr == 1) PG8_BAR; }
    }
    PG8_WAIT_V(0);
    if constexpr (!ALIGN_EPI) { if (wr == 0) PG8_BAR; }
    PG8_BAR;
    if constexpr (Epi::AFTER_DRAIN) { E.fused(acc, cur, wr, wc, fr, fq, lds, wid, lane); S.done(cur); }
#undef PG8_SA
#undef PG8_SB
#undef PG8_STAGE
#undef PG8_LDA
#undef PG8_LDB
#undef PG8_MMA
#undef PG8_WAIT_V
#undef PG8_WAIT_L
#undef PG8_BAR
#undef PG8_SCHED
}

__device__ __forceinline__ float fsig(float x) { return __builtin_amdgcn_rcpf(1.f + __expf(-x)); }
__device__ __forceinline__ float fsilu(float x) { return x * fsig(x); }
__device__ __forceinline__ float fgelu(float x) { return x * fsig(1.5957691216057308f * (x + 0.044715f * x * x * x)); }
__device__ __forceinline__ u32x4 pack8(const f32x4& v0, const f32x4& v1) { u32x4 w; w.x = cvt_pk_bf16(v0[0], v0[1]); w.y = cvt_pk_bf16(v0[2], v0[3]); w.z = cvt_pk_bf16(v1[0], v1[1]); w.w = cvt_pk_bf16(v1[2], v1[3]); return w; }
__device__ __forceinline__ void unpack8(const u32x4& w, f32x4& v0, f32x4& v1) {
    v0[0] = __uint_as_float(w.x << 16); v0[1] = __uint_as_float(w.x & 0xffff0000u); v0[2] = __uint_as_float(w.y << 16); v0[3] = __uint_as_float(w.y & 0xffff0000u);
    v1[0] = __uint_as_float(w.z << 16); v1[1] = __uint_as_float(w.z & 0xffff0000u); v1[2] = __uint_as_float(w.w << 16); v1[3] = __uint_as_float(w.w & 0xffff0000u); }

struct EpiLruIn {
    static constexpr bool PERM = true, AFTER_DRAIN = false;
    bf16_t* u; bf16_t* gl;
    __device__ __forceinline__ void operator()(const f32x4 (&acc)[2][2][4][2], const Unit& un, int wr, int wc, int fr, int fq) const {
        const int row0 = un.pm * BM + wr * 64 + fr; const bool isg = un.pn >= 6;
        bf16_t* base = (isg ? gl : u) + (isg ? un.pn - 6 : un.pn) * BM + wc * 32 + 8 * fq;
#pragma unroll
        for (int ai = 0; ai < 2; ++ai)
#pragma unroll
            for (int m = 0; m < 4; ++m) { bf16_t* rowp = base + (size_t)(row0 + ai * HALF + m * 16) * 1536;
#pragma unroll
                for (int bj = 0; bj < 2; ++bj) { f32x4 v0 = acc[ai][bj][m][0], v1 = acc[ai][bj][m][1];
                    if (isg) {
#pragma unroll
                        for (int e = 0; e < 4; ++e) { v0[e] = fgelu(v0[e]); v1[e] = fgelu(v1[e]); } }
                    *(u32x4*)(rowp + bj * HALF) = pack8(v0, v1); } }
    }
};
struct EpiRetIn {
    static constexpr bool PERM = true, AFTER_DRAIN = false;
    bf16_t* q; bf16_t* k; bf16_t* v; bf16_t* g; const float* rope;
    __device__ __forceinline__ void operator()(const f32x4 (&acc)[2][2][4][2], const Unit& un, int wr, int wc, int fr, int fq) const {
        const int row0 = un.pm * BM + wr * 64 + fr;
        if (un.pn < 8) {
            const bool isk = un.pn >= 4; const int h = un.pn & 3;
            const float lg = __log2f(1.f - __builtin_amdgcn_exp2f(-5.f - (float)h));
            const int jb = wc * 32 + 8 * fq;
            bf16_t* base = (isk ? k : q) + h * 256 + jb;
#pragma unroll
            for (int ai = 0; ai < 2; ++ai)
#pragma unroll
                for (int m = 0; m < 4; ++m) { const int r = row0 + ai * HALF + m * 16, s = r & 8191, n = s & 127;
                    const float sc = isk ? __builtin_amdgcn_exp2f(-(float)n * lg) * 0.0625f : __builtin_amdgcn_exp2f((float)n * lg);
                    const f32x4* tp = (const f32x4*)(rope + ((size_t)s * 128 + jb) * 2);
                    f32x4 o1[2], o2[2];
#pragma unroll
                    for (int nn = 0; nn < 2; ++nn) { const f32x4 ta = tp[2 * nn], tb = tp[2 * nn + 1]; const f32x4 a = acc[ai][0][m][nn], b = acc[ai][1][m][nn];
                        o1[nn][0] = (a[0] * ta[0] - b[0] * ta[1]) * sc; o2[nn][0] = (a[0] * ta[1] + b[0] * ta[0]) * sc;
                        o1[nn][1] = (a[1] * ta[2] - b[1] * ta[3]) * sc; o2[nn][1] = (a[1] * ta[3] + b[1] * ta[2]) * sc;
                        o1[nn][2] = (a[2] * tb[0] - b[2] * tb[1]) * sc; o2[nn][2] = (a[2] * tb[1] + b[2] * tb[0]) * sc;
                        o1[nn][3] = (a[3] * tb[2] - b[3] * tb[3]) * sc; o2[nn][3] = (a[3] * tb[3] + b[3] * tb[2]) * sc; }
                    bf16_t* rowp = isk ? base + (size_t)r * 1024 : q + ((size_t)(r >> 7) * 4 + h) * 32768 + ((wc * 4 + fq) * 128 + n) * 8;
                    *(u32x4*)(rowp) = pack8(o1[0], o1[1]); *(u32x4*)(rowp + (isk ? HALF : 16384)) = pack8(o2[0], o2[1]);
                    asm volatile("" ::: "memory"); }
        } else {
            const bool isg = un.pn >= 16;
            bf16_t* base = (isg ? g : v) + ((un.pn - 8) & 7) * BM + wc * 32 + 8 * fq;
#pragma unroll
            for (int ai = 0; ai < 2; ++ai)
#pragma unroll
                for (int m = 0; m < 4; ++m) { bf16_t* rowp = base + (size_t)(row0 + ai * HALF + m * 16) * 2048;
#pragma unroll
                    for (int bj = 0; bj < 2; ++bj) { f32x4 v0 = acc[ai][bj][m][0], v1 = acc[ai][bj][m][1];
                        if (isg) {
#pragma unroll
                            for (int e = 0; e < 4; ++e) { v0[e] = fsilu(v0[e]); v1[e] = fsilu(v1[e]); } }
                        *(u32x4*)(rowp + bj * HALF) = pack8(v0, v1); } }
        }
    }
};
struct EpiGates {
    static constexpr bool PERM = true, AFTER_DRAIN = false;
    const float* bm; bf16_t* gates;
    __device__ __forceinline__ void operator()(const f32x4 (&acc)[2][2][4][2], const Unit& un, int wr, int wc, int fr, int fq) const {
        const int row0 = un.pm * BM + wr * 64 + fr, col0 = un.pn * BM + wc * 32 + 8 * fq;
        f32x4 bv[2][2];
#pragma unroll
        for (int bj = 0; bj < 2; ++bj)
#pragma unroll
            for (int n = 0; n < 2; ++n) bv[bj][n] = *(const f32x4*)(bm + col0 + bj * HALF + 4 * n);
#pragma unroll
        for (int ai = 0; ai < 2; ++ai)
#pragma unroll
            for (int m = 0; m < 4; ++m) { bf16_t* rowp = gates + (size_t)(row0 + ai * HALF + m * 16) * 2048 + col0;
#pragma unroll
                for (int bj = 0; bj < 2; ++bj) { f32x4 v0 = acc[ai][bj][m][0] + bv[bj][0], v1 = acc[ai][bj][m][1] + bv[bj][1];
#pragma unroll
                    for (int e = 0; e < 4; ++e) { v0[e] = fsig(v0[e]); v1[e] = fsig(v1[e]); }
                    *(u32x4*)(rowp + bj * HALF) = pack8(v0, v1); } }
    }
};
template <int MODE> struct EpiMerge {
    static constexpr bool PERM = true, AFTER_DRAIN = false;
    const bf16_t* gates; const bf16_t* m1in; bf16_t* o;
    __device__ __forceinline__ void operator()(const f32x4 (&acc)[2][2][4][2], const Unit& un, int wr, int wc, int fr, int fq) const {
        const int row0 = un.pm * BM + wr * 64 + fr, col0 = un.pn * BM + wc * 32 + 8 * fq;
#pragma unroll
        for (int ai = 0; ai < 2; ++ai)
#pragma unroll
            for (int m = 0; m < 4; ++m) { const size_t r = (size_t)(row0 + ai * HALF + m * 16);
#pragma unroll
                for (int bj = 0; bj < 2; ++bj) { const int c = col0 + bj * HALF;
                    f32x4 g0, g1; unpack8(*(const u32x4*)(gates + r * 2048 + MODE * 1024 + c), g0, g1);
                    f32x4 v0 = acc[ai][bj][m][0] * g0, v1 = acc[ai][bj][m][1] * g1;
                    if (MODE == 1) { f32x4 p0, p1; unpack8(*(const u32x4*)(m1in + r * 1024 + c), p0, p1); v0 += p0; v1 += p1; }
                    *(u32x4*)(o + r * 1024 + c) = pack8(v0, v1); } }
    }
};
struct EpiOut {
    static constexpr bool PERM = true, AFTER_DRAIN = false;
    const float* x; bf16_t* y; float alpha;
    __device__ __forceinline__ void operator()(const f32x4 (&acc)[2][2][4][2], const Unit& un, int wr, int wc, int fr, int fq) const {
        const int row0 = un.pm * BM + wr * 64 + fr, col0 = un.pn * BM + wc * 32 + 8 * fq;
#pragma unroll
        for (int ai = 0; ai < 2; ++ai)
#pragma unroll
            for (int m = 0; m < 4; ++m) { const size_t off = (size_t)(row0 + ai * HALF + m * 16) * 1024 + col0;
#pragma unroll
                for (int bj = 0; bj < 2; ++bj) { const f32x4 x0 = *(const f32x4*)(x + off + bj * HALF), x1 = *(const f32x4*)(x + off + bj * HALF + 4);
                    *(u32x4*)(y + off + bj * HALF) = pack8(x0 * alpha + acc[ai][bj][m][0], x1 * alpha + acc[ai][bj][m][1]); } }
    }
};
struct MoeTab { int tileStart[33]; int cnt[32]; int pad_[3]; int tileExp[320]; };
__device__ __forceinline__ void moe_build_tab(PG8_LAS MoeTab* tab, const int* cnt) {
    if (threadIdx.x == 0) { int t = 0; for (int e = 0; e < 32; ++e) { const int c = cnt[e * 64], nt = (c + 255) >> 8; tab->tileStart[e] = t; tab->cnt[e] = c; for (int i = 0; i < nt; ++i) tab->tileExp[t + i] = e; t += nt; } tab->tileStart[32] = t; }
    __syncthreads();
}
template <bool GATHER> struct MoeOrder {
    int U, G, c; const PG8_LAS MoeTab* tab; const int* list;
    __device__ __forceinline__ bool next(int i, Unit& u) const {
        const long L = (long)i * G + c; if (L >= U) return false;
        int wgid = (int)L; { const int q = U / NXCD, r = U % NXCD, xcd = wgid % NXCD, off = wgid / NXCD; wgid = (xcd < r ? xcd * (q + 1) : r * (q + 1) + (xcd - r) * q) + off; }
        u.pm = wgid >> 2; u.pn = tab->tileExp[u.pm] * 4 + (wgid & 3); return true;
    }
    __device__ __forceinline__ void a_ready(const Unit&) const {}
    __device__ __forceinline__ void done(const Unit&) const {}
    __device__ __forceinline__ const char* a_base(const Gemm& g, const Unit& u) const { return GATHER ? (const char*)g.A : (const char*)g.A + (size_t)u.pm * (size_t)(BM * g.K * 2); }
    __device__ __forceinline__ void a_off(const Gemm& g, const Unit& u, const int (&R)[2], const int (&C)[2], unsigned (&v)[2][2]) const {
        if (!GATHER) { _Pragma("unroll") for (int hh = 0; hh < 2; ++hh) _Pragma("unroll") for (int i = 0; i < 2; ++i) v[hh][i] = (unsigned)((hh * HALF + R[i]) * g.K + C[i]) * 2u; }
        else { const int e = u.pn >> 2, base = (u.pm - tab->tileStart[e]) * BM, ce = tab->cnt[e];
            _Pragma("unroll") for (int hh = 0; hh < 2; ++hh) _Pragma("unroll") for (int i = 0; i < 2; ++i) { const int lr = base + hh * HALF + R[i]; const int tok = (lr < ce) ? (list[e * 32768 + lr] >> 1) : 0; v[hh][i] = (unsigned)(tok * g.K + C[i]) * 2u; } }
    }
};
struct EpiSwiGLU {
    static constexpr bool PERM = true, AFTER_DRAIN = false;
    bf16_t* h;
    __device__ __forceinline__ void operator()(const f32x4 (&acc)[2][2][4][2], const Unit& un, int wr, int wc, int fr, int fq) const {
        const int row0 = un.pm * BM + wr * 64 + fr, col0 = (un.pn & 3) * 128 + wc * 32 + 8 * fq;
#pragma unroll
        for (int ai = 0; ai < 2; ++ai)
#pragma unroll
            for (int m = 0; m < 4; ++m) { f32x4 v0, v1;
#pragma unroll
                for (int e = 0; e < 4; ++e) { v0[e] = fsilu(acc[ai][0][m][0][e]) * acc[ai][1][m][0][e]; v1[e] = fsilu(acc[ai][0][m][1][e]) * acc[ai][1][m][1][e]; }
                *(u32x4*)(h + (size_t)(row0 + ai * HALF + m * 16) * 512 + col0) = pack8(v0, v1); }
    }
};
struct EpiMoeOut {
    static constexpr bool PERM = true, AFTER_DRAIN = false;
    const PG8_LAS MoeTab* tab; const int* list; const float* rw; bf16_t* ys;
    __device__ __forceinline__ void operator()(const f32x4 (&acc)[2][2][4][2], const Unit& un, int wr, int wc, int fr, int fq) const {
        const int e = un.pn >> 2, lrow0 = (un.pm - tab->tileStart[e]) * BM + wr * 64 + fr, ce = tab->cnt[e], col0 = (un.pn & 3) * BM + wc * 32 + 8 * fq;
        int slot[8]; float wgt[8];
#pragma unroll
        for (int i = 0; i < 8; ++i) { const int lr = lrow0 + (i >> 2) * HALF + (i & 3) * 16; slot[i] = (lr < ce) ? list[e * 32768 + lr] : -1; }
#pragma unroll
        for (int i = 0; i < 8; ++i) wgt[i] = (slot[i] >= 0) ? rw[slot[i]] : 0.f;
#pragma unroll
        for (int ai = 0; ai < 2; ++ai)
#pragma unroll
            for (int m = 0; m < 4; ++m) { const int i = ai * 4 + m;
                if (slot[i] >= 0) { const float w = wgt[i]; bf16_t* rowp = ys + (size_t)slot[i] * 1024 + col0;
#pragma unroll
                    for (int bj = 0; bj < 2; ++bj) *(u32x4*)(rowp + bj * HALF) = pack8(acc[ai][bj][m][0] * w, acc[ai][bj][m][1] * w); } }
    }
};

__device__ __forceinline__ float clamp448(float v) { return fminf(fmaxf(v, -448.f), 448.f); }
__device__ __forceinline__ unsigned pk4_fp8(float a, float b, float c, float d) { int p = __builtin_amdgcn_cvt_pk_fp8_f32(clamp448(a), clamp448(b), 0, false); p = __builtin_amdgcn_cvt_pk_fp8_f32(clamp448(c), clamp448(d), p, true); return (unsigned)p; }
constexpr float FP8_SX = 4.f, FP8_SW = 64.f, FP8_SH = 8.f;
struct EpiSwiGLU8 {
    static constexpr bool PERM = true, AFTER_DRAIN = false;
    unsigned char* h;
    __device__ __forceinline__ void operator()(const f32x4 (&acc)[2][2][4][2], const Unit& un, int wr, int wc, int fr, int fq) const {
        const int row0 = un.pm * BM + wr * 64 + fr, col0 = (un.pn & 3) * 128 + wc * 32 + 8 * fq; const float ds = 1.f / (FP8_SX * FP8_SW);
#pragma unroll
        for (int ai = 0; ai < 2; ++ai)
#pragma unroll
            for (int m = 0; m < 4; ++m) { float v[8];
#pragma unroll
                for (int e = 0; e < 4; ++e) { v[e] = FP8_SH * fsilu(acc[ai][0][m][0][e] * ds) * (acc[ai][1][m][0][e] * ds); v[4 + e] = FP8_SH * fsilu(acc[ai][0][m][1][e] * ds) * (acc[ai][1][m][1][e] * ds); }
                uint2 o; o.x = pk4_fp8(v[0], v[1], v[2], v[3]); o.y = pk4_fp8(v[4], v[5], v[6], v[7]);
                *(uint2*)(h + (size_t)(row0 + ai * HALF + m * 16) * 512 + col0) = o; }
    }
};
struct EpiMoeOut8 {
    static constexpr bool PERM = true, AFTER_DRAIN = false;
    const PG8_LAS MoeTab* tab; const int* list; const float* rw; bf16_t* ys;
    __device__ __forceinline__ void operator()(const f32x4 (&acc)[2][2][4][2], const Unit& un, int wr, int wc, int fr, int fq) const {
        const int e = un.pn >> 2, lrow0 = (un.pm - tab->tileStart[e]) * BM + wr * 64 + fr, ce = tab->cnt[e], col0 = (un.pn & 3) * BM + wc * 32 + 8 * fq;
#pragma unroll
        for (int ai = 0; ai < 2; ++ai)
#pragma unroll
            for (int m = 0; m < 4; ++m) { const int lr = lrow0 + ai * HALF + m * 16;
                if (lr < ce) { const int slot = list[e * 32768 + lr]; const float w = rw[slot] * (1.f / (FP8_SH * FP8_SW)); bf16_t* rowp = ys + (size_t)slot * 1024 + col0;
#pragma unroll
                    for (int bj = 0; bj < 2; ++bj) *(u32x4*)(rowp + bj * HALF) = pack8(acc[ai][bj][m][0] * w, acc[ai][bj][m][1] * w); }
                asm volatile("" ::: "memory"); }
    }
};
}

DEV unsigned pk2(float lo, float hi) { return (unsigned)f2bf(lo) | ((unsigned)f2bf(hi) << 16); }
typedef unsigned v4u __attribute__((ext_vector_type(4)));
DEV void transpose_item(const float* W, int K, int N, bf16_t* WT, int row_off, float* scr, int item, int lane) {
    const int nblk = N / 32, kb = item / nblk, nb = item % nblk, k0 = 64 * kb, n0 = 32 * nb;
    float wv[32];
#pragma unroll
    for (int i = 0; i < 32; ++i) wv[i] = W[(size_t)(k0 + 2 * i + (lane >> 5)) * N + n0 + (lane & 31)];
#pragma unroll
    for (int i = 0; i < 32; ++i) scr[(2 * i + (lane >> 5)) * 33 + (lane & 31)] = wv[i];
    asm volatile("s_waitcnt lgkmcnt(0)" ::: "memory");
    const int c = lane & 7;
#pragma unroll
    for (int j = 0; j < 4; ++j) { const int n = (lane >> 3) + 8 * j; const float* s = scr + (8 * c) * 33 + n;
        v4u o; o.x = pk2(s[0 * 33], s[1 * 33]); o.y = pk2(s[2 * 33], s[3 * 33]); o.z = pk2(s[4 * 33], s[5 * 33]); o.w = pk2(s[6 * 33], s[7 * 33]);
        *(v4u*)(WT + (size_t)(row_off + n0 + n) * K + k0 + 8 * c) = o; }
    asm volatile("s_waitcnt lgkmcnt(0)" ::: "memory");
}
DEV void p_weights(float* lds, const float* w_in, const float* w_ret_o, const float* w_lru_o, const float* w_out, const float* w_rg_r, const float* w_rg_i, bf16_t* w_in_t, bf16_t* w_ro_t, bf16_t* w_lo_t, bf16_t* w_out_t, bf16_t* wrg_t) {
    const int wave = threadIdx.x >> 6, lane = threadIdx.x & 63;
    float* scr = lds + wave * 2304;
    constexpr int I0 = 16 * (WIN_N / 32), I1 = 32 * 32, I2 = 24 * 32, I3 = 16 * 32, I4 = 16 * 18;
    for (int it = blockIdx.x * 8 + wave; it < I0 + I1 + I2 + I3 + I4; it += gridDim.x * 8) {
        int r = it;
        if (r < I0) { transpose_item(w_in, 1024, WIN_N, w_in_t, 0, scr, r, lane); continue; } r -= I0;
        if (r < I1) { transpose_item(w_ret_o, 2048, 1024, w_ro_t, 0, scr, r, lane); continue; } r -= I1;
        if (r < I2) { transpose_item(w_lru_o, 1536, 1024, w_lo_t, 0, scr, r, lane); continue; } r -= I2;
        if (r < I3) { transpose_item(w_out, 1024, 1024, w_out_t, 0, scr, r, lane); continue; } r -= I3;
        { const int mi = r / 18, sub = r - mi * 18; const float* W = (mi < 8 ? w_rg_r + (size_t)mi * 192 * 192 : w_rg_i + (size_t)(mi - 8) * 192 * 192);
          transpose_item(W, 192, 192, wrg_t + (size_t)mi * 192 * 192, 0, scr, sub, lane); }
    }
}


DEV void transpose_item_fp8(const float* W, int K, int N, unsigned char* WT, int row_off, float scale, float* scr, int item, int lane) {
    const int nblk = N / 32, kb = item / nblk, nb = item % nblk, k0 = 64 * kb, n0 = 32 * nb;
    float wv[32];
#pragma unroll
    for (int i = 0; i < 32; ++i) wv[i] = W[(size_t)(k0 + 2 * i + (lane >> 5)) * N + n0 + (lane & 31)];
#pragma unroll
    for (int i = 0; i < 32; ++i) scr[(2 * i + (lane >> 5)) * 33 + (lane & 31)] = wv[i] * scale;
    asm volatile("s_waitcnt lgkmcnt(0)" ::: "memory");
    const int c = lane & 3;
#pragma unroll
    for (int j = 0; j < 2; ++j) { const int n = (lane >> 2) + 16 * j; const float* s = scr + (16 * c) * 33 + n;
        v4u o; o.x = pg8::pk4_fp8(s[0 * 33], s[1 * 33], s[2 * 33], s[3 * 33]); o.y = pg8::pk4_fp8(s[4 * 33], s[5 * 33], s[6 * 33], s[7 * 33]);
        o.z = pg8::pk4_fp8(s[8 * 33], s[9 * 33], s[10 * 33], s[11 * 33]); o.w = pg8::pk4_fp8(s[12 * 33], s[13 * 33], s[14 * 33], s[15 * 33]);
        *(v4u*)(WT + (size_t)(row_off + n0 + n) * K + k0 + 16 * c) = o; }
    asm volatile("s_waitcnt lgkmcnt(0)" ::: "memory");
}
DEV void p_expert_weights(float* lds, const float* w_eg, const float* w_eu, const float* w_ed, unsigned char* wgu8, unsigned char* wd8) {
    const int wave = threadIdx.x >> 6, lane = threadIdx.x & 63;
    float* scr = lds + wave * 2304;
    for (int it = blockIdx.x * 8 + wave; it < 3 * 8192; it += gridDim.x * 8) {
        const int kind = it >> 13, r = it & 8191, e = r >> 8, sub = r & 255;
        if (kind < 2) { const int nb = sub & 15; transpose_item_fp8((kind ? w_eu : w_eg) + (size_t)e * 1024 * 512, 1024, 512, wgu8 + (size_t)e * 1024 * 1024, (nb >> 2) * 128 + kind * 128, pg8::FP8_SW, scr, sub, lane); }
        else transpose_item_fp8(w_ed + (size_t)e * 512 * 1024, 512, 1024, wd8 + (size_t)e * 1024 * 512, 0, pg8::FP8_SW, scr, sub, lane);
    }
}

DEV void p_router_consts(float* lds, const float* g1, const float* b1, const float* wg, const float* bg, const float* we, const float* be, float* sb) {
    if (blockIdx.x != 0) return;
    const int t = threadIdx.x, wv = t >> 6, lane = t & 63;
    float s[36], q[36];
#pragma unroll
    for (int c = 0; c < 36; ++c) { s[c] = 0.f; q[c] = 0.f; }
#pragma unroll
    for (int kk = 0; kk < 2; ++kk) { const int k = t + 512 * kk; const float gk = g1[k], bk = b1[k];
#pragma unroll
        for (int c4 = 0; c4 < 9; ++c4) { const float4 w = (c4 < 8) ? *(const float4*)(we + (size_t)k * 32 + c4 * 4) : *(const float4*)(wg + (size_t)k * 4);
            s[4 * c4] += gk * w.x; s[4 * c4 + 1] += gk * w.y; s[4 * c4 + 2] += gk * w.z; s[4 * c4 + 3] += gk * w.w;
            q[4 * c4] += bk * w.x; q[4 * c4 + 1] += bk * w.y; q[4 * c4 + 2] += bk * w.z; q[4 * c4 + 3] += bk * w.w; } }
#pragma unroll
    for (int m = 1; m < 64; m <<= 1) {
#pragma unroll
        for (int c = 0; c < 36; ++c) { s[c] += __shfl_xor(s[c], m); q[c] += __shfl_xor(q[c], m); } }
    if (lane == 0) {
#pragma unroll
        for (int c = 0; c < 36; ++c) { lds[wv * 96 + c] = s[c]; lds[wv * 96 + 48 + c] = q[c]; } }
    __syncthreads();
    if (t < 96) { const int cc = t % 48; float v = 0.f;
        if (cc < 36) { for (int p = 0; p < 8; ++p) v += lds[p * 96 + t]; if (t >= 48) v += (cc < 32) ? be[cc] : bg[cc - 32]; }
        sb[t] = v; }
    __syncthreads();
}
DEV void p_cvt_x(const float* x, bf16_t* xb) {
    const size_t n4 = (size_t)NTOK * DM / 4, stride = (size_t)gridDim.x * NTHR;
    for (size_t i0 = (size_t)blockIdx.x * NTHR + threadIdx.x; i0 < n4; i0 += 8 * stride) {
        float4 t[8];
#pragma unroll
        for (int u = 0; u < 8; ++u) { const size_t i = i0 + u * stride; t[u] = (i < n4) ? ((const float4*)x)[i] : make_float4(0.f, 0.f, 0.f, 0.f); }
#pragma unroll
        for (int u = 0; u < 8; ++u) { const size_t i = i0 + u * stride; if (i < n4) { uint2 o; o.x = pg8::cvt_pk_bf16(t[u].x, t[u].y); o.y = pg8::cvt_pk_bf16(t[u].z, t[u].w); ((uint2*)xb)[i] = o; } }
    }
}
DEV void p_rope_table(float2* tab) {
    for (int i = blockIdx.x * NTHR + threadIdx.x; i < 8192 * 128; i += gridDim.x * NTHR) {
        const int s = i >> 7, j = i & 127;
        const double r = 0.93057204092969897;
        double inv = 1.0; for (int t = 0; t < j; ++t) inv *= r;
        const double ang = (double)s * inv;
        const double twopi_hi = 6.283185307179586232, twopi_lo = 2.4492935982947064e-16;
        const double n = rint(ang / twopi_hi);
        const double x = (ang - n * twopi_hi) - n * twopi_lo;
        const double x2 = x * x;
        double acc = 1.0 - x2 * (1.0 / (22.0 * 23.0));
#pragma unroll
        for (int k = 21; k >= 3; k -= 2) acc = 1.0 - x2 * (1.0 / ((double)(k - 1) * (double)k)) * acc;
        double acc2 = 1.0 - x2 * (1.0 / (21.0 * 22.0));
#pragma unroll
        for (int k = 20; k >= 2; k -= 2) acc2 = 1.0 - x2 * (1.0 / ((double)(k - 1) * (double)k)) * acc2;
        tab[i] = make_float2((float)acc2, (float)(x * acc));
    }
}

typedef short bf16x8_t __attribute__((ext_vector_type(8)));
typedef float f32x4_t __attribute__((ext_vector_type(4)));
typedef short s16x4_t __attribute__((ext_vector_type(4)));
typedef unsigned u32x4_t __attribute__((ext_vector_type(4)));
constexpr int LRU_ROWB = 400;
DEV void p_lru_compute(unsigned char* lds, const bf16_t* ulru, const float* cw, const float* cb, const bf16_t* wrg_t,
                       const float* b_r, const float* b_i, const float* lam, bf16_t* epsb, bf16_t* xinb, float* segA, float* segH) {
    int tid_ = threadIdx.x; asm volatile("" : "+v"(tid_));
    const int tid = tid_, wave = tid >> 6, lane = tid & 63, fr = lane & 15, fq = lane >> 4, wr = wave >> 2, wc = wave & 3;
    unsigned char* stg = lds + 256 * LRU_ROWB + wave * 4096;
    for (int item = blockIdx.x; item < 1024; item += gridDim.x) {
        const int n = item & 7, b = (item >> 3) & 3, seg = item >> 5;
        const size_t t0 = (size_t)b * SEQ + seg * 256;
#pragma unroll 4
        for (int idx = tid; idx < 256 * 24; idx += NTHR) {
            const int r = idx / 24, c8 = idx - r * 24, ch0 = n * 192 + c8 * 8;
            float acc[8];
            { const float4 c0 = *(const float4*)(cb + ch0), c1 = *(const float4*)(cb + ch0 + 4); acc[0] = c0.x; acc[1] = c0.y; acc[2] = c0.z; acc[3] = c0.w; acc[4] = c1.x; acc[5] = c1.y; acc[6] = c1.z; acc[7] = c1.w; }
#pragma unroll
            for (int j = 0; j < 4; ++j) {
                if (seg * 256 + r - 3 + j >= 0) {
                    const uint4 uv = *(const uint4*)(ulru + (t0 + r - 3 + j) * 1536 + ch0);
                    const float4 w0 = *(const float4*)(cw + j * 1536 + ch0), w1 = *(const float4*)(cw + j * 1536 + ch0 + 4);
                    acc[0] += w0.x * __uint_as_float(uv.x << 16); acc[1] += w0.y * __uint_as_float(uv.x & 0xffff0000u);
                    acc[2] += w0.z * __uint_as_float(uv.y << 16); acc[3] += w0.w * __uint_as_float(uv.y & 0xffff0000u);
                    acc[4] += w1.x * __uint_as_float(uv.z << 16); acc[5] += w1.y * __uint_as_float(uv.z & 0xffff0000u);
                    acc[6] += w1.z * __uint_as_float(uv.w << 16); acc[7] += w1.w * __uint_as_float(uv.w & 0xffff0000u);
                }
            }
            uint4 o; o.x = pg8::cvt_pk_bf16(acc[0], acc[1]); o.y = pg8::cvt_pk_bf16(acc[2], acc[3]); o.z = pg8::cvt_pk_bf16(acc[4], acc[5]); o.w = pg8::cvt_pk_bf16(acc[6], acc[7]);
            *(uint4*)(lds + r * LRU_ROWB + c8 * 16) = o;
        }
        __syncthreads();
        float cbr[3], cbi[3], csp[3], hrun[3], atot[3];
        const int sub = seg * 2 + wr;
#pragma unroll
        for (int tc = 0; tc < 3; ++tc) { const int ch = n * 192 + 48 * wc + 16 * tc + fr; cbr[tc] = b_r[ch]; cbi[tc] = b_i[ch]; csp[tc] = 8.f * 1.4426950408889634f * log1pf(__expf(-lam[ch])); atot[tc] = 1.f; hrun[tc] = 0.f; }
        const bf16_t* wrb = wrg_t + ((size_t)n * 192 + 48 * wc + fr) * 192 + fq * 8;
        const bf16_t* wib = wrb + (size_t)8 * 192 * 192;
#pragma unroll
        for (int tc = 0; tc < 3; ++tc) {
            bf16x8_t bfr[6][2];
#pragma unroll
            for (int ks = 0; ks < 6; ++ks) { bfr[ks][0] = *(const bf16x8_t*)(wrb + tc * 16 * 192 + ks * 32); bfr[ks][1] = *(const bf16x8_t*)(wib + tc * 16 * 192 + ks * 32); }
#pragma unroll
            for (int p = 0; p < 2; ++p) {
                const int rowb = 128 * wr + 64 * p;
                f32x4_t acc[4][2];
#pragma unroll
                for (int m = 0; m < 4; ++m) { acc[m][0] = (f32x4_t){0.f, 0.f, 0.f, 0.f}; acc[m][1] = (f32x4_t){0.f, 0.f, 0.f, 0.f}; }
#pragma unroll
                for (int ks = 0; ks < 6; ++ks) {
                    bf16x8_t afr[4];
#pragma unroll
                    for (int m = 0; m < 4; ++m) afr[m] = *(const bf16x8_t*)(lds + (rowb + 16 * (fr >> 2) + 4 * m + (fr & 3)) * LRU_ROWB + ks * 64 + fq * 16);
#pragma unroll
                    for (int m = 0; m < 4; ++m) { acc[m][0] = __builtin_amdgcn_mfma_f32_16x16x32_bf16(afr[m], bfr[ks][0], acc[m][0], 0, 0, 0); acc[m][1] = __builtin_amdgcn_mfma_f32_16x16x32_bf16(afr[m], bfr[ks][1], acc[m][1], 0, 0, 0); }
                }
                const int coff = (48 * wc + 16 * tc + fr) * 2;
                const unsigned char* up = lds + (rowb + 16 * fq) * LRU_ROWB + coff;
                float Al = 1.f, Bl = 0.f;
                unsigned pe[8], px[8];
#pragma unroll
                for (int m = 0; m < 4; ++m) {
                    float ee[4], xx[4];
#pragma unroll
                    for (int j = 0; j < 4; ++j) {
                        const float rr = pg8::fsig(acc[m][0][j] + cbr[tc]), ii = pg8::fsig(acc[m][1][j] + cbi[tc]);
                        const float aa = __builtin_amdgcn_exp2f(-csp[tc] * rr);
                        const float u = bf2f(*(const bf16_t*)(up + (4 * m + j) * LRU_ROWB));
                        const float om = 1.f - aa;
                        const float x = __builtin_amdgcn_sqrtf(fmaxf(om * (1.f + aa), 0.f)) * ii * u;
                        ee[j] = om; xx[j] = x; Bl = aa * Bl + x; Al *= aa;
                    }
                    pe[2 * m] = pg8::cvt_pk_bf16(ee[0], ee[1]); pe[2 * m + 1] = pg8::cvt_pk_bf16(ee[2], ee[3]);
                    px[2 * m] = pg8::cvt_pk_bf16(xx[0], xx[1]); px[2 * m + 1] = pg8::cvt_pk_bf16(xx[2], xx[3]);
                }
                { float h = hrun[tc], ap = 1.f;
#pragma unroll
                  for (int q = 0; q < 4; ++q) { const float Aq = __shfl(Al, fr + 16 * q), Bq = __shfl(Bl, fr + 16 * q); h = Aq * h + Bq; ap *= Aq; }
                  hrun[tc] = h; atot[tc] *= ap; }
#pragma unroll
                for (int m = 0; m < 4; ++m)
#pragma unroll
                    for (int j = 0; j < 4; ++j) { const int tk = 16 * fq + 4 * m + j; const unsigned we = pe[2 * m + (j >> 1)], wx = px[2 * m + (j >> 1)];
                        *(bf16_t*)(stg + tk * 32 + fr * 2) = (bf16_t)((j & 1) ? (we >> 16) : (we & 0xffff));
                        *(bf16_t*)(stg + 2048 + tk * 32 + fr * 2) = (bf16_t)((j & 1) ? (wx >> 16) : (wx & 0xffff)); }
                asm volatile("s_waitcnt lgkmcnt(0)" ::: "memory");
#pragma unroll
                for (int i = 0; i < 2; ++i) { const int piece = lane + 64 * i, tk = piece >> 1, hf = piece & 1;
                    const size_t go = (t0 + rowb + tk) * 1536 + n * 192 + 48 * wc + 16 * tc + 8 * hf;
                    *(u32x4_t*)(epsb + go) = *(const u32x4_t*)(stg + tk * 32 + hf * 16);
                    *(u32x4_t*)(xinb + go) = *(const u32x4_t*)(stg + 2048 + tk * 32 + hf * 16); }
                asm volatile("s_waitcnt lgkmcnt(0)" ::: "memory");
            }
        }
        if (fq == 0) {
#pragma unroll
            for (int tc = 0; tc < 3; ++tc) { const size_t o = ((size_t)b * 64 + sub) * 1536 + n * 192 + 48 * wc + 16 * tc + fr; segA[o] = atot[tc]; segH[o] = hrun[tc]; }
        }
        __syncthreads();
    }
}
DEV void p_lru_scan(const bf16_t* epsb, const bf16_t* xinb, bf16_t* gl, const float* carry) {
    const int tid = threadIdx.x;
    if (tid >= 384) return;
    for (int item = blockIdx.x; item < 256; item += gridDim.x) {
        const int b = item >> 6, sub = item & 63;
        const size_t base = ((size_t)b * SEQ + sub * 128) * 1536 + tid * 4;
        const float4 cin = *(const float4*)(carry + ((size_t)b * 64 + sub) * 1536 + tid * 4);
        float h0 = cin.x, h1 = cin.y, h2 = cin.z, h3 = cin.w;
#pragma unroll 8
        for (int t = 0; t < 128; ++t) {
            const size_t o = base + (size_t)t * 1536;
            const uint2 ev = *(const uint2*)(epsb + o), xv = *(const uint2*)(xinb + o), gv = *(const uint2*)(gl + o);
            h0 = (1.f - __uint_as_float(ev.x << 16)) * h0 + __uint_as_float(xv.x << 16);
            h1 = (1.f - __uint_as_float(ev.x & 0xffff0000u)) * h1 + __uint_as_float(xv.x & 0xffff0000u);
            h2 = (1.f - __uint_as_float(ev.y << 16)) * h2 + __uint_as_float(xv.y << 16);
            h3 = (1.f - __uint_as_float(ev.y & 0xffff0000u)) * h3 + __uint_as_float(xv.y & 0xffff0000u);
            uint2 ov; ov.x = pg8::cvt_pk_bf16(h0 * __uint_as_float(gv.x << 16), h1 * __uint_as_float(gv.x & 0xffff0000u)); ov.y = pg8::cvt_pk_bf16(h2 * __uint_as_float(gv.y << 16), h3 * __uint_as_float(gv.y & 0xffff0000u));
            *(uint2*)(gl + o) = ov;
        }
    }
}
DEV void p_lru_carry(float* lds, const float* segA, const float* segH, float* carry) {
    float* tA = lds; float* tH = lds + 64 * 65;
    for (int item = blockIdx.x; item < 96; item += gridDim.x) {
        const int b = item / 24, c0 = (item % 24) * 64;
        for (int i = threadIdx.x; i < 64 * 64; i += NTHR) { const int s = i >> 6, c = i & 63; const size_t o = ((size_t)b * 64 + s) * 1536 + c0 + c; tA[s * 65 + c] = segA[o]; tH[s * 65 + c] = segH[o]; }
        __syncthreads();
        if (threadIdx.x < 64) { const int c = threadIdx.x; float h = 0.f;
            for (int s = 0; s < 64; ++s) { const float a = tA[s * 65 + c], hh = tH[s * 65 + c]; tA[s * 65 + c] = h; h = a * h + hh; } }
        __syncthreads();
        for (int i = threadIdx.x; i < 64 * 64; i += NTHR) { const int s = i >> 6, c = i & 63; carry[((size_t)b * 64 + s) * 1536 + c0 + c] = tA[s * 65 + c]; }
        __syncthreads();
    }
}
#define LDS_BARRIER() do { asm volatile("s_waitcnt lgkmcnt(0)" ::: "memory"); __builtin_amdgcn_s_barrier(); asm volatile("" ::: "memory"); } while (0)
DEV void p_scores(unsigned char* lds, const bf16_t* q, const bf16_t* k, bf16_t* P) {
    int tid_ = threadIdx.x; asm volatile("" : "+v"(tid_));
    const int tid = tid_, w = tid >> 6, lane = tid & 63, fr = lane & 15, fq = lane >> 4;
    const int krow = tid >> 5, kch = tid & 31;
    u32x4_t kreg[8]; bf16x8_t qa[8];
    int g = blockIdx.x;
    if (g < 1024) { const int c = g & 63, bh = g >> 6, b = bh >> 2, h = bh & 3; const size_t tok0 = (size_t)b * SEQ + c * 128;
        const bf16_t* kc = k + tok0 * 1024 + h * 256;
#pragma unroll
        for (int ii = 0; ii < 8; ++ii) kreg[ii] = *(const u32x4_t*)(kc + (size_t)(krow + 16 * ii) * 1024 + kch * 8);
        const bf16_t* qp = q + ((tok0 >> 7) * 4 + h) * 32768 + (fq * 128 + 16 * w + fr) * 8;
#pragma unroll
        for (int ks = 0; ks < 8; ++ks) qa[ks] = *(const bf16x8_t*)(qp + ks * 4096); }
    for (; g < 1024; g += gridDim.x) {
#pragma unroll
        for (int ii = 0; ii < 8; ++ii) *(u32x4_t*)(lds + (krow + 16 * ii) * 528 + kch * 16) = kreg[ii];
        bf16x8_t qc[8];
#pragma unroll
        for (int ks = 0; ks < 8; ++ks) qc[ks] = qa[ks];
        const int gn = g + gridDim.x;
        if (gn < 1024) { const int c = gn & 63, bh = gn >> 6, b = bh >> 2, h = bh & 3; const size_t tok0 = (size_t)b * SEQ + c * 128;
            const bf16_t* kc = k + tok0 * 1024 + h * 256;
#pragma unroll
            for (int ii = 0; ii < 8; ++ii) kreg[ii] = *(const u32x4_t*)(kc + (size_t)(krow + 16 * ii) * 1024 + kch * 8);
            const bf16_t* qp = q + ((tok0 >> 7) * 4 + h) * 32768 + (fq * 128 + 16 * w + fr) * 8;
#pragma unroll
            for (int ks = 0; ks < 8; ++ks) qa[ks] = *(const bf16x8_t*)(qp + ks * 4096); }
        LDS_BARRIER();
        f32x4_t acc[8];
#pragma unroll
        for (int nt = 0; nt < 8; ++nt) acc[nt] = (f32x4_t){0.f, 0.f, 0.f, 0.f};
#pragma unroll
        for (int ks = 0; ks < 8; ++ks)
#pragma unroll
            for (int nt = 0; nt < 8; ++nt) { const bf16x8_t bb = *(const bf16x8_t*)(lds + (16 * nt + fr) * 528 + ks * 64 + fq * 16); acc[nt] = __builtin_amdgcn_mfma_f32_16x16x32_bf16(bb, qc[ks], acc[nt], 0, 0, 0); }
        {
            const int c = g & 63, bh = g >> 6, b = bh >> 2, h = bh & 3;
            bf16_t* kt = const_cast<bf16_t*>(k) + ((size_t)b * SEQ + c * 128 + fq * 8 + w) * 1024 + h * 256 + fr * 8;
#pragma unroll
            for (int ks = 0; ks < 4; ++ks)
#pragma unroll
                for (int di = 0; di < 2; ++di) {
                    const unsigned char* kp = lds + (32 * ks + 8 * fq + (fr >> 2)) * 528 + (16 * (2 * w + di) + 4 * (fr & 3)) * 2;
                    const s16x4_t t0 = __builtin_amdgcn_ds_read_tr16_b64_v4i16((LAS s16x4_t*)(kp));
                    const s16x4_t t1 = __builtin_amdgcn_ds_read_tr16_b64_v4i16((LAS s16x4_t*)(kp + 4 * 528));
                    *(bf16x8_t*)(kt + ks * 32768 + di * 128) = (bf16x8_t){t0[0], t0[1], t0[2], t0[3], t1[0], t1[1], t1[2], t1[3]};
                }
        }
        LDS_BARRIER();
        bf16_t* Pg = P + (size_t)g * 16384 + ((fq >> 1) * 128 + 16 * w + fr) * 8 + 4 * (fq & 1);
        int mrow = 16 * w + fr - 4 * fq; asm volatile("" : "+v"(mrow));
#pragma unroll
        for (int nt = 0; nt < 8; ++nt) {
            uint2 o; o.x = pg8::cvt_pk_bf16((16 * nt <= mrow) ? acc[nt][0] : 0.f, (16 * nt + 1 <= mrow) ? acc[nt][1] : 0.f);
            o.y = pg8::cvt_pk_bf16((16 * nt + 2 <= mrow) ? acc[nt][2] : 0.f, (16 * nt + 3 <= mrow) ? acc[nt][3] : 0.f);
            *(uint2*)(Pg + ((nt >> 1) * 4 + 2 * (nt & 1)) * 1024) = o; }
    }
    __syncthreads();
}
constexpr int RT_KS = 528, RT_VS = 272, RT_V = 0, RT_U = 2 * 32 * RT_VS;
DEV void p_ret_mfma(unsigned char* lds, const bf16_t* q, const bf16_t* k, bf16_t* v, const bf16_t* P) {
    int tid_ = threadIdx.x; asm volatile("" : "+v"(tid_));
    const int tid = tid_, w = tid >> 6, lane = tid & 63, fr = lane & 15, fq = lane >> 4;
    for (int wk = blockIdx.x; wk < 256; wk += gridDim.x) {
        const int xcd = wk & 7, idx = wk >> 3, bh = xcd * 2 + (idx >> 4), sl = idx & 15, b = bh >> 2, h = bh & 3;
        float g128; { const double gam = 1.0 - exp2(-5.0 - (double)h); g128 = (float)exp2(128.0 * log2(gam)); }
        asm volatile("" : "+v"(g128));
        f32x4_t accU[2][2];
#pragma unroll
        for (int et = 0; et < 2; ++et)
#pragma unroll
            for (int di = 0; di < 2; ++di) accU[et][di] = (f32x4_t){0.f, 0.f, 0.f, 0.f};
        for (int i = tid; i < 32 * RT_KS / 4; i += NTHR) ((unsigned*)(lds + RT_U))[i] = 0u;
        const size_t tokb = (size_t)b * SEQ;
        const int vm = tid >> 2, ve = (tid & 3) * 8;
        const bf16_t* vsl = v + tokb * 2048 + h * 512 + sl * 32;
#define RT_STAGE_V(buf, vr) do { unsigned char* vp_ = lds + RT_V + (buf) * 32 * RT_VS + ve * RT_VS + vm * 2; \
            *(bf16_t*)(vp_ + 0 * RT_VS) = (bf16_t)((vr)[0] & 0xffff); *(bf16_t*)(vp_ + 1 * RT_VS) = (bf16_t)((vr)[0] >> 16); \
            *(bf16_t*)(vp_ + 2 * RT_VS) = (bf16_t)((vr)[1] & 0xffff); *(bf16_t*)(vp_ + 3 * RT_VS) = (bf16_t)((vr)[1] >> 16); \
            *(bf16_t*)(vp_ + 4 * RT_VS) = (bf16_t)((vr)[2] & 0xffff); *(bf16_t*)(vp_ + 5 * RT_VS) = (bf16_t)((vr)[2] >> 16); \
            *(bf16_t*)(vp_ + 6 * RT_VS) = (bf16_t)((vr)[3] & 0xffff); *(bf16_t*)(vp_ + 7 * RT_VS) = (bf16_t)((vr)[3] >> 16); } while (0)
        u32x4_t vreg = *(const u32x4_t*)(vsl + (size_t)vm * 2048 + ve);
        RT_STAGE_V(0, vreg);
        vreg = *(const u32x4_t*)(vsl + (size_t)(128 + vm) * 2048 + ve);
        bf16x8_t qa[8], pa[4], kb[2][4];
        const bf16_t* qp = q + ((tokb >> 7) * 4 + h) * 32768 + (fq * 128 + 16 * w + fr) * 8;
        const bf16_t* pp = P + (size_t)(bh * 64) * 16384 + (fq * 128 + 16 * w + fr) * 8;
        const bf16_t* kp = k + (tokb + fq * 8 + w) * 1024 + h * 256 + fr * 8;
        {
#pragma unroll
            for (int ks = 0; ks < 8; ++ks) qa[ks] = *(const bf16x8_t*)(qp + ks * 4096);
#pragma unroll
            for (int ks = 0; ks < 4; ++ks) pa[ks] = *(const bf16x8_t*)(pp + ks * 4096);
#pragma unroll
            for (int di = 0; di < 2; ++di)
#pragma unroll
                for (int ks = 0; ks < 4; ++ks) kb[di][ks] = *(const bf16x8_t*)(kp + ks * 32768 + di * 128);
        }
        LDS_BARRIER();
#pragma unroll 1
        for (int c = 0; c < 64; ++c) {
            const size_t tok0 = tokb + c * 128;
            const unsigned char* ldsU = lds + RT_U + (c & 1) * 32 * RT_KS;
            const unsigned char* ldsV = lds + RT_V + (c & 1) * 32 * RT_VS;
            f32x4_t ao[2] = {(f32x4_t){0.f, 0.f, 0.f, 0.f}, (f32x4_t){0.f, 0.f, 0.f, 0.f}};
            {
                bf16x8_t bu[8];
#pragma unroll
                for (int nt = 0; nt < 2; ++nt) {
#pragma unroll
                    for (int ks = 0; ks < 8; ++ks) bu[ks] = *(const bf16x8_t*)(ldsU + (16 * nt + fr) * RT_KS + ks * 64 + fq * 16);
#pragma unroll
                    for (int ks = 0; ks < 8; ++ks) ao[nt] = __builtin_amdgcn_mfma_f32_16x16x32_bf16(qa[ks], bu[ks], ao[nt], 0, 0, 0);
                }
            }
            bf16x8_t bv[2][4];
#pragma unroll
            for (int nt = 0; nt < 2; ++nt)
#pragma unroll
                for (int ks = 0; ks < 4; ++ks) bv[nt][ks] = *(const bf16x8_t*)(ldsV + (16 * nt + fr) * RT_VS + ks * 64 + fq * 16);
#pragma unroll
            for (int ks = 0; ks < 4; ++ks)
#pragma unroll
                for (int nt = 0; nt < 2; ++nt) ao[nt] = __builtin_amdgcn_mfma_f32_16x16x32_bf16(pa[ks], bv[nt][ks], ao[nt], 0, 0, 0);
            if (c + 1 < 64) {
                const bf16_t* qn = qp + (size_t)(c + 1) * 131072;
#pragma unroll
                for (int ks = 0; ks < 8; ++ks) qa[ks] = *(const bf16x8_t*)(qn + ks * 4096);
                const bf16_t* pn = pp + (size_t)(c + 1) * 16384;
#pragma unroll
                for (int ks = 0; ks < 4; ++ks) pa[ks] = *(const bf16x8_t*)(pn + ks * 4096);
            }
            {
                bf16_t* vc = v + (tok0 + 16 * w + 4 * fq) * 2048 + h * 512 + sl * 32 + fr;
#pragma unroll
                for (int nt = 0; nt < 2; ++nt)
#pragma unroll
                    for (int j = 0; j < 4; ++j) vc[(size_t)j * 2048 + 16 * nt] = f2bf(ao[nt][j]);
            }
#pragma unroll
            for (int ks = 0; ks < 4; ++ks)
#pragma unroll
                for (int di = 0; di < 2; ++di)
#pragma unroll
                    for (int et = 0; et < 2; ++et) accU[et][di] = __builtin_amdgcn_mfma_f32_16x16x32_bf16(bv[et][ks], kb[di][ks], accU[et][di], 0, 0, 0);
            if (c + 1 < 64) {
                const bf16_t* kn = kp + (size_t)(c + 1) * 131072;
#pragma unroll
                for (int di = 0; di < 2; ++di)
#pragma unroll
                    for (int ks = 0; ks < 4; ++ks) kb[di][ks] = *(const bf16x8_t*)(kn + ks * 32768 + di * 128);
            }
#pragma unroll
            for (int et = 0; et < 2; ++et)
#pragma unroll
                for (int di = 0; di < 2; ++di) accU[et][di] = accU[et][di] * g128;
            {
                unsigned char* un = lds + RT_U + ((c + 1) & 1) * 32 * RT_KS;
#pragma unroll
                for (int et = 0; et < 2; ++et)
#pragma unroll
                    for (int di = 0; di < 2; ++di)
#pragma unroll
                        for (int j = 0; j < 4; ++j) *(bf16_t*)(un + (16 * et + 4 * fq + j) * RT_KS + (16 * (2 * w + di) + fr) * 2) = f2bf(accU[et][di][j]);
                if (c + 1 < 64) { RT_STAGE_V((c + 1) & 1, vreg); }
                if (c + 2 < 64) vreg = *(const u32x4_t*)(vsl + (size_t)((c + 2) * 128 + vm) * 2048 + ve);
            }
            LDS_BARRIER();
        }
#undef RT_STAGE_V
        __syncthreads();
    }
}
DEV void p_headnorm(bf16_t* ret, const bf16_t* g) {
    const int lane = threadIdx.x & 63;
    for (int w = (blockIdx.x * NTHR + threadIdx.x) >> 6; w < NTOK * 4; w += gridDim.x * (NTHR / 64)) {
        const size_t o = (size_t)w * 512 + lane * 8;
        const u32x4_t rv = *(const u32x4_t*)(ret + o), gv = *(const u32x4_t*)(g + o);
        float x[8], gg[8]; float s = 0.f;
#pragma unroll
        for (int j = 0; j < 4; ++j) { x[2 * j] = __uint_as_float(rv[j] << 16); x[2 * j + 1] = __uint_as_float(rv[j] & 0xffff0000u); gg[2 * j] = __uint_as_float(gv[j] << 16); gg[2 * j + 1] = __uint_as_float(gv[j] & 0xffff0000u); }
#pragma unroll
        for (int j = 0; j < 8; ++j) s += x[j];
#pragma unroll
        for (int m = 1; m < 64; m <<= 1) s += __shfl_xor(s, m);
        const float mu = s * (1.f / 512.f); float q = 0.f;
#pragma unroll
        for (int j = 0; j < 8; ++j) { x[j] -= mu; q += x[j] * x[j]; }
#pragma unroll
        for (int m = 1; m < 64; m <<= 1) q += __shfl_xor(q, m);
        const float rstd = rsqrtf(q * (1.f / 512.f) + LN_EPS);
        u32x4_t ov;
#pragma unroll
        for (int j = 0; j < 4; ++j) ov[j] = pg8::cvt_pk_bf16(x[2 * j] * rstd * gg[2 * j], x[2 * j + 1] * rstd * gg[2 * j + 1]);
        *(u32x4_t*)(ret + o) = ov;
    }
}

typedef float f32x4v __attribute__((ext_vector_type(4)));
DEV void p_ln1_route(float* lds, const bf16_t* y, bf16_t* x1b, unsigned char* x1q, const float* g1, const float* b1, const float* wg, const float* bg,
                     const float* we, const float* be, int2* route_e, float2* route_w, int* cnt, int* list, const float* sb) {
    const int wv = threadIdx.x >> 6, lane = threadIdx.x & 63, r16 = lane & 15, kq = lane >> 4;
    float* Wp = lds;
    float* Sc = lds + 1024 * 36;
    float* Bc = Sc + 48;
    int* lcnt = (int*)(Bc + 48);
    int* rowE = lcnt + 32;
    int* rowP = rowE + 256;
    for (int i = threadIdx.x; i < 1024 * 9; i += NTHR) { const int k = i / 9, c4 = i - k * 9; const float gk = g1[k];
        float4 w = (c4 < 8) ? *(const float4*)(we + (size_t)k * 32 + c4 * 4) : *(const float4*)(wg + (size_t)k * 4);
        w.x *= gk; w.y *= gk; w.z *= gk; w.w *= gk; *(float4*)(Wp + k * 36 + c4 * 4) = w; }
    if (threadIdx.x < 32) lcnt[threadIdx.x] = 0;
    __syncthreads();
    if (threadIdx.x < 96) Sc[threadIdx.x] = sb[threadIdx.x];
    __syncthreads();
    constexpr int rows_per_wg = 128;
    for (int blk = blockIdx.x; blk < NTOK / rows_per_wg; blk += gridDim.x) {
    { const int tile = wv;
        const int lrow0 = tile * 16, row0 = blk * rows_per_wg + lrow0;
        const bf16_t* yp = y + (size_t)(row0 + r16) * 1024 + 4 * kq;
        f32x4v acc[3] = {(f32x4v){0.f, 0.f, 0.f, 0.f}, (f32x4v){0.f, 0.f, 0.f, 0.f}, (f32x4v){0.f, 0.f, 0.f, 0.f}};
        float s1 = 0.f, s2 = 0.f; const float m2 = (r16 < 4) ? 1.f : 0.f;
#pragma unroll 8
        for (int t = 0; t < 64; ++t) {
            const uint2 yr = *(const uint2*)(yp + 16 * t); const float4 yv = make_float4(__uint_as_float(yr.x << 16), __uint_as_float(yr.x & 0xffff0000u), __uint_as_float(yr.y << 16), __uint_as_float(yr.y & 0xffff0000u));
            s1 += (yv.x + yv.y) + (yv.z + yv.w); s2 += (yv.x * yv.x + yv.y * yv.y) + (yv.z * yv.z + yv.w * yv.w);
            const float* wrow = Wp + (16 * t + 4 * kq) * 36 + r16;
            const float ye[4] = {yv.x, yv.y, yv.z, yv.w};
#pragma unroll
            for (int j = 0; j < 4; ++j)
#pragma unroll
                for (int nt = 0; nt < 3; ++nt) { const float wv = (nt < 2) ? wrow[j * 36 + 16 * nt] : wrow[j * 36 + 32 - (r16 & 12)] * m2;
                    acc[nt] = __builtin_amdgcn_mfma_f32_16x16x4f32(ye[j], wv, acc[nt], 0, 0, 0); }
        }
        s1 += __shfl_xor(s1, 16); s1 += __shfl_xor(s1, 32); s2 += __shfl_xor(s2, 16); s2 += __shfl_xor(s2, 32);
        const float mu = s1 * (1.f / 1024.f), rstd = rsqrtf(fmaxf(s2 * (1.f / 1024.f) - mu * mu, 0.f) + LN_EPS);
#pragma unroll 8
        for (int t = 0; t < 64; ++t) {
            const uint2 yr = *(const uint2*)(yp + 16 * t); const float4 yv = make_float4(__uint_as_float(yr.x << 16), __uint_as_float(yr.x & 0xffff0000u), __uint_as_float(yr.y << 16), __uint_as_float(yr.y & 0xffff0000u));
            const float4 gv = *(const float4*)(g1 + 16 * t + 4 * kq), bv = *(const float4*)(b1 + 16 * t + 4 * kq);
            const float4 o = make_float4((yv.x - mu) * rstd * gv.x + bv.x, (yv.y - mu) * rstd * gv.y + bv.y, (yv.z - mu) * rstd * gv.z + bv.z, (yv.w - mu) * rstd * gv.w + bv.w);
            uint2 ob; ob.x = pg8::cvt_pk_bf16(o.x, o.y); ob.y = pg8::cvt_pk_bf16(o.z, o.w);
            *(uint2*)(x1b + (size_t)(row0 + r16) * 1024 + 16 * t + 4 * kq) = ob;
            *(unsigned*)(x1q + (size_t)(row0 + r16) * 1024 + 16 * t + 4 * kq) = pg8::pk4_fp8(o.x * pg8::FP8_SX, o.y * pg8::FP8_SX, o.z * pg8::FP8_SX, o.w * pg8::FP8_SX);
        }
#pragma unroll
        for (int j = 0; j < 4; ++j) {
            const int rl = 4 * kq + j;
            const float mur = __shfl(mu, rl), rsr = __shfl(rstd, rl);
            float lg[3];
#pragma unroll
            for (int nt = 0; nt < 3; ++nt) lg[nt] = rsr * (acc[nt][j] - mur * Sc[16 * nt + r16]) + Bc[16 * nt + r16];
            const int gb = 16 * kq;
            const float g0 = __shfl(lg[2], gb + 0), g1v = __shfl(lg[2], gb + 1), g2 = __shfl(lg[2], gb + 2), g3 = __shfl(lg[2], gb + 3);
            int gi = 0; float gm = g0; if (g1v > gm) { gm = g1v; gi = 1; } if (g2 > gm) { gm = g2; gi = 2; } if (g3 > gm) { gm = g3; gi = 3; }
            const float gw = 1.f / (expf(g0 - gm) + expf(g1v - gm) + expf(g2 - gm) + expf(g3 - gm));
            const float lsel = (gi & 2) ? lg[1] : lg[0];
            float ev[8];
#pragma unroll
            for (int t = 0; t < 8; ++t) ev[t] = __shfl(lsel, gb + (gi & 1) * 8 + t);
            int i1 = 0; float v1 = ev[0];
#pragma unroll
            for (int t = 1; t < 8; ++t) if (ev[t] > v1) { v1 = ev[t]; i1 = t; }
            int i2 = -1; float v2 = -INFINITY;
#pragma unroll
            for (int t = 0; t < 8; ++t) if (t != i1 && ev[t] > v2) { v2 = ev[t]; i2 = t; }
            const float w1 = 1.f / (1.f + expf(v2 - v1)), w2 = 1.f - w1;
            if (r16 == 0) {
                const int lr = lrow0 + rl, r = row0 + rl, e1 = gi * 8 + i1, e2 = gi * 8 + i2;
                route_e[r] = make_int2(e1, e2); route_w[r] = make_float2(gw * w1, gw * w2);
                rowE[2 * lr] = e1; rowP[2 * lr] = atomicAdd(&lcnt[e1], 1);
                rowE[2 * lr + 1] = e2; rowP[2 * lr + 1] = atomicAdd(&lcnt[e2], 1);
            }
        }
    }
    __syncthreads();
    if (threadIdx.x < 32) lcnt[threadIdx.x] = atomicAdd(&cnt[threadIdx.x * 64], lcnt[threadIdx.x]);
    __syncthreads();
    for (int i = threadIdx.x; i < 2 * rows_per_wg; i += NTHR) { const int e = rowE[i]; list[e * 32768 + lcnt[e] + rowP[i]] = (blk * rows_per_wg + (i >> 1)) * 2 + (i & 1); }
    __syncthreads();
    if (threadIdx.x < 32) lcnt[threadIdx.x] = 0;
    __syncthreads();
    }
}

DEV void p_final(float* out, const bf16_t* x1b, const bf16_t* ys, const float* g2, const float* b2) {
    const int lane = threadIdx.x & 63;
    for (int r = (blockIdx.x * NTHR + threadIdx.x) >> 6; r < NTOK; r += gridDim.x * (NTHR / 64)) {
        float x[16]; float s = 0.f;
#pragma unroll
        for (int j = 0; j < 4; ++j) { const int col = j * 256 + lane * 4; const ushort4 tb = *(const ushort4*)(x1b + (size_t)r * 1024 + col); const float4 t = make_float4(bf2f(tb.x), bf2f(tb.y), bf2f(tb.z), bf2f(tb.w));
            const ushort4 a = *(const ushort4*)(ys + (size_t)(2 * r) * 1024 + col), b = *(const ushort4*)(ys + (size_t)(2 * r + 1) * 1024 + col);
            x[4 * j] = ALPHA * t.x + bf2f(a.x) + bf2f(b.x); x[4 * j + 1] = ALPHA * t.y + bf2f(a.y) + bf2f(b.y); x[4 * j + 2] = ALPHA * t.z + bf2f(a.z) + bf2f(b.z); x[4 * j + 3] = ALPHA * t.w + bf2f(a.w) + bf2f(b.w);
            s += (x[4 * j] + x[4 * j + 1]) + (x[4 * j + 2] + x[4 * j + 3]); }
#pragma unroll
        for (int m = 1; m < 64; m <<= 1) s += __shfl_xor(s, m);
        const float mu = s * (1.f / 1024.f); float q = 0.f;
#pragma unroll
        for (int j = 0; j < 16; ++j) { x[j] -= mu; q += x[j] * x[j]; }
#pragma unroll
        for (int m = 1; m < 64; m <<= 1) q += __shfl_xor(q, m);
        const float rstd = rsqrtf(q * (1.f / 1024.f) + LN_EPS);
#pragma unroll
        for (int j = 0; j < 4; ++j) { const int col = j * 256 + lane * 4; const float4 gg = *(const float4*)(g2 + col), bb = *(const float4*)(b2 + col);
            *(float4*)(out + (size_t)r * 1024 + col) = make_float4(x[4 * j] * rstd * gg.x + bb.x, x[4 * j + 1] * rstd * gg.y + bb.y, x[4 * j + 2] * rstd * gg.z + bb.z, x[4 * j + 3] * rstd * gg.w + bb.w); }
    }
}

struct Args { const float* in[24]; float* out; unsigned char* ws; };
__global__ void __launch_bounds__(NTHR, 2) mega_fwd(Args a) {
    extern __shared__ __attribute__((aligned(16))) unsigned char lds_raw[];
    float* ldsf = (float*)lds_raw;
    PG8_LAS unsigned char* ldsl = (PG8_LAS unsigned char*)lds_raw;
    volatile LAS unsigned* MISC = (volatile LAS unsigned*)((LAS unsigned char*)lds_raw + LDS_MISC);
    for (int u = threadIdx.x; u < 128; u += NTHR) MISC[u] = 0u;
    __syncthreads();
    unsigned char* ws = a.ws;
    XcdBarrier bar = xcd_barrier_post((unsigned*)(ws + WS_CTL) + CW_BAR, MISC + 8);
#define GRID_BAR() xcd_barrier(bar)
    const float* x = a.in[0]; const float* w_in = a.in[1]; const float* b_merge = a.in[2];
    const float* conv_w = a.in[3]; const float* conv_b = a.in[4];
    const float* w_rg_r = a.in[5]; const float* b_rg_r = a.in[6]; const float* w_rg_i = a.in[7]; const float* b_rg_i = a.in[8];
    const float* lam = a.in[9]; const float* w_ret_o = a.in[10]; const float* w_lru_o = a.in[11]; const float* w_out = a.in[12];
    const float* ln1_g = a.in[13]; const float* ln1_b = a.in[14]; const float* w_group = a.in[15]; const float* b_group = a.in[16];
    const float* w_er = a.in[17]; const float* b_er = a.in[18]; const float* w_eg = a.in[19]; const float* w_eu = a.in[20];
    const float* w_ed = a.in[21]; const float* ln2_g = a.in[22]; const float* ln2_b = a.in[23];
    float* out = a.out;
    int* cnt = (int*)(ws + WS_CTL); float2* rope = (float2*)(ws + WS_ROPE); int2* route_e = (int2*)(ws + WS_ROUTE_E); float2* route_w = (float2*)(ws + WS_ROUTE_W); int* list = (int*)(ws + WS_LIST);
    bf16_t* xb = (bf16_t*)(ws + WS_XB); bf16_t* gl = (bf16_t*)(ws + WS_GL); bf16_t* ulru = (bf16_t*)(ws + WS_ULRU); bf16_t* uconv = (bf16_t*)(ws + WS_UCONV);
    bf16_t* epsb = (bf16_t*)(ws + WS_EPS); bf16_t* inp = (bf16_t*)out;
    bf16_t* q = (bf16_t*)(ws + WS_Q); bf16_t* k = (bf16_t*)(ws + WS_K); bf16_t* v = (bf16_t*)(ws + WS_V); bf16_t* gbuf = (bf16_t*)out;
    bf16_t* P = (bf16_t*)(ws + WS_P); bf16_t* gates = (bf16_t*)(ws + WS_GATES); bf16_t* m1 = (bf16_t*)out; bf16_t* merged = xb;
    bf16_t* w_in_t = (bf16_t*)(ws + WS_WIN_T); bf16_t* w_ro_t = (bf16_t*)(ws + WS_WRO_T); bf16_t* w_lo_t = (bf16_t*)(ws + WS_WLO_T); bf16_t* w_out_t = (bf16_t*)(ws + WS_WOUT_T);
    bf16_t* wrg_t = (bf16_t*)(ws + WS_WRG_T); float* segA = (float*)(ws + WS_SEGA); float* segH = (float*)(ws + WS_SEGH); float* carry = (float*)(ws + WS_CARRY);
    float* rsb = (float*)(ws + WS_RSB);
    unsigned char* wgu8 = ws + WS_WGU_T; unsigned char* wd8 = ws + WS_WD_T; unsigned char* x1q = ws + WS_X1Q;
    bf16_t* x1b = gl; bf16_t* hbuf = (bf16_t*)(ws + WS_H); bf16_t* ys = (bf16_t*)(ws + WS_YSLOT);

    p_router_consts(ldsf, ln1_g, ln1_b, w_group, b_group, w_er, b_er, rsb); p_cvt_x(x, xb); p_rope_table(rope); p_weights(ldsf, w_in, w_ret_o, w_lru_o, w_out, w_rg_r, w_rg_i, w_in_t, w_ro_t, w_lo_t, w_out_t, wrg_t);
    GRID_BAR();
    { pg8::Gemm g{xb, w_in_t + (size_t)C_U * 1024, NTOK, 3072, 1024}; pg8::StaticOrder S; S.init(NTOK, 3072, (int)gridDim.x, (int)blockIdx.x);
      pg8::gemm_phase<pg8::EpiLruIn, pg8::StaticOrder, true, true>(ldsl, g, S, pg8::EpiLruIn{ulru, gl}); }
    GRID_BAR();
    p_lru_compute(lds_raw, ulru, conv_w, conv_b, wrg_t, b_rg_r, b_rg_i, lam, uconv, epsb, segA, segH);
    GRID_BAR();
    p_lru_carry(ldsf, segA, segH, carry);
    GRID_BAR();
    p_lru_scan(uconv, epsb, gl, carry);
    GRID_BAR();
    { pg8::Gemm g{xb, w_in_t, NTOK, 6144, 1024}; pg8::StaticOrder S; S.init(NTOK, 6144, (int)gridDim.x, (int)blockIdx.x);
      pg8::gemm_phase<pg8::EpiRetIn, pg8::StaticOrder, true, true>(ldsl, g, S, pg8::EpiRetIn{q, k, v, gbuf, (const float*)rope}); }
    GRID_BAR();
    p_scores(lds_raw, q, k, P);
    GRID_BAR();
    p_ret_mfma(lds_raw, q, k, v, P);
    GRID_BAR();
    p_headnorm(v, gbuf);
    { pg8::Gemm g{xb, w_in_t + (size_t)C_GATE * 1024, NTOK, 2048, 1024}; pg8::StaticOrder S; S.init(NTOK, 2048, (int)gridDim.x, (int)blockIdx.x);
      pg8::gemm_phase<pg8::EpiGates, pg8::StaticOrder, true, true>(ldsl, g, S, pg8::EpiGates{b_merge, gates}); }
    GRID_BAR();
    { pg8::Gemm g{v, w_ro_t, NTOK, 1024, 2048}; pg8::StaticOrder S; S.init(NTOK, 1024, (int)gridDim.x, (int)blockIdx.x);
      pg8::gemm_phase<pg8::EpiMerge<0>, pg8::StaticOrder, true, true>(ldsl, g, S, pg8::EpiMerge<0>{gates, nullptr, m1}); }
    GRID_BAR();
    { pg8::Gemm g{gl, w_lo_t, NTOK, 1024, 1536}; pg8::StaticOrder S; S.init(NTOK, 1024, (int)gridDim.x, (int)blockIdx.x);
      pg8::gemm_phase<pg8::EpiMerge<1>, pg8::StaticOrder, true, true>(ldsl, g, S, pg8::EpiMerge<1>{gates, m1, merged}); }
    GRID_BAR();
    { pg8::Gemm g{merged, w_out_t, NTOK, 1024, 1024}; pg8::StaticOrder S; S.init(NTOK, 1024, (int)gridDim.x, (int)blockIdx.x);
      pg8::gemm_phase<pg8::EpiOut, pg8::StaticOrder, true, true>(ldsl, g, S, pg8::EpiOut{x, (bf16_t*)out, ALPHA}); }
    GRID_BAR();
    p_ln1_route(ldsf, (const bf16_t*)out, x1b, x1q, ln1_g, ln1_b, w_group, b_group, w_er, b_er, route_e, route_w, cnt, list, rsb);
    p_expert_weights(ldsf, w_eg, w_eu, w_ed, wgu8, wd8);
    GRID_BAR();
    {
        PG8_LAS pg8::MoeTab* tab = (PG8_LAS pg8::MoeTab*)(ldsl + LDS_TAB);
        pg8::moe_build_tab(tab, cnt);
        const int T = tab->tileStart[32];
        { pg8::Gemm g{(const bf16_t*)x1q, (const bf16_t*)wgu8, T * 256, 32 * 1024, 512}; pg8::MoeOrder<true> S{T * 4, (int)gridDim.x, (int)blockIdx.x, tab, list};
          pg8::gemm_phase<pg8::EpiSwiGLU8, pg8::MoeOrder<true>, true, true, true>(ldsl, g, S, pg8::EpiSwiGLU8{(unsigned char*)hbuf}); }
        GRID_BAR();
        { pg8::Gemm g{hbuf, (const bf16_t*)wd8, T * 256, 32 * 1024, 256}; pg8::MoeOrder<false> S{T * 4, (int)gridDim.x, (int)blockIdx.x, tab, list};
          pg8::gemm_phase<pg8::EpiMoeOut8, pg8::MoeOrder<false>, true, true, true>(ldsl, g, S, pg8::EpiMoeOut8{tab, list, (const float*)route_w, ys}); }
    }
    GRID_BAR();
    p_final(out, x1b, ys, ln2_g, ln2_b);
}

extern "C" void kernel_launch(void* const* d_in, const int* in_sizes, int n_in, void* d_out, int out_size, void* d_ws, size_t ws_size, hipStream_t stream) {
    static int grid = 0;
    if (grid == 0) {
        if (n_in != 24 || in_sizes[0] != NTOK * DM || out_size != NTOK * DM || ws_size < WS_END) {
            fprintf(stderr, "kernel_launch: unexpected shapes (n_in %d, in0 %d, out %d, ws %zu)\n", n_in, n_in > 0 ? in_sizes[0] : -1, out_size, ws_size); grid = -1; return; }
        int dev = 0, cus = 0, per_cu = 0;
        if (hipGetDevice(&dev) != hipSuccess || hipDeviceGetAttribute(&cus, hipDeviceAttributeMultiprocessorCount, dev) != hipSuccess) { fprintf(stderr, "kernel_launch: device query failed\n"); grid = -1; return; }
        if (hipFuncSetAttribute((const void*)mega_fwd, hipFuncAttributeMaxDynamicSharedMemorySize, LDS_BYTES) != hipSuccess) { fprintf(stderr, "kernel_launch: hipFuncSetAttribute failed\n"); grid = -1; return; }
        if (hipOccupancyMaxActiveBlocksPerMultiprocessor(&per_cu, (const void*)mega_fwd, NTHR, LDS_BYTES) != hipSuccess || per_cu < 1) {
            fprintf(stderr, "kernel_launch: occupancy query reports %d workgroups per CU\n", per_cu); (void)hipGetLastError(); grid = -1; return; }
        grid = cus;
    }
    if (grid < 0) return;
    if (hipMemsetAsync((char*)d_ws + WS_CTL, 0, CTL_ZERO_BYTES, stream) != hipSuccess) { fprintf(stderr, "kernel_launch: memset failed\n"); return; }
    Args a{};
    for (int i = 0; i < 24; ++i) a.in[i] = (const float*)d_in[i];
    a.out = (float*)d_out; a.ws = (unsigned char*)d_ws;
    hipLaunchKernelGGL(mega_fwd, dim3(grid), dim3(NTHR), LDS_BYTES, stream, a);
    const hipError_t le = hipPeekAtLastError();
    if (le != hipSuccess) fprintf(stderr, "kernel_launch: launch failed: %s\n", hipGetErrorName(le));
}
```

```cpp
#include <hip/hip_runtime.h>
#include <cstdio>
#include <cstdint>

typedef unsigned short bf16_t;
#define DEV __device__ __forceinline__
#define LAS __attribute__((address_space(3)))

DEV float bf2f(bf16_t h) { return __uint_as_float(((unsigned)h) << 16); }
DEV bf16_t f2bf(float f) { unsigned u = __float_as_uint(f); return (bf16_t)((u + 0x7fffu + ((u >> 16) & 1u)) >> 16); }

constexpr int NTHR = 512;
constexpr int NTOK = 32768, DM = 1024, SEQ = 8192;
constexpr int WIN_N = 11264;
constexpr int C_Q = 0, C_K = 1024, C_V = 2048, C_G = 4096, C_U = 6144, C_GL = 7680, C_GATE = 9216;
constexpr float ALPHA = 1.189207115002721f;
constexpr float LN_EPS = 1e-5f;
constexpr size_t MiB = 1u << 20;
constexpr size_t WS_CTL = 0;
constexpr size_t CTL_ZERO_BYTES = 1 * MiB;
constexpr int CW_BAR = 4096;
constexpr size_t WS_ROPE = 1 * MiB;
constexpr size_t WS_ROUTE_E = 9 * MiB;
constexpr size_t WS_ROUTE_W = 9 * MiB + 512 * 1024;
constexpr size_t WS_LIST = 10 * MiB;
constexpr size_t WS_WRG_T = 14 * MiB;
constexpr size_t WS_RSB = 15 * MiB + 512 * 1024;
constexpr size_t WS_SEGA = 16 * MiB;
constexpr size_t WS_SEGH = 18 * MiB;
constexpr size_t WS_CARRY = 20 * MiB;
constexpr size_t WS_XB = 32 * MiB;
constexpr size_t WS_GL = 96 * MiB;
constexpr size_t WS_ULRU = 192 * MiB;
constexpr size_t WS_Q = 192 * MiB;
constexpr size_t WS_K = 256 * MiB;
constexpr size_t WS_GATES = 192 * MiB;
constexpr size_t WS_UCONV = 288 * MiB;
constexpr size_t WS_P = 320 * MiB;
constexpr size_t WS_V = 352 * MiB;
constexpr size_t WS_EPS = 384 * MiB;
constexpr size_t WS_H = 192 * MiB;
constexpr size_t WS_YSLOT = 264 * MiB;
constexpr size_t WS_WGU_T = 352 * MiB;
constexpr size_t WS_WD_T = 416 * MiB;
constexpr size_t WS_X1Q = 160 * MiB;
constexpr int LDS_TAB = 131072;
constexpr size_t WS_WIN_T = 480 * MiB;
constexpr size_t WS_WRO_T = 502 * MiB;
constexpr size_t WS_WLO_T = 506 * MiB;
constexpr size_t WS_WOUT_T = 509 * MiB;
constexpr size_t WS_END = 512 * MiB;
constexpr int LDS_BYTES = 163840;
constexpr int LDS_MISC = 163840 - 512;

#define XB_TMO      128
#define XB_XCNT(j)  (256  + 64 * (j))
#define XB_XSUB(j)  (1280 + 64 * (j))
#define XB_XGEN(j)  (2304 + 64 * (j))
#define XB_TOP      3328
#define XB_TOPGEN   3392
#define XCD_BAR_WORDS 3456
#define XB_SPIN_CAP (1u << 22)
DEV unsigned xb_ld(unsigned* p)              { return __hip_atomic_load(p, __ATOMIC_RELAXED, __HIP_MEMORY_SCOPE_AGENT); }
DEV unsigned xb_add(unsigned* p, unsigned v) { return __hip_atomic_fetch_add(p, v, __ATOMIC_RELAXED, __HIP_MEMORY_SCOPE_AGENT); }
DEV unsigned xb_xcc_id() { return (unsigned)__builtin_amdgcn_s_getreg((3 << 11) | 20) & 0xFu; }
#define XB_SPIN(cond, bar) do { unsigned _sp = 0; while (cond) { __builtin_amdgcn_s_sleep(1); \
    if ((++_sp & 255u) == 0u) { if (xb_ld(&(bar)[XB_TMO])) break; if (_sp > XB_SPIN_CAP) { atomicAdd(&(bar)[XB_TMO], 1u); break; } } } } while (0)
struct XcdBarrier { unsigned* bar; unsigned x; volatile LAS unsigned* st; };
DEV XcdBarrier xcd_barrier_post(unsigned* bar, volatile LAS unsigned* st) {
    XcdBarrier b; b.bar = bar; b.x = xb_xcc_id(); b.st = st;
    if (threadIdx.x == 0) (void)xb_add(&bar[XB_XCNT(b.x)], 1u);
    return b;
}
DEV void xcd_barrier_complete(unsigned* bar, unsigned x, unsigned& nloc, unsigned& nx) {
    const unsigned G = gridDim.x * gridDim.y * gridDim.z;
    unsigned sum, cnt, mine, sp = 0u;
    for (;;) {
        sum = 0u; cnt = 0u; mine = 0u;
#pragma unroll
        for (unsigned j = 0; j < 16; ++j) { const unsigned c = xb_ld(&bar[XB_XCNT(j)]); sum += c; cnt += (c > 0u) ? 1u : 0u; mine = (j == x) ? c : mine; }
        if (sum == G) break;
        __builtin_amdgcn_s_sleep(1);
        if ((++sp & 255u) == 0u) { if (xb_ld(&bar[XB_TMO])) break; if (sp > XB_SPIN_CAP) { atomicAdd(&bar[XB_TMO], 1u); break; } }
    }
    nloc = mine > 0u ? mine : 1u; nx = cnt > 0u ? cnt : 1u;
}
DEV void xcd_barrier(const XcdBarrier& b) {
    asm volatile("s_waitcnt vmcnt(0)" ::: "memory");
    __syncthreads();
    if (threadIdx.x == 0) {
        unsigned* bar = b.bar;
        __builtin_amdgcn_s_waitcnt(0);
        unsigned nloc = b.st[0], nx = b.st[1];
        if (nloc == 0u) { xcd_barrier_complete(bar, b.x, nloc, nx); b.st[0] = nloc; b.st[1] = nx; }
        const unsigned old = xb_add(&bar[XB_XSUB(b.x)], 1u);
        const unsigned gen = old / nloc;
        if (old + 1u == (gen + 1u) * nloc) {
            __builtin_amdgcn_fence(__ATOMIC_RELEASE, "agent");
            asm volatile("s_waitcnt vmcnt(0)" ::: "memory");
            const unsigned og = xb_add(&bar[XB_TOP], 1u);
            const unsigned tg = og / nx;
            if (og + 1u == (tg + 1u) * nx) xb_add(&bar[XB_TOPGEN], 1u);
            else XB_SPIN(xb_ld(&bar[XB_TOPGEN]) == tg, bar);
            __builtin_amdgcn_fence(__ATOMIC_ACQUIRE, "agent");
            xb_add(&bar[XB_XGEN(b.x)], 1u);
            asm volatile("s_waitcnt vmcnt(0)" ::: "memory");
        } else {
            XB_SPIN(xb_ld(&bar[XB_XGEN(b.x)]) == gen, bar);
            __builtin_amdgcn_fence(__ATOMIC_ACQUIRE, "agent");
            asm volatile("s_waitcnt vmcnt(0)" ::: "memory");
        }
    }
    __syncthreads();
}

namespace pg8 {
#define PG8_LAS __attribute__((address_space(3)))
typedef unsigned short bf16_t;
typedef short bf16x8 __attribute__((ext_vector_type(8)));
typedef float f32x4 __attribute__((ext_vector_type(4)));
typedef unsigned u32x4 __attribute__((ext_vector_type(4)));
constexpr int BM = 256, BK = 64, HALF = 128, HTB = HALF * BK * 2  , STAGE_BYTES = 8 * HTB, NXCD = 8, WGM = 8;

__host__ __device__ __forceinline__ int lds_byte(int r, int c) { const int st = (r >> 4) * 2 + (c >> 5), rr = r & 15, cc = c & 31, ob = rr * 64 + cc * 2; return st * 1024 + (ob ^ (((ob >> 9) & 1) << 5)); }
__host__ __device__ __forceinline__ void stage_rc(int b, int& R, int& C) { const int st = b / 1024, sb = b % 1024, swz = sb ^ (((sb >> 9) & 1) << 5); R = (st >> 1) * 16 + swz / 64; C = (st & 1) * 32 + (swz % 64) / 2; }
__host__ __device__ __forceinline__ int perm32(int rho) { const int n = rho >> 4, i = rho & 15; return 8 * (i >> 2) + 4 * n + (i & 3); }

struct Unit { int pm, pn; };
struct Gemm { const bf16_t* A; const bf16_t* Bt; int M, N, K; };

struct StaticOrder {
    int nM, nN, nwg, G, c;
    __host__ __device__ void init(int M, int N, int G_, int c_) { nM = M / BM; nN = N / BM; nwg = nM * nN; G = G_; c = c_; }
    __host__ __device__ bool next(int i, Unit& u) const {
        const long L = (long)i * G + c; if (L >= nwg) return false;
        int wgid = (int)L; { const int q = nwg / NXCD, r = nwg % NXCD, xcd = wgid % NXCD, off = wgid / NXCD; wgid = (xcd < r ? xcd * (q + 1) : r * (q + 1) + (xcd - r) * q) + off; }
        const int nig = WGM * nN, gid = wgid / nig, fm = gid * WGM, gsz = (nM - fm) < WGM ? (nM - fm) : WGM;
        u.pm = fm + ((wgid % nig) % gsz); u.pn = (wgid % nig) / gsz; return true;
    }
    __device__ __forceinline__ void a_ready(const Unit&) const {}
    __device__ __forceinline__ void done(const Unit&) const {}
    __device__ __forceinline__ const char* a_base(const Gemm& g, const Unit& u) const { return (const char*)g.A + (size_t)u.pm * (size_t)(BM * g.K * 2); }
    __device__ __forceinline__ void a_off(const Gemm& g, const Unit&, const int (&R)[2], const int (&C)[2], unsigned (&v)[2][2]) const {
        _Pragma("unroll") for (int hh = 0; hh < 2; ++hh) _Pragma("unroll") for (int i = 0; i < 2; ++i) v[hh][i] = (unsigned)((hh * HALF + R[i]) * g.K + C[i]) * 2u; }
};
typedef __bf16 bf16x2_t __attribute__((ext_vector_type(2)));
typedef float f32x2_t __attribute__((ext_vector_type(2)));
__device__ __forceinline__ unsigned cvt_pk_bf16(float lo, float hi) { f32x2_t v = {lo, hi}; return __builtin_bit_cast(unsigned, __builtin_convertvector(v, bf16x2_t)); }
typedef int i32x4 __attribute__((ext_vector_type(4)));
typedef int i32x8 __attribute__((ext_vector_type(8)));
template <bool MX8> struct Frag { struct A4 { bf16x8 v[4][2]; }; struct B2 { bf16x8 v[2][2]; }; };
template <> struct Frag<true> { struct A4 { i32x8 v[4]; }; struct B2 { i32x8 v[2]; }; };
__device__ __forceinline__ i32x8 ld32(const PG8_LAS unsigned char* p0, const PG8_LAS unsigned char* p1) { const i32x4 a = *(const PG8_LAS i32x4*)p0, b = *(const PG8_LAS i32x4*)p1; return __builtin_shufflevector(a, b, 0, 1, 2, 3, 4, 5, 6, 7); }
template <class Epi, class Sched, bool ALIGN_EPI = false, bool SP2 = false, bool MX8 = false>
__device__ __forceinline__ void gemm_phase(PG8_LAS unsigned char* lds, const Gemm g, const Sched& S, const Epi& E) {
    int tid_ = threadIdx.x; asm volatile("" : "+v"(tid_));
    const int tid = tid_, wid = __builtin_amdgcn_readfirstlane(tid >> 6), lane = tid & 63, wr = wid >> 2, wc = wid & 3, fr = lane & 15, fq = lane >> 4;
    const int K = g.K, nt = K / BK;
    unsigned voffB[2], vA[2][2], vN[2][2]; int sR[2], sC[2];
#pragma unroll
    for (int i = 0; i < 2; ++i) { int R, C; stage_rc(tid * 16 + i * 8192, R, C); const int Rb = Epi::PERM ? ((R & ~31) + perm32(R & 31)) : R;
        sR[i] = R; sC[i] = C; voffB[i] = (unsigned)(Rb * K + C) * 2u; }
    const size_t kstep = (size_t)(BK * 2);
    const size_t hstep = (size_t)HALF * K * 2;
    const size_t tstep = 2 * hstep;
    const unsigned ldsw = (unsigned)wid * 1024u;
    const int aoff = lds_byte(wr * 64 + fr, fq * 8), boff = lds_byte(wc * 32 + fr, fq * 8);
#define PG8_SA(b, h) (((b) * 2 + (h)) * HTB)
#define PG8_SB(b, h) ((4 + (b) * 2 + (h)) * HTB)
#define PG8_STAGE(bufoff, gbase, voff) do { _Pragma("unroll") for (int _i = 0; _i < 2; ++_i) \
        __builtin_amdgcn_global_load_lds((const unsigned*)((const char*)(gbase) + (voff)[_i]), (PG8_LAS unsigned*)(lds + (bufoff) + ldsw + _i * 8192), 16, 0, 0); } while (0)
#define PG8_LDA(dst, b, h) do { if constexpr (MX8) { _Pragma("unroll") for (int m = 0; m < 4; ++m) dst.v[m] = ld32(lds + PG8_SA(b, h) + aoff + m * 2048, lds + PG8_SA(b, h) + aoff + m * 2048 + 1024); } \
        else { _Pragma("unroll") for (int m = 0; m < 4; ++m) _Pragma("unroll") for (int k = 0; k < 2; ++k) dst.v[m][k] = *(const PG8_LAS bf16x8*)(lds + PG8_SA(b, h) + aoff + m * 2048 + k * 1024); } } while (0)
#define PG8_LDB(dst, b, h) do { if constexpr (MX8) { _Pragma("unroll") for (int n = 0; n < 2; ++n) dst.v[n] = ld32(lds + PG8_SB(b, h) + boff + n * 2048, lds + PG8_SB(b, h) + boff + n * 2048 + 1024); } \
        else { _Pragma("unroll") for (int n = 0; n < 2; ++n) _Pragma("unroll") for (int k = 0; k < 2; ++k) dst.v[n][k] = *(const PG8_LAS bf16x8*)(lds + PG8_SB(b, h) + boff + n * 2048 + k * 1024); } } while (0)
#define PG8_MMA(ai, bj, At, Bt) do { __builtin_amdgcn_s_setprio(1); \
        if constexpr (MX8) { _Pragma("unroll") for (int m = 0; m < 4; ++m) _Pragma("unroll") for (int n = 0; n < 2; ++n) \
            { acc[ai][bj][m][n] = __builtin_amdgcn_mfma_scale_f32_16x16x128_f8f6f4(Bt.v[n], At.v[m], acc[ai][bj][m][n], 0, 0, 0, 0x7f7f7f7f, 0, 0x7f7f7f7f); asm volatile("" : "+v"(acc[ai][bj][m][n])); } } \
        else { _Pragma("unroll") for (int m = 0; m < 4; ++m) _Pragma("unroll") for (int n = 0; n < 2; ++n) _Pragma("unroll") for (int k = 0; k < 2; ++k) \
            acc[ai][bj][m][n] = __builtin_amdgcn_mfma_f32_16x16x32_bf16(Bt.v[n][k], At.v[m][k], acc[ai][bj][m][n], 0, 0, 0); } \
        __builtin_amdgcn_s_setprio(0); } while (0)
#define PG8_WAIT_V(n) asm volatile("s_waitcnt vmcnt(" #n ")" ::: "memory")
#define PG8_WAIT_L(n) asm volatile("s_waitcnt lgkmcnt(" #n ")" ::: "memory")
#define PG8_BAR __builtin_amdgcn_s_barrier()
#define PG8_SCHED __builtin_amdgcn_sched_barrier(0)
    Unit cur, nxt; int ui = 0;
    if (!S.next(0, cur)) return;
    f32x4 acc[2][2][4][2];
#pragma unroll
    for (int a = 0; a < 2; ++a)
#pragma unroll
        for (int b = 0; b < 2; ++b)
#pragma unroll
            for (int m = 0; m < 4; ++m)
#pragma unroll
                for (int n = 0; n < 2; ++n) acc[a][b][m][n] = (f32x4){0.f, 0.f, 0.f, 0.f};
    typename Frag<MX8>::A4 At; typename Frag<MX8>::B2 B0, B1;
    const char* cA = S.a_base(g, cur); const char* cB = (const char*)g.Bt + (size_t)cur.pn * tstep;
    S.a_ready(cur); S.a_off(g, cur, sR, sC, vA);
    if constexpr (SP2) {
        PG8_STAGE(PG8_SB(0, 0), cB, voffB); PG8_STAGE(PG8_SB(0, 1), cB + hstep, voffB); PG8_STAGE(PG8_SA(0, 0), cA, vA[0]); PG8_STAGE(PG8_SA(0, 1), cA, vA[1]);
        if (wr == 1) PG8_BAR;
        PG8_WAIT_V(2); PG8_BAR;
        PG8_STAGE(PG8_SB(1, 0), cB + kstep, voffB); PG8_STAGE(PG8_SA(1, 0), cA + kstep, vA[0]); PG8_STAGE(PG8_SB(1, 1), cB + hstep + kstep, voffB);
        PG8_WAIT_V(6); PG8_BAR;
    } else { static_assert(SP2, "only the SP2 K-loop is kept in this file"); }
    for (;;) {
        const bool has_next = S.next(ui + 1, nxt);
        const char* nA = has_next ? S.a_base(g, nxt) : cA; const char* nB = has_next ? (const char*)g.Bt + (size_t)nxt.pn * tstep : cB;
        if (has_next) S.a_off(g, nxt, sR, sC, vN); else { vN[0][0] = vA[0][0]; vN[0][1] = vA[0][1]; vN[1][0] = vA[1][0]; vN[1][1] = vA[1][1]; }
#pragma unroll 1
        for (int t = 0; t < nt; t += 2) {
            const bool last = (t == nt - 2);
            const char* a1 = cA + (size_t)(t + 1) * kstep;
            const char* a2 = last ? nA : cA + (size_t)(t + 2) * kstep; const char* b2 = last ? nB : cB + (size_t)(t + 2) * kstep;
            const char* a3 = a2 + kstep; const char* b3 = b2 + kstep;
            unsigned v2[2][2]; v2[0][0] = last ? vN[0][0] : vA[0][0]; v2[0][1] = last ? vN[0][1] : vA[0][1]; v2[1][0] = last ? vN[1][0] : vA[1][0]; v2[1][1] = last ? vN[1][1] : vA[1][1];
            if (last && has_next) S.a_ready(nxt);
            if constexpr (SP2) {
            PG8_LDB(B0, 0, 0); PG8_LDB(B1, 0, 1); PG8_SCHED; PG8_LDA(At, 0, 0); PG8_STAGE(PG8_SA(1, 1), a1, vA[1]);
            PG8_WAIT_V(8); PG8_WAIT_L(0); PG8_BAR; PG8_MMA(0, 0, At, B0); PG8_MMA(0, 1, At, B1); PG8_BAR; PG8_SCHED;
            PG8_LDA(At, 0, 1); PG8_STAGE(PG8_SB(0, 0), b2, voffB); PG8_STAGE(PG8_SB(0, 1), b2 + hstep, voffB); PG8_STAGE(PG8_SA(0, 0), a2, v2[0]);
            PG8_WAIT_V(8); PG8_WAIT_L(0); PG8_BAR; PG8_MMA(1, 0, At, B0); PG8_MMA(1, 1, At, B1); PG8_BAR; PG8_SCHED;
            PG8_LDB(B0, 1, 0); PG8_LDB(B1, 1, 1); PG8_SCHED; PG8_LDA(At, 1, 0); PG8_STAGE(PG8_SA(0, 1), a2, v2[1]);
            PG8_WAIT_V(8); PG8_WAIT_L(0); PG8_BAR; PG8_MMA(0, 0, At, B0); PG8_MMA(0, 1, At, B1); PG8_BAR; PG8_SCHED;
            PG8_LDA(At, 1, 1); PG8_STAGE(PG8_SB(1, 0), b3, voffB); PG8_STAGE(PG8_SB(1, 1), b3 + hstep, voffB); PG8_STAGE(PG8_SA(1, 0), a3, v2[0]);
            PG8_WAIT_V(8); PG8_WAIT_L(0); PG8_BAR; PG8_MMA(1, 0, At, B0); PG8_MMA(1, 1, At, B1); PG8_BAR; PG8_SCHED;
            }
        }
        if constexpr (ALIGN_EPI) { if (wr == 0) PG8_BAR; }
        if constexpr (!Epi::AFTER_DRAIN) { E(acc, cur, wr, wc, fr, fq); S.done(cur); }
        if (!has_next) break;
#pragma unroll
        for (int a = 0; a < 2; ++a)
#pragma unroll
            for (int b = 0; b < 2; ++b)
#pragma unroll
                for (int m = 0; m < 4; ++m)
#pragma unroll
                    for (int n = 0; n < 2; ++n) acc[a][b][m][n] = (f32x4){0.f, 0.f, 0.f, 0.f};
        cur = nxt; cA = nA; cB = nB; ++ui; vA[0][0] = vN[0][0]; vA[0][1] = vN[0][1]; vA[1][0] = vN[1][0]; vA[1][1] = vN[1][1];
        if constexpr (ALIGN_EPI) { if (wr == 1) PG8_BAR; }
    }
    PG8_WAIT_V(0);
    if constexpr (!ALIGN_EPI) { if (wr == 0) PG8_BAR; }
    PG8_BAR;
    if constexpr (Epi::AFTER_DRAIN) { E.fused(acc, cur, wr, wc, fr, fq, lds, wid, lane); S.done(cur); }
#undef PG8_SA
#undef PG8_SB
#undef PG8_STAGE
#undef PG8_LDA
#undef PG8_LDB
#undef PG8_MMA
#undef PG8_WAIT_V
#undef PG8_WAIT_L
#undef PG8_BAR
#undef PG8_SCHED
}

__device__ __forceinline__ float fsig(float x) { return __builtin_amdgcn_rcpf(1.f + __expf(-x)); }
__device__ __forceinline__ float fsilu(float x) { return x * fsig(x); }
__device__ __forceinline__ float fgelu(float x) { return x * fsig(1.5957691216057308f * (x + 0.044715f * x * x * x)); }
__device__ __forceinline__ u32x4 pack8(const f32x4& v0, const f32x4& v1) { u32x4 w; w.x = cvt_pk_bf16(v0[0], v0[1]); w.y = cvt_pk_bf16(v0[2], v0[3]); w.z = cvt_pk_bf16(v1[0], v1[1]); w.w = cvt_pk_bf16(v1[2], v1[3]); return w; }
__device__ __forceinline__ void unpack8(const u32x4& w, f32x4& v0, f32x4& v1) {
    v0[0] = __uint_as_float(w.x << 16); v0[1] = __uint_as_float(w.x & 0xffff0000u); v0[2] = __uint_as_float(w.y << 16); v0[3] = __uint_as_float(w.y & 0xffff0000u);
    v1[0] = __uint_as_float(w.z << 16); v1[1] = __uint_as_float(w.z & 0xffff0000u); v1[2] = __uint_as_float(w.w << 16); v1[3] = __uint_as_float(w.w & 0xffff0000u); }

struct EpiLruIn {
    static constexpr bool PERM = true, AFTER_DRAIN = false;
    bf16_t* u; bf16_t* gl;
    __device__ __forceinline__ void operator()(const f32x4 (&acc)[2][2][4][2], const Unit& un, int wr, int wc, int fr, int fq) const {
        const int row0 = un.pm * BM + wr * 64 + fr; const bool isg = un.pn >= 6;
        bf16_t* base = (isg ? gl : u) + (isg ? un.pn - 6 : un.pn) * BM + wc * 32 + 8 * fq;
#pragma unroll
        for (int ai = 0; ai < 2; ++ai)
#pragma unroll
            for (int m = 0; m < 4; ++m) { bf16_t* rowp = base + (size_t)(row0 + ai * HALF + m * 16) * 1536;
#pragma unroll
                for (int bj = 0; bj < 2; ++bj) { f32x4 v0 = acc[ai][bj][m][0], v1 = acc[ai][bj][m][1];
                    if (isg) {
#pragma unroll
                        for (int e = 0; e < 4; ++e) { v0[e] = fgelu(v0[e]); v1[e] = fgelu(v1[e]); } }
                    *(u32x4*)(rowp + bj * HALF) = pack8(v0, v1); } }
    }
};
struct EpiRetIn {
    static constexpr bool PERM = true, AFTER_DRAIN = false;
    bf16_t* q; bf16_t* k; bf16_t* v; bf16_t* g; const float* rope;
    __device__ __forceinline__ void operator()(const f32x4 (&acc)[2][2][4][2], const Unit& un, int wr, int wc, int fr, int fq) const {
        const int row0 = un.pm * BM + wr * 64 + fr;
        if (un.pn < 8) {
            const bool isk = un.pn >= 4; const int h = un.pn & 3;
            const float lg = __log2f(1.f - __builtin_amdgcn_exp2f(-5.f - (float)h));
            const int jb = wc * 32 + 8 * fq;
            bf16_t* base = (isk ? k : q) + h * 256 + jb;
#pragma unroll
            for (int ai = 0; ai < 2; ++ai)
#pragma unroll
                for (int m = 0; m < 4; ++m) { const int r = row0 + ai * HALF + m * 16, s = r & 8191, n = s & 127;
                    const float sc = isk ? __builtin_amdgcn_exp2f(-(float)n * lg) * 0.0625f : __builtin_amdgcn_exp2f((float)n * lg);
                    const f32x4* tp = (const f32x4*)(rope + ((size_t)s * 128 + jb) * 2);
                    f32x4 o1[2], o2[2];
#pragma unroll
                    for (int nn = 0; nn < 2; ++nn) { const f32x4 ta = tp[2 * nn], tb = tp[2 * nn + 1]; const f32x4 a = acc[ai][0][m][nn], b = acc[ai][1][m][nn];
                        o1[nn][0] = (a[0] * ta[0] - b[0] * ta[1]) * sc; o2[nn][0] = (a[0] * ta[1] + b[0] * ta[0]) * sc;
                        o1[nn][1] = (a[1] * ta[2] - b[1] * ta[3]) * sc; o2[nn][1] = (a[1] * ta[3] + b[1] * ta[2]) * sc;
                        o1[nn][2] = (a[2] * tb[0] - b[2] * tb[1]) * sc; o2[nn][2] = (a[2] * tb[1] + b[2] * tb[0]) * sc;
                        o1[nn][3] = (a[3] * tb[2] - b[3] * tb[3]) * sc; o2[nn][3] = (a[3] * tb[3] + b[3] * tb[2]) * sc; }
                    bf16_t* rowp = isk ? base + (size_t)r * 1024 : q + ((size_t)(r >> 7) * 4 + h) * 32768 + ((wc * 4 + fq) * 128 + n) * 8;
                    *(u32x4*)(rowp) = pack8(o1[0], o1[1]); *(u32x4*)(rowp + (isk ? HALF : 16384)) = pack8(o2[0], o2[1]);
                    asm volatile("" ::: "memory"); }
        } else {
            const bool isg = un.pn >= 16;
            bf16_t* base = (isg ? g : v) + ((un.pn - 8) & 7) * BM + wc * 32 + 8 * fq;
#pragma unroll
            for (int ai = 0; ai < 2; ++ai)
#pragma unroll
                for (int m = 0; m < 4; ++m) { bf16_t* rowp = base + (size_t)(row0 + ai * HALF + m * 16) * 2048;
#pragma unroll
                    for (int bj = 0; bj < 2; ++bj) { f32x4 v0 = acc[ai][bj][m][0], v1 = acc[ai][bj][m][1];
                        if (isg) {
#pragma unroll
                            for (int e = 0; e < 4; ++e) { v0[e] = fsilu(v0[e]); v1[e] = fsilu(v1[e]); } }
                        *(u32x4*)(rowp + bj * HALF) = pack8(v0, v1); } }
        }
    }
};
struct EpiGates {
    static constexpr bool PERM = true, AFTER_DRAIN = false;
    const float* bm; bf16_t* gates;
    __device__ __forceinline__ void operator()(const f32x4 (&acc)[2][2][4][2], const Unit& un, int wr, int wc, int fr, int fq) const {
        const int row0 = un.pm * BM + wr * 64 + fr, col0 = un.pn * BM + wc * 32 + 8 * fq;
        f32x4 bv[2][2];
#pragma unroll
        for (int bj = 0; bj < 2; ++bj)
#pragma unroll
            for (int n = 0; n < 2; ++n) bv[bj][n] = *(const f32x4*)(bm + col0 + bj * HALF + 4 * n);
#pragma unroll
        for (int ai = 0; ai < 2; ++ai)
#pragma unroll
            for (int m = 0; m < 4; ++m) { bf16_t* rowp = gates + (size_t)(row0 + ai * HALF + m * 16) * 2048 + col0;
#pragma unroll
                for (int bj = 0; bj < 2; ++bj) { f32x4 v0 = acc[ai][bj][m][0] + bv[bj][0], v1 = acc[ai][bj][m][1] + bv[bj][1];
#pragma unroll
                    for (int e = 0; e < 4; ++e) { v0[e] = fsig(v0[e]); v1[e] = fsig(v1[e]); }
                    *(u32x4*)(rowp + bj * HALF) = pack8(v0, v1); } }
    }
};
template <int MODE> struct EpiMerge {
    static constexpr bool PERM = true, AFTER_DRAIN = false;
    const bf16_t* gates; const bf16_t* m1in; bf16_t* o;
    __device__ __forceinline__ void operator()(const f32x4 (&acc)[2][2][4][2], const Unit& un, int wr, int wc, int fr, int fq) const {
        const int row0 = un.pm * BM + wr * 64 + fr, col0 = un.pn * BM + wc * 32 + 8 * fq;
#pragma unroll
        for (int ai = 0; ai < 2; ++ai)
#pragma unroll
            for (int m = 0; m < 4; ++m) { const size_t r = (size_t)(row0 + ai * HALF + m * 16);
#pragma unroll
                for (int bj = 0; bj < 2; ++bj) { const int c = col0 + bj * HALF;
                    f32x4 g0, g1; unpack8(*(const u32x4*)(gates + r * 2048 + MODE * 1024 + c), g0, g1);
                    f32x4 v0 = acc[ai][bj][m][0] * g0, v1 = acc[ai][bj][m][1] * g1;
                    if (MODE == 1) { f32x4 p0, p1; unpack8(*(const u32x4*)(m1in + r * 1024 + c), p0, p1); v0 += p0; v1 += p1; }
                    *(u32x4*)(o + r * 1024 + c) = pack8(v0, v1); } }
    }
};
struct EpiOut {
    static constexpr bool PERM = true, AFTER_DRAIN = false;
    const float* x; bf16_t* y; float alpha;
    __device__ __forceinline__ void operator()(const f32x4 (&acc)[2][2][4][2], const Unit& un, int wr, int wc, int fr, int fq) const {
        const int row0 = un.pm * BM + wr * 64 + fr, col0 = un.pn * BM + wc * 32 + 8 * fq;
#pragma unroll
        for (int ai = 0; ai < 2; ++ai)
#pragma unroll
            for (int m = 0; m < 4; ++m) { const size_t off = (size_t)(row0 + ai * HALF + m * 16) * 1024 + col0;
#pragma unroll
                for (int bj = 0; bj < 2; ++bj) { const f32x4 x0 = *(const f32x4*)(x + off + bj * HALF), x1 = *(const f32x4*)(x + off + bj * HALF + 4);
                    *(u32x4*)(y + off + bj * HALF) = pack8(x0 * alpha + acc[ai][bj][m][0], x1 * alpha + acc[ai][bj][m][1]); } }
    }
};
struct MoeTab { int tileStart[33]; int cnt[32]; int pad_[3]; int tileExp[320]; };
__device__ __forceinline__ void moe_build_tab(PG8_LAS MoeTab* tab, const int* cnt) {
    if (threadIdx.x == 0) { int t = 0; for (int e = 0; e < 32; ++e) { const int c = cnt[e * 64], nt = (c + 255) >> 8; tab->tileStart[e] = t; tab->cnt[e] = c; for (int i = 0; i < nt; ++i) tab->tileExp[t + i] = e; t += nt; } tab->tileStart[32] = t; }
    __syncthreads();
}
template <bool GATHER> struct MoeOrder {
    int U, G, c; const PG8_LAS MoeTab* tab; const int* list;
    __device__ __forceinline__ bool next(int i, Unit& u) const {
        const long L = (long)i * G + c; if (L >= U) return false;
        int wgid = (int)L; { const int q = U / NXCD, r = U % NXCD, xcd = wgid % NXCD, off = wgid / NXCD; wgid = (xcd < r ? xcd * (q + 1) : r * (q + 1) + (xcd - r) * q) + off; }
        u.pm = wgid >> 2; u.pn = tab->tileExp[u.pm] * 4 + (wgid & 3); return true;
    }
    __device__ __forceinline__ void a_ready(const Unit&) const {}
    __device__ __forceinline__ void done(const Unit&) const {}
    __device__ __forceinline__ const char* a_base(const Gemm& g, const Unit& u) const { return GATHER ? (const char*)g.A : (const char*)g.A + (size_t)u.pm * (size_t)(BM * g.K * 2); }
    __device__ __forceinline__ void a_off(const Gemm& g, const Unit& u, const int (&R)[2], const int (&C)[2], unsigned (&v)[2][2]) const {
        if (!GATHER) { _Pragma("unroll") for (int hh = 0; hh < 2; ++hh) _Pragma("unroll") for (int i = 0; i < 2; ++i) v[hh][i] = (unsigned)((hh * HALF + R[i]) * g.K + C[i]) * 2u; }
        else { const int e = u.pn >> 2, base = (u.pm - tab->tileStart[e]) * BM, ce = tab->cnt[e];
            _Pragma("unroll") for (int hh = 0; hh < 2; ++hh) _Pragma("unroll") for (int i = 0; i < 2; ++i) { const int lr = base + hh * HALF + R[i]; const int tok = (lr < ce) ? (list[e * 32768 + lr] >> 1) : 0; v[hh][i] = (unsigned)(tok * g.K + C[i]) * 2u; } }
    }
};
struct EpiSwiGLU {
    static constexpr bool PERM = true, AFTER_DRAIN = false;
    bf16_t* h;
    __device__ __forceinline__ void operator()(const f32x4 (&acc)[2][2][4][2], const Unit& un, int wr, int wc, int fr, int fq) const {
        const int row0 = un.pm * BM + wr * 64 + fr, col0 = (un.pn & 3) * 128 + wc * 32 + 8 * fq;
#pragma unroll
        for (int ai = 0; ai < 2; ++ai)
#pragma unroll
            for (int m = 0; m < 4; ++m) { f32x4 v0, v1;
#pragma unroll
                for (int e = 0; e < 4; ++e) { v0[e] = fsilu(acc[ai][0][m][0][e]) * acc[ai][1][m][0][e]; v1[e] = fsilu(acc[ai][0][m][1][e]) * acc[ai][1][m][1][e]; }
                *(u32x4*)(h + (size_t)(row0 + ai * HALF + m * 16) * 512 + col0) = pack8(v0, v1); }
    }
};
struct EpiMoeOut {
    static constexpr bool PERM = true, AFTER_DRAIN = false;
    const PG8_LAS MoeTab* tab; const int* list; const float* rw; bf16_t* ys;
    __device__ __forceinline__ void operator()(const f32x4 (&acc)[2][2][4][2], const Unit& un, int wr, int wc, int fr, int fq) const {
        const int e = un.pn >> 2, lrow0 = (un.pm - tab->tileStart[e]) * BM + wr * 64 + fr, ce = tab->cnt[e], col0 = (un.pn & 3) * BM + wc * 32 + 8 * fq;
        int slot[8]; float wgt[8];
#pragma unroll
        for (int i = 0; i < 8; ++i) { const int lr = lrow0 + (i >> 2) * HALF + (i & 3) * 16; slot[i] = (lr < ce) ? list[e * 32768 + lr] : -1; }
#pragma unroll
        for (int i = 0; i < 8; ++i) wgt[i] = (slot[i] >= 0) ? rw[slot[i]] : 0.f;
#pragma unroll
        for (int ai = 0; ai < 2; ++ai)
#pragma unroll
            for (int m = 0; m < 4; ++m) { const int i = ai * 4 + m;
                if (slot[i] >= 0) { const float w = wgt[i]; bf16_t* rowp = ys + (size_t)slot[i] * 1024 + col0;
#pragma unroll
                    for (int bj = 0; bj < 2; ++bj) *(u32x4*)(rowp + bj * HALF) = pack8(acc[ai][bj][m][0] * w, acc[ai][bj][m][1] * w); } }
    }
};

__device__ __forceinline__ float clamp448(float v) { return fminf(fmaxf(v, -448.f), 448.f); }
__device__ __forceinline__ unsigned pk4_fp8(float a, float b, float c, float d) { int p = __builtin_amdgcn_cvt_pk_fp8_f32(clamp448(a), clamp448(b), 0, false); p = __builtin_amdgcn_cvt_pk_fp8_f32(clamp448(c), clamp448(d), p, true); return (unsigned)p; }
constexpr float FP8_SX = 4.f, FP8_SW = 64.f, FP8_SH = 8.f;
struct EpiSwiGLU8 {
    static constexpr bool PERM = true, AFTER_DRAIN = false;
    unsigned char* h;
    __device__ __forceinline__ void operator()(const f32x4 (&acc)[2][2][4][2], const Unit& un, int wr, int wc, int fr, int fq) const {
        const int row0 = un.pm * BM + wr * 64 + fr, col0 = (un.pn & 3) * 128 + wc * 32 + 8 * fq; const float ds = 1.f / (FP8_SX * FP8_SW);
#pragma unroll
        for (int ai = 0; ai < 2; ++ai)
#pragma unroll
            for (int m = 0; m < 4; ++m) { float v[8];
#pragma unroll
                for (int e = 0; e < 4; ++e) { v[e] = FP8_SH * fsilu(acc[ai][0][m][0][e] * ds) * (acc[ai][1][m][0][e] * ds); v[4 + e] = FP8_SH * fsilu(acc[ai][0][m][1][e] * ds) * (acc[ai][1][m][1][e] * ds); }
                uint2 o; o.x = pk4_fp8(v[0], v[1], v[2], v[3]); o.y = pk4_fp8(v[4], v[5], v[6], v[7]);
                *(uint2*)(h + (size_t)(row0 + ai * HALF + m * 16) * 512 + col0) = o; }
    }
};
struct EpiMoeOut8 {
    static constexpr bool PERM = true, AFTER_DRAIN = false;
    const PG8_LAS MoeTab* tab; const int* list; const float* rw; bf16_t* ys;
    __device__ __forceinline__ void operator()(const f32x4 (&acc)[2][2][4][2], const Unit& un, int wr, int wc, int fr, int fq) const {
        const int e = un.pn >> 2, lrow0 = (un.pm - tab->tileStart[e]) * BM + wr * 64 + fr, ce = tab->cnt[e], col0 = (un.pn & 3) * BM + wc * 32 + 8 * fq;
#pragma unroll
        for (int ai = 0; ai < 2; ++ai)
#pragma unroll
            for (int m = 0; m < 4; ++m) { const int lr = lrow0 + ai * HALF + m * 16;
                if (lr < ce) { const int slot = list[e * 32768 + lr]; const float w = rw[slot] * (1.f / (FP8_SH * FP8_SW)); bf16_t* rowp = ys + (size_t)slot * 1024 + col0;
#pragma unroll
                    for (int bj = 0; bj < 2; ++bj) *(u32x4*)(rowp + bj * HALF) = pack8(acc[ai][bj][m][0] * w, acc[ai][bj][m][1] * w); }
                asm volatile("" ::: "memory"); }
    }
};
}

DEV unsigned pk2(float lo, float hi) { return (unsigned)f2bf(lo) | ((unsigned)f2bf(hi) << 16); }
typedef unsigned v4u __attribute__((ext_vector_type(4)));
DEV void transpose_item(const float* W, int K, int N, bf16_t* WT, int row_off, float* scr, int item, int lane) {
    const int nblk = N / 32, kb = item / nblk, nb = item % nblk, k0 = 64 * kb, n0 = 32 * nb;
    float wv[32];
#pragma unroll
    for (int i = 0; i < 32; ++i) wv[i] = W[(size_t)(k0 + 2 * i + (lane >> 5)) * N + n0 + (lane & 31)];
#pragma unroll
    for (int i = 0; i < 32; ++i) scr[(2 * i + (lane >> 5)) * 33 + (lane & 31)] = wv[i];
    asm volatile("s_waitcnt lgkmcnt(0)" ::: "memory");
    const int c = lane & 7;
#pragma unroll
    for (int j = 0; j < 4; ++j) { const int n = (lane >> 3) + 8 * j; const float* s = scr + (8 * c) * 33 + n;
        v4u o; o.x = pk2(s[0 * 33], s[1 * 33]); o.y = pk2(s[2 * 33], s[3 * 33]); o.z = pk2(s[4 * 33], s[5 * 33]); o.w = pk2(s[6 * 33], s[7 * 33]);
        *(v4u*)(WT + (size_t)(row_off + n0 + n) * K + k0 + 8 * c) = o; }
    asm volatile("s_waitcnt lgkmcnt(0)" ::: "memory");
}
DEV void p_weights(float* lds, const float* w_in, const float* w_ret_o, const float* w_lru_o, const float* w_out, const float* w_rg_r, const float* w_rg_i, bf16_t* w_in_t, bf16_t* w_ro_t, bf16_t* w_lo_t, bf16_t* w_out_t, bf16_t* wrg_t) {
    const int wave = threadIdx.x >> 6, lane = threadIdx.x & 63;
    float* scr = lds + wave * 2304;
    constexpr int I0 = 16 * (WIN_N / 32), I1 = 32 * 32, I2 = 24 * 32, I3 = 16 * 32, I4 = 16 * 18;
    for (int it = blockIdx.x * 8 + wave; it < I0 + I1 + I2 + I3 + I4; it += gridDim.x * 8) {
        int r = it;
        if (r < I0) { transpose_item(w_in, 1024, WIN_N, w_in_t, 0, scr, r, lane); continue; } r -= I0;
        if (r < I1) { transpose_item(w_ret_o, 2048, 1024, w_ro_t, 0, scr, r, lane); continue; } r -= I1;
        if (r < I2) { transpose_item(w_lru_o, 1536, 1024, w_lo_t, 0, scr, r, lane); continue; } r -= I2;
        if (r < I3) { transpose_item(w_out, 1024, 1024, w_out_t, 0, scr, r, lane); continue; } r -= I3;
        { const int mi = r / 18, sub = r - mi * 18; const float* W = (mi < 8 ? w_rg_r + (size_t)mi * 192 * 192 : w_rg_i + (size_t)(mi - 8) * 192 * 192);
          transpose_item(W, 192, 192, wrg_t + (size_t)mi * 192 * 192, 0, scr, sub, lane); }
    }
}


DEV void transpose_item_fp8(const float* W, int K, int N, unsigned char* WT, int row_off, float scale, float* scr, int item, int lane) {
    const int nblk = N / 32, kb = item / nblk, nb = item % nblk, k0 = 64 * kb, n0 = 32 * nb;
    float wv[32];
#pragma unroll
    for (int i = 0; i < 32; ++i) wv[i] = W[(size_t)(k0 + 2 * i + (lane >> 5)) * N + n0 + (lane & 31)];
#pragma unroll
    for (int i = 0; i < 32; ++i) scr[(2 * i + (lane >> 5)) * 33 + (lane & 31)] = wv[i] * scale;
    asm volatile("s_waitcnt lgkmcnt(0)" ::: "memory");
    const int c = lane & 3;
#pragma unroll
    for (int j = 0; j < 2; ++j) { const int n = (lane >> 2) + 16 * j; const float* s = scr + (16 * c) * 33 + n;
        v4u o; o.x = pg8::pk4_fp8(s[0 * 33], s[1 * 33], s[2 * 33], s[3 * 33]); o.y = pg8::pk4_fp8(s[4 * 33], s[5 * 33], s[6 * 33], s[7 * 33]);
        o.z = pg8::pk4_fp8(s[8 * 33], s[9 * 33], s[10 * 33], s[11 * 33]); o.w = pg8::pk4_fp8(s[12 * 33], s[13 * 33], s[14 * 33], s[15 * 33]);
        *(v4u*)(WT + (size_t)(row_off + n0 + n) * K + k0 + 16 * c) = o; }
    asm volatile("s_waitcnt lgkmcnt(0)" ::: "memory");
}
DEV void p_expert_weights(float* lds, const float* w_eg, const float* w_eu, const float* w_ed, unsigned char* wgu8, unsigned char* wd8) {
    const int wave = threadIdx.x >> 6, lane = threadIdx.x & 63;
    float* scr = lds + wave * 2304;
    for (int it = blockIdx.x * 8 + wave; it < 3 * 8192; it += gridDim.x * 8) {
        const int kind = it >> 13, r = it & 8191, e = r >> 8, sub = r & 255;
        if (kind < 2) { const int nb = sub & 15; transpose_item_fp8((kind ? w_eu : w_eg) + (size_t)e * 1024 * 512, 1024, 512, wgu8 + (size_t)e * 1024 * 1024, (nb >> 2) * 128 + kind * 128, pg8::FP8_SW, scr, sub, lane); }
        else transpose_item_fp8(w_ed + (size_t)e * 512 * 1024, 512, 1024, wd8 + (size_t)e * 1024 * 512, 0, pg8::FP8_SW, scr, sub, lane);
    }
}

DEV void p_router_consts(float* lds, const float* g1, const float* b1, const float* wg, const float* bg, const float* we, const float* be, float* sb) {
    if (blockIdx.x != 0) return;
    const int t = threadIdx.x, wv = t >> 6, lane = t & 63;
    float s[36], q[36];
#pragma unroll
    for (int c = 0; c < 36; ++c) { s[c] = 0.f; q[c] = 0.f; }
#pragma unroll
    for (int kk = 0; kk < 2; ++kk) { const int k = t + 512 * kk; const float gk = g1[k], bk = b1[k];
#pragma unroll
        for (int c4 = 0; c4 < 9; ++c4) { const float4 w = (c4 < 8) ? *(const float4*)(we + (size_t)k * 32 + c4 * 4) : *(const float4*)(wg + (size_t)k * 4);
            s[4 * c4] += gk * w.x; s[4 * c4 + 1] += gk * w.y; s[4 * c4 + 2] += gk * w.z; s[4 * c4 + 3] += gk * w.w;
            q[4 * c4] += bk * w.x; q[4 * c4 + 1] += bk * w.y; q[4 * c4 + 2] += bk * w.z; q[4 * c4 + 3] += bk * w.w; } }
#pragma unroll
    for (int m = 1; m < 64; m <<= 1) {
#pragma unroll
        for (int c = 0; c < 36; ++c) { s[c] += __shfl_xor(s[c], m); q[c] += __shfl_xor(q[c], m); } }
    if (lane == 0) {
#pragma unroll
        for (int c = 0; c < 36; ++c) { lds[wv * 96 + c] = s[c]; lds[wv * 96 + 48 + c] = q[c]; } }
    __syncthreads();
    if (t < 96) { const int cc = t % 48; float v = 0.f;
        if (cc < 36) { for (int p = 0; p < 8; ++p) v += lds[p * 96 + t]; if (t >= 48) v += (cc < 32) ? be[cc] : bg[cc - 32]; }
        sb[t] = v; }
    __syncthreads();
}
DEV void p_cvt_x(const float* x, bf16_t* xb) {
    const size_t n4 = (size_t)NTOK * DM / 4, stride = (size_t)gridDim.x * NTHR;
    for (size_t i0 = (size_t)blockIdx.x * NTHR + threadIdx.x; i0 < n4; i0 += 8 * stride) {
        float4 t[8];
#pragma unroll
        for (int u = 0; u < 8; ++u) { const size_t i = i0 + u * stride; t[u] = (i < n4) ? ((const float4*)x)[i] : make_float4(0.f, 0.f, 0.f, 0.f); }
#pragma unroll
        for (int u = 0; u < 8; ++u) { const size_t i = i0 + u * stride; if (i < n4) { uint2 o; o.x = pg8::cvt_pk_bf16(t[u].x, t[u].y); o.y = pg8::cvt_pk_bf16(t[u].z, t[u].w); ((uint2*)xb)[i] = o; } }
    }
}
DEV void p_rope_table(float2* tab) {
    for (int i = blockIdx.x * NTHR + threadIdx.x; i < 8192 * 128; i += gridDim.x * NTHR) {
        const int s = i >> 7, j = i & 127;
        const double r = 0.93057204092969897;
        double inv = 1.0; for (int t = 0; t < j; ++t) inv *= r;
        const double ang = (double)s * inv;
        const double twopi_hi = 6.283185307179586232, twopi_lo = 2.4492935982947064e-16;
        const double n = rint(ang / twopi_hi);
        const double x = (ang - n * twopi_hi) - n * twopi_lo;
        const double x2 = x * x;
        double acc = 1.0 - x2 * (1.0 / (22.0 * 23.0));
#pragma unroll
        for (int k = 21; k >= 3; k -= 2) acc = 1.0 - x2 * (1.0 / ((double)(k - 1) * (double)k)) * acc;
        double acc2 = 1.0 - x2 * (1.0 / (21.0 * 22.0));
#pragma unroll
        for (int k = 20; k >= 2; k -= 2) acc2 = 1.0 - x2 * (1.0 / ((double)(k - 1) * (double)k)) * acc2;
        tab[i] = make_float2((float)acc2, (float)(x * acc));
    }
}

typedef short bf16x8_t __attribute__((ext_vector_type(8)));
typedef float f32x4_t __attribute__((ext_vector_type(4)));
typedef short s16x4_t __attribute__((ext_vector_type(4)));
typedef unsigned u32x4_t __attribute__((ext_vector_type(4)));
constexpr int LRU_ROWB = 400;
DEV void p_lru_compute(unsigned char* lds, const bf16_t* ulru, const float* cw, const float* cb, const bf16_t* wrg_t,
                       const float* b_r, const float* b_i, const float* lam, bf16_t* epsb, bf16_t* xinb, float* segA, float* segH) {
    int tid_ = threadIdx.x; asm volatile("" : "+v"(tid_));
    const int tid = tid_, wave = tid >> 6, lane = tid & 63, fr = lane & 15, fq = lane >> 4, wr = wave >> 2, wc = wave & 3;
    unsigned char* stg = lds + 256 * LRU_ROWB + wave * 4096;
    for (int item = blockIdx.x; item < 1024; item += gridDim.x) {
        const int n = item & 7, b = (item >> 3) & 3, seg = item >> 5;
        const size_t t0 = (size_t)b * SEQ + seg * 256;
#pragma unroll 4
        for (int idx = tid; idx < 256 * 24; idx += NTHR) {
            const int r = idx / 24, c8 = idx - r * 24, ch0 = n * 192 + c8 * 8;
            float acc[8];
            { const float4 c0 = *(const float4*)(cb + ch0), c1 = *(const float4*)(cb + ch0 + 4); acc[0] = c0.x; acc[1] = c0.y; acc[2] = c0.z; acc[3] = c0.w; acc[4] = c1.x; acc[5] = c1.y; acc[6] = c1.z; acc[7] = c1.w; }
#pragma unroll
            for (int j = 0; j < 4; ++j) {
                if (seg * 256 + r - 3 + j >= 0) {
                    const uint4 uv = *(const uint4*)(ulru + (t0 + r - 3 + j) * 1536 + ch0);
                    const float4 w0 = *(const float4*)(cw + j * 1536 + ch0), w1 = *(const float4*)(cw + j * 1536 + ch0 + 4);
                    acc[0] += w0.x * __uint_as_float(uv.x << 16); acc[1] += w0.y * __uint_as_float(uv.x & 0xffff0000u);
                    acc[2] += w0.z * __uint_as_float(uv.y << 16); acc[3] += w0.w * __uint_as_float(uv.y & 0xffff0000u);
                    acc[4] += w1.x * __uint_as_float(uv.z << 16); acc[5] += w1.y * __uint_as_float(uv.z & 0xffff0000u);
                    acc[6] += w1.z * __uint_as_float(uv.w << 16); acc[7] += w1.w * __uint_as_float(uv.w & 0xffff0000u);
                }
            }
            uint4 o; o.x = pg8::cvt_pk_bf16(acc[0], acc[1]); o.y = pg8::cvt_pk_bf16(acc[2], acc[3]); o.z = pg8::cvt_pk_bf16(acc[4], acc[5]); o.w = pg8::cvt_pk_bf16(acc[6], acc[7]);
            *(uint4*)(lds + r * LRU_ROWB + c8 * 16) = o;
        }
        __syncthreads();
        float cbr[3], cbi[3], csp[3], hrun[3], atot[3];
        const int sub = seg * 2 + wr;
#pragma unroll
        for (int tc = 0; tc < 3; ++tc) { const int ch = n * 192 + 48 * wc + 16 * tc + fr; cbr[tc] = b_r[ch]; cbi[tc] = b_i[ch]; csp[tc] = 8.f * 1.4426950408889634f * log1pf(__expf(-lam[ch])); atot[tc] = 1.f; hrun[tc] = 0.f; }
        const bf16_t* wrb = wrg_t + ((size_t)n * 192 + 48 * wc + fr) * 192 + fq * 8;
        const bf16_t* wib = wrb + (size_t)8 * 192 * 192;
#pragma unroll
        for (int tc = 0; tc < 3; ++tc) {
            bf16x8_t bfr[6][2];
#pragma unroll
            for (int ks = 0; ks < 6; ++ks) { bfr[ks][0] = *(const bf16x8_t*)(wrb + tc * 16 * 192 + ks * 32); bfr[ks][1] = *(const bf16x8_t*)(wib + tc * 16 * 192 + ks * 32); }
#pragma unroll
            for (int p = 0; p < 2; ++p) {
                const int rowb = 128 * wr + 64 * p;
                f32x4_t acc[4][2];
#pragma unroll
                for (int m = 0; m < 4; ++m) { acc[m][0] = (f32x4_t){0.f, 0.f, 0.f, 0.f}; acc[m][1] = (f32x4_t){0.f, 0.f, 0.f, 0.f}; }
#pragma unroll
                for (int ks = 0; ks < 6; ++ks) {
                    bf16x8_t afr[4];
#pragma unroll
                    for (int m = 0; m < 4; ++m) afr[m] = *(const bf16x8_t*)(lds + (rowb + 16 * (fr >> 2) + 4 * m + (fr & 3)) * LRU_ROWB + ks * 64 + fq * 16);
#pragma unroll
                    for (int m = 0; m < 4; ++m) { acc[m][0] = __builtin_amdgcn_mfma_f32_16x16x32_bf16(afr[m], bfr[ks][0], acc[m][0], 0, 0, 0); acc[m][1] = __builtin_amdgcn_mfma_f32_16x16x32_bf16(afr[m], bfr[ks][1], acc[m][1], 0, 0, 0); }
                }
                const int coff = (48 * wc + 16 * tc + fr) * 2;
                const unsigned char* up = lds + (rowb + 16 * fq) * LRU_ROWB + coff;
                float Al = 1.f, Bl = 0.f;
                unsigned pe[8], px[8];
#pragma unroll
                for (int m = 0; m < 4; ++m) {
                    float ee[4], xx[4];
#pragma unroll
                    for (int j = 0; j < 4; ++j) {
                        const float rr = pg8::fsig(acc[m][0][j] + cbr[tc]), ii = pg8::fsig(acc[m][1][j] + cbi[tc]);
                        const float aa = __builtin_amdgcn_exp2f(-csp[tc] * rr);
                        const float u = bf2f(*(const bf16_t*)(up + (4 * m + j) * LRU_ROWB));
                        const float om = 1.f - aa;
                        const float x = __builtin_amdgcn_sqrtf(fmaxf(om * (1.f + aa), 0.f)) * ii * u;
                        ee[j] = om; xx[j] = x; Bl = aa * Bl + x; Al *= aa;
                    }
                    pe[2 * m] = pg8::cvt_pk_bf16(ee[0], ee[1]); pe[2 * m + 1] = pg8::cvt_pk_bf16(ee[2], ee[3]);
                    px[2 * m] = pg8::cvt_pk_bf16(xx[0], xx[1]); px[2 * m + 1] = pg8::cvt_pk_bf16(xx[2], xx[3]);
                }
                { float h = hrun[tc], ap = 1.f;
#pragma unroll
                  for (int q = 0; q < 4; ++q) { const float Aq = __shfl(Al, fr + 16 * q), Bq = __shfl(Bl, fr + 16 * q); h = Aq * h + Bq; ap *= Aq; }
                  hrun[tc] = h; atot[tc] *= ap; }
#pragma unroll
                for (int m = 0; m < 4; ++m)
#pragma unroll
                    for (int j = 0; j < 4; ++j) { const int tk = 16 * fq + 4 * m + j; const unsigned we = pe[2 * m + (j >> 1)], wx = px[2 * m + (j >> 1)];
                        *(bf16_t*)(stg + tk * 32 + fr * 2) = (bf16_t)((j & 1) ? (we >> 16) : (we & 0xffff));
                        *(bf16_t*)(stg + 2048 + tk * 32 + fr * 2) = (bf16_t)((j & 1) ? (wx >> 16) : (wx & 0xffff)); }
                asm volatile("s_waitcnt lgkmcnt(0)" ::: "memory");
#pragma unroll
                for (int i = 0; i < 2; ++i) { const int piece = lane + 64 * i, tk = piece >> 1, hf = piece & 1;
                    const size_t go = (t0 + rowb + tk) * 1536 + n * 192 + 48 * wc + 16 * tc + 8 * hf;
                    *(u32x4_t*)(epsb + go) = *(const u32x4_t*)(stg + tk * 32 + hf * 16);
                    *(u32x4_t*)(xinb + go) = *(const u32x4_t*)(stg + 2048 + tk * 32 + hf * 16); }
                asm volatile("s_waitcnt lgkmcnt(0)" ::: "memory");
            }
        }
        if (fq == 0) {
#pragma unroll
            for (int tc = 0; tc < 3; ++tc) { const size_t o = ((size_t)b * 64 + sub) * 1536 + n * 192 + 48 * wc + 16 * tc + fr; segA[o] = atot[tc]; segH[o] = hrun[tc]; }
        }
        __syncthreads();
    }
}
DEV void p_lru_scan(const bf16_t* epsb, const bf16_t* xinb, bf16_t* gl, const float* carry) {
    const int tid = threadIdx.x;
    if (tid >= 384) return;
    for (int item = blockIdx.x; item < 256; item += gridDim.x) {
        const int b = item >> 6, sub = item & 63;
        const size_t base = ((size_t)b * SEQ + sub * 128) * 1536 + tid * 4;
        const float4 cin = *(const float4*)(carry + ((size_t)b * 64 + sub) * 1536 + tid * 4);
        float h0 = cin.x, h1 = cin.y, h2 = cin.z, h3 = cin.w;
#pragma unroll 8
        for (int t = 0; t < 128; ++t) {
            const size_t o = base + (size_t)t * 1536;
            const uint2 ev = *(const uint2*)(epsb + o), xv = *(const uint2*)(xinb + o), gv = *(const uint2*)(gl + o);
            h0 = (1.f - __uint_as_float(ev.x << 16)) * h0 + __uint_as_float(xv.x << 16);
            h1 = (1.f - __uint_as_float(ev.x & 0xffff0000u)) * h1 + __uint_as_float(xv.x & 0xffff0000u);
            h2 = (1.f - __uint_as_float(ev.y << 16)) * h2 + __uint_as_float(xv.y << 16);
            h3 = (1.f - __uint_as_float(ev.y & 0xffff0000u)) * h3 + __uint_as_float(xv.y & 0xffff0000u);
            uint2 ov; ov.x = pg8::cvt_pk_bf16(h0 * __uint_as_float(gv.x << 16), h1 * __uint_as_float(gv.x & 0xffff0000u)); ov.y = pg8::cvt_pk_bf16(h2 * __uint_as_float(gv.y << 16), h3 * __uint_as_float(gv.y & 0xffff0000u));
            *(uint2*)(gl + o) = ov;
        }
    }
}
DEV void p_lru_carry(float* lds, const float* segA, const float* segH, float* carry) {
    float* tA = lds; float* tH = lds + 64 * 65;
    for (int item = blockIdx.x; item < 96; item += gridDim.x) {
        const int b = item / 24, c0 = (item % 24) * 64;
        for (int i = threadIdx.x; i < 64 * 64; i += NTHR) { const int s = i >> 6, c = i & 63; const size_t o = ((size_t)b * 64 + s) * 1536 + c0 + c; tA[s * 65 + c] = segA[o]; tH[s * 65 + c] = segH[o]; }
        __syncthreads();
        if (threadIdx.x < 64) { const int c = threadIdx.x; float h = 0.f;
            for (int s = 0; s < 64; ++s) { const float a = tA[s * 65 + c], hh = tH[s * 65 + c]; tA[s * 65 + c] = h; h = a * h + hh; } }
        __syncthreads();
        for (int i = threadIdx.x; i < 64 * 64; i += NTHR) { const int s = i >> 6, c = i & 63; carry[((size_t)b * 64 + s) * 1536 + c0 + c] = tA[s * 65 + c]; }
        __syncthreads();
    }
}
#define LDS_BARRIER() do { asm volatile("s_waitcnt lgkmcnt(0)" ::: "memory"); __builtin_amdgcn_s_barrier(); asm volatile("" ::: "memory"); } while (0)
DEV void p_scores(unsigned char* lds, const bf16_t* q, const bf16_t* k, bf16_t* P) {
    int tid_ = threadIdx.x; asm volatile("" : "+v"(tid_));
    const int tid = tid_, w = tid >> 6, lane = tid & 63, fr = lane & 15, fq = lane >> 4;
    const int krow = tid >> 5, kch = tid & 31;
    u32x4_t kreg[8]; bf16x8_t qa[8];
    int g = blockIdx.x;
    if (g < 1024) { const int c = g & 63, bh = g >> 6, b = bh >> 2, h = bh & 3; const size_t tok0 = (size_t)b * SEQ + c * 128;
        const bf16_t* kc = k + tok0 * 1024 + h * 256;
#pragma unroll
        for (int ii = 0; ii < 8; ++ii) kreg[ii] = *(const u32x4_t*)(kc + (size_t)(krow + 16 * ii) * 1024 + kch * 8);
        const bf16_t* qp = q + ((tok0 >> 7) * 4 + h) * 32768 + (fq * 128 + 16 * w + fr) * 8;
#pragma unroll
        for (int ks = 0; ks < 8; ++ks) qa[ks] = *(const bf16x8_t*)(qp + ks * 4096); }
    for (; g < 1024; g += gridDim.x) {
#pragma unroll
        for (int ii = 0; ii < 8; ++ii) *(u32x4_t*)(lds + (krow + 16 * ii) * 528 + kch * 16) = kreg[ii];
        bf16x8_t qc[8];
#pragma unroll
        for (int ks = 0; ks < 8; ++ks) qc[ks] = qa[ks];
        const int gn = g + gridDim.x;
        if (gn < 1024) { const int c = gn & 63, bh = gn >> 6, b = bh >> 2, h = bh & 3; const size_t tok0 = (size_t)b * SEQ + c * 128;
            const bf16_t* kc = k + tok0 * 1024 + h * 256;
#pragma unroll
            for (int ii = 0; ii < 8; ++ii) kreg[ii] = *(const u32x4_t*)(kc + (size_t)(krow + 16 * ii) * 1024 + kch * 8);
            const bf16_t* qp = q + ((tok0 >> 7) * 4 + h) * 32768 + (fq * 128 + 16 * w + fr) * 8;
#pragma unroll
            for (int ks = 0; ks < 8; ++ks) qa[ks] = *(const bf16x8_t*)(qp + ks * 4096); }
        LDS_BARRIER();
        f32x4_t acc[8];
#pragma unroll
        for (int nt = 0; nt < 8; ++nt) acc[nt] = (f32x4_t){0.f, 0.f, 0.f, 0.f};
#pragma unroll
        for (int ks = 0; ks < 8; ++ks)
#pragma unroll
            for (int nt = 0; nt < 8; ++nt) { const bf16x8_t bb = *(const bf16x8_t*)(lds + (16 * nt + fr) * 528 + ks * 64 + fq * 16); acc[nt] = __builtin_amdgcn_mfma_f32_16x16x32_bf16(bb, qc[ks], acc[nt], 0, 0, 0); }
        {
            const int c = g & 63, bh = g >> 6, b = bh >> 2, h = bh & 3;
            bf16_t* kt = const_cast<bf16_t*>(k) + ((size_t)b * SEQ + c * 128 + fq * 8 + w) * 1024 + h * 256 + fr * 8;
#pragma unroll
            for (int ks = 0; ks < 4; ++ks)
#pragma unroll
                for (int di = 0; di < 2; ++di) {
                    const unsigned char* kp = lds + (32 * ks + 8 * fq + (fr >> 2)) * 528 + (16 * (2 * w + di) + 4 * (fr & 3)) * 2;
                    const s16x4_t t0 = __builtin_amdgcn_ds_read_tr16_b64_v4i16((LAS s16x4_t*)(kp));
                    const s16x4_t t1 = __builtin_amdgcn_ds_read_tr16_b64_v4i16((LAS s16x4_t*)(kp + 4 * 528));
                    *(bf16x8_t*)(kt + ks * 32768 + di * 128) = (bf16x8_t){t0[0], t0[1], t0[2], t0[3], t1[0], t1[1], t1[2], t1[3]};
                }
        }
        LDS_BARRIER();
        bf16_t* Pg = P + (size_t)g * 16384 + ((fq >> 1) * 128 + 16 * w + fr) * 8 + 4 * (fq & 1);
        int mrow = 16 * w + fr - 4 * fq; asm volatile("" : "+v"(mrow));
#pragma unroll
        for (int nt = 0; nt < 8; ++nt) {
            uint2 o; o.x = pg8::cvt_pk_bf16((16 * nt <= mrow) ? acc[nt][0] : 0.f, (16 * nt + 1 <= mrow) ? acc[nt][1] : 0.f);
            o.y = pg8::cvt_pk_bf16((16 * nt + 2 <= mrow) ? acc[nt][2] : 0.f, (16 * nt + 3 <= mrow) ? acc[nt][3] : 0.f);
            *(uint2*)(Pg + ((nt >> 1) * 4 + 2 * (nt & 1)) * 1024) = o; }
    }
    __syncthreads();
}
constexpr int RT_KS = 528, RT_VS = 272, RT_V = 0, RT_U = 2 * 32 * RT_VS;
DEV void p_ret_mfma(unsigned char* lds, const bf16_t* q, const bf16_t* k, bf16_t* v, const bf16_t* P) {
    int tid_ = threadIdx.x; asm volatile("" : "+v"(tid_));
    const int tid = tid_, w = tid >> 6, lane = tid & 63, fr = lane & 15, fq = lane >> 4;
    for (int wk = blockIdx.x; wk < 256; wk += gridDim.x) {
        const int xcd = wk & 7, idx = wk >> 3, bh = xcd * 2 + (idx >> 4), sl = idx & 15, b = bh >> 2, h = bh & 3;
        float g128; { const double gam = 1.0 - exp2(-5.0 - (double)h); g128 = (float)exp2(128.0 * log2(gam)); }
        asm volatile("" : "+v"(g128));
        f32x4_t accU[2][2];
#pragma unroll
        for (int et = 0; et < 2; ++et)
#pragma unroll
            for (int di = 0; di < 2; ++di) accU[et][di] = (f32x4_t){0.f, 0.f, 0.f, 0.f};
        for (int i = tid; i < 32 * RT_KS / 4; i += NTHR) ((unsigned*)(lds + RT_U))[i] = 0u;
        const size_t tokb = (size_t)b * SEQ;
        const int vm = tid >> 2, ve = (tid & 3) * 8;
        const bf16_t* vsl = v + tokb * 2048 + h * 512 + sl * 32;
#define RT_STAGE_V(buf, vr) do { unsigned char* vp_ = lds + RT_V + (buf) * 32 * RT_VS + ve * RT_VS + vm * 2; \
            *(bf16_t*)(vp_ + 0 * RT_VS) = (bf16_t)((vr)[0] & 0xffff); *(bf16_t*)(vp_ + 1 * RT_VS) = (bf16_t)((vr)[0] >> 16); \
            *(bf16_t*)(vp_ + 2 * RT_VS) = (bf16_t)((vr)[1] & 0xffff); *(bf16_t*)(vp_ + 3 * RT_VS) = (bf16_t)((vr)[1] >> 16); \
            *(bf16_t*)(vp_ + 4 * RT_VS) = (bf16_t)((vr)[2] & 0xffff); *(bf16_t*)(vp_ + 5 * RT_VS) = (bf16_t)((vr)[2] >> 16); \
            *(bf16_t*)(vp_ + 6 * RT_VS) = (bf16_t)((vr)[3] & 0xffff); *(bf16_t*)(vp_ + 7 * RT_VS) = (bf16_t)((vr)[3] >> 16); } while (0)
        u32x4_t vreg = *(const u32x4_t*)(vsl + (size_t)vm * 2048 + ve);
        RT_STAGE_V(0, vreg);
        vreg = *(const u32x4_t*)(vsl + (size_t)(128 + vm) * 2048 + ve);
        bf16x8_t qa[8], pa[4], kb[2][4];
        const bf16_t* qp = q + ((tokb >> 7) * 4 + h) * 32768 + (fq * 128 + 16 * w + fr) * 8;
        const bf16_t* pp = P + (size_t)(bh * 64) * 16384 + (fq * 128 + 16 * w + fr) * 8;
        const bf16_t* kp = k + (tokb + fq * 8 + w) * 1024 + h * 256 + fr * 8;
        {
#pragma unroll
            for (int ks = 0; ks < 8; ++ks) qa[ks] = *(const bf16x8_t*)(qp + ks * 4096);
#pragma unroll
            for (int ks = 0; ks < 4; ++ks) { if (2 * ks <= w) pa[ks] = *(const bf16x8_t*)(pp + ks * 4096); else pa[ks] = (bf16x8_t){0, 0, 0, 0, 0, 0, 0, 0}; }
#pragma unroll
            for (int di = 0; di < 2; ++di)
#pragma unroll
                for (int ks = 0; ks < 4; ++ks) kb[di][ks] = *(const bf16x8_t*)(kp + ks * 32768 + di * 128);
        }
        LDS_BARRIER();
#pragma unroll 1
        for (int c = 0; c < 64; ++c) {
            const size_t tok0 = tokb + c * 128;
            const unsigned char* ldsU = lds + RT_U + (c & 1) * 32 * RT_KS;
            const unsigned char* ldsV = lds + RT_V + (c & 1) * 32 * RT_VS;
            f32x4_t ao[2] = {(f32x4_t){0.f, 0.f, 0.f, 0.f}, (f32x4_t){0.f, 0.f, 0.f, 0.f}};
            {
                bf16x8_t bu[8];
#pragma unroll
                for (int nt = 0; nt < 2; ++nt) {
#pragma unroll
                    for (int ks = 0; ks < 8; ++ks) bu[ks] = *(const bf16x8_t*)(ldsU + (16 * nt + fr) * RT_KS + ks * 64 + fq * 16);
#pragma unroll
                    for (int ks = 0; ks < 8; ++ks) ao[nt] = __builtin_amdgcn_mfma_f32_16x16x32_bf16(bu[ks], qa[ks], ao[nt], 0, 0, 0);
                }
            }
            bf16x8_t bv[2][4];
#pragma unroll
            for (int nt = 0; nt < 2; ++nt)
#pragma unroll
                for (int ks = 0; ks < 4; ++ks) bv[nt][ks] = *(const bf16x8_t*)(ldsV + (16 * nt + fr) * RT_VS + ks * 64 + fq * 16);
#pragma unroll
            for (int ks = 0; ks < 4; ++ks)
#pragma unroll
                for (int nt = 0; nt < 2; ++nt) ao[nt] = __builtin_amdgcn_mfma_f32_16x16x32_bf16(bv[nt][ks], pa[ks], ao[nt], 0, 0, 0);
            if (c + 1 < 64) {
                const bf16_t* qn = qp + (size_t)(c + 1) * 131072;
#pragma unroll
                for (int ks = 0; ks < 8; ++ks) qa[ks] = *(const bf16x8_t*)(qn + ks * 4096);
                const bf16_t* pn = pp + (size_t)(c + 1) * 16384;
#pragma unroll
                for (int ks = 0; ks < 4; ++ks) if (2 * ks <= w) pa[ks] = *(const bf16x8_t*)(pn + ks * 4096);
            }
            {
                bf16_t* vc = v + (tok0 + 16 * w + fr) * 2048 + h * 512 + sl * 32 + 4 * fq;
#pragma unroll
                for (int nt = 0; nt < 2; ++nt) { uint2 o; o.x = pg8::cvt_pk_bf16(ao[nt][0], ao[nt][1]); o.y = pg8::cvt_pk_bf16(ao[nt][2], ao[nt][3]); *(uint2*)(vc + 16 * nt) = o; }
            }
#pragma unroll
            for (int ks = 0; ks < 4; ++ks)
#pragma unroll
                for (int di = 0; di < 2; ++di)
#pragma unroll
                    for (int et = 0; et < 2; ++et) accU[et][di] = __builtin_amdgcn_mfma_f32_16x16x32_bf16(kb[di][ks], bv[et][ks], accU[et][di], 0, 0, 0);
            if (c + 1 < 64) {
                const bf16_t* kn = kp + (size_t)(c + 1) * 131072;
#pragma unroll
                for (int di = 0; di < 2; ++di)
#pragma unroll
                    for (int ks = 0; ks < 4; ++ks) kb[di][ks] = *(const bf16x8_t*)(kn + ks * 32768 + di * 128);
            }
#pragma unroll
            for (int et = 0; et < 2; ++et)
#pragma unroll
                for (int di = 0; di < 2; ++di) accU[et][di] = accU[et][di] * g128;
            {
                unsigned char* un = lds + RT_U + ((c + 1) & 1) * 32 * RT_KS;
#pragma unroll
                for (int et = 0; et < 2; ++et)
#pragma unroll
                    for (int di = 0; di < 2; ++di) { uint2 o; o.x = pg8::cvt_pk_bf16(accU[et][di][0], accU[et][di][1]); o.y = pg8::cvt_pk_bf16(accU[et][di][2], accU[et][di][3]);
                        *(uint2*)(un + (16 * et + fr) * RT_KS + (16 * (2 * w + di) + 4 * fq) * 2) = o; }
                if (c + 1 < 64) { RT_STAGE_V((c + 1) & 1, vreg); }
                if (c + 2 < 64) vreg = *(const u32x4_t*)(vsl + (size_t)((c + 2) * 128 + vm) * 2048 + ve);
            }
            LDS_BARRIER();
        }
#undef RT_STAGE_V
        __syncthreads();
    }
}
DEV void p_headnorm(bf16_t* ret, const bf16_t* g) {
    const int lane = threadIdx.x & 63;
    for (int w = (blockIdx.x * NTHR + threadIdx.x) >> 6; w < NTOK * 4; w += gridDim.x * (NTHR / 64)) {
        const size_t o = (size_t)w * 512 + lane * 8;
        const u32x4_t rv = *(const u32x4_t*)(ret + o), gv = *(const u32x4_t*)(g + o);
        float x[8], gg[8]; float s = 0.f;
#pragma unroll
        for (int j = 0; j < 4; ++j) { x[2 * j] = __uint_as_float(rv[j] << 16); x[2 * j + 1] = __uint_as_float(rv[j] & 0xffff0000u); gg[2 * j] = __uint_as_float(gv[j] << 16); gg[2 * j + 1] = __uint_as_float(gv[j] & 0xffff0000u); }
#pragma unroll
        for (int j = 0; j < 8; ++j) s += x[j];
#pragma unroll
        for (int m = 1; m < 64; m <<= 1) s += __shfl_xor(s, m);
        const float mu = s * (1.f / 512.f); float q = 0.f;
#pragma unroll
        for (int j = 0; j < 8; ++j) { x[j] -= mu; q += x[j] * x[j]; }
#pragma unroll
        for (int m = 1; m < 64; m <<= 1) q += __shfl_xor(q, m);
        const float rstd = rsqrtf(q * (1.f / 512.f) + LN_EPS);
        u32x4_t ov;
#pragma unroll
        for (int j = 0; j < 4; ++j) ov[j] = pg8::cvt_pk_bf16(x[2 * j] * rstd * gg[2 * j], x[2 * j + 1] * rstd * gg[2 * j + 1]);
        *(u32x4_t*)(ret + o) = ov;
    }
}

typedef float f32x4v __attribute__((ext_vector_type(4)));
DEV void p_ln1_route(float* lds, const bf16_t* y, bf16_t* x1b, unsigned char* x1q, const float* g1, const float* b1, const float* wg, const float* bg,
                     const float* we, const float* be, int2* route_e, float2* route_w, int* cnt, int* list, const float* sb) {
    const int wv = threadIdx.x >> 6, lane = threadIdx.x & 63, r16 = lane & 15, kq = lane >> 4;
    float* Wp = lds;
    float* Sc = lds + 1024 * 36;
    float* Bc = Sc + 48;
    int* lcnt = (int*)(Bc + 48);
    int* rowE = lcnt + 32;
    int* rowP = rowE + 256;
    for (int i = threadIdx.x; i < 1024 * 9; i += NTHR) { const int k = i / 9, c4 = i - k * 9; const float gk = g1[k];
        float4 w = (c4 < 8) ? *(const float4*)(we + (size_t)k * 32 + c4 * 4) : *(const float4*)(wg + (size_t)k * 4);
        w.x *= gk; w.y *= gk; w.z *= gk; w.w *= gk; *(float4*)(Wp + k * 36 + c4 * 4) = w; }
    if (threadIdx.x < 32) lcnt[threadIdx.x] = 0;
    __syncthreads();
    if (threadIdx.x < 96) Sc[threadIdx.x] = sb[threadIdx.x];
    __syncthreads();
    constexpr int rows_per_wg = 128;
    for (int blk = blockIdx.x; blk < NTOK / rows_per_wg; blk += gridDim.x) {
    { const int tile = wv;
        const int lrow0 = tile * 16, row0 = blk * rows_per_wg + lrow0;
        const bf16_t* yp = y + (size_t)(row0 + r16) * 1024 + 4 * kq;
        f32x4v acc[3] = {(f32x4v){0.f, 0.f, 0.f, 0.f}, (f32x4v){0.f, 0.f, 0.f, 0.f}, (f32x4v){0.f, 0.f, 0.f, 0.f}};
        float s1 = 0.f, s2 = 0.f; const float m2 = (r16 < 4) ? 1.f : 0.f;
#pragma unroll 8
        for (int t = 0; t < 64; ++t) {
            const uint2 yr = *(const uint2*)(yp + 16 * t); const float4 yv = make_float4(__uint_as_float(yr.x << 16), __uint_as_float(yr.x & 0xffff0000u), __uint_as_float(yr.y << 16), __uint_as_float(yr.y & 0xffff0000u));
            s1 += (yv.x + yv.y) + (yv.z + yv.w); s2 += (yv.x * yv.x + yv.y * yv.y) + (yv.z * yv.z + yv.w * yv.w);
            const float* wrow = Wp + (16 * t + 4 * kq) * 36 + r16;
            const float ye[4] = {yv.x, yv.y, yv.z, yv.w};
#pragma unroll
            for (int j = 0; j < 4; ++j)
#pragma unroll
                for (int nt = 0; nt < 3; ++nt) { const float wv = (nt < 2) ? wrow[j * 36 + 16 * nt] : wrow[j * 36 + 32 - (r16 & 12)] * m2;
                    acc[nt] = __builtin_amdgcn_mfma_f32_16x16x4f32(ye[j], wv, acc[nt], 0, 0, 0); }
        }
        s1 += __shfl_xor(s1, 16); s1 += __shfl_xor(s1, 32); s2 += __shfl_xor(s2, 16); s2 += __shfl_xor(s2, 32);
        const float mu = s1 * (1.f / 1024.f), rstd = rsqrtf(fmaxf(s2 * (1.f / 1024.f) - mu * mu, 0.f) + LN_EPS);
#pragma unroll 8
        for (int t = 0; t < 64; ++t) {
            const uint2 yr = *(const uint2*)(yp + 16 * t); const float4 yv = make_float4(__uint_as_float(yr.x << 16), __uint_as_float(yr.x & 0xffff0000u), __uint_as_float(yr.y << 16), __uint_as_float(yr.y & 0xffff0000u));
            const float4 gv = *(const float4*)(g1 + 16 * t + 4 * kq), bv = *(const float4*)(b1 + 16 * t + 4 * kq);
            const float4 o = make_float4((yv.x - mu) * rstd * gv.x + bv.x, (yv.y - mu) * rstd * gv.y + bv.y, (yv.z - mu) * rstd * gv.z + bv.z, (yv.w - mu) * rstd * gv.w + bv.w);
            uint2 ob; ob.x = pg8::cvt_pk_bf16(o.x, o.y); ob.y = pg8::cvt_pk_bf16(o.z, o.w);
            *(uint2*)(x1b + (size_t)(row0 + r16) * 1024 + 16 * t + 4 * kq) = ob;
            *(unsigned*)(x1q + (size_t)(row0 + r16) * 1024 + 16 * t + 4 * kq) = pg8::pk4_fp8(o.x * pg8::FP8_SX, o.y * pg8::FP8_SX, o.z * pg8::FP8_SX, o.w * pg8::FP8_SX);
        }
#pragma unroll
        for (int j = 0; j < 4; ++j) {
            const int rl = 4 * kq + j;
            const float mur = __shfl(mu, rl), rsr = __shfl(rstd, rl);
            float lg[3];
#pragma unroll
            for (int nt = 0; nt < 3; ++nt) lg[nt] = rsr * (acc[nt][j] - mur * Sc[16 * nt + r16]) + Bc[16 * nt + r16];
            const int gb = 16 * kq;
            const float g0 = __shfl(lg[2], gb + 0), g1v = __shfl(lg[2], gb + 1), g2 = __shfl(lg[2], gb + 2), g3 = __shfl(lg[2], gb + 3);
            int gi = 0; float gm = g0; if (g1v > gm) { gm = g1v; gi = 1; } if (g2 > gm) { gm = g2; gi = 2; } if (g3 > gm) { gm = g3; gi = 3; }
            const float gw = 1.f / (expf(g0 - gm) + expf(g1v - gm) + expf(g2 - gm) + expf(g3 - gm));
            const float lsel = (gi & 2) ? lg[1] : lg[0];
            float ev[8];
#pragma unroll
            for (int t = 0; t < 8; ++t) ev[t] = __shfl(lsel, gb + (gi & 1) * 8 + t);
            int i1 = 0; float v1 = ev[0];
#pragma unroll
            for (int t = 1; t < 8; ++t) if (ev[t] > v1) { v1 = ev[t]; i1 = t; }
            int i2 = -1; float v2 = -INFINITY;
#pragma unroll
            for (int t = 0; t < 8; ++t) if (t != i1 && ev[t] > v2) { v2 = ev[t]; i2 = t; }
            const float w1 = 1.f / (1.f + expf(v2 - v1)), w2 = 1.f - w1;
            if (r16 == 0) {
                const int lr = lrow0 + rl, r = row0 + rl, e1 = gi * 8 + i1, e2 = gi * 8 + i2;
                route_e[r] = make_int2(e1, e2); route_w[r] = make_float2(gw * w1, gw * w2);
                rowE[2 * lr] = e1; rowP[2 * lr] = atomicAdd(&lcnt[e1], 1);
                rowE[2 * lr + 1] = e2; rowP[2 * lr + 1] = atomicAdd(&lcnt[e2], 1);
            }
        }
    }
    __syncthreads();
    if (threadIdx.x < 32) lcnt[threadIdx.x] = atomicAdd(&cnt[threadIdx.x * 64], lcnt[threadIdx.x]);
    __syncthreads();
    for (int i = threadIdx.x; i < 2 * rows_per_wg; i += NTHR) { const int e = rowE[i]; list[e * 32768 + lcnt[e] + rowP[i]] = (blk * rows_per_wg + (i >> 1)) * 2 + (i & 1); }
    __syncthreads();
    if (threadIdx.x < 32) lcnt[threadIdx.x] = 0;
    __syncthreads();
    }
}

DEV void p_final(float* out, const bf16_t* x1b, const bf16_t* ys, const float* g2, const float* b2) {
    const int lane = threadIdx.x & 63;
    for (int r = (blockIdx.x * NTHR + threadIdx.x) >> 6; r < NTOK; r += gridDim.x * (NTHR / 64)) {
        float x[16]; float s = 0.f;
#pragma unroll
        for (int j = 0; j < 4; ++j) { const int col = j * 256 + lane * 4; const ushort4 tb = *(const ushort4*)(x1b + (size_t)r * 1024 + col); const float4 t = make_float4(bf2f(tb.x), bf2f(tb.y), bf2f(tb.z), bf2f(tb.w));
            const ushort4 a = *(const ushort4*)(ys + (size_t)(2 * r) * 1024 + col), b = *(const ushort4*)(ys + (size_t)(2 * r + 1) * 1024 + col);
            x[4 * j] = ALPHA * t.x + bf2f(a.x) + bf2f(b.x); x[4 * j + 1] = ALPHA * t.y + bf2f(a.y) + bf2f(b.y); x[4 * j + 2] = ALPHA * t.z + bf2f(a.z) + bf2f(b.z); x[4 * j + 3] = ALPHA * t.w + bf2f(a.w) + bf2f(b.w);
            s += (x[4 * j] + x[4 * j + 1]) + (x[4 * j + 2] + x[4 * j + 3]); }
#pragma unroll
        for (int m = 1; m < 64; m <<= 1) s += __shfl_xor(s, m);
        const float mu = s * (1.f / 1024.f); float q = 0.f;
#pragma unroll
        for (int j = 0; j < 16; ++j) { x[j] -= mu; q += x[j] * x[j]; }
#pragma unroll
        for (int m = 1; m < 64; m <<= 1) q += __shfl_xor(q, m);
        const float rstd = rsqrtf(q * (1.f / 1024.f) + LN_EPS);
#pragma unroll
        for (int j = 0; j < 4; ++j) { const int col = j * 256 + lane * 4; const float4 gg = *(const float4*)(g2 + col), bb = *(const float4*)(b2 + col);
            *(float4*)(out + (size_t)r * 1024 + col) = make_float4(x[4 * j] * rstd * gg.x + bb.x, x[4 * j + 1] * rstd * gg.y + bb.y, x[4 * j + 2] * rstd * gg.z + bb.z, x[4 * j + 3] * rstd * gg.w + bb.w); }
    }
}

struct Args { const float* in[24]; float* out; unsigned char* ws; };
__global__ void __launch_bounds__(NTHR, 2) mega_fwd(Args a) {
    extern __shared__ __attribute__((aligned(16))) unsigned char lds_raw[];
    float* ldsf = (float*)lds_raw;
    PG8_LAS unsigned char* ldsl = (PG8_LAS unsigned char*)lds_raw;
    volatile LAS unsigned* MISC = (volatile LAS unsigned*)((LAS unsigned char*)lds_raw + LDS_MISC);
    for (int u = threadIdx.x; u < 128; u += NTHR) MISC[u] = 0u;
    __syncthreads();
    unsigned char* ws = a.ws;
    XcdBarrier bar = xcd_barrier_post((unsigned*)(ws + WS_CTL) + CW_BAR, MISC + 8);
#define GRID_BAR() xcd_barrier(bar)
    const float* x = a.in[0]; const float* w_in = a.in[1]; const float* b_merge = a.in[2];
    const float* conv_w = a.in[3]; const float* conv_b = a.in[4];
    const float* w_rg_r = a.in[5]; const float* b_rg_r = a.in[6]; const float* w_rg_i = a.in[7]; const float* b_rg_i = a.in[8];
    const float* lam = a.in[9]; const float* w_ret_o = a.in[10]; const float* w_lru_o = a.in[11]; const float* w_out = a.in[12];
    const float* ln1_g = a.in[13]; const float* ln1_b = a.in[14]; const float* w_group = a.in[15]; const float* b_group = a.in[16];
    const float* w_er = a.in[17]; const float* b_er = a.in[18]; const float* w_eg = a.in[19]; const float* w_eu = a.in[20];
    const float* w_ed = a.in[21]; const float* ln2_g = a.in[22]; const float* ln2_b = a.in[23];
    float* out = a.out;
    int* cnt = (int*)(ws + WS_CTL); float2* rope = (float2*)(ws + WS_ROPE); int2* route_e = (int2*)(ws + WS_ROUTE_E); float2* route_w = (float2*)(ws + WS_ROUTE_W); int* list = (int*)(ws + WS_LIST);
    bf16_t* xb = (bf16_t*)(ws + WS_XB); bf16_t* gl = (bf16_t*)(ws + WS_GL); bf16_t* ulru = (bf16_t*)(ws + WS_ULRU); bf16_t* uconv = (bf16_t*)(ws + WS_UCONV);
    bf16_t* epsb = (bf16_t*)(ws + WS_EPS); bf16_t* inp = (bf16_t*)out;
    bf16_t* q = (bf16_t*)(ws + WS_Q); bf16_t* k = (bf16_t*)(ws + WS_K); bf16_t* v = (bf16_t*)(ws + WS_V); bf16_t* gbuf = (bf16_t*)out;
    bf16_t* P = (bf16_t*)(ws + WS_P); bf16_t* gates = (bf16_t*)(ws + WS_GATES); bf16_t* m1 = (bf16_t*)out; bf16_t* merged = xb;
    bf16_t* w_in_t = (bf16_t*)(ws + WS_WIN_T); bf16_t* w_ro_t = (bf16_t*)(ws + WS_WRO_T); bf16_t* w_lo_t = (bf16_t*)(ws + WS_WLO_T); bf16_t* w_out_t = (bf16_t*)(ws + WS_WOUT_T);
    bf16_t* wrg_t = (bf16_t*)(ws + WS_WRG_T); float* segA = (float*)(ws + WS_SEGA); float* segH = (float*)(ws + WS_SEGH); float* carry = (float*)(ws + WS_CARRY);
    float* rsb = (float*)(ws + WS_RSB);
    unsigned char* wgu8 = ws + WS_WGU_T; unsigned char* wd8 = ws + WS_WD_T; unsigned char* x1q = ws + WS_X1Q;
    bf16_t* x1b = gl; bf16_t* hbuf = (bf16_t*)(ws + WS_H); bf16_t* ys = (bf16_t*)(ws + WS_YSLOT);

    p_router_consts(ldsf, ln1_g, ln1_b, w_group, b_group, w_er, b_er, rsb); p_cvt_x(x, xb); p_rope_table(rope); p_weights(ldsf, w_in, w_ret_o, w_lru_o, w_out, w_rg_r, w_rg_i, w_in_t, w_ro_t, w_lo_t, w_out_t, wrg_t);
    GRID_BAR();
    { pg8::Gemm g{xb, w_in_t + (size_t)C_U * 1024, NTOK, 3072, 1024}; pg8::StaticOrder S; S.init(NTOK, 3072, (int)gridDim.x, (int)blockIdx.x);
      pg8::gemm_phase<pg8::EpiLruIn, pg8::StaticOrder, true, true>(ldsl, g, S, pg8::EpiLruIn{ulru, gl}); }
    GRID_BAR();
    p_lru_compute(lds_raw, ulru, conv_w, conv_b, wrg_t, b_rg_r, b_rg_i, lam, uconv, epsb, segA, segH);
    GRID_BAR();
    p_lru_carry(ldsf, segA, segH, carry);
    GRID_BAR();
    p_lru_scan(uconv, epsb, gl, carry);
    GRID_BAR();
    { pg8::Gemm g{xb, w_in_t, NTOK, 6144, 1024}; pg8::StaticOrder S; S.init(NTOK, 6144, (int)gridDim.x, (int)blockIdx.x);
      pg8::gemm_phase<pg8::EpiRetIn, pg8::StaticOrder, true, true>(ldsl, g, S, pg8::EpiRetIn{q, k, v, gbuf, (const float*)rope}); }
    GRID_BAR();
    p_scores(lds_raw, q, k, P);
    GRID_BAR();
    p_ret_mfma(lds_raw, q, k, v, P);
    GRID_BAR();
    p_headnorm(v, gbuf);
    { pg8::Gemm g{xb, w_in_t + (size_t)C_GATE * 1024, NTOK, 2048, 1024}; pg8::StaticOrder S; S.init(NTOK, 2048, (int)gridDim.x, (int)blockIdx.x);
      pg8::gemm_phase<pg8::EpiGates, pg8::StaticOrder, true, true>(ldsl, g, S, pg8::EpiGates{b_merge, gates}); }
    GRID_BAR();
    { pg8::Gemm g{v, w_ro_t, NTOK, 1024, 2048}; pg8::StaticOrder S; S.init(NTOK, 1024, (int)gridDim.x, (int)blockIdx.x);
      pg8::gemm_phase<pg8::EpiMerge<0>, pg8::StaticOrder, true, true>(ldsl, g, S, pg8::EpiMerge<0>{gates, nullptr, m1}); }
    GRID_BAR();
    { pg8::Gemm g{gl, w_lo_t, NTOK, 1024, 1536}; pg8::StaticOrder S; S.init(NTOK, 1024, (int)gridDim.x, (int)blockIdx.x);
      pg8::gemm_phase<pg8::EpiMerge<1>, pg8::StaticOrder, true, true>(ldsl, g, S, pg8::EpiMerge<1>{gates, m1, merged}); }
    GRID_BAR();
    { pg8::Gemm g{merged, w_out_t, NTOK, 1024, 1024}; pg8::StaticOrder S; S.init(NTOK, 1024, (int)gridDim.x, (int)blockIdx.x);
      pg8::gemm_phase<pg8::EpiOut, pg8::StaticOrder, true, true>(ldsl, g, S, pg8::EpiOut{x, (bf16_t*)out, ALPHA}); }
    GRID_BAR();
    p_ln1_route(ldsf, (const bf16_t*)out, x1b, x1q, ln1_g, ln1_b, w_group, b_group, w_er, b_er, route_e, route_w, cnt, list, rsb);
    p_expert_weights(ldsf, w_eg, w_eu, w_ed, wgu8, wd8);
    GRID_BAR();
    {
        PG8_LAS pg8::MoeTab* tab = (PG8_LAS pg8::MoeTab*)(ldsl + LDS_TAB);
        pg8::moe_build_tab(tab, cnt);
        const int T = tab->tileStart[32];
        { pg8::Gemm g{(const bf16_t*)x1q, (const bf16_t*)wgu8, T * 256, 32 * 1024, 512}; pg8::MoeOrder<true> S{T * 4, (int)gridDim.x, (int)blockIdx.x, tab, list};
          pg8::gemm_phase<pg8::EpiSwiGLU8, pg8::MoeOrder<true>, true, true, true>(ldsl, g, S, pg8::EpiSwiGLU8{(unsigned char*)hbuf}); }
        GRID_BAR();
        { pg8::Gemm g{hbuf, (const bf16_t*)wd8, T * 256, 32 * 1024, 256}; pg8::MoeOrder<false> S{T * 4, (int)gridDim.x, (int)blockIdx.x, tab, list};
          pg8::gemm_phase<pg8::EpiMoeOut8, pg8::MoeOrder<false>, true, true, true>(ldsl, g, S, pg8::EpiMoeOut8{tab, list, (const float*)route_w, ys}); }
    }
    GRID_BAR();
    p_final(out, x1b, ys, ln2_g, ln2_b);
}

extern "C" void kernel_launch(void* const* d_in, const int* in_sizes, int n_in, void* d_out, int out_size, void* d_ws, size_t ws_size, hipStream_t stream) {
    static int grid = 0;
    if (grid == 0) {
        if (n_in != 24 || in_sizes[0] != NTOK * DM || out_size != NTOK * DM || ws_size < WS_END) {
            fprintf(stderr, "kernel_launch: unexpected shapes (n_in %d, in0 %d, out %d, ws %zu)\n", n_in, n_in > 0 ? in_sizes[0] : -1, out_size, ws_size); grid = -1; return; }
        int dev = 0, cus = 0, per_cu = 0;
        if (hipGetDevice(&dev) != hipSuccess || hipDeviceGetAttribute(&cus, hipDeviceAttributeMultiprocessorCount, dev) != hipSuccess) { fprintf(stderr, "kernel_launch: device query failed\n"); grid = -1; return; }
        if (hipFuncSetAttribute((const void*)mega_fwd, hipFuncAttributeMaxDynamicSharedMemorySize, LDS_BYTES) != hipSuccess) { fprintf(stderr, "kernel_launch: hipFuncSetAttribute failed\n"); grid = -1; return; }
        if (hipOccupancyMaxActiveBlocksPerMultiprocessor(&per_cu, (const void*)mega_fwd, NTHR, LDS_BYTES) != hipSuccess || per_cu < 1) {
            fprintf(stderr, "kernel_launch: occupancy query reports %d workgroups per CU\n", per_cu); (void)hipGetLastError(); grid = -1; return; }
        grid = cus;
    }
    if (grid < 0) return;
    if (hipMemsetAsync((char*)d_ws + WS_CTL, 0, CTL_ZERO_BYTES, stream) != hipSuccess) { fprintf(stderr, "kernel_launch: memset failed\n"); return; }
    Args a{};
    for (int i = 0; i < 24; ++i) a.in[i] = (const float*)d_in[i];
    a.out = (float*)d_out; a.ws = (unsigned char*)d_ws;
    hipLaunchKernelGGL(mega_fwd, dim3(grid), dim3(NTHR), LDS_BYTES, stream, a);
    const hipError_t le = hipPeekAtLastError();
    if (le != hipSuccess) fprintf(stderr, "kernel_launch: launch failed: %s\n", hipGetErrorName(le));
}
```

```cpp
#include <hip/hip_runtime.h>
#include <cstdio>
#include <cstdint>

typedef unsigned short bf16_t;
#define DEV __device__ __forceinline__
#define LAS __attribute__((address_space(3)))

DEV int otid() { int t = threadIdx.x; asm volatile("" : "+v"(t)); return t; }
DEV float bf2f(bf16_t h) { return __uint_as_float(((unsigned)h) << 16); }
typedef short bf16x8_t __attribute__((ext_vector_type(8)));
typedef unsigned u32x4_t __attribute__((ext_vector_type(4)));
DEV bf16_t f2bf(float f) { unsigned u = __float_as_uint(f); return (bf16_t)((u + 0x7fffu + ((u >> 16) & 1u)) >> 16); }

constexpr int NTHR = 512;
constexpr int NTOK = 32768, DM = 1024, SEQ = 8192;
constexpr int WIN_N = 11264;
constexpr int C_Q = 0, C_K = 1024, C_V = 2048, C_G = 4096, C_U = 6144, C_GL = 7680, C_GATE = 9216;
constexpr float ALPHA = 1.189207115002721f;
constexpr float LN_EPS = 1e-5f;
constexpr size_t MiB = 1u << 20;
constexpr size_t WS_CTL = 0;
constexpr size_t CTL_ZERO_BYTES = 1 * MiB;
constexpr int CW_BAR = 4096;
constexpr size_t WS_ROPE = 1 * MiB;
constexpr size_t WS_ROUTE_E = 9 * MiB;
constexpr size_t WS_ROUTE_W = 9 * MiB + 512 * 1024;
constexpr size_t WS_LIST = 10 * MiB;
constexpr size_t WS_WRG_T = 14 * MiB;
constexpr size_t WS_RSB = 15 * MiB + 512 * 1024;
constexpr size_t WS_RTAB = 22 * MiB;
constexpr size_t WS_SEGA = 16 * MiB;
constexpr size_t WS_SEGH = 18 * MiB;
constexpr size_t WS_CARRY = 20 * MiB;
constexpr size_t WS_XB = 32 * MiB;
constexpr size_t WS_GL = 96 * MiB;
constexpr size_t WS_ULRU = 192 * MiB;
constexpr size_t WS_Q = 192 * MiB;
constexpr size_t WS_K = 256 * MiB;
constexpr size_t WS_GATES = 192 * MiB;
constexpr size_t WS_UCONV = 288 * MiB;
constexpr size_t WS_P = 320 * MiB;
constexpr size_t WS_V = 352 * MiB;
constexpr size_t WS_EPS = 384 * MiB;
constexpr size_t WS_H = 192 * MiB;
constexpr size_t WS_YSLOT = 264 * MiB;
constexpr size_t WS_WGU_T = 352 * MiB;
constexpr size_t WS_WD_T = 416 * MiB;
constexpr size_t WS_X1Q = 160 * MiB;
constexpr int LDS_TAB = 131072;
constexpr size_t WS_WIN_T = 480 * MiB;
constexpr size_t WS_WRO_T = 502 * MiB;
constexpr size_t WS_WLO_T = 506 * MiB;
constexpr size_t WS_WOUT_T = 509 * MiB;
constexpr size_t WS_END = 512 * MiB;
constexpr int LDS_BYTES = 163840;
constexpr int LDS_MISC = 163840 - 512;

#define XB_TMO      128
#define XB_XCNT(j)  (256  + 64 * (j))
#define XB_XSUB(j)  (1280 + 64 * (j))
#define XB_XGEN(j)  (2304 + 64 * (j))
#define XB_TOP      3328
#define XB_TOPGEN   3392
#define XCD_BAR_WORDS 3456
#define XB_SPIN_CAP (1u << 22)
DEV unsigned xb_ld(unsigned* p)              { return __hip_atomic_load(p, __ATOMIC_RELAXED, __HIP_MEMORY_SCOPE_AGENT); }
DEV unsigned xb_add(unsigned* p, unsigned v) { return __hip_atomic_fetch_add(p, v, __ATOMIC_RELAXED, __HIP_MEMORY_SCOPE_AGENT); }
DEV unsigned xb_xcc_id() { return (unsigned)__builtin_amdgcn_s_getreg((3 << 11) | 20) & 0xFu; }
#define XB_SPIN(cond, bar) do { unsigned _sp = 0; while (cond) { __builtin_amdgcn_s_sleep(1); \
    if ((++_sp & 255u) == 0u) { if (xb_ld(&(bar)[XB_TMO])) break; if (_sp > XB_SPIN_CAP) { atomicAdd(&(bar)[XB_TMO], 1u); break; } } } } while (0)
struct XcdBarrier { unsigned* bar; unsigned x; volatile LAS unsigned* st; };
DEV XcdBarrier xcd_barrier_post(unsigned* bar, volatile LAS unsigned* st) {
    XcdBarrier b; b.bar = bar; b.x = xb_xcc_id(); b.st = st;
    if (otid() == 0) (void)xb_add(&bar[XB_XCNT(b.x)], 1u);
    return b;
}
DEV void xcd_barrier_complete(unsigned* bar, unsigned x, unsigned& nloc, unsigned& nx) {
    const unsigned G = gridDim.x * gridDim.y * gridDim.z;
    unsigned sum, cnt, mine, sp = 0u;
    for (;;) {
        sum = 0u; cnt = 0u; mine = 0u;
#pragma unroll
        for (unsigned j = 0; j < 16; ++j) { const unsigned c = xb_ld(&bar[XB_XCNT(j)]); sum += c; cnt += (c > 0u) ? 1u : 0u; mine = (j == x) ? c : mine; }
        if (sum == G) break;
        __builtin_amdgcn_s_sleep(1);
        if ((++sp & 255u) == 0u) { if (xb_ld(&bar[XB_TMO])) break; if (sp > XB_SPIN_CAP) { atomicAdd(&bar[XB_TMO], 1u); break; } }
    }
    nloc = mine > 0u ? mine : 1u; nx = cnt > 0u ? cnt : 1u;
}
DEV void xcd_barrier(const XcdBarrier& b) {
    asm volatile("s_waitcnt vmcnt(0)" ::: "memory");
    __syncthreads();
    if (otid() == 0) {
        unsigned* bar = b.bar;
        __builtin_amdgcn_s_waitcnt(0);
        unsigned nloc = b.st[0], nx = b.st[1];
        if (nloc == 0u) { xcd_barrier_complete(bar, b.x, nloc, nx); b.st[0] = nloc; b.st[1] = nx; }
        const unsigned old = xb_add(&bar[XB_XSUB(b.x)], 1u);
        const unsigned gen = old / nloc;
        if (old + 1u == (gen + 1u) * nloc) {
            __builtin_amdgcn_fence(__ATOMIC_RELEASE, "agent");
            asm volatile("s_waitcnt vmcnt(0)" ::: "memory");
            const unsigned og = xb_add(&bar[XB_TOP], 1u);
            const unsigned tg = og / nx;
            if (og + 1u == (tg + 1u) * nx) xb_add(&bar[XB_TOPGEN], 1u);
            else XB_SPIN(xb_ld(&bar[XB_TOPGEN]) == tg, bar);
            __builtin_amdgcn_fence(__ATOMIC_ACQUIRE, "agent");
            xb_add(&bar[XB_XGEN(b.x)], 1u);
            asm volatile("s_waitcnt vmcnt(0)" ::: "memory");
        } else {
            XB_SPIN(xb_ld(&bar[XB_XGEN(b.x)]) == gen, bar);
            __builtin_amdgcn_fence(__ATOMIC_ACQUIRE, "agent");
            asm volatile("s_waitcnt vmcnt(0)" ::: "memory");
        }
    }
    __syncthreads();
}

namespace pg8 {
#define PG8_LAS __attribute__((address_space(3)))
typedef unsigned short bf16_t;
typedef short bf16x8 __attribute__((ext_vector_type(8)));
typedef float f32x4 __attribute__((ext_vector_type(4)));
typedef unsigned u32x4 __attribute__((ext_vector_type(4)));
constexpr int BM = 256, BK = 64, HALF = 128, HTB = HALF * BK * 2  , STAGE_BYTES = 8 * HTB, NXCD = 8, WGM = 8;

__host__ __device__ __forceinline__ int lds_byte(int r, int c) { const int st = (r >> 4) * 2 + (c >> 5), rr = r & 15, cc = c & 31, ob = rr * 64 + cc * 2; return st * 1024 + (ob ^ (((ob >> 9) & 1) << 5)); }
__host__ __device__ __forceinline__ void stage_rc(int b, int& R, int& C) { const int st = b / 1024, sb = b % 1024, swz = sb ^ (((sb >> 9) & 1) << 5); R = (st >> 1) * 16 + swz / 64; C = (st & 1) * 32 + (swz % 64) / 2; }
__host__ __device__ __forceinline__ int perm32(int rho) { const int n = rho >> 4, i = rho & 15; return 8 * (i >> 2) + 4 * n + (i & 3); }

struct Unit { int pm, pn; };
struct Gemm { const bf16_t* A; const bf16_t* Bt; int M, N, K; };

struct StaticOrder {
    int nM, nN, nwg, G, c;
    __host__ __device__ void init(int M, int N, int G_, int c_) { nM = M / BM; nN = N / BM; nwg = nM * nN; G = G_; c = c_; }
    __host__ __device__ bool next(int i, Unit& u) const {
        const long L = (long)i * G + c; if (L >= nwg) return false;
        int wgid = (int)L; { const int q = nwg / NXCD, r = nwg % NXCD, xcd = wgid % NXCD, off = wgid / NXCD; wgid = (xcd < r ? xcd * (q + 1) : r * (q + 1) + (xcd - r) * q) + off; }
        const int nig = WGM * nN, gid = wgid / nig, fm = gid * WGM, gsz = (nM - fm) < WGM ? (nM - fm) : WGM;
        u.pm = fm + ((wgid % nig) % gsz); u.pn = (wgid % nig) / gsz; return true;
    }
    __device__ __forceinline__ void a_ready(const Unit&) const {}
    __device__ __forceinline__ void done(const Unit&) const {}
    __device__ __forceinline__ const char* a_base(const Gemm& g, const Unit& u) const { return (const char*)g.A + (size_t)u.pm * (size_t)(BM * g.K * 2); }
    __device__ __forceinline__ void a_off(const Gemm& g, const Unit&, const int (&R)[2], const int (&C)[2], unsigned (&v)[2][2]) const {
        _Pragma("unroll") for (int hh = 0; hh < 2; ++hh) _Pragma("unroll") for (int i = 0; i < 2; ++i) v[hh][i] = (unsigned)((hh * HALF + R[i]) * g.K + C[i]) * 2u; }
};
typedef __bf16 bf16x2_t __attribute__((ext_vector_type(2)));
typedef float f32x2_t __attribute__((ext_vector_type(2)));
__device__ __forceinline__ unsigned cvt_pk_bf16(float lo, float hi) { f32x2_t v = {lo, hi}; return __builtin_bit_cast(unsigned, __builtin_convertvector(v, bf16x2_t)); }
typedef int i32x4 __attribute__((ext_vector_type(4)));
typedef int i32x8 __attribute__((ext_vector_type(8)));
template <bool MX8> struct Frag { struct A4 { bf16x8 v[4][2]; }; struct B2 { bf16x8 v[2][2]; }; };
template <> struct Frag<true> { struct A4 { i32x8 v[4]; }; struct B2 { i32x8 v[2]; }; };
__device__ __forceinline__ i32x8 ld32(const PG8_LAS unsigned char* p0, const PG8_LAS unsigned char* p1) { const i32x4 a = *(const PG8_LAS i32x4*)p0, b = *(const PG8_LAS i32x4*)p1; return __builtin_shufflevector(a, b, 0, 1, 2, 3, 4, 5, 6, 7); }
template <class Epi, class Sched, bool ALIGN_EPI = false, bool SP2 = false, bool MX8 = false>
__device__ __forceinline__ void gemm_phase(PG8_LAS unsigned char* lds, const Gemm g, const Sched& S, const Epi& E) {
    int tid_ = otid(); asm volatile("" : "+v"(tid_));
    const int tid = tid_, wid = __builtin_amdgcn_readfirstlane(tid >> 6), lane = tid & 63, wr = wid >> 2, wc = wid & 3, fr = lane & 15, fq = lane >> 4;
    const int K = g.K, nt = K / BK;
    unsigned voffB[2], vA[2][2], vN[2][2]; int sR[2], sC[2];
#pragma unroll
    for (int i = 0; i < 2; ++i) { int R, C; stage_rc(tid * 16 + i * 8192, R, C); const int Rb = Epi::PERM ? ((R & ~31) + perm32(R & 31)) : R;
        sR[i] = R; sC[i] = C; voffB[i] = (unsigned)(Rb * K + C) * 2u; }
    const size_t kstep = (size_t)(BK * 2);
    const size_t hstep = (size_t)HALF * K * 2;
    const size_t tstep = 2 * hstep;
    const unsigned ldsw = (unsigned)wid * 1024u;
    const int aoff = lds_byte(wr * 64 + fr, fq * 8), boff = lds_byte(wc * 32 + fr, fq * 8);
#define PG8_SA(b, h) (((b) * 2 + (h)) * HTB)
#define PG8_SB(b, h) ((4 + (b) * 2 + (h)) * HTB)
#define PG8_STAGE(bufoff, gbase, voff) do { _Pragma("unroll") for (int _i = 0; _i < 2; ++_i) \
        __builtin_amdgcn_global_load_lds((const unsigned*)((const char*)(gbase) + (voff)[_i]), (PG8_LAS unsigned*)(lds + (bufoff) + ldsw + _i * 8192), 16, 0, 0); } while (0)
#define PG8_LDA(dst, b, h) do { if constexpr (MX8) { _Pragma("unroll") for (int m = 0; m < 4; ++m) dst.v[m] = ld32(lds + PG8_SA(b, h) + aoff + m * 2048, lds + PG8_SA(b, h) + aoff + m * 2048 + 1024); } \
        else { _Pragma("unroll") for (int m = 0; m < 4; ++m) _Pragma("unroll") for (int k = 0; k < 2; ++k) dst.v[m][k] = *(const PG8_LAS bf16x8*)(lds + PG8_SA(b, h) + aoff + m * 2048 + k * 1024); } } while (0)
#define PG8_LDB(dst, b, h) do { if constexpr (MX8) { _Pragma("unroll") for (int n = 0; n < 2; ++n) dst.v[n] = ld32(lds + PG8_SB(b, h) + boff + n * 2048, lds + PG8_SB(b, h) + boff + n * 2048 + 1024); } \
        else { _Pragma("unroll") for (int n = 0; n < 2; ++n) _Pragma("unroll") for (int k = 0; k < 2; ++k) dst.v[n][k] = *(const PG8_LAS bf16x8*)(lds + PG8_SB(b, h) + boff + n * 2048 + k * 1024); } } while (0)
#define PG8_MMA(ai, bj, At, Bt) do { __builtin_amdgcn_s_setprio(1); \
        if constexpr (MX8) { _Pragma("unroll") for (int m = 0; m < 4; ++m) _Pragma("unroll") for (int n = 0; n < 2; ++n) \
            { acc[ai][bj][m][n] = __builtin_amdgcn_mfma_scale_f32_16x16x128_f8f6f4(Bt.v[n], At.v[m], acc[ai][bj][m][n], 0, 0, 0, 0x7f7f7f7f, 0, 0x7f7f7f7f); asm volatile("" : "+v"(acc[ai][bj][m][n])); } } \
        else { _Pragma("unroll") for (int m = 0; m < 4; ++m) _Pragma("unroll") for (int n = 0; n < 2; ++n) _Pragma("unroll") for (int k = 0; k < 2; ++k) \
            acc[ai][bj][m][n] = __builtin_amdgcn_mfma_f32_16x16x32_bf16(Bt.v[n][k], At.v[m][k], acc[ai][bj][m][n], 0, 0, 0); } \
        __builtin_amdgcn_s_setprio(0); } while (0)
#define PG8_WAIT_V(n) asm volatile("s_waitcnt vmcnt(" #n ")" ::: "memory")
#define PG8_WAIT_L(n) asm volatile("s_waitcnt lgkmcnt(" #n ")" ::: "memory")
#define PG8_BAR __builtin_amdgcn_s_barrier()
#define PG8_SCHED __builtin_amdgcn_sched_barrier(0)
    Unit cur, nxt; int ui = 0;
    if (!S.next(0, cur)) return;
    f32x4 acc[2][2][4][2];
#pragma unroll
    for (int a = 0; a < 2; ++a)
#pragma unroll
        for (int b = 0; b < 2; ++b)
#pragma unroll
            for (int m = 0; m < 4; ++m)
#pragma unroll
                for (int n = 0; n < 2; ++n) acc[a][b][m][n] = (f32x4){0.f, 0.f, 0.f, 0.f};
    typename Frag<MX8>::A4 At; typename Frag<MX8>::B2 B0, B1;
    const char* cA = S.a_base(g, cur); const char* cB = (const char*)g.Bt + (size_t)cur.pn * tstep;
    S.a_ready(cur); S.a_off(g, cur, sR, sC, vA);
    if constexpr (SP2) {
        PG8_STAGE(PG8_SB(0, 0), cB, voffB); PG8_STAGE(PG8_SB(0, 1), cB + hstep, voffB); PG8_STAGE(PG8_SA(0, 0), cA, vA[0]); PG8_STAGE(PG8_SA(0, 1), cA, vA[1]);
        if (wr == 1) PG8_BAR;
        PG8_WAIT_V(2); PG8_BAR;
        PG8_STAGE(PG8_SB(1, 0), cB + kstep, voffB); PG8_STAGE(PG8_SA(1, 0), cA + kstep, vA[0]); PG8_STAGE(PG8_SB(1, 1), cB + hstep + kstep, voffB);
        PG8_WAIT_V(6); PG8_BAR;
    } else { static_assert(SP2, "only the SP2 K-loop is kept in this file"); }
    for (;;) {
        const bool has_next = S.next(ui + 1, nxt);
        const char* nA = has_next ? S.a_base(g, nxt) : cA; const char* nB = has_next ? (const char*)g.Bt + (size_t)nxt.pn * tstep : cB;
        if (has_next) S.a_off(g, nxt, sR, sC, vN); else { vN[0][0] = vA[0][0]; vN[0][1] = vA[0][1]; vN[1][0] = vA[1][0]; vN[1][1] = vA[1][1]; }
#pragma unroll 1
        for (int t = 0; t < nt; t += 2) {
            const bool last = (t == nt - 2);
            const char* a1 = cA + (size_t)(t + 1) * kstep;
            const char* a2 = last ? nA : cA + (size_t)(t + 2) * kstep; const char* b2 = last ? nB : cB + (size_t)(t + 2) * kstep;
            const char* a3 = a2 + kstep; const char* b3 = b2 + kstep;
            unsigned v2[2][2]; v2[0][0] = last ? vN[0][0] : vA[0][0]; v2[0][1] = last ? vN[0][1] : vA[0][1]; v2[1][0] = last ? vN[1][0] : vA[1][0]; v2[1][1] = last ? vN[1][1] : vA[1][1];
            if (last && has_next) S.a_ready(nxt);
            if constexpr (SP2) {
            PG8_LDB(B0, 0, 0); PG8_LDB(B1, 0, 1); PG8_SCHED; PG8_LDA(At, 0, 0); PG8_STAGE(PG8_SA(1, 1), a1, vA[1]);
            PG8_WAIT_V(8); PG8_WAIT_L(0); PG8_BAR; PG8_MMA(0, 0, At, B0); PG8_MMA(0, 1, At, B1); PG8_BAR; PG8_SCHED;
            PG8_LDA(At, 0, 1); PG8_STAGE(PG8_SB(0, 0), b2, voffB); PG8_STAGE(PG8_SB(0, 1), b2 + hstep, voffB); PG8_STAGE(PG8_SA(0, 0), a2, v2[0]);
            PG8_WAIT_V(8); PG8_WAIT_L(0); PG8_BAR; PG8_MMA(1, 0, At, B0); PG8_MMA(1, 1, At, B1); PG8_BAR; PG8_SCHED;
            PG8_LDB(B0, 1, 0); PG8_LDB(B1, 1, 1); PG8_SCHED; PG8_LDA(At, 1, 0); PG8_STAGE(PG8_SA(0, 1), a2, v2[1]);
            PG8_WAIT_V(8); PG8_WAIT_L(0); PG8_BAR; PG8_MMA(0, 0, At, B0); PG8_MMA(0, 1, At, B1); PG8_BAR; PG8_SCHED;
            PG8_LDA(At, 1, 1); PG8_STAGE(PG8_SB(1, 0), b3, voffB); PG8_STAGE(PG8_SB(1, 1), b3 + hstep, voffB); PG8_STAGE(PG8_SA(1, 0), a3, v2[0]);
            PG8_WAIT_V(8); PG8_WAIT_L(0); PG8_BAR; PG8_MMA(1, 0, At, B0); PG8_MMA(1, 1, At, B1); PG8_BAR; PG8_SCHED;
            }
        }
        if constexpr (ALIGN_EPI) { if (wr == 0) PG8_BAR; }
        if constexpr (!Epi::AFTER_DRAIN) { E(acc, cur, wr, wc, fr, fq); S.done(cur); }
        if (!has_next) break;
#pragma unroll
        for (int a = 0; a < 2; ++a)
#pragma unroll
            for (int b = 0; b < 2; ++b)
#pragma unroll
                for (int m = 0; m < 4; ++m)
#pragma unroll
                    for (int n = 0; n < 2; ++n) acc[a][b][m][n] = (f32x4){0.f, 0.f, 0.f, 0.f};
        cur = nxt; cA = nA; cB = nB; ++ui; vA[0][0] = vN[0][0]; vA[0][1] = vN[0][1]; vA[1][0] = vN[1][0]; vA[1][1] = vN[1][1];
        if constexpr (ALIGN_EPI) { if (wr == 1) PG8_BAR; }
    }
    PG8_WAIT_V(0);
    if constexpr (!ALIGN_EPI) { if (wr == 0) PG8_BAR; }
    PG8_BAR;
    if constexpr (Epi::AFTER_DRAIN) { E.fused(acc, cur, wr, wc, fr, fq, lds, wid, lane); S.done(cur); }
#undef PG8_SA
#undef PG8_SB
#undef PG8_STAGE
#undef PG8_LDA
#undef PG8_LDB
#undef PG8_MMA
#undef PG8_WAIT_V
#undef PG8_WAIT_L
#undef PG8_BAR
#undef PG8_SCHED
}

__device__ __forceinline__ float fsig(float x) { return __builtin_amdgcn_rcpf(1.f + __expf(-x)); }
__device__ __forceinline__ float fsilu(float x) { return x * fsig(x); }
__device__ __forceinline__ float fgelu(float x) { return x * fsig(1.5957691216057308f * (x + 0.044715f * x * x * x)); }
__device__ __forceinline__ u32x4 pack8(const f32x4& v0, const f32x4& v1) { u32x4 w; w.x = cvt_pk_bf16(v0[0], v0[1]); w.y = cvt_pk_bf16(v0[2], v0[3]); w.z = cvt_pk_bf16(v1[0], v1[1]); w.w = cvt_pk_bf16(v1[2], v1[3]); return w; }
__device__ __forceinline__ void unpack8(const u32x4& w, f32x4& v0, f32x4& v1) {
    v0[0] = __uint_as_float(w.x << 16); v0[1] = __uint_as_float(w.x & 0xffff0000u); v0[2] = __uint_as_float(w.y << 16); v0[3] = __uint_as_float(w.y & 0xffff0000u);
    v1[0] = __uint_as_float(w.z << 16); v1[1] = __uint_as_float(w.z & 0xffff0000u); v1[2] = __uint_as_float(w.w << 16); v1[3] = __uint_as_float(w.w & 0xffff0000u); }

struct EpiLruIn {
    static constexpr bool PERM = true, AFTER_DRAIN = false;
    bf16_t* u; bf16_t* gl;
    __device__ __forceinline__ void operator()(const f32x4 (&acc)[2][2][4][2], const Unit& un, int wr, int wc, int fr, int fq) const {
        const int row0 = un.pm * BM + wr * 64 + fr; const bool isg = un.pn >= 6;
        bf16_t* base = (isg ? gl : u) + (isg ? un.pn - 6 : un.pn) * BM + wc * 32 + 8 * fq;
#pragma unroll
        for (int ai = 0; ai < 2; ++ai)
#pragma unroll
            for (int m = 0; m < 4; ++m) { bf16_t* rowp = base + (size_t)(row0 + ai * HALF + m * 16) * 1536;
#pragma unroll
                for (int bj = 0; bj < 2; ++bj) { f32x4 v0 = acc[ai][bj][m][0], v1 = acc[ai][bj][m][1];
                    if (isg) {
#pragma unroll
                        for (int e = 0; e < 4; ++e) { v0[e] = fgelu(v0[e]); v1[e] = fgelu(v1[e]); } }
                    *(u32x4*)(rowp + bj * HALF) = pack8(v0, v1); } }
    }
};
struct EpiRetIn {
    static constexpr bool PERM = true, AFTER_DRAIN = false;
    bf16_t* q; bf16_t* k; bf16_t* v; bf16_t* g; const float* rope;
    __device__ __forceinline__ void operator()(const f32x4 (&acc)[2][2][4][2], const Unit& un, int wr, int wc, int fr, int fq) const {
        const int row0 = un.pm * BM + wr * 64 + fr;
        if (un.pn < 8) {
            const bool isk = un.pn >= 4; const int h = un.pn & 3;
            const float lg = __log2f(1.f - __builtin_amdgcn_exp2f(-5.f - (float)h));
            const int jb = wc * 32 + 8 * fq;
            bf16_t* base = (isk ? k : q) + h * 256 + jb;
#pragma unroll
            for (int ai = 0; ai < 2; ++ai)
#pragma unroll
                for (int m = 0; m < 4; ++m) { const int r = row0 + ai * HALF + m * 16, s = r & 8191, n = s & 127;
                    const float sc = isk ? __builtin_amdgcn_exp2f(-(float)n * lg) * 0.0625f : __builtin_amdgcn_exp2f((float)n * lg);
                    const f32x4* tp = (const f32x4*)(rope + ((size_t)s * 128 + jb) * 2);
                    f32x4 o1[2], o2[2];
#pragma unroll
                    for (int nn = 0; nn < 2; ++nn) { const f32x4 ta = tp[2 * nn], tb = tp[2 * nn + 1]; const f32x4 a = acc[ai][0][m][nn], b = acc[ai][1][m][nn];
                        o1[nn][0] = (a[0] * ta[0] - b[0] * ta[1]) * sc; o2[nn][0] = (a[0] * ta[1] + b[0] * ta[0]) * sc;
                        o1[nn][1] = (a[1] * ta[2] - b[1] * ta[3]) * sc; o2[nn][1] = (a[1] * ta[3] + b[1] * ta[2]) * sc;
                        o1[nn][2] = (a[2] * tb[0] - b[2] * tb[1]) * sc; o2[nn][2] = (a[2] * tb[1] + b[2] * tb[0]) * sc;
                        o1[nn][3] = (a[3] * tb[2] - b[3] * tb[3]) * sc; o2[nn][3] = (a[3] * tb[3] + b[3] * tb[2]) * sc; }
                    bf16_t* rowp = isk ? base + (size_t)r * 1024 : q + ((size_t)(r >> 7) * 4 + h) * 32768 + ((wc * 4 + fq) * 128 + n) * 8;
                    *(u32x4*)(rowp) = pack8(o1[0], o1[1]); *(u32x4*)(rowp + (isk ? HALF : 16384)) = pack8(o2[0], o2[1]);
                    asm volatile("" ::: "memory"); }
        } else {
            const bool isg = un.pn >= 16;
            bf16_t* base = (isg ? g : v) + ((un.pn - 8) & 7) * BM + wc * 32 + 8 * fq;
#pragma unroll
            for (int ai = 0; ai < 2; ++ai)
#pragma unroll
                for (int m = 0; m < 4; ++m) { bf16_t* rowp = base + (size_t)(row0 + ai * HALF + m * 16) * 2048;
#pragma unroll
                    for (int bj = 0; bj < 2; ++bj) { f32x4 v0 = acc[ai][bj][m][0], v1 = acc[ai][bj][m][1];
                        if (isg) {
#pragma unroll
                            for (int e = 0; e < 4; ++e) { v0[e] = fsilu(v0[e]); v1[e] = fsilu(v1[e]); } }
                        *(u32x4*)(rowp + bj * HALF) = pack8(v0, v1); } }
        }
    }
};
struct EpiGates {
    static constexpr bool PERM = true, AFTER_DRAIN = false;
    const float* bm; bf16_t* gates;
    __device__ __forceinline__ void operator()(const f32x4 (&acc)[2][2][4][2], const Unit& un, int wr, int wc, int fr, int fq) const {
        const int row0 = un.pm * BM + wr * 64 + fr, col0 = un.pn * BM + wc * 32 + 8 * fq;
        f32x4 bv[2][2];
#pragma unroll
        for (int bj = 0; bj < 2; ++bj)
#pragma unroll
            for (int n = 0; n < 2; ++n) bv[bj][n] = *(const f32x4*)(bm + col0 + bj * HALF + 4 * n);
#pragma unroll
        for (int ai = 0; ai < 2; ++ai)
#pragma unroll
            for (int m = 0; m < 4; ++m) { bf16_t* rowp = gates + (size_t)(row0 + ai * HALF + m * 16) * 2048 + col0;
#pragma unroll
                for (int bj = 0; bj < 2; ++bj) { f32x4 v0 = acc[ai][bj][m][0] + bv[bj][0], v1 = acc[ai][bj][m][1] + bv[bj][1];
#pragma unroll
                    for (int e = 0; e < 4; ++e) { v0[e] = fsig(v0[e]); v1[e] = fsig(v1[e]); }
                    *(u32x4*)(rowp + bj * HALF) = pack8(v0, v1); } }
    }
};
template <int MODE> struct EpiMerge {
    static constexpr bool PERM = true, AFTER_DRAIN = false;
    const bf16_t* gates; const bf16_t* m1in; bf16_t* o;
    __device__ __forceinline__ void operator()(const f32x4 (&acc)[2][2][4][2], const Unit& un, int wr, int wc, int fr, int fq) const {
        const int row0 = un.pm * BM + wr * 64 + fr, col0 = un.pn * BM + wc * 32 + 8 * fq;
#pragma unroll
        for (int ai = 0; ai < 2; ++ai)
#pragma unroll
            for (int m = 0; m < 4; ++m) { const size_t r = (size_t)(row0 + ai * HALF + m * 16);
#pragma unroll
                for (int bj = 0; bj < 2; ++bj) { const int c = col0 + bj * HALF;
                    f32x4 g0, g1; unpack8(*(const u32x4*)(gates + r * 2048 + MODE * 1024 + c), g0, g1);
                    f32x4 v0 = acc[ai][bj][m][0] * g0, v1 = acc[ai][bj][m][1] * g1;
                    if (MODE == 1) { f32x4 p0, p1; unpack8(*(const u32x4*)(m1in + r * 1024 + c), p0, p1); v0 += p0; v1 += p1; }
                    *(u32x4*)(o + r * 1024 + c) = pack8(v0, v1); } }
    }
};
struct EpiOut {
    static constexpr bool PERM = true, AFTER_DRAIN = false;
    const float* x; bf16_t* y; float alpha;
    __device__ __forceinline__ void operator()(const f32x4 (&acc)[2][2][4][2], const Unit& un, int wr, int wc, int fr, int fq) const {
        const int row0 = un.pm * BM + wr * 64 + fr, col0 = un.pn * BM + wc * 32 + 8 * fq;
#pragma unroll
        for (int ai = 0; ai < 2; ++ai)
#pragma unroll
            for (int m = 0; m < 4; ++m) { const size_t off = (size_t)(row0 + ai * HALF + m * 16) * 1024 + col0;
#pragma unroll
                for (int bj = 0; bj < 2; ++bj) { const f32x4 x0 = *(const f32x4*)(x + off + bj * HALF), x1 = *(const f32x4*)(x + off + bj * HALF + 4);
                    *(u32x4*)(y + off + bj * HALF) = pack8(x0 * alpha + acc[ai][bj][m][0], x1 * alpha + acc[ai][bj][m][1]); } }
    }
};
struct MoeTab { int tileStart[33]; int cnt[32]; int pad_[3]; int tileExp[320]; };
__device__ __forceinline__ void moe_build_tab(PG8_LAS MoeTab* tab, const int* cnt) {
    if (otid() == 0) { int t = 0; for (int e = 0; e < 32; ++e) { const int c = cnt[e * 64], nt = (c + 255) >> 8; tab->tileStart[e] = t; tab->cnt[e] = c; for (int i = 0; i < nt; ++i) tab->tileExp[t + i] = e; t += nt; } tab->tileStart[32] = t; }
    __syncthreads();
}
template <bool GATHER> struct MoeOrder {
    int U, G, c; const PG8_LAS MoeTab* tab; const int* list;
    __device__ __forceinline__ bool next(int i, Unit& u) const {
        const long L = (long)i * G + c; if (L >= U) return false;
        int wgid = (int)L; { const int q = U / NXCD, r = U % NXCD, xcd = wgid % NXCD, off = wgid / NXCD; wgid = (xcd < r ? xcd * (q + 1) : r * (q + 1) + (xcd - r) * q) + off; }
        u.pm = wgid >> 2; u.pn = tab->tileExp[u.pm] * 4 + (wgid & 3); return true;
    }
    __device__ __forceinline__ void a_ready(const Unit&) const {}
    __device__ __forceinline__ void done(const Unit&) const {}
    __device__ __forceinline__ const char* a_base(const Gemm& g, const Unit& u) const { return GATHER ? (const char*)g.A : (const char*)g.A + (size_t)u.pm * (size_t)(BM * g.K * 2); }
    __device__ __forceinline__ void a_off(const Gemm& g, const Unit& u, const int (&R)[2], const int (&C)[2], unsigned (&v)[2][2]) const {
        if (!GATHER) { _Pragma("unroll") for (int hh = 0; hh < 2; ++hh) _Pragma("unroll") for (int i = 0; i < 2; ++i) v[hh][i] = (unsigned)((hh * HALF + R[i]) * g.K + C[i]) * 2u; }
        else { const int e = u.pn >> 2, base = (u.pm - tab->tileStart[e]) * BM, ce = tab->cnt[e];
            _Pragma("unroll") for (int hh = 0; hh < 2; ++hh) _Pragma("unroll") for (int i = 0; i < 2; ++i) { const int lr = base + hh * HALF + R[i]; const int tok = (lr < ce) ? (list[e * 32768 + lr] >> 1) : 0; v[hh][i] = (unsigned)(tok * g.K + C[i]) * 2u; } }
    }
};
struct EpiSwiGLU {
    static constexpr bool PERM = true, AFTER_DRAIN = false;
    bf16_t* h;
    __device__ __forceinline__ void operator()(const f32x4 (&acc)[2][2][4][2], const Unit& un, int wr, int wc, int fr, int fq) const {
        const int row0 = un.pm * BM + wr * 64 + fr, col0 = (un.pn & 3) * 128 + wc * 32 + 8 * fq;
#pragma unroll
        for (int ai = 0; ai < 2; ++ai)
#pragma unroll
            for (int m = 0; m < 4; ++m) { f32x4 v0, v1;
#pragma unroll
                for (int e = 0; e < 4; ++e) { v0[e] = fsilu(acc[ai][0][m][0][e]) * acc[ai][1][m][0][e]; v1[e] = fsilu(acc[ai][0][m][1][e]) * acc[ai][1][m][1][e]; }
                *(u32x4*)(h + (size_t)(row0 + ai * HALF + m * 16) * 512 + col0) = pack8(v0, v1); }
    }
};
struct EpiMoeOut {
    static constexpr bool PERM = true, AFTER_DRAIN = false;
    const PG8_LAS MoeTab* tab; const int* list; const float* rw; bf16_t* ys;
    __device__ __forceinline__ void operator()(const f32x4 (&acc)[2][2][4][2], const Unit& un, int wr, int wc, int fr, int fq) const {
        const int e = un.pn >> 2, lrow0 = (un.pm - tab->tileStart[e]) * BM + wr * 64 + fr, ce = tab->cnt[e], col0 = (un.pn & 3) * BM + wc * 32 + 8 * fq;
        int slot[8]; float wgt[8];
#pragma unroll
        for (int i = 0; i < 8; ++i) { const int lr = lrow0 + (i >> 2) * HALF + (i & 3) * 16; slot[i] = (lr < ce) ? list[e * 32768 + lr] : -1; }
#pragma unroll
        for (int i = 0; i < 8; ++i) wgt[i] = (slot[i] >= 0) ? rw[slot[i]] : 0.f;
#pragma unroll
        for (int ai = 0; ai < 2; ++ai)
#pragma unroll
            for (int m = 0; m < 4; ++m) { const int i = ai * 4 + m;
                if (slot[i] >= 0) { const float w = wgt[i]; bf16_t* rowp = ys + (size_t)slot[i] * 1024 + col0;
#pragma unroll
                    for (int bj = 0; bj < 2; ++bj) *(u32x4*)(rowp + bj * HALF) = pack8(acc[ai][bj][m][0] * w, acc[ai][bj][m][1] * w); } }
    }
};

__device__ __forceinline__ float clamp448(float v) { return fminf(fmaxf(v, -448.f), 448.f); }
__device__ __forceinline__ unsigned pk4_fp8(float a, float b, float c, float d) { int p = __builtin_amdgcn_cvt_pk_fp8_f32(clamp448(a), clamp448(b), 0, false); p = __builtin_amdgcn_cvt_pk_fp8_f32(clamp448(c), clamp448(d), p, true); return (unsigned)p; }
constexpr float FP8_SX = 4.f, FP8_SW = 64.f, FP8_SH = 8.f;
struct EpiSwiGLU8 {
    static constexpr bool PERM = true, AFTER_DRAIN = false;
    unsigned char* h;
    __device__ __forceinline__ void operator()(const f32x4 (&acc)[2][2][4][2], const Unit& un, int wr, int wc, int fr, int fq) const {
        const int row0 = un.pm * BM + wr * 64 + fr, col0 = (un.pn & 3) * 128 + wc * 32 + 8 * fq; const float ds = 1.f / (FP8_SX * FP8_SW);
#pragma unroll
        for (int ai = 0; ai < 2; ++ai)
#pragma unroll
            for (int m = 0; m < 4; ++m) { float v[8];
#pragma unroll
                for (int e = 0; e < 4; ++e) { v[e] = FP8_SH * fsilu(acc[ai][0][m][0][e] * ds) * (acc[ai][1][m][0][e] * ds); v[4 + e] = FP8_SH * fsilu(acc[ai][0][m][1][e] * ds) * (acc[ai][1][m][1][e] * ds); }
                uint2 o; o.x = pk4_fp8(v[0], v[1], v[2], v[3]); o.y = pk4_fp8(v[4], v[5], v[6], v[7]);
                *(uint2*)(h + (size_t)(row0 + ai * HALF + m * 16) * 512 + col0) = o; }
    }
};
struct EpiMoeOut8 {
    static constexpr bool PERM = true, AFTER_DRAIN = false;
    const PG8_LAS MoeTab* tab; const int* list; const float* rw; bf16_t* ys;
    __device__ __forceinline__ void operator()(const f32x4 (&acc)[2][2][4][2], const Unit& un, int wr, int wc, int fr, int fq) const {
        const int e = un.pn >> 2, lrow0 = (un.pm - tab->tileStart[e]) * BM + wr * 64 + fr, ce = tab->cnt[e], col0 = (un.pn & 3) * BM + wc * 32 + 8 * fq;
#pragma unroll
        for (int ai = 0; ai < 2; ++ai)
#pragma unroll
            for (int m = 0; m < 4; ++m) { const int lr = lrow0 + ai * HALF + m * 16;
                if (lr < ce) { const int slot = list[e * 32768 + lr]; const float w = rw[slot] * (1.f / (FP8_SH * FP8_SW)); bf16_t* rowp = ys + (size_t)slot * 1024 + col0;
#pragma unroll
                    for (int bj = 0; bj < 2; ++bj) *(u32x4*)(rowp + bj * HALF) = pack8(acc[ai][bj][m][0] * w, acc[ai][bj][m][1] * w); }
                asm volatile("" ::: "memory"); }
    }
};
}

DEV unsigned pk2(float lo, float hi) { return (unsigned)f2bf(lo) | ((unsigned)f2bf(hi) << 16); }
typedef unsigned v4u __attribute__((ext_vector_type(4)));
DEV void transpose_item(const float* W, int K, int N, bf16_t* WT, int row_off, float* scr, int item, int lane) {
    const int nblk = N / 32, kb = item / nblk, nb = item % nblk, k0 = 64 * kb, n0 = 32 * nb;
    float wv[32];
#pragma unroll
    for (int i = 0; i < 32; ++i) wv[i] = W[(size_t)(k0 + 2 * i + (lane >> 5)) * N + n0 + (lane & 31)];
#pragma unroll
    for (int i = 0; i < 32; ++i) scr[(2 * i + (lane >> 5)) * 33 + (lane & 31)] = wv[i];
    asm volatile("s_waitcnt lgkmcnt(0)" ::: "memory");
    const int c = lane & 7;
#pragma unroll
    for (int j = 0; j < 4; ++j) { const int n = (lane >> 3) + 8 * j; const float* s = scr + (8 * c) * 33 + n;
        v4u o; o.x = pk2(s[0 * 33], s[1 * 33]); o.y = pk2(s[2 * 33], s[3 * 33]); o.z = pk2(s[4 * 33], s[5 * 33]); o.w = pk2(s[6 * 33], s[7 * 33]);
        *(v4u*)(WT + (size_t)(row_off + n0 + n) * K + k0 + 8 * c) = o; }
    asm volatile("s_waitcnt lgkmcnt(0)" ::: "memory");
}
DEV void p_weights(float* lds, const float* w_in, const float* w_ret_o, const float* w_lru_o, const float* w_out, const float* w_rg_r, const float* w_rg_i, bf16_t* w_in_t, bf16_t* w_ro_t, bf16_t* w_lo_t, bf16_t* w_out_t, bf16_t* wrg_t) {
    const int wave = otid() >> 6, lane = otid() & 63;
    float* scr = lds + wave * 2304;
    constexpr int I0 = 16 * (WIN_N / 32), I1 = 32 * 32, I2 = 24 * 32, I3 = 16 * 32, I4 = 16 * 18;
    for (int it = blockIdx.x * 8 + wave; it < I0 + I1 + I2 + I3 + I4; it += gridDim.x * 8) {
        int r = it;
        if (r < I0) { transpose_item(w_in, 1024, WIN_N, w_in_t, 0, scr, r, lane); continue; } r -= I0;
        if (r < I1) { transpose_item(w_ret_o, 2048, 1024, w_ro_t, 0, scr, r, lane); continue; } r -= I1;
        if (r < I2) { transpose_item(w_lru_o, 1536, 1024, w_lo_t, 0, scr, r, lane); continue; } r -= I2;
        if (r < I3) { transpose_item(w_out, 1024, 1024, w_out_t, 0, scr, r, lane); continue; } r -= I3;
        { const int mi = r / 18, sub = r - mi * 18; const float* W = (mi < 8 ? w_rg_r + (size_t)mi * 192 * 192 : w_rg_i + (size_t)(mi - 8) * 192 * 192);
          transpose_item(W, 192, 192, wrg_t + (size_t)mi * 192 * 192, 0, scr, sub, lane); }
    }
}


DEV void transpose_item_fp8(const float* W, int K, int N, unsigned char* WT, int row_off, float scale, float* scr, int item, int lane) {
    const int nblk = N / 32, kb = item / nblk, nb = item % nblk, k0 = 64 * kb, n0 = 32 * nb;
    float wv[32];
#pragma unroll
    for (int i = 0; i < 32; ++i) wv[i] = W[(size_t)(k0 + 2 * i + (lane >> 5)) * N + n0 + (lane & 31)];
#pragma unroll
    for (int i = 0; i < 32; ++i) scr[(2 * i + (lane >> 5)) * 33 + (lane & 31)] = wv[i] * scale;
    asm volatile("s_waitcnt lgkmcnt(0)" ::: "memory");
    const int c = lane & 3;
#pragma unroll
    for (int j = 0; j < 2; ++j) { const int n = (lane >> 2) + 16 * j; const float* s = scr + (16 * c) * 33 + n;
        v4u o; o.x = pg8::pk4_fp8(s[0 * 33], s[1 * 33], s[2 * 33], s[3 * 33]); o.y = pg8::pk4_fp8(s[4 * 33], s[5 * 33], s[6 * 33], s[7 * 33]);
        o.z = pg8::pk4_fp8(s[8 * 33], s[9 * 33], s[10 * 33], s[11 * 33]); o.w = pg8::pk4_fp8(s[12 * 33], s[13 * 33], s[14 * 33], s[15 * 33]);
        *(v4u*)(WT + (size_t)(row_off + n0 + n) * K + k0 + 16 * c) = o; }
    asm volatile("s_waitcnt lgkmcnt(0)" ::: "memory");
}
DEV void p_expert_weights(float* lds, const float* w_eg, const float* w_eu, const float* w_ed, unsigned char* wgu8, unsigned char* wd8) {
    const int wave = otid() >> 6, lane = otid() & 63;
    float* scr = lds + wave * 2304;
    for (int it = blockIdx.x * 8 + wave; it < 3 * 8192; it += gridDim.x * 8) {
        const int kind = it >> 13, r = it & 8191, e = r >> 8, sub = r & 255;
        if (kind < 2) { const int nb = sub & 15; transpose_item_fp8((kind ? w_eu : w_eg) + (size_t)e * 1024 * 512, 1024, 512, wgu8 + (size_t)e * 1024 * 1024, (nb >> 2) * 128 + kind * 128, pg8::FP8_SW, scr, sub, lane); }
        else transpose_item_fp8(w_ed + (size_t)e * 512 * 1024, 512, 1024, wd8 + (size_t)e * 1024 * 512, 0, pg8::FP8_SW, scr, sub, lane);
    }
}

DEV void p_router_consts(float* lds, const float* g1, const float* b1, const float* wg, const float* bg, const float* we, const float* be, float* sb, unsigned char* rtab) {
    int tq_ = otid(); asm volatile("" : "+v"(tq_));
    for (int p = blockIdx.x * NTHR + tq_; p < 9216; p += gridDim.x * NTHR) {
        int T, part, kq, stride; const float* srcp;
        if (p < 8192) { const int col = p & 15, nt = (p >> 6) & 1; kq = (p >> 4) & 3; part = (p >> 7) & 1; T = p >> 8; srcp = we + 16 * nt + col; stride = 32; }
        else { const int p2 = p - 8192, col = p2 & 3; kq = (p2 >> 2) & 3; part = (p2 >> 4) & 1; T = p2 >> 5; srcp = wg + col; stride = 4; }
        const int k0 = 32 * T + 8 * kq;
        unsigned o[4];
#pragma unroll
        for (int j2 = 0; j2 < 4; ++j2) { unsigned pr = 0;
#pragma unroll
            for (int e = 0; e < 2; ++e) { const int kk = k0 + 2 * j2 + e; const float wv_ = g1[kk] * srcp[(size_t)kk * stride];
                const bf16_t hi = f2bf(wv_); const bf16_t val = part ? f2bf(wv_ - bf2f(hi)) : hi; pr |= (unsigned)val << (16 * e); }
            o[j2] = pr; }
        *(u32x4_t*)(rtab + (size_t)p * 16) = (u32x4_t){o[0], o[1], o[2], o[3]};
    }
    if (blockIdx.x != 0) return;
    const int t = otid(), wv = t >> 6, lane = t & 63;
    float s[36], q[36];
#pragma unroll
    for (int c = 0; c < 36; ++c) { s[c] = 0.f; q[c] = 0.f; }
#pragma unroll
    for (int kk = 0; kk < 2; ++kk) { const int k = t + 512 * kk; const float gk = g1[k], bk = b1[k];
#pragma unroll
        for (int c4 = 0; c4 < 9; ++c4) { const float4 w = (c4 < 8) ? *(const float4*)(we + (size_t)k * 32 + c4 * 4) : *(const float4*)(wg + (size_t)k * 4);
            s[4 * c4] += gk * w.x; s[4 * c4 + 1] += gk * w.y; s[4 * c4 + 2] += gk * w.z; s[4 * c4 + 3] += gk * w.w;
            q[4 * c4] += bk * w.x; q[4 * c4 + 1] += bk * w.y; q[4 * c4 + 2] += bk * w.z; q[4 * c4 + 3] += bk * w.w; } }
#pragma unroll
    for (int m = 1; m < 64; m <<= 1) {
#pragma unroll
        for (int c = 0; c < 36; ++c) { s[c] += __shfl_xor(s[c], m); q[c] += __shfl_xor(q[c], m); } }
    if (lane == 0) {
#pragma unroll
        for (int c = 0; c < 36; ++c) { lds[wv * 96 + c] = s[c]; lds[wv * 96 + 48 + c] = q[c]; } }
    __syncthreads();
    if (t < 96) { const int cc = t % 48; float v = 0.f;
        if (cc < 36) { for (int p = 0; p < 8; ++p) v += lds[p * 96 + t]; if (t >= 48) v += (cc < 32) ? be[cc] : bg[cc - 32]; }
        sb[t] = v; }
    __syncthreads();
}
DEV void p_cvt_x(const float* x, bf16_t* xb) {
    const size_t n4 = (size_t)NTOK * DM / 4, stride = (size_t)gridDim.x * NTHR;
    for (size_t i0 = (size_t)blockIdx.x * NTHR + otid(); i0 < n4; i0 += 8 * stride) {
        float4 t[8];
#pragma unroll
        for (int u = 0; u < 8; ++u) { const size_t i = i0 + u * stride; t[u] = (i < n4) ? ((const float4*)x)[i] : make_float4(0.f, 0.f, 0.f, 0.f); }
#pragma unroll
        for (int u = 0; u < 8; ++u) { const size_t i = i0 + u * stride; if (i < n4) { uint2 o; o.x = pg8::cvt_pk_bf16(t[u].x, t[u].y); o.y = pg8::cvt_pk_bf16(t[u].z, t[u].w); ((uint2*)xb)[i] = o; } }
    }
}
DEV void p_rope_table(float2* tab) {
    for (int i = blockIdx.x * NTHR + otid(); i < 8192 * 128; i += gridDim.x * NTHR) {
        const int s = i >> 7, j = i & 127;
        const double r = 0.93057204092969897;
        double inv = 1.0; for (int t = 0; t < j; ++t) inv *= r;
        const double ang = (double)s * inv;
        const double twopi_hi = 6.283185307179586232, twopi_lo = 2.4492935982947064e-16;
        const double n = rint(ang / twopi_hi);
        const double x = (ang - n * twopi_hi) - n * twopi_lo;
        const double x2 = x * x;
        double acc = 1.0 - x2 * (1.0 / (22.0 * 23.0));
#pragma unroll
        for (int k = 21; k >= 3; k -= 2) acc = 1.0 - x2 * (1.0 / ((double)(k - 1) * (double)k)) * acc;
        double acc2 = 1.0 - x2 * (1.0 / (21.0 * 22.0));
#pragma unroll
        for (int k = 20; k >= 2; k -= 2) acc2 = 1.0 - x2 * (1.0 / ((double)(k - 1) * (double)k)) * acc2;
        tab[i] = make_float2((float)acc2, (float)(x * acc));
    }
}

typedef float f32x4_t __attribute__((ext_vector_type(4)));
typedef short s16x4_t __attribute__((ext_vector_type(4)));
constexpr int LRU_ROWB = 400;
DEV void p_lru_compute(unsigned char* lds, const bf16_t* ulru, const float* cw, const float* cb, const bf16_t* wrg_t,
                       const float* b_r, const float* b_i, const float* lam, bf16_t* epsb, bf16_t* xinb, float* segA, float* segH) {
    int tid_ = otid(); asm volatile("" : "+v"(tid_));
    const int tid = tid_, wave = tid >> 6, lane = tid & 63, fr = lane & 15, fq = lane >> 4, wr = wave >> 2, wc = wave & 3;
    unsigned char* stg = lds + 256 * LRU_ROWB + wave * 4096;
    for (int item = blockIdx.x; item < 1024; item += gridDim.x) {
        const int n = item & 7, b = (item >> 3) & 3, seg = item >> 5;
        const size_t t0 = (size_t)b * SEQ + seg * 256;
#pragma unroll 4
        for (int idx = tid; idx < 256 * 24; idx += NTHR) {
            const int r = idx / 24, c8 = idx - r * 24, ch0 = n * 192 + c8 * 8;
            float acc[8];
            { const float4 c0 = *(const float4*)(cb + ch0), c1 = *(const float4*)(cb + ch0 + 4); acc[0] = c0.x; acc[1] = c0.y; acc[2] = c0.z; acc[3] = c0.w; acc[4] = c1.x; acc[5] = c1.y; acc[6] = c1.z; acc[7] = c1.w; }
#pragma unroll
            for (int j = 0; j < 4; ++j) {
                if (seg * 256 + r - 3 + j >= 0) {
                    const uint4 uv = *(const uint4*)(ulru + (t0 + r - 3 + j) * 1536 + ch0);
                    const float4 w0 = *(const float4*)(cw + j * 1536 + ch0), w1 = *(const float4*)(cw + j * 1536 + ch0 + 4);
                    acc[0] += w0.x * __uint_as_float(uv.x << 16); acc[1] += w0.y * __uint_as_float(uv.x & 0xffff0000u);
                    acc[2] += w0.z * __uint_as_float(uv.y << 16); acc[3] += w0.w * __uint_as_float(uv.y & 0xffff0000u);
                    acc[4] += w1.x * __uint_as_float(uv.z << 16); acc[5] += w1.y * __uint_as_float(uv.z & 0xffff0000u);
                    acc[6] += w1.z * __uint_as_float(uv.w << 16); acc[7] += w1.w * __uint_as_float(uv.w & 0xffff0000u);
                }
            }
            uint4 o; o.x = pg8::cvt_pk_bf16(acc[0], acc[1]); o.y = pg8::cvt_pk_bf16(acc[2], acc[3]); o.z = pg8::cvt_pk_bf16(acc[4], acc[5]); o.w = pg8::cvt_pk_bf16(acc[6], acc[7]);
            *(uint4*)(lds + r * LRU_ROWB + c8 * 16) = o;
        }
        __syncthreads();
        float cbr[3], cbi[3], csp[3], hrun[3], atot[3];
        const int sub = seg * 2 + wr;
#pragma unroll
        for (int tc = 0; tc < 3; ++tc) { const int ch = n * 192 + 48 * wc + 16 * tc + fr; cbr[tc] = b_r[ch]; cbi[tc] = b_i[ch]; csp[tc] = 8.f * 1.4426950408889634f * log1pf(__expf(-lam[ch])); atot[tc] = 1.f; hrun[tc] = 0.f; }
        const bf16_t* wrb = wrg_t + ((size_t)n * 192 + 48 * wc + fr) * 192 + fq * 8;
        const bf16_t* wib = wrb + (size_t)8 * 192 * 192;
#pragma unroll
        for (int tc = 0; tc < 3; ++tc) {
            bf16x8_t bfr[6][2];
#pragma unroll
            for (int ks = 0; ks < 6; ++ks) { bfr[ks][0] = *(const bf16x8_t*)(wrb + tc * 16 * 192 + ks * 32); bfr[ks][1] = *(const bf16x8_t*)(wib + tc * 16 * 192 + ks * 32); }
#pragma unroll
            for (int p = 0; p < 2; ++p) {
                const int rowb = 128 * wr + 64 * p;
                f32x4_t acc[4][2];
#pragma unroll
                for (int m = 0; m < 4; ++m) { acc[m][0] = (f32x4_t){0.f, 0.f, 0.f, 0.f}; acc[m][1] = (f32x4_t){0.f, 0.f, 0.f, 0.f}; }
#pragma unroll
                for (int ks = 0; ks < 6; ++ks) {
                    bf16x8_t afr[4];
#pragma unroll
                    for (int m = 0; m < 4; ++m) afr[m] = *(const bf16x8_t*)(lds + (rowb + 16 * (fr >> 2) + 4 * m + (fr & 3)) * LRU_ROWB + ks * 64 + fq * 16);
#pragma unroll
                    for (int m = 0; m < 4; ++m) { acc[m][0] = __builtin_amdgcn_mfma_f32_16x16x32_bf16(afr[m], bfr[ks][0], acc[m][0], 0, 0, 0); acc[m][1] = __builtin_amdgcn_mfma_f32_16x16x32_bf16(afr[m], bfr[ks][1], acc[m][1], 0, 0, 0); }
                }
                const int coff = (48 * wc + 16 * tc + fr) * 2;
                const unsigned char* up = lds + (rowb + 16 * fq) * LRU_ROWB + coff;
                float Al = 1.f, Bl = 0.f;
                unsigned pe[8], px[8];
#pragma unroll
                for (int m = 0; m < 4; ++m) {
                    float ee[4], xx[4];
#pragma unroll
                    for (int j = 0; j < 4; ++j) {
                        const float rr = pg8::fsig(acc[m][0][j] + cbr[tc]), ii = pg8::fsig(acc[m][1][j] + cbi[tc]);
                        const float aa = __builtin_amdgcn_exp2f(-csp[tc] * rr);
                        const float u = bf2f(*(const bf16_t*)(up + (4 * m + j) * LRU_ROWB));
                        const float om = 1.f - aa;
                        const float x = __builtin_amdgcn_sqrtf(fmaxf(om * (1.f + aa), 0.f)) * ii * u;
                        ee[j] = om; xx[j] = x; Bl = aa * Bl + x; Al *= aa;
                    }
                    pe[2 * m] = pg8::cvt_pk_bf16(ee[0], ee[1]); pe[2 * m + 1] = pg8::cvt_pk_bf16(ee[2], ee[3]);
                    px[2 * m] = pg8::cvt_pk_bf16(xx[0], xx[1]); px[2 * m + 1] = pg8::cvt_pk_bf16(xx[2], xx[3]);
                }
                { float h = hrun[tc], ap = 1.f;
#pragma unroll
                  for (int q = 0; q < 4; ++q) { const float Aq = __shfl(Al, fr + 16 * q), Bq = __shfl(Bl, fr + 16 * q); h = Aq * h + Bq; ap *= Aq; }
                  hrun[tc] = h; atot[tc] *= ap; }
#pragma unroll
                for (int m = 0; m < 4; ++m)
#pragma unroll
                    for (int j = 0; j < 4; ++j) { const int tk = 16 * fq + 4 * m + j; const unsigned we = pe[2 * m + (j >> 1)], wx = px[2 * m + (j >> 1)];
                        *(bf16_t*)(stg + tk * 32 + fr * 2) = (bf16_t)((j & 1) ? (we >> 16) : (we & 0xffff));
                        *(bf16_t*)(stg + 2048 + tk * 32 + fr * 2) = (bf16_t)((j & 1) ? (wx >> 16) : (wx & 0xffff)); }
                asm volatile("s_waitcnt lgkmcnt(0)" ::: "memory");
#pragma unroll
                for (int i = 0; i < 2; ++i) { const int piece = lane + 64 * i, tk = piece >> 1, hf = piece & 1;
                    const size_t go = (t0 + rowb + tk) * 1536 + n * 192 + 48 * wc + 16 * tc + 8 * hf;
                    *(u32x4_t*)(epsb + go) = *(const u32x4_t*)(stg + tk * 32 + hf * 16);
                    *(u32x4_t*)(xinb + go) = *(const u32x4_t*)(stg + 2048 + tk * 32 + hf * 16); }
                asm volatile("s_waitcnt lgkmcnt(0)" ::: "memory");
            }
        }
        if (fq == 0) {
#pragma unroll
            for (int tc = 0; tc < 3; ++tc) { const size_t o = ((size_t)b * 64 + sub) * 1536 + n * 192 + 48 * wc + 16 * tc + fr; segA[o] = atot[tc]; segH[o] = hrun[tc]; }
        }
        __syncthreads();
    }
}
DEV void p_lru_scan(const bf16_t* epsb, const bf16_t* xinb, bf16_t* gl, const float* carry) {
    const int tid = otid();
    if (tid >= 384) return;
    for (int item = blockIdx.x; item < 256; item += gridDim.x) {
        const int b = item >> 6, sub = item & 63;
        const size_t base = ((size_t)b * SEQ + sub * 128) * 1536 + tid * 4;
        const float4 cin = *(const float4*)(carry + ((size_t)b * 64 + sub) * 1536 + tid * 4);
        float h0 = cin.x, h1 = cin.y, h2 = cin.z, h3 = cin.w;
#pragma unroll 8
        for (int t = 0; t < 128; ++t) {
            const size_t o = base + (size_t)t * 1536;
            const uint2 ev = *(const uint2*)(epsb + o), xv = *(const uint2*)(xinb + o), gv = *(const uint2*)(gl + o);
            h0 = (1.f - __uint_as_float(ev.x << 16)) * h0 + __uint_as_float(xv.x << 16);
            h1 = (1.f - __uint_as_float(ev.x & 0xffff0000u)) * h1 + __uint_as_float(xv.x & 0xffff0000u);
            h2 = (1.f - __uint_as_float(ev.y << 16)) * h2 + __uint_as_float(xv.y << 16);
            h3 = (1.f - __uint_as_float(ev.y & 0xffff0000u)) * h3 + __uint_as_float(xv.y & 0xffff0000u);
            uint2 ov; ov.x = pg8::cvt_pk_bf16(h0 * __uint_as_float(gv.x << 16), h1 * __uint_as_float(gv.x & 0xffff0000u)); ov.y = pg8::cvt_pk_bf16(h2 * __uint_as_float(gv.y << 16), h3 * __uint_as_float(gv.y & 0xffff0000u));
            *(uint2*)(gl + o) = ov;
        }
    }
}
DEV void p_lru_carry(float* lds, const float* segA, const float* segH, float* carry) {
    float* tA = lds; float* tH = lds + 64 * 65;
    for (int item = blockIdx.x; item < 96; item += gridDim.x) {
        const int b = item / 24, c0 = (item % 24) * 64;
        for (int i = otid(); i < 64 * 64; i += NTHR) { const int s = i >> 6, c = i & 63; const size_t o = ((size_t)b * 64 + s) * 1536 + c0 + c; tA[s * 65 + c] = segA[o]; tH[s * 65 + c] = segH[o]; }
        __syncthreads();
        if (otid() < 64) { const int c = otid(); float h = 0.f;
            for (int s = 0; s < 64; ++s) { const float a = tA[s * 65 + c], hh = tH[s * 65 + c]; tA[s * 65 + c] = h; h = a * h + hh; } }
        __syncthreads();
        for (int i = otid(); i < 64 * 64; i += NTHR) { const int s = i >> 6, c = i & 63; carry[((size_t)b * 64 + s) * 1536 + c0 + c] = tA[s * 65 + c]; }
        __syncthreads();
    }
}
#define LDS_BARRIER() do { asm volatile("s_waitcnt lgkmcnt(0)" ::: "memory"); __builtin_amdgcn_s_barrier(); asm volatile("" ::: "memory"); } while (0)
DEV void p_scores(unsigned char* lds, const bf16_t* q, const bf16_t* k, bf16_t* P) {
    int tid_ = otid(); asm volatile("" : "+v"(tid_));
    const int tid = tid_, w = tid >> 6, lane = tid & 63, fr = lane & 15, fq = lane >> 4;
    const int krow = tid >> 5, kch = tid & 31;
    u32x4_t kreg[8]; bf16x8_t qa[8];
    int g = blockIdx.x;
    if (g < 1024) { const int c = g & 63, bh = g >> 6, b = bh >> 2, h = bh & 3; const size_t tok0 = (size_t)b * SEQ + c * 128;
        const bf16_t* kc = k + tok0 * 1024 + h * 256;
#pragma unroll
        for (int ii = 0; ii < 8; ++ii) kreg[ii] = *(const u32x4_t*)(kc + (size_t)(krow + 16 * ii) * 1024 + kch * 8);
        const bf16_t* qp = q + ((tok0 >> 7) * 4 + h) * 32768 + (fq * 128 + 16 * w + fr) * 8;
#pragma unroll
        for (int ks = 0; ks < 8; ++ks) qa[ks] = *(const bf16x8_t*)(qp + ks * 4096); }
    for (; g < 1024; g += gridDim.x) {
#pragma unroll
        for (int ii = 0; ii < 8; ++ii) *(u32x4_t*)(lds + (krow + 16 * ii) * 528 + kch * 16) = kreg[ii];
        bf16x8_t qc[8];
#pragma unroll
        for (int ks = 0; ks < 8; ++ks) qc[ks] = qa[ks];
        const int gn = g + gridDim.x;
        if (gn < 1024) { const int c = gn & 63, bh = gn >> 6, b = bh >> 2, h = bh & 3; const size_t tok0 = (size_t)b * SEQ + c * 128;
            const bf16_t* kc = k + tok0 * 1024 + h * 256;
#pragma unroll
            for (int ii = 0; ii < 8; ++ii) kreg[ii] = *(const u32x4_t*)(kc + (size_t)(krow + 16 * ii) * 1024 + kch * 8);
            const bf16_t* qp = q + ((tok0 >> 7) * 4 + h) * 32768 + (fq * 128 + 16 * w + fr) * 8;
#pragma unroll
            for (int ks = 0; ks < 8; ++ks) qa[ks] = *(const bf16x8_t*)(qp + ks * 4096); }
        LDS_BARRIER();
        f32x4_t acc[8];
#pragma unroll
        for (int nt = 0; nt < 8; ++nt) acc[nt] = (f32x4_t){0.f, 0.f, 0.f, 0.f};
#pragma unroll
        for (int ks = 0; ks < 8; ++ks)
#pragma unroll
            for (int nt = 0; nt < 8; ++nt) { const bf16x8_t bb = *(const bf16x8_t*)(lds + (16 * nt + fr) * 528 + ks * 64 + fq * 16); acc[nt] = __builtin_amdgcn_mfma_f32_16x16x32_bf16(bb, qc[ks], acc[nt], 0, 0, 0); }
        {
            const int c = g & 63, bh = g >> 6, b = bh >> 2, h = bh & 3;
            bf16_t* kt = const_cast<bf16_t*>(k) + ((size_t)b * SEQ + c * 128 + fq * 8 + w) * 1024 + h * 256 + fr * 8;
#pragma unroll
            for (int ks = 0; ks < 4; ++ks)
#pragma unroll
                for (int di = 0; di < 2; ++di) {
                    const unsigned char* kp = lds + (32 * ks + 8 * fq + (fr >> 2)) * 528 + (16 * (2 * w + di) + 4 * (fr & 3)) * 2;
                    const s16x4_t t0 = __builtin_amdgcn_ds_read_tr16_b64_v4i16((LAS s16x4_t*)(kp));
                    const s16x4_t t1 = __builtin_amdgcn_ds_read_tr16_b64_v4i16((LAS s16x4_t*)(kp + 4 * 528));
                    *(bf16x8_t*)(kt + ks * 32768 + di * 128) = (bf16x8_t){t0[0], t0[1], t0[2], t0[3], t1[0], t1[1], t1[2], t1[3]};
                }
        }
        LDS_BARRIER();
        bf16_t* Pg = P + (size_t)g * 16384 + ((fq >> 1) * 128 + 16 * w + fr) * 8 + 4 * (fq & 1);
        int mrow = 16 * w + fr - 4 * fq; asm volatile("" : "+v"(mrow));
#pragma unroll
        for (int nt = 0; nt < 8; ++nt) {
            uint2 o; o.x = pg8::cvt_pk_bf16((16 * nt <= mrow) ? acc[nt][0] : 0.f, (16 * nt + 1 <= mrow) ? acc[nt][1] : 0.f);
            o.y = pg8::cvt_pk_bf16((16 * nt + 2 <= mrow) ? acc[nt][2] : 0.f, (16 * nt + 3 <= mrow) ? acc[nt][3] : 0.f);
            *(uint2*)(Pg + ((nt >> 1) * 4 + 2 * (nt & 1)) * 1024) = o; }
    }
    __syncthreads();
}
constexpr int RT_KS = 528, RT_VS = 272, RT_V = 0, RT_U = 2 * 32 * RT_VS;
DEV void p_ret_mfma(unsigned char* lds, const bf16_t* q, const bf16_t* k, bf16_t* v, const bf16_t* P) {
    int tid_ = otid(); asm volatile("" : "+v"(tid_));
    const int tid = tid_, w = tid >> 6, lane = tid & 63, fr = lane & 15, fq = lane >> 4;
    for (int wk = blockIdx.x; wk < 256; wk += gridDim.x) {
        const int xcd = wk & 7, idx = wk >> 3, bh = xcd * 2 + (idx >> 4), sl = idx & 15, b = bh >> 2, h = bh & 3;
        float g128; { const double gam = 1.0 - exp2(-5.0 - (double)h); g128 = (float)exp2(128.0 * log2(gam)); }
        asm volatile("" : "+v"(g128));
        f32x4_t accU[2][2];
#pragma unroll
        for (int et = 0; et < 2; ++et)
#pragma unroll
            for (int di = 0; di < 2; ++di) accU[et][di] = (f32x4_t){0.f, 0.f, 0.f, 0.f};
        for (int i = tid; i < 32 * RT_KS / 4; i += NTHR) ((unsigned*)(lds + RT_U))[i] = 0u;
        const size_t tokb = (size_t)b * SEQ;
        const int vm = tid >> 2, ve = (tid & 3) * 8;
        const bf16_t* vsl = v + tokb * 2048 + h * 512 + sl * 32;
#define RT_STAGE_V(buf, vr) do { unsigned char* vp_ = lds + RT_V + (buf) * 32 * RT_VS + ve * RT_VS + vm * 2; \
            *(bf16_t*)(vp_ + 0 * RT_VS) = (bf16_t)((vr)[0] & 0xffff); *(bf16_t*)(vp_ + 1 * RT_VS) = (bf16_t)((vr)[0] >> 16); \
            *(bf16_t*)(vp_ + 2 * RT_VS) = (bf16_t)((vr)[1] & 0xffff); *(bf16_t*)(vp_ + 3 * RT_VS) = (bf16_t)((vr)[1] >> 16); \
            *(bf16_t*)(vp_ + 4 * RT_VS) = (bf16_t)((vr)[2] & 0xffff); *(bf16_t*)(vp_ + 5 * RT_VS) = (bf16_t)((vr)[2] >> 16); \
            *(bf16_t*)(vp_ + 6 * RT_VS) = (bf16_t)((vr)[3] & 0xffff); *(bf16_t*)(vp_ + 7 * RT_VS) = (bf16_t)((vr)[3] >> 16); } while (0)
        u32x4_t vreg = *(const u32x4_t*)(vsl + (size_t)vm * 2048 + ve);
        RT_STAGE_V(0, vreg);
        vreg = *(const u32x4_t*)(vsl + (size_t)(128 + vm) * 2048 + ve);
        bf16x8_t qa[8], pa[4], kb[2][4];
        const bf16_t* qp = q + ((tokb >> 7) * 4 + h) * 32768 + (fq * 128 + 16 * w + fr) * 8;
        const bf16_t* pp = P + (size_t)(bh * 64) * 16384 + (fq * 128 + 16 * w + fr) * 8;
        const bf16_t* kp = k + (tokb + fq * 8 + w) * 1024 + h * 256 + fr * 8;
        {
#pragma unroll
            for (int ks = 0; ks < 8; ++ks) qa[ks] = *(const bf16x8_t*)(qp + ks * 4096);
#pragma unroll
            for (int ks = 0; ks < 4; ++ks) { if (2 * ks <= w) pa[ks] = *(const bf16x8_t*)(pp + ks * 4096); else pa[ks] = (bf16x8_t){0, 0, 0, 0, 0, 0, 0, 0}; }
#pragma unroll
            for (int di = 0; di < 2; ++di)
#pragma unroll
                for (int ks = 0; ks < 4; ++ks) kb[di][ks] = *(const bf16x8_t*)(kp + ks * 32768 + di * 128);
        }
        LDS_BARRIER();
#pragma unroll 1
        for (int c = 0; c < 64; ++c) {
            const size_t tok0 = tokb + c * 128;
            const unsigned char* ldsU = lds + RT_U + (c & 1) * 32 * RT_KS;
            const unsigned char* ldsV = lds + RT_V + (c & 1) * 32 * RT_VS;
            f32x4_t ao[2] = {(f32x4_t){0.f, 0.f, 0.f, 0.f}, (f32x4_t){0.f, 0.f, 0.f, 0.f}};
            {
                bf16x8_t bu[8];
#pragma unroll
                for (int nt = 0; nt < 2; ++nt) {
#pragma unroll
                    for (int ks = 0; ks < 8; ++ks) bu[ks] = *(const bf16x8_t*)(ldsU + (16 * nt + fr) * RT_KS + ks * 64 + fq * 16);
#pragma unroll
                    for (int ks = 0; ks < 8; ++ks) ao[nt] = __builtin_amdgcn_mfma_f32_16x16x32_bf16(bu[ks], qa[ks], ao[nt], 0, 0, 0);
                }
            }
            bf16x8_t bv[2][4];
#pragma unroll
            for (int nt = 0; nt < 2; ++nt)
#pragma unroll
                for (int ks = 0; ks < 4; ++ks) bv[nt][ks] = *(const bf16x8_t*)(ldsV + (16 * nt + fr) * RT_VS + ks * 64 + fq * 16);
#pragma unroll
            for (int ks = 0; ks < 4; ++ks)
#pragma unroll
                for (int nt = 0; nt < 2; ++nt) ao[nt] = __builtin_amdgcn_mfma_f32_16x16x32_bf16(bv[nt][ks], pa[ks], ao[nt], 0, 0, 0);
            if (c + 1 < 64) {
                const bf16_t* qn = qp + (size_t)(c + 1) * 131072;
#pragma unroll
                for (int ks = 0; ks < 8; ++ks) qa[ks] = *(const bf16x8_t*)(qn + ks * 4096);
                const bf16_t* pn = pp + (size_t)(c + 1) * 16384;
#pragma unroll
                for (int ks = 0; ks < 4; ++ks) if (2 * ks <= w) pa[ks] = *(const bf16x8_t*)(pn + ks * 4096);
            }
            {
                bf16_t* vc = v + (tok0 + 16 * w + fr) * 2048 + h * 512 + sl * 32 + 4 * fq;
#pragma unroll
                for (int nt = 0; nt < 2; ++nt) { uint2 o; o.x = pg8::cvt_pk_bf16(ao[nt][0], ao[nt][1]); o.y = pg8::cvt_pk_bf16(ao[nt][2], ao[nt][3]); *(uint2*)(vc + 16 * nt) = o; }
            }
#pragma unroll
            for (int ks = 0; ks < 4; ++ks)
#pragma unroll
                for (int di = 0; di < 2; ++di)
#pragma unroll
                    for (int et = 0; et < 2; ++et) accU[et][di] = __builtin_amdgcn_mfma_f32_16x16x32_bf16(kb[di][ks], bv[et][ks], accU[et][di], 0, 0, 0);
            if (c + 1 < 64) {
                const bf16_t* kn = kp + (size_t)(c + 1) * 131072;
#pragma unroll
                for (int di = 0; di < 2; ++di)
#pragma unroll
                    for (int ks = 0; ks < 4; ++ks) kb[di][ks] = *(const bf16x8_t*)(kn + ks * 32768 + di * 128);
            }
#pragma unroll
            for (int et = 0; et < 2; ++et)
#pragma unroll
                for (int di = 0; di < 2; ++di) accU[et][di] = accU[et][di] * g128;
            {
                unsigned char* un = lds + RT_U + ((c + 1) & 1) * 32 * RT_KS;
#pragma unroll
                for (int et = 0; et < 2; ++et)
#pragma unroll
                    for (int di = 0; di < 2; ++di) { uint2 o; o.x = pg8::cvt_pk_bf16(accU[et][di][0], accU[et][di][1]); o.y = pg8::cvt_pk_bf16(accU[et][di][2], accU[et][di][3]);
                        *(uint2*)(un + (16 * et + fr) * RT_KS + (16 * (2 * w + di) + 4 * fq) * 2) = o; }
                if (c + 1 < 64) { RT_STAGE_V((c + 1) & 1, vreg); }
                if (c + 2 < 64) vreg = *(const u32x4_t*)(vsl + (size_t)((c + 2) * 128 + vm) * 2048 + ve);
            }
            LDS_BARRIER();
        }
#undef RT_STAGE_V
        __syncthreads();
    }
}
DEV void p_headnorm(bf16_t* ret, const bf16_t* g) {
    const int lane = otid() & 63;
    for (int w = (blockIdx.x * NTHR + otid()) >> 6; w < NTOK * 4; w += gridDim.x * (NTHR / 64)) {
        const size_t o = (size_t)w * 512 + lane * 8;
        const u32x4_t rv = *(const u32x4_t*)(ret + o), gv = *(const u32x4_t*)(g + o);
        float x[8], gg[8]; float s = 0.f;
#pragma unroll
        for (int j = 0; j < 4; ++j) { x[2 * j] = __uint_as_float(rv[j] << 16); x[2 * j + 1] = __uint_as_float(rv[j] & 0xffff0000u); gg[2 * j] = __uint_as_float(gv[j] << 16); gg[2 * j + 1] = __uint_as_float(gv[j] & 0xffff0000u); }
#pragma unroll
        for (int j = 0; j < 8; ++j) s += x[j];
#pragma unroll
        for (int m = 1; m < 64; m <<= 1) s += __shfl_xor(s, m);
        const float mu = s * (1.f / 512.f); float q = 0.f;
#pragma unroll
        for (int j = 0; j < 8; ++j) { x[j] -= mu; q += x[j] * x[j]; }
#pragma unroll
        for (int m = 1; m < 64; m <<= 1) q += __shfl_xor(q, m);
        const float rstd = rsqrtf(q * (1.f / 512.f) + LN_EPS);
        u32x4_t ov;
#pragma unroll
        for (int j = 0; j < 4; ++j) ov[j] = pg8::cvt_pk_bf16(x[2 * j] * rstd * gg[2 * j], x[2 * j + 1] * rstd * gg[2 * j + 1]);
        *(u32x4_t*)(ret + o) = ov;
    }
}

typedef float f32x4v __attribute__((ext_vector_type(4)));
DEV void p_ln1_route(float* lds, const bf16_t* y, bf16_t* x1b, unsigned char* x1q, const float* g1, const float* b1, const unsigned char* rtab,
                     int2* route_e, float2* route_w, int* cnt, int* list, const float* sb) {
    int tid_ = otid(); asm volatile("" : "+v"(tid_));
    const int tid = tid_, wv = tid >> 6, lane = tid & 63, r16 = lane & 15, kq = lane >> 4;
    const unsigned char* Wt = (const unsigned char*)lds;
    float* Sc = lds + 1024 * 36;
    float* Bc = Sc + 48;
    int* lcnt = (int*)(Bc + 48);
    int* rowE = lcnt + 32;
    int* rowP = rowE + 256;
#pragma unroll 6
    for (int i = tid; i < 9216; i += NTHR) ((u32x4_t*)lds)[i] = ((const u32x4_t*)rtab)[i];
    if (tid < 32) lcnt[tid] = 0;
    __syncthreads();
    if (tid < 96) Sc[tid] = sb[tid];
    __syncthreads();
    constexpr int rows_per_wg = 128;
    for (int blk = blockIdx.x; blk < NTOK / rows_per_wg; blk += gridDim.x) {
    { const int tile = wv;
        const int lrow0 = tile * 16, row0 = blk * rows_per_wg + lrow0;
        const bf16_t* yp = y + (size_t)(row0 + r16) * 1024 + 8 * kq;
        const unsigned char* tb = Wt + lane * 16;
        const unsigned char* tb2 = Wt + 131072 + (kq * 4 + (r16 & 3)) * 16;
        f32x4v acc[3] = {(f32x4v){0.f, 0.f, 0.f, 0.f}, (f32x4v){0.f, 0.f, 0.f, 0.f}, (f32x4v){0.f, 0.f, 0.f, 0.f}};
        float s1 = 0.f, s2 = 0.f;
#pragma unroll 4
        for (int T = 0; T < 32; ++T) {
            const u32x4_t yr = *(const u32x4_t*)(yp + 32 * T);
#pragma unroll
            for (int e = 0; e < 4; ++e) { const float lo = __uint_as_float(yr[e] << 16), hi = __uint_as_float(yr[e] & 0xffff0000u); s1 += lo + hi; s2 += lo * lo + hi * hi; }
            const bf16x8_t a = __builtin_bit_cast(bf16x8_t, yr);
#pragma unroll
            for (int part = 0; part < 2; ++part) {
#pragma unroll
                for (int nt = 0; nt < 2; ++nt) acc[nt] = __builtin_amdgcn_mfma_f32_16x16x32_bf16(a, *(const bf16x8_t*)(tb + ((T * 2 + part) * 2 + nt) * 1024), acc[nt], 0, 0, 0);
                acc[2] = __builtin_amdgcn_mfma_f32_16x16x32_bf16(a, *(const bf16x8_t*)(tb2 + (T * 2 + part) * 256), acc[2], 0, 0, 0);
            }
        }
        s1 += __shfl_xor(s1, 16); s1 += __shfl_xor(s1, 32); s2 += __shfl_xor(s2, 16); s2 += __shfl_xor(s2, 32);
        const float mu = s1 * (1.f / 1024.f), rstd = rsqrtf(fmaxf(s2 * (1.f / 1024.f) - mu * mu, 0.f) + LN_EPS);
        {
            float gA[8], bA[8], gB[8], bB[8];
#pragma unroll
            for (int e = 0; e < 2; ++e) { const float4 t0 = *(const float4*)(g1 + 8 * lane + 4 * e), t1 = *(const float4*)(b1 + 8 * lane + 4 * e), t2 = *(const float4*)(g1 + 512 + 8 * lane + 4 * e), t3 = *(const float4*)(b1 + 512 + 8 * lane + 4 * e);
                gA[4 * e] = t0.x; gA[4 * e + 1] = t0.y; gA[4 * e + 2] = t0.z; gA[4 * e + 3] = t0.w; bA[4 * e] = t1.x; bA[4 * e + 1] = t1.y; bA[4 * e + 2] = t1.z; bA[4 * e + 3] = t1.w;
                gB[4 * e] = t2.x; gB[4 * e + 1] = t2.y; gB[4 * e + 2] = t2.z; gB[4 * e + 3] = t2.w; bB[4 * e] = t3.x; bB[4 * e + 1] = t3.y; bB[4 * e + 2] = t3.z; bB[4 * e + 3] = t3.w; }
#pragma unroll 2
            for (int rr = 0; rr < 16; ++rr) {
                const float mur = __shfl(mu, rr), rsr = __shfl(rstd, rr);
                const size_t ro = (size_t)(row0 + rr) * 1024 + 8 * lane;
                const u32x4_t ya = *(const u32x4_t*)(y + ro), yb = *(const u32x4_t*)(y + ro + 512);
                float oa[8], ob[8];
#pragma unroll
                for (int e = 0; e < 4; ++e) {
                    oa[2 * e] = (__uint_as_float(ya[e] << 16) - mur) * rsr * gA[2 * e] + bA[2 * e]; oa[2 * e + 1] = (__uint_as_float(ya[e] & 0xffff0000u) - mur) * rsr * gA[2 * e + 1] + bA[2 * e + 1];
                    ob[2 * e] = (__uint_as_float(yb[e] << 16) - mur) * rsr * gB[2 * e] + bB[2 * e]; ob[2 * e + 1] = (__uint_as_float(yb[e] & 0xffff0000u) - mur) * rsr * gB[2 * e + 1] + bB[2 * e + 1]; }
                *(u32x4_t*)(x1b + ro) = (u32x4_t){pg8::cvt_pk_bf16(oa[0], oa[1]), pg8::cvt_pk_bf16(oa[2], oa[3]), pg8::cvt_pk_bf16(oa[4], oa[5]), pg8::cvt_pk_bf16(oa[6], oa[7])};
                *(u32x4_t*)(x1b + ro + 512) = (u32x4_t){pg8::cvt_pk_bf16(ob[0], ob[1]), pg8::cvt_pk_bf16(ob[2], ob[3]), pg8::cvt_pk_bf16(ob[4], ob[5]), pg8::cvt_pk_bf16(ob[6], ob[7])};
                uint2 qa_, qb_;
                qa_.x = pg8::pk4_fp8(oa[0] * pg8::FP8_SX, oa[1] * pg8::FP8_SX, oa[2] * pg8::FP8_SX, oa[3] * pg8::FP8_SX); qa_.y = pg8::pk4_fp8(oa[4] * pg8::FP8_SX, oa[5] * pg8::FP8_SX, oa[6] * pg8::FP8_SX, oa[7] * pg8::FP8_SX);
                qb_.x = pg8::pk4_fp8(ob[0] * pg8::FP8_SX, ob[1] * pg8::FP8_SX, ob[2] * pg8::FP8_SX, ob[3] * pg8::FP8_SX); qb_.y = pg8::pk4_fp8(ob[4] * pg8::FP8_SX, ob[5] * pg8::FP8_SX, ob[6] * pg8::FP8_SX, ob[7] * pg8::FP8_SX);
                *(uint2*)(x1q + ro) = qa_; *(uint2*)(x1q + ro + 512) = qb_;
            }
        }
#pragma unroll
        for (int j = 0; j < 4; ++j) {
            const int rl = 4 * kq + j;
            const float mur = __shfl(mu, rl), rsr = __shfl(rstd, rl);
            float lg[3];
#pragma unroll
            for (int nt = 0; nt < 3; ++nt) lg[nt] = rsr * (acc[nt][j] - mur * Sc[16 * nt + r16]) + Bc[16 * nt + r16];
            const int gb = 16 * kq;
            const float g0 = __shfl(lg[2], gb + 0), g1v = __shfl(lg[2], gb + 1), g2 = __shfl(lg[2], gb + 2), g3 = __shfl(lg[2], gb + 3);
            int gi = 0; float gm = g0; if (g1v > gm) { gm = g1v; gi = 1; } if (g2 > gm) { gm = g2; gi = 2; } if (g3 > gm) { gm = g3; gi = 3; }
            const float gw = 1.f / (expf(g0 - gm) + expf(g1v - gm) + expf(g2 - gm) + expf(g3 - gm));
            const float lsel = (gi & 2) ? lg[1] : lg[0];
            float ev[8];
#pragma unroll
            for (int t = 0; t < 8; ++t) ev[t] = __shfl(lsel, gb + (gi & 1) * 8 + t);
            int i1 = 0; float v1 = ev[0];
#pragma unroll
            for (int t = 1; t < 8; ++t) if (ev[t] > v1) { v1 = ev[t]; i1 = t; }
            int i2 = -1; float v2 = -INFINITY;
#pragma unroll
            for (int t = 0; t < 8; ++t) if (t != i1 && ev[t] > v2) { v2 = ev[t]; i2 = t; }
            const float w1 = 1.f / (1.f + expf(v2 - v1)), w2 = 1.f - w1;
            if (r16 == 0) {
                const int lr = lrow0 + rl, r = row0 + rl, e1 = gi * 8 + i1, e2 = gi * 8 + i2;
                route_e[r] = make_int2(e1, e2); route_w[r] = make_float2(gw * w1, gw * w2);
                rowE[2 * lr] = e1; rowP[2 * lr] = atomicAdd(&lcnt[e1], 1);
                rowE[2 * lr + 1] = e2; rowP[2 * lr + 1] = atomicAdd(&lcnt[e2], 1);
            }
        }
    }
    __syncthreads();
    if (tid < 32) lcnt[tid] = atomicAdd(&cnt[tid * 64], lcnt[tid]);
    __syncthreads();
    for (int i = tid; i < 2 * rows_per_wg; i += NTHR) { const int e = rowE[i]; list[e * 32768 + lcnt[e] + rowP[i]] = (blk * rows_per_wg + (i >> 1)) * 2 + (i & 1); }
    __syncthreads();
    if (tid < 32) lcnt[tid] = 0;
    __syncthreads();
    }
}

DEV void p_final(float* out, const bf16_t* x1b, const bf16_t* ys, const float* g2, const float* b2) {
    const int lane = otid() & 63;
    for (int r = (blockIdx.x * NTHR + otid()) >> 6; r < NTOK; r += gridDim.x * (NTHR / 64)) {
        float x[16]; float s = 0.f;
#pragma unroll
        for (int j = 0; j < 4; ++j) { const int col = j * 256 + lane * 4; const ushort4 tb = *(const ushort4*)(x1b + (size_t)r * 1024 + col); const float4 t = make_float4(bf2f(tb.x), bf2f(tb.y), bf2f(tb.z), bf2f(tb.w));
            const ushort4 a = *(const ushort4*)(ys + (size_t)(2 * r) * 1024 + col), b = *(const ushort4*)(ys + (size_t)(2 * r + 1) * 1024 + col);
            x[4 * j] = ALPHA * t.x + bf2f(a.x) + bf2f(b.x); x[4 * j + 1] = ALPHA * t.y + bf2f(a.y) + bf2f(b.y); x[4 * j + 2] = ALPHA * t.z + bf2f(a.z) + bf2f(b.z); x[4 * j + 3] = ALPHA * t.w + bf2f(a.w) + bf2f(b.w);
            s += (x[4 * j] + x[4 * j + 1]) + (x[4 * j + 2] + x[4 * j + 3]); }
#pragma unroll
        for (int m = 1; m < 64; m <<= 1) s += __shfl_xor(s, m);
        const float mu = s * (1.f / 1024.f); float q = 0.f;
#pragma unroll
        for (int j = 0; j < 16; ++j) { x[j] -= mu; q += x[j] * x[j]; }
#pragma unroll
        for (int m = 1; m < 64; m <<= 1) q += __shfl_xor(q, m);
        const float rstd = rsqrtf(q * (1.f / 1024.f) + LN_EPS);
#pragma unroll
        for (int j = 0; j < 4; ++j) { const int col = j * 256 + lane * 4; const float4 gg = *(const float4*)(g2 + col), bb = *(const float4*)(b2 + col);
            *(float4*)(out + (size_t)r * 1024 + col) = make_float4(x[4 * j] * rstd * gg.x + bb.x, x[4 * j + 1] * rstd * gg.y + bb.y, x[4 * j + 2] * rstd * gg.z + bb.z, x[4 * j + 3] * rstd * gg.w + bb.w); }
    }
}

struct Args { const float* in[24]; float* out; unsigned char* ws; };
__global__ void __launch_bounds__(NTHR, 2) mega_fwd(Args a) {
    extern __shared__ __attribute__((aligned(16))) unsigned char lds_raw[];
    float* ldsf = (float*)lds_raw;
    PG8_LAS unsigned char* ldsl = (PG8_LAS unsigned char*)lds_raw;
    volatile LAS unsigned* MISC = (volatile LAS unsigned*)((LAS unsigned char*)lds_raw + LDS_MISC);
    for (int u = otid(); u < 128; u += NTHR) MISC[u] = 0u;
    __syncthreads();
    unsigned char* ws = a.ws;
    XcdBarrier bar = xcd_barrier_post((unsigned*)(ws + WS_CTL) + CW_BAR, MISC + 8);
#define GRID_BAR() xcd_barrier(bar)
    const float* x = a.in[0]; const float* w_in = a.in[1]; const float* b_merge = a.in[2];
    const float* conv_w = a.in[3]; const float* conv_b = a.in[4];
    const float* w_rg_r = a.in[5]; const float* b_rg_r = a.in[6]; const float* w_rg_i = a.in[7]; const float* b_rg_i = a.in[8];
    const float* lam = a.in[9]; const float* w_ret_o = a.in[10]; const float* w_lru_o = a.in[11]; const float* w_out = a.in[12];
    const float* ln1_g = a.in[13]; const float* ln1_b = a.in[14]; const float* w_group = a.in[15]; const float* b_group = a.in[16];
    const float* w_er = a.in[17]; const float* b_er = a.in[18]; const float* w_eg = a.in[19]; const float* w_eu = a.in[20];
    const float* w_ed = a.in[21]; const float* ln2_g = a.in[22]; const float* ln2_b = a.in[23];
    float* out = a.out;
    int* cnt = (int*)(ws + WS_CTL); float2* rope = (float2*)(ws + WS_ROPE); int2* route_e = (int2*)(ws + WS_ROUTE_E); float2* route_w = (float2*)(ws + WS_ROUTE_W); int* list = (int*)(ws + WS_LIST);
    bf16_t* xb = (bf16_t*)(ws + WS_XB); bf16_t* gl = (bf16_t*)(ws + WS_GL); bf16_t* ulru = (bf16_t*)(ws + WS_ULRU); bf16_t* uconv = (bf16_t*)(ws + WS_UCONV);
    bf16_t* epsb = (bf16_t*)(ws + WS_EPS); bf16_t* inp = (bf16_t*)out;
    bf16_t* q = (bf16_t*)(ws + WS_Q); bf16_t* k = (bf16_t*)(ws + WS_K); bf16_t* v = (bf16_t*)(ws + WS_V); bf16_t* gbuf = (bf16_t*)out;
    bf16_t* P = (bf16_t*)(ws + WS_P); bf16_t* gates = (bf16_t*)(ws + WS_GATES); bf16_t* m1 = (bf16_t*)out; bf16_t* merged = xb;
    bf16_t* w_in_t = (bf16_t*)(ws + WS_WIN_T); bf16_t* w_ro_t = (bf16_t*)(ws + WS_WRO_T); bf16_t* w_lo_t = (bf16_t*)(ws + WS_WLO_T); bf16_t* w_out_t = (bf16_t*)(ws + WS_WOUT_T);
    bf16_t* wrg_t = (bf16_t*)(ws + WS_WRG_T); float* segA = (float*)(ws + WS_SEGA); float* segH = (float*)(ws + WS_SEGH); float* carry = (float*)(ws + WS_CARRY);
    float* rsb = (float*)(ws + WS_RSB);
    unsigned char* wgu8 = ws + WS_WGU_T; unsigned char* wd8 = ws + WS_WD_T; unsigned char* x1q = ws + WS_X1Q;
    bf16_t* x1b = gl; bf16_t* hbuf = (bf16_t*)(ws + WS_H); bf16_t* ys = (bf16_t*)(ws + WS_YSLOT);

    p_router_consts(ldsf, ln1_g, ln1_b, w_group, b_group, w_er, b_er, rsb, ws + WS_RTAB); p_cvt_x(x, xb); p_rope_table(rope); p_weights(ldsf, w_in, w_ret_o, w_lru_o, w_out, w_rg_r, w_rg_i, w_in_t, w_ro_t, w_lo_t, w_out_t, wrg_t);
    GRID_BAR();
    { pg8::Gemm g{xb, w_in_t + (size_t)C_U * 1024, NTOK, 3072, 1024}; pg8::StaticOrder S; S.init(NTOK, 3072, (int)gridDim.x, (int)blockIdx.x);
      pg8::gemm_phase<pg8::EpiLruIn, pg8::StaticOrder, true, true>(ldsl, g, S, pg8::EpiLruIn{ulru, gl}); }
    GRID_BAR();
    p_lru_compute(lds_raw, ulru, conv_w, conv_b, wrg_t, b_rg_r, b_rg_i, lam, uconv, epsb, segA, segH);
    GRID_BAR();
    p_lru_carry(ldsf, segA, segH, carry);
    GRID_BAR();
    p_lru_scan(uconv, epsb, gl, carry);
    GRID_BAR();
    { pg8::Gemm g{xb, w_in_t, NTOK, 6144, 1024}; pg8::StaticOrder S; S.init(NTOK, 6144, (int)gridDim.x, (int)blockIdx.x);
      pg8::gemm_phase<pg8::EpiRetIn, pg8::StaticOrder, true, true>(ldsl, g, S, pg8::EpiRetIn{q, k, v, gbuf, (const float*)rope}); }
    GRID_BAR();
    p_scores(lds_raw, q, k, P);
    GRID_BAR();
    p_ret_mfma(lds_raw, q, k, v, P);
    GRID_BAR();
    p_headnorm(v, gbuf);
    { pg8::Gemm g{xb, w_in_t + (size_t)C_GATE * 1024, NTOK, 2048, 1024}; pg8::StaticOrder S; S.init(NTOK, 2048, (int)gridDim.x, (int)blockIdx.x);
      pg8::gemm_phase<pg8::EpiGates, pg8::StaticOrder, true, true>(ldsl, g, S, pg8::EpiGates{b_merge, gates}); }
    GRID_BAR();
    { pg8::Gemm g{v, w_ro_t, NTOK, 1024, 2048}; pg8::StaticOrder S; S.init(NTOK, 1024, (int)gridDim.x, (int)blockIdx.x);
      pg8::gemm_phase<pg8::EpiMerge<0>, pg8::StaticOrder, true, true>(ldsl, g, S, pg8::EpiMerge<0>{gates, nullptr, m1}); }
    GRID_BAR();
    { pg8::Gemm g{gl, w_lo_t, NTOK, 1024, 1536}; pg8::StaticOrder S; S.init(NTOK, 1024, (int)gridDim.x, (int)blockIdx.x);
      pg8::gemm_phase<pg8::EpiMerge<1>, pg8::StaticOrder, true, true>(ldsl, g, S, pg8::EpiMerge<1>{gates, m1, merged}); }
    GRID_BAR();
    { pg8::Gemm g{merged, w_out_t, NTOK, 1024, 1024}; pg8::StaticOrder S; S.init(NTOK, 1024, (int)gridDim.x, (int)blockIdx.x);
      pg8::gemm_phase<pg8::EpiOut, pg8::StaticOrder, true, true>(ldsl, g, S, pg8::EpiOut{x, (bf16_t*)out, ALPHA}); }
    GRID_BAR();
    p_ln1_route(ldsf, (const bf16_t*)out, x1b, x1q, ln1_g, ln1_b, ws + WS_RTAB, route_e, route_w, cnt, list, rsb);
    p_expert_weights(ldsf, w_eg, w_eu, w_ed, wgu8, wd8);
    GRID_BAR();
    {
        PG8_LAS pg8::MoeTab* tab = (PG8_LAS pg8::MoeTab*)(ldsl + LDS_TAB);
        pg8::moe_build_tab(tab, cnt);
        const int T = tab->tileStart[32];
        { pg8::Gemm g{(const bf16_t*)x1q, (const bf16_t*)wgu8, T * 256, 32 * 1024, 512}; pg8::MoeOrder<true> S{T * 4, (int)gridDim.x, (int)blockIdx.x, tab, list};
          pg8::gemm_phase<pg8::EpiSwiGLU8, pg8::MoeOrder<true>, true, true, true>(ldsl, g, S, pg8::EpiSwiGLU8{(unsigned char*)hbuf}); }
        GRID_BAR();
        { pg8::Gemm g{hbuf, (const bf16_t*)wd8, T * 256, 32 * 1024, 256}; pg8::MoeOrder<false> S{T * 4, (int)gridDim.x, (int)blockIdx.x, tab, list};
          pg8::gemm_phase<pg8::EpiMoeOut8, pg8::MoeOrder<false>, true, true, true>(ldsl, g, S, pg8::EpiMoeOut8{tab, list, (const float*)route_w, ys}); }
    }
    GRID_BAR();
    p_final(out, x1b, ys, ln2_g, ln2_b);
}

extern "C" void kernel_launch(void* const* d_in, const int* in_sizes, int n_in, void* d_out, int out_size, void* d_ws, size_t ws_size, hipStream_t stream) {
    static int grid = 0;
    if (grid == 0) {
        if (n_in != 24 || in_sizes[0] != NTOK * DM || out_size != NTOK * DM || ws_size < WS_END) {
            fprintf(stderr, "kernel_launch: unexpected shapes (n_in %d, in0 %d, out %d, ws %zu)\n", n_in, n_in > 0 ? in_sizes[0] : -1, out_size, ws_size); grid = -1; return; }
        int dev = 0, cus = 0, per_cu = 0;
        if (hipGetDevice(&dev) != hipSuccess || hipDeviceGetAttribute(&cus, hipDeviceAttributeMultiprocessorCount, dev) != hipSuccess) { fprintf(stderr, "kernel_launch: device query failed\n"); grid = -1; return; }
        if (hipFuncSetAttribute((const void*)mega_fwd, hipFuncAttributeMaxDynamicSharedMemorySize, LDS_BYTES) != hipSuccess) { fprintf(stderr, "kernel_launch: hipFuncSetAttribute failed\n"); grid = -1; return; }
        if (hipOccupancyMaxActiveBlocksPerMultiprocessor(&per_cu, (const void*)mega_fwd, NTHR, LDS_BYTES) != hipSuccess || per_cu < 1) {
            fprintf(stderr, "kernel_launch: occupancy query reports %d workgroups per CU\n", per_cu); (void)hipGetLastError(); grid = -1; return; }
        grid = cus;
    }
    if (grid < 0) return;
    if (hipMemsetAsync((char*)d_ws + WS_CTL, 0, CTL_ZERO_BYTES, stream) != hipSuccess) { fprintf(stderr, "kernel_launch: memset failed\n"); return; }
    Args a{};
    for (int i = 0; i < 24; ++i) a.in[i] = (const float*)d_in[i];
    a.out = (float*)d_out; a.ws = (unsigned char*)d_ws;
    hipLaunchKernelGGL(mega_fwd, dim3(grid), dim3(NTHR), LDS_BYTES, stream, a);
    const hipError_t le = hipPeekAtLastError();
    if (le != hipSuccess) fprintf(stderr, "kernel_launch: launch failed: %s\n", hipGetErrorName(le));
}
```

```cpp
#include <hip/hip_runtime.h>
#include <cstdio>
#include <cstdint>

typedef unsigned short bf16_t;
#define DEV __device__ __forceinline__
#define LAS __attribute__((address_space(3)))

DEV int otid() { int t = threadIdx.x; asm volatile("" : "+v"(t)); return t; }
DEV float bf2f(bf16_t h) { return __uint_as_float(((unsigned)h) << 16); }
typedef short bf16x8_t __attribute__((ext_vector_type(8)));
typedef unsigned u32x4_t __attribute__((ext_vector_type(4)));
DEV bf16_t f2bf(float f) { unsigned u = __float_as_uint(f); return (bf16_t)((u + 0x7fffu + ((u >> 16) & 1u)) >> 16); }

constexpr int NTHR = 512;
constexpr int NTOK = 32768, DM = 1024, SEQ = 8192;
constexpr int WIN_N = 11264;
constexpr int C_Q = 0, C_K = 1024, C_V = 2048, C_G = 4096, C_U = 6144, C_GL = 7680, C_GATE = 9216;
constexpr float ALPHA = 1.189207115002721f;
constexpr float LN_EPS = 1e-5f;
constexpr size_t MiB = 1u << 20;
constexpr size_t WS_CTL = 0;
constexpr size_t CTL_ZERO_BYTES = 1 * MiB;
constexpr int CW_BAR = 4096;
constexpr size_t WS_ROPE = 1 * MiB;
constexpr size_t WS_ROUTE_E = 9 * MiB;
constexpr size_t WS_ROUTE_W = 9 * MiB + 512 * 1024;
constexpr size_t WS_LIST = 10 * MiB;
constexpr size_t WS_WRG_T = 14 * MiB;
constexpr size_t WS_RSB = 15 * MiB + 512 * 1024;
constexpr size_t WS_RTAB = 22 * MiB;
constexpr size_t WS_SEGA = 16 * MiB;
constexpr size_t WS_SEGH = 18 * MiB;
constexpr size_t WS_CARRY = 20 * MiB;
constexpr size_t WS_XB = 32 * MiB;
constexpr size_t WS_GL = 96 * MiB;
constexpr size_t WS_ULRU = 192 * MiB;
constexpr size_t WS_Q = 192 * MiB;
constexpr size_t WS_K = 256 * MiB;
constexpr size_t WS_GATES = 192 * MiB;
constexpr size_t WS_UCONV = 288 * MiB;
constexpr size_t WS_P = 320 * MiB;
constexpr size_t WS_V = 352 * MiB;
constexpr size_t WS_EPS = 384 * MiB;
constexpr size_t WS_H = 192 * MiB;
constexpr size_t WS_YSLOT = 264 * MiB;
constexpr size_t WS_WGU_T = 352 * MiB;
constexpr size_t WS_WD_T = 416 * MiB;
constexpr size_t WS_X1Q = 160 * MiB;
constexpr int LDS_TAB = 131072;
constexpr size_t WS_WIN_T = 480 * MiB;
constexpr size_t WS_WRO_T = 502 * MiB;
constexpr size_t WS_WLO_T = 506 * MiB;
constexpr size_t WS_WOUT_T = 509 * MiB;
constexpr size_t WS_END = 512 * MiB;
constexpr int LDS_BYTES = 163840;
constexpr int LDS_MISC = 163840 - 512;

#define XB_TMO      128
#define XB_XCNT(j)  (256  + 64 * (j))
#define XB_XSUB(j)  (1280 + 64 * (j))
#define XB_XGEN(j)  (2304 + 64 * (j))
#define XB_TOP      3328
#define XB_TOPGEN   3392
#define XCD_BAR_WORDS 3456
#define XB_SPIN_CAP (1u << 22)
DEV unsigned xb_ld(unsigned* p)              { return __hip_atomic_load(p, __ATOMIC_RELAXED, __HIP_MEMORY_SCOPE_AGENT); }
DEV unsigned xb_add(unsigned* p, unsigned v) { return __hip_atomic_fetch_add(p, v, __ATOMIC_RELAXED, __HIP_MEMORY_SCOPE_AGENT); }
DEV unsigned xb_xcc_id() { return (unsigned)__builtin_amdgcn_s_getreg((3 << 11) | 20) & 0xFu; }
#define XB_SPIN(cond, bar) do { unsigned _sp = 0; while (cond) { __builtin_amdgcn_s_sleep(1); \
    if ((++_sp & 255u) == 0u) { if (xb_ld(&(bar)[XB_TMO])) break; if (_sp > XB_SPIN_CAP) { atomicAdd(&(bar)[XB_TMO], 1u); break; } } } } while (0)
struct XcdBarrier { unsigned* bar; unsigned x; volatile LAS unsigned* st; };
DEV XcdBarrier xcd_barrier_post(unsigned* bar, volatile LAS unsigned* st) {
    XcdBarrier b; b.bar = bar; b.x = xb_xcc_id(); b.st = st;
    if (otid() == 0) (void)xb_add(&bar[XB_XCNT(b.x)], 1u);
    return b;
}
DEV void xcd_barrier_complete(unsigned* bar, unsigned x, unsigned& nloc, unsigned& nx) {
    const unsigned G = gridDim.x * gridDim.y * gridDim.z;
    unsigned sum, cnt, mine, sp = 0u;
    for (;;) {
        sum = 0u; cnt = 0u; mine = 0u;
#pragma unroll
        for (unsigned j = 0; j < 16; ++j) { const unsigned c = xb_ld(&bar[XB_XCNT(j)]); sum += c; cnt += (c > 0u) ? 1u : 0u; mine = (j == x) ? c : mine; }
        if (sum == G) break;
        __builtin_amdgcn_s_sleep(1);
        if ((++sp & 255u) == 0u) { if (xb_ld(&bar[XB_TMO])) break; if (sp > XB_SPIN_CAP) { atomicAdd(&bar[XB_TMO], 1u); break; } }
    }
    nloc = mine > 0u ? mine : 1u; nx = cnt > 0u ? cnt : 1u;
}
DEV void xcd_barrier(const XcdBarrier& b) {
    asm volatile("s_waitcnt vmcnt(0)" ::: "memory");
    __syncthreads();
    if (otid() == 0) {
        unsigned* bar = b.bar;
        __builtin_amdgcn_s_waitcnt(0);
        unsigned nloc = b.st[0], nx = b.st[1];
        if (nloc == 0u) { xcd_barrier_complete(bar, b.x, nloc, nx); b.st[0] = nloc; b.st[1] = nx; }
        const unsigned old = xb_add(&bar[XB_XSUB(b.x)], 1u);
        const unsigned gen = old / nloc;
        if (old + 1u == (gen + 1u) * nloc) {
            __builtin_amdgcn_fence(__ATOMIC_RELEASE, "agent");
            asm volatile("s_waitcnt vmcnt(0)" ::: "memory");
            const unsigned og = xb_add(&bar[XB_TOP], 1u);
            const unsigned tg = og / nx;
            if (og + 1u == (tg + 1u) * nx) xb_add(&bar[XB_TOPGEN], 1u);
            else XB_SPIN(xb_ld(&bar[XB_TOPGEN]) == tg, bar);
            __builtin_amdgcn_fence(__ATOMIC_ACQUIRE, "agent");
            xb_add(&bar[XB_XGEN(b.x)], 1u);
            asm volatile("s_waitcnt vmcnt(0)" ::: "memory");
        } else {
            XB_SPIN(xb_ld(&bar[XB_XGEN(b.x)]) == gen, bar);
            __builtin_amdgcn_fence(__ATOMIC_ACQUIRE, "agent");
            asm volatile("s_waitcnt vmcnt(0)" ::: "memory");
        }
    }
    __syncthreads();
}

namespace pg8 {
#define PG8_LAS __attribute__((address_space(3)))
typedef unsigned short bf16_t;
typedef short bf16x8 __attribute__((ext_vector_type(8)));
typedef float f32x4 __attribute__((ext_vector_type(4)));
typedef unsigned u32x4 __attribute__((ext_vector_type(4)));
constexpr int BM = 256, BK = 64, HALF = 128, HTB = HALF * BK * 2  , STAGE_BYTES = 8 * HTB, NXCD = 8, WGM = 8;

__host__ __device__ __forceinline__ int lds_byte(int r, int c) { const int st = (r >> 4) * 2 + (c >> 5), rr = r & 15, cc = c & 31, ob = rr * 64 + cc * 2; return st * 1024 + (ob ^ (((ob >> 9) & 1) << 5)); }
__host__ __device__ __forceinline__ void stage_rc(int b, int& R, int& C) { const int st = b / 1024, sb = b % 1024, swz = sb ^ (((sb >> 9) & 1) << 5); R = (st >> 1) * 16 + swz / 64; C = (st & 1) * 32 + (swz % 64) / 2; }
__host__ __device__ __forceinline__ int perm32(int rho) { const int n = rho >> 4, i = rho & 15; return 8 * (i >> 2) + 4 * n + (i & 3); }

struct Unit { int pm, pn; };
struct Gemm { const bf16_t* A; const bf16_t* Bt; int M, N, K; };

struct StaticOrder {
    int nM, nN, nwg, G, c;
    __host__ __device__ void init(int M, int N, int G_, int c_) { nM = M / BM; nN = N / BM; nwg = nM * nN; G = G_; c = c_; }
    __host__ __device__ bool next(int i, Unit& u) const {
        const long L = (long)i * G + c; if (L >= nwg) return false;
        int wgid = (int)L; { const int q = nwg / NXCD, r = nwg % NXCD, xcd = wgid % NXCD, off = wgid / NXCD; wgid = (xcd < r ? xcd * (q + 1) : r * (q + 1) + (xcd - r) * q) + off; }
        const int nig = WGM * nN, gid = wgid / nig, fm = gid * WGM, gsz = (nM - fm) < WGM ? (nM - fm) : WGM;
        u.pm = fm + ((wgid % nig) % gsz); u.pn = (wgid % nig) / gsz; return true;
    }
    __device__ __forceinline__ void a_ready(const Unit&) const {}
    __device__ __forceinline__ void done(const Unit&) const {}
    __device__ __forceinline__ const char* a_base(const Gemm& g, const Unit& u) const { return (const char*)g.A + (size_t)u.pm * (size_t)(BM * g.K * 2); }
    __device__ __forceinline__ void a_off(const Gemm& g, const Unit&, const int (&R)[2], const int (&C)[2], unsigned (&v)[2][2]) const {
        _Pragma("unroll") for (int hh = 0; hh < 2; ++hh) _Pragma("unroll") for (int i = 0; i < 2; ++i) v[hh][i] = (unsigned)((hh * HALF + R[i]) * g.K + C[i]) * 2u; }
};
typedef __bf16 bf16x2_t __attribute__((ext_vector_type(2)));
typedef float f32x2_t __attribute__((ext_vector_type(2)));
__device__ __forceinline__ unsigned cvt_pk_bf16(float lo, float hi) { f32x2_t v = {lo, hi}; return __builtin_bit_cast(unsigned, __builtin_convertvector(v, bf16x2_t)); }
typedef int i32x4 __attribute__((ext_vector_type(4)));
typedef int i32x8 __attribute__((ext_vector_type(8)));
template <bool MX8> struct Frag { struct A4 { bf16x8 v[4][2]; }; struct B2 { bf16x8 v[2][2]; }; };
template <> struct Frag<true> { struct A4 { i32x8 v[4]; }; struct B2 { i32x8 v[2]; }; };
__device__ __forceinline__ i32x8 ld32(const PG8_LAS unsigned char* p0, const PG8_LAS unsigned char* p1) { const i32x4 a = *(const PG8_LAS i32x4*)p0, b = *(const PG8_LAS i32x4*)p1; return __builtin_shufflevector(a, b, 0, 1, 2, 3, 4, 5, 6, 7); }
template <class Epi, class Sched, bool ALIGN_EPI = false, bool SP2 = false, bool MX8 = false>
__device__ __forceinline__ void gemm_phase(PG8_LAS unsigned char* lds, const Gemm g, const Sched& S, const Epi& E) {
    int tid_ = otid(); asm volatile("" : "+v"(tid_));
    const int tid = tid_, wid = __builtin_amdgcn_readfirstlane(tid >> 6), lane = tid & 63, wr = wid >> 2, wc = wid & 3, fr = lane & 15, fq = lane >> 4;
    const int K = g.K, nt = K / BK;
    unsigned voffB[2], vA[2][2], vN[2][2]; int sR[2], sC[2];
#pragma unroll
    for (int i = 0; i < 2; ++i) { int R, C; stage_rc(tid * 16 + i * 8192, R, C); const int Rb = Epi::PERM ? ((R & ~31) + perm32(R & 31)) : R;
        sR[i] = R; sC[i] = C; voffB[i] = (unsigned)(Rb * K + C) * 2u; }
    const size_t kstep = (size_t)(BK * 2);
    const size_t hstep = (size_t)HALF * K * 2;
    const size_t tstep = 2 * hstep;
    const unsigned ldsw = (unsigned)wid * 1024u;
    const int aoff = lds_byte(wr * 64 + fr, fq * 8), boff = lds_byte(wc * 32 + fr, fq * 8);
#define PG8_SA(b, h) (((b) * 2 + (h)) * HTB)
#define PG8_SB(b, h) ((4 + (b) * 2 + (h)) * HTB)
#define PG8_STAGE(bufoff, gbase, voff) do { _Pragma("unroll") for (int _i = 0; _i < 2; ++_i) \
        __builtin_amdgcn_global_load_lds((const unsigned*)((const char*)(gbase) + (voff)[_i]), (PG8_LAS unsigned*)(lds + (bufoff) + ldsw + _i * 8192), 16, 0, 0); } while (0)
#define PG8_LDA(dst, b, h) do { if constexpr (MX8) { _Pragma("unroll") for (int m = 0; m < 4; ++m) dst.v[m] = ld32(lds + PG8_SA(b, h) + aoff + m * 2048, lds + PG8_SA(b, h) + aoff + m * 2048 + 1024); } \
        else { _Pragma("unroll") for (int m = 0; m < 4; ++m) _Pragma("unroll") for (int k = 0; k < 2; ++k) dst.v[m][k] = *(const PG8_LAS bf16x8*)(lds + PG8_SA(b, h) + aoff + m * 2048 + k * 1024); } } while (0)
#define PG8_LDB(dst, b, h) do { if constexpr (MX8) { _Pragma("unroll") for (int n = 0; n < 2; ++n) dst.v[n] = ld32(lds + PG8_SB(b, h) + boff + n * 2048, lds + PG8_SB(b, h) + boff + n * 2048 + 1024); } \
        else { _Pragma("unroll") for (int n = 0; n < 2; ++n) _Pragma("unroll") for (int k = 0; k < 2; ++k) dst.v[n][k] = *(const PG8_LAS bf16x8*)(lds + PG8_SB(b, h) + boff + n * 2048 + k * 1024); } } while (0)
#define PG8_MMA(ai, bj, At, Bt) do { __builtin_amdgcn_s_setprio(1); \
        if constexpr (MX8) { _Pragma("unroll") for (int m = 0; m < 4; ++m) _Pragma("unroll") for (int n = 0; n < 2; ++n) \
            { acc[ai][bj][m][n] = __builtin_amdgcn_mfma_scale_f32_16x16x128_f8f6f4(Bt.v[n], At.v[m], acc[ai][bj][m][n], 0, 0, 0, 0x7f7f7f7f, 0, 0x7f7f7f7f); asm volatile("" : "+v"(acc[ai][bj][m][n])); } } \
        else { _Pragma("unroll") for (int m = 0; m < 4; ++m) _Pragma("unroll") for (int n = 0; n < 2; ++n) _Pragma("unroll") for (int k = 0; k < 2; ++k) \
            acc[ai][bj][m][n] = __builtin_amdgcn_mfma_f32_16x16x32_bf16(Bt.v[n][k], At.v[m][k], acc[ai][bj][m][n], 0, 0, 0); } \
        __builtin_amdgcn_s_setprio(0); } while (0)
#define PG8_WAIT_V(n) asm volatile("s_waitcnt vmcnt(" #n ")" ::: "memory")
#define PG8_WAIT_L(n) asm volatile("s_waitcnt lgkmcnt(" #n ")" ::: "memory")
#define PG8_BAR __builtin_amdgcn_s_barrier()
#define PG8_SCHED __builtin_amdgcn_sched_barrier(0)
    Unit cur, nxt; int ui = 0;
    if (!S.next(0, cur)) return;
    f32x4 acc[2][2][4][2];
#pragma unroll
    for (int a = 0; a < 2; ++a)
#pragma unroll
        for (int b = 0; b < 2; ++b)
#pragma unroll
            for (int m = 0; m < 4; ++m)
#pragma unroll
                for (int n = 0; n < 2; ++n) acc[a][b][m][n] = (f32x4){0.f, 0.f, 0.f, 0.f};
    typename Frag<MX8>::A4 At; typename Frag<MX8>::B2 B0, B1;
    const char* cA = S.a_base(g, cur); const char* cB = (const char*)g.Bt + (size_t)cur.pn * tstep;
    S.a_ready(cur); S.a_off(g, cur, sR, sC, vA);
    if constexpr (SP2) {
        PG8_STAGE(PG8_SB(0, 0), cB, voffB); PG8_STAGE(PG8_SB(0, 1), cB + hstep, voffB); PG8_STAGE(PG8_SA(0, 0), cA, vA[0]); PG8_STAGE(PG8_SA(0, 1), cA, vA[1]);
        if (wr == 1) PG8_BAR;
        PG8_WAIT_V(2); PG8_BAR;
        PG8_STAGE(PG8_SB(1, 0), cB + kstep, voffB); PG8_STAGE(PG8_SA(1, 0), cA + kstep, vA[0]); PG8_STAGE(PG8_SB(1, 1), cB + hstep + kstep, voffB);
        PG8_WAIT_V(6); PG8_BAR;
    } else { static_assert(SP2, "only the SP2 K-loop is kept in this file"); }
    for (;;) {
        const bool has_next = S.next(ui + 1, nxt);
        const char* nA = has_next ? S.a_base(g, nxt) : cA; const char* nB = has_next ? (const char*)g.Bt + (size_t)nxt.pn * tstep : cB;
        if (has_next) S.a_off(g, nxt, sR, sC, vN); else { vN[0][0] = vA[0][0]; vN[0][1] = vA[0][1]; vN[1][0] = vA[1][0]; vN[1][1] = vA[1][1]; }
#pragma unroll 1
        for (int t = 0; t < nt; t += 2) {
            const bool last = (t == nt - 2);
            const char* a1 = cA + (size_t)(t + 1) * kstep;
            const char* a2 = last ? nA : cA + (size_t)(t + 2) * kstep; const char* b2 = last ? nB : cB + (size_t)(t + 2) * kstep;
            const char* a3 = a2 + kstep; const char* b3 = b2 + kstep;
            unsigned v2[2][2]; v2[0][0] = last ? vN[0][0] : vA[0][0]; v2[0][1] = last ? vN[0][1] : vA[0][1]; v2[1][0] = last ? vN[1][0] : vA[1][0]; v2[1][1] = last ? vN[1][1] : vA[1][1];
            if (last && has_next) S.a_ready(nxt);
            if constexpr (SP2) {
            PG8_LDB(B0, 0, 0); PG8_LDB(B1, 0, 1); PG8_SCHED; PG8_LDA(At, 0, 0); PG8_STAGE(PG8_SA(1, 1), a1, vA[1]);
            PG8_WAIT_V(8); PG8_WAIT_L(0); PG8_BAR; PG8_MMA(0, 0, At, B0); PG8_MMA(0, 1, At, B1); PG8_BAR; PG8_SCHED;
            PG8_LDA(At, 0, 1); PG8_STAGE(PG8_SB(0, 0), b2, voffB); PG8_STAGE(PG8_SB(0, 1), b2 + hstep, voffB); PG8_STAGE(PG8_SA(0, 0), a2, v2[0]);
            PG8_WAIT_V(8); PG8_WAIT_L(0); PG8_BAR; PG8_MMA(1, 0, At, B0); PG8_MMA(1, 1, At, B1); PG8_BAR; PG8_SCHED;
            PG8_LDB(B0, 1, 0); PG8_LDB(B1, 1, 1); PG8_SCHED; PG8_LDA(At, 1, 0); PG8_STAGE(PG8_SA(0, 1), a2, v2[1]);
            PG8_WAIT_V(8); PG8_WAIT_L(0); PG8_BAR; PG8_MMA(0, 0, At, B0); PG8_MMA(0, 1, At, B1); PG8_BAR; PG8_SCHED;
            PG8_LDA(At, 1, 1); PG8_STAGE(PG8_SB(1, 0), b3, voffB); PG8_STAGE(PG8_SB(1, 1), b3 + hstep, voffB); PG8_STAGE(PG8_SA(1, 0), a3, v2[0]);
            PG8_WAIT_V(8); PG8_WAIT_L(0); PG8_BAR; PG8_MMA(1, 0, At, B0); PG8_MMA(1, 1, At, B1); PG8_BAR; PG8_SCHED;
            }
        }
        if constexpr (ALIGN_EPI) { if (wr == 0) PG8_BAR; }
        if constexpr (!Epi::AFTER_DRAIN) { E(acc, cur, wr, wc, fr, fq); S.done(cur); }
        if (!has_next) break;
#pragma unroll
        for (int a = 0; a < 2; ++a)
#pragma unroll
            for (int b = 0; b < 2; ++b)
#pragma unroll
                for (int m = 0; m < 4; ++m)
#pragma unroll
                    for (int n = 0; n < 2; ++n) acc[a][b][m][n] = (f32x4){0.f, 0.f, 0.f, 0.f};
        cur = nxt; cA = nA; cB = nB; ++ui; vA[0][0] = vN[0][0]; vA[0][1] = vN[0][1]; vA[1][0] = vN[1][0]; vA[1][1] = vN[1][1];
        if constexpr (ALIGN_EPI) { if (wr == 1) PG8_BAR; }
    }
    PG8_WAIT_V(0);
    if constexpr (!ALIGN_EPI) { if (wr == 0) PG8_BAR; }
    PG8_BAR;
    if constexpr (Epi::AFTER_DRAIN) { E.fused(acc, cur, wr, wc, fr, fq, lds, wid, lane); S.done(cur); }
#undef PG8_SA
#undef PG8_SB
#undef PG8_STAGE
#undef PG8_LDA
#undef PG8_LDB
#undef PG8_MMA
#undef PG8_WAIT_V
#undef PG8_WAIT_L
#undef PG8_BAR
#undef PG8_SCHED
}

__device__ __forceinline__ float fsig(float x) { return __builtin_amdgcn_rcpf(1.f + __expf(-x)); }
__device__ __forceinline__ float fsilu(float x) { return x * fsig(x); }
__device__ __forceinline__ float fgelu(float x) { return x * fsig(1.5957691216057308f * (x + 0.044715f * x * x * x)); }
__device__ __forceinline__ u32x4 pack8(const f32x4& v0, const f32x4& v1) { u32x4 w; w.x = cvt_pk_bf16(v0[0], v0[1]); w.y = cvt_pk_bf16(v0[2], v0[3]); w.z = cvt_pk_bf16(v1[0], v1[1]); w.w = cvt_pk_bf16(v1[2], v1[3]); return w; }
__device__ __forceinline__ void unpack8(const u32x4& w, f32x4& v0, f32x4& v1) {
    v0[0] = __uint_as_float(w.x << 16); v0[1] = __uint_as_float(w.x & 0xffff0000u); v0[2] = __uint_as_float(w.y << 16); v0[3] = __uint_as_float(w.y & 0xffff0000u);
    v1[0] = __uint_as_float(w.z << 16); v1[1] = __uint_as_float(w.z & 0xffff0000u); v1[2] = __uint_as_float(w.w << 16); v1[3] = __uint_as_float(w.w & 0xffff0000u); }

struct EpiLruIn {
    static constexpr bool PERM = true, AFTER_DRAIN = false;
    bf16_t* u; bf16_t* gl;
    __device__ __forceinline__ void operator()(const f32x4 (&acc)[2][2][4][2], const Unit& un, int wr, int wc, int fr, int fq) const {
        const int row0 = un.pm * BM + wr * 64 + fr; const bool isg = un.pn >= 6;
        bf16_t* base = (isg ? gl : u) + (isg ? un.pn - 6 : un.pn) * BM + wc * 32 + 8 * fq;
#pragma unroll
        for (int ai = 0; ai < 2; ++ai)
#pragma unroll
            for (int m = 0; m < 4; ++m) { bf16_t* rowp = base + (size_t)(row0 + ai * HALF + m * 16) * 1536;
#pragma unroll
                for (int bj = 0; bj < 2; ++bj) { f32x4 v0 = acc[ai][bj][m][0], v1 = acc[ai][bj][m][1];
                    if (isg) {
#pragma unroll
                        for (int e = 0; e < 4; ++e) { v0[e] = fgelu(v0[e]); v1[e] = fgelu(v1[e]); } }
                    *(u32x4*)(rowp + bj * HALF) = pack8(v0, v1); } }
    }
};
struct EpiRetIn {
    static constexpr bool PERM = true, AFTER_DRAIN = false;
    bf16_t* q; bf16_t* k; bf16_t* v; bf16_t* g; const float* rope;
    __device__ __forceinline__ void operator()(const f32x4 (&acc)[2][2][4][2], const Unit& un, int wr, int wc, int fr, int fq) const {
        const int row0 = un.pm * BM + wr * 64 + fr;
        if (un.pn < 8) {
            const bool isk = un.pn >= 4; const int h = un.pn & 3;
            const float lg = __log2f(1.f - __builtin_amdgcn_exp2f(-5.f - (float)h));
            const int jb = wc * 32 + 8 * fq;
            bf16_t* base = (isk ? k : q) + h * 256 + jb;
#pragma unroll
            for (int ai = 0; ai < 2; ++ai)
#pragma unroll
                for (int m = 0; m < 4; ++m) { const int r = row0 + ai * HALF + m * 16, s = r & 8191, n = s & 127;
                    const float sc = isk ? __builtin_amdgcn_exp2f(-(float)n * lg) * 0.0625f : __builtin_amdgcn_exp2f((float)n * lg);
                    const f32x4* tp = (const f32x4*)(rope + ((size_t)s * 128 + jb) * 2);
                    f32x4 o1[2], o2[2];
#pragma unroll
                    for (int nn = 0; nn < 2; ++nn) { const f32x4 ta = tp[2 * nn], tb = tp[2 * nn + 1]; const f32x4 a = acc[ai][0][m][nn], b = acc[ai][1][m][nn];
                        o1[nn][0] = (a[0] * ta[0] - b[0] * ta[1]) * sc; o2[nn][0] = (a[0] * ta[1] + b[0] * ta[0]) * sc;
                        o1[nn][1] = (a[1] * ta[2] - b[1] * ta[3]) * sc; o2[nn][1] = (a[1] * ta[3] + b[1] * ta[2]) * sc;
                        o1[nn][2] = (a[2] * tb[0] - b[2] * tb[1]) * sc; o2[nn][2] = (a[2] * tb[1] + b[2] * tb[0]) * sc;
                        o1[nn][3] = (a[3] * tb[2] - b[3] * tb[3]) * sc; o2[nn][3] = (a[3] * tb[3] + b[3] * tb[2]) * sc; }
                    bf16_t* rowp = isk ? base + (size_t)r * 1024 : q + ((size_t)(r >> 7) * 4 + h) * 32768 + ((wc * 4 + fq) * 128 + n) * 8;
                    *(u32x4*)(rowp) = pack8(o1[0], o1[1]); *(u32x4*)(rowp + (isk ? HALF : 16384)) = pack8(o2[0], o2[1]);
                    asm volatile("" ::: "memory"); }
        } else {
            const bool isg = un.pn >= 16;
            bf16_t* base = (isg ? g : v) + ((un.pn - 8) & 7) * BM + wc * 32 + 8 * fq;
#pragma unroll
            for (int ai = 0; ai < 2; ++ai)
#pragma unroll
                for (int m = 0; m < 4; ++m) { bf16_t* rowp = base + (size_t)(row0 + ai * HALF + m * 16) * 2048;
#pragma unroll
                    for (int bj = 0; bj < 2; ++bj) { f32x4 v0 = acc[ai][bj][m][0], v1 = acc[ai][bj][m][1];
                        if (isg) {
#pragma unroll
                            for (int e = 0; e < 4; ++e) { v0[e] = fsilu(v0[e]); v1[e] = fsilu(v1[e]); } }
                        *(u32x4*)(rowp + bj * HALF) = pack8(v0, v1); } }
        }
    }
};
struct EpiGates {
    static constexpr bool PERM = true, AFTER_DRAIN = false;
    const float* bm; bf16_t* gates;
    __device__ __forceinline__ void operator()(const f32x4 (&acc)[2][2][4][2], const Unit& un, int wr, int wc, int fr, int fq) const {
        const int row0 = un.pm * BM + wr * 64 + fr, col0 = un.pn * BM + wc * 32 + 8 * fq;
        f32x4 bv[2][2];
#pragma unroll
        for (int bj = 0; bj < 2; ++bj)
#pragma unroll
            for (int n = 0; n < 2; ++n) bv[bj][n] = *(const f32x4*)(bm + col0 + bj * HALF + 4 * n);
#pragma unroll
        for (int ai = 0; ai < 2; ++ai)
#pragma unroll
            for (int m = 0; m < 4; ++m) { bf16_t* rowp = gates + (size_t)(row0 + ai * HALF + m * 16) * 2048 + col0;
#pragma unroll
                for (int bj = 0; bj < 2; ++bj) { f32x4 v0 = acc[ai][bj][m][0] + bv[bj][0], v1 = acc[ai][bj][m][1] + bv[bj][1];
#pragma unroll
                    for (int e = 0; e < 4; ++e) { v0[e] = fsig(v0[e]); v1[e] = fsig(v1[e]); }
                    *(u32x4*)(rowp + bj * HALF) = pack8(v0, v1); } }
    }
};
template <int MODE> struct EpiMerge {
    static constexpr bool PERM = true, AFTER_DRAIN = false;
    const bf16_t* gates; const bf16_t* m1in; bf16_t* o;
    __device__ __forceinline__ void operator()(const f32x4 (&acc)[2][2][4][2], const Unit& un, int wr, int wc, int fr, int fq) const {
        const int row0 = un.pm * BM + wr * 64 + fr, col0 = un.pn * BM + wc * 32 + 8 * fq;
#pragma unroll
        for (int ai = 0; ai < 2; ++ai)
#pragma unroll
            for (int m = 0; m < 4; ++m) { const size_t r = (size_t)(row0 + ai * HALF + m * 16);
#pragma unroll
                for (int bj = 0; bj < 2; ++bj) { const int c = col0 + bj * HALF;
                    f32x4 g0, g1; unpack8(*(const u32x4*)(gates + r * 2048 + MODE * 1024 + c), g0, g1);
                    f32x4 v0 = acc[ai][bj][m][0] * g0, v1 = acc[ai][bj][m][1] * g1;
                    if (MODE == 1) { f32x4 p0, p1; unpack8(*(const u32x4*)(m1in + r * 1024 + c), p0, p1); v0 += p0; v1 += p1; }
                    *(u32x4*)(o + r * 1024 + c) = pack8(v0, v1); } }
    }
};
struct EpiOut {
    static constexpr bool PERM = true, AFTER_DRAIN = false;
    const float* x; bf16_t* y; float alpha;
    __device__ __forceinline__ void operator()(const f32x4 (&acc)[2][2][4][2], const Unit& un, int wr, int wc, int fr, int fq) const {
        const int row0 = un.pm * BM + wr * 64 + fr, col0 = un.pn * BM + wc * 32 + 8 * fq;
#pragma unroll
        for (int ai = 0; ai < 2; ++ai)
#pragma unroll
            for (int m = 0; m < 4; ++m) { const size_t off = (size_t)(row0 + ai * HALF + m * 16) * 1024 + col0;
#pragma unroll
                for (int bj = 0; bj < 2; ++bj) { const f32x4 x0 = *(const f32x4*)(x + off + bj * HALF), x1 = *(const f32x4*)(x + off + bj * HALF + 4);
                    *(u32x4*)(y + off + bj * HALF) = pack8(x0 * alpha + acc[ai][bj][m][0], x1 * alpha + acc[ai][bj][m][1]); } }
    }
};
struct MoeTab { int tileStart[33]; int cnt[32]; int pad_[3]; int tileExp[320]; };
__device__ __forceinline__ void moe_build_tab(PG8_LAS MoeTab* tab, const int* cnt) {
    if (otid() == 0) { int t = 0; for (int e = 0; e < 32; ++e) { const int c = cnt[e * 64], nt = (c + 255) >> 8; tab->tileStart[e] = t; tab->cnt[e] = c; for (int i = 0; i < nt; ++i) tab->tileExp[t + i] = e; t += nt; } tab->tileStart[32] = t; }
    __syncthreads();
}
template <bool GATHER> struct MoeOrder {
    int U, G, c; const PG8_LAS MoeTab* tab; const int* list;
    __device__ __forceinline__ bool next(int i, Unit& u) const {
        const long L = (long)i * G + c; if (L >= U) return false;
        int wgid = (int)L; { const int q = U / NXCD, r = U % NXCD, xcd = wgid % NXCD, off = wgid / NXCD; wgid = (xcd < r ? xcd * (q + 1) : r * (q + 1) + (xcd - r) * q) + off; }
        u.pm = wgid >> 2; u.pn = tab->tileExp[u.pm] * 4 + (wgid & 3); return true;
    }
    __device__ __forceinline__ void a_ready(const Unit&) const {}
    __device__ __forceinline__ void done(const Unit&) const {}
    __device__ __forceinline__ const char* a_base(const Gemm& g, const Unit& u) const { return GATHER ? (const char*)g.A : (const char*)g.A + (size_t)u.pm * (size_t)(BM * g.K * 2); }
    __device__ __forceinline__ void a_off(const Gemm& g, const Unit& u, const int (&R)[2], const int (&C)[2], unsigned (&v)[2][2]) const {
        if (!GATHER) { _Pragma("unroll") for (int hh = 0; hh < 2; ++hh) _Pragma("unroll") for (int i = 0; i < 2; ++i) v[hh][i] = (unsigned)((hh * HALF + R[i]) * g.K + C[i]) * 2u; }
        else { const int e = u.pn >> 2, base = (u.pm - tab->tileStart[e]) * BM, ce = tab->cnt[e];
            _Pragma("unroll") for (int hh = 0; hh < 2; ++hh) _Pragma("unroll") for (int i = 0; i < 2; ++i) { const int lr = base + hh * HALF + R[i]; const int tok = (lr < ce) ? (list[e * 32768 + lr] >> 1) : 0; v[hh][i] = (unsigned)(tok * g.K + C[i]) * 2u; } }
    }
};
struct EpiSwiGLU {
    static constexpr bool PERM = true, AFTER_DRAIN = false;
    bf16_t* h;
    __device__ __forceinline__ void operator()(const f32x4 (&acc)[2][2][4][2], const Unit& un, int wr, int wc, int fr, int fq) const {
        const int row0 = un.pm * BM + wr * 64 + fr, col0 = (un.pn & 3) * 128 + wc * 32 + 8 * fq;
#pragma unroll
        for (int ai = 0; ai < 2; ++ai)
#pragma unroll
            for (int m = 0; m < 4; ++m) { f32x4 v0, v1;
#pragma unroll
                for (int e = 0; e < 4; ++e) { v0[e] = fsilu(acc[ai][0][m][0][e]) * acc[ai][1][m][0][e]; v1[e] = fsilu(acc[ai][0][m][1][e]) * acc[ai][1][m][1][e]; }
                *(u32x4*)(h + (size_t)(row0 + ai * HALF + m * 16) * 512 + col0) = pack8(v0, v1); }
    }
};
struct EpiMoeOut {
    static constexpr bool PERM = true, AFTER_DRAIN = false;
    const PG8_LAS MoeTab* tab; const int* list; const float* rw; bf16_t* ys;
    __device__ __forceinline__ void operator()(const f32x4 (&acc)[2][2][4][2], const Unit& un, int wr, int wc, int fr, int fq) const {
        const int e = un.pn >> 2, lrow0 = (un.pm - tab->tileStart[e]) * BM + wr * 64 + fr, ce = tab->cnt[e], col0 = (un.pn & 3) * BM + wc * 32 + 8 * fq;
        int slot[8]; float wgt[8];
#pragma unroll
        for (int i = 0; i < 8; ++i) { const int lr = lrow0 + (i >> 2) * HALF + (i & 3) * 16; slot[i] = (lr < ce) ? list[e * 32768 + lr] : -1; }
#pragma unroll
        for (int i = 0; i < 8; ++i) wgt[i] = (slot[i] >= 0) ? rw[slot[i]] : 0.f;
#pragma unroll
        for (int ai = 0; ai < 2; ++ai)
#pragma unroll
            for (int m = 0; m < 4; ++m) { const int i = ai * 4 + m;
                if (slot[i] >= 0) { const float w = wgt[i]; bf16_t* rowp = ys + (size_t)slot[i] * 1024 + col0;
#pragma unroll
                    for (int bj = 0; bj < 2; ++bj) *(u32x4*)(rowp + bj * HALF) = pack8(acc[ai][bj][m][0] * w, acc[ai][bj][m][1] * w); } }
    }
};

__device__ __forceinline__ float clamp448(float v) { return fminf(fmaxf(v, -448.f), 448.f); }
__device__ __forceinline__ unsigned pk4_fp8(float a, float b, float c, float d) { int p = __builtin_amdgcn_cvt_pk_fp8_f32(clamp448(a), clamp448(b), 0, false); p = __builtin_amdgcn_cvt_pk_fp8_f32(clamp448(c), clamp448(d), p, true); return (unsigned)p; }
constexpr float FP8_SX = 4.f, FP8_SW = 64.f, FP8_SH = 8.f;
struct EpiSwiGLU8 {
    static constexpr bool PERM = true, AFTER_DRAIN = false;
    unsigned char* h;
    __device__ __forceinline__ void operator()(const f32x4 (&acc)[2][2][4][2], const Unit& un, int wr, int wc, int fr, int fq) const {
        const int row0 = un.pm * BM + wr * 64 + fr, col0 = (un.pn & 3) * 128 + wc * 32 + 8 * fq; const float ds = 1.f / (FP8_SX * FP8_SW);
#pragma unroll
        for (int ai = 0; ai < 2; ++ai)
#pragma unroll
            for (int m = 0; m < 4; ++m) { float v[8];
#pragma unroll
                for (int e = 0; e < 4; ++e) { v[e] = FP8_SH * fsilu(acc[ai][0][m][0][e] * ds) * (acc[ai][1][m][0][e] * ds); v[4 + e] = FP8_SH * fsilu(acc[ai][0][m][1][e] * ds) * (acc[ai][1][m][1][e] * ds); }
                uint2 o; o.x = pk4_fp8(v[0], v[1], v[2], v[3]); o.y = pk4_fp8(v[4], v[5], v[6], v[7]);
                *(uint2*)(h + (size_t)(row0 + ai * HALF + m * 16) * 512 + col0) = o; }
    }
};
struct EpiMoeOut8 {
    static constexpr bool PERM = true, AFTER_DRAIN = false;
    const PG8_LAS MoeTab* tab; const int* list; const float* rw; bf16_t* ys;
    __device__ __forceinline__ void operator()(const f32x4 (&acc)[2][2][4][2], const Unit& un, int wr, int wc, int fr, int fq) const {
        const int e = un.pn >> 2, lrow0 = (un.pm - tab->tileStart[e]) * BM + wr * 64 + fr, ce = tab->cnt[e], col0 = (un.pn & 3) * BM + wc * 32 + 8 * fq;
#pragma unroll
        for (int ai = 0; ai < 2; ++ai)
#pragma unroll
            for (int m = 0; m < 4; ++m) { const int lr = lrow0 + ai * HALF + m * 16;
                if (lr < ce) { const int slot = list[e * 32768 + lr]; const float w = rw[slot] * (1.f / (FP8_SH * FP8_SW)); bf16_t* rowp = ys + (size_t)slot * 1024 + col0;
#pragma unroll
                    for (int bj = 0; bj < 2; ++bj) *(u32x4*)(rowp + bj * HALF) = pack8(acc[ai][bj][m][0] * w, acc[ai][bj][m][1] * w); }
                asm volatile("" ::: "memory"); }
    }
};
}

DEV unsigned pk2(float lo, float hi) { return (unsigned)f2bf(lo) | ((unsigned)f2bf(hi) << 16); }
typedef unsigned v4u __attribute__((ext_vector_type(4)));
DEV void transpose_item(const float* W, int K, int N, bf16_t* WT, int row_off, float* scr, int item, int lane, bool gatefrag = false) {
    const int nblk = N / 32, kb = item / nblk, nb = item % nblk, k0 = 64 * kb, n0 = 32 * nb;
    float wv[32];
#pragma unroll
    for (int i = 0; i < 32; ++i) wv[i] = W[(size_t)(k0 + 2 * i + (lane >> 5)) * N + n0 + (lane & 31)];
#pragma unroll
    for (int i = 0; i < 32; ++i) scr[(2 * i + (lane >> 5)) * 33 + (lane & 31)] = wv[i];
    asm volatile("s_waitcnt lgkmcnt(0)" ::: "memory");
    const int c = lane & 7;
#pragma unroll
    for (int j = 0; j < 4; ++j) { const int n = (lane >> 3) + 8 * j; const float* s = scr + (8 * c) * 33 + n;
        v4u o; o.x = pk2(s[0 * 33], s[1 * 33]); o.y = pk2(s[2 * 33], s[3 * 33]); o.z = pk2(s[4 * 33], s[5 * 33]); o.w = pk2(s[6 * 33], s[7 * 33]);
        const int oc = n0 + n, kk = k0 + 8 * c;
        const size_t off = gatefrag ? (size_t)((((oc / 48) * 3 + (oc % 48) / 16) * 6 + (kk >> 5)) * 64 + ((kk >> 3) & 3) * 16 + (oc & 15)) * 8 : (size_t)(row_off + oc) * K + kk;
        *(v4u*)(WT + off) = o; }
    asm volatile("s_waitcnt lgkmcnt(0)" ::: "memory");
}
DEV void p_weights(float* lds, const float* w_in, const float* w_ret_o, const float* w_lru_o, const float* w_out, const float* w_rg_r, const float* w_rg_i, bf16_t* w_in_t, bf16_t* w_ro_t, bf16_t* w_lo_t, bf16_t* w_out_t, bf16_t* wrg_t) {
    const int wave = otid() >> 6, lane = otid() & 63;
    float* scr = lds + wave * 2304;
    constexpr int I0 = 16 * (WIN_N / 32), I1 = 32 * 32, I2 = 24 * 32, I3 = 16 * 32, I4 = 16 * 18;
    for (int it = blockIdx.x * 8 + wave; it < I0 + I1 + I2 + I3 + I4; it += gridDim.x * 8) {
        int r = it;
        if (r < I0) { transpose_item(w_in, 1024, WIN_N, w_in_t, 0, scr, r, lane); continue; } r -= I0;
        if (r < I1) { transpose_item(w_ret_o, 2048, 1024, w_ro_t, 0, scr, r, lane); continue; } r -= I1;
        if (r < I2) { transpose_item(w_lru_o, 1536, 1024, w_lo_t, 0, scr, r, lane); continue; } r -= I2;
        if (r < I3) { transpose_item(w_out, 1024, 1024, w_out_t, 0, scr, r, lane); continue; } r -= I3;
        { const int mi = r / 18, sub = r - mi * 18; const float* W = (mi < 8 ? w_rg_r + (size_t)mi * 192 * 192 : w_rg_i + (size_t)(mi - 8) * 192 * 192);
          transpose_item(W, 192, 192, wrg_t + (size_t)mi * 192 * 192, 0, scr, sub, lane, true); }
    }
}


DEV void transpose_item_fp8(const float* W, int K, int N, unsigned char* WT, int row_off, float scale, float* scr, int item, int lane) {
    const int nblk = N / 32, kb = item / nblk, nb = item % nblk, k0 = 64 * kb, n0 = 32 * nb;
    float wv[32];
#pragma unroll
    for (int i = 0; i < 32; ++i) wv[i] = W[(size_t)(k0 + 2 * i + (lane >> 5)) * N + n0 + (lane & 31)];
#pragma unroll
    for (int i = 0; i < 32; ++i) scr[(2 * i + (lane >> 5)) * 33 + (lane & 31)] = wv[i] * scale;
    asm volatile("s_waitcnt lgkmcnt(0)" ::: "memory");
    const int c = lane & 3;
#pragma unroll
    for (int j = 0; j < 2; ++j) { const int n = (lane >> 2) + 16 * j; const float* s = scr + (16 * c) * 33 + n;
        v4u o; o.x = pg8::pk4_fp8(s[0 * 33], s[1 * 33], s[2 * 33], s[3 * 33]); o.y = pg8::pk4_fp8(s[4 * 33], s[5 * 33], s[6 * 33], s[7 * 33]);
        o.z = pg8::pk4_fp8(s[8 * 33], s[9 * 33], s[10 * 33], s[11 * 33]); o.w = pg8::pk4_fp8(s[12 * 33], s[13 * 33], s[14 * 33], s[15 * 33]);
        *(v4u*)(WT + (size_t)(row_off + n0 + n) * K + k0 + 16 * c) = o; }
    asm volatile("s_waitcnt lgkmcnt(0)" ::: "memory");
}
DEV void p_expert_weights(float* lds, const float* w_eg, const float* w_eu, const float* w_ed, unsigned char* wgu8, unsigned char* wd8) {
    const int wave = otid() >> 6, lane = otid() & 63;
    float* scr = lds + wave * 2304;
    for (int it = blockIdx.x * 8 + wave; it < 3 * 8192; it += gridDim.x * 8) {
        const int kind = it >> 13, r = it & 8191, e = r >> 8, sub = r & 255;
        if (kind < 2) { const int nb = sub & 15; transpose_item_fp8((kind ? w_eu : w_eg) + (size_t)e * 1024 * 512, 1024, 512, wgu8 + (size_t)e * 1024 * 1024, (nb >> 2) * 128 + kind * 128, pg8::FP8_SW, scr, sub, lane); }
        else transpose_item_fp8(w_ed + (size_t)e * 512 * 1024, 512, 1024, wd8 + (size_t)e * 1024 * 512, 0, pg8::FP8_SW, scr, sub, lane);
    }
}

DEV void p_router_consts(float* lds, const float* g1, const float* b1, const float* wg, const float* bg, const float* we, const float* be, float* sb, unsigned char* rtab) {
    int tq_ = otid(); asm volatile("" : "+v"(tq_));
    for (int p = blockIdx.x * NTHR + tq_; p < 9216; p += gridDim.x * NTHR) {
        int T, part, kq, stride; const float* srcp;
        if (p < 8192) { const int col = p & 15, nt = (p >> 6) & 1; kq = (p >> 4) & 3; part = (p >> 7) & 1; T = p >> 8; srcp = we + 16 * nt + col; stride = 32; }
        else { const int p2 = p - 8192, col = p2 & 3; kq = (p2 >> 2) & 3; part = (p2 >> 4) & 1; T = p2 >> 5; srcp = wg + col; stride = 4; }
        const int k0 = 32 * T + 8 * kq;
        unsigned o[4];
#pragma unroll
        for (int j2 = 0; j2 < 4; ++j2) { unsigned pr = 0;
#pragma unroll
            for (int e = 0; e < 2; ++e) { const int kk = k0 + 2 * j2 + e; const float wv_ = g1[kk] * srcp[(size_t)kk * stride];
                const bf16_t hi = f2bf(wv_); const bf16_t val = part ? f2bf(wv_ - bf2f(hi)) : hi; pr |= (unsigned)val << (16 * e); }
            o[j2] = pr; }
        *(u32x4_t*)(rtab + (size_t)p * 16) = (u32x4_t){o[0], o[1], o[2], o[3]};
    }
    if (blockIdx.x != 0) return;
    const int t = otid(), wv = t >> 6, lane = t & 63;
    float s[36], q[36];
#pragma unroll
    for (int c = 0; c < 36; ++c) { s[c] = 0.f; q[c] = 0.f; }
#pragma unroll
    for (int kk = 0; kk < 2; ++kk) { const int k = t + 512 * kk; const float gk = g1[k], bk = b1[k];
#pragma unroll
        for (int c4 = 0; c4 < 9; ++c4) { const float4 w = (c4 < 8) ? *(const float4*)(we + (size_t)k * 32 + c4 * 4) : *(const float4*)(wg + (size_t)k * 4);
            s[4 * c4] += gk * w.x; s[4 * c4 + 1] += gk * w.y; s[4 * c4 + 2] += gk * w.z; s[4 * c4 + 3] += gk * w.w;
            q[4 * c4] += bk * w.x; q[4 * c4 + 1] += bk * w.y; q[4 * c4 + 2] += bk * w.z; q[4 * c4 + 3] += bk * w.w; } }
#pragma unroll
    for (int m = 1; m < 64; m <<= 1) {
#pragma unroll
        for (int c = 0; c < 36; ++c) { s[c] += __shfl_xor(s[c], m); q[c] += __shfl_xor(q[c], m); } }
    if (lane == 0) {
#pragma unroll
        for (int c = 0; c < 36; ++c) { lds[wv * 96 + c] = s[c]; lds[wv * 96 + 48 + c] = q[c]; } }
    __syncthreads();
    if (t < 96) { const int cc = t % 48; float v = 0.f;
        if (cc < 36) { for (int p = 0; p < 8; ++p) v += lds[p * 96 + t]; if (t >= 48) v += (cc < 32) ? be[cc] : bg[cc - 32]; }
        sb[t] = v; }
    __syncthreads();
}
DEV void p_cvt_x(const float* x, bf16_t* xb) {
    const size_t n4 = (size_t)NTOK * DM / 4, stride = (size_t)gridDim.x * NTHR;
    for (size_t i0 = (size_t)blockIdx.x * NTHR + otid(); i0 < n4; i0 += 8 * stride) {
        float4 t[8];
#pragma unroll
        for (int u = 0; u < 8; ++u) { const size_t i = i0 + u * stride; t[u] = (i < n4) ? ((const float4*)x)[i] : make_float4(0.f, 0.f, 0.f, 0.f); }
#pragma unroll
        for (int u = 0; u < 8; ++u) { const size_t i = i0 + u * stride; if (i < n4) { uint2 o; o.x = pg8::cvt_pk_bf16(t[u].x, t[u].y); o.y = pg8::cvt_pk_bf16(t[u].z, t[u].w); ((uint2*)xb)[i] = o; } }
    }
}
DEV void p_rope_table(float2* tab) {
    for (int i = blockIdx.x * NTHR + otid(); i < 8192 * 128; i += gridDim.x * NTHR) {
        const int s = i >> 7, j = i & 127;
        const double r = 0.93057204092969897;
        double inv = 1.0; for (int t = 0; t < j; ++t) inv *= r;
        const double ang = (double)s * inv;
        const double twopi_hi = 6.283185307179586232, twopi_lo = 2.4492935982947064e-16;
        const double n = rint(ang / twopi_hi);
        const double x = (ang - n * twopi_hi) - n * twopi_lo;
        const double x2 = x * x;
        double acc = 1.0 - x2 * (1.0 / (22.0 * 23.0));
#pragma unroll
        for (int k = 21; k >= 3; k -= 2) acc = 1.0 - x2 * (1.0 / ((double)(k - 1) * (double)k)) * acc;
        double acc2 = 1.0 - x2 * (1.0 / (21.0 * 22.0));
#pragma unroll
        for (int k = 20; k >= 2; k -= 2) acc2 = 1.0 - x2 * (1.0 / ((double)(k - 1) * (double)k)) * acc2;
        tab[i] = make_float2((float)acc2, (float)(x * acc));
    }
}

typedef float f32x4_t __attribute__((ext_vector_type(4)));
typedef short s16x4_t __attribute__((ext_vector_type(4)));
constexpr int LRU_ROWB = 400;
DEV void p_lru_compute(unsigned char* lds, const bf16_t* ulru, const float* cw, const float* cb, const bf16_t* wrg_t,
                       const float* b_r, const float* b_i, const float* lam, bf16_t* epsb, bf16_t* xinb, float* segA, float* segH) {
    int tid_ = otid(); asm volatile("" : "+v"(tid_));
    const int tid = tid_, wave = tid >> 6, lane = tid & 63, fr = lane & 15, fq = lane >> 4, wr = wave >> 2, wc = wave & 3;
    unsigned char* stg = lds + 256 * LRU_ROWB + wave * 4096;
    for (int item = blockIdx.x; item < 1024; item += gridDim.x) {
        const int n = item & 7, b = (item >> 3) & 3, seg = item >> 5;
        const size_t t0 = (size_t)b * SEQ + seg * 256;
        {
            const int c8 = tid % 24, run = tid / 24, r0 = run * 13;
            if (run < 20) {
                const int ch0 = n * 192 + c8 * 8;
                float wj[4][8], bias[8];
#pragma unroll
                for (int j = 0; j < 4; ++j) { const float4 w0 = *(const float4*)(cw + j * 1536 + ch0), w1 = *(const float4*)(cw + j * 1536 + ch0 + 4);
                    wj[j][0] = w0.x; wj[j][1] = w0.y; wj[j][2] = w0.z; wj[j][3] = w0.w; wj[j][4] = w1.x; wj[j][5] = w1.y; wj[j][6] = w1.z; wj[j][7] = w1.w; }
                { const float4 c0 = *(const float4*)(cb + ch0), c1 = *(const float4*)(cb + ch0 + 4); bias[0] = c0.x; bias[1] = c0.y; bias[2] = c0.z; bias[3] = c0.w; bias[4] = c1.x; bias[5] = c1.y; bias[6] = c1.z; bias[7] = c1.w; }
                u32x4_t raw[16];
#pragma unroll
                for (int i = 0; i < 16; ++i) { const int r = r0 - 3 + i;
                    raw[i] = (r < 256 && seg * 256 + r >= 0) ? *(const u32x4_t*)(ulru + (t0 + r) * 1536 + ch0) : (u32x4_t){0u, 0u, 0u, 0u}; }
                float xw[4][8];
#pragma unroll
                for (int i = 0; i < 16; ++i) {
#pragma unroll
                    for (int e = 0; e < 4; ++e) { xw[i & 3][2 * e] = __uint_as_float(raw[i][e] << 16); xw[i & 3][2 * e + 1] = __uint_as_float(raw[i][e] & 0xffff0000u); }
                    if (i >= 3) {
                        const int r = r0 + i - 3;
                        float acc[8];
#pragma unroll
                        for (int e = 0; e < 8; ++e) acc[e] = bias[e] + wj[0][e] * xw[(i + 1) & 3][e] + wj[1][e] * xw[(i + 2) & 3][e] + wj[2][e] * xw[(i + 3) & 3][e] + wj[3][e] * xw[i & 3][e];
                        if (r < 256) { uint4 o; o.x = pg8::cvt_pk_bf16(acc[0], acc[1]); o.y = pg8::cvt_pk_bf16(acc[2], acc[3]); o.z = pg8::cvt_pk_bf16(acc[4], acc[5]); o.w = pg8::cvt_pk_bf16(acc[6], acc[7]);
                            *(uint4*)(lds + r * LRU_ROWB + c8 * 16) = o; }
                    }
                }
            }
        }
        __syncthreads();
        float cbr[3], cbi[3], csp[3], hrun[3], atot[3];
        const int sub = seg * 2 + wr;
#pragma unroll
        for (int tc = 0; tc < 3; ++tc) { const int ch = n * 192 + 48 * wc + 16 * tc + fr; cbr[tc] = b_r[ch]; cbi[tc] = b_i[ch]; csp[tc] = 8.f * 1.4426950408889634f * log1pf(__expf(-lam[ch])); atot[tc] = 1.f; hrun[tc] = 0.f; }
        const bf16_t* wrb = wrg_t + (size_t)n * 192 * 192 + (size_t)(wc * 18) * 512 + lane * 8;
        const bf16_t* wib = wrb + (size_t)8 * 192 * 192;
#pragma unroll
        for (int tc = 0; tc < 3; ++tc) {
            bf16x8_t bfr[6][2];
#pragma unroll
            for (int ks = 0; ks < 6; ++ks) { bfr[ks][0] = *(const bf16x8_t*)(wrb + (tc * 6 + ks) * 512); bfr[ks][1] = *(const bf16x8_t*)(wib + (tc * 6 + ks) * 512); }
#pragma unroll
            for (int p = 0; p < 2; ++p) {
                const int rowb = 128 * wr + 64 * p;
                f32x4_t acc[4][2];
#pragma unroll
                for (int m = 0; m < 4; ++m) { acc[m][0] = (f32x4_t){0.f, 0.f, 0.f, 0.f}; acc[m][1] = (f32x4_t){0.f, 0.f, 0.f, 0.f}; }
#pragma unroll
                for (int ks = 0; ks < 6; ++ks) {
                    bf16x8_t afr[4];
#pragma unroll
                    for (int m = 0; m < 4; ++m) afr[m] = *(const bf16x8_t*)(lds + (rowb + 16 * (fr >> 2) + 4 * m + (fr & 3)) * LRU_ROWB + ks * 64 + fq * 16);
#pragma unroll
                    for (int m = 0; m < 4; ++m) { acc[m][0] = __builtin_amdgcn_mfma_f32_16x16x32_bf16(afr[m], bfr[ks][0], acc[m][0], 0, 0, 0); acc[m][1] = __builtin_amdgcn_mfma_f32_16x16x32_bf16(afr[m], bfr[ks][1], acc[m][1], 0, 0, 0); }
                }
                const int coff = (48 * wc + 16 * tc + fr) * 2;
                const unsigned char* up = lds + (rowb + 16 * fq) * LRU_ROWB + coff;
                float Al = 1.f, Bl = 0.f;
                unsigned pe[8], px[8];
#pragma unroll
                for (int m = 0; m < 4; ++m) {
                    float ee[4], xx[4];
#pragma unroll
                    for (int j = 0; j < 4; ++j) {
                        const float rr = pg8::fsig(acc[m][0][j] + cbr[tc]), ii = pg8::fsig(acc[m][1][j] + cbi[tc]);
                        const float aa = __builtin_amdgcn_exp2f(-csp[tc] * rr);
                        const float u = bf2f(*(const bf16_t*)(up + (4 * m + j) * LRU_ROWB));
                        const float om = 1.f - aa;
                        const float x = __builtin_amdgcn_sqrtf(fmaxf(om * (1.f + aa), 0.f)) * ii * u;
                        ee[j] = om; xx[j] = x; Bl = aa * Bl + x; Al *= aa;
                    }
                    pe[2 * m] = pg8::cvt_pk_bf16(ee[0], ee[1]); pe[2 * m + 1] = pg8::cvt_pk_bf16(ee[2], ee[3]);
                    px[2 * m] = pg8::cvt_pk_bf16(xx[0], xx[1]); px[2 * m + 1] = pg8::cvt_pk_bf16(xx[2], xx[3]);
                }
                { float h = hrun[tc], ap = 1.f;
#pragma unroll
                  for (int q = 0; q < 4; ++q) { const float Aq = __shfl(Al, fr + 16 * q), Bq = __shfl(Bl, fr + 16 * q); h = Aq * h + Bq; ap *= Aq; }
                  hrun[tc] = h; atot[tc] *= ap; }
#pragma unroll
                for (int m = 0; m < 4; ++m)
#pragma unroll
                    for (int j = 0; j < 4; ++j) { const int tk = 16 * fq + 4 * m + j; const unsigned we = pe[2 * m + (j >> 1)], wx = px[2 * m + (j >> 1)];
                        *(bf16_t*)(stg + tk * 32 + fr * 2) = (bf16_t)((j & 1) ? (we >> 16) : (we & 0xffff));
                        *(bf16_t*)(stg + 2048 + tk * 32 + fr * 2) = (bf16_t)((j & 1) ? (wx >> 16) : (wx & 0xffff)); }
                asm volatile("s_waitcnt lgkmcnt(0)" ::: "memory");
#pragma unroll
                for (int i = 0; i < 2; ++i) { const int piece = lane + 64 * i, tk = piece >> 1, hf = piece & 1;
                    const size_t go = (t0 + rowb + tk) * 1536 + n * 192 + 48 * wc + 16 * tc + 8 * hf;
                    *(u32x4_t*)(epsb + go) = *(const u32x4_t*)(stg + tk * 32 + hf * 16);
                    *(u32x4_t*)(xinb + go) = *(const u32x4_t*)(stg + 2048 + tk * 32 + hf * 16); }
                asm volatile("s_waitcnt lgkmcnt(0)" ::: "memory");
            }
        }
        if (fq == 0) {
#pragma unroll
            for (int tc = 0; tc < 3; ++tc) { const size_t o = ((size_t)b * 64 + sub) * 1536 + n * 192 + 48 * wc + 16 * tc + fr; segA[o] = atot[tc]; segH[o] = hrun[tc]; }
        }
        __syncthreads();
    }
}
DEV void p_lru_scan(const bf16_t* epsb, const bf16_t* xinb, bf16_t* gl, const float* carry) {
    const int tid = otid();
    if (tid >= 384) return;
    for (int item = blockIdx.x; item < 256; item += gridDim.x) {
        const int b = item >> 6, sub = item & 63;
        const size_t base = ((size_t)b * SEQ + sub * 128) * 1536 + tid * 4;
        const float4 cin = *(const float4*)(carry + ((size_t)b * 64 + sub) * 1536 + tid * 4);
        float h0 = cin.x, h1 = cin.y, h2 = cin.z, h3 = cin.w;
#pragma unroll 8
        for (int t = 0; t < 128; ++t) {
            const size_t o = base + (size_t)t * 1536;
            const uint2 ev = *(const uint2*)(epsb + o), xv = *(const uint2*)(xinb + o), gv = *(const uint2*)(gl + o);
            h0 = (1.f - __uint_as_float(ev.x << 16)) * h0 + __uint_as_float(xv.x << 16);
            h1 = (1.f - __uint_as_float(ev.x & 0xffff0000u)) * h1 + __uint_as_float(xv.x & 0xffff0000u);
            h2 = (1.f - __uint_as_float(ev.y << 16)) * h2 + __uint_as_float(xv.y << 16);
            h3 = (1.f - __uint_as_float(ev.y & 0xffff0000u)) * h3 + __uint_as_float(xv.y & 0xffff0000u);
            uint2 ov; ov.x = pg8::cvt_pk_bf16(h0 * __uint_as_float(gv.x << 16), h1 * __uint_as_float(gv.x & 0xffff0000u)); ov.y = pg8::cvt_pk_bf16(h2 * __uint_as_float(gv.y << 16), h3 * __uint_as_float(gv.y & 0xffff0000u));
            *(uint2*)(gl + o) = ov;
        }
    }
}
DEV void p_lru_carry(float* lds, const float* segA, const float* segH, float* carry) {
    float* tA = lds; float* tH = lds + 64 * 65;
    for (int item = blockIdx.x; item < 96; item += gridDim.x) {
        const int b = item / 24, c0 = (item % 24) * 64;
        for (int i = otid(); i < 64 * 64; i += NTHR) { const int s = i >> 6, c = i & 63; const size_t o = ((size_t)b * 64 + s) * 1536 + c0 + c; tA[s * 65 + c] = segA[o]; tH[s * 65 + c] = segH[o]; }
        __syncthreads();
        if (otid() < 64) { const int c = otid(); float h = 0.f;
            for (int s = 0; s < 64; ++s) { const float a = tA[s * 65 + c], hh = tH[s * 65 + c]; tA[s * 65 + c] = h; h = a * h + hh; } }
        __syncthreads();
        for (int i = otid(); i < 64 * 64; i += NTHR) { const int s = i >> 6, c = i & 63; carry[((size_t)b * 64 + s) * 1536 + c0 + c] = tA[s * 65 + c]; }
        __syncthreads();
    }
}
#define LDS_BARRIER() do { asm volatile("s_waitcnt lgkmcnt(0)" ::: "memory"); __builtin_amdgcn_s_barrier(); asm volatile("" ::: "memory"); } while (0)
DEV void p_scores(unsigned char* lds, const bf16_t* q, const bf16_t* k, bf16_t* P) {
    int tid_ = otid(); asm volatile("" : "+v"(tid_));
    const int tid = tid_, w = tid >> 6, lane = tid & 63, fr = lane & 15, fq = lane >> 4;
    const int krow = tid >> 5, kch = tid & 31;
    u32x4_t kreg[8]; bf16x8_t qa[8];
    int g = blockIdx.x;
    if (g < 1024) { const int c = g & 63, bh = g >> 6, b = bh >> 2, h = bh & 3; const size_t tok0 = (size_t)b * SEQ + c * 128;
        const bf16_t* kc = k + tok0 * 1024 + h * 256;
#pragma unroll
        for (int ii = 0; ii < 8; ++ii) kreg[ii] = *(const u32x4_t*)(kc + (size_t)(krow + 16 * ii) * 1024 + kch * 8);
        const bf16_t* qp = q + ((tok0 >> 7) * 4 + h) * 32768 + (fq * 128 + 16 * w + fr) * 8;
#pragma unroll
        for (int ks = 0; ks < 8; ++ks) qa[ks] = *(const bf16x8_t*)(qp + ks * 4096); }
    for (; g < 1024; g += gridDim.x) {
#pragma unroll
        for (int ii = 0; ii < 8; ++ii) *(u32x4_t*)(lds + (krow + 16 * ii) * 528 + kch * 16) = kreg[ii];
        bf16x8_t qc[8];
#pragma unroll
        for (int ks = 0; ks < 8; ++ks) qc[ks] = qa[ks];
        const int gn = g + gridDim.x;
        if (gn < 1024) { const int c = gn & 63, bh = gn >> 6, b = bh >> 2, h = bh & 3; const size_t tok0 = (size_t)b * SEQ + c * 128;
            const bf16_t* kc = k + tok0 * 1024 + h * 256;
#pragma unroll
            for (int ii = 0; ii < 8; ++ii) kreg[ii] = *(const u32x4_t*)(kc + (size_t)(krow + 16 * ii) * 1024 + kch * 8);
            const bf16_t* qp = q + ((tok0 >> 7) * 4 + h) * 32768 + (fq * 128 + 16 * w + fr) * 8;
#pragma unroll
            for (int ks = 0; ks < 8; ++ks) qa[ks] = *(const bf16x8_t*)(qp + ks * 4096); }
        LDS_BARRIER();
        f32x4_t acc[8];
#pragma unroll
        for (int nt = 0; nt < 8; ++nt) acc[nt] = (f32x4_t){0.f, 0.f, 0.f, 0.f};
#pragma unroll
        for (int ks = 0; ks < 8; ++ks)
#pragma unroll
            for (int nt = 0; nt < 8; ++nt) { const bf16x8_t bb = *(const bf16x8_t*)(lds + (16 * nt + fr) * 528 + ks * 64 + fq * 16); acc[nt] = __builtin_amdgcn_mfma_f32_16x16x32_bf16(bb, qc[ks], acc[nt], 0, 0, 0); }
        {
            const int c = g & 63, bh = g >> 6, b = bh >> 2, h = bh & 3;
            bf16_t* kt = const_cast<bf16_t*>(k) + ((size_t)b * SEQ + c * 128 + fq * 8 + w) * 1024 + h * 256 + fr * 8;
#pragma unroll
            for (int ks = 0; ks < 4; ++ks)
#pragma unroll
                for (int di = 0; di < 2; ++di) {
                    const unsigned char* kp = lds + (32 * ks + 8 * fq + (fr >> 2)) * 528 + (16 * (2 * w + di) + 4 * (fr & 3)) * 2;
                    const s16x4_t t0 = __builtin_amdgcn_ds_read_tr16_b64_v4i16((LAS s16x4_t*)(kp));
                    const s16x4_t t1 = __builtin_amdgcn_ds_read_tr16_b64_v4i16((LAS s16x4_t*)(kp + 4 * 528));
                    *(bf16x8_t*)(kt + ks * 32768 + di * 128) = (bf16x8_t){t0[0], t0[1], t0[2], t0[3], t1[0], t1[1], t1[2], t1[3]};
                }
        }
        LDS_BARRIER();
        bf16_t* Pg = P + (size_t)g * 16384 + ((fq >> 1) * 128 + 16 * w + fr) * 8 + 4 * (fq & 1);
        int mrow = 16 * w + fr - 4 * fq; asm volatile("" : "+v"(mrow));
#pragma unroll
        for (int nt = 0; nt < 8; ++nt) {
            uint2 o; o.x = pg8::cvt_pk_bf16((16 * nt <= mrow) ? acc[nt][0] : 0.f, (16 * nt + 1 <= mrow) ? acc[nt][1] : 0.f);
            o.y = pg8::cvt_pk_bf16((16 * nt + 2 <= mrow) ? acc[nt][2] : 0.f, (16 * nt + 3 <= mrow) ? acc[nt][3] : 0.f);
            *(uint2*)(Pg + ((nt >> 1) * 4 + 2 * (nt & 1)) * 1024) = o; }
    }
    __syncthreads();
}
constexpr int RT_KS = 528, RT_VS = 272, RT_V = 0, RT_U = 2 * 32 * RT_VS;
DEV void p_ret_mfma(unsigned char* lds, const bf16_t* q, const bf16_t* k, bf16_t* v, const bf16_t* P) {
    int tid_ = otid(); asm volatile("" : "+v"(tid_));
    const int tid = tid_, w = tid >> 6, lane = tid & 63, fr = lane & 15, fq = lane >> 4;
    for (int wk = blockIdx.x; wk < 256; wk += gridDim.x) {
        const int xcd = wk & 7, idx = wk >> 3, bh = xcd * 2 + (idx >> 4), sl = idx & 15, b = bh >> 2, h = bh & 3;
        float g128; { const double gam = 1.0 - exp2(-5.0 - (double)h); g128 = (float)exp2(128.0 * log2(gam)); }
        asm volatile("" : "+v"(g128));
        f32x4_t accU[2][2];
#pragma unroll
        for (int et = 0; et < 2; ++et)
#pragma unroll
            for (int di = 0; di < 2; ++di) accU[et][di] = (f32x4_t){0.f, 0.f, 0.f, 0.f};
        for (int i = tid; i < 32 * RT_KS / 4; i += NTHR) ((unsigned*)(lds + RT_U))[i] = 0u;
        const size_t tokb = (size_t)b * SEQ;
        const int vm = tid >> 2, ve = (tid & 3) * 8;
        const bf16_t* vsl = v + tokb * 2048 + h * 512 + sl * 32;
#define RT_STAGE_V(buf, vr) do { unsigned char* vp_ = lds + RT_V + (buf) * 32 * RT_VS + ve * RT_VS + vm * 2; \
            *(bf16_t*)(vp_ + 0 * RT_VS) = (bf16_t)((vr)[0] & 0xffff); *(bf16_t*)(vp_ + 1 * RT_VS) = (bf16_t)((vr)[0] >> 16); \
            *(bf16_t*)(vp_ + 2 * RT_VS) = (bf16_t)((vr)[1] & 0xffff); *(bf16_t*)(vp_ + 3 * RT_VS) = (bf16_t)((vr)[1] >> 16); \
            *(bf16_t*)(vp_ + 4 * RT_VS) = (bf16_t)((vr)[2] & 0xffff); *(bf16_t*)(vp_ + 5 * RT_VS) = (bf16_t)((vr)[2] >> 16); \
            *(bf16_t*)(vp_ + 6 * RT_VS) = (bf16_t)((vr)[3] & 0xffff); *(bf16_t*)(vp_ + 7 * RT_VS) = (bf16_t)((vr)[3] >> 16); } while (0)
        u32x4_t vreg = *(const u32x4_t*)(vsl + (size_t)vm * 2048 + ve);
        RT_STAGE_V(0, vreg);
        vreg = *(const u32x4_t*)(vsl + (size_t)(128 + vm) * 2048 + ve);
        bf16x8_t qa[8], pa[4], kb[2][4];
        const bf16_t* qp = q + ((tokb >> 7) * 4 + h) * 32768 + (fq * 128 + 16 * w + fr) * 8;
        const bf16_t* pp = P + (size_t)(bh * 64) * 16384 + (fq * 128 + 16 * w + fr) * 8;
        const bf16_t* kp = k + (tokb + fq * 8 + w) * 1024 + h * 256 + fr * 8;
        {
#pragma unroll
            for (int ks = 0; ks < 8; ++ks) qa[ks] = *(const bf16x8_t*)(qp + ks * 4096);
#pragma unroll
            for (int ks = 0; ks < 4; ++ks) { if (2 * ks <= w) pa[ks] = *(const bf16x8_t*)(pp + ks * 4096); else pa[ks] = (bf16x8_t){0, 0, 0, 0, 0, 0, 0, 0}; }
#pragma unroll
            for (int di = 0; di < 2; ++di)
#pragma unroll
                for (int ks = 0; ks < 4; ++ks) kb[di][ks] = *(const bf16x8_t*)(kp + ks * 32768 + di * 128);
        }
        LDS_BARRIER();
#pragma unroll 1
        for (int c = 0; c < 64; ++c) {
            const size_t tok0 = tokb + c * 128;
            const unsigned char* ldsU = lds + RT_U + (c & 1) * 32 * RT_KS;
            const unsigned char* ldsV = lds + RT_V + (c & 1) * 32 * RT_VS;
            f32x4_t ao[2] = {(f32x4_t){0.f, 0.f, 0.f, 0.f}, (f32x4_t){0.f, 0.f, 0.f, 0.f}};
            {
                bf16x8_t bu[8];
#pragma unroll
                for (int nt = 0; nt < 2; ++nt) {
#pragma unroll
                    for (int ks = 0; ks < 8; ++ks) bu[ks] = *(const bf16x8_t*)(ldsU + (16 * nt + fr) * RT_KS + ks * 64 + fq * 16);
#pragma unroll
                    for (int ks = 0; ks < 8; ++ks) ao[nt] = __builtin_amdgcn_mfma_f32_16x16x32_bf16(bu[ks], qa[ks], ao[nt], 0, 0, 0);
                }
            }
            bf16x8_t bv[2][4];
#pragma unroll
            for (int nt = 0; nt < 2; ++nt)
#pragma unroll
                for (int ks = 0; ks < 4; ++ks) bv[nt][ks] = *(const bf16x8_t*)(ldsV + (16 * nt + fr) * RT_VS + ks * 64 + fq * 16);
#pragma unroll
            for (int ks = 0; ks < 4; ++ks)
#pragma unroll
                for (int nt = 0; nt < 2; ++nt) ao[nt] = __builtin_amdgcn_mfma_f32_16x16x32_bf16(bv[nt][ks], pa[ks], ao[nt], 0, 0, 0);
            if (c + 1 < 64) {
                const bf16_t* qn = qp + (size_t)(c + 1) * 131072;
#pragma unroll
                for (int ks = 0; ks < 8; ++ks) qa[ks] = *(const bf16x8_t*)(qn + ks * 4096);
                const bf16_t* pn = pp + (size_t)(c + 1) * 16384;
#pragma unroll
                for (int ks = 0; ks < 4; ++ks) if (2 * ks <= w) pa[ks] = *(const bf16x8_t*)(pn + ks * 4096);
            }
            {
                bf16_t* vc = v + (tok0 + 16 * w + fr) * 2048 + h * 512 + sl * 32 + 4 * fq;
#pragma unroll
                for (int nt = 0; nt < 2; ++nt) { uint2 o; o.x = pg8::cvt_pk_bf16(ao[nt][0], ao[nt][1]); o.y = pg8::cvt_pk_bf16(ao[nt][2], ao[nt][3]); *(uint2*)(vc + 16 * nt) = o; }
            }
#pragma unroll
            for (int ks = 0; ks < 4; ++ks)
#pragma unroll
                for (int di = 0; di < 2; ++di)
#pragma unroll
                    for (int et = 0; et < 2; ++et) accU[et][di] = __builtin_amdgcn_mfma_f32_16x16x32_bf16(kb[di][ks], bv[et][ks], accU[et][di], 0, 0, 0);
            if (c + 1 < 64) {
                const bf16_t* kn = kp + (size_t)(c + 1) * 131072;
#pragma unroll
                for (int di = 0; di < 2; ++di)
#pragma unroll
                    for (int ks = 0; ks < 4; ++ks) kb[di][ks] = *(const bf16x8_t*)(kn + ks * 32768 + di * 128);
            }
#pragma unroll
            for (int et = 0; et < 2; ++et)
#pragma unroll
                for (int di = 0; di < 2; ++di) accU[et][di] = accU[et][di] * g128;
            {
                unsigned char* un = lds + RT_U + ((c + 1) & 1) * 32 * RT_KS;
#pragma unroll
                for (int et = 0; et < 2; ++et)
#pragma unroll
                    for (int di = 0; di < 2; ++di) { uint2 o; o.x = pg8::cvt_pk_bf16(accU[et][di][0], accU[et][di][1]); o.y = pg8::cvt_pk_bf16(accU[et][di][2], accU[et][di][3]);
                        *(uint2*)(un + (16 * et + fr) * RT_KS + (16 * (2 * w + di) + 4 * fq) * 2) = o; }
                if (c + 1 < 64) { RT_STAGE_V((c + 1) & 1, vreg); }
                if (c + 2 < 64) vreg = *(const u32x4_t*)(vsl + (size_t)((c + 2) * 128 + vm) * 2048 + ve);
            }
            LDS_BARRIER();
        }
#undef RT_STAGE_V
        __syncthreads();
    }
}
DEV void p_headnorm(bf16_t* ret, const bf16_t* g) {
    const int lane = otid() & 63;
    for (int w = (blockIdx.x * NTHR + otid()) >> 6; w < NTOK * 4; w += gridDim.x * (NTHR / 64)) {
        const size_t o = (size_t)w * 512 + lane * 8;
        const u32x4_t rv = *(const u32x4_t*)(ret + o), gv = *(const u32x4_t*)(g + o);
        float x[8], gg[8]; float s = 0.f;
#pragma unroll
        for (int j = 0; j < 4; ++j) { x[2 * j] = __uint_as_float(rv[j] << 16); x[2 * j + 1] = __uint_as_float(rv[j] & 0xffff0000u); gg[2 * j] = __uint_as_float(gv[j] << 16); gg[2 * j + 1] = __uint_as_float(gv[j] & 0xffff0000u); }
#pragma unroll
        for (int j = 0; j < 8; ++j) s += x[j];
#pragma unroll
        for (int m = 1; m < 64; m <<= 1) s += __shfl_xor(s, m);
        const float mu = s * (1.f / 512.f); float q = 0.f;
#pragma unroll
        for (int j = 0; j < 8; ++j) { x[j] -= mu; q += x[j] * x[j]; }
#pragma unroll
        for (int m = 1; m < 64; m <<= 1) q += __shfl_xor(q, m);
        const float rstd = rsqrtf(q * (1.f / 512.f) + LN_EPS);
        u32x4_t ov;
#pragma unroll
        for (int j = 0; j < 4; ++j) ov[j] = pg8::cvt_pk_bf16(x[2 * j] * rstd * gg[2 * j], x[2 * j + 1] * rstd * gg[2 * j + 1]);
        *(u32x4_t*)(ret + o) = ov;
    }
}

typedef float f32x4v __attribute__((ext_vector_type(4)));
DEV void p_ln1_route(float* lds, const bf16_t* y, bf16_t* x1b, unsigned char* x1q, const float* g1, const float* b1, const unsigned char* rtab,
                     int2* route_e, float2* route_w, int* cnt, int* list, const float* sb) {
    int tid_ = otid(); asm volatile("" : "+v"(tid_));
    const int tid = tid_, wv = tid >> 6, lane = tid & 63, r16 = lane & 15, kq = lane >> 4;
    const unsigned char* Wt = (const unsigned char*)lds;
    float* Sc = lds + 1024 * 36;
    float* Bc = Sc + 48;
    int* lcnt = (int*)(Bc + 48);
    int* rowE = lcnt + 32;
    int* rowP = rowE + 256;
#pragma unroll 6
    for (int i = tid; i < 9216; i += NTHR) ((u32x4_t*)lds)[i] = ((const u32x4_t*)rtab)[i];
    if (tid < 32) lcnt[tid] = 0;
    __syncthreads();
    if (tid < 96) Sc[tid] = sb[tid];
    __syncthreads();
    constexpr int rows_per_wg = 128;
    for (int blk = blockIdx.x; blk < NTOK / rows_per_wg; blk += gridDim.x) {
    { const int tile = wv;
        const int lrow0 = tile * 16, row0 = blk * rows_per_wg + lrow0;
        const bf16_t* yp = y + (size_t)(row0 + r16) * 1024 + 8 * kq;
        const unsigned char* tb = Wt + lane * 16;
        const unsigned char* tb2 = Wt + 131072 + (kq * 4 + (r16 & 3)) * 16;
        f32x4v acc[3] = {(f32x4v){0.f, 0.f, 0.f, 0.f}, (f32x4v){0.f, 0.f, 0.f, 0.f}, (f32x4v){0.f, 0.f, 0.f, 0.f}};
        float s1 = 0.f, s2 = 0.f;
#pragma unroll 4
        for (int T = 0; T < 32; ++T) {
            const u32x4_t yr = *(const u32x4_t*)(yp + 32 * T);
#pragma unroll
            for (int e = 0; e < 4; ++e) { const float lo = __uint_as_float(yr[e] << 16), hi = __uint_as_float(yr[e] & 0xffff0000u); s1 += lo + hi; s2 += lo * lo + hi * hi; }
            const bf16x8_t a = __builtin_bit_cast(bf16x8_t, yr);
#pragma unroll
            for (int part = 0; part < 2; ++part) {
#pragma unroll
                for (int nt = 0; nt < 2; ++nt) acc[nt] = __builtin_amdgcn_mfma_f32_16x16x32_bf16(a, *(const bf16x8_t*)(tb + ((T * 2 + part) * 2 + nt) * 1024), acc[nt], 0, 0, 0);
                acc[2] = __builtin_amdgcn_mfma_f32_16x16x32_bf16(a, *(const bf16x8_t*)(tb2 + (T * 2 + part) * 256), acc[2], 0, 0, 0);
            }
        }
        s1 += __shfl_xor(s1, 16); s1 += __shfl_xor(s1, 32); s2 += __shfl_xor(s2, 16); s2 += __shfl_xor(s2, 32);
        const float mu = s1 * (1.f / 1024.f), rstd = rsqrtf(fmaxf(s2 * (1.f / 1024.f) - mu * mu, 0.f) + LN_EPS);
        {
            float gA[8], bA[8], gB[8], bB[8];
#pragma unroll
            for (int e = 0; e < 2; ++e) { const float4 t0 = *(const float4*)(g1 + 8 * lane + 4 * e), t1 = *(const float4*)(b1 + 8 * lane + 4 * e), t2 = *(const float4*)(g1 + 512 + 8 * lane + 4 * e), t3 = *(const float4*)(b1 + 512 + 8 * lane + 4 * e);
                gA[4 * e] = t0.x; gA[4 * e + 1] = t0.y; gA[4 * e + 2] = t0.z; gA[4 * e + 3] = t0.w; bA[4 * e] = t1.x; bA[4 * e + 1] = t1.y; bA[4 * e + 2] = t1.z; bA[4 * e + 3] = t1.w;
                gB[4 * e] = t2.x; gB[4 * e + 1] = t2.y; gB[4 * e + 2] = t2.z; gB[4 * e + 3] = t2.w; bB[4 * e] = t3.x; bB[4 * e + 1] = t3.y; bB[4 * e + 2] = t3.z; bB[4 * e + 3] = t3.w; }
#pragma unroll 2
            for (int rr = 0; rr < 16; ++rr) {
                const float mur = __shfl(mu, rr), rsr = __shfl(rstd, rr);
                const size_t ro = (size_t)(row0 + rr) * 1024 + 8 * lane;
                const u32x4_t ya = *(const u32x4_t*)(y + ro), yb = *(const u32x4_t*)(y + ro + 512);
                float oa[8], ob[8];
#pragma unroll
                for (int e = 0; e < 4; ++e) {
                    oa[2 * e] = (__uint_as_float(ya[e] << 16) - mur) * rsr * gA[2 * e] + bA[2 * e]; oa[2 * e + 1] = (__uint_as_float(ya[e] & 0xffff0000u) - mur) * rsr * gA[2 * e + 1] + bA[2 * e + 1];
                    ob[2 * e] = (__uint_as_float(yb[e] << 16) - mur) * rsr * gB[2 * e] + bB[2 * e]; ob[2 * e + 1] = (__uint_as_float(yb[e] & 0xffff0000u) - mur) * rsr * gB[2 * e + 1] + bB[2 * e + 1]; }
                *(u32x4_t*)(x1b + ro) = (u32x4_t){pg8::cvt_pk_bf16(oa[0], oa[1]), pg8::cvt_pk_bf16(oa[2], oa[3]), pg8::cvt_pk_bf16(oa[4], oa[5]), pg8::cvt_pk_bf16(oa[6], oa[7])};
                *(u32x4_t*)(x1b + ro + 512) = (u32x4_t){pg8::cvt_pk_bf16(ob[0], ob[1]), pg8::cvt_pk_bf16(ob[2], ob[3]), pg8::cvt_pk_bf16(ob[4], ob[5]), pg8::cvt_pk_bf16(ob[6], ob[7])};
                uint2 qa_, qb_;
                qa_.x = pg8::pk4_fp8(oa[0] * pg8::FP8_SX, oa[1] * pg8::FP8_SX, oa[2] * pg8::FP8_SX, oa[3] * pg8::FP8_SX); qa_.y = pg8::pk4_fp8(oa[4] * pg8::FP8_SX, oa[5] * pg8::FP8_SX, oa[6] * pg8::FP8_SX, oa[7] * pg8::FP8_SX);
                qb_.x = pg8::pk4_fp8(ob[0] * pg8::FP8_SX, ob[1] * pg8::FP8_SX, ob[2] * pg8::FP8_SX, ob[3] * pg8::FP8_SX); qb_.y = pg8::pk4_fp8(ob[4] * pg8::FP8_SX, ob[5] * pg8::FP8_SX, ob[6] * pg8::FP8_SX, ob[7] * pg8::FP8_SX);
                *(uint2*)(x1q + ro) = qa_; *(uint2*)(x1q + ro + 512) = qb_;
            }
        }
#pragma unroll
        for (int j = 0; j < 4; ++j) {
            const int rl = 4 * kq + j;
            const float mur = __shfl(mu, rl), rsr = __shfl(rstd, rl);
            float lg[3];
#pragma unroll
            for (int nt = 0; nt < 3; ++nt) lg[nt] = rsr * (acc[nt][j] - mur * Sc[16 * nt + r16]) + Bc[16 * nt + r16];
            const int gb = 16 * kq;
            const float g0 = __shfl(lg[2], gb + 0), g1v = __shfl(lg[2], gb + 1), g2 = __shfl(lg[2], gb + 2), g3 = __shfl(lg[2], gb + 3);
            int gi = 0; float gm = g0; if (g1v > gm) { gm = g1v; gi = 1; } if (g2 > gm) { gm = g2; gi = 2; } if (g3 > gm) { gm = g3; gi = 3; }
            const float gw = 1.f / (expf(g0 - gm) + expf(g1v - gm) + expf(g2 - gm) + expf(g3 - gm));
            const float lsel = (gi & 2) ? lg[1] : lg[0];
            float ev[8];
#pragma unroll
            for (int t = 0; t < 8; ++t) ev[t] = __shfl(lsel, gb + (gi & 1) * 8 + t);
            int i1 = 0; float v1 = ev[0];
#pragma unroll
            for (int t = 1; t < 8; ++t) if (ev[t] > v1) { v1 = ev[t]; i1 = t; }
            int i2 = -1; float v2 = -INFINITY;
#pragma unroll
            for (int t = 0; t < 8; ++t) if (t != i1 && ev[t] > v2) { v2 = ev[t]; i2 = t; }
            const float w1 = 1.f / (1.f + expf(v2 - v1)), w2 = 1.f - w1;
            if (r16 == 0) {
                const int lr = lrow0 + rl, r = row0 + rl, e1 = gi * 8 + i1, e2 = gi * 8 + i2;
                route_e[r] = make_int2(e1, e2); route_w[r] = make_float2(gw * w1, gw * w2);
                rowE[2 * lr] = e1; rowP[2 * lr] = atomicAdd(&lcnt[e1], 1);
                rowE[2 * lr + 1] = e2; rowP[2 * lr + 1] = atomicAdd(&lcnt[e2], 1);
            }
        }
    }
    __syncthreads();
    if (tid < 32) lcnt[tid] = atomicAdd(&cnt[tid * 64], lcnt[tid]);
    __syncthreads();
    for (int i = tid; i < 2 * rows_per_wg; i += NTHR) { const int e = rowE[i]; list[e * 32768 + lcnt[e] + rowP[i]] = (blk * rows_per_wg + (i >> 1)) * 2 + (i & 1); }
    __syncthreads();
    if (tid < 32) lcnt[tid] = 0;
    __syncthreads();
    }
}

DEV void p_final(float* out, const bf16_t* x1b, const bf16_t* ys, const float* g2, const float* b2) {
    const int lane = otid() & 63;
    for (int r = (blockIdx.x * NTHR + otid()) >> 6; r < NTOK; r += gridDim.x * (NTHR / 64)) {
        float x[16]; float s = 0.f;
#pragma unroll
        for (int j = 0; j < 4; ++j) { const int col = j * 256 + lane * 4; const ushort4 tb = *(const ushort4*)(x1b + (size_t)r * 1024 + col); const float4 t = make_float4(bf2f(tb.x), bf2f(tb.y), bf2f(tb.z), bf2f(tb.w));
            const ushort4 a = *(const ushort4*)(ys + (size_t)(2 * r) * 1024 + col), b = *(const ushort4*)(ys + (size_t)(2 * r + 1) * 1024 + col);
            x[4 * j] = ALPHA * t.x + bf2f(a.x) + bf2f(b.x); x[4 * j + 1] = ALPHA * t.y + bf2f(a.y) + bf2f(b.y); x[4 * j + 2] = ALPHA * t.z + bf2f(a.z) + bf2f(b.z); x[4 * j + 3] = ALPHA * t.w + bf2f(a.w) + bf2f(b.w);
            s += (x[4 * j] + x[4 * j + 1]) + (x[4 * j + 2] + x[4 * j + 3]); }
#pragma unroll
        for (int m = 1; m < 64; m <<= 1) s += __shfl_xor(s, m);
        const float mu = s * (1.f / 1024.f); float q = 0.f;
#pragma unroll
        for (int j = 0; j < 16; ++j) { x[j] -= mu; q += x[j] * x[j]; }
#pragma unroll
        for (int m = 1; m < 64; m <<= 1) q += __shfl_xor(q, m);
        const float rstd = rsqrtf(q * (1.f / 1024.f) + LN_EPS);
#pragma unroll
        for (int j = 0; j < 4; ++j) { const int col = j * 256 + lane * 4; const float4 gg = *(const float4*)(g2 + col), bb = *(const float4*)(b2 + col);
            *(float4*)(out + (size_t)r * 1024 + col) = make_float4(x[4 * j] * rstd * gg.x + bb.x, x[4 * j + 1] * rstd * gg.y + bb.y, x[4 * j + 2] * rstd * gg.z + bb.z, x[4 * j + 3] * rstd * gg.w + bb.w); }
    }
}

struct Args { const float* in[24]; float* out; unsigned char* ws; };
__global__ void __launch_bounds__(NTHR, 2) mega_fwd(Args a) {
    extern __shared__ __attribute__((aligned(16))) unsigned char lds_raw[];
    float* ldsf = (float*)lds_raw;
    PG8_LAS unsigned char* ldsl = (PG8_LAS unsigned char*)lds_raw;
    volatile LAS unsigned* MISC = (volatile LAS unsigned*)((LAS unsigned char*)lds_raw + LDS_MISC);
    for (int u = otid(); u < 128; u += NTHR) MISC[u] = 0u;
    __syncthreads();
    unsigned char* ws = a.ws;
    XcdBarrier bar = xcd_barrier_post((unsigned*)(ws + WS_CTL) + CW_BAR, MISC + 8);
#define GRID_BAR() xcd_barrier(bar)
    const float* x = a.in[0]; const float* w_in = a.in[1]; const float* b_merge = a.in[2];
    const float* conv_w = a.in[3]; const float* conv_b = a.in[4];
    const float* w_rg_r = a.in[5]; const float* b_rg_r = a.in[6]; const float* w_rg_i = a.in[7]; const float* b_rg_i = a.in[8];
    const float* lam = a.in[9]; const float* w_ret_o = a.in[10]; const float* w_lru_o = a.in[11]; const float* w_out = a.in[12];
    const float* ln1_g = a.in[13]; const float* ln1_b = a.in[14]; const float* w_group = a.in[15]; const float* b_group = a.in[16];
    const float* w_er = a.in[17]; const float* b_er = a.in[18]; const float* w_eg = a.in[19]; const float* w_eu = a.in[20];
    const float* w_ed = a.in[21]; const float* ln2_g = a.in[22]; const float* ln2_b = a.in[23];
    float* out = a.out;
    int* cnt = (int*)(ws + WS_CTL); float2* rope = (float2*)(ws + WS_ROPE); int2* route_e = (int2*)(ws + WS_ROUTE_E); float2* route_w = (float2*)(ws + WS_ROUTE_W); int* list = (int*)(ws + WS_LIST);
    bf16_t* xb = (bf16_t*)(ws + WS_XB); bf16_t* gl = (bf16_t*)(ws + WS_GL); bf16_t* ulru = (bf16_t*)(ws + WS_ULRU); bf16_t* uconv = (bf16_t*)(ws + WS_UCONV);
    bf16_t* epsb = (bf16_t*)(ws + WS_EPS); bf16_t* inp = (bf16_t*)out;
    bf16_t* q = (bf16_t*)(ws + WS_Q); bf16_t* k = (bf16_t*)(ws + WS_K); bf16_t* v = (bf16_t*)(ws + WS_V); bf16_t* gbuf = (bf16_t*)out;
    bf16_t* P = (bf16_t*)(ws + WS_P); bf16_t* gates = (bf16_t*)(ws + WS_GATES); bf16_t* m1 = (bf16_t*)out; bf16_t* merged = xb;
    bf16_t* w_in_t = (bf16_t*)(ws + WS_WIN_T); bf16_t* w_ro_t = (bf16_t*)(ws + WS_WRO_T); bf16_t* w_lo_t = (bf16_t*)(ws + WS_WLO_T); bf16_t* w_out_t = (bf16_t*)(ws + WS_WOUT_T);
    bf16_t* wrg_t = (bf16_t*)(ws + WS_WRG_T); float* segA = (float*)(ws + WS_SEGA); float* segH = (float*)(ws + WS_SEGH); float* carry = (float*)(ws + WS_CARRY);
    float* rsb = (float*)(ws + WS_RSB);
    unsigned char* wgu8 = ws + WS_WGU_T; unsigned char* wd8 = ws + WS_WD_T; unsigned char* x1q = ws + WS_X1Q;
    bf16_t* x1b = gl; bf16_t* hbuf = (bf16_t*)(ws + WS_H); bf16_t* ys = (bf16_t*)(ws + WS_YSLOT);

    p_router_consts(ldsf, ln1_g, ln1_b, w_group, b_group, w_er, b_er, rsb, ws + WS_RTAB); p_cvt_x(x, xb); p_rope_table(rope); p_weights(ldsf, w_in, w_ret_o, w_lru_o, w_out, w_rg_r, w_rg_i, w_in_t, w_ro_t, w_lo_t, w_out_t, wrg_t);
    GRID_BAR();
    { pg8::Gemm g{xb, w_in_t + (size_t)C_U * 1024, NTOK, 3072, 1024}; pg8::StaticOrder S; S.init(NTOK, 3072, (int)gridDim.x, (int)blockIdx.x);
      pg8::gemm_phase<pg8::EpiLruIn, pg8::StaticOrder, true, true>(ldsl, g, S, pg8::EpiLruIn{ulru, gl}); }
    GRID_BAR();
    p_lru_compute(lds_raw, ulru, conv_w, conv_b, wrg_t, b_rg_r, b_rg_i, lam, uconv, epsb, segA, segH);
    GRID_BAR();
    p_lru_carry(ldsf, segA, segH, carry);
    GRID_BAR();
    p_lru_scan(uconv, epsb, gl, carry);
    GRID_BAR();
    { pg8::Gemm g{xb, w_in_t, NTOK, 6144, 1024}; pg8::StaticOrder S; S.init(NTOK, 6144, (int)gridDim.x, (int)blockIdx.x);
      pg8::gemm_phase<pg8::EpiRetIn, pg8::StaticOrder, true, true>(ldsl, g, S, pg8::EpiRetIn{q, k, v, gbuf, (const float*)rope}); }
    GRID_BAR();
    p_scores(lds_raw, q, k, P);
    GRID_BAR();
    p_ret_mfma(lds_raw, q, k, v, P);
    GRID_BAR();
    p_headnorm(v, gbuf);
    { pg8::Gemm g{xb, w_in_t + (size_t)C_GATE * 1024, NTOK, 2048, 1024}; pg8::StaticOrder S; S.init(NTOK, 2048, (int)gridDim.x, (int)blockIdx.x);
      pg8::gemm_phase<pg8::EpiGates, pg8::StaticOrder, true, true>(ldsl, g, S, pg8::EpiGates{b_merge, gates}); }
    GRID_BAR();
    { pg8::Gemm g{v, w_ro_t, NTOK, 1024, 2048}; pg8::StaticOrder S; S.init(NTOK, 1024, (int)gridDim.x, (int)blockIdx.x);
      pg8::gemm_phase<pg8::EpiMerge<0>, pg8::StaticOrder, true, true>(ldsl, g, S, pg8::EpiMerge<0>{gates, nullptr, m1}); }
    GRID_BAR();
    { pg8::Gemm g{gl, w_lo_t, NTOK, 1024, 1536}; pg8::StaticOrder S; S.init(NTOK, 1024, (int)gridDim.x, (int)blockIdx.x);
      pg8::gemm_phase<pg8::EpiMerge<1>, pg8::StaticOrder, true, true>(ldsl, g, S, pg8::EpiMerge<1>{gates, m1, merged}); }
    GRID_BAR();
    { pg8::Gemm g{merged, w_out_t, NTOK, 1024, 1024}; pg8::StaticOrder S; S.init(NTOK, 1024, (int)gridDim.x, (int)blockIdx.x);
      pg8::gemm_phase<pg8::EpiOut, pg8::StaticOrder, true, true>(ldsl, g, S, pg8::EpiOut{x, (bf16_t*)out, ALPHA}); }
    GRID_BAR();
    p_ln1_route(ldsf, (const bf16_t*)out, x1b, x1q, ln1_g, ln1_b, ws + WS_RTAB, route_e, route_w, cnt, list, rsb);
    p_expert_weights(ldsf, w_eg, w_eu, w_ed, wgu8, wd8);
    GRID_BAR();
    {
        PG8_LAS pg8::MoeTab* tab = (PG8_LAS pg8::MoeTab*)(ldsl + LDS_TAB);
        pg8::moe_build_tab(tab, cnt);
        const int T = tab->tileStart[32];
        { pg8::Gemm g{(const bf16_t*)x1q, (const bf16_t*)wgu8, T * 256, 32 * 1024, 512}; pg8::MoeOrder<true> S{T * 4, (int)gridDim.x, (int)blockIdx.x, tab, list};
          pg8::gemm_phase<pg8::EpiSwiGLU8, pg8::MoeOrder<true>, true, true, true>(ldsl, g, S, pg8::EpiSwiGLU8{(unsigned char*)hbuf}); }
        GRID_BAR();
        { pg8::Gemm g{hbuf, (const bf16_t*)wd8, T * 256, 32 * 1024, 256}; pg8::MoeOrder<false> S{T * 4, (int)gridDim.x, (int)blockIdx.x, tab, list};
          pg8::gemm_phase<pg8::EpiMoeOut8, pg8::MoeOrder<false>, true, true, true>(ldsl, g, S, pg8::EpiMoeOut8{tab, list, (const float*)route_w, ys}); }
    }
    GRID_BAR();
    p_final(out, x1b, ys, ln2_g, ln2_b);
}

extern "C" void kernel_launch(void* const* d_in, const int* in_sizes, int n_in, void* d_out, int out_size, void* d_ws, size_t ws_size, hipStream_t stream) {
    static int grid = 0;
    if (grid == 0) {
        if (n_in != 24 || in_sizes[0] != NTOK * DM || out_size != NTOK * DM || ws_size < WS_END) {
            fprintf(stderr, "kernel_launch: unexpected shapes (n_in %d, in0 %d, out %d, ws %zu)\n", n_in, n_in > 0 ? in_sizes[0] : -1, out_size, ws_size); grid = -1; return; }
        int dev = 0, cus = 0, per_cu = 0;
        if (hipGetDevice(&dev) != hipSuccess || hipDeviceGetAttribute(&cus, hipDeviceAttributeMultiprocessorCount, dev) != hipSuccess) { fprintf(stderr, "kernel_launch: device query failed\n"); grid = -1; return; }
        if (hipFuncSetAttribute((const void*)mega_fwd, hipFuncAttributeMaxDynamicSharedMemorySize, LDS_BYTES) != hipSuccess) { fprintf(stderr, "kernel_launch: hipFuncSetAttribute failed\n"); grid = -1; return; }
        if (hipOccupancyMaxActiveBlocksPerMultiprocessor(&per_cu, (const void*)mega_fwd, NTHR, LDS_BYTES) != hipSuccess || per_cu < 1) {
            fprintf(stderr, "kernel_launch: occupancy query reports %d workgroups per CU\n", per_cu); (void)hipGetLastError(); grid = -1; return; }
        grid = cus;
    }
    if (grid < 0) return;
    if (hipMemsetAsync((char*)d_ws + WS_CTL, 0, CTL_ZERO_BYTES, stream) != hipSuccess) { fprintf(stderr, "kernel_launch: memset failed\n"); return; }
    Args a{};
    for (int i = 0; i < 24; ++i) a.in[i] = (const float*)d_in[i];
    a.out = (float*)d_out; a.ws = (unsigned char*)d_ws;
    hipLaunchKernelGGL(mega_fwd, dim3(grid), dim3(NTHR), LDS_BYTES, stream, a);
    const hipError_t le = hipPeekAtLastError();
    if (le != hipSuccess) fprintf(stderr, "kernel_launch: launch failed: %s\n", hipGetErrorName(le));
}
```

```cpp
#include <hip/hip_runtime.h>
#include <cstdio>
#include <cstdint>

typedef unsigned short bf16_t;
#define DEV __device__ __forceinline__
#define LAS __attribute__((address_space(3)))

DEV int otid() { int t = threadIdx.x; asm volatile("" : "+v"(t)); return t; }
DEV float bf2f(bf16_t h) { return __uint_as_float(((unsigned)h) << 16); }
typedef short bf16x8_t __attribute__((ext_vector_type(8)));
typedef unsigned u32x4_t __attribute__((ext_vector_type(4)));
DEV bf16_t f2bf(float f) { unsigned u = __float_as_uint(f); return (bf16_t)((u + 0x7fffu + ((u >> 16) & 1u)) >> 16); }

constexpr int NTHR = 512;
constexpr int NTOK = 32768, DM = 1024, SEQ = 8192;
constexpr int WIN_N = 11264;
constexpr int C_Q = 0, C_K = 1024, C_V = 2048, C_G = 4096, C_U = 6144, C_GL = 7680, C_GATE = 9216;
constexpr float ALPHA = 1.189207115002721f;
constexpr float LN_EPS = 1e-5f;
constexpr size_t MiB = 1u << 20;
constexpr size_t WS_CTL = 0;
constexpr size_t CTL_ZERO_BYTES = 1 * MiB;
constexpr int CW_BAR = 4096;
constexpr size_t WS_ROPE = 1 * MiB;
constexpr size_t WS_ROUTE_E = 9 * MiB;
constexpr size_t WS_ROUTE_W = 9 * MiB + 512 * 1024;
constexpr size_t WS_LIST = 10 * MiB;
constexpr size_t WS_WRG_T = 14 * MiB;
constexpr size_t WS_RSB = 15 * MiB + 512 * 1024;
constexpr size_t WS_RTAB = 22 * MiB;
constexpr size_t WS_SEGA = 16 * MiB;
constexpr size_t WS_SEGH = 18 * MiB;
constexpr size_t WS_CARRY = 20 * MiB;
constexpr size_t WS_XB = 32 * MiB;
constexpr size_t WS_GL = 96 * MiB;
constexpr size_t WS_ULRU = 192 * MiB;
constexpr size_t WS_Q = 192 * MiB;
constexpr size_t WS_K = 256 * MiB;
constexpr size_t WS_GATES = 192 * MiB;
constexpr size_t WS_UCONV = 288 * MiB;
constexpr size_t WS_P = 320 * MiB;
constexpr size_t WS_V = 352 * MiB;
constexpr size_t WS_EPS = 384 * MiB;
constexpr size_t WS_H = 192 * MiB;
constexpr size_t WS_YSLOT = 264 * MiB;
constexpr size_t WS_WGU_T = 352 * MiB;
constexpr size_t WS_WD_T = 416 * MiB;
constexpr size_t WS_X1Q = 160 * MiB;
constexpr int LDS_TAB = 131072;
constexpr size_t WS_WIN_T = 480 * MiB;
constexpr size_t WS_WRO_T = 502 * MiB;
constexpr size_t WS_WLO_T = 506 * MiB;
constexpr size_t WS_WOUT_T = 509 * MiB;
constexpr size_t WS_END = 512 * MiB;
constexpr int LDS_BYTES = 163840;
constexpr int LDS_MISC = 163840 - 512;

#define XB_TMO      128
#define XB_XCNT(j)  (256  + 64 * (j))
#define XB_XSUB(j)  (1280 + 64 * (j))
#define XB_XGEN(j)  (2304 + 64 * (j))
#define XB_TOP      3328
#define XB_TOPGEN   3392
#define XCD_BAR_WORDS 3456
#define XB_SPIN_CAP (1u << 22)
DEV unsigned xb_ld(unsigned* p)              { return __hip_atomic_load(p, __ATOMIC_RELAXED, __HIP_MEMORY_SCOPE_AGENT); }
DEV unsigned xb_add(unsigned* p, unsigned v) { return __hip_atomic_fetch_add(p, v, __ATOMIC_RELAXED, __HIP_MEMORY_SCOPE_AGENT); }
DEV unsigned xb_xcc_id() { return (unsigned)__builtin_amdgcn_s_getreg((3 << 11) | 20) & 0xFu; }
#define XB_SPIN(cond, bar) do { unsigned _sp = 0; while (cond) { __builtin_amdgcn_s_sleep(1); \
    if ((++_sp & 255u) == 0u) { if (xb_ld(&(bar)[XB_TMO])) break; if (_sp > XB_SPIN_CAP) { atomicAdd(&(bar)[XB_TMO], 1u); break; } } } } while (0)
struct XcdBarrier { unsigned* bar; unsigned x; volatile LAS unsigned* st; };
DEV XcdBarrier xcd_barrier_post(unsigned* bar, volatile LAS unsigned* st) {
    XcdBarrier b; b.bar = bar; b.x = xb_xcc_id(); b.st = st;
    if (otid() == 0) (void)xb_add(&bar[XB_XCNT(b.x)], 1u);
    return b;
}
DEV void xcd_barrier_complete(unsigned* bar, unsigned x, unsigned& nloc, unsigned& nx) {
    const unsigned G = gridDim.x * gridDim.y * gridDim.z;
    unsigned sum, cnt, mine, sp = 0u;
    for (;;) {
        sum = 0u; cnt = 0u; mine = 0u;
#pragma unroll
        for (unsigned j = 0; j < 16; ++j) { const unsigned c = xb_ld(&bar[XB_XCNT(j)]); sum += c; cnt += (c > 0u) ? 1u : 0u; mine = (j == x) ? c : mine; }
        if (sum == G) break;
        __builtin_amdgcn_s_sleep(1);
        if ((++sp & 255u) == 0u) { if (xb_ld(&bar[XB_TMO])) break; if (sp > XB_SPIN_CAP) { atomicAdd(&bar[XB_TMO], 1u); break; } }
    }
    nloc = mine > 0u ? mine : 1u; nx = cnt > 0u ? cnt : 1u;
}
DEV void xcd_barrier(const XcdBarrier& b) {
    asm volatile("s_waitcnt vmcnt(0)" ::: "memory");
    __syncthreads();
    if (otid() == 0) {
        unsigned* bar = b.bar;
        __builtin_amdgcn_s_waitcnt(0);
        unsigned nloc = b.st[0], nx = b.st[1];
        if (nloc == 0u) { xcd_barrier_complete(bar, b.x, nloc, nx); b.st[0] = nloc; b.st[1] = nx; }
        const unsigned old = xb_add(&bar[XB_XSUB(b.x)], 1u);
        const unsigned gen = old / nloc;
        if (old + 1u == (gen + 1u) * nloc) {
            __builtin_amdgcn_fence(__ATOMIC_RELEASE, "agent");
            asm volatile("s_waitcnt vmcnt(0)" ::: "memory");
            const unsigned og = xb_add(&bar[XB_TOP], 1u);
            const unsigned tg = og / nx;
            if (og + 1u == (tg + 1u) * nx) xb_add(&bar[XB_TOPGEN], 1u);
            else XB_SPIN(xb_ld(&bar[XB_TOPGEN]) == tg, bar);
            __builtin_amdgcn_fence(__ATOMIC_ACQUIRE, "agent");
            xb_add(&bar[XB_XGEN(b.x)], 1u);
            asm volatile("s_waitcnt vmcnt(0)" ::: "memory");
        } else {
            XB_SPIN(xb_ld(&bar[XB_XGEN(b.x)]) == gen, bar);
            __builtin_amdgcn_fence(__ATOMIC_ACQUIRE, "agent");
            asm volatile("s_waitcnt vmcnt(0)" ::: "memory");
        }
    }
    __syncthreads();
}

namespace pg8 {
#define PG8_LAS __attribute__((address_space(3)))
typedef unsigned short bf16_t;
typedef short bf16x8 __attribute__((ext_vector_type(8)));
typedef float f32x4 __attribute__((ext_vector_type(4)));
typedef unsigned u32x4 __attribute__((ext_vector_type(4)));
constexpr int BM = 256, BK = 64, HALF = 128, HTB = HALF * BK * 2  , STAGE_BYTES = 8 * HTB, NXCD = 8, WGM = 8;

__host__ __device__ __forceinline__ int lds_byte(int r, int c) { const int st = (r >> 4) * 2 + (c >> 5), rr = r & 15, cc = c & 31, ob = rr * 64 + cc * 2; return st * 1024 + (ob ^ (((ob >> 9) & 1) << 5)); }
__host__ __device__ __forceinline__ void stage_rc(int b, int& R, int& C) { const int st = b / 1024, sb = b % 1024, swz = sb ^ (((sb >> 9) & 1) << 5); R = (st >> 1) * 16 + swz / 64; C = (st & 1) * 32 + (swz % 64) / 2; }
__host__ __device__ __forceinline__ int perm32(int rho) { const int n = rho >> 4, i = rho & 15; return 8 * (i >> 2) + 4 * n + (i & 3); }

struct Unit { int pm, pn; };
struct Gemm { const bf16_t* A; const bf16_t* Bt; int M, N, K; };

struct StaticOrder {
    int nM, nN, nwg, G, c;
    __host__ __device__ void init(int M, int N, int G_, int c_) { nM = M / BM; nN = N / BM; nwg = nM * nN; G = G_; c = c_; }
    __host__ __device__ bool next(int i, Unit& u) const {
        const long L = (long)i * G + c; if (L >= nwg) return false;
        int wgid = (int)L; { const int q = nwg / NXCD, r = nwg % NXCD, xcd = wgid % NXCD, off = wgid / NXCD; wgid = (xcd < r ? xcd * (q + 1) : r * (q + 1) + (xcd - r) * q) + off; }
        const int nig = WGM * nN, gid = wgid / nig, fm = gid * WGM, gsz = (nM - fm) < WGM ? (nM - fm) : WGM;
        u.pm = fm + ((wgid % nig) % gsz); u.pn = (wgid % nig) / gsz; return true;
    }
    __device__ __forceinline__ void a_ready(const Unit&) const {}
    __device__ __forceinline__ void done(const Unit&) const {}
    __device__ __forceinline__ const char* a_base(const Gemm& g, const Unit& u) const { return (const char*)g.A + (size_t)u.pm * (size_t)(BM * g.K * 2); }
    __device__ __forceinline__ void a_off(const Gemm& g, const Unit&, const int (&R)[2], const int (&C)[2], unsigned (&v)[2][2]) const {
        _Pragma("unroll") for (int hh = 0; hh < 2; ++hh) _Pragma("unroll") for (int i = 0; i < 2; ++i) v[hh][i] = (unsigned)((hh * HALF + R[i]) * g.K + C[i]) * 2u; }
};
typedef __bf16 bf16x2_t __attribute__((ext_vector_type(2)));
typedef float f32x2_t __attribute__((ext_vector_type(2)));
__device__ __forceinline__ unsigned cvt_pk_bf16(float lo, float hi) { f32x2_t v = {lo, hi}; return __builtin_bit_cast(unsigned, __builtin_convertvector(v, bf16x2_t)); }
typedef int i32x4 __attribute__((ext_vector_type(4)));
typedef int i32x8 __attribute__((ext_vector_type(8)));
template <bool MX8> struct Frag { struct A4 { bf16x8 v[4][2]; }; struct B2 { bf16x8 v[2][2]; }; };
template <> struct Frag<true> { struct A4 { i32x8 v[4]; }; struct B2 { i32x8 v[2]; }; };
__device__ __forceinline__ i32x8 ld32(const PG8_LAS unsigned char* p0, const PG8_LAS unsigned char* p1) { const i32x4 a = *(const PG8_LAS i32x4*)p0, b = *(const PG8_LAS i32x4*)p1; return __builtin_shufflevector(a, b, 0, 1, 2, 3, 4, 5, 6, 7); }
template <class Epi, class Sched, bool ALIGN_EPI = false, bool SP2 = false, bool MX8 = false>
__device__ __forceinline__ void gemm_phase(PG8_LAS unsigned char* lds, const Gemm g, const Sched& S, const Epi& E) {
    int tid_ = otid(); asm volatile("" : "+v"(tid_));
    const int tid = tid_, wid = __builtin_amdgcn_readfirstlane(tid >> 6), lane = tid & 63, wr = wid >> 2, wc = wid & 3, fr = lane & 15, fq = lane >> 4;
    const int K = g.K, nt = K / BK;
    unsigned voffB[2], vA[2][2], vN[2][2]; int sR[2], sC[2];
#pragma unroll
    for (int i = 0; i < 2; ++i) { int R, C; stage_rc(tid * 16 + i * 8192, R, C); const int Rb = Epi::PERM ? ((R & ~31) + perm32(R & 31)) : R;
        sR[i] = R; sC[i] = C; voffB[i] = (unsigned)(Rb * K + C) * 2u; }
    const size_t kstep = (size_t)(BK * 2);
    const size_t hstep = (size_t)HALF * K * 2;
    const size_t tstep = 2 * hstep;
    const unsigned ldsw = (unsigned)wid * 1024u;
    const int aoff = lds_byte(wr * 64 + fr, fq * 8), boff = lds_byte(wc * 32 + fr, fq * 8);
#define PG8_SA(b, h) (((b) * 2 + (h)) * HTB)
#define PG8_SB(b, h) ((4 + (b) * 2 + (h)) * HTB)
#define PG8_STAGE(bufoff, gbase, voff) do { _Pragma("unroll") for (int _i = 0; _i < 2; ++_i) \
        __builtin_amdgcn_global_load_lds((const unsigned*)((const char*)(gbase) + (voff)[_i]), (PG8_LAS unsigned*)(lds + (bufoff) + ldsw + _i * 8192), 16, 0, 0); } while (0)
#define PG8_LDA(dst, b, h) do { if constexpr (MX8) { _Pragma("unroll") for (int m = 0; m < 4; ++m) dst.v[m] = ld32(lds + PG8_SA(b, h) + aoff + m * 2048, lds + PG8_SA(b, h) + aoff + m * 2048 + 1024); } \
        else { _Pragma("unroll") for (int m = 0; m < 4; ++m) _Pragma("unroll") for (int k = 0; k < 2; ++k) dst.v[m][k] = *(const PG8_LAS bf16x8*)(lds + PG8_SA(b, h) + aoff + m * 2048 + k * 1024); } } while (0)
#define PG8_LDB(dst, b, h) do { if constexpr (MX8) { _Pragma("unroll") for (int n = 0; n < 2; ++n) dst.v[n] = ld32(lds + PG8_SB(b, h) + boff + n * 2048, lds + PG8_SB(b, h) + boff + n * 2048 + 1024); } \
        else { _Pragma("unroll") for (int n = 0; n < 2; ++n) _Pragma("unroll") for (int k = 0; k < 2; ++k) dst.v[n][k] = *(const PG8_LAS bf16x8*)(lds + PG8_SB(b, h) + boff + n * 2048 + k * 1024); } } while (0)
#define PG8_MMA(ai, bj, At, Bt) do { __builtin_amdgcn_s_setprio(1); \
        if constexpr (MX8) { _Pragma("unroll") for (int m = 0; m < 4; ++m) _Pragma("unroll") for (int n = 0; n < 2; ++n) \
            { acc[ai][bj][m][n] = __builtin_amdgcn_mfma_scale_f32_16x16x128_f8f6f4(Bt.v[n], At.v[m], acc[ai][bj][m][n], 0, 0, 0, 0x7f7f7f7f, 0, 0x7f7f7f7f); asm volatile("" : "+v"(acc[ai][bj][m][n])); } } \
        else { _Pragma("unroll") for (int m = 0; m < 4; ++m) _Pragma("unroll") for (int n = 0; n < 2; ++n) _Pragma("unroll") for (int k = 0; k < 2; ++k) \
            acc[ai][bj][m][n] = __builtin_amdgcn_mfma_f32_16x16x32_bf16(Bt.v[n][k], At.v[m][k], acc[ai][bj][m][n], 0, 0, 0); } \
        __builtin_amdgcn_s_setprio(0); } while (0)
#define PG8_WAIT_V(n) asm volatile("s_waitcnt vmcnt(" #n ")" ::: "memory")
#define PG8_WAIT_L(n) asm volatile("s_waitcnt lgkmcnt(" #n ")" ::: "memory")
#define PG8_BAR __builtin_amdgcn_s_barrier()
#define PG8_SCHED __builtin_amdgcn_sched_barrier(0)
    Unit cur, nxt; int ui = 0;
    if (!S.next(0, cur)) return;
    f32x4 acc[2][2][4][2];
#pragma unroll
    for (int a = 0; a < 2; ++a)
#pragma unroll
        for (int b = 0; b < 2; ++b)
#pragma unroll
            for (int m = 0; m < 4; ++m)
#pragma unroll
                for (int n = 0; n < 2; ++n) acc[a][b][m][n] = (f32x4){0.f, 0.f, 0.f, 0.f};
    typename Frag<MX8>::A4 At; typename Frag<MX8>::B2 B0, B1;
    const char* cA = S.a_base(g, cur); const char* cB = (const char*)g.Bt + (size_t)cur.pn * tstep;
    S.a_ready(cur); S.a_off(g, cur, sR, sC, vA);
    if constexpr (SP2) {
        PG8_STAGE(PG8_SB(0, 0), cB, voffB); PG8_STAGE(PG8_SB(0, 1), cB + hstep, voffB); PG8_STAGE(PG8_SA(0, 0), cA, vA[0]); PG8_STAGE(PG8_SA(0, 1), cA, vA[1]);
        if (wr == 1) PG8_BAR;
        PG8_WAIT_V(2); PG8_BAR;
        PG8_STAGE(PG8_SB(1, 0), cB + kstep, voffB); PG8_STAGE(PG8_SA(1, 0), cA + kstep, vA[0]); PG8_STAGE(PG8_SB(1, 1), cB + hstep + kstep, voffB);
        PG8_WAIT_V(6); PG8_BAR;
    } else { static_assert(SP2, "only the SP2 K-loop is kept in this file"); }
    for (;;) {
        const bool has_next = S.next(ui + 1, nxt);
        const char* nA = has_next ? S.a_base(g, nxt) : cA; const char* nB = has_next ? (const char*)g.Bt + (size_t)nxt.pn * tstep : cB;
        if (has_next) S.a_off(g, nxt, sR, sC, vN); else { vN[0][0] = vA[0][0]; vN[0][1] = vA[0][1]; vN[1][0] = vA[1][0]; vN[1][1] = vA[1][1]; }
#pragma unroll 1
        for (int t = 0; t < nt; t += 2) {
            const bool last = (t == nt - 2);
            const char* a1 = cA + (size_t)(t + 1) * kstep;
            const char* a2 = last ? nA : cA + (size_t)(t + 2) * kstep; const char* b2 = last ? nB : cB + (size_t)(t + 2) * kstep;
            const char* a3 = a2 + kstep; const char* b3 = b2 + kstep;
            unsigned v2[2][2]; v2[0][0] = last ? vN[0][0] : vA[0][0]; v2[0][1] = last ? vN[0][1] : vA[0][1]; v2[1][0] = last ? vN[1][0] : vA[1][0]; v2[1][1] = last ? vN[1][1] : vA[1][1];
            if (last && has_next) S.a_ready(nxt);
            if constexpr (SP2) {
            PG8_LDB(B0, 0, 0); PG8_LDB(B1, 0, 1); PG8_SCHED; PG8_LDA(At, 0, 0); PG8_STAGE(PG8_SA(1, 1), a1, vA[1]);
            PG8_WAIT_V(8); PG8_WAIT_L(0); PG8_BAR; PG8_MMA(0, 0, At, B0); PG8_MMA(0, 1, At, B1); PG8_BAR; PG8_SCHED;
            PG8_LDA(At, 0, 1); PG8_STAGE(PG8_SB(0, 0), b2, voffB); PG8_STAGE(PG8_SB(0, 1), b2 + hstep, voffB); PG8_STAGE(PG8_SA(0, 0), a2, v2[0]);
            PG8_WAIT_V(8); PG8_WAIT_L(0); PG8_BAR; PG8_MMA(1, 0, At, B0); PG8_MMA(1, 1, At, B1); PG8_BAR; PG8_SCHED;
            PG8_LDB(B0, 1, 0); PG8_LDB(B1, 1, 1); PG8_SCHED; PG8_LDA(At, 1, 0); PG8_STAGE(PG8_SA(0, 1), a2, v2[1]);
            PG8_WAIT_V(8); PG8_WAIT_L(0); PG8_BAR; PG8_MMA(0, 0, At, B0); PG8_MMA(0, 1, At, B1); PG8_BAR; PG8_SCHED;
            PG8_LDA(At, 1, 1); PG8_STAGE(PG8_SB(1, 0), b3, voffB); PG8_STAGE(PG8_SB(1, 1), b3 + hstep, voffB); PG8_STAGE(PG8_SA(1, 0), a3, v2[0]);
            PG8_WAIT_V(8); PG8_WAIT_L(0); PG8_BAR; PG8_MMA(1, 0, At, B0); PG8_MMA(1, 1, At, B1); PG8_BAR; PG8_SCHED;
            }
        }
        if constexpr (ALIGN_EPI) { if (wr == 0) PG8_BAR; }
        if constexpr (!Epi::AFTER_DRAIN) { E(acc, cur, wr, wc, fr, fq); S.done(cur); }
        if (!has_next) break;
#pragma unroll
        for (int a = 0; a < 2; ++a)
#pragma unroll
            for (int b = 0; b < 2; ++b)
#pragma unroll
                for (int m = 0; m < 4; ++m)
#pragma unroll
                    for (int n = 0; n < 2; ++n) acc[a][b][m][n] = (f32x4){0.f, 0.f, 0.f, 0.f};
        cur = nxt; cA = nA; cB = nB; ++ui; vA[0][0] = vN[0][0]; vA[0][1] = vN[0][1]; vA[1][0] = vN[1][0]; vA[1][1] = vN[1][1];
        if constexpr (ALIGN_EPI) { if (wr == 1) PG8_BAR; }
    }
    PG8_WAIT_V(0);
    if constexpr (!ALIGN_EPI) { if (wr == 0) PG8_BAR; }
    PG8_BAR;
    if constexpr (Epi::AFTER_DRAIN) { E.fused(acc, cur, wr, wc, fr, fq, lds, wid, lane); S.done(cur); }
#undef PG8_SA
#undef PG8_SB
#undef PG8_STAGE
#undef PG8_LDA
#undef PG8_LDB
#undef PG8_MMA
#undef PG8_WAIT_V
#undef PG8_WAIT_L
#undef PG8_BAR
#undef PG8_SCHED
}

__device__ __forceinline__ float fsig(float x) { return __builtin_amdgcn_rcpf(1.f + __expf(-x)); }
__device__ __forceinline__ float fsilu(float x) { return x * fsig(x); }
__device__ __forceinline__ float fgelu(float x) { return x * fsig(1.5957691216057308f * (x + 0.044715f * x * x * x)); }
__device__ __forceinline__ u32x4 pack8(const f32x4& v0, const f32x4& v1) { u32x4 w; w.x = cvt_pk_bf16(v0[0], v0[1]); w.y = cvt_pk_bf16(v0[2], v0[3]); w.z = cvt_pk_bf16(v1[0], v1[1]); w.w = cvt_pk_bf16(v1[2], v1[3]); return w; }
__device__ __forceinline__ void unpack8(const u32x4& w, f32x4& v0, f32x4& v1) {
    v0[0] = __uint_as_float(w.x << 16); v0[1] = __uint_as_float(w.x & 0xffff0000u); v0[2] = __uint_as_float(w.y << 16); v0[3] = __uint_as_float(w.y & 0xffff0000u);
    v1[0] = __uint_as_float(w.z << 16); v1[1] = __uint_as_float(w.z & 0xffff0000u); v1[2] = __uint_as_float(w.w << 16); v1[3] = __uint_as_float(w.w & 0xffff0000u); }

struct EpiLruIn {
    static constexpr bool PERM = true, AFTER_DRAIN = false;
    bf16_t* u; bf16_t* gl;
    __device__ __forceinline__ void operator()(const f32x4 (&acc)[2][2][4][2], const Unit& un, int wr, int wc, int fr, int fq) const {
        const int row0 = un.pm * BM + wr * 64 + fr; const bool isg = un.pn >= 6;
        bf16_t* base = (isg ? gl : u) + (isg ? un.pn - 6 : un.pn) * BM + wc * 32 + 8 * fq;
#pragma unroll
        for (int ai = 0; ai < 2; ++ai)
#pragma unroll
            for (int m = 0; m < 4; ++m) { bf16_t* rowp = base + (size_t)(row0 + ai * HALF + m * 16) * 1536;
#pragma unroll
                for (int bj = 0; bj < 2; ++bj) { f32x4 v0 = acc[ai][bj][m][0], v1 = acc[ai][bj][m][1];
                    if (isg) {
#pragma unroll
                        for (int e = 0; e < 4; ++e) { v0[e] = fgelu(v0[e]); v1[e] = fgelu(v1[e]); } }
                    *(u32x4*)(rowp + bj * HALF) = pack8(v0, v1); } }
    }
};
struct EpiRetIn {
    static constexpr bool PERM = true, AFTER_DRAIN = false;
    bf16_t* q; bf16_t* k; bf16_t* v; bf16_t* g; const float* rope;
    __device__ __forceinline__ void operator()(const f32x4 (&acc)[2][2][4][2], const Unit& un, int wr, int wc, int fr, int fq) const {
        const int row0 = un.pm * BM + wr * 64 + fr;
        if (un.pn < 8) {
            const bool isk = un.pn >= 4; const int h = un.pn & 3;
            const float lg = __log2f(1.f - __builtin_amdgcn_exp2f(-5.f - (float)h));
            const int jb = wc * 32 + 8 * fq;
            bf16_t* base = (isk ? k : q) + h * 256 + jb;
#pragma unroll
            for (int ai = 0; ai < 2; ++ai)
#pragma unroll
                for (int m = 0; m < 4; ++m) { const int r = row0 + ai * HALF + m * 16, s = r & 8191, n = s & 127;
                    const float sc = isk ? __builtin_amdgcn_exp2f(-(float)n * lg) * 0.0625f : __builtin_amdgcn_exp2f((float)n * lg);
                    const f32x4* tp = (const f32x4*)(rope + ((size_t)s * 128 + jb) * 2);
                    f32x4 o1[2], o2[2];
#pragma unroll
                    for (int nn = 0; nn < 2; ++nn) { const f32x4 ta = tp[2 * nn], tb = tp[2 * nn + 1]; const f32x4 a = acc[ai][0][m][nn], b = acc[ai][1][m][nn];
                        o1[nn][0] = (a[0] * ta[0] - b[0] * ta[1]) * sc; o2[nn][0] = (a[0] * ta[1] + b[0] * ta[0]) * sc;
                        o1[nn][1] = (a[1] * ta[2] - b[1] * ta[3]) * sc; o2[nn][1] = (a[1] * ta[3] + b[1] * ta[2]) * sc;
                        o1[nn][2] = (a[2] * tb[0] - b[2] * tb[1]) * sc; o2[nn][2] = (a[2] * tb[1] + b[2] * tb[0]) * sc;
                        o1[nn][3] = (a[3] * tb[2] - b[3] * tb[3]) * sc; o2[nn][3] = (a[3] * tb[3] + b[3] * tb[2]) * sc; }
                    bf16_t* rowp = isk ? base + (size_t)r * 1024 : q + ((size_t)(r >> 7) * 4 + h) * 32768 + ((wc * 4 + fq) * 128 + n) * 8;
                    *(u32x4*)(rowp) = pack8(o1[0], o1[1]); *(u32x4*)(rowp + (isk ? HALF : 16384)) = pack8(o2[0], o2[1]);
                    asm volatile("" ::: "memory"); }
        } else {
            const bool isg = un.pn >= 16;
            bf16_t* base = (isg ? g : v) + ((un.pn - 8) & 7) * BM + wc * 32 + 8 * fq;
#pragma unroll
            for (int ai = 0; ai < 2; ++ai)
#pragma unroll
                for (int m = 0; m < 4; ++m) { bf16_t* rowp = base + (size_t)(row0 + ai * HALF + m * 16) * 2048;
#pragma unroll
                    for (int bj = 0; bj < 2; ++bj) { f32x4 v0 = acc[ai][bj][m][0], v1 = acc[ai][bj][m][1];
                        if (isg) {
#pragma unroll
                            for (int e = 0; e < 4; ++e) { v0[e] = fsilu(v0[e]); v1[e] = fsilu(v1[e]); } }
                        *(u32x4*)(rowp + bj * HALF) = pack8(v0, v1); } }
        }
    }
};
struct EpiGates {
    static constexpr bool PERM = true, AFTER_DRAIN = false;
    const float* bm; bf16_t* gates;
    __device__ __forceinline__ void operator()(const f32x4 (&acc)[2][2][4][2], const Unit& un, int wr, int wc, int fr, int fq) const {
        const int row0 = un.pm * BM + wr * 64 + fr, col0 = un.pn * BM + wc * 32 + 8 * fq;
        f32x4 bv[2][2];
#pragma unroll
        for (int bj = 0; bj < 2; ++bj)
#pragma unroll
            for (int n = 0; n < 2; ++n) bv[bj][n] = *(const f32x4*)(bm + col0 + bj * HALF + 4 * n);
#pragma unroll
        for (int ai = 0; ai < 2; ++ai)
#pragma unroll
            for (int m = 0; m < 4; ++m) { bf16_t* rowp = gates + (size_t)(row0 + ai * HALF + m * 16) * 2048 + col0;
#pragma unroll
                for (int bj = 0; bj < 2; ++bj) { f32x4 v0 = acc[ai][bj][m][0] + bv[bj][0], v1 = acc[ai][bj][m][1] + bv[bj][1];
#pragma unroll
                    for (int e = 0; e < 4; ++e) { v0[e] = fsig(v0[e]); v1[e] = fsig(v1[e]); }
                    *(u32x4*)(rowp + bj * HALF) = pack8(v0, v1); } }
    }
};
template <int MODE> struct EpiMerge {
    static constexpr bool PERM = true, AFTER_DRAIN = false;
    const bf16_t* gates; const bf16_t* m1in; bf16_t* o;
    __device__ __forceinline__ void operator()(const f32x4 (&acc)[2][2][4][2], const Unit& un, int wr, int wc, int fr, int fq) const {
        const int row0 = un.pm * BM + wr * 64 + fr, col0 = un.pn * BM + wc * 32 + 8 * fq;
#pragma unroll
        for (int ai = 0; ai < 2; ++ai)
#pragma unroll
            for (int m = 0; m < 4; ++m) { const size_t r = (size_t)(row0 + ai * HALF + m * 16);
#pragma unroll
                for (int bj = 0; bj < 2; ++bj) { const int c = col0 + bj * HALF;
                    f32x4 g0, g1; unpack8(*(const u32x4*)(gates + r * 2048 + MODE * 1024 + c), g0, g1);
                    f32x4 v0 = acc[ai][bj][m][0] * g0, v1 = acc[ai][bj][m][1] * g1;
                    if (MODE == 1) { f32x4 p0, p1; unpack8(*(const u32x4*)(m1in + r * 1024 + c), p0, p1); v0 += p0; v1 += p1; }
                    *(u32x4*)(o + r * 1024 + c) = pack8(v0, v1); } }
    }
};
struct EpiOut {
    static constexpr bool PERM = true, AFTER_DRAIN = false;
    const float* x; bf16_t* y; float alpha;
    __device__ __forceinline__ void operator()(const f32x4 (&acc)[2][2][4][2], const Unit& un, int wr, int wc, int fr, int fq) const {
        const int row0 = un.pm * BM + wr * 64 + fr, col0 = un.pn * BM + wc * 32 + 8 * fq;
#pragma unroll
        for (int ai = 0; ai < 2; ++ai)
#pragma unroll
            for (int m = 0; m < 4; ++m) { const size_t off = (size_t)(row0 + ai * HALF + m * 16) * 1024 + col0;
#pragma unroll
                for (int bj = 0; bj < 2; ++bj) { const f32x4 x0 = *(const f32x4*)(x + off + bj * HALF), x1 = *(const f32x4*)(x + off + bj * HALF + 4);
                    *(u32x4*)(y + off + bj * HALF) = pack8(x0 * alpha + acc[ai][bj][m][0], x1 * alpha + acc[ai][bj][m][1]); } }
    }
};
struct MoeTab { int tileStart[33]; int cnt[32]; int pad_[3]; int tileExp[320]; };
__device__ __forceinline__ void moe_build_tab(PG8_LAS MoeTab* tab, const int* cnt) {
    if (otid() == 0) { int t = 0; for (int e = 0; e < 32; ++e) { const int c = cnt[e * 64], nt = (c + 255) >> 8; tab->tileStart[e] = t; tab->cnt[e] = c; for (int i = 0; i < nt; ++i) tab->tileExp[t + i] = e; t += nt; } tab->tileStart[32] = t; }
    __syncthreads();
}
template <bool GATHER> struct MoeOrder {
    int U, G, c; const PG8_LAS MoeTab* tab; const int* list;
    __device__ __forceinline__ bool next(int i, Unit& u) const {
        const long L = (long)i * G + c; if (L >= U) return false;
        int wgid = (int)L; { const int q = U / NXCD, r = U % NXCD, xcd = wgid % NXCD, off = wgid / NXCD; wgid = (xcd < r ? xcd * (q + 1) : r * (q + 1) + (xcd - r) * q) + off; }
        u.pm = wgid >> 2; u.pn = tab->tileExp[u.pm] * 4 + (wgid & 3); return true;
    }
    __device__ __forceinline__ void a_ready(const Unit&) const {}
    __device__ __forceinline__ void done(const Unit&) const {}
    __device__ __forceinline__ const char* a_base(const Gemm& g, const Unit& u) const { return GATHER ? (const char*)g.A : (const char*)g.A + (size_t)u.pm * (size_t)(BM * g.K * 2); }
    __device__ __forceinline__ void a_off(const Gemm& g, const Unit& u, const int (&R)[2], const int (&C)[2], unsigned (&v)[2][2]) const {
        if (!GATHER) { _Pragma("unroll") for (int hh = 0; hh < 2; ++hh) _Pragma("unroll") for (int i = 0; i < 2; ++i) v[hh][i] = (unsigned)((hh * HALF + R[i]) * g.K + C[i]) * 2u; }
        else { const int e = u.pn >> 2, base = (u.pm - tab->tileStart[e]) * BM, ce = tab->cnt[e];
            _Pragma("unroll") for (int hh = 0; hh < 2; ++hh) _Pragma("unroll") for (int i = 0; i < 2; ++i) { const int lr = base + hh * HALF + R[i]; const int tok = (lr < ce) ? (list[e * 32768 + lr] >> 1) : 0; v[hh][i] = (unsigned)(tok * g.K + C[i]) * 2u; } }
    }
};
struct EpiSwiGLU {
    static constexpr bool PERM = true, AFTER_DRAIN = false;
    bf16_t* h;
    __device__ __forceinline__ void operator()(const f32x4 (&acc)[2][2][4][2], const Unit& un, int wr, int wc, int fr, int fq) const {
        const int row0 = un.pm * BM + wr * 64 + fr, col0 = (un.pn & 3) * 128 + wc * 32 + 8 * fq;
#pragma unroll
        for (int ai = 0; ai < 2; ++ai)
#pragma unroll
            for (int m = 0; m < 4; ++m) { f32x4 v0, v1;
#pragma unroll
                for (int e = 0; e < 4; ++e) { v0[e] = fsilu(acc[ai][0][m][0][e]) * acc[ai][1][m][0][e]; v1[e] = fsilu(acc[ai][0][m][1][e]) * acc[ai][1][m][1][e]; }
                *(u32x4*)(h + (size_t)(row0 + ai * HALF + m * 16) * 512 + col0) = pack8(v0, v1); }
    }
};
struct EpiMoeOut {
    static constexpr bool PERM = true, AFTER_DRAIN = false;
    const PG8_LAS MoeTab* tab; const int* list; const float* rw; bf16_t* ys;
    __device__ __forceinline__ void operator()(const f32x4 (&acc)[2][2][4][2], const Unit& un, int wr, int wc, int fr, int fq) const {
        const int e = un.pn >> 2, lrow0 = (un.pm - tab->tileStart[e]) * BM + wr * 64 + fr, ce = tab->cnt[e], col0 = (un.pn & 3) * BM + wc * 32 + 8 * fq;
        int slot[8]; float wgt[8];
#pragma unroll
        for (int i = 0; i < 8; ++i) { const int lr = lrow0 + (i >> 2) * HALF + (i & 3) * 16; slot[i] = (lr < ce) ? list[e * 32768 + lr] : -1; }
#pragma unroll
        for (int i = 0; i < 8; ++i) wgt[i] = (slot[i] >= 0) ? rw[slot[i]] : 0.f;
#pragma unroll
        for (int ai = 0; ai < 2; ++ai)
#pragma unroll
            for (int m = 0; m < 4; ++m) { const int i = ai * 4 + m;
                if (slot[i] >= 0) { const float w = wgt[i]; bf16_t* rowp = ys + (size_t)slot[i] * 1024 + col0;
#pragma unroll
                    for (int bj = 0; bj < 2; ++bj) *(u32x4*)(rowp + bj * HALF) = pack8(acc[ai][bj][m][0] * w, acc[ai][bj][m][1] * w); } }
    }
};

__device__ __forceinline__ float clamp448(float v) { return fminf(fmaxf(v, -448.f), 448.f); }
__device__ __forceinline__ unsigned pk4_fp8(float a, float b, float c, float d) { int p = __builtin_amdgcn_cvt_pk_fp8_f32(clamp448(a), clamp448(b), 0, false); p = __builtin_amdgcn_cvt_pk_fp8_f32(clamp448(c), clamp448(d), p, true); return (unsigned)p; }
constexpr float FP8_SX = 4.f, FP8_SW = 64.f, FP8_SH = 8.f;
struct EpiSwiGLU8 {
    static constexpr bool PERM = true, AFTER_DRAIN = false;
    unsigned char* h;
    __device__ __forceinline__ void operator()(const f32x4 (&acc)[2][2][4][2], const Unit& un, int wr, int wc, int fr, int fq) const {
        const int row0 = un.pm * BM + wr * 64 + fr, col0 = (un.pn & 3) * 128 + wc * 32 + 8 * fq; const float ds = 1.f / (FP8_SX * FP8_SW);
#pragma unroll
        for (int ai = 0; ai < 2; ++ai)
#pragma unroll
            for (int m = 0; m < 4; ++m) { float v[8];
#pragma unroll
                for (int e = 0; e < 4; ++e) { v[e] = FP8_SH * fsilu(acc[ai][0][m][0][e] * ds) * (acc[ai][1][m][0][e] * ds); v[4 + e] = FP8_SH * fsilu(acc[ai][0][m][1][e] * ds) * (acc[ai][1][m][1][e] * ds); }
                uint2 o; o.x = pk4_fp8(v[0], v[1], v[2], v[3]); o.y = pk4_fp8(v[4], v[5], v[6], v[7]);
                *(uint2*)(h + (size_t)(row0 + ai * HALF + m * 16) * 512 + col0) = o; }
    }
};
struct EpiMoeOut8 {
    static constexpr bool PERM = true, AFTER_DRAIN = false;
    const PG8_LAS MoeTab* tab; const int* list; const float* rw; bf16_t* ys;
    __device__ __forceinline__ void operator()(const f32x4 (&acc)[2][2][4][2], const Unit& un, int wr, int wc, int fr, int fq) const {
        const int e = un.pn >> 2, lrow0 = (un.pm - tab->tileStart[e]) * BM + wr * 64 + fr, ce = tab->cnt[e], col0 = (un.pn & 3) * BM + wc * 32 + 8 * fq;
#pragma unroll
        for (int ai = 0; ai < 2; ++ai)
#pragma unroll
            for (int m = 0; m < 4; ++m) { const int lr = lrow0 + ai * HALF + m * 16;
                if (lr < ce) { const int slot = list[e * 32768 + lr]; const float w = rw[slot] * (1.f / (FP8_SH * FP8_SW)); bf16_t* rowp = ys + (size_t)slot * 1024 + col0;
#pragma unroll
                    for (int bj = 0; bj < 2; ++bj) *(u32x4*)(rowp + bj * HALF) = pack8(acc[ai][bj][m][0] * w, acc[ai][bj][m][1] * w); }
                asm volatile("" ::: "memory"); }
    }
};
}

DEV unsigned pk2(float lo, float hi) { return (unsigned)f2bf(lo) | ((unsigned)f2bf(hi) << 16); }
typedef unsigned v4u __attribute__((ext_vector_type(4)));
DEV void tr_load(const float* W, int N, int item, int lane, float (&wv)[32]) {
    const int nblk = N / 32, kb = item / nblk, nb = item % nblk, k0 = 64 * kb, n0 = 32 * nb;
#pragma unroll
    for (int i = 0; i < 32; ++i) wv[i] = W[(size_t)(k0 + 2 * i + (lane >> 5)) * N + n0 + (lane & 31)];
}
DEV void tr_store(const float (&wv)[32], int K, int N, bf16_t* WT, float* scr, int item, int lane, bool gatefrag) {
    const int nblk = N / 32, kb = item / nblk, nb = item % nblk, k0 = 64 * kb, n0 = 32 * nb;
#pragma unroll
    for (int i = 0; i < 32; ++i) scr[(2 * i + (lane >> 5)) * 33 + (lane & 31)] = wv[i];
    asm volatile("s_waitcnt lgkmcnt(0)" ::: "memory");
    const int c = lane & 7;
#pragma unroll
    for (int j = 0; j < 4; ++j) { const int n = (lane >> 3) + 8 * j; const float* s = scr + (8 * c) * 33 + n;
        v4u o; o.x = pk2(s[0 * 33], s[1 * 33]); o.y = pk2(s[2 * 33], s[3 * 33]); o.z = pk2(s[4 * 33], s[5 * 33]); o.w = pk2(s[6 * 33], s[7 * 33]);
        const int oc = n0 + n, kk = k0 + 8 * c;
        const size_t off = gatefrag ? (size_t)((((oc / 48) * 3 + (oc % 48) / 16) * 6 + (kk >> 5)) * 64 + ((kk >> 3) & 3) * 16 + (oc & 15)) * 8 : (size_t)oc * K + kk;
        *(v4u*)(WT + off) = o; }
    asm volatile("s_waitcnt lgkmcnt(0)" ::: "memory");
}
DEV void tr_store_fp8(const float (&wv)[32], int K, int N, unsigned char* WT, int row_off, float scale, float* scr, int item, int lane) {
    const int nblk = N / 32, kb = item / nblk, nb = item % nblk, k0 = 64 * kb, n0 = 32 * nb;
#pragma unroll
    for (int i = 0; i < 32; ++i) scr[(2 * i + (lane >> 5)) * 33 + (lane & 31)] = wv[i] * scale;
    asm volatile("s_waitcnt lgkmcnt(0)" ::: "memory");
    const int c = lane & 3;
#pragma unroll
    for (int j = 0; j < 2; ++j) { const int n = (lane >> 2) + 16 * j; const float* s = scr + (16 * c) * 33 + n;
        v4u o; o.x = pg8::pk4_fp8(s[0 * 33], s[1 * 33], s[2 * 33], s[3 * 33]); o.y = pg8::pk4_fp8(s[4 * 33], s[5 * 33], s[6 * 33], s[7 * 33]);
        o.z = pg8::pk4_fp8(s[8 * 33], s[9 * 33], s[10 * 33], s[11 * 33]); o.w = pg8::pk4_fp8(s[12 * 33], s[13 * 33], s[14 * 33], s[15 * 33]);
        *(v4u*)(WT + (size_t)(row_off + n0 + n) * K + k0 + 16 * c) = o; }
    asm volatile("s_waitcnt lgkmcnt(0)" ::: "memory");
}
DEV void p_weights(float* lds, const float* w_in, const float* w_ret_o, const float* w_lru_o, const float* w_out, const float* w_rg_r, const float* w_rg_i, bf16_t* w_in_t, bf16_t* w_ro_t, bf16_t* w_lo_t, bf16_t* w_out_t, bf16_t* wrg_t, int wave, int nwaves, const float* x, bf16_t* xb) {
    const int lane = otid() & 63;
    float* scr = lds + wave * 2304;
    constexpr int I0 = 16 * (WIN_N / 32), I1 = 32 * 32, I2 = 24 * 32, I3 = 16 * 32, I4 = 16 * 18, NIT = I0 + I1 + I2 + I3 + I4;
#define PW_DECODE(it_, W_, WT_, K_, N_, sub_, gf_) const float* W_; bf16_t* WT_; int K_, N_, sub_; bool gf_ = false; { int r_ = (it_); \
        if (r_ < I0) { W_ = w_in; WT_ = w_in_t; K_ = 1024; N_ = WIN_N; sub_ = r_; } \
        else if ((r_ -= I0) < I1) { W_ = w_ret_o; WT_ = w_ro_t; K_ = 2048; N_ = 1024; sub_ = r_; } \
        else if ((r_ -= I1) < I2) { W_ = w_lru_o; WT_ = w_lo_t; K_ = 1536; N_ = 1024; sub_ = r_; } \
        else if ((r_ -= I2) < I3) { W_ = w_out; WT_ = w_out_t; K_ = 1024; N_ = 1024; sub_ = r_; } \
        else { r_ -= I3; const int mi_ = r_ / 18; W_ = (mi_ < 8 ? w_rg_r + (size_t)mi_ * 192 * 192 : w_rg_i + (size_t)(mi_ - 8) * 192 * 192); WT_ = wrg_t + (size_t)mi_ * 192 * 192; K_ = 192; N_ = 192; sub_ = r_ - mi_ * 18; gf_ = true; } }
    const int step = gridDim.x * nwaves;
    int it = blockIdx.x * nwaves + wave;
    float wv[32], wn[32];
    const size_t n4 = (size_t)NTOK * DM / 4, cstride = (size_t)gridDim.x * NTHR;
    size_t ci = (size_t)blockIdx.x * NTHR + wave * 64 + lane;
    if (it < NIT) { PW_DECODE(it, W0, T0, K0, N0, s0, g0); (void)T0; (void)K0; (void)g0; tr_load(W0, N0, s0, lane, wv); }
    for (; it < NIT || ci < n4; it += step) {
        const int nx = it + step;
        if (nx < NIT) { PW_DECODE(nx, W1, T1, K1, N1, s1, g1); (void)T1; (void)K1; (void)g1; tr_load(W1, N1, s1, lane, wn); }
        if (ci < n4) {
            float4 t[16];
#pragma unroll
            for (int u = 0; u < 16; ++u) { const size_t i = ci + u * cstride; t[u] = (i < n4) ? ((const float4*)x)[i] : make_float4(0.f, 0.f, 0.f, 0.f); }
#pragma unroll
            for (int u = 0; u < 16; ++u) { const size_t i = ci + u * cstride; if (i < n4) { uint2 o; o.x = pg8::cvt_pk_bf16(t[u].x, t[u].y); o.y = pg8::cvt_pk_bf16(t[u].z, t[u].w); ((uint2*)xb)[i] = o; } }
            ci += 16 * cstride;
        }
        if (it < NIT) { PW_DECODE(it, W2, T2, K2, N2, s2, g2); (void)W2; tr_store(wv, K2, N2, T2, scr, s2, lane, g2); }
#pragma unroll
        for (int i = 0; i < 32; ++i) wv[i] = wn[i];
    }
#undef PW_DECODE
}
DEV void p_expert_weights(float* lds, const float* w_eg, const float* w_eu, const float* w_ed, unsigned char* wgu8, unsigned char* wd8) {
    const int wave = otid() >> 6, lane = otid() & 63;
    float* scr = lds + wave * 2304;
#define EW_SRC(it_) ((((it_) >> 13) == 0 ? w_eg : ((it_) >> 13) == 1 ? w_eu : w_ed) + (size_t)(((it_) & 8191) >> 8) * 1024 * 512)
    const int step = gridDim.x * 8;
    int it = blockIdx.x * 8 + wave;
    float wv[32], wn[32];
    if (it < 3 * 8192) tr_load(EW_SRC(it), (it >> 13) < 2 ? 512 : 1024, it & 255, lane, wv);
    for (; it < 3 * 8192; it += step) {
        const int nx = it + step;
        if (nx < 3 * 8192) tr_load(EW_SRC(nx), (nx >> 13) < 2 ? 512 : 1024, nx & 255, lane, wn);
        const int kind = it >> 13, e = (it & 8191) >> 8, sub = it & 255;
        if (kind < 2) { const int nb = sub & 15; tr_store_fp8(wv, 1024, 512, wgu8 + (size_t)e * 1024 * 1024, (nb >> 2) * 128 + kind * 128, pg8::FP8_SW, scr, sub, lane); }
        else tr_store_fp8(wv, 512, 1024, wd8 + (size_t)e * 1024 * 512, 0, pg8::FP8_SW, scr, sub, lane);
#pragma unroll
        for (int i = 0; i < 32; ++i) wv[i] = wn[i];
    }
#undef EW_SRC
}

DEV void p_router_table(const float* g1, const float* wg, const float* we, unsigned char* rtab, int tg, int nthr) {
    for (int p = (gridDim.x - 1 - blockIdx.x) * nthr + tg; p < 9216; p += gridDim.x * nthr) {
        int T, part, kq, stride; const float* srcp;
        if (p < 8192) { const int col = p & 15, nt = (p >> 6) & 1; kq = (p >> 4) & 3; part = (p >> 7) & 1; T = p >> 8; srcp = we + 16 * nt + col; stride = 32; }
        else { const int p2 = p - 8192, col = p2 & 3; kq = (p2 >> 2) & 3; part = (p2 >> 4) & 1; T = p2 >> 5; srcp = wg + col; stride = 4; }
        const int k0 = 32 * T + 8 * kq;
        unsigned o[4];
#pragma unroll
        for (int j2 = 0; j2 < 4; ++j2) { unsigned pr = 0;
#pragma unroll
            for (int e = 0; e < 2; ++e) { const int kk = k0 + 2 * j2 + e; const float wv_ = g1[kk] * srcp[(size_t)kk * stride];
                const bf16_t hi = f2bf(wv_); const bf16_t val = part ? f2bf(wv_ - bf2f(hi)) : hi; pr |= (unsigned)val << (16 * e); }
            o[j2] = pr; }
        *(u32x4_t*)(rtab + (size_t)p * 16) = (u32x4_t){o[0], o[1], o[2], o[3]};
    }
}
DEV void p_router_consts(float* lds, const float* g1, const float* b1, const float* wg, const float* bg, const float* we, const float* be, float* sb) {
    const int t = otid(), wv = t >> 6, lane = t & 63;
    for (int c = (int)blockIdx.x - 64; c < 36; c += gridDim.x) {
        if (c < 0) continue;
        float s = 0.f, q = 0.f;
#pragma unroll
        for (int kk = 0; kk < 2; ++kk) { const int k = t + 512 * kk; const float w = (c < 32) ? we[(size_t)k * 32 + c] : wg[(size_t)k * 4 + c - 32]; s += g1[k] * w; q += b1[k] * w; }
#pragma unroll
        for (int m = 1; m < 64; m <<= 1) { s += __shfl_xor(s, m); q += __shfl_xor(q, m); }
        if (lane == 0) { lds[wv * 2] = s; lds[wv * 2 + 1] = q; }
        __syncthreads();
        if (t == 0) { float S = 0.f, B = 0.f;
            for (int p = 0; p < 8; ++p) { S += lds[p * 2]; B += lds[p * 2 + 1]; }
            sb[c] = S; sb[48 + c] = B + ((c < 32) ? be[c] : bg[c - 32]);
            if (c == 0) { for (int z = 36; z < 48; ++z) { sb[z] = 0.f; sb[48 + z] = 0.f; } } }
        __syncthreads();
    }
}
DEV void p_cvt_x(const float* x, bf16_t* xb, int tg, int nthr) {
    const size_t n4 = (size_t)NTOK * DM / 4, stride = (size_t)gridDim.x * nthr;
    for (size_t i0 = (size_t)blockIdx.x * nthr + tg; i0 < n4; i0 += 16 * stride) {
        float4 t[16];
#pragma unroll
        for (int u = 0; u < 16; ++u) { const size_t i = i0 + u * stride; t[u] = (i < n4) ? ((const float4*)x)[i] : make_float4(0.f, 0.f, 0.f, 0.f); }
#pragma unroll
        for (int u = 0; u < 16; ++u) { const size_t i = i0 + u * stride; if (i < n4) { uint2 o; o.x = pg8::cvt_pk_bf16(t[u].x, t[u].y); o.y = pg8::cvt_pk_bf16(t[u].z, t[u].w); ((uint2*)xb)[i] = o; } }
    }
}
DEV void p_rope_table(float2* tab, int tg, int nthr) {
    const int i0 = blockIdx.x * nthr + tg, j = i0 & 127;
    const double r = 0.93057204092969897;
    double inv = 1.0; for (int t = 0; t < j; ++t) inv *= r;
    for (int i = i0; i < 8192 * 128; i += gridDim.x * nthr) {
        const int s = i >> 7;
        const double ang = (double)s * inv;
        const double twopi_hi = 6.283185307179586232, twopi_lo = 2.4492935982947064e-16;
        const double n = rint(ang * 0.15915494309189535);
        const double x = (ang - n * twopi_hi) - n * twopi_lo;
        const double x2 = x * x;
        double acc = 1.0 - x2 * (1.0 / (22.0 * 23.0));
#pragma unroll
        for (int k = 21; k >= 3; k -= 2) acc = 1.0 - x2 * (1.0 / ((double)(k - 1) * (double)k)) * acc;
        double acc2 = 1.0 - x2 * (1.0 / (21.0 * 22.0));
#pragma unroll
        for (int k = 20; k >= 2; k -= 2) acc2 = 1.0 - x2 * (1.0 / ((double)(k - 1) * (double)k)) * acc2;
        tab[i] = make_float2((float)acc2, (float)(x * acc));
    }
}

typedef float f32x4_t __attribute__((ext_vector_type(4)));
typedef short s16x4_t __attribute__((ext_vector_type(4)));
constexpr int LRU_ROWB = 400;
DEV void p_lru_compute(unsigned char* lds, const bf16_t* ulru, const float* cw, const float* cb, const bf16_t* wrg_t,
                       const float* b_r, const float* b_i, const float* lam, bf16_t* epsb, bf16_t* xinb, float* segA, float* segH) {
    int tid_ = otid(); asm volatile("" : "+v"(tid_));
    const int tid = tid_, wave = tid >> 6, lane = tid & 63, fr = lane & 15, fq = lane >> 4, wr = wave >> 2, wc = wave & 3;
    unsigned char* stg = lds + 256 * LRU_ROWB + wave * 4096;
    for (int item = blockIdx.x; item < 1024; item += gridDim.x) {
        const int n = item & 7, b = (item >> 3) & 3, seg = item >> 5;
        const size_t t0 = (size_t)b * SEQ + seg * 256;
        {
            const int c8 = tid % 24, run = tid / 24, r0 = run * 13;
            if (run < 20) {
                const int ch0 = n * 192 + c8 * 8;
                float wj[4][8], bias[8];
#pragma unroll
                for (int j = 0; j < 4; ++j) { const float4 w0 = *(const float4*)(cw + j * 1536 + ch0), w1 = *(const float4*)(cw + j * 1536 + ch0 + 4);
                    wj[j][0] = w0.x; wj[j][1] = w0.y; wj[j][2] = w0.z; wj[j][3] = w0.w; wj[j][4] = w1.x; wj[j][5] = w1.y; wj[j][6] = w1.z; wj[j][7] = w1.w; }
                { const float4 c0 = *(const float4*)(cb + ch0), c1 = *(const float4*)(cb + ch0 + 4); bias[0] = c0.x; bias[1] = c0.y; bias[2] = c0.z; bias[3] = c0.w; bias[4] = c1.x; bias[5] = c1.y; bias[6] = c1.z; bias[7] = c1.w; }
                u32x4_t raw[16];
#pragma unroll
                for (int i = 0; i < 16; ++i) { const int r = r0 - 3 + i;
                    raw[i] = (r < 256 && seg * 256 + r >= 0) ? *(const u32x4_t*)(ulru + (t0 + r) * 1536 + ch0) : (u32x4_t){0u, 0u, 0u, 0u}; }
                float xw[4][8];
#pragma unroll
                for (int i = 0; i < 16; ++i) {
#pragma unroll
                    for (int e = 0; e < 4; ++e) { xw[i & 3][2 * e] = __uint_as_float(raw[i][e] << 16); xw[i & 3][2 * e + 1] = __uint_as_float(raw[i][e] & 0xffff0000u); }
                    if (i >= 3) {
                        const int r = r0 + i - 3;
                        float acc[8];
#pragma unroll
                        for (int e = 0; e < 8; ++e) acc[e] = bias[e] + wj[0][e] * xw[(i + 1) & 3][e] + wj[1][e] * xw[(i + 2) & 3][e] + wj[2][e] * xw[(i + 3) & 3][e] + wj[3][e] * xw[i & 3][e];
                        if (r < 256) { uint4 o; o.x = pg8::cvt_pk_bf16(acc[0], acc[1]); o.y = pg8::cvt_pk_bf16(acc[2], acc[3]); o.z = pg8::cvt_pk_bf16(acc[4], acc[5]); o.w = pg8::cvt_pk_bf16(acc[6], acc[7]);
                            *(uint4*)(lds + r * LRU_ROWB + c8 * 16) = o; }
                    }
                }
            }
        }
        __syncthreads();
        float cbr[3], cbi[3], csp[3], hrun[3], atot[3];
        const int sub = seg * 2 + wr;
#pragma unroll
        for (int tc = 0; tc < 3; ++tc) { const int ch = n * 192 + 48 * wc + 16 * tc + fr; cbr[tc] = b_r[ch]; cbi[tc] = b_i[ch]; csp[tc] = 8.f * 1.4426950408889634f * log1pf(__expf(-lam[ch])); atot[tc] = 1.f; hrun[tc] = 0.f; }
        const bf16_t* wrb = wrg_t + (size_t)n * 192 * 192 + (size_t)(wc * 18) * 512 + lane * 8;
        const bf16_t* wib = wrb + (size_t)8 * 192 * 192;
#pragma unroll
        for (int tc = 0; tc < 3; ++tc) {
            bf16x8_t bfr[6][2];
#pragma unroll
            for (int ks = 0; ks < 6; ++ks) { bfr[ks][0] = *(const bf16x8_t*)(wrb + (tc * 6 + ks) * 512); bfr[ks][1] = *(const bf16x8_t*)(wib + (tc * 6 + ks) * 512); }
#pragma unroll
            for (int p = 0; p < 2; ++p) {
                const int rowb = 128 * wr + 64 * p;
                f32x4_t acc[4][2];
#pragma unroll
                for (int m = 0; m < 4; ++m) { acc[m][0] = (f32x4_t){0.f, 0.f, 0.f, 0.f}; acc[m][1] = (f32x4_t){0.f, 0.f, 0.f, 0.f}; }
#pragma unroll
                for (int ks = 0; ks < 6; ++ks) {
                    bf16x8_t afr[4];
#pragma unroll
                    for (int m = 0; m < 4; ++m) afr[m] = *(const bf16x8_t*)(lds + (rowb + 16 * (fr >> 2) + 4 * m + (fr & 3)) * LRU_ROWB + ks * 64 + fq * 16);
#pragma unroll
                    for (int m = 0; m < 4; ++m) { acc[m][0] = __builtin_amdgcn_mfma_f32_16x16x32_bf16(afr[m], bfr[ks][0], acc[m][0], 0, 0, 0); acc[m][1] = __builtin_amdgcn_mfma_f32_16x16x32_bf16(afr[m], bfr[ks][1], acc[m][1], 0, 0, 0); }
                }
                const int coff = (48 * wc + 16 * tc + fr) * 2;
                const unsigned char* up = lds + (rowb + 16 * fq) * LRU_ROWB + coff;
                float Al = 1.f, Bl = 0.f;
                unsigned pe[8], px[8];
#pragma unroll
                for (int m = 0; m < 4; ++m) {
                    float ee[4], xx[4];
#pragma unroll
                    for (int j = 0; j < 4; ++j) {
                        const float rr = pg8::fsig(acc[m][0][j] + cbr[tc]), ii = pg8::fsig(acc[m][1][j] + cbi[tc]);
                        const float aa = __builtin_amdgcn_exp2f(-csp[tc] * rr);
                        const float u = bf2f(*(const bf16_t*)(up + (4 * m + j) * LRU_ROWB));
                        const float om = 1.f - aa;
                        const float x = __builtin_amdgcn_sqrtf(fmaxf(om * (1.f + aa), 0.f)) * ii * u;
                        ee[j] = om; xx[j] = x; Bl = aa * Bl + x; Al *= aa;
                    }
                    pe[2 * m] = pg8::cvt_pk_bf16(ee[0], ee[1]); pe[2 * m + 1] = pg8::cvt_pk_bf16(ee[2], ee[3]);
                    px[2 * m] = pg8::cvt_pk_bf16(xx[0], xx[1]); px[2 * m + 1] = pg8::cvt_pk_bf16(xx[2], xx[3]);
                }
                { float h = hrun[tc], ap = 1.f;
#pragma unroll
                  for (int q = 0; q < 4; ++q) { const float Aq = __shfl(Al, fr + 16 * q), Bq = __shfl(Bl, fr + 16 * q); h = Aq * h + Bq; ap *= Aq; }
                  hrun[tc] = h; atot[tc] *= ap; }
#pragma unroll
                for (int m = 0; m < 4; ++m)
#pragma unroll
                    for (int j = 0; j < 4; ++j) { const int tk = 16 * fq + 4 * m + j; const unsigned we = pe[2 * m + (j >> 1)], wx = px[2 * m + (j >> 1)];
                        *(bf16_t*)(stg + tk * 32 + fr * 2) = (bf16_t)((j & 1) ? (we >> 16) : (we & 0xffff));
                        *(bf16_t*)(stg + 2048 + tk * 32 + fr * 2) = (bf16_t)((j & 1) ? (wx >> 16) : (wx & 0xffff)); }
                asm volatile("s_waitcnt lgkmcnt(0)" ::: "memory");
#pragma unroll
                for (int i = 0; i < 2; ++i) { const int piece = lane + 64 * i, tk = piece >> 1, hf = piece & 1;
                    const size_t go = (t0 + rowb + tk) * 1536 + n * 192 + 48 * wc + 16 * tc + 8 * hf;
                    *(u32x4_t*)(epsb + go) = *(const u32x4_t*)(stg + tk * 32 + hf * 16);
                    *(u32x4_t*)(xinb + go) = *(const u32x4_t*)(stg + 2048 + tk * 32 + hf * 16); }
                asm volatile("s_waitcnt lgkmcnt(0)" ::: "memory");
            }
        }
        if (fq == 0) {
#pragma unroll
            for (int tc = 0; tc < 3; ++tc) { const size_t o = ((size_t)b * 64 + sub) * 1536 + n * 192 + 48 * wc + 16 * tc + fr; segA[o] = atot[tc]; segH[o] = hrun[tc]; }
        }
        __syncthreads();
    }
}
DEV void p_lru_scan(const bf16_t* epsb, const bf16_t* xinb, bf16_t* gl, const float* carry) {
    const int tid = otid();
    if (tid >= 384) return;
    for (int item = blockIdx.x; item < 256; item += gridDim.x) {
        const int b = item >> 6, sub = item & 63;
        const size_t base = ((size_t)b * SEQ + sub * 128) * 1536 + tid * 4;
        const float4 cin = *(const float4*)(carry + ((size_t)b * 64 + sub) * 1536 + tid * 4);
        float h0 = cin.x, h1 = cin.y, h2 = cin.z, h3 = cin.w;
#pragma unroll 8
        for (int t = 0; t < 128; ++t) {
            const size_t o = base + (size_t)t * 1536;
            const uint2 ev = *(const uint2*)(epsb + o), xv = *(const uint2*)(xinb + o), gv = *(const uint2*)(gl + o);
            h0 = (1.f - __uint_as_float(ev.x << 16)) * h0 + __uint_as_float(xv.x << 16);
            h1 = (1.f - __uint_as_float(ev.x & 0xffff0000u)) * h1 + __uint_as_float(xv.x & 0xffff0000u);
            h2 = (1.f - __uint_as_float(ev.y << 16)) * h2 + __uint_as_float(xv.y << 16);
            h3 = (1.f - __uint_as_float(ev.y & 0xffff0000u)) * h3 + __uint_as_float(xv.y & 0xffff0000u);
            uint2 ov; ov.x = pg8::cvt_pk_bf16(h0 * __uint_as_float(gv.x << 16), h1 * __uint_as_float(gv.x & 0xffff0000u)); ov.y = pg8::cvt_pk_bf16(h2 * __uint_as_float(gv.y << 16), h3 * __uint_as_float(gv.y & 0xffff0000u));
            *(uint2*)(gl + o) = ov;
        }
    }
}
DEV void p_lru_carry(float* lds, const float* segA, const float* segH, float* carry) {
    float* tA = lds; float* tH = lds + 64 * 65;
    for (int item = blockIdx.x; item < 96; item += gridDim.x) {
        const int b = item / 24, c0 = (item % 24) * 64;
        for (int i = otid(); i < 64 * 64; i += NTHR) { const int s = i >> 6, c = i & 63; const size_t o = ((size_t)b * 64 + s) * 1536 + c0 + c; tA[s * 65 + c] = segA[o]; tH[s * 65 + c] = segH[o]; }
        __syncthreads();
        if (otid() < 64) { const int c = otid(); float h = 0.f;
            for (int s = 0; s < 64; ++s) { const float a = tA[s * 65 + c], hh = tH[s * 65 + c]; tA[s * 65 + c] = h; h = a * h + hh; } }
        __syncthreads();
        for (int i = otid(); i < 64 * 64; i += NTHR) { const int s = i >> 6, c = i & 63; carry[((size_t)b * 64 + s) * 1536 + c0 + c] = tA[s * 65 + c]; }
        __syncthreads();
    }
}
#define LDS_BARRIER() do { asm volatile("s_waitcnt lgkmcnt(0)" ::: "memory"); __builtin_amdgcn_s_barrier(); asm volatile("" ::: "memory"); } while (0)
DEV void p_scores(unsigned char* lds, const bf16_t* q, const bf16_t* k, bf16_t* P) {
    int tid_ = otid(); asm volatile("" : "+v"(tid_));
    const int tid = tid_, w = tid >> 6, lane = tid & 63, fr = lane & 15, fq = lane >> 4;
    const int krow = tid >> 5, kch = tid & 31;
    u32x4_t kreg[8]; bf16x8_t qa[8];
    int g = blockIdx.x;
    if (g < 1024) { const int c = g & 63, bh = g >> 6, b = bh >> 2, h = bh & 3; const size_t tok0 = (size_t)b * SEQ + c * 128;
        const bf16_t* kc = k + tok0 * 1024 + h * 256;
#pragma unroll
        for (int ii = 0; ii < 8; ++ii) kreg[ii] = *(const u32x4_t*)(kc + (size_t)(krow + 16 * ii) * 1024 + kch * 8);
        const bf16_t* qp = q + ((tok0 >> 7) * 4 + h) * 32768 + (fq * 128 + 16 * w + fr) * 8;
#pragma unroll
        for (int ks = 0; ks < 8; ++ks) qa[ks] = *(const bf16x8_t*)(qp + ks * 4096); }
    for (; g < 1024; g += gridDim.x) {
#pragma unroll
        for (int ii = 0; ii < 8; ++ii) *(u32x4_t*)(lds + (krow + 16 * ii) * 528 + kch * 16) = kreg[ii];
        bf16x8_t qc[8];
#pragma unroll
        for (int ks = 0; ks < 8; ++ks) qc[ks] = qa[ks];
        const int gn = g + gridDim.x;
        if (gn < 1024) { const int c = gn & 63, bh = gn >> 6, b = bh >> 2, h = bh & 3; const size_t tok0 = (size_t)b * SEQ + c * 128;
            const bf16_t* kc = k + tok0 * 1024 + h * 256;
#pragma unroll
            for (int ii = 0; ii < 8; ++ii) kreg[ii] = *(const u32x4_t*)(kc + (size_t)(krow + 16 * ii) * 1024 + kch * 8);
            const bf16_t* qp = q + ((tok0 >> 7) * 4 + h) * 32768 + (fq * 128 + 16 * w + fr) * 8;
#pragma unroll
            for (int ks = 0; ks < 8; ++ks) qa[ks] = *(const bf16x8_t*)(qp + ks * 4096); }
        LDS_BARRIER();
        f32x4_t acc[8];
#pragma unroll
        for (int nt = 0; nt < 8; ++nt) acc[nt] = (f32x4_t){0.f, 0.f, 0.f, 0.f};
#pragma unroll
        for (int ks = 0; ks < 8; ++ks)
#pragma unroll
            for (int nt = 0; nt < 8; ++nt) { const bf16x8_t bb = *(const bf16x8_t*)(lds + (16 * nt + fr) * 528 + ks * 64 + fq * 16); acc[nt] = __builtin_amdgcn_mfma_f32_16x16x32_bf16(bb, qc[ks], acc[nt], 0, 0, 0); }
        {
            const int c = g & 63, bh = g >> 6, b = bh >> 2, h = bh & 3;
            bf16_t* kt = const_cast<bf16_t*>(k) + ((size_t)b * SEQ + c * 128 + fq * 8 + w) * 1024 + h * 256 + fr * 8;
#pragma unroll
            for (int ks = 0; ks < 4; ++ks)
#pragma unroll
                for (int di = 0; di < 2; ++di) {
                    const unsigned char* kp = lds + (32 * ks + 8 * fq + (fr >> 2)) * 528 + (16 * (2 * w + di) + 4 * (fr & 3)) * 2;
                    const s16x4_t t0 = __builtin_amdgcn_ds_read_tr16_b64_v4i16((LAS s16x4_t*)(kp));
                    const s16x4_t t1 = __builtin_amdgcn_ds_read_tr16_b64_v4i16((LAS s16x4_t*)(kp + 4 * 528));
                    *(bf16x8_t*)(kt + ks * 32768 + di * 128) = (bf16x8_t){t0[0], t0[1], t0[2], t0[3], t1[0], t1[1], t1[2], t1[3]};
                }
        }
        LDS_BARRIER();
        bf16_t* Pg = P + (size_t)g * 16384 + ((fq >> 1) * 128 + 16 * w + fr) * 8 + 4 * (fq & 1);
        int mrow = 16 * w + fr - 4 * fq; asm volatile("" : "+v"(mrow));
#pragma unroll
        for (int nt = 0; nt < 8; ++nt) {
            uint2 o; o.x = pg8::cvt_pk_bf16((16 * nt <= mrow) ? acc[nt][0] : 0.f, (16 * nt + 1 <= mrow) ? acc[nt][1] : 0.f);
            o.y = pg8::cvt_pk_bf16((16 * nt + 2 <= mrow) ? acc[nt][2] : 0.f, (16 * nt + 3 <= mrow) ? acc[nt][3] : 0.f);
            *(uint2*)(Pg + ((nt >> 1) * 4 + 2 * (nt & 1)) * 1024) = o; }
    }
    __syncthreads();
}
constexpr int RT_KS = 528, RT_VS = 272, RT_V = 0, RT_U = 2 * 32 * RT_VS;
DEV void p_ret_mfma(unsigned char* lds, const bf16_t* q, const bf16_t* k, bf16_t* v, const bf16_t* P) {
    int tid_ = otid(); asm volatile("" : "+v"(tid_));
    const int tid = tid_, w = tid >> 6, lane = tid & 63, fr = lane & 15, fq = lane >> 4;
    for (int wk = blockIdx.x; wk < 256; wk += gridDim.x) {
        const int xcd = wk & 7, idx = wk >> 3, bh = xcd * 2 + (idx >> 4), sl = idx & 15, b = bh >> 2, h = bh & 3;
        float g128; { const double gam = 1.0 - exp2(-5.0 - (double)h); g128 = (float)exp2(128.0 * log2(gam)); }
        asm volatile("" : "+v"(g128));
        f32x4_t accU[2][2];
#pragma unroll
        for (int et = 0; et < 2; ++et)
#pragma unroll
            for (int di = 0; di < 2; ++di) accU[et][di] = (f32x4_t){0.f, 0.f, 0.f, 0.f};
        for (int i = tid; i < 32 * RT_KS / 4; i += NTHR) ((unsigned*)(lds + RT_U))[i] = 0u;
        const size_t tokb = (size_t)b * SEQ;
        const int vm = tid >> 2, ve = (tid & 3) * 8;
        const bf16_t* vsl = v + tokb * 2048 + h * 512 + sl * 32;
#define RT_STAGE_V(buf, vr) do { unsigned char* vp_ = lds + RT_V + (buf) * 32 * RT_VS + ve * RT_VS + vm * 2; \
            *(bf16_t*)(vp_ + 0 * RT_VS) = (bf16_t)((vr)[0] & 0xffff); *(bf16_t*)(vp_ + 1 * RT_VS) = (bf16_t)((vr)[0] >> 16); \
            *(bf16_t*)(vp_ + 2 * RT_VS) = (bf16_t)((vr)[1] & 0xffff); *(bf16_t*)(vp_ + 3 * RT_VS) = (bf16_t)((vr)[1] >> 16); \
            *(bf16_t*)(vp_ + 4 * RT_VS) = (bf16_t)((vr)[2] & 0xffff); *(bf16_t*)(vp_ + 5 * RT_VS) = (bf16_t)((vr)[2] >> 16); \
            *(bf16_t*)(vp_ + 6 * RT_VS) = (bf16_t)((vr)[3] & 0xffff); *(bf16_t*)(vp_ + 7 * RT_VS) = (bf16_t)((vr)[3] >> 16); } while (0)
        u32x4_t vreg = *(const u32x4_t*)(vsl + (size_t)vm * 2048 + ve);
        RT_STAGE_V(0, vreg);
        vreg = *(const u32x4_t*)(vsl + (size_t)(128 + vm) * 2048 + ve);
        bf16x8_t qa[8], pa[4], kb[2][4];
        const bf16_t* qp = q + ((tokb >> 7) * 4 + h) * 32768 + (fq * 128 + 16 * w + fr) * 8;
        const bf16_t* pp = P + (size_t)(bh * 64) * 16384 + (fq * 128 + 16 * w + fr) * 8;
        const bf16_t* kp = k + (tokb + fq * 8 + w) * 1024 + h * 256 + fr * 8;
        {
#pragma unroll
            for (int ks = 0; ks < 8; ++ks) qa[ks] = *(const bf16x8_t*)(qp + ks * 4096);
#pragma unroll
            for (int ks = 0; ks < 4; ++ks) { if (2 * ks <= w) pa[ks] = *(const bf16x8_t*)(pp + ks * 4096); else pa[ks] = (bf16x8_t){0, 0, 0, 0, 0, 0, 0, 0}; }
#pragma unroll
            for (int di = 0; di < 2; ++di)
#pragma unroll
                for (int ks = 0; ks < 4; ++ks) kb[di][ks] = *(const bf16x8_t*)(kp + ks * 32768 + di * 128);
        }
        LDS_BARRIER();
#pragma unroll 1
        for (int c = 0; c < 64; ++c) {
            const size_t tok0 = tokb + c * 128;
            const unsigned char* ldsU = lds + RT_U + (c & 1) * 32 * RT_KS;
            const unsigned char* ldsV = lds + RT_V + (c & 1) * 32 * RT_VS;
            f32x4_t ao[2] = {(f32x4_t){0.f, 0.f, 0.f, 0.f}, (f32x4_t){0.f, 0.f, 0.f, 0.f}};
            {
                bf16x8_t bu[8];
#pragma unroll
                for (int nt = 0; nt < 2; ++nt) {
#pragma unroll
                    for (int ks = 0; ks < 8; ++ks) bu[ks] = *(const bf16x8_t*)(ldsU + (16 * nt + fr) * RT_KS + ks * 64 + fq * 16);
#pragma unroll
                    for (int ks = 0; ks < 8; ++ks) ao[nt] = __builtin_amdgcn_mfma_f32_16x16x32_bf16(bu[ks], qa[ks], ao[nt], 0, 0, 0);
                }
            }
            bf16x8_t bv[2][4];
#pragma unroll
            for (int nt = 0; nt < 2; ++nt)
#pragma unroll
                for (int ks = 0; ks < 4; ++ks) bv[nt][ks] = *(const bf16x8_t*)(ldsV + (16 * nt + fr) * RT_VS + ks * 64 + fq * 16);
#pragma unroll
            for (int ks = 0; ks < 4; ++ks)
#pragma unroll
                for (int nt = 0; nt < 2; ++nt) ao[nt] = __builtin_amdgcn_mfma_f32_16x16x32_bf16(bv[nt][ks], pa[ks], ao[nt], 0, 0, 0);
            if (c + 1 < 64) {
                const bf16_t* qn = qp + (size_t)(c + 1) * 131072;
#pragma unroll
                for (int ks = 0; ks < 8; ++ks) qa[ks] = *(const bf16x8_t*)(qn + ks * 4096);
                const bf16_t* pn = pp + (size_t)(c + 1) * 16384;
#pragma unroll
                for (int ks = 0; ks < 4; ++ks) if (2 * ks <= w) pa[ks] = *(const bf16x8_t*)(pn + ks * 4096);
            }
            {
                bf16_t* vc = v + (tok0 + 16 * w + fr) * 2048 + h * 512 + sl * 32 + 4 * fq;
#pragma unroll
                for (int nt = 0; nt < 2; ++nt) { uint2 o; o.x = pg8::cvt_pk_bf16(ao[nt][0], ao[nt][1]); o.y = pg8::cvt_pk_bf16(ao[nt][2], ao[nt][3]); *(uint2*)(vc + 16 * nt) = o; }
            }
#pragma unroll
            for (int ks = 0; ks < 4; ++ks)
#pragma unroll
                for (int di = 0; di < 2; ++di)
#pragma unroll
                    for (int et = 0; et < 2; ++et) accU[et][di] = __builtin_amdgcn_mfma_f32_16x16x32_bf16(kb[di][ks], bv[et][ks], accU[et][di], 0, 0, 0);
            if (c + 1 < 64) {
                const bf16_t* kn = kp + (size_t)(c + 1) * 131072;
#pragma unroll
                for (int di = 0; di < 2; ++di)
#pragma unroll
                    for (int ks = 0; ks < 4; ++ks) kb[di][ks] = *(const bf16x8_t*)(kn + ks * 32768 + di * 128);
            }
#pragma unroll
            for (int et = 0; et < 2; ++et)
#pragma unroll
                for (int di = 0; di < 2; ++di) accU[et][di] = accU[et][di] * g128;
            {
                unsigned char* un = lds + RT_U + ((c + 1) & 1) * 32 * RT_KS;
#pragma unroll
                for (int et = 0; et < 2; ++et)
#pragma unroll
                    for (int di = 0; di < 2; ++di) { uint2 o; o.x = pg8::cvt_pk_bf16(accU[et][di][0], accU[et][di][1]); o.y = pg8::cvt_pk_bf16(accU[et][di][2], accU[et][di][3]);
                        *(uint2*)(un + (16 * et + fr) * RT_KS + (16 * (2 * w + di) + 4 * fq) * 2) = o; }
                if (c + 1 < 64) { RT_STAGE_V((c + 1) & 1, vreg); }
                if (c + 2 < 64) vreg = *(const u32x4_t*)(vsl + (size_t)((c + 2) * 128 + vm) * 2048 + ve);
            }
            LDS_BARRIER();
        }
#undef RT_STAGE_V
        __syncthreads();
    }
}
DEV void p_headnorm(bf16_t* ret, const bf16_t* g) {
    const int lane = otid() & 63;
    for (int w = (blockIdx.x * NTHR + otid()) >> 6; w < NTOK * 4; w += gridDim.x * (NTHR / 64)) {
        const size_t o = (size_t)w * 512 + lane * 8;
        const u32x4_t rv = *(const u32x4_t*)(ret + o), gv = *(const u32x4_t*)(g + o);
        float x[8], gg[8]; float s = 0.f;
#pragma unroll
        for (int j = 0; j < 4; ++j) { x[2 * j] = __uint_as_float(rv[j] << 16); x[2 * j + 1] = __uint_as_float(rv[j] & 0xffff0000u); gg[2 * j] = __uint_as_float(gv[j] << 16); gg[2 * j + 1] = __uint_as_float(gv[j] & 0xffff0000u); }
#pragma unroll
        for (int j = 0; j < 8; ++j) s += x[j];
#pragma unroll
        for (int m = 1; m < 64; m <<= 1) s += __shfl_xor(s, m);
        const float mu = s * (1.f / 512.f); float q = 0.f;
#pragma unroll
        for (int j = 0; j < 8; ++j) { x[j] -= mu; q += x[j] * x[j]; }
#pragma unroll
        for (int m = 1; m < 64; m <<= 1) q += __shfl_xor(q, m);
        const float rstd = rsqrtf(q * (1.f / 512.f) + LN_EPS);
        u32x4_t ov;
#pragma unroll
        for (int j = 0; j < 4; ++j) ov[j] = pg8::cvt_pk_bf16(x[2 * j] * rstd * gg[2 * j], x[2 * j + 1] * rstd * gg[2 * j + 1]);
        *(u32x4_t*)(ret + o) = ov;
    }
}

typedef float f32x4v __attribute__((ext_vector_type(4)));
DEV void p_ln1_route(float* lds, const bf16_t* y, bf16_t* x1b, unsigned char* x1q, const float* g1, const float* b1, const unsigned char* rtab,
                     int2* route_e, float2* route_w, int* cnt, int* list, const float* sb) {
    int tid_ = otid(); asm volatile("" : "+v"(tid_));
    const int tid = tid_, wv = tid >> 6, lane = tid & 63, r16 = lane & 15, kq = lane >> 4;
    const unsigned char* Wt = (const unsigned char*)lds;
    float* Sc = lds + 1024 * 36;
    float* Bc = Sc + 48;
    int* lcnt = (int*)(Bc + 48);
    int* rowE = lcnt + 32;
    int* rowP = rowE + 256;
#pragma unroll 6
    for (int i = tid; i < 9216; i += NTHR) ((u32x4_t*)lds)[i] = ((const u32x4_t*)rtab)[i];
    if (tid < 32) lcnt[tid] = 0;
    __syncthreads();
    if (tid < 96) Sc[tid] = sb[tid];
    __syncthreads();
    constexpr int rows_per_wg = 128;
    for (int blk = blockIdx.x; blk < NTOK / rows_per_wg; blk += gridDim.x) {
    { const int tile = wv;
        const int lrow0 = tile * 16, row0 = blk * rows_per_wg + lrow0;
        const bf16_t* yp = y + (size_t)(row0 + r16) * 1024 + 8 * kq;
        const unsigned char* tb = Wt + lane * 16;
        const unsigned char* tb2 = Wt + 131072 + (kq * 4 + (r16 & 3)) * 16;
        f32x4v acc[3] = {(f32x4v){0.f, 0.f, 0.f, 0.f}, (f32x4v){0.f, 0.f, 0.f, 0.f}, (f32x4v){0.f, 0.f, 0.f, 0.f}};
        float s1 = 0.f, s2 = 0.f;
#pragma unroll 4
        for (int T = 0; T < 32; ++T) {
            const u32x4_t yr = *(const u32x4_t*)(yp + 32 * T);
#pragma unroll
            for (int e = 0; e < 4; ++e) { const float lo = __uint_as_float(yr[e] << 16), hi = __uint_as_float(yr[e] & 0xffff0000u); s1 += lo + hi; s2 += lo * lo + hi * hi; }
            const bf16x8_t a = __builtin_bit_cast(bf16x8_t, yr);
#pragma unroll
            for (int part = 0; part < 2; ++part) {
#pragma unroll
                for (int nt = 0; nt < 2; ++nt) acc[nt] = __builtin_amdgcn_mfma_f32_16x16x32_bf16(a, *(const bf16x8_t*)(tb + ((T * 2 + part) * 2 + nt) * 1024), acc[nt], 0, 0, 0);
                acc[2] = __builtin_amdgcn_mfma_f32_16x16x32_bf16(a, *(const bf16x8_t*)(tb2 + (T * 2 + part) * 256), acc[2], 0, 0, 0);
            }
        }
        s1 += __shfl_xor(s1, 16); s1 += __shfl_xor(s1, 32); s2 += __shfl_xor(s2, 16); s2 += __shfl_xor(s2, 32);
        const float mu = s1 * (1.f / 1024.f), rstd = rsqrtf(fmaxf(s2 * (1.f / 1024.f) - mu * mu, 0.f) + LN_EPS);
        {
            float gA[8], bA[8], gB[8], bB[8];
#pragma unroll
            for (int e = 0; e < 2; ++e) { const float4 t0 = *(const float4*)(g1 + 8 * lane + 4 * e), t1 = *(const float4*)(b1 + 8 * lane + 4 * e), t2 = *(const float4*)(g1 + 512 + 8 * lane + 4 * e), t3 = *(const float4*)(b1 + 512 + 8 * lane + 4 * e);
                gA[4 * e] = t0.x; gA[4 * e + 1] = t0.y; gA[4 * e + 2] = t0.z; gA[4 * e + 3] = t0.w; bA[4 * e] = t1.x; bA[4 * e + 1] = t1.y; bA[4 * e + 2] = t1.z; bA[4 * e + 3] = t1.w;
                gB[4 * e] = t2.x; gB[4 * e + 1] = t2.y; gB[4 * e + 2] = t2.z; gB[4 * e + 3] = t2.w; bB[4 * e] = t3.x; bB[4 * e + 1] = t3.y; bB[4 * e + 2] = t3.z; bB[4 * e + 3] = t3.w; }
#pragma unroll 2
            for (int rr = 0; rr < 16; ++rr) {
                const float mur = __shfl(mu, rr), rsr = __shfl(rstd, rr);
                const size_t ro = (size_t)(row0 + rr) * 1024 + 8 * lane;
                const u32x4_t ya = *(const u32x4_t*)(y + ro), yb = *(const u32x4_t*)(y + ro + 512);
                float oa[8], ob[8];
#pragma unroll
                for (int e = 0; e < 4; ++e) {
                    oa[2 * e] = (__uint_as_float(ya[e] << 16) - mur) * rsr * gA[2 * e] + bA[2 * e]; oa[2 * e + 1] = (__uint_as_float(ya[e] & 0xffff0000u) - mur) * rsr * gA[2 * e + 1] + bA[2 * e + 1];
                    ob[2 * e] = (__uint_as_float(yb[e] << 16) - mur) * rsr * gB[2 * e] + bB[2 * e]; ob[2 * e + 1] = (__uint_as_float(yb[e] & 0xffff0000u) - mur) * rsr * gB[2 * e + 1] + bB[2 * e + 1]; }
                *(u32x4_t*)(x1b + ro) = (u32x4_t){pg8::cvt_pk_bf16(oa[0], oa[1]), pg8::cvt_pk_bf16(oa[2], oa[3]), pg8::cvt_pk_bf16(oa[4], oa[5]), pg8::cvt_pk_bf16(oa[6], oa[7])};
                *(u32x4_t*)(x1b + ro + 512) = (u32x4_t){pg8::cvt_pk_bf16(ob[0], ob[1]), pg8::cvt_pk_bf16(ob[2], ob[3]), pg8::cvt_pk_bf16(ob[4], ob[5]), pg8::cvt_pk_bf16(ob[6], ob[7])};
                uint2 qa_, qb_;
                qa_.x = pg8::pk4_fp8(oa[0] * pg8::FP8_SX, oa[1] * pg8::FP8_SX, oa[2] * pg8::FP8_SX, oa[3] * pg8::FP8_SX); qa_.y = pg8::pk4_fp8(oa[4] * pg8::FP8_SX, oa[5] * pg8::FP8_SX, oa[6] * pg8::FP8_SX, oa[7] * pg8::FP8_SX);
                qb_.x = pg8::pk4_fp8(ob[0] * pg8::FP8_SX, ob[1] * pg8::FP8_SX, ob[2] * pg8::FP8_SX, ob[3] * pg8::FP8_SX); qb_.y = pg8::pk4_fp8(ob[4] * pg8::FP8_SX, ob[5] * pg8::FP8_SX, ob[6] * pg8::FP8_SX, ob[7] * pg8::FP8_SX);
                *(uint2*)(x1q + ro) = qa_; *(uint2*)(x1q + ro + 512) = qb_;
            }
        }
#pragma unroll
        for (int j = 0; j < 4; ++j) {
            const int rl = 4 * kq + j;
            const float mur = __shfl(mu, rl), rsr = __shfl(rstd, rl);
            float lg[3];
#pragma unroll
            for (int nt = 0; nt < 3; ++nt) lg[nt] = rsr * (acc[nt][j] - mur * Sc[16 * nt + r16]) + Bc[16 * nt + r16];
            const int gb = 16 * kq;
            const float g0 = __shfl(lg[2], gb + 0), g1v = __shfl(lg[2], gb + 1), g2 = __shfl(lg[2], gb + 2), g3 = __shfl(lg[2], gb + 3);
            int gi = 0; float gm = g0; if (g1v > gm) { gm = g1v; gi = 1; } if (g2 > gm) { gm = g2; gi = 2; } if (g3 > gm) { gm = g3; gi = 3; }
            const float gw = 1.f / (expf(g0 - gm) + expf(g1v - gm) + expf(g2 - gm) + expf(g3 - gm));
            const float lsel = (gi & 2) ? lg[1] : lg[0];
            float ev[8];
#pragma unroll
            for (int t = 0; t < 8; ++t) ev[t] = __shfl(lsel, gb + (gi & 1) * 8 + t);
            int i1 = 0; float v1 = ev[0];
#pragma unroll
            for (int t = 1; t < 8; ++t) if (ev[t] > v1) { v1 = ev[t]; i1 = t; }
            int i2 = -1; float v2 = -INFINITY;
#pragma unroll
            for (int t = 0; t < 8; ++t) if (t != i1 && ev[t] > v2) { v2 = ev[t]; i2 = t; }
            const float w1 = 1.f / (1.f + expf(v2 - v1)), w2 = 1.f - w1;
            if (r16 == 0) {
                const int lr = lrow0 + rl, r = row0 + rl, e1 = gi * 8 + i1, e2 = gi * 8 + i2;
                route_e[r] = make_int2(e1, e2); route_w[r] = make_float2(gw * w1, gw * w2);
                rowE[2 * lr] = e1; rowP[2 * lr] = atomicAdd(&lcnt[e1], 1);
                rowE[2 * lr + 1] = e2; rowP[2 * lr + 1] = atomicAdd(&lcnt[e2], 1);
            }
        }
    }
    __syncthreads();
    if (tid < 32) lcnt[tid] = atomicAdd(&cnt[tid * 64], lcnt[tid]);
    __syncthreads();
    for (int i = tid; i < 2 * rows_per_wg; i += NTHR) { const int e = rowE[i]; list[e * 32768 + lcnt[e] + rowP[i]] = (blk * rows_per_wg + (i >> 1)) * 2 + (i & 1); }
    __syncthreads();
    if (tid < 32) lcnt[tid] = 0;
    __syncthreads();
    }
}

DEV void p_final(float* out, const bf16_t* x1b, const bf16_t* ys, const float* g2, const float* b2) {
    const int lane = otid() & 63;
    for (int r = (blockIdx.x * NTHR + otid()) >> 6; r < NTOK; r += gridDim.x * (NTHR / 64)) {
        float x[16]; float s = 0.f;
#pragma unroll
        for (int j = 0; j < 4; ++j) { const int col = j * 256 + lane * 4; const ushort4 tb = *(const ushort4*)(x1b + (size_t)r * 1024 + col); const float4 t = make_float4(bf2f(tb.x), bf2f(tb.y), bf2f(tb.z), bf2f(tb.w));
            const ushort4 a = *(const ushort4*)(ys + (size_t)(2 * r) * 1024 + col), b = *(const ushort4*)(ys + (size_t)(2 * r + 1) * 1024 + col);
            x[4 * j] = ALPHA * t.x + bf2f(a.x) + bf2f(b.x); x[4 * j + 1] = ALPHA * t.y + bf2f(a.y) + bf2f(b.y); x[4 * j + 2] = ALPHA * t.z + bf2f(a.z) + bf2f(b.z); x[4 * j + 3] = ALPHA * t.w + bf2f(a.w) + bf2f(b.w);
            s += (x[4 * j] + x[4 * j + 1]) + (x[4 * j + 2] + x[4 * j + 3]); }
#pragma unroll
        for (int m = 1; m < 64; m <<= 1) s += __shfl_xor(s, m);
        const float mu = s * (1.f / 1024.f); float q = 0.f;
#pragma unroll
        for (int j = 0; j < 16; ++j) { x[j] -= mu; q += x[j] * x[j]; }
#pragma unroll
        for (int m = 1; m < 64; m <<= 1) q += __shfl_xor(q, m);
        const float rstd = rsqrtf(q * (1.f / 1024.f) + LN_EPS);
#pragma unroll
        for (int j = 0; j < 4; ++j) { const int col = j * 256 + lane * 4; const float4 gg = *(const float4*)(g2 + col), bb = *(const float4*)(b2 + col);
            *(float4*)(out + (size_t)r * 1024 + col) = make_float4(x[4 * j] * rstd * gg.x + bb.x, x[4 * j + 1] * rstd * gg.y + bb.y, x[4 * j + 2] * rstd * gg.z + bb.z, x[4 * j + 3] * rstd * gg.w + bb.w); }
    }
}

struct Args { const float* in[24]; float* out; unsigned char* ws; };
__global__ void __launch_bounds__(NTHR, 2) mega_fwd(Args a) {
    extern __shared__ __attribute__((aligned(16))) unsigned char lds_raw[];
    float* ldsf = (float*)lds_raw;
    PG8_LAS unsigned char* ldsl = (PG8_LAS unsigned char*)lds_raw;
    volatile LAS unsigned* MISC = (volatile LAS unsigned*)((LAS unsigned char*)lds_raw + LDS_MISC);
    for (int u = otid(); u < 128; u += NTHR) MISC[u] = 0u;
    __syncthreads();
    unsigned char* ws = a.ws;
    XcdBarrier bar = xcd_barrier_post((unsigned*)(ws + WS_CTL) + CW_BAR, MISC + 8);
#define GRID_BAR() xcd_barrier(bar)
    const float* x = a.in[0]; const float* w_in = a.in[1]; const float* b_merge = a.in[2];
    const float* conv_w = a.in[3]; const float* conv_b = a.in[4];
    const float* w_rg_r = a.in[5]; const float* b_rg_r = a.in[6]; const float* w_rg_i = a.in[7]; const float* b_rg_i = a.in[8];
    const float* lam = a.in[9]; const float* w_ret_o = a.in[10]; const float* w_lru_o = a.in[11]; const float* w_out = a.in[12];
    const float* ln1_g = a.in[13]; const float* ln1_b = a.in[14]; const float* w_group = a.in[15]; const float* b_group = a.in[16];
    const float* w_er = a.in[17]; const float* b_er = a.in[18]; const float* w_eg = a.in[19]; const float* w_eu = a.in[20];
    const float* w_ed = a.in[21]; const float* ln2_g = a.in[22]; const float* ln2_b = a.in[23];
    float* out = a.out;
    int* cnt = (int*)(ws + WS_CTL); float2* rope = (float2*)(ws + WS_ROPE); int2* route_e = (int2*)(ws + WS_ROUTE_E); float2* route_w = (float2*)(ws + WS_ROUTE_W); int* list = (int*)(ws + WS_LIST);
    bf16_t* xb = (bf16_t*)(ws + WS_XB); bf16_t* gl = (bf16_t*)(ws + WS_GL); bf16_t* ulru = (bf16_t*)(ws + WS_ULRU); bf16_t* uconv = (bf16_t*)(ws + WS_UCONV);
    bf16_t* epsb = (bf16_t*)(ws + WS_EPS); bf16_t* inp = (bf16_t*)out;
    bf16_t* q = (bf16_t*)(ws + WS_Q); bf16_t* k = (bf16_t*)(ws + WS_K); bf16_t* v = (bf16_t*)(ws + WS_V); bf16_t* gbuf = (bf16_t*)out;
    bf16_t* P = (bf16_t*)(ws + WS_P); bf16_t* gates = (bf16_t*)(ws + WS_GATES); bf16_t* m1 = (bf16_t*)out; bf16_t* merged = xb;
    bf16_t* w_in_t = (bf16_t*)(ws + WS_WIN_T); bf16_t* w_ro_t = (bf16_t*)(ws + WS_WRO_T); bf16_t* w_lo_t = (bf16_t*)(ws + WS_WLO_T); bf16_t* w_out_t = (bf16_t*)(ws + WS_WOUT_T);
    bf16_t* wrg_t = (bf16_t*)(ws + WS_WRG_T); float* segA = (float*)(ws + WS_SEGA); float* segH = (float*)(ws + WS_SEGH); float* carry = (float*)(ws + WS_CARRY);
    float* rsb = (float*)(ws + WS_RSB);
    unsigned char* wgu8 = ws + WS_WGU_T; unsigned char* wd8 = ws + WS_WD_T; unsigned char* x1q = ws + WS_X1Q;
    bf16_t* x1b = gl; bf16_t* hbuf = (bf16_t*)(ws + WS_H); bf16_t* ys = (bf16_t*)(ws + WS_YSLOT);

    { const int t0_ = otid(); p_rope_table(rope, t0_, NTHR); p_router_table(ln1_g, w_group, w_er, ws + WS_RTAB, t0_, NTHR);
      p_weights(ldsf, w_in, w_ret_o, w_lru_o, w_out, w_rg_r, w_rg_i, w_in_t, w_ro_t, w_lo_t, w_out_t, wrg_t, t0_ >> 6, 8, x, xb); }
    __syncthreads();
    p_router_consts(ldsf, ln1_g, ln1_b, w_group, b_group, w_er, b_er, rsb);
    GRID_BAR();
    { pg8::Gemm g{xb, w_in_t + (size_t)C_U * 1024, NTOK, 3072, 1024}; pg8::StaticOrder S; S.init(NTOK, 3072, (int)gridDim.x, (int)blockIdx.x);
      pg8::gemm_phase<pg8::EpiLruIn, pg8::StaticOrder, true, true>(ldsl, g, S, pg8::EpiLruIn{ulru, gl}); }
    GRID_BAR();
    p_lru_compute(lds_raw, ulru, conv_w, conv_b, wrg_t, b_rg_r, b_rg_i, lam, uconv, epsb, segA, segH);
    GRID_BAR();
    p_lru_carry(ldsf, segA, segH, carry);
    GRID_BAR();
    p_lru_scan(uconv, epsb, gl, carry);
    GRID_BAR();
    { pg8::Gemm g{xb, w_in_t, NTOK, 6144, 1024}; pg8::StaticOrder S; S.init(NTOK, 6144, (int)gridDim.x, (int)blockIdx.x);
      pg8::gemm_phase<pg8::EpiRetIn, pg8::StaticOrder, true, true>(ldsl, g, S, pg8::EpiRetIn{q, k, v, gbuf, (const float*)rope}); }
    GRID_BAR();
    p_scores(lds_raw, q, k, P);
    GRID_BAR();
    p_ret_mfma(lds_raw, q, k, v, P);
    GRID_BAR();
    p_headnorm(v, gbuf);
    { pg8::Gemm g{xb, w_in_t + (size_t)C_GATE * 1024, NTOK, 2048, 1024}; pg8::StaticOrder S; S.init(NTOK, 2048, (int)gridDim.x, (int)blockIdx.x);
      pg8::gemm_phase<pg8::EpiGates, pg8::StaticOrder, true, true>(ldsl, g, S, pg8::EpiGates{b_merge, gates}); }
    GRID_BAR();
    { pg8::Gemm g{v, w_ro_t, NTOK, 1024, 2048}; pg8::StaticOrder S; S.init(NTOK, 1024, (int)gridDim.x, (int)blockIdx.x);
      pg8::gemm_phase<pg8::EpiMerge<0>, pg8::StaticOrder, true, true>(ldsl, g, S, pg8::EpiMerge<0>{gates, nullptr, m1}); }
    GRID_BAR();
    { pg8::Gemm g{gl, w_lo_t, NTOK, 1024, 1536}; pg8::StaticOrder S; S.init(NTOK, 1024, (int)gridDim.x, (int)blockIdx.x);
      pg8::gemm_phase<pg8::EpiMerge<1>, pg8::StaticOrder, true, true>(ldsl, g, S, pg8::EpiMerge<1>{gates, m1, merged}); }
    GRID_BAR();
    { pg8::Gemm g{merged, w_out_t, NTOK, 1024, 1024}; pg8::StaticOrder S; S.init(NTOK, 1024, (int)gridDim.x, (int)blockIdx.x);
      pg8::gemm_phase<pg8::EpiOut, pg8::StaticOrder, true, true>(ldsl, g, S, pg8::EpiOut{x, (bf16_t*)out, ALPHA}); }
    GRID_BAR();
    p_ln1_route(ldsf, (const bf16_t*)out, x1b, x1q, ln1_g, ln1_b, ws + WS_RTAB, route_e, route_w, cnt, list, rsb);
    p_expert_weights(ldsf, w_eg, w_eu, w_ed, wgu8, wd8);
    GRID_BAR();
    {
        PG8_LAS pg8::MoeTab* tab = (PG8_LAS pg8::MoeTab*)(ldsl + LDS_TAB);
        pg8::moe_build_tab(tab, cnt);
        const int T = tab->tileStart[32];
        { pg8::Gemm g{(const bf16_t*)x1q, (const bf16_t*)wgu8, T * 256, 32 * 1024, 512}; pg8::MoeOrder<true> S{T * 4, (int)gridDim.x, (int)blockIdx.x, tab, list};
          pg8::gemm_phase<pg8::EpiSwiGLU8, pg8::MoeOrder<true>, true, true, true>(ldsl, g, S, pg8::EpiSwiGLU8{(unsigned char*)hbuf}); }
        GRID_BAR();
        { pg8::Gemm g{hbuf, (const bf16_t*)wd8, T * 256, 32 * 1024, 256}; pg8::MoeOrder<false> S{T * 4, (int)gridDim.x, (int)blockIdx.x, tab, list};
          pg8::gemm_phase<pg8::EpiMoeOut8, pg8::MoeOrder<false>, true, true, true>(ldsl, g, S, pg8::EpiMoeOut8{tab, list, (const float*)route_w, ys}); }
    }
    GRID_BAR();
    p_final(out, x1b, ys, ln2_g, ln2_b);
}

extern "C" void kernel_launch(void* const* d_in, const int* in_sizes, int n_in, void* d_out, int out_size, void* d_ws, size_t ws_size, hipStream_t stream) {
    static int grid = 0;
    if (grid == 0) {
        if (n_in != 24 || in_sizes[0] != NTOK * DM || out_size != NTOK * DM || ws_size < WS_END) {
            fprintf(stderr, "kernel_launch: unexpected shapes (n_in %d, in0 %d, out %d, ws %zu)\n", n_in, n_in > 0 ? in_sizes[0] : -1, out_size, ws_size); grid = -1; return; }
        int dev = 0, cus = 0, per_cu = 0;
        if (hipGetDevice(&dev) != hipSuccess || hipDeviceGetAttribute(&cus, hipDeviceAttributeMultiprocessorCount, dev) != hipSuccess) { fprintf(stderr, "kernel_launch: device query failed\n"); grid = -1; return; }
        if (hipFuncSetAttribute((const void*)mega_fwd, hipFuncAttributeMaxDynamicSharedMemorySize, LDS_BYTES) != hipSuccess) { fprintf(stderr, "kernel_launch: hipFuncSetAttribute failed\n"); grid = -1; return; }
        if (hipOccupancyMaxActiveBlocksPerMultiprocessor(&per_cu, (const void*)mega_fwd, NTHR, LDS_BYTES) != hipSuccess || per_cu < 1) {
            fprintf(stderr, "kernel_launch: occupancy query reports %d workgroups per CU\n", per_cu); (void)hipGetLastError(); grid = -1; return; }
        grid = cus;
    }
    if (grid < 0) return;
    if (hipMemsetAsync((char*)d_ws + WS_CTL, 0, CTL_ZERO_BYTES, stream) != hipSuccess) { fprintf(stderr, "kernel_launch: memset failed\n"); return; }
    Args a{};
    for (int i = 0; i < 24; ++i) a.in[i] = (const float*)d_in[i];
    a.out = (float*)d_out; a.ws = (unsigned char*)d_ws;
    hipLaunchKernelGGL(mega_fwd, dim3(grid), dim3(NTHR), LDS_BYTES, stream, a);
    const hipError_t le = hipPeekAtLastError();
    if (le != hipSuccess) fprintf(stderr, "kernel_launch: launch failed: %s\n", hipGetErrorName(le));
}
```

```cpp
#include <hip/hip_runtime.h>
#include <cstdio>
#include <cstdint>

typedef unsigned short bf16_t;
#define DEV __device__ __forceinline__
#define LAS __attribute__((address_space(3)))

DEV int otid() { int t = threadIdx.x; asm volatile("" : "+v"(t)); return t; }
DEV float bf2f(bf16_t h) { return __uint_as_float(((unsigned)h) << 16); }
typedef short bf16x8_t __attribute__((ext_vector_type(8)));
typedef unsigned u32x4_t __attribute__((ext_vector_type(4)));
DEV bf16_t f2bf(float f) { unsigned u = __float_as_uint(f); return (bf16_t)((u + 0x7fffu + ((u >> 16) & 1u)) >> 16); }

constexpr int NTHR = 512;
constexpr int NTOK = 32768, DM = 1024, SEQ = 8192;
constexpr int WIN_N = 11264;
constexpr int C_Q = 0, C_K = 1024, C_V = 2048, C_G = 4096, C_U = 6144, C_GL = 7680, C_GATE = 9216;
constexpr float ALPHA = 1.189207115002721f;
constexpr float LN_EPS = 1e-5f;
constexpr size_t MiB = 1u << 20;
constexpr size_t WS_CTL = 0;
constexpr size_t CTL_ZERO_BYTES = 1 * MiB;
constexpr int CW_BAR = 4096;
constexpr size_t WS_ROPE = 1 * MiB;
constexpr size_t WS_ROUTE_E = 9 * MiB;
constexpr size_t WS_ROUTE_W = 9 * MiB + 512 * 1024;
constexpr size_t WS_LIST = 10 * MiB;
constexpr size_t WS_WRG_T = 14 * MiB;
constexpr size_t WS_RSB = 15 * MiB + 512 * 1024;
constexpr size_t WS_RTAB = 22 * MiB;
constexpr size_t WS_SEGA = 16 * MiB;
constexpr size_t WS_SEGH = 18 * MiB;
constexpr size_t WS_CARRY = 20 * MiB;
constexpr size_t WS_XB = 32 * MiB;
constexpr size_t WS_GL = 96 * MiB;
constexpr size_t WS_ULRU = 192 * MiB;
constexpr size_t WS_Q = 192 * MiB;
constexpr size_t WS_K = 256 * MiB;
constexpr size_t WS_GATES = 192 * MiB;
constexpr size_t WS_UCONV = 288 * MiB;
constexpr size_t WS_P = 320 * MiB;
constexpr size_t WS_V = 352 * MiB;
constexpr size_t WS_EPS = 384 * MiB;
constexpr size_t WS_H = 192 * MiB;
constexpr size_t WS_YSLOT = 264 * MiB;
constexpr size_t WS_WGU_T = 352 * MiB;
constexpr size_t WS_WD_T = 416 * MiB;
constexpr size_t WS_X1Q = 160 * MiB;
constexpr int LDS_TAB = 131072;
constexpr size_t WS_WIN_T = 480 * MiB;
constexpr size_t WS_WRO_T = 502 * MiB;
constexpr size_t WS_WLO_T = 506 * MiB;
constexpr size_t WS_WOUT_T = 509 * MiB;
constexpr size_t WS_END = 512 * MiB;
constexpr int LDS_BYTES = 163840;
constexpr int LDS_MISC = 163840 - 512;

#define XB_TMO      128
#define XB_XCNT(j)  (256  + 64 * (j))
#define XB_XSUB(j)  (1280 + 64 * (j))
#define XB_XGEN(j)  (2304 + 64 * (j))
#define XB_TOP      3328
#define XB_TOPGEN   3392
#define XCD_BAR_WORDS 3456
#define XB_SPIN_CAP (1u << 22)
DEV unsigned xb_ld(unsigned* p)              { return __hip_atomic_load(p, __ATOMIC_RELAXED, __HIP_MEMORY_SCOPE_AGENT); }
DEV unsigned xb_add(unsigned* p, unsigned v) { return __hip_atomic_fetch_add(p, v, __ATOMIC_RELAXED, __HIP_MEMORY_SCOPE_AGENT); }
DEV unsigned xb_xcc_id() { return (unsigned)__builtin_amdgcn_s_getreg((3 << 11) | 20) & 0xFu; }
#define XB_SPIN(cond, bar) do { unsigned _sp = 0; while (cond) { __builtin_amdgcn_s_sleep(1); \
    if ((++_sp & 255u) == 0u) { if (xb_ld(&(bar)[XB_TMO])) break; if (_sp > XB_SPIN_CAP) { atomicAdd(&(bar)[XB_TMO], 1u); break; } } } } while (0)
struct XcdBarrier { unsigned* bar; unsigned x; volatile LAS unsigned* st; };
DEV XcdBarrier xcd_barrier_post(unsigned* bar, volatile LAS unsigned* st) {
    XcdBarrier b; b.bar = bar; b.x = xb_xcc_id(); b.st = st;
    if (otid() == 0) (void)xb_add(&bar[XB_XCNT(b.x)], 1u);
    return b;
}
DEV void xcd_barrier_complete(unsigned* bar, unsigned x, unsigned& nloc, unsigned& nx) {
    const unsigned G = gridDim.x * gridDim.y * gridDim.z;
    unsigned sum, cnt, mine, sp = 0u;
    for (;;) {
        sum = 0u; cnt = 0u; mine = 0u;
#pragma unroll
        for (unsigned j = 0; j < 16; ++j) { const unsigned c = xb_ld(&bar[XB_XCNT(j)]); sum += c; cnt += (c > 0u) ? 1u : 0u; mine = (j == x) ? c : mine; }
        if (sum == G) break;
        __builtin_amdgcn_s_sleep(1);
        if ((++sp & 255u) == 0u) { if (xb_ld(&bar[XB_TMO])) break; if (sp > XB_SPIN_CAP) { atomicAdd(&bar[XB_TMO], 1u); break; } }
    }
    nloc = mine > 0u ? mine : 1u; nx = cnt > 0u ? cnt : 1u;
}
DEV void xcd_barrier(const XcdBarrier& b) {
    asm volatile("s_waitcnt vmcnt(0)" ::: "memory");
    __syncthreads();
    if (otid() == 0) {
        unsigned* bar = b.bar;
        __builtin_amdgcn_s_waitcnt(0);
        unsigned nloc = b.st[0], nx = b.st[1];
        if (nloc == 0u) { xcd_barrier_complete(bar, b.x, nloc, nx); b.st[0] = nloc; b.st[1] = nx; }
        const unsigned old = xb_add(&bar[XB_XSUB(b.x)], 1u);
        const unsigned gen = old / nloc;
        if (old + 1u == (gen + 1u) * nloc) {
            __builtin_amdgcn_fence(__ATOMIC_RELEASE, "agent");
            asm volatile("s_waitcnt vmcnt(0)" ::: "memory");
            const unsigned og = xb_add(&bar[XB_TOP], 1u);
            const unsigned tg = og / nx;
            if (og + 1u == (tg + 1u) * nx) xb_add(&bar[XB_TOPGEN], 1u);
            else XB_SPIN(xb_ld(&bar[XB_TOPGEN]) == tg, bar);
            __builtin_amdgcn_fence(__ATOMIC_ACQUIRE, "agent");
            xb_add(&bar[XB_XGEN(b.x)], 1u);
            asm volatile("s_waitcnt vmcnt(0)" ::: "memory");
        } else {
            XB_SPIN(xb_ld(&bar[XB_XGEN(b.x)]) == gen, bar);
            __builtin_amdgcn_fence(__ATOMIC_ACQUIRE, "agent");
            asm volatile("s_waitcnt vmcnt(0)" ::: "memory");
        }
    }
    __syncthreads();
}

namespace pg8 {
#define PG8_LAS __attribute__((address_space(3)))
typedef unsigned short bf16_t;
typedef short bf16x8 __attribute__((ext_vector_type(8)));
typedef float f32x4 __attribute__((ext_vector_type(4)));
typedef unsigned u32x4 __attribute__((ext_vector_type(4)));
constexpr int BM = 256, BK = 64, HALF = 128, HTB = HALF * BK * 2  , STAGE_BYTES = 8 * HTB, NXCD = 8, WGM = 8;

__host__ __device__ __forceinline__ int lds_byte(int r, int c) { const int st = (r >> 4) * 2 + (c >> 5), rr = r & 15, cc = c & 31, ob = rr * 64 + cc * 2; return st * 1024 + (ob ^ (((ob >> 9) & 1) << 5)); }
__host__ __device__ __forceinline__ void stage_rc(int b, int& R, int& C) { const int st = b / 1024, sb = b % 1024, swz = sb ^ (((sb >> 9) & 1) << 5); R = (st >> 1) * 16 + swz / 64; C = (st & 1) * 32 + (swz % 64) / 2; }
__host__ __device__ __forceinline__ int perm32(int rho) { const int n = rho >> 4, i = rho & 15; return 8 * (i >> 2) + 4 * n + (i & 3); }

struct Unit { int pm, pn; };
struct Gemm { const bf16_t* A; const bf16_t* Bt; int M, N, K; };

struct StaticOrder {
    int nM, nN, nwg, G, c;
    __host__ __device__ void init(int M, int N, int G_, int c_) { nM = M / BM; nN = N / BM; nwg = nM * nN; G = G_; c = c_; }
    __host__ __device__ bool next(int i, Unit& u) const {
        const long L = (long)i * G + c; if (L >= nwg) return false;
        int wgid = (int)L; { const int q = nwg / NXCD, r = nwg % NXCD, xcd = wgid % NXCD, off = wgid / NXCD; wgid = (xcd < r ? xcd * (q + 1) : r * (q + 1) + (xcd - r) * q) + off; }
        const int nig = WGM * nN, gid = wgid / nig, fm = gid * WGM, gsz = (nM - fm) < WGM ? (nM - fm) : WGM;
        u.pm = fm + ((wgid % nig) % gsz); u.pn = (wgid % nig) / gsz; return true;
    }
    __device__ __forceinline__ void a_ready(const Unit&) const {}
    __device__ __forceinline__ void done(const Unit&) const {}
    __device__ __forceinline__ const char* a_base(const Gemm& g, const Unit& u) const { return (const char*)g.A + (size_t)u.pm * (size_t)(BM * g.K * 2); }
    __device__ __forceinline__ void a_off(const Gemm& g, const Unit&, const int (&R)[2], const int (&C)[2], unsigned (&v)[2][2]) const {
        _Pragma("unroll") for (int hh = 0; hh < 2; ++hh) _Pragma("unroll") for (int i = 0; i < 2; ++i) v[hh][i] = (unsigned)((hh * HALF + R[i]) * g.K + C[i]) * 2u; }
};
typedef __bf16 bf16x2_t __attribute__((ext_vector_type(2)));
typedef float f32x2_t __attribute__((ext_vector_type(2)));
__device__ __forceinline__ unsigned cvt_pk_bf16(float lo, float hi) { f32x2_t v = {lo, hi}; return __builtin_bit_cast(unsigned, __builtin_convertvector(v, bf16x2_t)); }
typedef int i32x4 __attribute__((ext_vector_type(4)));
typedef int i32x8 __attribute__((ext_vector_type(8)));
template <bool MX8> struct Frag { struct A4 { bf16x8 v[4][2]; }; struct B2 { bf16x8 v[2][2]; }; };
template <> struct Frag<true> { struct A4 { i32x8 v[4]; }; struct B2 { i32x8 v[2]; }; };
__device__ __forceinline__ i32x8 ld32(const PG8_LAS unsigned char* p0, const PG8_LAS unsigned char* p1) { const i32x4 a = *(const PG8_LAS i32x4*)p0, b = *(const PG8_LAS i32x4*)p1; return __builtin_shufflevector(a, b, 0, 1, 2, 3, 4, 5, 6, 7); }
template <class Epi, class Sched, bool ALIGN_EPI = false, bool SP2 = false, bool MX8 = false>
__device__ __forceinline__ void gemm_phase(PG8_LAS unsigned char* lds, const Gemm g, const Sched& S, const Epi& E) {
    int tid_ = otid(); asm volatile("" : "+v"(tid_));
    const int tid = tid_, wid = __builtin_amdgcn_readfirstlane(tid >> 6), lane = tid & 63, wr = wid >> 2, wc = wid & 3, fr = lane & 15, fq = lane >> 4;
    const int K = g.K, nt = K / BK;
    unsigned voffB[2], vA[2][2], vN[2][2]; int sR[2], sC[2];
#pragma unroll
    for (int i = 0; i < 2; ++i) { int R, C; stage_rc(tid * 16 + i * 8192, R, C); const int Rb = Epi::PERM ? ((R & ~31) + perm32(R & 31)) : R;
        sR[i] = R; sC[i] = C; voffB[i] = (unsigned)(Rb * K + C) * 2u; }
    const size_t kstep = (size_t)(BK * 2);
    const size_t hstep = (size_t)HALF * K * 2;
    const size_t tstep = 2 * hstep;
    const unsigned ldsw = (unsigned)wid * 1024u;
    const int aoff = lds_byte(wr * 64 + fr, fq * 8), boff = lds_byte(wc * 32 + fr, fq * 8);
#define PG8_SA(b, h) (((b) * 2 + (h)) * HTB)
#define PG8_SB(b, h) ((4 + (b) * 2 + (h)) * HTB)
#define PG8_STAGE(bufoff, gbase, voff) do { _Pragma("unroll") for (int _i = 0; _i < 2; ++_i) \
        __builtin_amdgcn_global_load_lds((const unsigned*)((const char*)(gbase) + (voff)[_i]), (PG8_LAS unsigned*)(lds + (bufoff) + ldsw + _i * 8192), 16, 0, 0); } while (0)
#define PG8_LDA(dst, b, h) do { if constexpr (MX8) { _Pragma("unroll") for (int m = 0; m < 4; ++m) dst.v[m] = ld32(lds + PG8_SA(b, h) + aoff + m * 2048, lds + PG8_SA(b, h) + aoff + m * 2048 + 1024); } \
        else { _Pragma("unroll") for (int m = 0; m < 4; ++m) _Pragma("unroll") for (int k = 0; k < 2; ++k) dst.v[m][k] = *(const PG8_LAS bf16x8*)(lds + PG8_SA(b, h) + aoff + m * 2048 + k * 1024); } } while (0)
#define PG8_LDB(dst, b, h) do { if constexpr (MX8) { _Pragma("unroll") for (int n = 0; n < 2; ++n) dst.v[n] = ld32(lds + PG8_SB(b, h) + boff + n * 2048, lds + PG8_SB(b, h) + boff + n * 2048 + 1024); } \
        else { _Pragma("unroll") for (int n = 0; n < 2; ++n) _Pragma("unroll") for (int k = 0; k < 2; ++k) dst.v[n][k] = *(const PG8_LAS bf16x8*)(lds + PG8_SB(b, h) + boff + n * 2048 + k * 1024); } } while (0)
#define PG8_MMA(ai, bj, At, Bt) do { __builtin_amdgcn_s_setprio(1); \
        if constexpr (MX8) { _Pragma("unroll") for (int m = 0; m < 4; ++m) _Pragma("unroll") for (int n = 0; n < 2; ++n) \
            { acc[ai][bj][m][n] = __builtin_amdgcn_mfma_scale_f32_16x16x128_f8f6f4(Bt.v[n], At.v[m], acc[ai][bj][m][n], 0, 0, 0, 0x7f7f7f7f, 0, 0x7f7f7f7f); asm volatile("" : "+v"(acc[ai][bj][m][n])); } } \
        else { _Pragma("unroll") for (int m = 0; m < 4; ++m) _Pragma("unroll") for (int n = 0; n < 2; ++n) _Pragma("unroll") for (int k = 0; k < 2; ++k) \
            acc[ai][bj][m][n] = __builtin_amdgcn_mfma_f32_16x16x32_bf16(Bt.v[n][k], At.v[m][k], acc[ai][bj][m][n], 0, 0, 0); } \
        __builtin_amdgcn_s_setprio(0); } while (0)
#define PG8_WAIT_V(n) asm volatile("s_waitcnt vmcnt(" #n ")" ::: "memory")
#define PG8_WAIT_L(n) asm volatile("s_waitcnt lgkmcnt(" #n ")" ::: "memory")
#define PG8_BAR __builtin_amdgcn_s_barrier()
#define PG8_SCHED __builtin_amdgcn_sched_barrier(0)
    Unit cur, nxt; int ui = 0;
    if (!S.next(0, cur)) return;
    f32x4 acc[2][2][4][2];
#pragma unroll
    for (int a = 0; a < 2; ++a)
#pragma unroll
        for (int b = 0; b < 2; ++b)
#pragma unroll
            for (int m = 0; m < 4; ++m)
#pragma unroll
                for (int n = 0; n < 2; ++n) acc[a][b][m][n] = (f32x4){0.f, 0.f, 0.f, 0.f};
    typename Frag<MX8>::A4 At; typename Frag<MX8>::B2 B0, B1;
    const char* cA = S.a_base(g, cur); const char* cB = (const char*)g.Bt + (size_t)cur.pn * tstep;
    S.a_ready(cur); S.a_off(g, cur, sR, sC, vA);
    if constexpr (SP2) {
        PG8_STAGE(PG8_SB(0, 0), cB, voffB); PG8_STAGE(PG8_SB(0, 1), cB + hstep, voffB); PG8_STAGE(PG8_SA(0, 0), cA, vA[0]); PG8_STAGE(PG8_SA(0, 1), cA, vA[1]);
        if (wr == 1) PG8_BAR;
        PG8_WAIT_V(2); PG8_BAR;
        PG8_STAGE(PG8_SB(1, 0), cB + kstep, voffB); PG8_STAGE(PG8_SA(1, 0), cA + kstep, vA[0]); PG8_STAGE(PG8_SB(1, 1), cB + hstep + kstep, voffB);
        PG8_WAIT_V(6); PG8_BAR;
    } else { static_assert(SP2, "only the SP2 K-loop is kept in this file"); }
    for (;;) {
        const bool has_next = S.next(ui + 1, nxt);
        const char* nA = has_next ? S.a_base(g, nxt) : cA; const char* nB = has_next ? (const char*)g.Bt + (size_t)nxt.pn * tstep : cB;
        if (has_next) S.a_off(g, nxt, sR, sC, vN); else { vN[0][0] = vA[0][0]; vN[0][1] = vA[0][1]; vN[1][0] = vA[1][0]; vN[1][1] = vA[1][1]; }
#pragma unroll 1
        for (int t = 0; t < nt; t += 2) {
            const bool last = (t == nt - 2);
            const char* a1 = cA + (size_t)(t + 1) * kstep;
            const char* a2 = last ? nA : cA + (size_t)(t + 2) * kstep; const char* b2 = last ? nB : cB + (size_t)(t + 2) * kstep;
            const char* a3 = a2 + kstep; const char* b3 = b2 + kstep;
            unsigned v2[2][2]; v2[0][0] = last ? vN[0][0] : vA[0][0]; v2[0][1] = last ? vN[0][1] : vA[0][1]; v2[1][0] = last ? vN[1][0] : vA[1][0]; v2[1][1] = last ? vN[1][1] : vA[1][1];
            if (last && has_next) S.a_ready(nxt);
            if constexpr (SP2) {
            PG8_LDB(B0, 0, 0); PG8_LDB(B1, 0, 1); PG8_SCHED; PG8_LDA(At, 0, 0); PG8_STAGE(PG8_SA(1, 1), a1, vA[1]);
            PG8_WAIT_V(8); PG8_WAIT_L(0); PG8_BAR; PG8_MMA(0, 0, At, B0); PG8_MMA(0, 1, At, B1); PG8_BAR; PG8_SCHED;
            PG8_LDA(At, 0, 1); PG8_STAGE(PG8_SB(0, 0), b2, voffB); PG8_STAGE(PG8_SB(0, 1), b2 + hstep, voffB); PG8_STAGE(PG8_SA(0, 0), a2, v2[0]);
            PG8_WAIT_V(8); PG8_WAIT_L(0); PG8_BAR; PG8_MMA(1, 0, At, B0); PG8_MMA(1, 1, At, B1); PG8_BAR; PG8_SCHED;
            PG8_LDB(B0, 1, 0); PG8_LDB(B1, 1, 1); PG8_SCHED; PG8_LDA(At, 1, 0); PG8_STAGE(PG8_SA(0, 1), a2, v2[1]);
            PG8_WAIT_V(8); PG8_WAIT_L(0); PG8_BAR; PG8_MMA(0, 0, At, B0); PG8_MMA(0, 1, At, B1); PG8_BAR; PG8_SCHED;
            PG8_LDA(At, 1, 1); PG8_STAGE(PG8_SB(1, 0), b3, voffB); PG8_STAGE(PG8_SB(1, 1), b3 + hstep, voffB); PG8_STAGE(PG8_SA(1, 0), a3, v2[0]);
            PG8_WAIT_V(8); PG8_WAIT_L(0); PG8_BAR; PG8_MMA(1, 0, At, B0); PG8_MMA(1, 1, At, B1); PG8_BAR; PG8_SCHED;
            }
        }
        if constexpr (ALIGN_EPI) { if (wr == 0) PG8_BAR; }
        if constexpr (!Epi::AFTER_DRAIN) { E(acc, cur, wr, wc, fr, fq); S.done(cur); }
        if (!has_next) break;
#pragma unroll
        for (int a = 0; a < 2; ++a)
#pragma unroll
            for (int b = 0; b < 2; ++b)
#pragma unroll
                for (int m = 0; m < 4; ++m)
#pragma unroll
                    for (int n = 0; n < 2; ++n) acc[a][b][m][n] = (f32x4){0.f, 0.f, 0.f, 0.f};
        cur = nxt; cA = nA; cB = nB; ++ui; vA[0][0] = vN[0][0]; vA[0][1] = vN[0][1]; vA[1][0] = vN[1][0]; vA[1][1] = vN[1][1];
        if constexpr (ALIGN_EPI) { if (wr == 1) PG8_BAR; }
    }
    PG8_WAIT_V(0);
    if constexpr (!ALIGN_EPI) { if (wr == 0) PG8_BAR; }
    PG8_BAR;
    if constexpr (Epi::AFTER_DRAIN) { E.fused(acc, cur, wr, wc, fr, fq, lds, wid, lane); S.done(cur); }
#undef PG8_SA
#undef PG8_SB
#undef PG8_STAGE
#undef PG8_LDA
#undef PG8_LDB
#undef PG8_MMA
#undef PG8_WAIT_V
#undef PG8_WAIT_L
#undef PG8_BAR
#undef PG8_SCHED
}

__device__ __forceinline__ float fsig(float x) { return __builtin_amdgcn_rcpf(1.f + __expf(-x)); }
__device__ __forceinline__ float fsilu(float x) { return x * fsig(x); }
__device__ __forceinline__ float fgelu(float x) { return x * fsig(1.5957691216057308f * (x + 0.044715f * x * x * x)); }
__device__ __forceinline__ u32x4 pack8(const f32x4& v0, const f32x4& v1) { u32x4 w; w.x = cvt_pk_bf16(v0[0], v0[1]); w.y = cvt_pk_bf16(v0[2], v0[3]); w.z = cvt_pk_bf16(v1[0], v1[1]); w.w = cvt_pk_bf16(v1[2], v1[3]); return w; }
__device__ __forceinline__ void unpack8(const u32x4& w, f32x4& v0, f32x4& v1) {
    v0[0] = __uint_as_float(w.x << 16); v0[1] = __uint_as_float(w.x & 0xffff0000u); v0[2] = __uint_as_float(w.y << 16); v0[3] = __uint_as_float(w.y & 0xffff0000u);
    v1[0] = __uint_as_float(w.z << 16); v1[1] = __uint_as_float(w.z & 0xffff0000u); v1[2] = __uint_as_float(w.w << 16); v1[3] = __uint_as_float(w.w & 0xffff0000u); }

struct EpiLruIn {
    static constexpr bool PERM = true, AFTER_DRAIN = false;
    bf16_t* u; bf16_t* gl;
    __device__ __forceinline__ void operator()(const f32x4 (&acc)[2][2][4][2], const Unit& un, int wr, int wc, int fr, int fq) const {
        const int row0 = un.pm * BM + wr * 64 + fr; const bool isg = un.pn >= 6;
        bf16_t* base = (isg ? gl : u) + (isg ? un.pn - 6 : un.pn) * BM + wc * 32 + 8 * fq;
#pragma unroll
        for (int ai = 0; ai < 2; ++ai)
#pragma unroll
            for (int m = 0; m < 4; ++m) { bf16_t* rowp = base + (size_t)(row0 + ai * HALF + m * 16) * 1536;
#pragma unroll
                for (int bj = 0; bj < 2; ++bj) { f32x4 v0 = acc[ai][bj][m][0], v1 = acc[ai][bj][m][1];
                    if (isg) {
#pragma unroll
                        for (int e = 0; e < 4; ++e) { v0[e] = fgelu(v0[e]); v1[e] = fgelu(v1[e]); } }
                    *(u32x4*)(rowp + bj * HALF) = pack8(v0, v1); } }
    }
};
__device__ __forceinline__ float clamp448(float v) { return fminf(fmaxf(v, -448.f), 448.f); }
__device__ __forceinline__ unsigned pk4_fp8(float a, float b, float c, float d) { int p = __builtin_amdgcn_cvt_pk_fp8_f32(clamp448(a), clamp448(b), 0, false); p = __builtin_amdgcn_cvt_pk_fp8_f32(clamp448(c), clamp448(d), p, true); return (unsigned)p; }
struct EpiRetIn {
    static constexpr bool PERM = true, AFTER_DRAIN = false;
    bf16_t* q; bf16_t* k; bf16_t* v; bf16_t* g; const float* rope;
    __device__ __forceinline__ void operator()(const f32x4 (&acc)[2][2][4][2], const Unit& un, int wr, int wc, int fr, int fq) const {
        const int row0 = un.pm * BM + wr * 64 + fr;
        if (un.pn < 8) {
            const bool isk = un.pn >= 4; const int h = un.pn & 3;
            const float lg = __log2f(1.f - __builtin_amdgcn_exp2f(-5.f - (float)h));
            const int jb = wc * 32 + 8 * fq;
            bf16_t* base = (isk ? k : q) + h * 256 + jb;
#pragma unroll
            for (int ai = 0; ai < 2; ++ai)
#pragma unroll
                for (int m = 0; m < 4; ++m) { const int r = row0 + ai * HALF + m * 16, s = r & 8191, n = s & 127;
                    const float sc = isk ? __builtin_amdgcn_exp2f(-(float)n * lg) * 0.0625f : __builtin_amdgcn_exp2f((float)n * lg) * 64.f;
                    const f32x4* tp = (const f32x4*)(rope + ((size_t)s * 128 + jb) * 2);
                    f32x4 o1[2], o2[2];
#pragma unroll
                    for (int nn = 0; nn < 2; ++nn) { const f32x4 ta = tp[2 * nn], tb = tp[2 * nn + 1]; const f32x4 a = acc[ai][0][m][nn], b = acc[ai][1][m][nn];
                        o1[nn][0] = (a[0] * ta[0] - b[0] * ta[1]) * sc; o2[nn][0] = (a[0] * ta[1] + b[0] * ta[0]) * sc;
                        o1[nn][1] = (a[1] * ta[2] - b[1] * ta[3]) * sc; o2[nn][1] = (a[1] * ta[3] + b[1] * ta[2]) * sc;
                        o1[nn][2] = (a[2] * tb[0] - b[2] * tb[1]) * sc; o2[nn][2] = (a[2] * tb[1] + b[2] * tb[0]) * sc;
                        o1[nn][3] = (a[3] * tb[2] - b[3] * tb[3]) * sc; o2[nn][3] = (a[3] * tb[3] + b[3] * tb[2]) * sc; }
                    if (isk) { bf16_t* rowp = base + (size_t)r * 1024; *(u32x4*)(rowp) = pack8(o1[0], o1[1]); *(u32x4*)(rowp + HALF) = pack8(o2[0], o2[1]); }
                    else { unsigned char* qb = (unsigned char*)q + ((size_t)(r >> 7) * 4 + h) * 32768 + (size_t)(((wc >> 1) * 4 + fq) * 128 + n) * 16 + (wc & 1) * 8;
                        uint2 a, b; a.x = pk4_fp8(o1[0][0], o1[0][1], o1[0][2], o1[0][3]); a.y = pk4_fp8(o1[1][0], o1[1][1], o1[1][2], o1[1][3]);
                        b.x = pk4_fp8(o2[0][0], o2[0][1], o2[0][2], o2[0][3]); b.y = pk4_fp8(o2[1][0], o2[1][1], o2[1][2], o2[1][3]);
                        *(uint2*)qb = a; *(uint2*)(qb + 16384) = b; }
                    asm volatile("" ::: "memory"); }
        } else {
            const bool isg = un.pn >= 16;
            bf16_t* base = (isg ? g : v) + ((un.pn - 8) & 7) * BM + wc * 32 + 8 * fq;
#pragma unroll
            for (int ai = 0; ai < 2; ++ai)
#pragma unroll
                for (int m = 0; m < 4; ++m) { bf16_t* rowp = base + (size_t)(row0 + ai * HALF + m * 16) * 2048;
#pragma unroll
                    for (int bj = 0; bj < 2; ++bj) { f32x4 v0 = acc[ai][bj][m][0], v1 = acc[ai][bj][m][1];
                        if (isg) {
#pragma unroll
                            for (int e = 0; e < 4; ++e) { v0[e] = fsilu(v0[e]); v1[e] = fsilu(v1[e]); } }
                        *(u32x4*)(rowp + bj * HALF) = pack8(v0, v1); } }
        }
    }
};
struct EpiGates {
    static constexpr bool PERM = true, AFTER_DRAIN = false;
    const float* bm; bf16_t* gates;
    __device__ __forceinline__ void operator()(const f32x4 (&acc)[2][2][4][2], const Unit& un, int wr, int wc, int fr, int fq) const {
        const int row0 = un.pm * BM + wr * 64 + fr, col0 = un.pn * BM + wc * 32 + 8 * fq;
        f32x4 bv[2][2];
#pragma unroll
        for (int bj = 0; bj < 2; ++bj)
#pragma unroll
            for (int n = 0; n < 2; ++n) bv[bj][n] = *(const f32x4*)(bm + col0 + bj * HALF + 4 * n);
#pragma unroll
        for (int ai = 0; ai < 2; ++ai)
#pragma unroll
            for (int m = 0; m < 4; ++m) { bf16_t* rowp = gates + (size_t)(row0 + ai * HALF + m * 16) * 2048 + col0;
#pragma unroll
                for (int bj = 0; bj < 2; ++bj) { f32x4 v0 = acc[ai][bj][m][0] + bv[bj][0], v1 = acc[ai][bj][m][1] + bv[bj][1];
#pragma unroll
                    for (int e = 0; e < 4; ++e) { v0[e] = fsig(v0[e]); v1[e] = fsig(v1[e]); }
                    *(u32x4*)(rowp + bj * HALF) = pack8(v0, v1); } }
    }
};
template <int MODE> struct EpiMerge {
    static constexpr bool PERM = true, AFTER_DRAIN = false;
    const bf16_t* gates; const bf16_t* m1in; bf16_t* o;
    __device__ __forceinline__ void operator()(const f32x4 (&acc)[2][2][4][2], const Unit& un, int wr, int wc, int fr, int fq) const {
        const int row0 = un.pm * BM + wr * 64 + fr, col0 = un.pn * BM + wc * 32 + 8 * fq;
#pragma unroll
        for (int ai = 0; ai < 2; ++ai)
#pragma unroll
            for (int m = 0; m < 4; ++m) { const size_t r = (size_t)(row0 + ai * HALF + m * 16);
#pragma unroll
                for (int bj = 0; bj < 2; ++bj) { const int c = col0 + bj * HALF;
                    f32x4 g0, g1; unpack8(*(const u32x4*)(gates + r * 2048 + MODE * 1024 + c), g0, g1);
                    f32x4 v0 = acc[ai][bj][m][0] * g0, v1 = acc[ai][bj][m][1] * g1;
                    if (MODE == 1) { f32x4 p0, p1; unpack8(*(const u32x4*)(m1in + r * 1024 + c), p0, p1); v0 += p0; v1 += p1; }
                    *(u32x4*)(o + r * 1024 + c) = pack8(v0, v1); } }
    }
};
struct EpiOut {
    static constexpr bool PERM = true, AFTER_DRAIN = false;
    const float* x; bf16_t* y; float alpha;
    __device__ __forceinline__ void operator()(const f32x4 (&acc)[2][2][4][2], const Unit& un, int wr, int wc, int fr, int fq) const {
        const int row0 = un.pm * BM + wr * 64 + fr, col0 = un.pn * BM + wc * 32 + 8 * fq;
#pragma unroll
        for (int ai = 0; ai < 2; ++ai)
#pragma unroll
            for (int m = 0; m < 4; ++m) { const size_t off = (size_t)(row0 + ai * HALF + m * 16) * 1024 + col0;
#pragma unroll
                for (int bj = 0; bj < 2; ++bj) { const f32x4 x0 = *(const f32x4*)(x + off + bj * HALF), x1 = *(const f32x4*)(x + off + bj * HALF + 4);
                    *(u32x4*)(y + off + bj * HALF) = pack8(x0 * alpha + acc[ai][bj][m][0], x1 * alpha + acc[ai][bj][m][1]); } }
    }
};
struct MoeTab { int tileStart[33]; int cnt[32]; int pad_[3]; int tileExp[320]; };
__device__ __forceinline__ void moe_build_tab(PG8_LAS MoeTab* tab, const int* cnt) {
    if (otid() == 0) { int t = 0; for (int e = 0; e < 32; ++e) { const int c = cnt[e * 64], nt = (c + 255) >> 8; tab->tileStart[e] = t; tab->cnt[e] = c; for (int i = 0; i < nt; ++i) tab->tileExp[t + i] = e; t += nt; } tab->tileStart[32] = t; }
    __syncthreads();
}
template <bool GATHER> struct MoeOrder {
    int U, G, c; const PG8_LAS MoeTab* tab; const int* list;
    __device__ __forceinline__ bool next(int i, Unit& u) const {
        const long L = (long)i * G + c; if (L >= U) return false;
        int wgid = (int)L; { const int q = U / NXCD, r = U % NXCD, xcd = wgid % NXCD, off = wgid / NXCD; wgid = (xcd < r ? xcd * (q + 1) : r * (q + 1) + (xcd - r) * q) + off; }
        u.pm = wgid >> 2; u.pn = tab->tileExp[u.pm] * 4 + (wgid & 3); return true;
    }
    __device__ __forceinline__ void a_ready(const Unit&) const {}
    __device__ __forceinline__ void done(const Unit&) const {}
    __device__ __forceinline__ const char* a_base(const Gemm& g, const Unit& u) const { return GATHER ? (const char*)g.A : (const char*)g.A + (size_t)u.pm * (size_t)(BM * g.K * 2); }
    __device__ __forceinline__ void a_off(const Gemm& g, const Unit& u, const int (&R)[2], const int (&C)[2], unsigned (&v)[2][2]) const {
        if (!GATHER) { _Pragma("unroll") for (int hh = 0; hh < 2; ++hh) _Pragma("unroll") for (int i = 0; i < 2; ++i) v[hh][i] = (unsigned)((hh * HALF + R[i]) * g.K + C[i]) * 2u; }
        else { const int e = u.pn >> 2, base = (u.pm - tab->tileStart[e]) * BM, ce = tab->cnt[e];
            _Pragma("unroll") for (int hh = 0; hh < 2; ++hh) _Pragma("unroll") for (int i = 0; i < 2; ++i) { const int lr = base + hh * HALF + R[i]; const int tok = (lr < ce) ? (list[e * 32768 + lr] >> 1) : 0; v[hh][i] = (unsigned)(tok * g.K + C[i]) * 2u; } }
    }
};
struct EpiSwiGLU {
    static constexpr bool PERM = true, AFTER_DRAIN = false;
    bf16_t* h;
    __device__ __forceinline__ void operator()(const f32x4 (&acc)[2][2][4][2], const Unit& un, int wr, int wc, int fr, int fq) const {
        const int row0 = un.pm * BM + wr * 64 + fr, col0 = (un.pn & 3) * 128 + wc * 32 + 8 * fq;
#pragma unroll
        for (int ai = 0; ai < 2; ++ai)
#pragma unroll
            for (int m = 0; m < 4; ++m) { f32x4 v0, v1;
#pragma unroll
                for (int e = 0; e < 4; ++e) { v0[e] = fsilu(acc[ai][0][m][0][e]) * acc[ai][1][m][0][e]; v1[e] = fsilu(acc[ai][0][m][1][e]) * acc[ai][1][m][1][e]; }
                *(u32x4*)(h + (size_t)(row0 + ai * HALF + m * 16) * 512 + col0) = pack8(v0, v1); }
    }
};
struct EpiMoeOut {
    static constexpr bool PERM = true, AFTER_DRAIN = false;
    const PG8_LAS MoeTab* tab; const int* list; const float* rw; bf16_t* ys;
    __device__ __forceinline__ void operator()(const f32x4 (&acc)[2][2][4][2], const Unit& un, int wr, int wc, int fr, int fq) const {
        const int e = un.pn >> 2, lrow0 = (un.pm - tab->tileStart[e]) * BM + wr * 64 + fr, ce = tab->cnt[e], col0 = (un.pn & 3) * BM + wc * 32 + 8 * fq;
        int slot[8]; float wgt[8];
#pragma unroll
        for (int i = 0; i < 8; ++i) { const int lr = lrow0 + (i >> 2) * HALF + (i & 3) * 16; slot[i] = (lr < ce) ? list[e * 32768 + lr] : -1; }
#pragma unroll
        for (int i = 0; i < 8; ++i) wgt[i] = (slot[i] >= 0) ? rw[slot[i]] : 0.f;
#pragma unroll
        for (int ai = 0; ai < 2; ++ai)
#pragma unroll
            for (int m = 0; m < 4; ++m) { const int i = ai * 4 + m;
                if (slot[i] >= 0) { const float w = wgt[i]; bf16_t* rowp = ys + (size_t)slot[i] * 1024 + col0;
#pragma unroll
                    for (int bj = 0; bj < 2; ++bj) *(u32x4*)(rowp + bj * HALF) = pack8(acc[ai][bj][m][0] * w, acc[ai][bj][m][1] * w); } }
    }
};

constexpr float FP8_SX = 4.f, FP8_SW = 64.f, FP8_SH = 8.f;
struct EpiSwiGLU8 {
    static constexpr bool PERM = true, AFTER_DRAIN = false;
    unsigned char* h;
    __device__ __forceinline__ void operator()(const f32x4 (&acc)[2][2][4][2], const Unit& un, int wr, int wc, int fr, int fq) const {
        const int row0 = un.pm * BM + wr * 64 + fr, col0 = (un.pn & 3) * 128 + wc * 32 + 8 * fq; const float ds = 1.f / (FP8_SX * FP8_SW);
#pragma unroll
        for (int ai = 0; ai < 2; ++ai)
#pragma unroll
            for (int m = 0; m < 4; ++m) { float v[8];
#pragma unroll
                for (int e = 0; e < 4; ++e) { v[e] = FP8_SH * fsilu(acc[ai][0][m][0][e] * ds) * (acc[ai][1][m][0][e] * ds); v[4 + e] = FP8_SH * fsilu(acc[ai][0][m][1][e] * ds) * (acc[ai][1][m][1][e] * ds); }
                uint2 o; o.x = pk4_fp8(v[0], v[1], v[2], v[3]); o.y = pk4_fp8(v[4], v[5], v[6], v[7]);
                *(uint2*)(h + (size_t)(row0 + ai * HALF + m * 16) * 512 + col0) = o; }
    }
};
struct EpiMoeOut8 {
    static constexpr bool PERM = true, AFTER_DRAIN = false;
    const PG8_LAS MoeTab* tab; const int* list; const float* rw; bf16_t* ys;
    __device__ __forceinline__ void operator()(const f32x4 (&acc)[2][2][4][2], const Unit& un, int wr, int wc, int fr, int fq) const {
        const int e = un.pn >> 2, lrow0 = (un.pm - tab->tileStart[e]) * BM + wr * 64 + fr, ce = tab->cnt[e], col0 = (un.pn & 3) * BM + wc * 32 + 8 * fq;
#pragma unroll
        for (int ai = 0; ai < 2; ++ai)
#pragma unroll
            for (int m = 0; m < 4; ++m) { const int lr = lrow0 + ai * HALF + m * 16;
                if (lr < ce) { const int slot = list[e * 32768 + lr]; const float w = rw[slot] * (1.f / (FP8_SH * FP8_SW)); bf16_t* rowp = ys + (size_t)slot * 1024 + col0;
#pragma unroll
                    for (int bj = 0; bj < 2; ++bj) *(u32x4*)(rowp + bj * HALF) = pack8(acc[ai][bj][m][0] * w, acc[ai][bj][m][1] * w); }
                asm volatile("" ::: "memory"); }
    }
};
}

DEV unsigned pk2(float lo, float hi) { return (unsigned)f2bf(lo) | ((unsigned)f2bf(hi) << 16); }
typedef unsigned v4u __attribute__((ext_vector_type(4)));
DEV void tr_load(const float* W, int N, int item, int lane, float (&wv)[32]) {
    const int nblk = N / 32, kb = item / nblk, nb = item % nblk, k0 = 64 * kb, n0 = 32 * nb;
#pragma unroll
    for (int i = 0; i < 32; ++i) wv[i] = W[(size_t)(k0 + 2 * i + (lane >> 5)) * N + n0 + (lane & 31)];
}
DEV void tr_store(const float (&wv)[32], int K, int N, bf16_t* WT, float* scr, int item, int lane, bool gatefrag) {
    const int nblk = N / 32, kb = item / nblk, nb = item % nblk, k0 = 64 * kb, n0 = 32 * nb;
#pragma unroll
    for (int i = 0; i < 32; ++i) scr[(2 * i + (lane >> 5)) * 33 + (lane & 31)] = wv[i];
    asm volatile("s_waitcnt lgkmcnt(0)" ::: "memory");
    const int c = lane & 7;
#pragma unroll
    for (int j = 0; j < 4; ++j) { const int n = (lane >> 3) + 8 * j; const float* s = scr + (8 * c) * 33 + n;
        v4u o; o.x = pk2(s[0 * 33], s[1 * 33]); o.y = pk2(s[2 * 33], s[3 * 33]); o.z = pk2(s[4 * 33], s[5 * 33]); o.w = pk2(s[6 * 33], s[7 * 33]);
        const int oc = n0 + n, kk = k0 + 8 * c;
        const size_t off = gatefrag ? (size_t)((((oc / 48) * 3 + (oc % 48) / 16) * 6 + (kk >> 5)) * 64 + ((kk >> 3) & 3) * 16 + (oc & 15)) * 8 : (size_t)oc * K + kk;
        *(v4u*)(WT + off) = o; }
    asm volatile("s_waitcnt lgkmcnt(0)" ::: "memory");
}
DEV void tr_store_fp8(const float (&wv)[32], int K, int N, unsigned char* WT, int row_off, float scale, float* scr, int item, int lane) {
    const int nblk = N / 32, kb = item / nblk, nb = item % nblk, k0 = 64 * kb, n0 = 32 * nb;
#pragma unroll
    for (int i = 0; i < 32; ++i) scr[(2 * i + (lane >> 5)) * 33 + (lane & 31)] = wv[i] * scale;
    asm volatile("s_waitcnt lgkmcnt(0)" ::: "memory");
    const int c = lane & 3;
#pragma unroll
    for (int j = 0; j < 2; ++j) { const int n = (lane >> 2) + 16 * j; const float* s = scr + (16 * c) * 33 + n;
        v4u o; o.x = pg8::pk4_fp8(s[0 * 33], s[1 * 33], s[2 * 33], s[3 * 33]); o.y = pg8::pk4_fp8(s[4 * 33], s[5 * 33], s[6 * 33], s[7 * 33]);
        o.z = pg8::pk4_fp8(s[8 * 33], s[9 * 33], s[10 * 33], s[11 * 33]); o.w = pg8::pk4_fp8(s[12 * 33], s[13 * 33], s[14 * 33], s[15 * 33]);
        *(v4u*)(WT + (size_t)(row_off + n0 + n) * K + k0 + 16 * c) = o; }
    asm volatile("s_waitcnt lgkmcnt(0)" ::: "memory");
}
DEV void p_weights(float* lds, const float* w_in, const float* w_ret_o, const float* w_lru_o, const float* w_out, const float* w_rg_r, const float* w_rg_i, bf16_t* w_in_t, bf16_t* w_ro_t, bf16_t* w_lo_t, bf16_t* w_out_t, bf16_t* wrg_t, int wave, int nwaves, const float* x, bf16_t* xb) {
    const int lane = otid() & 63;
    float* scr = lds + wave * 2304;
    constexpr int I0 = 16 * (WIN_N / 32), I1 = 32 * 32, I2 = 24 * 32, I3 = 16 * 32, I4 = 16 * 18, NIT = I0 + I1 + I2 + I3 + I4;
#define PW_DECODE(it_, W_, WT_, K_, N_, sub_, gf_) const float* W_; bf16_t* WT_; int K_, N_, sub_; bool gf_ = false; { int r_ = (it_); \
        if (r_ < I0) { W_ = w_in; WT_ = w_in_t; K_ = 1024; N_ = WIN_N; sub_ = r_; } \
        else if ((r_ -= I0) < I1) { W_ = w_ret_o; WT_ = w_ro_t; K_ = 2048; N_ = 1024; sub_ = r_; } \
        else if ((r_ -= I1) < I2) { W_ = w_lru_o; WT_ = w_lo_t; K_ = 1536; N_ = 1024; sub_ = r_; } \
        else if ((r_ -= I2) < I3) { W_ = w_out; WT_ = w_out_t; K_ = 1024; N_ = 1024; sub_ = r_; } \
        else { r_ -= I3; const int mi_ = r_ / 18; W_ = (mi_ < 8 ? w_rg_r + (size_t)mi_ * 192 * 192 : w_rg_i + (size_t)(mi_ - 8) * 192 * 192); WT_ = wrg_t + (size_t)mi_ * 192 * 192; K_ = 192; N_ = 192; sub_ = r_ - mi_ * 18; gf_ = true; } }
    const int step = gridDim.x * nwaves;
    int it = blockIdx.x * nwaves + wave;
    float wv[32], wn[32];
    const size_t n4 = (size_t)NTOK * DM / 4, cstride = (size_t)gridDim.x * NTHR;
    size_t ci = (size_t)blockIdx.x * NTHR + wave * 64 + lane;
    if (it < NIT) { PW_DECODE(it, W0, T0, K0, N0, s0, g0); (void)T0; (void)K0; (void)g0; tr_load(W0, N0, s0, lane, wv); }
    for (; it < NIT || ci < n4; it += step) {
        const int nx = it + step;
        if (nx < NIT) { PW_DECODE(nx, W1, T1, K1, N1, s1, g1); (void)T1; (void)K1; (void)g1; tr_load(W1, N1, s1, lane, wn); }
        if (ci < n4) {
            float4 t[16];
#pragma unroll
            for (int u = 0; u < 16; ++u) { const size_t i = ci + u * cstride; t[u] = (i < n4) ? ((const float4*)x)[i] : make_float4(0.f, 0.f, 0.f, 0.f); }
#pragma unroll
            for (int u = 0; u < 16; ++u) { const size_t i = ci + u * cstride; if (i < n4) { uint2 o; o.x = pg8::cvt_pk_bf16(t[u].x, t[u].y); o.y = pg8::cvt_pk_bf16(t[u].z, t[u].w); ((uint2*)xb)[i] = o; } }
            ci += 16 * cstride;
        }
        if (it < NIT) { PW_DECODE(it, W2, T2, K2, N2, s2, g2); (void)W2; tr_store(wv, K2, N2, T2, scr, s2, lane, g2); }
#pragma unroll
        for (int i = 0; i < 32; ++i) wv[i] = wn[i];
    }
#undef PW_DECODE
}
DEV void p_expert_weights(float* lds, const float* w_eg, const float* w_eu, const float* w_ed, unsigned char* wgu8, unsigned char* wd8) {
    const int wave = otid() >> 6, lane = otid() & 63;
    float* scr = lds + wave * 2304;
#define EW_SRC(it_) ((((it_) >> 13) == 0 ? w_eg : ((it_) >> 13) == 1 ? w_eu : w_ed) + (size_t)(((it_) & 8191) >> 8) * 1024 * 512)
    const int step = gridDim.x * 8;
    int it = blockIdx.x * 8 + wave;
    float wv[32], wn[32];
    if (it < 3 * 8192) tr_load(EW_SRC(it), (it >> 13) < 2 ? 512 : 1024, it & 255, lane, wv);
    for (; it < 3 * 8192; it += step) {
        const int nx = it + step;
        if (nx < 3 * 8192) tr_load(EW_SRC(nx), (nx >> 13) < 2 ? 512 : 1024, nx & 255, lane, wn);
        const int kind = it >> 13, e = (it & 8191) >> 8, sub = it & 255;
        if (kind < 2) { const int nb = sub & 15; tr_store_fp8(wv, 1024, 512, wgu8 + (size_t)e * 1024 * 1024, (nb >> 2) * 128 + kind * 128, pg8::FP8_SW, scr, sub, lane); }
        else tr_store_fp8(wv, 512, 1024, wd8 + (size_t)e * 1024 * 512, 0, pg8::FP8_SW, scr, sub, lane);
#pragma unroll
        for (int i = 0; i < 32; ++i) wv[i] = wn[i];
    }
#undef EW_SRC
}

DEV void p_router_table(const float* g1, const float* wg, const float* we, unsigned char* rtab, int tg, int nthr) {
    for (int p = (gridDim.x - 1 - blockIdx.x) * nthr + tg; p < 9216; p += gridDim.x * nthr) {
        int T, part, kq, stride; const float* srcp;
        if (p < 8192) { const int col = p & 15, nt = (p >> 6) & 1; kq = (p >> 4) & 3; part = (p >> 7) & 1; T = p >> 8; srcp = we + 16 * nt + col; stride = 32; }
        else { const int p2 = p - 8192, col = p2 & 3; kq = (p2 >> 2) & 3; part = (p2 >> 4) & 1; T = p2 >> 5; srcp = wg + col; stride = 4; }
        const int k0 = 32 * T + 8 * kq;
        unsigned o[4];
#pragma unroll
        for (int j2 = 0; j2 < 4; ++j2) { unsigned pr = 0;
#pragma unroll
            for (int e = 0; e < 2; ++e) { const int kk = k0 + 2 * j2 + e; const float wv_ = g1[kk] * srcp[(size_t)kk * stride];
                const bf16_t hi = f2bf(wv_); const bf16_t val = part ? f2bf(wv_ - bf2f(hi)) : hi; pr |= (unsigned)val << (16 * e); }
            o[j2] = pr; }
        *(u32x4_t*)(rtab + (size_t)p * 16) = (u32x4_t){o[0], o[1], o[2], o[3]};
    }
}
DEV void p_router_consts(float* lds, const float* g1, const float* b1, const float* wg, const float* bg, const float* we, const float* be, float* sb) {
    const int t = otid(), wv = t >> 6, lane = t & 63;
    for (int c = (int)blockIdx.x - 64; c < 36; c += gridDim.x) {
        if (c < 0) continue;
        float s = 0.f, q = 0.f;
#pragma unroll
        for (int kk = 0; kk < 2; ++kk) { const int k = t + 512 * kk; const float w = (c < 32) ? we[(size_t)k * 32 + c] : wg[(size_t)k * 4 + c - 32]; s += g1[k] * w; q += b1[k] * w; }
#pragma unroll
        for (int m = 1; m < 64; m <<= 1) { s += __shfl_xor(s, m); q += __shfl_xor(q, m); }
        if (lane == 0) { lds[wv * 2] = s; lds[wv * 2 + 1] = q; }
        __syncthreads();
        if (t == 0) { float S = 0.f, B = 0.f;
            for (int p = 0; p < 8; ++p) { S += lds[p * 2]; B += lds[p * 2 + 1]; }
            sb[c] = S; sb[48 + c] = B + ((c < 32) ? be[c] : bg[c - 32]);
            if (c == 0) { for (int z = 36; z < 48; ++z) { sb[z] = 0.f; sb[48 + z] = 0.f; } } }
        __syncthreads();
    }
}
DEV void p_cvt_x(const float* x, bf16_t* xb, int tg, int nthr) {
    const size_t n4 = (size_t)NTOK * DM / 4, stride = (size_t)gridDim.x * nthr;
    for (size_t i0 = (size_t)blockIdx.x * nthr + tg; i0 < n4; i0 += 16 * stride) {
        float4 t[16];
#pragma unroll
        for (int u = 0; u < 16; ++u) { const size_t i = i0 + u * stride; t[u] = (i < n4) ? ((const float4*)x)[i] : make_float4(0.f, 0.f, 0.f, 0.f); }
#pragma unroll
        for (int u = 0; u < 16; ++u) { const size_t i = i0 + u * stride; if (i < n4) { uint2 o; o.x = pg8::cvt_pk_bf16(t[u].x, t[u].y); o.y = pg8::cvt_pk_bf16(t[u].z, t[u].w); ((uint2*)xb)[i] = o; } }
    }
}
DEV void p_rope_table(float2* tab, int tg, int nthr) {
    const int i0 = blockIdx.x * nthr + tg, j = i0 & 127;
    const double r = 0.93057204092969897;
    double inv = 1.0; for (int t = 0; t < j; ++t) inv *= r;
    for (int i = i0; i < 8192 * 128; i += gridDim.x * nthr) {
        const int s = i >> 7;
        const double ang = (double)s * inv;
        const double twopi_hi = 6.283185307179586232, twopi_lo = 2.4492935982947064e-16;
        const double n = rint(ang * 0.15915494309189535);
        const double x = (ang - n * twopi_hi) - n * twopi_lo;
        const double x2 = x * x;
        double acc = 1.0 - x2 * (1.0 / (22.0 * 23.0));
#pragma unroll
        for (int k = 21; k >= 3; k -= 2) acc = 1.0 - x2 * (1.0 / ((double)(k - 1) * (double)k)) * acc;
        double acc2 = 1.0 - x2 * (1.0 / (21.0 * 22.0));
#pragma unroll
        for (int k = 20; k >= 2; k -= 2) acc2 = 1.0 - x2 * (1.0 / ((double)(k - 1) * (double)k)) * acc2;
        tab[i] = make_float2((float)acc2, (float)(x * acc));
    }
}

typedef float f32x4_t __attribute__((ext_vector_type(4)));
typedef short s16x4_t __attribute__((ext_vector_type(4)));
constexpr int LRU_ROWB = 400;
DEV void p_lru_compute(unsigned char* lds, const bf16_t* ulru, const float* cw, const float* cb, const bf16_t* wrg_t,
                       const float* b_r, const float* b_i, const float* lam, bf16_t* epsb, bf16_t* xinb, float* segA, float* segH) {
    int tid_ = otid(); asm volatile("" : "+v"(tid_));
    const int tid = tid_, wave = tid >> 6, lane = tid & 63, fr = lane & 15, fq = lane >> 4, wr = wave >> 2, wc = wave & 3;
    unsigned char* stg = lds + 256 * LRU_ROWB + wave * 4096;
    for (int item = blockIdx.x; item < 1024; item += gridDim.x) {
        const int n = item & 7, b = (item >> 3) & 3, seg = item >> 5;
        const size_t t0 = (size_t)b * SEQ + seg * 256;
        {
            const int c8 = tid % 24, run = tid / 24, r0 = run * 13;
            if (run < 20) {
                const int ch0 = n * 192 + c8 * 8;
                float wj[4][8], bias[8];
#pragma unroll
                for (int j = 0; j < 4; ++j) { const float4 w0 = *(const float4*)(cw + j * 1536 + ch0), w1 = *(const float4*)(cw + j * 1536 + ch0 + 4);
                    wj[j][0] = w0.x; wj[j][1] = w0.y; wj[j][2] = w0.z; wj[j][3] = w0.w; wj[j][4] = w1.x; wj[j][5] = w1.y; wj[j][6] = w1.z; wj[j][7] = w1.w; }
                { const float4 c0 = *(const float4*)(cb + ch0), c1 = *(const float4*)(cb + ch0 + 4); bias[0] = c0.x; bias[1] = c0.y; bias[2] = c0.z; bias[3] = c0.w; bias[4] = c1.x; bias[5] = c1.y; bias[6] = c1.z; bias[7] = c1.w; }
                u32x4_t raw[16];
#pragma unroll
                for (int i = 0; i < 16; ++i) { const int r = r0 - 3 + i;
                    raw[i] = (r < 256 && seg * 256 + r >= 0) ? *(const u32x4_t*)(ulru + (t0 + r) * 1536 + ch0) : (u32x4_t){0u, 0u, 0u, 0u}; }
                float xw[4][8];
#pragma unroll
                for (int i = 0; i < 16; ++i) {
#pragma unroll
                    for (int e = 0; e < 4; ++e) { xw[i & 3][2 * e] = __uint_as_float(raw[i][e] << 16); xw[i & 3][2 * e + 1] = __uint_as_float(raw[i][e] & 0xffff0000u); }
                    if (i >= 3) {
                        const int r = r0 + i - 3;
                        float acc[8];
#pragma unroll
                        for (int e = 0; e < 8; ++e) acc[e] = bias[e] + wj[0][e] * xw[(i + 1) & 3][e] + wj[1][e] * xw[(i + 2) & 3][e] + wj[2][e] * xw[(i + 3) & 3][e] + wj[3][e] * xw[i & 3][e];
                        if (r < 256) { uint4 o; o.x = pg8::cvt_pk_bf16(acc[0], acc[1]); o.y = pg8::cvt_pk_bf16(acc[2], acc[3]); o.z = pg8::cvt_pk_bf16(acc[4], acc[5]); o.w = pg8::cvt_pk_bf16(acc[6], acc[7]);
                            *(uint4*)(lds + r * LRU_ROWB + c8 * 16) = o; }
                    }
                }
            }
        }
        __syncthreads();
        float cbr[3], cbi[3], csp[3], hrun[3], atot[3];
        const int sub = seg * 2 + wr;
#pragma unroll
        for (int tc = 0; tc < 3; ++tc) { const int ch = n * 192 + 48 * wc + 16 * tc + fr; cbr[tc] = b_r[ch]; cbi[tc] = b_i[ch]; csp[tc] = 8.f * 1.4426950408889634f * log1pf(__expf(-lam[ch])); atot[tc] = 1.f; hrun[tc] = 0.f; }
        const bf16_t* wrb = wrg_t + (size_t)n * 192 * 192 + (size_t)(wc * 18) * 512 + lane * 8;
        const bf16_t* wib = wrb + (size_t)8 * 192 * 192;
#pragma unroll
        for (int tc = 0; tc < 3; ++tc) {
            bf16x8_t bfr[6][2];
#pragma unroll
            for (int ks = 0; ks < 6; ++ks) { bfr[ks][0] = *(const bf16x8_t*)(wrb + (tc * 6 + ks) * 512); bfr[ks][1] = *(const bf16x8_t*)(wib + (tc * 6 + ks) * 512); }
#pragma unroll
            for (int p = 0; p < 2; ++p) {
                const int rowb = 128 * wr + 64 * p;
                f32x4_t acc[4][2];
#pragma unroll
                for (int m = 0; m < 4; ++m) { acc[m][0] = (f32x4_t){0.f, 0.f, 0.f, 0.f}; acc[m][1] = (f32x4_t){0.f, 0.f, 0.f, 0.f}; }
#pragma unroll
                for (int ks = 0; ks < 6; ++ks) {
                    bf16x8_t afr[4];
#pragma unroll
                    for (int m = 0; m < 4; ++m) afr[m] = *(const bf16x8_t*)(lds + (rowb + 16 * (fr >> 2) + 4 * m + (fr & 3)) * LRU_ROWB + ks * 64 + fq * 16);
#pragma unroll
                    for (int m = 0; m < 4; ++m) { acc[m][0] = __builtin_amdgcn_mfma_f32_16x16x32_bf16(afr[m], bfr[ks][0], acc[m][0], 0, 0, 0); acc[m][1] = __builtin_amdgcn_mfma_f32_16x16x32_bf16(afr[m], bfr[ks][1], acc[m][1], 0, 0, 0); }
                }
                const int coff = (48 * wc + 16 * tc + fr) * 2;
                const unsigned char* up = lds + (rowb + 16 * fq) * LRU_ROWB + coff;
                float Al = 1.f, Bl = 0.f;
                unsigned pe[8], px[8];
#pragma unroll
                for (int m = 0; m < 4; ++m) {
                    float ee[4], xx[4];
#pragma unroll
                    for (int j = 0; j < 4; ++j) {
                        const float rr = pg8::fsig(acc[m][0][j] + cbr[tc]), ii = pg8::fsig(acc[m][1][j] + cbi[tc]);
                        const float aa = __builtin_amdgcn_exp2f(-csp[tc] * rr);
                        const float u = bf2f(*(const bf16_t*)(up + (4 * m + j) * LRU_ROWB));
                        const float om = 1.f - aa;
                        const float x = __builtin_amdgcn_sqrtf(fmaxf(om * (1.f + aa), 0.f)) * ii * u;
                        ee[j] = om; xx[j] = x; Bl = aa * Bl + x; Al *= aa;
                    }
                    pe[2 * m] = pg8::cvt_pk_bf16(ee[0], ee[1]); pe[2 * m + 1] = pg8::cvt_pk_bf16(ee[2], ee[3]);
                    px[2 * m] = pg8::cvt_pk_bf16(xx[0], xx[1]); px[2 * m + 1] = pg8::cvt_pk_bf16(xx[2], xx[3]);
                }
                { float h = hrun[tc], ap = 1.f;
#pragma unroll
                  for (int q = 0; q < 4; ++q) { const float Aq = __shfl(Al, fr + 16 * q), Bq = __shfl(Bl, fr + 16 * q); h = Aq * h + Bq; ap *= Aq; }
                  hrun[tc] = h; atot[tc] *= ap; }
#pragma unroll
                for (int m = 0; m < 4; ++m)
#pragma unroll
                    for (int j = 0; j < 4; ++j) { const int tk = 16 * fq + 4 * m + j; const unsigned we = pe[2 * m + (j >> 1)], wx = px[2 * m + (j >> 1)];
                        *(bf16_t*)(stg + tk * 32 + fr * 2) = (bf16_t)((j & 1) ? (we >> 16) : (we & 0xffff));
                        *(bf16_t*)(stg + 2048 + tk * 32 + fr * 2) = (bf16_t)((j & 1) ? (wx >> 16) : (wx & 0xffff)); }
                asm volatile("s_waitcnt lgkmcnt(0)" ::: "memory");
#pragma unroll
                for (int i = 0; i < 2; ++i) { const int piece = lane + 64 * i, tk = piece >> 1, hf = piece & 1;
                    const size_t go = (t0 + rowb + tk) * 1536 + n * 192 + 48 * wc + 16 * tc + 8 * hf;
                    *(u32x4_t*)(epsb + go) = *(const u32x4_t*)(stg + tk * 32 + hf * 16);
                    *(u32x4_t*)(xinb + go) = *(const u32x4_t*)(stg + 2048 + tk * 32 + hf * 16); }
                asm volatile("s_waitcnt lgkmcnt(0)" ::: "memory");
            }
        }
        if (fq == 0) {
#pragma unroll
            for (int tc = 0; tc < 3; ++tc) { const size_t o = ((size_t)b * 64 + sub) * 1536 + n * 192 + 48 * wc + 16 * tc + fr; segA[o] = atot[tc]; segH[o] = hrun[tc]; }
        }
        __syncthreads();
    }
}
DEV void p_lru_scan(const bf16_t* epsb, const bf16_t* xinb, bf16_t* gl, const float* carry) {
    const int tid = otid();
    if (tid >= 384) return;
    for (int item = blockIdx.x; item < 256; item += gridDim.x) {
        const int b = item >> 6, sub = item & 63;
        const size_t base = ((size_t)b * SEQ + sub * 128) * 1536 + tid * 4;
        const float4 cin = *(const float4*)(carry + ((size_t)b * 64 + sub) * 1536 + tid * 4);
        float h0 = cin.x, h1 = cin.y, h2 = cin.z, h3 = cin.w;
#pragma unroll 8
        for (int t = 0; t < 128; ++t) {
            const size_t o = base + (size_t)t * 1536;
            const uint2 ev = *(const uint2*)(epsb + o), xv = *(const uint2*)(xinb + o), gv = *(const uint2*)(gl + o);
            h0 = (1.f - __uint_as_float(ev.x << 16)) * h0 + __uint_as_float(xv.x << 16);
            h1 = (1.f - __uint_as_float(ev.x & 0xffff0000u)) * h1 + __uint_as_float(xv.x & 0xffff0000u);
            h2 = (1.f - __uint_as_float(ev.y << 16)) * h2 + __uint_as_float(xv.y << 16);
            h3 = (1.f - __uint_as_float(ev.y & 0xffff0000u)) * h3 + __uint_as_float(xv.y & 0xffff0000u);
            uint2 ov; ov.x = pg8::cvt_pk_bf16(h0 * __uint_as_float(gv.x << 16), h1 * __uint_as_float(gv.x & 0xffff0000u)); ov.y = pg8::cvt_pk_bf16(h2 * __uint_as_float(gv.y << 16), h3 * __uint_as_float(gv.y & 0xffff0000u));
            *(uint2*)(gl + o) = ov;
        }
    }
}
DEV void p_lru_carry(float* lds, const float* segA, const float* segH, float* carry) {
    float* tA = lds; float* tH = lds + 64 * 65;
    for (int item = blockIdx.x; item < 96; item += gridDim.x) {
        const int b = item / 24, c0 = (item % 24) * 64;
        for (int i = otid(); i < 64 * 64; i += NTHR) { const int s = i >> 6, c = i & 63; const size_t o = ((size_t)b * 64 + s) * 1536 + c0 + c; tA[s * 65 + c] = segA[o]; tH[s * 65 + c] = segH[o]; }
        __syncthreads();
        if (otid() < 64) { const int c = otid(); float h = 0.f;
            for (int s = 0; s < 64; ++s) { const float a = tA[s * 65 + c], hh = tH[s * 65 + c]; tA[s * 65 + c] = h; h = a * h + hh; } }
        __syncthreads();
        for (int i = otid(); i < 64 * 64; i += NTHR) { const int s = i >> 6, c = i & 63; carry[((size_t)b * 64 + s) * 1536 + c0 + c] = tA[s * 65 + c]; }
        __syncthreads();
    }
}
DEV bf16x8_t fp8x8_to_bf16(unsigned d0, unsigned d1) {
    typedef __bf16 bf2_t __attribute__((ext_vector_type(2)));
    const unsigned a = __builtin_bit_cast(unsigned, __builtin_amdgcn_cvt_scalef32_pk_bf16_fp8(d0, 1.0f, false)), b = __builtin_bit_cast(unsigned, __builtin_amdgcn_cvt_scalef32_pk_bf16_fp8(d0, 1.0f, true));
    const unsigned c = __builtin_bit_cast(unsigned, __builtin_amdgcn_cvt_scalef32_pk_bf16_fp8(d1, 1.0f, false)), d = __builtin_bit_cast(unsigned, __builtin_amdgcn_cvt_scalef32_pk_bf16_fp8(d1, 1.0f, true));
    return __builtin_bit_cast(bf16x8_t, (u32x4_t){a, b, c, d});
}
#define LDS_BARRIER() do { asm volatile("s_waitcnt lgkmcnt(0)" ::: "memory"); __builtin_amdgcn_s_barrier(); asm volatile("" ::: "memory"); } while (0)
DEV void p_scores(unsigned char* lds, const bf16_t* q, const bf16_t* k, bf16_t* P) {
    int tid_ = otid(); asm volatile("" : "+v"(tid_));
    const int tid = tid_, w = tid >> 6, lane = tid & 63, fr = lane & 15, fq = lane >> 4;
    const int krow = tid >> 5, kch = tid & 31;
    u32x4_t kreg[8], qraw[4];
    int g = blockIdx.x;
    if (g < 1024) { const int c = g & 63, bh = g >> 6, b = bh >> 2, h = bh & 3; const size_t tok0 = (size_t)b * SEQ + c * 128;
        const bf16_t* kc = k + tok0 * 1024 + h * 256;
#pragma unroll
        for (int ii = 0; ii < 8; ++ii) kreg[ii] = *(const u32x4_t*)(kc + (size_t)(krow + 16 * ii) * 1024 + kch * 8);
        const unsigned char* qp = (const unsigned char*)q + ((tok0 >> 7) * 4 + h) * 32768 + (fq * 128 + 16 * w + fr) * 16;
#pragma unroll
        for (int i = 0; i < 4; ++i) qraw[i] = *(const u32x4_t*)(qp + i * 8192); }
    for (; g < 1024; g += gridDim.x) {
#pragma unroll
        for (int ii = 0; ii < 8; ++ii) *(u32x4_t*)(lds + (krow + 16 * ii) * 528 + kch * 16) = kreg[ii];
        bf16x8_t qc[8];
#pragma unroll
        for (int i = 0; i < 4; ++i) { qc[2 * i] = fp8x8_to_bf16(qraw[i][0], qraw[i][1]); qc[2 * i + 1] = fp8x8_to_bf16(qraw[i][2], qraw[i][3]); }
        const int gn = g + gridDim.x;
        if (gn < 1024) { const int c = gn & 63, bh = gn >> 6, b = bh >> 2, h = bh & 3; const size_t tok0 = (size_t)b * SEQ + c * 128;
            const bf16_t* kc = k + tok0 * 1024 + h * 256;
#pragma unroll
            for (int ii = 0; ii < 8; ++ii) kreg[ii] = *(const u32x4_t*)(kc + (size_t)(krow + 16 * ii) * 1024 + kch * 8);
            const unsigned char* qp = (const unsigned char*)q + ((tok0 >> 7) * 4 + h) * 32768 + (fq * 128 + 16 * w + fr) * 16;
#pragma unroll
            for (int i = 0; i < 4; ++i) qraw[i] = *(const u32x4_t*)(qp + i * 8192); }
        LDS_BARRIER();
        f32x4_t acc[8];
#pragma unroll
        for (int nt = 0; nt < 8; ++nt) acc[nt] = (f32x4_t){0.f, 0.f, 0.f, 0.f};
#pragma unroll
        for (int ks = 0; ks < 8; ++ks)
#pragma unroll
            for (int nt = 0; nt < 8; ++nt) { const bf16x8_t bb = *(const bf16x8_t*)(lds + (16 * nt + fr) * 528 + ks * 64 + fq * 16); acc[nt] = __builtin_amdgcn_mfma_f32_16x16x32_bf16(bb, qc[ks], acc[nt], 0, 0, 0); }
        {
            const int c = g & 63, bh = g >> 6, b = bh >> 2, h = bh & 3;
            bf16_t* kt = const_cast<bf16_t*>(k) + ((size_t)b * SEQ + c * 128 + fq * 8 + w) * 1024 + h * 256 + fr * 8;
#pragma unroll
            for (int ks2 = 0; ks2 < 2; ++ks2)
#pragma unroll
                for (int di = 0; di < 2; ++di) {
                    unsigned o[4];
#pragma unroll
                    for (int e = 0; e < 2; ++e) {
                        const unsigned char* kp = lds + (32 * (2 * ks2 + e) + 8 * fq + (fr >> 2)) * 528 + (16 * (2 * w + di) + 4 * (fr & 3)) * 2;
                        const s16x4_t t0 = __builtin_amdgcn_ds_read_tr16_b64_v4i16((LAS s16x4_t*)(kp));
                        const s16x4_t t1 = __builtin_amdgcn_ds_read_tr16_b64_v4i16((LAS s16x4_t*)(kp + 4 * 528));
                        o[2 * e] = pg8::pk4_fp8(16.f * bf2f((bf16_t)t0[0]), 16.f * bf2f((bf16_t)t0[1]), 16.f * bf2f((bf16_t)t0[2]), 16.f * bf2f((bf16_t)t0[3]));
                        o[2 * e + 1] = pg8::pk4_fp8(16.f * bf2f((bf16_t)t1[0]), 16.f * bf2f((bf16_t)t1[1]), 16.f * bf2f((bf16_t)t1[2]), 16.f * bf2f((bf16_t)t1[3]));
                    }
                    *(u32x4_t*)(kt + ks2 * 32768 + di * 128) = (u32x4_t){o[0], o[1], o[2], o[3]};
                }
        }
        LDS_BARRIER();
        bf16_t* Pg = P + (size_t)g * 16384 + ((fq >> 1) * 128 + 16 * w + fr) * 8 + 4 * (fq & 1);
        int mrow = 16 * w + fr - 4 * fq; asm volatile("" : "+v"(mrow));
#pragma unroll
        for (int nt = 0; nt < 8; ++nt) {
            uint2 o; o.x = pg8::cvt_pk_bf16((16 * nt <= mrow) ? acc[nt][0] * 0.015625f : 0.f, (16 * nt + 1 <= mrow) ? acc[nt][1] * 0.015625f : 0.f);
            o.y = pg8::cvt_pk_bf16((16 * nt + 2 <= mrow) ? acc[nt][2] * 0.015625f : 0.f, (16 * nt + 3 <= mrow) ? acc[nt][3] * 0.015625f : 0.f);
            *(uint2*)(Pg + ((nt >> 1) * 4 + 2 * (nt & 1)) * 1024) = o; }
    }
    __syncthreads();
}
constexpr int RT_KS = 528, RT_VS = 272, RT_V = 0, RT_U = 2 * 32 * RT_VS;
DEV void p_ret_mfma(unsigned char* lds, const bf16_t* q, const bf16_t* k, bf16_t* v, const bf16_t* P) {
    int tid_ = otid(); asm volatile("" : "+v"(tid_));
    const int tid = tid_, w = tid >> 6, lane = tid & 63, fr = lane & 15, fq = lane >> 4;
    for (int wk = blockIdx.x; wk < 256; wk += gridDim.x) {
        const int xcd = wk & 7, idx = wk >> 3, bh = xcd * 2 + (idx >> 4), sl = idx & 15, b = bh >> 2, h = bh & 3;
        float g128; { const double gam = 1.0 - exp2(-5.0 - (double)h); g128 = (float)exp2(128.0 * log2(gam)); }
        asm volatile("" : "+v"(g128));
        f32x4_t accU[2][2];
#pragma unroll
        for (int et = 0; et < 2; ++et)
#pragma unroll
            for (int di = 0; di < 2; ++di) accU[et][di] = (f32x4_t){0.f, 0.f, 0.f, 0.f};
        for (int i = tid; i < 32 * RT_KS / 4; i += NTHR) ((unsigned*)(lds + RT_U))[i] = 0u;
        const size_t tokb = (size_t)b * SEQ;
        const int vm = tid >> 2, ve = (tid & 3) * 8;
        const bf16_t* vsl = v + tokb * 2048 + h * 512 + sl * 32;
#define RT_STAGE_V(buf, vr) do { unsigned char* vp_ = lds + RT_V + (buf) * 32 * RT_VS + ve * RT_VS + vm * 2; \
            *(bf16_t*)(vp_ + 0 * RT_VS) = (bf16_t)((vr)[0] & 0xffff); *(bf16_t*)(vp_ + 1 * RT_VS) = (bf16_t)((vr)[0] >> 16); \
            *(bf16_t*)(vp_ + 2 * RT_VS) = (bf16_t)((vr)[1] & 0xffff); *(bf16_t*)(vp_ + 3 * RT_VS) = (bf16_t)((vr)[1] >> 16); \
            *(bf16_t*)(vp_ + 4 * RT_VS) = (bf16_t)((vr)[2] & 0xffff); *(bf16_t*)(vp_ + 5 * RT_VS) = (bf16_t)((vr)[2] >> 16); \
            *(bf16_t*)(vp_ + 6 * RT_VS) = (bf16_t)((vr)[3] & 0xffff); *(bf16_t*)(vp_ + 7 * RT_VS) = (bf16_t)((vr)[3] >> 16); } while (0)
        u32x4_t vreg = *(const u32x4_t*)(vsl + (size_t)vm * 2048 + ve);
        RT_STAGE_V(0, vreg);
        vreg = *(const u32x4_t*)(vsl + (size_t)(128 + vm) * 2048 + ve);
        u32x4_t qraw[4], kraw[2][2];
        bf16x8_t pa[4];
        const unsigned char* qp = (const unsigned char*)q + ((tokb >> 7) * 4 + h) * 32768 + (fq * 128 + 16 * w + fr) * 16;
        const bf16_t* pp = P + (size_t)(bh * 64) * 16384 + (fq * 128 + 16 * w + fr) * 8;
        const bf16_t* kp = k + (tokb + fq * 8 + w) * 1024 + h * 256 + fr * 8;
        {
#pragma unroll
            for (int i = 0; i < 4; ++i) qraw[i] = *(const u32x4_t*)(qp + i * 8192);
#pragma unroll
            for (int ks = 0; ks < 4; ++ks) { if (2 * ks <= w) pa[ks] = *(const bf16x8_t*)(pp + ks * 4096); else pa[ks] = (bf16x8_t){0, 0, 0, 0, 0, 0, 0, 0}; }
#pragma unroll
            for (int di = 0; di < 2; ++di)
#pragma unroll
                for (int i = 0; i < 2; ++i) kraw[di][i] = *(const u32x4_t*)(kp + i * 32768 + di * 128);
        }
        LDS_BARRIER();
#pragma unroll 1
        for (int c = 0; c < 64; ++c) {
            const size_t tok0 = tokb + c * 128;
            const unsigned char* ldsU = lds + RT_U + (c & 1) * 32 * RT_KS;
            const unsigned char* ldsV = lds + RT_V + (c & 1) * 32 * RT_VS;
            f32x4_t ao[2] = {(f32x4_t){0.f, 0.f, 0.f, 0.f}, (f32x4_t){0.f, 0.f, 0.f, 0.f}};
            {
                bf16x8_t qa[8];
#pragma unroll
                for (int i = 0; i < 4; ++i) { qa[2 * i] = fp8x8_to_bf16(qraw[i][0], qraw[i][1]); qa[2 * i + 1] = fp8x8_to_bf16(qraw[i][2], qraw[i][3]); }
                bf16x8_t bu[8];
#pragma unroll
                for (int nt = 0; nt < 2; ++nt) {
#pragma unroll
                    for (int ks = 0; ks < 8; ++ks) bu[ks] = *(const bf16x8_t*)(ldsU + (16 * nt + fr) * RT_KS + ks * 64 + fq * 16);
#pragma unroll
                    for (int ks = 0; ks < 8; ++ks) ao[nt] = __builtin_amdgcn_mfma_f32_16x16x32_bf16(bu[ks], qa[ks], ao[nt], 0, 0, 0);
                }
            }
            bf16x8_t bv[2][4];
#pragma unroll
            for (int nt = 0; nt < 2; ++nt)
#pragma unroll
                for (int ks = 0; ks < 4; ++ks) bv[nt][ks] = *(const bf16x8_t*)(ldsV + (16 * nt + fr) * RT_VS + ks * 64 + fq * 16);
#pragma unroll
            for (int ks = 0; ks < 4; ++ks)
#pragma unroll
                for (int nt = 0; nt < 2; ++nt) ao[nt] = __builtin_amdgcn_mfma_f32_16x16x32_bf16(bv[nt][ks], pa[ks], ao[nt], 0, 0, 0);
            if (c + 1 < 64) {
                const unsigned char* qn = qp + (size_t)(c + 1) * 131072;
#pragma unroll
                for (int i = 0; i < 4; ++i) qraw[i] = *(const u32x4_t*)(qn + i * 8192);
                const bf16_t* pn = pp + (size_t)(c + 1) * 16384;
#pragma unroll
                for (int ks = 0; ks < 4; ++ks) if (2 * ks <= w) pa[ks] = *(const bf16x8_t*)(pn + ks * 4096);
            }
            {
                bf16_t* vc = v + (tok0 + 16 * w + fr) * 2048 + h * 512 + sl * 32 + 4 * fq;
#pragma unroll
                for (int nt = 0; nt < 2; ++nt) { uint2 o; o.x = pg8::cvt_pk_bf16(ao[nt][0], ao[nt][1]); o.y = pg8::cvt_pk_bf16(ao[nt][2], ao[nt][3]); *(uint2*)(vc + 16 * nt) = o; }
            }
#pragma unroll
            for (int ks = 0; ks < 4; ++ks)
#pragma unroll
                for (int di = 0; di < 2; ++di) { const bf16x8_t kb = fp8x8_to_bf16(kraw[di][ks >> 1][2 * (ks & 1)], kraw[di][ks >> 1][2 * (ks & 1) + 1]);
#pragma unroll
                    for (int et = 0; et < 2; ++et) accU[et][di] = __builtin_amdgcn_mfma_f32_16x16x32_bf16(kb, bv[et][ks], accU[et][di], 0, 0, 0); }
            if (c + 1 < 64) {
                const bf16_t* kn = kp + (size_t)(c + 1) * 131072;
#pragma unroll
                for (int di = 0; di < 2; ++di)
#pragma unroll
                    for (int i = 0; i < 2; ++i) kraw[di][i] = *(const u32x4_t*)(kn + i * 32768 + di * 128);
            }
#pragma unroll
            for (int et = 0; et < 2; ++et)
#pragma unroll
                for (int di = 0; di < 2; ++di) accU[et][di] = accU[et][di] * g128;
            {
                unsigned char* un = lds + RT_U + ((c + 1) & 1) * 32 * RT_KS;
#pragma unroll
                for (int et = 0; et < 2; ++et)
#pragma unroll
                    for (int di = 0; di < 2; ++di) { const float us = 1.f / 1024.f;
                        uint2 o; o.x = pg8::cvt_pk_bf16(accU[et][di][0] * us, accU[et][di][1] * us); o.y = pg8::cvt_pk_bf16(accU[et][di][2] * us, accU[et][di][3] * us);
                        *(uint2*)(un + (16 * et + fr) * RT_KS + (16 * (2 * w + di) + 4 * fq) * 2) = o; }
                if (c + 1 < 64) { RT_STAGE_V((c + 1) & 1, vreg); }
                if (c + 2 < 64) vreg = *(const u32x4_t*)(vsl + (size_t)((c + 2) * 128 + vm) * 2048 + ve);
            }
            LDS_BARRIER();
        }
#undef RT_STAGE_V
        __syncthreads();
    }
}
DEV void p_headnorm(bf16_t* ret, const bf16_t* g) {
    const int lane = otid() & 63;
    for (int w = (blockIdx.x * NTHR + otid()) >> 6; w < NTOK * 4; w += gridDim.x * (NTHR / 64)) {
        const size_t o = (size_t)w * 512 + lane * 8;
        const u32x4_t rv = *(const u32x4_t*)(ret + o), gv = *(const u32x4_t*)(g + o);
        float x[8], gg[8]; float s = 0.f;
#pragma unroll
        for (int j = 0; j < 4; ++j) { x[2 * j] = __uint_as_float(rv[j] << 16); x[2 * j + 1] = __uint_as_float(rv[j] & 0xffff0000u); gg[2 * j] = __uint_as_float(gv[j] << 16); gg[2 * j + 1] = __uint_as_float(gv[j] & 0xffff0000u); }
#pragma unroll
        for (int j = 0; j < 8; ++j) s += x[j];
#pragma unroll
        for (int m = 1; m < 64; m <<= 1) s += __shfl_xor(s, m);
        const float mu = s * (1.f / 512.f); float q = 0.f;
#pragma unroll
        for (int j = 0; j < 8; ++j) { x[j] -= mu; q += x[j] * x[j]; }
#pragma unroll
        for (int m = 1; m < 64; m <<= 1) q += __shfl_xor(q, m);
        const float rstd = rsqrtf(q * (1.f / 512.f) + LN_EPS);
        u32x4_t ov;
#pragma unroll
        for (int j = 0; j < 4; ++j) ov[j] = pg8::cvt_pk_bf16(x[2 * j] * rstd * gg[2 * j], x[2 * j + 1] * rstd * gg[2 * j + 1]);
        *(u32x4_t*)(ret + o) = ov;
    }
}

typedef float f32x4v __attribute__((ext_vector_type(4)));
DEV void p_ln1_route(float* lds, const bf16_t* y, bf16_t* x1b, unsigned char* x1q, const float* g1, const float* b1, const unsigned char* rtab,
                     int2* route_e, float2* route_w, int* cnt, int* list, const float* sb) {
    int tid_ = otid(); asm volatile("" : "+v"(tid_));
    const int tid = tid_, wv = tid >> 6, lane = tid & 63, r16 = lane & 15, kq = lane >> 4;
    const unsigned char* Wt = (const unsigned char*)lds;
    float* Sc = lds + 1024 * 36;
    float* Bc = Sc + 48;
    int* lcnt = (int*)(Bc + 48);
    int* rowE = lcnt + 32;
    int* rowP = rowE + 256;
#pragma unroll 6
    for (int i = tid; i < 9216; i += NTHR) ((u32x4_t*)lds)[i] = ((const u32x4_t*)rtab)[i];
    if (tid < 32) lcnt[tid] = 0;
    __syncthreads();
    if (tid < 96) Sc[tid] = sb[tid];
    __syncthreads();
    constexpr int rows_per_wg = 128;
    for (int blk = blockIdx.x; blk < NTOK / rows_per_wg; blk += gridDim.x) {
    { const int tile = wv;
        const int lrow0 = tile * 16, row0 = blk * rows_per_wg + lrow0;
        const bf16_t* yp = y + (size_t)(row0 + r16) * 1024 + 8 * kq;
        const unsigned char* tb = Wt + lane * 16;
        const unsigned char* tb2 = Wt + 131072 + (kq * 4 + (r16 & 3)) * 16;
        f32x4v acc[3] = {(f32x4v){0.f, 0.f, 0.f, 0.f}, (f32x4v){0.f, 0.f, 0.f, 0.f}, (f32x4v){0.f, 0.f, 0.f, 0.f}};
        float s1 = 0.f, s2 = 0.f;
#pragma unroll 4
        for (int T = 0; T < 32; ++T) {
            const u32x4_t yr = *(const u32x4_t*)(yp + 32 * T);
#pragma unroll
            for (int e = 0; e < 4; ++e) { const float lo = __uint_as_float(yr[e] << 16), hi = __uint_as_float(yr[e] & 0xffff0000u); s1 += lo + hi; s2 += lo * lo + hi * hi; }
            const bf16x8_t a = __builtin_bit_cast(bf16x8_t, yr);
#pragma unroll
            for (int part = 0; part < 2; ++part) {
#pragma unroll
                for (int nt = 0; nt < 2; ++nt) acc[nt] = __builtin_amdgcn_mfma_f32_16x16x32_bf16(a, *(const bf16x8_t*)(tb + ((T * 2 + part) * 2 + nt) * 1024), acc[nt], 0, 0, 0);
                acc[2] = __builtin_amdgcn_mfma_f32_16x16x32_bf16(a, *(const bf16x8_t*)(tb2 + (T * 2 + part) * 256), acc[2], 0, 0, 0);
            }
        }
        s1 += __shfl_xor(s1, 16); s1 += __shfl_xor(s1, 32); s2 += __shfl_xor(s2, 16); s2 += __shfl_xor(s2, 32);
        const float mu = s1 * (1.f / 1024.f), rstd = rsqrtf(fmaxf(s2 * (1.f / 1024.f) - mu * mu, 0.f) + LN_EPS);
        {
            float gA[8], bA[8], gB[8], bB[8];
#pragma unroll
            for (int e = 0; e < 2; ++e) { const float4 t0 = *(const float4*)(g1 + 8 * lane + 4 * e), t1 = *(const float4*)(b1 + 8 * lane + 4 * e), t2 = *(const float4*)(g1 + 512 + 8 * lane + 4 * e), t3 = *(const float4*)(b1 + 512 + 8 * lane + 4 * e);
                gA[4 * e] = t0.x; gA[4 * e + 1] = t0.y; gA[4 * e + 2] = t0.z; gA[4 * e + 3] = t0.w; bA[4 * e] = t1.x; bA[4 * e + 1] = t1.y; bA[4 * e + 2] = t1.z; bA[4 * e + 3] = t1.w;
                gB[4 * e] = t2.x; gB[4 * e + 1] = t2.y; gB[4 * e + 2] = t2.z; gB[4 * e + 3] = t2.w; bB[4 * e] = t3.x; bB[4 * e + 1] = t3.y; bB[4 * e + 2] = t3.z; bB[4 * e + 3] = t3.w; }
#pragma unroll 2
            for (int rr = 0; rr < 16; ++rr) {
                const float mur = __shfl(mu, rr), rsr = __shfl(rstd, rr);
                const size_t ro = (size_t)(row0 + rr) * 1024 + 8 * lane;
                const u32x4_t ya = *(const u32x4_t*)(y + ro), yb = *(const u32x4_t*)(y + ro + 512);
                float oa[8], ob[8];
#pragma unroll
                for (int e = 0; e < 4; ++e) {
                    oa[2 * e] = (__uint_as_float(ya[e] << 16) - mur) * rsr * gA[2 * e] + bA[2 * e]; oa[2 * e + 1] = (__uint_as_float(ya[e] & 0xffff0000u) - mur) * rsr * gA[2 * e + 1] + bA[2 * e + 1];
                    ob[2 * e] = (__uint_as_float(yb[e] << 16) - mur) * rsr * gB[2 * e] + bB[2 * e]; ob[2 * e + 1] = (__uint_as_float(yb[e] & 0xffff0000u) - mur) * rsr * gB[2 * e + 1] + bB[2 * e + 1]; }
                *(u32x4_t*)(x1b + ro) = (u32x4_t){pg8::cvt_pk_bf16(oa[0], oa[1]), pg8::cvt_pk_bf16(oa[2], oa[3]), pg8::cvt_pk_bf16(oa[4], oa[5]), pg8::cvt_pk_bf16(oa[6], oa[7])};
                *(u32x4_t*)(x1b + ro + 512) = (u32x4_t){pg8::cvt_pk_bf16(ob[0], ob[1]), pg8::cvt_pk_bf16(ob[2], ob[3]), pg8::cvt_pk_bf16(ob[4], ob[5]), pg8::cvt_pk_bf16(ob[6], ob[7])};
                uint2 qa_, qb_;
                qa_.x = pg8::pk4_fp8(oa[0] * pg8::FP8_SX, oa[1] * pg8::FP8_SX, oa[2] * pg8::FP8_SX, oa[3] * pg8::FP8_SX); qa_.y = pg8::pk4_fp8(oa[4] * pg8::FP8_SX, oa[5] * pg8::FP8_SX, oa[6] * pg8::FP8_SX, oa[7] * pg8::FP8_SX);
                qb_.x = pg8::pk4_fp8(ob[0] * pg8::FP8_SX, ob[1] * pg8::FP8_SX, ob[2] * pg8::FP8_SX, ob[3] * pg8::FP8_SX); qb_.y = pg8::pk4_fp8(ob[4] * pg8::FP8_SX, ob[5] * pg8::FP8_SX, ob[6] * pg8::FP8_SX, ob[7] * pg8::FP8_SX);
                *(uint2*)(x1q + ro) = qa_; *(uint2*)(x1q + ro + 512) = qb_;
            }
        }
#pragma unroll
        for (int j = 0; j < 4; ++j) {
            const int rl = 4 * kq + j;
            const float mur = __shfl(mu, rl), rsr = __shfl(rstd, rl);
            float lg[3];
#pragma unroll
            for (int nt = 0; nt < 3; ++nt) lg[nt] = rsr * (acc[nt][j] - mur * Sc[16 * nt + r16]) + Bc[16 * nt + r16];
            const int gb = 16 * kq;
            const float g0 = __shfl(lg[2], gb + 0), g1v = __shfl(lg[2], gb + 1), g2 = __shfl(lg[2], gb + 2), g3 = __shfl(lg[2], gb + 3);
            int gi = 0; float gm = g0; if (g1v > gm) { gm = g1v; gi = 1; } if (g2 > gm) { gm = g2; gi = 2; } if (g3 > gm) { gm = g3; gi = 3; }
            const float gw = 1.f / (expf(g0 - gm) + expf(g1v - gm) + expf(g2 - gm) + expf(g3 - gm));
            const float lsel = (gi & 2) ? lg[1] : lg[0];
            float ev[8];
#pragma unroll
            for (int t = 0; t < 8; ++t) ev[t] = __shfl(lsel, gb + (gi & 1) * 8 + t);
            int i1 = 0; float v1 = ev[0];
#pragma unroll
            for (int t = 1; t < 8; ++t) if (ev[t] > v1) { v1 = ev[t]; i1 = t; }
            int i2 = -1; float v2 = -INFINITY;
#pragma unroll
            for (int t = 0; t < 8; ++t) if (t != i1 && ev[t] > v2) { v2 = ev[t]; i2 = t; }
            const float w1 = 1.f / (1.f + expf(v2 - v1)), w2 = 1.f - w1;
            if (r16 == 0) {
                const int lr = lrow0 + rl, r = row0 + rl, e1 = gi * 8 + i1, e2 = gi * 8 + i2;
                route_e[r] = make_int2(e1, e2); route_w[r] = make_float2(gw * w1, gw * w2);
                rowE[2 * lr] = e1; rowP[2 * lr] = atomicAdd(&lcnt[e1], 1);
                rowE[2 * lr + 1] = e2; rowP[2 * lr + 1] = atomicAdd(&lcnt[e2], 1);
            }
        }
    }
    __syncthreads();
    if (tid < 32) lcnt[tid] = atomicAdd(&cnt[tid * 64], lcnt[tid]);
    __syncthreads();
    for (int i = tid; i < 2 * rows_per_wg; i += NTHR) { const int e = rowE[i]; list[e * 32768 + lcnt[e] + rowP[i]] = (blk * rows_per_wg + (i >> 1)) * 2 + (i & 1); }
    __syncthreads();
    if (tid < 32) lcnt[tid] = 0;
    __syncthreads();
    }
}

DEV void p_final(float* out, const bf16_t* x1b, const bf16_t* ys, const float* g2, const float* b2) {
    const int lane = otid() & 63;
    for (int r = (blockIdx.x * NTHR + otid()) >> 6; r < NTOK; r += gridDim.x * (NTHR / 64)) {
        float x[16]; float s = 0.f;
#pragma unroll
        for (int j = 0; j < 4; ++j) { const int col = j * 256 + lane * 4; const ushort4 tb = *(const ushort4*)(x1b + (size_t)r * 1024 + col); const float4 t = make_float4(bf2f(tb.x), bf2f(tb.y), bf2f(tb.z), bf2f(tb.w));
            const ushort4 a = *(const ushort4*)(ys + (size_t)(2 * r) * 1024 + col), b = *(const ushort4*)(ys + (size_t)(2 * r + 1) * 1024 + col);
            x[4 * j] = ALPHA * t.x + bf2f(a.x) + bf2f(b.x); x[4 * j + 1] = ALPHA * t.y + bf2f(a.y) + bf2f(b.y); x[4 * j + 2] = ALPHA * t.z + bf2f(a.z) + bf2f(b.z); x[4 * j + 3] = ALPHA * t.w + bf2f(a.w) + bf2f(b.w);
            s += (x[4 * j] + x[4 * j + 1]) + (x[4 * j + 2] + x[4 * j + 3]); }
#pragma unroll
        for (int m = 1; m < 64; m <<= 1) s += __shfl_xor(s, m);
        const float mu = s * (1.f / 1024.f); float q = 0.f;
#pragma unroll
        for (int j = 0; j < 16; ++j) { x[j] -= mu; q += x[j] * x[j]; }
#pragma unroll
        for (int m = 1; m < 64; m <<= 1) q += __shfl_xor(q, m);
        const float rstd = rsqrtf(q * (1.f / 1024.f) + LN_EPS);
#pragma unroll
        for (int j = 0; j < 4; ++j) { const int col = j * 256 + lane * 4; const float4 gg = *(const float4*)(g2 + col), bb = *(const float4*)(b2 + col);
            *(float4*)(out + (size_t)r * 1024 + col) = make_float4(x[4 * j] * rstd * gg.x + bb.x, x[4 * j + 1] * rstd * gg.y + bb.y, x[4 * j + 2] * rstd * gg.z + bb.z, x[4 * j + 3] * rstd * gg.w + bb.w); }
    }
}

struct Args { const float* in[24]; float* out; unsigned char* ws; };
__global__ void __launch_bounds__(NTHR, 2) mega_fwd(Args a) {
    extern __shared__ __attribute__((aligned(16))) unsigned char lds_raw[];
    float* ldsf = (float*)lds_raw;
    PG8_LAS unsigned char* ldsl = (PG8_LAS unsigned char*)lds_raw;
    volatile LAS unsigned* MISC = (volatile LAS unsigned*)((LAS unsigned char*)lds_raw + LDS_MISC);
    for (int u = otid(); u < 128; u += NTHR) MISC[u] = 0u;
    __syncthreads();
    unsigned char* ws = a.ws;
    XcdBarrier bar = xcd_barrier_post((unsigned*)(ws + WS_CTL) + CW_BAR, MISC + 8);
#define GRID_BAR() xcd_barrier(bar)
    const float* x = a.in[0]; const float* w_in = a.in[1]; const float* b_merge = a.in[2];
    const float* conv_w = a.in[3]; const float* conv_b = a.in[4];
    const float* w_rg_r = a.in[5]; const float* b_rg_r = a.in[6]; const float* w_rg_i = a.in[7]; const float* b_rg_i = a.in[8];
    const float* lam = a.in[9]; const float* w_ret_o = a.in[10]; const float* w_lru_o = a.in[11]; const float* w_out = a.in[12];
    const float* ln1_g = a.in[13]; const float* ln1_b = a.in[14]; const float* w_group = a.in[15]; const float* b_group = a.in[16];
    const float* w_er = a.in[17]; const float* b_er = a.in[18]; const float* w_eg = a.in[19]; const float* w_eu = a.in[20];
    const float* w_ed = a.in[21]; const float* ln2_g = a.in[22]; const float* ln2_b = a.in[23];
    float* out = a.out;
    int* cnt = (int*)(ws + WS_CTL); float2* rope = (float2*)(ws + WS_ROPE); int2* route_e = (int2*)(ws + WS_ROUTE_E); float2* route_w = (float2*)(ws + WS_ROUTE_W); int* list = (int*)(ws + WS_LIST);
    bf16_t* xb = (bf16_t*)(ws + WS_XB); bf16_t* gl = (bf16_t*)(ws + WS_GL); bf16_t* ulru = (bf16_t*)(ws + WS_ULRU); bf16_t* uconv = (bf16_t*)(ws + WS_UCONV);
    bf16_t* epsb = (bf16_t*)(ws + WS_EPS); bf16_t* inp = (bf16_t*)out;
    bf16_t* q = (bf16_t*)(ws + WS_Q); bf16_t* k = (bf16_t*)(ws + WS_K); bf16_t* v = (bf16_t*)(ws + WS_V); bf16_t* gbuf = (bf16_t*)out;
    bf16_t* P = (bf16_t*)(ws + WS_P); bf16_t* gates = (bf16_t*)(ws + WS_GATES); bf16_t* m1 = (bf16_t*)out; bf16_t* merged = xb;
    bf16_t* w_in_t = (bf16_t*)(ws + WS_WIN_T); bf16_t* w_ro_t = (bf16_t*)(ws + WS_WRO_T); bf16_t* w_lo_t = (bf16_t*)(ws + WS_WLO_T); bf16_t* w_out_t = (bf16_t*)(ws + WS_WOUT_T);
    bf16_t* wrg_t = (bf16_t*)(ws + WS_WRG_T); float* segA = (float*)(ws + WS_SEGA); float* segH = (float*)(ws + WS_SEGH); float* carry = (float*)(ws + WS_CARRY);
    float* rsb = (float*)(ws + WS_RSB);
    unsigned char* wgu8 = ws + WS_WGU_T; unsigned char* wd8 = ws + WS_WD_T; unsigned char* x1q = ws + WS_X1Q;
    bf16_t* x1b = gl; bf16_t* hbuf = (bf16_t*)(ws + WS_H); bf16_t* ys = (bf16_t*)(ws + WS_YSLOT);

    { const int t0_ = otid(); p_rope_table(rope, t0_, NTHR); p_router_table(ln1_g, w_group, w_er, ws + WS_RTAB, t0_, NTHR);
      p_weights(ldsf, w_in, w_ret_o, w_lru_o, w_out, w_rg_r, w_rg_i, w_in_t, w_ro_t, w_lo_t, w_out_t, wrg_t, t0_ >> 6, 8, x, xb); }
    __syncthreads();
    p_router_consts(ldsf, ln1_g, ln1_b, w_group, b_group, w_er, b_er, rsb);
    GRID_BAR();
    { pg8::Gemm g{xb, w_in_t + (size_t)C_U * 1024, NTOK, 3072, 1024}; pg8::StaticOrder S; S.init(NTOK, 3072, (int)gridDim.x, (int)blockIdx.x);
      pg8::gemm_phase<pg8::EpiLruIn, pg8::StaticOrder, true, true>(ldsl, g, S, pg8::EpiLruIn{ulru, gl}); }
    GRID_BAR();
    p_lru_compute(lds_raw, ulru, conv_w, conv_b, wrg_t, b_rg_r, b_rg_i, lam, uconv, epsb, segA, segH);
    GRID_BAR();
    p_lru_carry(ldsf, segA, segH, carry);
    GRID_BAR();
    p_lru_scan(uconv, epsb, gl, carry);
    GRID_BAR();
    { pg8::Gemm g{xb, w_in_t, NTOK, 6144, 1024}; pg8::StaticOrder S; S.init(NTOK, 6144, (int)gridDim.x, (int)blockIdx.x);
      pg8::gemm_phase<pg8::EpiRetIn, pg8::StaticOrder, true, true>(ldsl, g, S, pg8::EpiRetIn{q, k, v, gbuf, (const float*)rope}); }
    GRID_BAR();
    p_scores(lds_raw, q, k, P);
    GRID_BAR();
    p_ret_mfma(lds_raw, q, k, v, P);
    GRID_BAR();
    p_headnorm(v, gbuf);
    { pg8::Gemm g{xb, w_in_t + (size_t)C_GATE * 1024, NTOK, 2048, 1024}; pg8::StaticOrder S; S.init(NTOK, 2048, (int)gridDim.x, (int)blockIdx.x);
      pg8::gemm_phase<pg8::EpiGates, pg8::StaticOrder, true, true>(ldsl, g, S, pg8::EpiGates{b_merge, gates}); }
    GRID_BAR();
    { pg8::Gemm g{v, w_ro_t, NTOK, 1024, 2048}; pg8::StaticOrder S; S.init(NTOK, 1024, (int)gridDim.x, (int)blockIdx.x);
      pg8::gemm_phase<pg8::EpiMerge<0>, pg8::StaticOrder, true, true>(ldsl, g, S, pg8::EpiMerge<0>{gates, nullptr, m1}); }
    GRID_BAR();
    { pg8::Gemm g{gl, w_lo_t, NTOK, 1024, 1536}; pg8::StaticOrder S; S.init(NTOK, 1024, (int)gridDim.x, (int)blockIdx.x);
      pg8::gemm_phase<pg8::EpiMerge<1>, pg8::StaticOrder, true, true>(ldsl, g, S, pg8::EpiMerge<1>{gates, m1, merged}); }
    GRID_BAR();
    { pg8::Gemm g{merged, w_out_t, NTOK, 1024, 1024}; pg8::StaticOrder S; S.init(NTOK, 1024, (int)gridDim.x, (int)blockIdx.x);
      pg8::gemm_phase<pg8::EpiOut, pg8::StaticOrder, true, true>(ldsl, g, S, pg8::EpiOut{x, (bf16_t*)out, ALPHA}); }
    GRID_BAR();
    p_ln1_route(ldsf, (const bf16_t*)out, x1b, x1q, ln1_g, ln1_b, ws + WS_RTAB, route_e, route_w, cnt, list, rsb);
    p_expert_weights(ldsf, w_eg, w_eu, w_ed, wgu8, wd8);
    GRID_BAR();
    {
        PG8_LAS pg8::MoeTab* tab = (PG8_LAS pg8::MoeTab*)(ldsl + LDS_TAB);
        pg8::moe_build_tab(tab, cnt);
        const int T = tab->tileStart[32];
        { pg8::Gemm g{(const bf16_t*)x1q, (const bf16_t*)wgu8, T * 256, 32 * 1024, 512}; pg8::MoeOrder<true> S{T * 4, (int)gridDim.x, (int)blockIdx.x, tab, list};
          pg8::gemm_phase<pg8::EpiSwiGLU8, pg8::MoeOrder<true>, true, true, true>(ldsl, g, S, pg8::EpiSwiGLU8{(unsigned char*)hbuf}); }
        GRID_BAR();
        { pg8::Gemm g{hbuf, (const bf16_t*)wd8, T * 256, 32 * 1024, 256}; pg8::MoeOrder<false> S{T * 4, (int)gridDim.x, (int)blockIdx.x, tab, list};
          pg8::gemm_phase<pg8::EpiMoeOut8, pg8::MoeOrder<false>, true, true, true>(ldsl, g, S, pg8::EpiMoeOut8{tab, list, (const float*)route_w, ys}); }
    }
    GRID_BAR();
    p_final(out, x1b, ys, ln2_g, ln2_b);
}

extern "C" void kernel_launch(void* const* d_in, const int* in_sizes, int n_in, void* d_out, int out_size, void* d_ws, size_t ws_size, hipStream_t stream) {
    static int grid = 0;
    if (grid == 0) {
        if (n_in != 24 || in_sizes[0] != NTOK * DM || out_size != NTOK * DM || ws_size < WS_END) {
            fprintf(stderr, "kernel_launch: unexpected shapes (n_in %d, in0 %d, out %d, ws %zu)\n", n_in, n_in > 0 ? in_sizes[0] : -1, out_size, ws_size); grid = -1; return; }
        int dev = 0, cus = 0, per_cu = 0;
        if (hipGetDevice(&dev) != hipSuccess || hipDeviceGetAttribute(&cus, hipDeviceAttributeMultiprocessorCount, dev) != hipSuccess) { fprintf(stderr, "kernel_launch: device query failed\n"); grid = -1; return; }
        if (hipFuncSetAttribute((const void*)mega_fwd, hipFuncAttributeMaxDynamicSharedMemorySize, LDS_BYTES) != hipSuccess) { fprintf(stderr, "kernel_launch: hipFuncSetAttribute failed\n"); grid = -1; return; }
        if (hipOccupancyMaxActiveBlocksPerMultiprocessor(&per_cu, (const void*)mega_fwd, NTHR, LDS_BYTES) != hipSuccess || per_cu < 1) {
            fprintf(stderr, "kernel_launch: occupancy query reports %d workgroups per CU\n", per_cu); (void)hipGetLastError(); grid = -1; return; }
        grid = cus;
    }
    if (grid < 0) return;
    if (hipMemsetAsync((char*)d_ws + WS_CTL, 0, CTL_ZERO_BYTES, stream) != hipSuccess) { fprintf(stderr, "kernel_launch: memset failed\n"); return; }
    Args a{};
    for (int i = 0; i < 24; ++i) a.in[i] = (const float*)d_in[i];
    a.out = (float*)d_out; a.ws = (unsigned char*)d_ws;
    hipLaunchKernelGGL(mega_fwd, dim3(grid), dim3(NTHR), LDS_BYTES, stream, a);
    const hipError_t le = hipPeekAtLastError();
    if (le != hipSuccess) fprintf(stderr, "kernel_launch: launch failed: %s\n", hipGetErrorName(le));
}
```

```cpp
#include <hip/hip_runtime.h>
#include <cstdio>
#include <cstdint>

typedef unsigned short bf16_t;
#define DEV __device__ __forceinline__
#define LAS __attribute__((address_space(3)))

DEV int otid() { int t = threadIdx.x; asm volatile("" : "+v"(t)); return t; }
DEV float bf2f(bf16_t h) { return __uint_as_float(((unsigned)h) << 16); }
typedef short bf16x8_t __attribute__((ext_vector_type(8)));
typedef unsigned u32x4_t __attribute__((ext_vector_type(4)));
DEV bf16_t f2bf(float f) { unsigned u = __float_as_uint(f); return (bf16_t)((u + 0x7fffu + ((u >> 16) & 1u)) >> 16); }

constexpr int NTHR = 512;
constexpr int NTOK = 32768, DM = 1024, SEQ = 8192;
constexpr int WIN_N = 11264;
constexpr int C_Q = 0, C_K = 1024, C_V = 2048, C_G = 4096, C_U = 6144, C_GL = 7680, C_GATE = 9216;
constexpr float ALPHA = 1.189207115002721f;
constexpr float LN_EPS = 1e-5f;
constexpr size_t MiB = 1u << 20;
constexpr size_t WS_CTL = 0;
constexpr size_t CTL_ZERO_BYTES = 1 * MiB;
constexpr int CW_BAR = 4096;
constexpr size_t WS_ROPE = 1 * MiB;
constexpr size_t WS_ROUTE_E = 9 * MiB;
constexpr size_t WS_ROUTE_W = 9 * MiB + 512 * 1024;
constexpr size_t WS_LIST = 10 * MiB;
constexpr size_t WS_WRG_T = 14 * MiB;
constexpr size_t WS_RSB = 15 * MiB + 512 * 1024;
constexpr size_t WS_RTAB = 22 * MiB;
constexpr size_t WS_SEGA = 16 * MiB;
constexpr size_t WS_SEGH = 18 * MiB;
constexpr size_t WS_CARRY = 20 * MiB;
constexpr size_t WS_XB = 32 * MiB;
constexpr size_t WS_GL = 96 * MiB;
constexpr size_t WS_ULRU = 192 * MiB;
constexpr size_t WS_Q = 192 * MiB;
constexpr size_t WS_K = 256 * MiB;
constexpr size_t WS_GATES = 192 * MiB;
constexpr size_t WS_UCONV = 288 * MiB;
constexpr size_t WS_P = 320 * MiB;
constexpr size_t WS_V = 352 * MiB;
constexpr size_t WS_EPS = 384 * MiB;
constexpr size_t WS_H = 192 * MiB;
constexpr size_t WS_YSLOT = 264 * MiB;
constexpr size_t WS_WGU_T = 352 * MiB;
constexpr size_t WS_WD_T = 416 * MiB;
constexpr size_t WS_X1Q = 160 * MiB;
constexpr int LDS_TAB = 131072;
constexpr size_t WS_WIN_T = 480 * MiB;
constexpr size_t WS_WRO_T = 502 * MiB;
constexpr size_t WS_WLO_T = 506 * MiB;
constexpr size_t WS_WOUT_T = 509 * MiB;
constexpr size_t WS_END = 512 * MiB;
constexpr int LDS_BYTES = 163840;
constexpr int LDS_MISC = 163840 - 512;

#define XB_TMO      128
#define XB_XCNT(j)  (256  + 64 * (j))
#define XB_XSUB(j)  (1280 + 64 * (j))
#define XB_XGEN(j)  (2304 + 64 * (j))
#define XB_TOP      3328
#define XB_TOPGEN   3392
#define XCD_BAR_WORDS 3456
#define XB_SPIN_CAP (1u << 22)
DEV unsigned xb_ld(unsigned* p)              { return __hip_atomic_load(p, __ATOMIC_RELAXED, __HIP_MEMORY_SCOPE_AGENT); }
DEV unsigned xb_add(unsigned* p, unsigned v) { return __hip_atomic_fetch_add(p, v, __ATOMIC_RELAXED, __HIP_MEMORY_SCOPE_AGENT); }
DEV unsigned xb_xcc_id() { return (unsigned)__builtin_amdgcn_s_getreg((3 << 11) | 20) & 0xFu; }
#define XB_SPIN(cond, bar) do { unsigned _sp = 0; while (cond) { __builtin_amdgcn_s_sleep(1); \
    if ((++_sp & 255u) == 0u) { if (xb_ld(&(bar)[XB_TMO])) break; if (_sp > XB_SPIN_CAP) { atomicAdd(&(bar)[XB_TMO], 1u); break; } } } } while (0)
struct XcdBarrier { unsigned* bar; unsigned x; volatile LAS unsigned* st; };
DEV XcdBarrier xcd_barrier_post(unsigned* bar, volatile LAS unsigned* st) {
    XcdBarrier b; b.bar = bar; b.x = xb_xcc_id(); b.st = st;
    if (otid() == 0) (void)xb_add(&bar[XB_XCNT(b.x)], 1u);
    return b;
}
DEV void xcd_barrier_complete(unsigned* bar, unsigned x, unsigned& nloc, unsigned& nx) {
    const unsigned G = gridDim.x * gridDim.y * gridDim.z;
    unsigned sum, cnt, mine, sp = 0u;
    for (;;) {
        sum = 0u; cnt = 0u; mine = 0u;
#pragma unroll
        for (unsigned j = 0; j < 16; ++j) { const unsigned c = xb_ld(&bar[XB_XCNT(j)]); sum += c; cnt += (c > 0u) ? 1u : 0u; mine = (j == x) ? c : mine; }
        if (sum == G) break;
        __builtin_amdgcn_s_sleep(1);
        if ((++sp & 255u) == 0u) { if (xb_ld(&bar[XB_TMO])) break; if (sp > XB_SPIN_CAP) { atomicAdd(&bar[XB_TMO], 1u); break; } }
    }
    nloc = mine > 0u ? mine : 1u; nx = cnt > 0u ? cnt : 1u;
}
DEV void xcd_barrier(const XcdBarrier& b) {
    asm volatile("s_waitcnt vmcnt(0)" ::: "memory");
    __syncthreads();
    if (otid() == 0) {
        unsigned* bar = b.bar;
        __builtin_amdgcn_s_waitcnt(0);
        unsigned nloc = b.st[0], nx = b.st[1];
        if (nloc == 0u) { xcd_barrier_complete(bar, b.x, nloc, nx); b.st[0] = nloc; b.st[1] = nx; }
        const unsigned old = xb_add(&bar[XB_XSUB(b.x)], 1u);
        const unsigned gen = old / nloc;
        if (old + 1u == (gen + 1u) * nloc) {
            __builtin_amdgcn_fence(__ATOMIC_RELEASE, "agent");
            asm volatile("s_waitcnt vmcnt(0)" ::: "memory");
            const unsigned og = xb_add(&bar[XB_TOP], 1u);
            const unsigned tg = og / nx;
            if (og + 1u == (tg + 1u) * nx) xb_add(&bar[XB_TOPGEN], 1u);
            else XB_SPIN(xb_ld(&bar[XB_TOPGEN]) == tg, bar);
            __builtin_amdgcn_fence(__ATOMIC_ACQUIRE, "agent");
            xb_add(&bar[XB_XGEN(b.x)], 1u);
            asm volatile("s_waitcnt vmcnt(0)" ::: "memory");
        } else {
            XB_SPIN(xb_ld(&bar[XB_XGEN(b.x)]) == gen, bar);
            __builtin_amdgcn_fence(__ATOMIC_ACQUIRE, "agent");
            asm volatile("s_waitcnt vmcnt(0)" ::: "memory");
        }
    }
    __syncthreads();
}

namespace pg8 {
#define PG8_LAS __attribute__((address_space(3)))
typedef unsigned short bf16_t;
typedef short bf16x8 __attribute__((ext_vector_type(8)));
typedef float f32x4 __attribute__((ext_vector_type(4)));
typedef unsigned u32x4 __attribute__((ext_vector_type(4)));
constexpr int BM = 256, BK = 64, HALF = 128, HTB = HALF * BK * 2  , STAGE_BYTES = 8 * HTB, NXCD = 8, WGM = 8;

__host__ __device__ __forceinline__ int lds_byte(int r, int c) { const int st = (r >> 4) * 2 + (c >> 5), rr = r & 15, cc = c & 31, ob = rr * 64 + cc * 2; return st * 1024 + (ob ^ (((ob >> 9) & 1) << 5)); }
__host__ __device__ __forceinline__ void stage_rc(int b, int& R, int& C) { const int st = b / 1024, sb = b % 1024, swz = sb ^ (((sb >> 9) & 1) << 5); R = (st >> 1) * 16 + swz / 64; C = (st & 1) * 32 + (swz % 64) / 2; }
__host__ __device__ __forceinline__ int perm32(int rho) { const int n = rho >> 4, i = rho & 15; return 8 * (i >> 2) + 4 * n + (i & 3); }

struct Unit { int pm, pn; };
struct Gemm { const bf16_t* A; const bf16_t* Bt; int M, N, K; };

struct StaticOrder {
    int nM, nN, nwg, G, c;
    __host__ __device__ void init(int M, int N, int G_, int c_) { nM = M / BM; nN = N / BM; nwg = nM * nN; G = G_; c = c_; }
    __host__ __device__ bool next(int i, Unit& u) const {
        const long L = (long)i * G + c; if (L >= nwg) return false;
        int wgid = (int)L; { const int q = nwg / NXCD, r = nwg % NXCD, xcd = wgid % NXCD, off = wgid / NXCD; wgid = (xcd < r ? xcd * (q + 1) : r * (q + 1) + (xcd - r) * q) + off; }
        const int nig = WGM * nN, gid = wgid / nig, fm = gid * WGM, gsz = (nM - fm) < WGM ? (nM - fm) : WGM;
        u.pm = fm + ((wgid % nig) % gsz); u.pn = (wgid % nig) / gsz; return true;
    }
    __device__ __forceinline__ void a_ready(const Unit&) const {}
    __device__ __forceinline__ void done(const Unit&) const {}
    __device__ __forceinline__ const char* a_base(const Gemm& g, const Unit& u) const { return (const char*)g.A + (size_t)u.pm * (size_t)(BM * g.K * 2); }
    __device__ __forceinline__ void a_off(const Gemm& g, const Unit&, const int (&R)[2], const int (&C)[2], unsigned (&v)[2][2]) const {
        _Pragma("unroll") for (int hh = 0; hh < 2; ++hh) _Pragma("unroll") for (int i = 0; i < 2; ++i) v[hh][i] = (unsigned)((hh * HALF + R[i]) * g.K + C[i]) * 2u; }
};
typedef __bf16 bf16x2_t __attribute__((ext_vector_type(2)));
typedef float f32x2_t __attribute__((ext_vector_type(2)));
__device__ __forceinline__ unsigned cvt_pk_bf16(float lo, float hi) { f32x2_t v = {lo, hi}; return __builtin_bit_cast(unsigned, __builtin_convertvector(v, bf16x2_t)); }
typedef int i32x4 __attribute__((ext_vector_type(4)));
typedef int i32x8 __attribute__((ext_vector_type(8)));
template <bool MX8> struct Frag { struct A4 { bf16x8 v[4][2]; }; struct B2 { bf16x8 v[2][2]; }; };
template <> struct Frag<true> { struct A4 { i32x8 v[4]; }; struct B2 { i32x8 v[2]; }; };
__device__ __forceinline__ i32x8 ld32(const PG8_LAS unsigned char* p0, const PG8_LAS unsigned char* p1) { const i32x4 a = *(const PG8_LAS i32x4*)p0, b = *(const PG8_LAS i32x4*)p1; return __builtin_shufflevector(a, b, 0, 1, 2, 3, 4, 5, 6, 7); }
template <class Epi, class Sched, bool ALIGN_EPI = false, bool SP2 = false, bool MX8 = false>
__device__ __forceinline__ void gemm_phase(PG8_LAS unsigned char* lds, const Gemm g, const Sched& S, const Epi& E) {
    int tid_ = otid(); asm volatile("" : "+v"(tid_));
    const int tid = tid_, wid = __builtin_amdgcn_readfirstlane(tid >> 6), lane = tid & 63, wr = wid >> 2, wc = wid & 3, fr = lane & 15, fq = lane >> 4;
    const int K = g.K, nt = K / BK;
    unsigned voffB[2], vA[2][2], vN[2][2]; int sR[2], sC[2];
#pragma unroll
    for (int i = 0; i < 2; ++i) { int R, C; stage_rc(tid * 16 + i * 8192, R, C); const int Rb = Epi::PERM ? ((R & ~31) + perm32(R & 31)) : R;
        sR[i] = R; sC[i] = C; voffB[i] = (unsigned)(Rb * K + C) * 2u; }
    const size_t kstep = (size_t)(BK * 2);
    const size_t hstep = (size_t)HALF * K * 2;
    const size_t tstep = 2 * hstep;
    const unsigned ldsw = (unsigned)wid * 1024u;
    const int aoff = lds_byte(wr * 64 + fr, fq * 8), boff = lds_byte(wc * 32 + fr, fq * 8);
#define PG8_SA(b, h) (((b) * 2 + (h)) * HTB)
#define PG8_SB(b, h) ((4 + (b) * 2 + (h)) * HTB)
#define PG8_STAGE(bufoff, gbase, voff) do { _Pragma("unroll") for (int _i = 0; _i < 2; ++_i) \
        __builtin_amdgcn_global_load_lds((const unsigned*)((const char*)(gbase) + (voff)[_i]), (PG8_LAS unsigned*)(lds + (bufoff) + ldsw + _i * 8192), 16, 0, 0); } while (0)
#define PG8_LDA(dst, b, h) do { if constexpr (MX8) { _Pragma("unroll") for (int m = 0; m < 4; ++m) dst.v[m] = ld32(lds + PG8_SA(b, h) + aoff + m * 2048, lds + PG8_SA(b, h) + aoff + m * 2048 + 1024); } \
        else { _Pragma("unroll") for (int m = 0; m < 4; ++m) _Pragma("unroll") for (int k = 0; k < 2; ++k) dst.v[m][k] = *(const PG8_LAS bf16x8*)(lds + PG8_SA(b, h) + aoff + m * 2048 + k * 1024); } } while (0)
#define PG8_LDB(dst, b, h) do { if constexpr (MX8) { _Pragma("unroll") for (int n = 0; n < 2; ++n) dst.v[n] = ld32(lds + PG8_SB(b, h) + boff + n * 2048, lds + PG8_SB(b, h) + boff + n * 2048 + 1024); } \
        else { _Pragma("unroll") for (int n = 0; n < 2; ++n) _Pragma("unroll") for (int k = 0; k < 2; ++k) dst.v[n][k] = *(const PG8_LAS bf16x8*)(lds + PG8_SB(b, h) + boff + n * 2048 + k * 1024); } } while (0)
#define PG8_MMA(ai, bj, At, Bt) do { __builtin_amdgcn_s_setprio(1); \
        if constexpr (MX8) { _Pragma("unroll") for (int m = 0; m < 4; ++m) _Pragma("unroll") for (int n = 0; n < 2; ++n) \
            { acc[ai][bj][m][n] = __builtin_amdgcn_mfma_scale_f32_16x16x128_f8f6f4(Bt.v[n], At.v[m], acc[ai][bj][m][n], 0, 0, 0, 0x7f7f7f7f, 0, 0x7f7f7f7f); asm volatile("" : "+v"(acc[ai][bj][m][n])); } } \
        else { _Pragma("unroll") for (int m = 0; m < 4; ++m) _Pragma("unroll") for (int n = 0; n < 2; ++n) _Pragma("unroll") for (int k = 0; k < 2; ++k) \
            acc[ai][bj][m][n] = __builtin_amdgcn_mfma_f32_16x16x32_bf16(Bt.v[n][k], At.v[m][k], acc[ai][bj][m][n], 0, 0, 0); } \
        __builtin_amdgcn_s_setprio(0); } while (0)
#define PG8_WAIT_V(n) asm volatile("s_waitcnt vmcnt(" #n ")" ::: "memory")
#define PG8_WAIT_L(n) asm volatile("s_waitcnt lgkmcnt(" #n ")" ::: "memory")
#define PG8_BAR __builtin_amdgcn_s_barrier()
#define PG8_SCHED __builtin_amdgcn_sched_barrier(0)
    Unit cur, nxt; int ui = 0;
    if (!S.next(0, cur)) return;
    f32x4 acc[2][2][4][2];
#pragma unroll
    for (int a = 0; a < 2; ++a)
#pragma unroll
        for (int b = 0; b < 2; ++b)
#pragma unroll
            for (int m = 0; m < 4; ++m)
#pragma unroll
                for (int n = 0; n < 2; ++n) acc[a][b][m][n] = (f32x4){0.f, 0.f, 0.f, 0.f};
    typename Frag<MX8>::A4 At; typename Frag<MX8>::B2 B0, B1;
    const char* cA = S.a_base(g, cur); const char* cB = (const char*)g.Bt + (size_t)cur.pn * tstep;
    S.a_ready(cur); S.a_off(g, cur, sR, sC, vA);
    if constexpr (SP2) {
        PG8_STAGE(PG8_SB(0, 0), cB, voffB); PG8_STAGE(PG8_SB(0, 1), cB + hstep, voffB); PG8_STAGE(PG8_SA(0, 0), cA, vA[0]); PG8_STAGE(PG8_SA(0, 1), cA, vA[1]);
        if (wr == 1) PG8_BAR;
        PG8_WAIT_V(2); PG8_BAR;
        PG8_STAGE(PG8_SB(1, 0), cB + kstep, voffB); PG8_STAGE(PG8_SA(1, 0), cA + kstep, vA[0]); PG8_STAGE(PG8_SB(1, 1), cB + hstep + kstep, voffB);
        PG8_WAIT_V(6); PG8_BAR;
    } else { static_assert(SP2, "only the SP2 K-loop is kept in this file"); }
    for (;;) {
        const bool has_next = S.next(ui + 1, nxt);
        const char* nA = has_next ? S.a_base(g, nxt) : cA; const char* nB = has_next ? (const char*)g.Bt + (size_t)nxt.pn * tstep : cB;
        if (has_next) S.a_off(g, nxt, sR, sC, vN); else { vN[0][0] = vA[0][0]; vN[0][1] = vA[0][1]; vN[1][0] = vA[1][0]; vN[1][1] = vA[1][1]; }
#pragma unroll 1
        for (int t = 0; t < nt; t += 2) {
            const bool last = (t == nt - 2);
            const char* a1 = cA + (size_t)(t + 1) * kstep;
            const char* a2 = last ? nA : cA + (size_t)(t + 2) * kstep; const char* b2 = last ? nB : cB + (size_t)(t + 2) * kstep;
            const char* a3 = a2 + kstep; const char* b3 = b2 + kstep;
            unsigned v2[2][2]; v2[0][0] = last ? vN[0][0] : vA[0][0]; v2[0][1] = last ? vN[0][1] : vA[0][1]; v2[1][0] = last ? vN[1][0] : vA[1][0]; v2[1][1] = last ? vN[1][1] : vA[1][1];
            if (last && has_next) S.a_ready(nxt);
            if constexpr (SP2) {
            PG8_LDB(B0, 0, 0); PG8_LDB(B1, 0, 1); PG8_SCHED; PG8_LDA(At, 0, 0); PG8_STAGE(PG8_SA(1, 1), a1, vA[1]);
            PG8_WAIT_V(8); PG8_WAIT_L(0); PG8_BAR; PG8_MMA(0, 0, At, B0); PG8_MMA(0, 1, At, B1); PG8_BAR; PG8_SCHED;
            PG8_LDA(At, 0, 1); PG8_STAGE(PG8_SB(0, 0), b2, voffB); PG8_STAGE(PG8_SB(0, 1), b2 + hstep, voffB); PG8_STAGE(PG8_SA(0, 0), a2, v2[0]);
            PG8_WAIT_V(8); PG8_WAIT_L(0); PG8_BAR; PG8_MMA(1, 0, At, B0); PG8_MMA(1, 1, At, B1); PG8_BAR; PG8_SCHED;
            PG8_LDB(B0, 1, 0); PG8_LDB(B1, 1, 1); PG8_SCHED; PG8_LDA(At, 1, 0); PG8_STAGE(PG8_SA(0, 1), a2, v2[1]);
            PG8_WAIT_V(8); PG8_WAIT_L(0); PG8_BAR; PG8_MMA(0, 0, At, B0); PG8_MMA(0, 1, At, B1); PG8_BAR; PG8_SCHED;
            PG8_LDA(At, 1, 1); PG8_STAGE(PG8_SB(1, 0), b3, voffB); PG8_STAGE(PG8_SB(1, 1), b3 + hstep, voffB); PG8_STAGE(PG8_SA(1, 0), a3, v2[0]);
            PG8_WAIT_V(8); PG8_WAIT_L(0); PG8_BAR; PG8_MMA(1, 0, At, B0); PG8_MMA(1, 1, At, B1); PG8_BAR; PG8_SCHED;
            }
        }
        if constexpr (ALIGN_EPI) { if (wr == 0) PG8_BAR; }
        if constexpr (!Epi::AFTER_DRAIN) { E(acc, cur, wr, wc, fr, fq); S.done(cur); }
        if (!has_next) break;
#pragma unroll
        for (int a = 0; a < 2; ++a)
#pragma unroll
            for (int b = 0; b < 2; ++b)
#pragma unroll
                for (int m = 0; m < 4; ++m)
#pragma unroll
                    for (int n = 0; n < 2; ++n) acc[a][b][m][n] = (f32x4){0.f, 0.f, 0.f, 0.f};
        cur = nxt; cA = nA; cB = nB; ++ui; vA[0][0] = vN[0][0]; vA[0][1] = vN[0][1]; vA[1][0] = vN[1][0]; vA[1][1] = vN[1][1];
        if constexpr (ALIGN_EPI) { if (wr == 1) PG8_BAR; }
    }
    PG8_WAIT_V(0);
    if constexpr (!ALIGN_EPI) { if (wr == 0) PG8_BAR; }
    PG8_BAR;
    if constexpr (Epi::AFTER_DRAIN) { E.fused(acc, cur, wr, wc, fr, fq, lds, wid, lane); S.done(cur); }
#undef PG8_SA
#undef PG8_SB
#undef PG8_STAGE
#undef PG8_LDA
#undef PG8_LDB
#undef PG8_MMA
#undef PG8_WAIT_V
#undef PG8_WAIT_L
#undef PG8_BAR
#undef PG8_SCHED
}

__device__ __forceinline__ float fsig(float x) { return __builtin_amdgcn_rcpf(1.f + __expf(-x)); }
__device__ __forceinline__ float fsilu(float x) { return x * fsig(x); }
__device__ __forceinline__ float fgelu(float x) { return x * fsig(1.5957691216057308f * (x + 0.044715f * x * x * x)); }
__device__ __forceinline__ u32x4 pack8(const f32x4& v0, const f32x4& v1) { u32x4 w; w.x = cvt_pk_bf16(v0[0], v0[1]); w.y = cvt_pk_bf16(v0[2], v0[3]); w.z = cvt_pk_bf16(v1[0], v1[1]); w.w = cvt_pk_bf16(v1[2], v1[3]); return w; }
__device__ __forceinline__ void unpack8(const u32x4& w, f32x4& v0, f32x4& v1) {
    v0[0] = __uint_as_float(w.x << 16); v0[1] = __uint_as_float(w.x & 0xffff0000u); v0[2] = __uint_as_float(w.y << 16); v0[3] = __uint_as_float(w.y & 0xffff0000u);
    v1[0] = __uint_as_float(w.z << 16); v1[1] = __uint_as_float(w.z & 0xffff0000u); v1[2] = __uint_as_float(w.w << 16); v1[3] = __uint_as_float(w.w & 0xffff0000u); }

struct EpiLruIn {
    static constexpr bool PERM = true, AFTER_DRAIN = false;
    bf16_t* u; bf16_t* gl;
    __device__ __forceinline__ void operator()(const f32x4 (&acc)[2][2][4][2], const Unit& un, int wr, int wc, int fr, int fq) const {
        const int row0 = un.pm * BM + wr * 64 + fr; const bool isg = un.pn >= 6;
        bf16_t* base = (isg ? gl : u) + (isg ? un.pn - 6 : un.pn) * BM + wc * 32 + 8 * fq;
#pragma unroll
        for (int ai = 0; ai < 2; ++ai)
#pragma unroll
            for (int m = 0; m < 4; ++m) { bf16_t* rowp = base + (size_t)(row0 + ai * HALF + m * 16) * 1536;
#pragma unroll
                for (int bj = 0; bj < 2; ++bj) { f32x4 v0 = acc[ai][bj][m][0], v1 = acc[ai][bj][m][1];
                    if (isg) {
#pragma unroll
                        for (int e = 0; e < 4; ++e) { v0[e] = fgelu(v0[e]); v1[e] = fgelu(v1[e]); } }
                    *(u32x4*)(rowp + bj * HALF) = pack8(v0, v1); } }
    }
};
__device__ __forceinline__ float clamp448(float v) { return fminf(fmaxf(v, -448.f), 448.f); }
__device__ __forceinline__ unsigned pk4_fp8(float a, float b, float c, float d) { int p = __builtin_amdgcn_cvt_pk_fp8_f32(clamp448(a), clamp448(b), 0, false); p = __builtin_amdgcn_cvt_pk_fp8_f32(clamp448(c), clamp448(d), p, true); return (unsigned)p; }
struct EpiRetIn {
    static constexpr bool PERM = true, AFTER_DRAIN = false;
    bf16_t* q; bf16_t* k; bf16_t* v; bf16_t* g; const float* rope;
    __device__ __forceinline__ void operator()(const f32x4 (&acc)[2][2][4][2], const Unit& un, int wr, int wc, int fr, int fq) const {
        const int row0 = un.pm * BM + wr * 64 + fr;
        if (un.pn < 8) {
            const bool isk = un.pn >= 4; const int h = un.pn & 3;
            const float lg = __log2f(1.f - __builtin_amdgcn_exp2f(-5.f - (float)h));
            const int jb = wc * 32 + 8 * fq;
            bf16_t* base = (isk ? k : q) + h * 256 + jb;
#pragma unroll
            for (int ai = 0; ai < 2; ++ai)
#pragma unroll
                for (int m = 0; m < 4; ++m) { const int r = row0 + ai * HALF + m * 16, s = r & 8191, n = s & 127;
                    const float sc = isk ? __builtin_amdgcn_exp2f(-(float)n * lg) * 0.0625f : __builtin_amdgcn_exp2f((float)n * lg) * 64.f;
                    const f32x4* tp = (const f32x4*)(rope + ((size_t)s * 128 + jb) * 2);
                    f32x4 o1[2], o2[2];
#pragma unroll
                    for (int nn = 0; nn < 2; ++nn) { const f32x4 ta = tp[2 * nn], tb = tp[2 * nn + 1]; const f32x4 a = acc[ai][0][m][nn], b = acc[ai][1][m][nn];
                        o1[nn][0] = (a[0] * ta[0] - b[0] * ta[1]) * sc; o2[nn][0] = (a[0] * ta[1] + b[0] * ta[0]) * sc;
                        o1[nn][1] = (a[1] * ta[2] - b[1] * ta[3]) * sc; o2[nn][1] = (a[1] * ta[3] + b[1] * ta[2]) * sc;
                        o1[nn][2] = (a[2] * tb[0] - b[2] * tb[1]) * sc; o2[nn][2] = (a[2] * tb[1] + b[2] * tb[0]) * sc;
                        o1[nn][3] = (a[3] * tb[2] - b[3] * tb[3]) * sc; o2[nn][3] = (a[3] * tb[3] + b[3] * tb[2]) * sc; }
                    if (isk) { bf16_t* rowp = base + (size_t)r * 1024; *(u32x4*)(rowp) = pack8(o1[0], o1[1]); *(u32x4*)(rowp + HALF) = pack8(o2[0], o2[1]); }
                    else { unsigned char* qb = (unsigned char*)q + ((size_t)(r >> 7) * 4 + h) * 32768 + (size_t)(((wc >> 1) * 4 + fq) * 128 + n) * 16 + (wc & 1) * 8;
                        uint2 a, b; a.x = pk4_fp8(o1[0][0], o1[0][1], o1[0][2], o1[0][3]); a.y = pk4_fp8(o1[1][0], o1[1][1], o1[1][2], o1[1][3]);
                        b.x = pk4_fp8(o2[0][0], o2[0][1], o2[0][2], o2[0][3]); b.y = pk4_fp8(o2[1][0], o2[1][1], o2[1][2], o2[1][3]);
                        *(uint2*)qb = a; *(uint2*)(qb + 16384) = b; }
                    asm volatile("" ::: "memory"); }
        } else {
            const bool isg = un.pn >= 16;
            bf16_t* base = (isg ? g : v) + ((un.pn - 8) & 7) * BM + wc * 32 + 8 * fq;
#pragma unroll
            for (int ai = 0; ai < 2; ++ai)
#pragma unroll
                for (int m = 0; m < 4; ++m) { bf16_t* rowp = base + (size_t)(row0 + ai * HALF + m * 16) * 2048;
#pragma unroll
                    for (int bj = 0; bj < 2; ++bj) { f32x4 v0 = acc[ai][bj][m][0], v1 = acc[ai][bj][m][1];
                        if (isg) {
#pragma unroll
                            for (int e = 0; e < 4; ++e) { v0[e] = fsilu(v0[e]); v1[e] = fsilu(v1[e]); } }
                        *(u32x4*)(rowp + bj * HALF) = pack8(v0, v1); } }
        }
    }
};
struct EpiGates {
    static constexpr bool PERM = true, AFTER_DRAIN = false;
    const float* bm; bf16_t* gates;
    __device__ __forceinline__ void operator()(const f32x4 (&acc)[2][2][4][2], const Unit& un, int wr, int wc, int fr, int fq) const {
        const int row0 = un.pm * BM + wr * 64 + fr, col0 = un.pn * BM + wc * 32 + 8 * fq;
        f32x4 bv[2][2];
#pragma unroll
        for (int bj = 0; bj < 2; ++bj)
#pragma unroll
            for (int n = 0; n < 2; ++n) bv[bj][n] = *(const f32x4*)(bm + col0 + bj * HALF + 4 * n);
#pragma unroll
        for (int ai = 0; ai < 2; ++ai)
#pragma unroll
            for (int m = 0; m < 4; ++m) { bf16_t* rowp = gates + (size_t)(row0 + ai * HALF + m * 16) * 2048 + col0;
#pragma unroll
                for (int bj = 0; bj < 2; ++bj) { f32x4 v0 = acc[ai][bj][m][0] + bv[bj][0], v1 = acc[ai][bj][m][1] + bv[bj][1];
#pragma unroll
                    for (int e = 0; e < 4; ++e) { v0[e] = fsig(v0[e]); v1[e] = fsig(v1[e]); }
                    *(u32x4*)(rowp + bj * HALF) = pack8(v0, v1); } }
    }
};
template <int MODE> struct EpiMerge {
    static constexpr bool PERM = true, AFTER_DRAIN = false;
    const bf16_t* gates; const bf16_t* m1in; bf16_t* o;
    __device__ __forceinline__ void operator()(const f32x4 (&acc)[2][2][4][2], const Unit& un, int wr, int wc, int fr, int fq) const {
        const int row0 = un.pm * BM + wr * 64 + fr, col0 = un.pn * BM + wc * 32 + 8 * fq;
#pragma unroll
        for (int ai = 0; ai < 2; ++ai)
#pragma unroll
            for (int m = 0; m < 4; ++m) { const size_t r = (size_t)(row0 + ai * HALF + m * 16);
#pragma unroll
                for (int bj = 0; bj < 2; ++bj) { const int c = col0 + bj * HALF;
                    f32x4 g0, g1; unpack8(*(const u32x4*)(gates + r * 2048 + MODE * 1024 + c), g0, g1);
                    f32x4 v0 = acc[ai][bj][m][0] * g0, v1 = acc[ai][bj][m][1] * g1;
                    if (MODE == 1) { f32x4 p0, p1; unpack8(*(const u32x4*)(m1in + r * 1024 + c), p0, p1); v0 += p0; v1 += p1; }
                    *(u32x4*)(o + r * 1024 + c) = pack8(v0, v1); } }
    }
};
struct EpiOut {
    static constexpr bool PERM = true, AFTER_DRAIN = false;
    const float* x; bf16_t* y; float alpha;
    __device__ __forceinline__ void operator()(const f32x4 (&acc)[2][2][4][2], const Unit& un, int wr, int wc, int fr, int fq) const {
        const int row0 = un.pm * BM + wr * 64 + fr, col0 = un.pn * BM + wc * 32 + 8 * fq;
#pragma unroll
        for (int ai = 0; ai < 2; ++ai)
#pragma unroll
            for (int m = 0; m < 4; ++m) { const size_t off = (size_t)(row0 + ai * HALF + m * 16) * 1024 + col0;
#pragma unroll
                for (int bj = 0; bj < 2; ++bj) { const f32x4 x0 = *(const f32x4*)(x + off + bj * HALF), x1 = *(const f32x4*)(x + off + bj * HALF + 4);
                    *(u32x4*)(y + off + bj * HALF) = pack8(x0 * alpha + acc[ai][bj][m][0], x1 * alpha + acc[ai][bj][m][1]); } }
    }
};
struct MoeTab { int tileStart[33]; int cnt[32]; int pad_[3]; int tileExp[320]; };
__device__ __forceinline__ void moe_build_tab(PG8_LAS MoeTab* tab, const int* cnt) {
    if (otid() == 0) { int t = 0; for (int e = 0; e < 32; ++e) { const int c = cnt[e * 64], nt = (c + 255) >> 8; tab->tileStart[e] = t; tab->cnt[e] = c; for (int i = 0; i < nt; ++i) tab->tileExp[t + i] = e; t += nt; } tab->tileStart[32] = t; }
    __syncthreads();
}
template <bool GATHER> struct MoeOrder {
    int U, G, c; const PG8_LAS MoeTab* tab; const int* list;
    __device__ __forceinline__ bool next(int i, Unit& u) const {
        const long L = (long)i * G + c; if (L >= U) return false;
        int wgid = (int)L; { const int q = U / NXCD, r = U % NXCD, xcd = wgid % NXCD, off = wgid / NXCD; wgid = (xcd < r ? xcd * (q + 1) : r * (q + 1) + (xcd - r) * q) + off; }
        u.pm = wgid >> 2; u.pn = tab->tileExp[u.pm] * 4 + (wgid & 3); return true;
    }
    __device__ __forceinline__ void a_ready(const Unit&) const {}
    __device__ __forceinline__ void done(const Unit&) const {}
    __device__ __forceinline__ const char* a_base(const Gemm& g, const Unit& u) const { return GATHER ? (const char*)g.A : (const char*)g.A + (size_t)u.pm * (size_t)(BM * g.K * 2); }
    __device__ __forceinline__ void a_off(const Gemm& g, const Unit& u, const int (&R)[2], const int (&C)[2], unsigned (&v)[2][2]) const {
        if (!GATHER) { _Pragma("unroll") for (int hh = 0; hh < 2; ++hh) _Pragma("unroll") for (int i = 0; i < 2; ++i) v[hh][i] = (unsigned)((hh * HALF + R[i]) * g.K + C[i]) * 2u; }
        else { const int e = u.pn >> 2, base = (u.pm - tab->tileStart[e]) * BM, ce = tab->cnt[e];
            _Pragma("unroll") for (int hh = 0; hh < 2; ++hh) _Pragma("unroll") for (int i = 0; i < 2; ++i) { const int lr = base + hh * HALF + R[i]; const int tok = (lr < ce) ? (list[e * 32768 + lr] >> 1) : 0; v[hh][i] = (unsigned)(tok * g.K + C[i]) * 2u; } }
    }
};
struct EpiSwiGLU {
    static constexpr bool PERM = true, AFTER_DRAIN = false;
    bf16_t* h;
    __device__ __forceinline__ void operator()(const f32x4 (&acc)[2][2][4][2], const Unit& un, int wr, int wc, int fr, int fq) const {
        const int row0 = un.pm * BM + wr * 64 + fr, col0 = (un.pn & 3) * 128 + wc * 32 + 8 * fq;
#pragma unroll
        for (int ai = 0; ai < 2; ++ai)
#pragma unroll
            for (int m = 0; m < 4; ++m) { f32x4 v0, v1;
#pragma unroll
                for (int e = 0; e < 4; ++e) { v0[e] = fsilu(acc[ai][0][m][0][e]) * acc[ai][1][m][0][e]; v1[e] = fsilu(acc[ai][0][m][1][e]) * acc[ai][1][m][1][e]; }
                *(u32x4*)(h + (size_t)(row0 + ai * HALF + m * 16) * 512 + col0) = pack8(v0, v1); }
    }
};
struct EpiMoeOut {
    static constexpr bool PERM = true, AFTER_DRAIN = false;
    const PG8_LAS MoeTab* tab; const int* list; const float* rw; bf16_t* ys;
    __device__ __forceinline__ void operator()(const f32x4 (&acc)[2][2][4][2], const Unit& un, int wr, int wc, int fr, int fq) const {
        const int e = un.pn >> 2, lrow0 = (un.pm - tab->tileStart[e]) * BM + wr * 64 + fr, ce = tab->cnt[e], col0 = (un.pn & 3) * BM + wc * 32 + 8 * fq;
        int slot[8]; float wgt[8];
#pragma unroll
        for (int i = 0; i < 8; ++i) { const int lr = lrow0 + (i >> 2) * HALF + (i & 3) * 16; slot[i] = (lr < ce) ? list[e * 32768 + lr] : -1; }
#pragma unroll
        for (int i = 0; i < 8; ++i) wgt[i] = (slot[i] >= 0) ? rw[slot[i]] : 0.f;
#pragma unroll
        for (int ai = 0; ai < 2; ++ai)
#pragma unroll
            for (int m = 0; m < 4; ++m) { const int i = ai * 4 + m;
                if (slot[i] >= 0) { const float w = wgt[i]; bf16_t* rowp = ys + (size_t)slot[i] * 1024 + col0;
#pragma unroll
                    for (int bj = 0; bj < 2; ++bj) *(u32x4*)(rowp + bj * HALF) = pack8(acc[ai][bj][m][0] * w, acc[ai][bj][m][1] * w); } }
    }
};

constexpr float FP8_SX = 4.f, FP8_SW = 64.f, FP8_SH = 8.f;
struct EpiSwiGLU8 {
    static constexpr bool PERM = true, AFTER_DRAIN = false;
    unsigned char* h;
    __device__ __forceinline__ void operator()(const f32x4 (&acc)[2][2][4][2], const Unit& un, int wr, int wc, int fr, int fq) const {
        const int row0 = un.pm * BM + wr * 64 + fr, col0 = (un.pn & 3) * 128 + wc * 32 + 8 * fq; const float ds = 1.f / (FP8_SX * FP8_SW);
#pragma unroll
        for (int ai = 0; ai < 2; ++ai)
#pragma unroll
            for (int m = 0; m < 4; ++m) { float v[8];
#pragma unroll
                for (int e = 0; e < 4; ++e) { v[e] = FP8_SH * fsilu(acc[ai][0][m][0][e] * ds) * (acc[ai][1][m][0][e] * ds); v[4 + e] = FP8_SH * fsilu(acc[ai][0][m][1][e] * ds) * (acc[ai][1][m][1][e] * ds); }
                uint2 o; o.x = pk4_fp8(v[0], v[1], v[2], v[3]); o.y = pk4_fp8(v[4], v[5], v[6], v[7]);
                *(uint2*)(h + (size_t)(row0 + ai * HALF + m * 16) * 512 + col0) = o; }
    }
};
struct EpiMoeOut8 {
    static constexpr bool PERM = true, AFTER_DRAIN = false;
    const PG8_LAS MoeTab* tab; const int* list; const float* rw; bf16_t* ys;
    __device__ __forceinline__ void operator()(const f32x4 (&acc)[2][2][4][2], const Unit& un, int wr, int wc, int fr, int fq) const {
        const int e = un.pn >> 2, lrow0 = (un.pm - tab->tileStart[e]) * BM + wr * 64 + fr, ce = tab->cnt[e], col0 = (un.pn & 3) * BM + wc * 32 + 8 * fq;
#pragma unroll
        for (int ai = 0; ai < 2; ++ai)
#pragma unroll
            for (int m = 0; m < 4; ++m) { const int lr = lrow0 + ai * HALF + m * 16;
                if (lr < ce) { const int slot = list[e * 32768 + lr]; const float w = rw[slot] * (1.f / (FP8_SH * FP8_SW)); bf16_t* rowp = ys + (size_t)slot * 1024 + col0;
#pragma unroll
                    for (int bj = 0; bj < 2; ++bj) *(u32x4*)(rowp + bj * HALF) = pack8(acc[ai][bj][m][0] * w, acc[ai][bj][m][1] * w); }
                asm volatile("" ::: "memory"); }
    }
};
}

DEV unsigned pk2(float lo, float hi) { return (unsigned)f2bf(lo) | ((unsigned)f2bf(hi) << 16); }
typedef unsigned v4u __attribute__((ext_vector_type(4)));
DEV void tr_load(const float* W, int N, int item, int lane, float (&wv)[32]) {
    const int nblk = N / 32, kb = item / nblk, nb = item % nblk, k0 = 64 * kb, n0 = 32 * nb;
#pragma unroll
    for (int i = 0; i < 32; ++i) wv[i] = W[(size_t)(k0 + 2 * i + (lane >> 5)) * N + n0 + (lane & 31)];
}
DEV void tr_store(const float (&wv)[32], int K, int N, bf16_t* WT, float* scr, int item, int lane, bool gatefrag) {
    const int nblk = N / 32, kb = item / nblk, nb = item % nblk, k0 = 64 * kb, n0 = 32 * nb;
#pragma unroll
    for (int i = 0; i < 32; ++i) scr[(2 * i + (lane >> 5)) * 33 + (lane & 31)] = wv[i];
    asm volatile("s_waitcnt lgkmcnt(0)" ::: "memory");
    const int c = lane & 7;
#pragma unroll
    for (int j = 0; j < 4; ++j) { const int n = (lane >> 3) + 8 * j; const float* s = scr + (8 * c) * 33 + n;
        v4u o; o.x = pk2(s[0 * 33], s[1 * 33]); o.y = pk2(s[2 * 33], s[3 * 33]); o.z = pk2(s[4 * 33], s[5 * 33]); o.w = pk2(s[6 * 33], s[7 * 33]);
        const int oc = n0 + n, kk = k0 + 8 * c;
        const size_t off = gatefrag ? (size_t)((((oc / 48) * 3 + (oc % 48) / 16) * 6 + (kk >> 5)) * 64 + ((kk >> 3) & 3) * 16 + (oc & 15)) * 8 : (size_t)oc * K + kk;
        *(v4u*)(WT + off) = o; }
    asm volatile("s_waitcnt lgkmcnt(0)" ::: "memory");
}
DEV void tr_store_fp8(const float (&wv)[32], int K, int N, unsigned char* WT, int row_off, float scale, float* scr, int item, int lane) {
    const int nblk = N / 32, kb = item / nblk, nb = item % nblk, k0 = 64 * kb, n0 = 32 * nb;
#pragma unroll
    for (int i = 0; i < 32; ++i) scr[(2 * i + (lane >> 5)) * 33 + (lane & 31)] = wv[i] * scale;
    asm volatile("s_waitcnt lgkmcnt(0)" ::: "memory");
    const int c = lane & 3;
#pragma unroll
    for (int j = 0; j < 2; ++j) { const int n = (lane >> 2) + 16 * j; const float* s = scr + (16 * c) * 33 + n;
        v4u o; o.x = pg8::pk4_fp8(s[0 * 33], s[1 * 33], s[2 * 33], s[3 * 33]); o.y = pg8::pk4_fp8(s[4 * 33], s[5 * 33], s[6 * 33], s[7 * 33]);
        o.z = pg8::pk4_fp8(s[8 * 33], s[9 * 33], s[10 * 33], s[11 * 33]); o.w = pg8::pk4_fp8(s[12 * 33], s[13 * 33], s[14 * 33], s[15 * 33]);
        *(v4u*)(WT + (size_t)(row_off + n0 + n) * K + k0 + 16 * c) = o; }
    asm volatile("s_waitcnt lgkmcnt(0)" ::: "memory");
}
DEV void p_weights(float* lds, const float* w_in, const float* w_ret_o, const float* w_lru_o, const float* w_out, const float* w_rg_r, const float* w_rg_i, bf16_t* w_in_t, bf16_t* w_ro_t, bf16_t* w_lo_t, bf16_t* w_out_t, bf16_t* wrg_t, int wave, int nwaves, const float* x, bf16_t* xb) {
    const int lane = otid() & 63;
    float* scr = lds + wave * 2304;
    constexpr int I0 = 16 * (WIN_N / 32), I1 = 32 * 32, I2 = 24 * 32, I3 = 16 * 32, I4 = 16 * 18, NIT = I0 + I1 + I2 + I3 + I4;
#define PW_DECODE(it_, W_, WT_, K_, N_, sub_, gf_) const float* W_; bf16_t* WT_; int K_, N_, sub_; bool gf_ = false; { int r_ = (it_); \
        if (r_ < I0) { W_ = w_in; WT_ = w_in_t; K_ = 1024; N_ = WIN_N; sub_ = r_; } \
        else if ((r_ -= I0) < I1) { W_ = w_ret_o; WT_ = w_ro_t; K_ = 2048; N_ = 1024; sub_ = r_; } \
        else if ((r_ -= I1) < I2) { W_ = w_lru_o; WT_ = w_lo_t; K_ = 1536; N_ = 1024; sub_ = r_; } \
        else if ((r_ -= I2) < I3) { W_ = w_out; WT_ = w_out_t; K_ = 1024; N_ = 1024; sub_ = r_; } \
        else { r_ -= I3; const int mi_ = r_ / 18; W_ = (mi_ < 8 ? w_rg_r + (size_t)mi_ * 192 * 192 : w_rg_i + (size_t)(mi_ - 8) * 192 * 192); WT_ = wrg_t + (size_t)mi_ * 192 * 192; K_ = 192; N_ = 192; sub_ = r_ - mi_ * 18; gf_ = true; } }
    const int step = gridDim.x * nwaves;
    int it = blockIdx.x * nwaves + wave;
    float wv[32], wn[32];
    const size_t n4 = (size_t)NTOK * DM / 4, cstride = (size_t)gridDim.x * NTHR;
    size_t ci = (size_t)blockIdx.x * NTHR + wave * 64 + lane;
    if (it < NIT) { PW_DECODE(it, W0, T0, K0, N0, s0, g0); (void)T0; (void)K0; (void)g0; tr_load(W0, N0, s0, lane, wv); }
    for (; it < NIT || ci < n4; it += step) {
        const int nx = it + step;
        if (nx < NIT) { PW_DECODE(nx, W1, T1, K1, N1, s1, g1); (void)T1; (void)K1; (void)g1; tr_load(W1, N1, s1, lane, wn); }
        if (ci < n4) {
            float4 t[16];
#pragma unroll
            for (int u = 0; u < 16; ++u) { const size_t i = ci + u * cstride; t[u] = (i < n4) ? ((const float4*)x)[i] : make_float4(0.f, 0.f, 0.f, 0.f); }
#pragma unroll
            for (int u = 0; u < 16; ++u) { const size_t i = ci + u * cstride; if (i < n4) { uint2 o; o.x = pg8::cvt_pk_bf16(t[u].x, t[u].y); o.y = pg8::cvt_pk_bf16(t[u].z, t[u].w); ((uint2*)xb)[i] = o; } }
            ci += 16 * cstride;
        }
        if (it < NIT) { PW_DECODE(it, W2, T2, K2, N2, s2, g2); (void)W2; tr_store(wv, K2, N2, T2, scr, s2, lane, g2); }
#pragma unroll
        for (int i = 0; i < 32; ++i) wv[i] = wn[i];
    }
#undef PW_DECODE
}
DEV void p_expert_weights(float* lds, const float* w_eg, const float* w_eu, const float* w_ed, unsigned char* wgu8, unsigned char* wd8) {
    const int wave = otid() >> 6, lane = otid() & 63;
    float* scr = lds + wave * 2304;
#define EW_SRC(it_) ((((it_) >> 13) == 0 ? w_eg : ((it_) >> 13) == 1 ? w_eu : w_ed) + (size_t)(((it_) & 8191) >> 8) * 1024 * 512)
    const int step = gridDim.x * 8;
    int it = blockIdx.x * 8 + wave;
    float wv[32], wn[32];
    if (it < 3 * 8192) tr_load(EW_SRC(it), (it >> 13) < 2 ? 512 : 1024, it & 255, lane, wv);
    for (; it < 3 * 8192; it += step) {
        const int nx = it + step;
        if (nx < 3 * 8192) tr_load(EW_SRC(nx), (nx >> 13) < 2 ? 512 : 1024, nx & 255, lane, wn);
        const int kind = it >> 13, e = (it & 8191) >> 8, sub = it & 255;
        if (kind < 2) { const int nb = sub & 15; tr_store_fp8(wv, 1024, 512, wgu8 + (size_t)e * 1024 * 1024, (nb >> 2) * 128 + kind * 128, pg8::FP8_SW, scr, sub, lane); }
        else tr_store_fp8(wv, 512, 1024, wd8 + (size_t)e * 1024 * 512, 0, pg8::FP8_SW, scr, sub, lane);
#pragma unroll
        for (int i = 0; i < 32; ++i) wv[i] = wn[i];
    }
#undef EW_SRC
}

DEV void p_router_table(const float* g1, const float* wg, const float* we, unsigned char* rtab, int tg, int nthr) {
    for (int p = (gridDim.x - 1 - blockIdx.x) * nthr + tg; p < 9216; p += gridDim.x * nthr) {
        int T, part, kq, stride; const float* srcp;
        if (p < 8192) { const int col = p & 15, nt = (p >> 6) & 1; kq = (p >> 4) & 3; part = (p >> 7) & 1; T = p >> 8; srcp = we + 16 * nt + col; stride = 32; }
        else { const int p2 = p - 8192, col = p2 & 3; kq = (p2 >> 2) & 3; part = (p2 >> 4) & 1; T = p2 >> 5; srcp = wg + col; stride = 4; }
        const int k0 = 32 * T + 8 * kq;
        unsigned o[4];
#pragma unroll
        for (int j2 = 0; j2 < 4; ++j2) { unsigned pr = 0;
#pragma unroll
            for (int e = 0; e < 2; ++e) { const int kk = k0 + 2 * j2 + e; const float wv_ = g1[kk] * srcp[(size_t)kk * stride];
                const bf16_t hi = f2bf(wv_); const bf16_t val = part ? f2bf(wv_ - bf2f(hi)) : hi; pr |= (unsigned)val << (16 * e); }
            o[j2] = pr; }
        *(u32x4_t*)(rtab + (size_t)p * 16) = (u32x4_t){o[0], o[1], o[2], o[3]};
    }
}
DEV void p_router_consts(float* lds, const float* g1, const float* b1, const float* wg, const float* bg, const float* we, const float* be, float* sb) {
    const int t = otid(), wv = t >> 6, lane = t & 63;
    for (int c = (int)blockIdx.x - 64; c < 36; c += gridDim.x) {
        if (c < 0) continue;
        float s = 0.f, q = 0.f;
#pragma unroll
        for (int kk = 0; kk < 2; ++kk) { const int k = t + 512 * kk; const float w = (c < 32) ? we[(size_t)k * 32 + c] : wg[(size_t)k * 4 + c - 32]; s += g1[k] * w; q += b1[k] * w; }
#pragma unroll
        for (int m = 1; m < 64; m <<= 1) { s += __shfl_xor(s, m); q += __shfl_xor(q, m); }
        if (lane == 0) { lds[wv * 2] = s; lds[wv * 2 + 1] = q; }
        __syncthreads();
        if (t == 0) { float S = 0.f, B = 0.f;
            for (int p = 0; p < 8; ++p) { S += lds[p * 2]; B += lds[p * 2 + 1]; }
            sb[c] = S; sb[48 + c] = B + ((c < 32) ? be[c] : bg[c - 32]);
            if (c == 0) { for (int z = 36; z < 48; ++z) { sb[z] = 0.f; sb[48 + z] = 0.f; } } }
        __syncthreads();
    }
}
DEV void p_cvt_x(const float* x, bf16_t* xb, int tg, int nthr) {
    const size_t n4 = (size_t)NTOK * DM / 4, stride = (size_t)gridDim.x * nthr;
    for (size_t i0 = (size_t)blockIdx.x * nthr + tg; i0 < n4; i0 += 16 * stride) {
        float4 t[16];
#pragma unroll
        for (int u = 0; u < 16; ++u) { const size_t i = i0 + u * stride; t[u] = (i < n4) ? ((const float4*)x)[i] : make_float4(0.f, 0.f, 0.f, 0.f); }
#pragma unroll
        for (int u = 0; u < 16; ++u) { const size_t i = i0 + u * stride; if (i < n4) { uint2 o; o.x = pg8::cvt_pk_bf16(t[u].x, t[u].y); o.y = pg8::cvt_pk_bf16(t[u].z, t[u].w); ((uint2*)xb)[i] = o; } }
    }
}
DEV void p_rope_table(float2* tab, int tg, int nthr) {
    const int i0 = blockIdx.x * nthr + tg, j = i0 & 127;
    const double r = 0.93057204092969897;
    double inv = 1.0; for (int t = 0; t < j; ++t) inv *= r;
    for (int i = i0; i < 8192 * 128; i += gridDim.x * nthr) {
        const int s = i >> 7;
        const double ang = (double)s * inv;
        const double twopi_hi = 6.283185307179586232, twopi_lo = 2.4492935982947064e-16;
        const double n = rint(ang * 0.15915494309189535);
        const double x = (ang - n * twopi_hi) - n * twopi_lo;
        const double x2 = x * x;
        double acc = 1.0 - x2 * (1.0 / (22.0 * 23.0));
#pragma unroll
        for (int k = 21; k >= 3; k -= 2) acc = 1.0 - x2 * (1.0 / ((double)(k - 1) * (double)k)) * acc;
        double acc2 = 1.0 - x2 * (1.0 / (21.0 * 22.0));
#pragma unroll
        for (int k = 20; k >= 2; k -= 2) acc2 = 1.0 - x2 * (1.0 / ((double)(k - 1) * (double)k)) * acc2;
        tab[i] = make_float2((float)acc2, (float)(x * acc));
    }
}

typedef float f32x4_t __attribute__((ext_vector_type(4)));
typedef short s16x4_t __attribute__((ext_vector_type(4)));
constexpr int LRU_ROWB = 400;
DEV void p_lru_compute(unsigned char* lds, const bf16_t* ulru, const float* cw, const float* cb, const bf16_t* wrg_t,
                       const float* b_r, const float* b_i, const float* lam, bf16_t* epsb, bf16_t* xinb, float* segA, float* segH) {
    int tid_ = otid(); asm volatile("" : "+v"(tid_));
    const int tid = tid_, wave = tid >> 6, lane = tid & 63, fr = lane & 15, fq = lane >> 4, wr = wave >> 2, wc = wave & 3;
    unsigned char* stg = lds + 256 * LRU_ROWB + wave * 4096;
    for (int item = blockIdx.x; item < 1024; item += gridDim.x) {
        const int n = item & 7, b = (item >> 3) & 3, seg = item >> 5;
        const size_t t0 = (size_t)b * SEQ + seg * 256;
        {
            const int c8 = tid % 24, run = tid / 24, r0 = run * 13;
            if (run < 20) {
                const int ch0 = n * 192 + c8 * 8;
                float wj[4][8], bias[8];
#pragma unroll
                for (int j = 0; j < 4; ++j) { const float4 w0 = *(const float4*)(cw + j * 1536 + ch0), w1 = *(const float4*)(cw + j * 1536 + ch0 + 4);
                    wj[j][0] = w0.x; wj[j][1] = w0.y; wj[j][2] = w0.z; wj[j][3] = w0.w; wj[j][4] = w1.x; wj[j][5] = w1.y; wj[j][6] = w1.z; wj[j][7] = w1.w; }
                { const float4 c0 = *(const float4*)(cb + ch0), c1 = *(const float4*)(cb + ch0 + 4); bias[0] = c0.x; bias[1] = c0.y; bias[2] = c0.z; bias[3] = c0.w; bias[4] = c1.x; bias[5] = c1.y; bias[6] = c1.z; bias[7] = c1.w; }
                u32x4_t raw[16];
#pragma unroll
                for (int i = 0; i < 16; ++i) { const int r = r0 - 3 + i;
                    raw[i] = (r < 256 && seg * 256 + r >= 0) ? *(const u32x4_t*)(ulru + (t0 + r) * 1536 + ch0) : (u32x4_t){0u, 0u, 0u, 0u}; }
                float xw[4][8];
#pragma unroll
                for (int i = 0; i < 16; ++i) {
#pragma unroll
                    for (int e = 0; e < 4; ++e) { xw[i & 3][2 * e] = __uint_as_float(raw[i][e] << 16); xw[i & 3][2 * e + 1] = __uint_as_float(raw[i][e] & 0xffff0000u); }
                    if (i >= 3) {
                        const int r = r0 + i - 3;
                        float acc[8];
#pragma unroll
                        for (int e = 0; e < 8; ++e) acc[e] = bias[e] + wj[0][e] * xw[(i + 1) & 3][e] + wj[1][e] * xw[(i + 2) & 3][e] + wj[2][e] * xw[(i + 3) & 3][e] + wj[3][e] * xw[i & 3][e];
                        if (r < 256) { uint4 o; o.x = pg8::cvt_pk_bf16(acc[0], acc[1]); o.y = pg8::cvt_pk_bf16(acc[2], acc[3]); o.z = pg8::cvt_pk_bf16(acc[4], acc[5]); o.w = pg8::cvt_pk_bf16(acc[6], acc[7]);
                            *(uint4*)(lds + r * LRU_ROWB + c8 * 16) = o; }
                    }
                }
            }
        }
        __syncthreads();
        float cbr[3], cbi[3], csp[3], hrun[3], atot[3];
        const int sub = seg * 2 + wr;
#pragma unroll
        for (int tc = 0; tc < 3; ++tc) { const int ch = n * 192 + 48 * wc + 16 * tc + fr; cbr[tc] = b_r[ch]; cbi[tc] = b_i[ch]; csp[tc] = 8.f * 1.4426950408889634f * log1pf(__expf(-lam[ch])); atot[tc] = 1.f; hrun[tc] = 0.f; }
        const bf16_t* wrb = wrg_t + (size_t)n * 192 * 192 + (size_t)(wc * 18) * 512 + lane * 8;
        const bf16_t* wib = wrb + (size_t)8 * 192 * 192;
#pragma unroll
        for (int tc = 0; tc < 3; ++tc) {
            bf16x8_t bfr[6][2];
#pragma unroll
            for (int ks = 0; ks < 6; ++ks) { bfr[ks][0] = *(const bf16x8_t*)(wrb + (tc * 6 + ks) * 512); bfr[ks][1] = *(const bf16x8_t*)(wib + (tc * 6 + ks) * 512); }
#pragma unroll
            for (int p = 0; p < 2; ++p) {
                const int rowb = 128 * wr + 64 * p;
                f32x4_t acc[4][2];
#pragma unroll
                for (int m = 0; m < 4; ++m) { acc[m][0] = (f32x4_t){0.f, 0.f, 0.f, 0.f}; acc[m][1] = (f32x4_t){0.f, 0.f, 0.f, 0.f}; }
#pragma unroll
                for (int ks = 0; ks < 6; ++ks) {
                    bf16x8_t afr[4];
#pragma unroll
                    for (int m = 0; m < 4; ++m) afr[m] = *(const bf16x8_t*)(lds + (rowb + 16 * (fr >> 2) + 4 * m + (fr & 3)) * LRU_ROWB + ks * 64 + fq * 16);
#pragma unroll
                    for (int m = 0; m < 4; ++m) { acc[m][0] = __builtin_amdgcn_mfma_f32_16x16x32_bf16(afr[m], bfr[ks][0], acc[m][0], 0, 0, 0); acc[m][1] = __builtin_amdgcn_mfma_f32_16x16x32_bf16(afr[m], bfr[ks][1], acc[m][1], 0, 0, 0); }
                }
                const int coff = (48 * wc + 16 * tc + fr) * 2;
                const unsigned char* up = lds + (rowb + 16 * fq) * LRU_ROWB + coff;
                float Al = 1.f, Bl = 0.f;
                unsigned pe[8], px[8];
#pragma unroll
                for (int m = 0; m < 4; ++m) {
                    float ee[4], xx[4];
#pragma unroll
                    for (int j = 0; j < 4; ++j) {
                        const float rr = pg8::fsig(acc[m][0][j] + cbr[tc]), ii = pg8::fsig(acc[m][1][j] + cbi[tc]);
                        const float aa = __builtin_amdgcn_exp2f(-csp[tc] * rr);
                        const float u = bf2f(*(const bf16_t*)(up + (4 * m + j) * LRU_ROWB));
                        const float om = 1.f - aa;
                        const float x = __builtin_amdgcn_sqrtf(fmaxf(om * (1.f + aa), 0.f)) * ii * u;
                        ee[j] = om; xx[j] = x; Bl = aa * Bl + x; Al *= aa;
                    }
                    pe[2 * m] = pg8::cvt_pk_bf16(ee[0], ee[1]); pe[2 * m + 1] = pg8::cvt_pk_bf16(ee[2], ee[3]);
                    px[2 * m] = pg8::cvt_pk_bf16(xx[0], xx[1]); px[2 * m + 1] = pg8::cvt_pk_bf16(xx[2], xx[3]);
                }
                { float h = hrun[tc], ap = 1.f;
#pragma unroll
                  for (int q = 0; q < 4; ++q) { const float Aq = __shfl(Al, fr + 16 * q), Bq = __shfl(Bl, fr + 16 * q); h = Aq * h + Bq; ap *= Aq; }
                  hrun[tc] = h; atot[tc] *= ap; }
#pragma unroll
                for (int m = 0; m < 4; ++m)
#pragma unroll
                    for (int j = 0; j < 4; ++j) { const int tk = 16 * fq + 4 * m + j; const unsigned we = pe[2 * m + (j >> 1)], wx = px[2 * m + (j >> 1)];
                        *(bf16_t*)(stg + tk * 32 + fr * 2) = (bf16_t)((j & 1) ? (we >> 16) : (we & 0xffff));
                        *(bf16_t*)(stg + 2048 + tk * 32 + fr * 2) = (bf16_t)((j & 1) ? (wx >> 16) : (wx & 0xffff)); }
                asm volatile("s_waitcnt lgkmcnt(0)" ::: "memory");
#pragma unroll
                for (int i = 0; i < 2; ++i) { const int piece = lane + 64 * i, tk = piece >> 1, hf = piece & 1;
                    const size_t go = (t0 + rowb + tk) * 1536 + n * 192 + 48 * wc + 16 * tc + 8 * hf;
                    *(u32x4_t*)(epsb + go) = *(const u32x4_t*)(stg + tk * 32 + hf * 16);
                    *(u32x4_t*)(xinb + go) = *(const u32x4_t*)(stg + 2048 + tk * 32 + hf * 16); }
                asm volatile("s_waitcnt lgkmcnt(0)" ::: "memory");
            }
        }
        if (fq == 0) {
#pragma unroll
            for (int tc = 0; tc < 3; ++tc) { const size_t o = ((size_t)b * 64 + sub) * 1536 + n * 192 + 48 * wc + 16 * tc + fr; segA[o] = atot[tc]; segH[o] = hrun[tc]; }
        }
        __syncthreads();
    }
}
DEV void p_lru_scan(const bf16_t* epsb, const bf16_t* xinb, bf16_t* gl, const float* segA, const float* segH) {
    const int tid = otid();
    if (tid >= 384) return;
    for (int item = blockIdx.x; item < 256; item += gridDim.x) {
        const int b = item >> 6, sub = item & 63;
        const size_t base = ((size_t)b * SEQ + sub * 128) * 1536 + tid * 4;
        float h0 = 0.f, h1 = 0.f, h2 = 0.f, h3 = 0.f;
        { const float* pa = segA + (size_t)b * 64 * 1536 + tid * 4; const float* ph = segH + (size_t)b * 64 * 1536 + tid * 4;
#pragma unroll 16
          for (int s = 0; s < sub; ++s) { const float4 av = *(const float4*)(pa + (size_t)s * 1536), hv = *(const float4*)(ph + (size_t)s * 1536);
              h0 = av.x * h0 + hv.x; h1 = av.y * h1 + hv.y; h2 = av.z * h2 + hv.z; h3 = av.w * h3 + hv.w; } }
#pragma unroll 8
        for (int t = 0; t < 128; ++t) {
            const size_t o = base + (size_t)t * 1536;
            const uint2 ev = *(const uint2*)(epsb + o), xv = *(const uint2*)(xinb + o), gv = *(const uint2*)(gl + o);
            h0 = (1.f - __uint_as_float(ev.x << 16)) * h0 + __uint_as_float(xv.x << 16);
            h1 = (1.f - __uint_as_float(ev.x & 0xffff0000u)) * h1 + __uint_as_float(xv.x & 0xffff0000u);
            h2 = (1.f - __uint_as_float(ev.y << 16)) * h2 + __uint_as_float(xv.y << 16);
            h3 = (1.f - __uint_as_float(ev.y & 0xffff0000u)) * h3 + __uint_as_float(xv.y & 0xffff0000u);
            uint2 ov; ov.x = pg8::cvt_pk_bf16(h0 * __uint_as_float(gv.x << 16), h1 * __uint_as_float(gv.x & 0xffff0000u)); ov.y = pg8::cvt_pk_bf16(h2 * __uint_as_float(gv.y << 16), h3 * __uint_as_float(gv.y & 0xffff0000u));
            *(uint2*)(gl + o) = ov;
        }
    }
}
DEV bf16x8_t fp8x8_to_bf16(unsigned d0, unsigned d1) {
    typedef __bf16 bf2_t __attribute__((ext_vector_type(2)));
    const unsigned a = __builtin_bit_cast(unsigned, __builtin_amdgcn_cvt_scalef32_pk_bf16_fp8(d0, 1.0f, false)), b = __builtin_bit_cast(unsigned, __builtin_amdgcn_cvt_scalef32_pk_bf16_fp8(d0, 1.0f, true));
    const unsigned c = __builtin_bit_cast(unsigned, __builtin_amdgcn_cvt_scalef32_pk_bf16_fp8(d1, 1.0f, false)), d = __builtin_bit_cast(unsigned, __builtin_amdgcn_cvt_scalef32_pk_bf16_fp8(d1, 1.0f, true));
    return __builtin_bit_cast(bf16x8_t, (u32x4_t){a, b, c, d});
}
#define LDS_BARRIER() do { asm volatile("s_waitcnt lgkmcnt(0)" ::: "memory"); __builtin_amdgcn_s_barrier(); asm volatile("" ::: "memory"); } while (0)
DEV void p_scores(unsigned char* lds, const bf16_t* q, const bf16_t* k, bf16_t* P) {
    int tid_ = otid(); asm volatile("" : "+v"(tid_));
    const int tid = tid_, w = tid >> 6, lane = tid & 63, fr = lane & 15, fq = lane >> 4;
    const int krow = tid >> 5, kch = tid & 31;
    u32x4_t kreg[8], qraw[4];
    int g = blockIdx.x;
    if (g < 1024) { const int c = g & 63, bh = g >> 6, b = bh >> 2, h = bh & 3; const size_t tok0 = (size_t)b * SEQ + c * 128;
        const bf16_t* kc = k + tok0 * 1024 + h * 256;
#pragma unroll
        for (int ii = 0; ii < 8; ++ii) kreg[ii] = *(const u32x4_t*)(kc + (size_t)(krow + 16 * ii) * 1024 + kch * 8);
        const unsigned char* qp = (const unsigned char*)q + ((tok0 >> 7) * 4 + h) * 32768 + (fq * 128 + 16 * w + fr) * 16;
#pragma unroll
        for (int i = 0; i < 4; ++i) qraw[i] = *(const u32x4_t*)(qp + i * 8192); }
    for (; g < 1024; g += gridDim.x) {
#pragma unroll
        for (int ii = 0; ii < 8; ++ii) *(u32x4_t*)(lds + (krow + 16 * ii) * 528 + kch * 16) = kreg[ii];
        bf16x8_t qc[8];
#pragma unroll
        for (int i = 0; i < 4; ++i) { qc[2 * i] = fp8x8_to_bf16(qraw[i][0], qraw[i][1]); qc[2 * i + 1] = fp8x8_to_bf16(qraw[i][2], qraw[i][3]); }
        const int gn = g + gridDim.x;
        if (gn < 1024) { const int c = gn & 63, bh = gn >> 6, b = bh >> 2, h = bh & 3; const size_t tok0 = (size_t)b * SEQ + c * 128;
            const bf16_t* kc = k + tok0 * 1024 + h * 256;
#pragma unroll
            for (int ii = 0; ii < 8; ++ii) kreg[ii] = *(const u32x4_t*)(kc + (size_t)(krow + 16 * ii) * 1024 + kch * 8);
            const unsigned char* qp = (const unsigned char*)q + ((tok0 >> 7) * 4 + h) * 32768 + (fq * 128 + 16 * w + fr) * 16;
#pragma unroll
            for (int i = 0; i < 4; ++i) qraw[i] = *(const u32x4_t*)(qp + i * 8192); }
        LDS_BARRIER();
        f32x4_t acc[8];
#pragma unroll
        for (int nt = 0; nt < 8; ++nt) acc[nt] = (f32x4_t){0.f, 0.f, 0.f, 0.f};
#pragma unroll
        for (int ks = 0; ks < 8; ++ks)
#pragma unroll
            for (int nt = 0; nt < 8; ++nt) { const bf16x8_t bb = *(const bf16x8_t*)(lds + (16 * nt + fr) * 528 + ks * 64 + fq * 16); acc[nt] = __builtin_amdgcn_mfma_f32_16x16x32_bf16(bb, qc[ks], acc[nt], 0, 0, 0); }
        {
            const int c = g & 63, bh = g >> 6, b = bh >> 2, h = bh & 3;
            bf16_t* kt = const_cast<bf16_t*>(k) + ((size_t)b * SEQ + c * 128 + fq * 8 + w) * 1024 + h * 256 + fr * 8;
#pragma unroll
            for (int ks2 = 0; ks2 < 2; ++ks2)
#pragma unroll
                for (int di = 0; di < 2; ++di) {
                    unsigned o[4];
#pragma unroll
                    for (int e = 0; e < 2; ++e) {
                        const unsigned char* kp = lds + (32 * (2 * ks2 + e) + 8 * fq + (fr >> 2)) * 528 + (16 * (2 * w + di) + 4 * (fr & 3)) * 2;
                        const s16x4_t t0 = __builtin_amdgcn_ds_read_tr16_b64_v4i16((LAS s16x4_t*)(kp));
                        const s16x4_t t1 = __builtin_amdgcn_ds_read_tr16_b64_v4i16((LAS s16x4_t*)(kp + 4 * 528));
                        o[2 * e] = pg8::pk4_fp8(16.f * bf2f((bf16_t)t0[0]), 16.f * bf2f((bf16_t)t0[1]), 16.f * bf2f((bf16_t)t0[2]), 16.f * bf2f((bf16_t)t0[3]));
                        o[2 * e + 1] = pg8::pk4_fp8(16.f * bf2f((bf16_t)t1[0]), 16.f * bf2f((bf16_t)t1[1]), 16.f * bf2f((bf16_t)t1[2]), 16.f * bf2f((bf16_t)t1[3]));
                    }
                    *(u32x4_t*)(kt + ks2 * 32768 + di * 128) = (u32x4_t){o[0], o[1], o[2], o[3]};
                }
        }
        LDS_BARRIER();
        bf16_t* Pg = P + (size_t)g * 16384 + ((fq >> 1) * 128 + 16 * w + fr) * 8 + 4 * (fq & 1);
        int mrow = 16 * w + fr - 4 * fq; asm volatile("" : "+v"(mrow));
#pragma unroll
        for (int nt = 0; nt < 8; ++nt) {
            uint2 o; o.x = pg8::cvt_pk_bf16((16 * nt <= mrow) ? acc[nt][0] * 0.015625f : 0.f, (16 * nt + 1 <= mrow) ? acc[nt][1] * 0.015625f : 0.f);
            o.y = pg8::cvt_pk_bf16((16 * nt + 2 <= mrow) ? acc[nt][2] * 0.015625f : 0.f, (16 * nt + 3 <= mrow) ? acc[nt][3] * 0.015625f : 0.f);
            *(uint2*)(Pg + ((nt >> 1) * 4 + 2 * (nt & 1)) * 1024) = o; }
    }
    __syncthreads();
}
constexpr int RT_KS = 528, RT_VS = 272, RT_V = 0, RT_U = 2 * 32 * RT_VS;
DEV void p_ret_mfma(unsigned char* lds, const bf16_t* q, const bf16_t* k, bf16_t* v, const bf16_t* P) {
    int tid_ = otid(); asm volatile("" : "+v"(tid_));
    const int tid = tid_, w = tid >> 6, lane = tid & 63, fr = lane & 15, fq = lane >> 4;
    for (int wk = blockIdx.x; wk < 256; wk += gridDim.x) {
        const int xcd = wk & 7, idx = wk >> 3, bh = xcd * 2 + (idx >> 4), sl = idx & 15, b = bh >> 2, h = bh & 3;
        float g128; { const double gam = 1.0 - exp2(-5.0 - (double)h); g128 = (float)exp2(128.0 * log2(gam)); }
        asm volatile("" : "+v"(g128));
        f32x4_t accU[2][2];
#pragma unroll
        for (int et = 0; et < 2; ++et)
#pragma unroll
            for (int di = 0; di < 2; ++di) accU[et][di] = (f32x4_t){0.f, 0.f, 0.f, 0.f};
        for (int i = tid; i < 32 * RT_KS / 4; i += NTHR) ((unsigned*)(lds + RT_U))[i] = 0u;
        const size_t tokb = (size_t)b * SEQ;
        const int vm = tid >> 2, ve = (tid & 3) * 8;
        const bf16_t* vsl = v + tokb * 2048 + h * 512 + sl * 32;
#define RT_STAGE_V(buf, vr) do { unsigned char* vp_ = lds + RT_V + (buf) * 32 * RT_VS + ve * RT_VS + vm * 2; \
            *(bf16_t*)(vp_ + 0 * RT_VS) = (bf16_t)((vr)[0] & 0xffff); *(bf16_t*)(vp_ + 1 * RT_VS) = (bf16_t)((vr)[0] >> 16); \
            *(bf16_t*)(vp_ + 2 * RT_VS) = (bf16_t)((vr)[1] & 0xffff); *(bf16_t*)(vp_ + 3 * RT_VS) = (bf16_t)((vr)[1] >> 16); \
            *(bf16_t*)(vp_ + 4 * RT_VS) = (bf16_t)((vr)[2] & 0xffff); *(bf16_t*)(vp_ + 5 * RT_VS) = (bf16_t)((vr)[2] >> 16); \
            *(bf16_t*)(vp_ + 6 * RT_VS) = (bf16_t)((vr)[3] & 0xffff); *(bf16_t*)(vp_ + 7 * RT_VS) = (bf16_t)((vr)[3] >> 16); } while (0)
        u32x4_t vreg = *(const u32x4_t*)(vsl + (size_t)vm * 2048 + ve);
        RT_STAGE_V(0, vreg);
        vreg = *(const u32x4_t*)(vsl + (size_t)(128 + vm) * 2048 + ve);
        u32x4_t qraw[4], kraw[2][2];
        bf16x8_t pa[4];
        const unsigned char* qp = (const unsigned char*)q + ((tokb >> 7) * 4 + h) * 32768 + (fq * 128 + 16 * w + fr) * 16;
        const bf16_t* pp = P + (size_t)(bh * 64) * 16384 + (fq * 128 + 16 * w + fr) * 8;
        const bf16_t* kp = k + (tokb + fq * 8 + w) * 1024 + h * 256 + fr * 8;
        {
#pragma unroll
            for (int i = 0; i < 4; ++i) qraw[i] = *(const u32x4_t*)(qp + i * 8192);
#pragma unroll
            for (int ks = 0; ks < 4; ++ks) { if (2 * ks <= w) pa[ks] = *(const bf16x8_t*)(pp + ks * 4096); else pa[ks] = (bf16x8_t){0, 0, 0, 0, 0, 0, 0, 0}; }
#pragma unroll
            for (int di = 0; di < 2; ++di)
#pragma unroll
                for (int i = 0; i < 2; ++i) kraw[di][i] = *(const u32x4_t*)(kp + i * 32768 + di * 128);
        }
        LDS_BARRIER();
#pragma unroll 1
        for (int c = 0; c < 64; ++c) {
            const size_t tok0 = tokb + c * 128;
            const unsigned char* ldsU = lds + RT_U + (c & 1) * 32 * RT_KS;
            const unsigned char* ldsV = lds + RT_V + (c & 1) * 32 * RT_VS;
            f32x4_t ao[2] = {(f32x4_t){0.f, 0.f, 0.f, 0.f}, (f32x4_t){0.f, 0.f, 0.f, 0.f}};
            {
                bf16x8_t qa[8];
#pragma unroll
                for (int i = 0; i < 4; ++i) { qa[2 * i] = fp8x8_to_bf16(qraw[i][0], qraw[i][1]); qa[2 * i + 1] = fp8x8_to_bf16(qraw[i][2], qraw[i][3]); }
                bf16x8_t bu[8];
#pragma unroll
                for (int nt = 0; nt < 2; ++nt) {
#pragma unroll
                    for (int ks = 0; ks < 8; ++ks) bu[ks] = *(const bf16x8_t*)(ldsU + (16 * nt + fr) * RT_KS + ks * 64 + fq * 16);
#pragma unroll
                    for (int ks = 0; ks < 8; ++ks) ao[nt] = __builtin_amdgcn_mfma_f32_16x16x32_bf16(bu[ks], qa[ks], ao[nt], 0, 0, 0);
                }
            }
            bf16x8_t bv[2][4];
#pragma unroll
            for (int nt = 0; nt < 2; ++nt)
#pragma unroll
                for (int ks = 0; ks < 4; ++ks) bv[nt][ks] = *(const bf16x8_t*)(ldsV + (16 * nt + fr) * RT_VS + ks * 64 + fq * 16);
#pragma unroll
            for (int ks = 0; ks < 4; ++ks)
#pragma unroll
                for (int nt = 0; nt < 2; ++nt) ao[nt] = __builtin_amdgcn_mfma_f32_16x16x32_bf16(bv[nt][ks], pa[ks], ao[nt], 0, 0, 0);
            if (c + 1 < 64) {
                const unsigned char* qn = qp + (size_t)(c + 1) * 131072;
#pragma unroll
                for (int i = 0; i < 4; ++i) qraw[i] = *(const u32x4_t*)(qn + i * 8192);
                const bf16_t* pn = pp + (size_t)(c + 1) * 16384;
#pragma unroll
                for (int ks = 0; ks < 4; ++ks) if (2 * ks <= w) pa[ks] = *(const bf16x8_t*)(pn + ks * 4096);
            }
            {
                bf16_t* vc = v + (tok0 + 16 * w + fr) * 2048 + h * 512 + sl * 32 + 4 * fq;
#pragma unroll
                for (int nt = 0; nt < 2; ++nt) { uint2 o; o.x = pg8::cvt_pk_bf16(ao[nt][0], ao[nt][1]); o.y = pg8::cvt_pk_bf16(ao[nt][2], ao[nt][3]); *(uint2*)(vc + 16 * nt) = o; }
            }
#pragma unroll
            for (int ks = 0; ks < 4; ++ks)
#pragma unroll
                for (int di = 0; di < 2; ++di) { const bf16x8_t kb = fp8x8_to_bf16(kraw[di][ks >> 1][2 * (ks & 1)], kraw[di][ks >> 1][2 * (ks & 1) + 1]);
#pragma unroll
                    for (int et = 0; et < 2; ++et) accU[et][di] = __builtin_amdgcn_mfma_f32_16x16x32_bf16(kb, bv[et][ks], accU[et][di], 0, 0, 0); }
            if (c + 1 < 64) {
                const bf16_t* kn = kp + (size_t)(c + 1) * 131072;
#pragma unroll
                for (int di = 0; di < 2; ++di)
#pragma unroll
                    for (int i = 0; i < 2; ++i) kraw[di][i] = *(const u32x4_t*)(kn + i * 32768 + di * 128);
            }
#pragma unroll
            for (int et = 0; et < 2; ++et)
#pragma unroll
                for (int di = 0; di < 2; ++di) accU[et][di] = accU[et][di] * g128;
            {
                unsigned char* un = lds + RT_U + ((c + 1) & 1) * 32 * RT_KS;
#pragma unroll
                for (int et = 0; et < 2; ++et)
#pragma unroll
                    for (int di = 0; di < 2; ++di) { const float us = 1.f / 1024.f;
                        uint2 o; o.x = pg8::cvt_pk_bf16(accU[et][di][0] * us, accU[et][di][1] * us); o.y = pg8::cvt_pk_bf16(accU[et][di][2] * us, accU[et][di][3] * us);
                        *(uint2*)(un + (16 * et + fr) * RT_KS + (16 * (2 * w + di) + 4 * fq) * 2) = o; }
                if (c + 1 < 64) { RT_STAGE_V((c + 1) & 1, vreg); }
                if (c + 2 < 64) vreg = *(const u32x4_t*)(vsl + (size_t)((c + 2) * 128 + vm) * 2048 + ve);
            }
            LDS_BARRIER();
        }
#undef RT_STAGE_V
        __syncthreads();
    }
}
DEV void p_headnorm(bf16_t* ret, const bf16_t* g) {
    const int lane = otid() & 63;
    for (int w = (blockIdx.x * NTHR + otid()) >> 6; w < NTOK * 4; w += gridDim.x * (NTHR / 64)) {
        const size_t o = (size_t)w * 512 + lane * 8;
        const u32x4_t rv = *(const u32x4_t*)(ret + o), gv = *(const u32x4_t*)(g + o);
        float x[8], gg[8]; float s = 0.f;
#pragma unroll
        for (int j = 0; j < 4; ++j) { x[2 * j] = __uint_as_float(rv[j] << 16); x[2 * j + 1] = __uint_as_float(rv[j] & 0xffff0000u); gg[2 * j] = __uint_as_float(gv[j] << 16); gg[2 * j + 1] = __uint_as_float(gv[j] & 0xffff0000u); }
#pragma unroll
        for (int j = 0; j < 8; ++j) s += x[j];
#pragma unroll
        for (int m = 1; m < 64; m <<= 1) s += __shfl_xor(s, m);
        const float mu = s * (1.f / 512.f); float q = 0.f;
#pragma unroll
        for (int j = 0; j < 8; ++j) { x[j] -= mu; q += x[j] * x[j]; }
#pragma unroll
        for (int m = 1; m < 64; m <<= 1) q += __shfl_xor(q, m);
        const float rstd = rsqrtf(q * (1.f / 512.f) + LN_EPS);
        u32x4_t ov;
#pragma unroll
        for (int j = 0; j < 4; ++j) ov[j] = pg8::cvt_pk_bf16(x[2 * j] * rstd * gg[2 * j], x[2 * j + 1] * rstd * gg[2 * j + 1]);
        *(u32x4_t*)(ret + o) = ov;
    }
}

typedef float f32x4v __attribute__((ext_vector_type(4)));
DEV void p_ln1_route(float* lds, const bf16_t* y, bf16_t* x1b, unsigned char* x1q, const float* g1, const float* b1, const unsigned char* rtab,
                     int2* route_e, float2* route_w, int* cnt, int* list, const float* sb) {
    int tid_ = otid(); asm volatile("" : "+v"(tid_));
    const int tid = tid_, wv = tid >> 6, lane = tid & 63, r16 = lane & 15, kq = lane >> 4;
    const unsigned char* Wt = (const unsigned char*)lds;
    float* Sc = lds + 1024 * 36;
    float* Bc = Sc + 48;
    int* lcnt = (int*)(Bc + 48);
    int* rowE = lcnt + 32;
    int* rowP = rowE + 256;
#pragma unroll 6
    for (int i = tid; i < 9216; i += NTHR) ((u32x4_t*)lds)[i] = ((const u32x4_t*)rtab)[i];
    if (tid < 32) lcnt[tid] = 0;
    __syncthreads();
    if (tid < 96) Sc[tid] = sb[tid];
    __syncthreads();
    constexpr int rows_per_wg = 128;
    for (int blk = blockIdx.x; blk < NTOK / rows_per_wg; blk += gridDim.x) {
    { const int tile = wv;
        const int lrow0 = tile * 16, row0 = blk * rows_per_wg + lrow0;
        const bf16_t* yp = y + (size_t)(row0 + r16) * 1024 + 8 * kq;
        const unsigned char* tb = Wt + lane * 16;
        const unsigned char* tb2 = Wt + 131072 + (kq * 4 + (r16 & 3)) * 16;
        f32x4v acc[3] = {(f32x4v){0.f, 0.f, 0.f, 0.f}, (f32x4v){0.f, 0.f, 0.f, 0.f}, (f32x4v){0.f, 0.f, 0.f, 0.f}};
        float s1 = 0.f, s2 = 0.f;
#pragma unroll 4
        for (int T = 0; T < 32; ++T) {
            const u32x4_t yr = *(const u32x4_t*)(yp + 32 * T);
#pragma unroll
            for (int e = 0; e < 4; ++e) { const float lo = __uint_as_float(yr[e] << 16), hi = __uint_as_float(yr[e] & 0xffff0000u); s1 += lo + hi; s2 += lo * lo + hi * hi; }
            const bf16x8_t a = __builtin_bit_cast(bf16x8_t, yr);
#pragma unroll
            for (int part = 0; part < 2; ++part) {
#pragma unroll
                for (int nt = 0; nt < 2; ++nt) acc[nt] = __builtin_amdgcn_mfma_f32_16x16x32_bf16(a, *(const bf16x8_t*)(tb + ((T * 2 + part) * 2 + nt) * 1024), acc[nt], 0, 0, 0);
                acc[2] = __builtin_amdgcn_mfma_f32_16x16x32_bf16(a, *(const bf16x8_t*)(tb2 + (T * 2 + part) * 256), acc[2], 0, 0, 0);
            }
        }
        s1 += __shfl_xor(s1, 16); s1 += __shfl_xor(s1, 32); s2 += __shfl_xor(s2, 16); s2 += __shfl_xor(s2, 32);
        const float mu = s1 * (1.f / 1024.f), rstd = rsqrtf(fmaxf(s2 * (1.f / 1024.f) - mu * mu, 0.f) + LN_EPS);
        {
            float gA[8], bA[8], gB[8], bB[8];
#pragma unroll
            for (int e = 0; e < 2; ++e) { const float4 t0 = *(const float4*)(g1 + 8 * lane + 4 * e), t1 = *(const float4*)(b1 + 8 * lane + 4 * e), t2 = *(const float4*)(g1 + 512 + 8 * lane + 4 * e), t3 = *(const float4*)(b1 + 512 + 8 * lane + 4 * e);
                gA[4 * e] = t0.x; gA[4 * e + 1] = t0.y; gA[4 * e + 2] = t0.z; gA[4 * e + 3] = t0.w; bA[4 * e] = t1.x; bA[4 * e + 1] = t1.y; bA[4 * e + 2] = t1.z; bA[4 * e + 3] = t1.w;
                gB[4 * e] = t2.x; gB[4 * e + 1] = t2.y; gB[4 * e + 2] = t2.z; gB[4 * e + 3] = t2.w; bB[4 * e] = t3.x; bB[4 * e + 1] = t3.y; bB[4 * e + 2] = t3.z; bB[4 * e + 3] = t3.w; }
#pragma unroll 2
            for (int rr = 0; rr < 16; ++rr) {
                const float mur = __shfl(mu, rr), rsr = __shfl(rstd, rr);
                const size_t ro = (size_t)(row0 + rr) * 1024 + 8 * lane;
                const u32x4_t ya = *(const u32x4_t*)(y + ro), yb = *(const u32x4_t*)(y + ro + 512);
                float oa[8], ob[8];
#pragma unroll
                for (int e = 0; e < 4; ++e) {
                    oa[2 * e] = (__uint_as_float(ya[e] << 16) - mur) * rsr * gA[2 * e] + bA[2 * e]; oa[2 * e + 1] = (__uint_as_float(ya[e] & 0xffff0000u) - mur) * rsr * gA[2 * e + 1] + bA[2 * e + 1];
                    ob[2 * e] = (__uint_as_float(yb[e] << 16) - mur) * rsr * gB[2 * e] + bB[2 * e]; ob[2 * e + 1] = (__uint_as_float(yb[e] & 0xffff0000u) - mur) * rsr * gB[2 * e + 1] + bB[2 * e + 1]; }
                *(u32x4_t*)(x1b + ro) = (u32x4_t){pg8::cvt_pk_bf16(oa[0], oa[1]), pg8::cvt_pk_bf16(oa[2], oa[3]), pg8::cvt_pk_bf16(oa[4], oa[5]), pg8::cvt_pk_bf16(oa[6], oa[7])};
                *(u32x4_t*)(x1b + ro + 512) = (u32x4_t){pg8::cvt_pk_bf16(ob[0], ob[1]), pg8::cvt_pk_bf16(ob[2], ob[3]), pg8::cvt_pk_bf16(ob[4], ob[5]), pg8::cvt_pk_bf16(ob[6], ob[7])};
                uint2 qa_, qb_;
                qa_.x = pg8::pk4_fp8(oa[0] * pg8::FP8_SX, oa[1] * pg8::FP8_SX, oa[2] * pg8::FP8_SX, oa[3] * pg8::FP8_SX); qa_.y = pg8::pk4_fp8(oa[4] * pg8::FP8_SX, oa[5] * pg8::FP8_SX, oa[6] * pg8::FP8_SX, oa[7] * pg8::FP8_SX);
                qb_.x = pg8::pk4_fp8(ob[0] * pg8::FP8_SX, ob[1] * pg8::FP8_SX, ob[2] * pg8::FP8_SX, ob[3] * pg8::FP8_SX); qb_.y = pg8::pk4_fp8(ob[4] * pg8::FP8_SX, ob[5] * pg8::FP8_SX, ob[6] * pg8::FP8_SX, ob[7] * pg8::FP8_SX);
                *(uint2*)(x1q + ro) = qa_; *(uint2*)(x1q + ro + 512) = qb_;
            }
        }
#pragma unroll
        for (int j = 0; j < 4; ++j) {
            const int rl = 4 * kq + j;
            const float mur = __shfl(mu, rl), rsr = __shfl(rstd, rl);
            float lg[3];
#pragma unroll
            for (int nt = 0; nt < 3; ++nt) lg[nt] = rsr * (acc[nt][j] - mur * Sc[16 * nt + r16]) + Bc[16 * nt + r16];
            const int gb = 16 * kq;
            const float g0 = __shfl(lg[2], gb + 0), g1v = __shfl(lg[2], gb + 1), g2 = __shfl(lg[2], gb + 2), g3 = __shfl(lg[2], gb + 3);
            int gi = 0; float gm = g0; if (g1v > gm) { gm = g1v; gi = 1; } if (g2 > gm) { gm = g2; gi = 2; } if (g3 > gm) { gm = g3; gi = 3; }
            const float gw = 1.f / (expf(g0 - gm) + expf(g1v - gm) + expf(g2 - gm) + expf(g3 - gm));
            const float lsel = (gi & 2) ? lg[1] : lg[0];
            float ev[8];
#pragma unroll
            for (int t = 0; t < 8; ++t) ev[t] = __shfl(lsel, gb + (gi & 1) * 8 + t);
            int i1 = 0; float v1 = ev[0];
#pragma unroll
            for (int t = 1; t < 8; ++t) if (ev[t] > v1) { v1 = ev[t]; i1 = t; }
            int i2 = -1; float v2 = -INFINITY;
#pragma unroll
            for (int t = 0; t < 8; ++t) if (t != i1 && ev[t] > v2) { v2 = ev[t]; i2 = t; }
            const float w1 = 1.f / (1.f + expf(v2 - v1)), w2 = 1.f - w1;
            if (r16 == 0) {
                const int lr = lrow0 + rl, r = row0 + rl, e1 = gi * 8 + i1, e2 = gi * 8 + i2;
                route_e[r] = make_int2(e1, e2); route_w[r] = make_float2(gw * w1, gw * w2);
                rowE[2 * lr] = e1; rowP[2 * lr] = atomicAdd(&lcnt[e1], 1);
                rowE[2 * lr + 1] = e2; rowP[2 * lr + 1] = atomicAdd(&lcnt[e2], 1);
            }
        }
    }
    __syncthreads();
    if (tid < 32) lcnt[tid] = atomicAdd(&cnt[tid * 64], lcnt[tid]);
    __syncthreads();
    for (int i = tid; i < 2 * rows_per_wg; i += NTHR) { const int e = rowE[i]; list[e * 32768 + lcnt[e] + rowP[i]] = (blk * rows_per_wg + (i >> 1)) * 2 + (i & 1); }
    __syncthreads();
    if (tid < 32) lcnt[tid] = 0;
    __syncthreads();
    }
}

DEV void p_final(float* out, const bf16_t* x1b, const bf16_t* ys, const float* g2, const float* b2) {
    const int lane = otid() & 63;
    for (int r = (blockIdx.x * NTHR + otid()) >> 6; r < NTOK; r += gridDim.x * (NTHR / 64)) {
        float x[16]; float s = 0.f;
#pragma unroll
        for (int j = 0; j < 4; ++j) { const int col = j * 256 + lane * 4; const ushort4 tb = *(const ushort4*)(x1b + (size_t)r * 1024 + col); const float4 t = make_float4(bf2f(tb.x), bf2f(tb.y), bf2f(tb.z), bf2f(tb.w));
            const ushort4 a = *(const ushort4*)(ys + (size_t)(2 * r) * 1024 + col), b = *(const ushort4*)(ys + (size_t)(2 * r + 1) * 1024 + col);
            x[4 * j] = ALPHA * t.x + bf2f(a.x) + bf2f(b.x); x[4 * j + 1] = ALPHA * t.y + bf2f(a.y) + bf2f(b.y); x[4 * j + 2] = ALPHA * t.z + bf2f(a.z) + bf2f(b.z); x[4 * j + 3] = ALPHA * t.w + bf2f(a.w) + bf2f(b.w);
            s += (x[4 * j] + x[4 * j + 1]) + (x[4 * j + 2] + x[4 * j + 3]); }
#pragma unroll
        for (int m = 1; m < 64; m <<= 1) s += __shfl_xor(s, m);
        const float mu = s * (1.f / 1024.f); float q = 0.f;
#pragma unroll
        for (int j = 0; j < 16; ++j) { x[j] -= mu; q += x[j] * x[j]; }
#pragma unroll
        for (int m = 1; m < 64; m <<= 1) q += __shfl_xor(q, m);
        const float rstd = rsqrtf(q * (1.f / 1024.f) + LN_EPS);
#pragma unroll
        for (int j = 0; j < 4; ++j) { const int col = j * 256 + lane * 4; const float4 gg = *(const float4*)(g2 + col), bb = *(const float4*)(b2 + col);
            *(float4*)(out + (size_t)r * 1024 + col) = make_float4(x[4 * j] * rstd * gg.x + bb.x, x[4 * j + 1] * rstd * gg.y + bb.y, x[4 * j + 2] * rstd * gg.z + bb.z, x[4 * j + 3] * rstd * gg.w + bb.w); }
    }
}

struct Args { const float* in[24]; float* out; unsigned char* ws; };
__global__ void __launch_bounds__(NTHR, 2) mega_fwd(Args a) {
    extern __shared__ __attribute__((aligned(16))) unsigned char lds_raw[];
    float* ldsf = (float*)lds_raw;
    PG8_LAS unsigned char* ldsl = (PG8_LAS unsigned char*)lds_raw;
    volatile LAS unsigned* MISC = (volatile LAS unsigned*)((LAS unsigned char*)lds_raw + LDS_MISC);
    for (int u = otid(); u < 128; u += NTHR) MISC[u] = 0u;
    __syncthreads();
    unsigned char* ws = a.ws;
    XcdBarrier bar = xcd_barrier_post((unsigned*)(ws + WS_CTL) + CW_BAR, MISC + 8);
#define GRID_BAR() xcd_barrier(bar)
    const float* x = a.in[0]; const float* w_in = a.in[1]; const float* b_merge = a.in[2];
    const float* conv_w = a.in[3]; const float* conv_b = a.in[4];
    const float* w_rg_r = a.in[5]; const float* b_rg_r = a.in[6]; const float* w_rg_i = a.in[7]; const float* b_rg_i = a.in[8];
    const float* lam = a.in[9]; const float* w_ret_o = a.in[10]; const float* w_lru_o = a.in[11]; const float* w_out = a.in[12];
    const float* ln1_g = a.in[13]; const float* ln1_b = a.in[14]; const float* w_group = a.in[15]; const float* b_group = a.in[16];
    const float* w_er = a.in[17]; const float* b_er = a.in[18]; const float* w_eg = a.in[19]; const float* w_eu = a.in[20];
    const float* w_ed = a.in[21]; const float* ln2_g = a.in[22]; const float* ln2_b = a.in[23];
    float* out = a.out;
    int* cnt = (int*)(ws + WS_CTL); float2* rope = (float2*)(ws + WS_ROPE); int2* route_e = (int2*)(ws + WS_ROUTE_E); float2* route_w = (float2*)(ws + WS_ROUTE_W); int* list = (int*)(ws + WS_LIST);
    bf16_t* xb = (bf16_t*)(ws + WS_XB); bf16_t* gl = (bf16_t*)(ws + WS_GL); bf16_t* ulru = (bf16_t*)(ws + WS_ULRU); bf16_t* uconv = (bf16_t*)(ws + WS_UCONV);
    bf16_t* epsb = (bf16_t*)(ws + WS_EPS); bf16_t* inp = (bf16_t*)out;
    bf16_t* q = (bf16_t*)(ws + WS_Q); bf16_t* k = (bf16_t*)(ws + WS_K); bf16_t* v = (bf16_t*)(ws + WS_V); bf16_t* gbuf = (bf16_t*)out;
    bf16_t* P = (bf16_t*)(ws + WS_P); bf16_t* gates = (bf16_t*)(ws + WS_GATES); bf16_t* m1 = (bf16_t*)out; bf16_t* merged = xb;
    bf16_t* w_in_t = (bf16_t*)(ws + WS_WIN_T); bf16_t* w_ro_t = (bf16_t*)(ws + WS_WRO_T); bf16_t* w_lo_t = (bf16_t*)(ws + WS_WLO_T); bf16_t* w_out_t = (bf16_t*)(ws + WS_WOUT_T);
    bf16_t* wrg_t = (bf16_t*)(ws + WS_WRG_T); float* segA = (float*)(ws + WS_SEGA); float* segH = (float*)(ws + WS_SEGH);
    float* rsb = (float*)(ws + WS_RSB);
    unsigned char* wgu8 = ws + WS_WGU_T; unsigned char* wd8 = ws + WS_WD_T; unsigned char* x1q = ws + WS_X1Q;
    bf16_t* x1b = gl; bf16_t* hbuf = (bf16_t*)(ws + WS_H); bf16_t* ys = (bf16_t*)(ws + WS_YSLOT);

    { const int t0_ = otid(); p_rope_table(rope, t0_, NTHR); p_router_table(ln1_g, w_group, w_er, ws + WS_RTAB, t0_, NTHR);
      p_weights(ldsf, w_in, w_ret_o, w_lru_o, w_out, w_rg_r, w_rg_i, w_in_t, w_ro_t, w_lo_t, w_out_t, wrg_t, t0_ >> 6, 8, x, xb); }
    __syncthreads();
    p_router_consts(ldsf, ln1_g, ln1_b, w_group, b_group, w_er, b_er, rsb);
    GRID_BAR();
    { pg8::Gemm g{xb, w_in_t + (size_t)C_U * 1024, NTOK, 3072, 1024}; pg8::StaticOrder S; S.init(NTOK, 3072, (int)gridDim.x, (int)blockIdx.x);
      pg8::gemm_phase<pg8::EpiLruIn, pg8::StaticOrder, true, true>(ldsl, g, S, pg8::EpiLruIn{ulru, gl}); }
    GRID_BAR();
    p_lru_compute(lds_raw, ulru, conv_w, conv_b, wrg_t, b_rg_r, b_rg_i, lam, uconv, epsb, segA, segH);
    GRID_BAR();
    p_lru_scan(uconv, epsb, gl, segA, segH);
    GRID_BAR();
    { pg8::Gemm g{xb, w_in_t, NTOK, 6144, 1024}; pg8::StaticOrder S; S.init(NTOK, 6144, (int)gridDim.x, (int)blockIdx.x);
      pg8::gemm_phase<pg8::EpiRetIn, pg8::StaticOrder, true, true>(ldsl, g, S, pg8::EpiRetIn{q, k, v, gbuf, (const float*)rope}); }
    GRID_BAR();
    p_scores(lds_raw, q, k, P);
    GRID_BAR();
    p_ret_mfma(lds_raw, q, k, v, P);
    GRID_BAR();
    p_headnorm(v, gbuf);
    { pg8::Gemm g{xb, w_in_t + (size_t)C_GATE * 1024, NTOK, 2048, 1024}; pg8::StaticOrder S; S.init(NTOK, 2048, (int)gridDim.x, (int)blockIdx.x);
      pg8::gemm_phase<pg8::EpiGates, pg8::StaticOrder, true, true>(ldsl, g, S, pg8::EpiGates{b_merge, gates}); }
    GRID_BAR();
    { pg8::Gemm g{v, w_ro_t, NTOK, 1024, 2048}; pg8::StaticOrder S; S.init(NTOK, 1024, (int)gridDim.x, (int)blockIdx.x);
      pg8::gemm_phase<pg8::EpiMerge<0>, pg8::StaticOrder, true, true>(ldsl, g, S, pg8::EpiMerge<0>{gates, nullptr, m1}); }
    GRID_BAR();
    { pg8::Gemm g{gl, w_lo_t, NTOK, 1024, 1536}; pg8::StaticOrder S; S.init(NTOK, 1024, (int)gridDim.x, (int)blockIdx.x);
      pg8::gemm_phase<pg8::EpiMerge<1>, pg8::StaticOrder, true, true>(ldsl, g, S, pg8::EpiMerge<1>{gates, m1, merged}); }
    GRID_BAR();
    { pg8::Gemm g{merged, w_out_t, NTOK, 1024, 1024}; pg8::StaticOrder S; S.init(NTOK, 1024, (int)gridDim.x, (int)blockIdx.x);
      pg8::gemm_phase<pg8::EpiOut, pg8::StaticOrder, true, true>(ldsl, g, S, pg8::EpiOut{x, (bf16_t*)out, ALPHA}); }
    GRID_BAR();
    p_ln1_route(ldsf, (const bf16_t*)out, x1b, x1q, ln1_g, ln1_b, ws + WS_RTAB, route_e, route_w, cnt, list, rsb);
    p_expert_weights(ldsf, w_eg, w_eu, w_ed, wgu8, wd8);
    GRID_BAR();
    {
        PG8_LAS pg8::MoeTab* tab = (PG8_LAS pg8::MoeTab*)(ldsl + LDS_TAB);
        pg8::moe_build_tab(tab, cnt);
        const int T = tab->tileStart[32];
        { pg8::Gemm g{(const bf16_t*)x1q, (const bf16_t*)wgu8, T * 256, 32 * 1024, 512}; pg8::MoeOrder<true> S{T * 4, (int)gridDim.x, (int)blockIdx.x, tab, list};
          pg8::gemm_phase<pg8::EpiSwiGLU8, pg8::MoeOrder<true>, true, true, true>(ldsl, g, S, pg8::EpiSwiGLU8{(unsigned char*)hbuf}); }
        GRID_BAR();
        { pg8::Gemm g{hbuf, (const bf16_t*)wd8, T * 256, 32 * 1024, 256}; pg8::MoeOrder<false> S{T * 4, (int)gridDim.x, (int)blockIdx.x, tab, list};
          pg8::gemm_phase<pg8::EpiMoeOut8, pg8::MoeOrder<false>, true, true, true>(ldsl, g, S, pg8::EpiMoeOut8{tab, list, (const float*)route_w, ys}); }
    }
    GRID_BAR();
    p_final(out, x1b, ys, ln2_g, ln2_b);
}

extern "C" void kernel_launch(void* const* d_in, const int* in_sizes, int n_in, void* d_out, int out_size, void* d_ws, size_t ws_size, hipStream_t stream) {
    static int grid = 0;
    if (grid == 0) {
        if (n_in != 24 || in_sizes[0] != NTOK * DM || out_size != NTOK * DM || ws_size < WS_END) {
            fprintf(stderr, "kernel_launch: unexpected shapes (n_in %d, in0 %d, out %d, ws %zu)\n", n_in, n_in > 0 ? in_sizes[0] : -1, out_size, ws_size); grid = -1; return; }
        int dev = 0, cus = 0, per_cu = 0;
        if (hipGetDevice(&dev) != hipSuccess || hipDeviceGetAttribute(&cus, hipDeviceAttributeMultiprocessorCount, dev) != hipSuccess) { fprintf(stderr, "kernel_launch: device query failed\n"); grid = -1; return; }
        if (hipFuncSetAttribute((const void*)mega_fwd, hipFuncAttributeMaxDynamicSharedMemorySize, LDS_BYTES) != hipSuccess) { fprintf(stderr, "kernel_launch: hipFuncSetAttribute failed\n"); grid = -1; return; }
        if (hipOccupancyMaxActiveBlocksPerMultiprocessor(&per_cu, (const void*)mega_fwd, NTHR, LDS_BYTES) != hipSuccess || per_cu < 1) {
            fprintf(stderr, "kernel_launch: occupancy query reports %d workgroups per CU\n", per_cu); (void)hipGetLastError(); grid = -1; return; }
        grid = cus;
    }
    if (grid < 0) return;
    if (hipMemsetAsync((char*)d_ws + WS_CTL, 0, CTL_ZERO_BYTES, stream) != hipSuccess) { fprintf(stderr, "kernel_launch: memset failed\n"); return; }
    Args a{};
    for (int i = 0; i < 24; ++i) a.in[i] = (const float*)d_in[i];
    a.out = (float*)d_out; a.ws = (unsigned char*)d_ws;
    hipLaunchKernelGGL(mega_fwd, dim3(grid), dim3(NTHR), LDS_BYTES, stream, a);
    const hipError_t le = hipPeekAtLastError();
    if (le != hipSuccess) fprintf(stderr, "kernel_launch: launch failed: %s\n", hipGetErrorName(le));
}
```

```cpp
#include <hip/hip_runtime.h>
#include <cstdio>
#include <cstdint>

typedef unsigned short bf16_t;
#define DEV __device__ __forceinline__
#define LAS __attribute__((address_space(3)))

DEV int otid() { int t = threadIdx.x; asm volatile("" : "+v"(t)); return t; }
DEV float bf2f(bf16_t h) { return __uint_as_float(((unsigned)h) << 16); }
typedef short bf16x8_t __attribute__((ext_vector_type(8)));
typedef unsigned u32x4_t __attribute__((ext_vector_type(4)));
DEV bf16_t f2bf(float f) { unsigned u = __float_as_uint(f); return (bf16_t)((u + 0x7fffu + ((u >> 16) & 1u)) >> 16); }

constexpr int NTHR = 512;
constexpr int NTOK = 32768, DM = 1024, SEQ = 8192;
constexpr int WIN_N = 11264;
constexpr int C_Q = 0, C_K = 1024, C_V = 2048, C_G = 4096, C_U = 6144, C_GL = 7680, C_GATE = 9216;
constexpr float ALPHA = 1.189207115002721f;
constexpr float LN_EPS = 1e-5f;
constexpr size_t MiB = 1u << 20;
constexpr size_t WS_CTL = 0;
constexpr size_t CTL_ZERO_BYTES = 64 * 1024;
constexpr int CW_BAR = 4096;
constexpr size_t WS_ROPE = 1 * MiB;
constexpr size_t WS_ROUTE_E = 9 * MiB;
constexpr size_t WS_ROUTE_W = 9 * MiB + 512 * 1024;
constexpr size_t WS_LIST = 10 * MiB;
constexpr size_t WS_WRG_T = 14 * MiB;
constexpr size_t WS_RSB = 15 * MiB + 512 * 1024;
constexpr size_t WS_RTAB = 22 * MiB;
constexpr size_t WS_SEGA = 16 * MiB;
constexpr size_t WS_SEGH = 18 * MiB;
constexpr size_t WS_CARRY = 20 * MiB;
constexpr size_t WS_XB = 32 * MiB;
constexpr size_t WS_GL = 96 * MiB;
constexpr size_t WS_ULRU = 192 * MiB;
constexpr size_t WS_Q = 192 * MiB;
constexpr size_t WS_K = 256 * MiB;
constexpr size_t WS_GATES = 192 * MiB;
constexpr size_t WS_UCONV = 288 * MiB;
constexpr size_t WS_P = 320 * MiB;
constexpr size_t WS_V = 352 * MiB;
constexpr size_t WS_EPS = 384 * MiB;
constexpr size_t WS_H = 192 * MiB;
constexpr size_t WS_YSLOT = 264 * MiB;
constexpr size_t WS_WGU_T = 352 * MiB;
constexpr size_t WS_WD_T = 416 * MiB;
constexpr size_t WS_X1Q = 160 * MiB;
constexpr int LDS_TAB = 131072;
constexpr size_t WS_WIN_T = 480 * MiB;
constexpr size_t WS_WRO_T = 502 * MiB;
constexpr size_t WS_RETN8 = 256 * MiB;
constexpr size_t WS_WLO_T = 506 * MiB;
constexpr size_t WS_WOUT_T = 509 * MiB;
constexpr size_t WS_END = 512 * MiB;
constexpr int LDS_BYTES = 163840;
constexpr int LDS_MISC = 163840 - 512;

#define XB_TMO      128
#define XB_XCNT(j)  (256  + 64 * (j))
#define XB_XSUB(j)  (1280 + 64 * (j))
#define XB_XGEN(j)  (2304 + 64 * (j))
#define XB_TOP      3328
#define XB_TOPGEN   3392
#define XCD_BAR_WORDS 3456
#define XB_SPIN_CAP (1u << 22)
DEV unsigned xb_ld(unsigned* p)              { return __hip_atomic_load(p, __ATOMIC_RELAXED, __HIP_MEMORY_SCOPE_AGENT); }
DEV unsigned xb_add(unsigned* p, unsigned v) { return __hip_atomic_fetch_add(p, v, __ATOMIC_RELAXED, __HIP_MEMORY_SCOPE_AGENT); }
DEV unsigned xb_xcc_id() { return (unsigned)__builtin_amdgcn_s_getreg((3 << 11) | 20) & 0xFu; }
#define XB_SPIN(cond, bar) do { unsigned _sp = 0; while (cond) { __builtin_amdgcn_s_sleep(1); \
    if ((++_sp & 255u) == 0u) { if (xb_ld(&(bar)[XB_TMO])) break; if (_sp > XB_SPIN_CAP) { atomicAdd(&(bar)[XB_TMO], 1u); break; } } } } while (0)
struct XcdBarrier { unsigned* bar; unsigned x; volatile LAS unsigned* st; };
DEV XcdBarrier xcd_barrier_post(unsigned* bar, volatile LAS unsigned* st) {
    XcdBarrier b; b.bar = bar; b.x = xb_xcc_id(); b.st = st;
    if (otid() == 0) (void)xb_add(&bar[XB_XCNT(b.x)], 1u);
    return b;
}
DEV void xcd_barrier_complete(unsigned* bar, unsigned x, unsigned& nloc, unsigned& nx) {
    const unsigned G = gridDim.x * gridDim.y * gridDim.z;
    unsigned sum, cnt, mine, sp = 0u;
    for (;;) {
        sum = 0u; cnt = 0u; mine = 0u;
#pragma unroll
        for (unsigned j = 0; j < 16; ++j) { const unsigned c = xb_ld(&bar[XB_XCNT(j)]); sum += c; cnt += (c > 0u) ? 1u : 0u; mine = (j == x) ? c : mine; }
        if (sum == G) break;
        __builtin_amdgcn_s_sleep(1);
        if ((++sp & 255u) == 0u) { if (xb_ld(&bar[XB_TMO])) break; if (sp > XB_SPIN_CAP) { atomicAdd(&bar[XB_TMO], 1u); break; } }
    }
    nloc = mine > 0u ? mine : 1u; nx = cnt > 0u ? cnt : 1u;
}
DEV void xcd_barrier(const XcdBarrier& b) {
    asm volatile("s_waitcnt vmcnt(0)" ::: "memory");
    __syncthreads();
    if (otid() == 0) {
        unsigned* bar = b.bar;
        __builtin_amdgcn_s_waitcnt(0);
        unsigned nloc = b.st[0], nx = b.st[1];
        if (nloc == 0u) { xcd_barrier_complete(bar, b.x, nloc, nx); b.st[0] = nloc; b.st[1] = nx; }
        const unsigned old = xb_add(&bar[XB_XSUB(b.x)], 1u);
        const unsigned gen = old / nloc;
        if (old + 1u == (gen + 1u) * nloc) {
            __builtin_amdgcn_fence(__ATOMIC_RELEASE, "agent");
            asm volatile("s_waitcnt vmcnt(0)" ::: "memory");
            const unsigned og = xb_add(&bar[XB_TOP], 1u);
            const unsigned tg = og / nx;
            if (og + 1u == (tg + 1u) * nx) xb_add(&bar[XB_TOPGEN], 1u);
            else XB_SPIN(xb_ld(&bar[XB_TOPGEN]) == tg, bar);
            __builtin_amdgcn_fence(__ATOMIC_ACQUIRE, "agent");
            xb_add(&bar[XB_XGEN(b.x)], 1u);
            asm volatile("s_waitcnt vmcnt(0)" ::: "memory");
        } else {
            XB_SPIN(xb_ld(&bar[XB_XGEN(b.x)]) == gen, bar);
            __builtin_amdgcn_fence(__ATOMIC_ACQUIRE, "agent");
            asm volatile("s_waitcnt vmcnt(0)" ::: "memory");
        }
    }
    __syncthreads();
}

namespace pg8 {
#define PG8_LAS __attribute__((address_space(3)))
typedef unsigned short bf16_t;
typedef short bf16x8 __attribute__((ext_vector_type(8)));
typedef float f32x4 __attribute__((ext_vector_type(4)));
typedef unsigned u32x4 __attribute__((ext_vector_type(4)));
constexpr int BM = 256, BK = 64, HALF = 128, HTB = HALF * BK * 2  , STAGE_BYTES = 8 * HTB, NXCD = 8, WGM = 8;

__host__ __device__ __forceinline__ int lds_byte(int r, int c) { const int st = (r >> 4) * 2 + (c >> 5), rr = r & 15, cc = c & 31, ob = rr * 64 + cc * 2; return st * 1024 + (ob ^ (((ob >> 9) & 1) << 5)); }
__host__ __device__ __forceinline__ void stage_rc(int b, int& R, int& C) { const int st = b / 1024, sb = b % 1024, swz = sb ^ (((sb >> 9) & 1) << 5); R = (st >> 1) * 16 + swz / 64; C = (st & 1) * 32 + (swz % 64) / 2; }
__host__ __device__ __forceinline__ int perm32(int rho) { const int n = rho >> 4, i = rho & 15; return 8 * (i >> 2) + 4 * n + (i & 3); }

struct Unit { int pm, pn; };
struct Gemm { const bf16_t* A; const bf16_t* Bt; int M, N, K; };

struct StaticOrder {
    int nM, nN, nwg, G, c;
    __host__ __device__ void init(int M, int N, int G_, int c_) { nM = M / BM; nN = N / BM; nwg = nM * nN; G = G_; c = c_; }
    __host__ __device__ bool next(int i, Unit& u) const {
        const long L = (long)i * G + c; if (L >= nwg) return false;
        int wgid = (int)L; { const int q = nwg / NXCD, r = nwg % NXCD, xcd = wgid % NXCD, off = wgid / NXCD; wgid = (xcd < r ? xcd * (q + 1) : r * (q + 1) + (xcd - r) * q) + off; }
        const int nig = WGM * nN, gid = wgid / nig, fm = gid * WGM, gsz = (nM - fm) < WGM ? (nM - fm) : WGM;
        u.pm = fm + ((wgid % nig) % gsz); u.pn = (wgid % nig) / gsz; return true;
    }
    __device__ __forceinline__ void a_ready(const Unit&) const {}
    __device__ __forceinline__ void done(const Unit&) const {}
    static constexpr bool PRE = false;
    __device__ __forceinline__ void a_pre(const Gemm&, const Unit&, const int (&)[2], unsigned (&)[2][2]) const {}
    __device__ __forceinline__ void a_cvt(const Gemm&, const int (&)[2], const unsigned (&)[2][2], unsigned (&)[2][2]) const {}
    __device__ __forceinline__ const char* a_base(const Gemm& g, const Unit& u) const { return (const char*)g.A + (size_t)u.pm * (size_t)(BM * g.K * 2); }
    __device__ __forceinline__ void a_off(const Gemm& g, const Unit&, const int (&R)[2], const int (&C)[2], unsigned (&v)[2][2]) const {
        _Pragma("unroll") for (int hh = 0; hh < 2; ++hh) _Pragma("unroll") for (int i = 0; i < 2; ++i) v[hh][i] = (unsigned)((hh * HALF + R[i]) * g.K + C[i]) * 2u; }
};
typedef __bf16 bf16x2_t __attribute__((ext_vector_type(2)));
typedef float f32x2_t __attribute__((ext_vector_type(2)));
__device__ __forceinline__ unsigned cvt_pk_bf16(float lo, float hi) { f32x2_t v = {lo, hi}; return __builtin_bit_cast(unsigned, __builtin_convertvector(v, bf16x2_t)); }
typedef int i32x4 __attribute__((ext_vector_type(4)));
typedef int i32x8 __attribute__((ext_vector_type(8)));
template <bool MX8> struct Frag { struct A4 { bf16x8 v[4][2]; }; struct B2 { bf16x8 v[2][2]; }; };
template <> struct Frag<true> { struct A4 { i32x8 v[4]; }; struct B2 { i32x8 v[2]; }; };
__device__ __forceinline__ i32x8 ld32(const PG8_LAS unsigned char* p0, const PG8_LAS unsigned char* p1) { const i32x4 a = *(const PG8_LAS i32x4*)p0, b = *(const PG8_LAS i32x4*)p1; return __builtin_shufflevector(a, b, 0, 1, 2, 3, 4, 5, 6, 7); }
template <class Epi, class Sched, bool ALIGN_EPI = false, bool SP2 = false, bool MX8 = false>
__device__ __forceinline__ void gemm_phase(PG8_LAS unsigned char* lds, const Gemm g, const Sched& S, const Epi& E) {
    int tid_ = otid(); asm volatile("" : "+v"(tid_));
    const int tid = tid_, wid = __builtin_amdgcn_readfirstlane(tid >> 6), lane = tid & 63, wr = wid >> 2, wc = wid & 3, fr = lane & 15, fq = lane >> 4;
    const int K = g.K, nt = K / BK;
    unsigned voffB[2], vA[2][2], vN[2][2]; int sR[2], sC[2];
#pragma unroll
    for (int i = 0; i < 2; ++i) { int R, C; stage_rc(tid * 16 + i * 8192, R, C); const int Rb = Epi::PERM ? ((R & ~31) + perm32(R & 31)) : R;
        sR[i] = R; sC[i] = C; voffB[i] = (unsigned)(Rb * K + C) * 2u; }
    const size_t kstep = (size_t)(BK * 2);
    const size_t hstep = (size_t)HALF * K * 2;
    const size_t tstep = 2 * hstep;
    const unsigned ldsw = (unsigned)wid * 1024u;
    const int aoff = lds_byte(wr * 64 + fr, fq * 8), boff = lds_byte(wc * 32 + fr, fq * 8);
#define PG8_SA(b, h) (((b) * 2 + (h)) * HTB)
#define PG8_SB(b, h) ((4 + (b) * 2 + (h)) * HTB)
#define PG8_STAGE(bufoff, gbase, voff) do { _Pragma("unroll") for (int _i = 0; _i < 2; ++_i) \
        __builtin_amdgcn_global_load_lds((const unsigned*)((const char*)(gbase) + (voff)[_i]), (PG8_LAS unsigned*)(lds + (bufoff) + ldsw + _i * 8192), 16, 0, 0); } while (0)
#define PG8_LDA(dst, b, h) do { if constexpr (MX8) { _Pragma("unroll") for (int m = 0; m < 4; ++m) dst.v[m] = ld32(lds + PG8_SA(b, h) + aoff + m * 2048, lds + PG8_SA(b, h) + aoff + m * 2048 + 1024); } \
        else { _Pragma("unroll") for (int m = 0; m < 4; ++m) _Pragma("unroll") for (int k = 0; k < 2; ++k) dst.v[m][k] = *(const PG8_LAS bf16x8*)(lds + PG8_SA(b, h) + aoff + m * 2048 + k * 1024); } } while (0)
#define PG8_LDB(dst, b, h) do { if constexpr (MX8) { _Pragma("unroll") for (int n = 0; n < 2; ++n) dst.v[n] = ld32(lds + PG8_SB(b, h) + boff + n * 2048, lds + PG8_SB(b, h) + boff + n * 2048 + 1024); } \
        else { _Pragma("unroll") for (int n = 0; n < 2; ++n) _Pragma("unroll") for (int k = 0; k < 2; ++k) dst.v[n][k] = *(const PG8_LAS bf16x8*)(lds + PG8_SB(b, h) + boff + n * 2048 + k * 1024); } } while (0)
#define PG8_MMA(ai, bj, At, Bt) do { __builtin_amdgcn_s_setprio(1); \
        if constexpr (MX8) { _Pragma("unroll") for (int m = 0; m < 4; ++m) _Pragma("unroll") for (int n = 0; n < 2; ++n) \
            { acc[ai][bj][m][n] = __builtin_amdgcn_mfma_scale_f32_16x16x128_f8f6f4(Bt.v[n], At.v[m], acc[ai][bj][m][n], 0, 0, 0, 0x7f7f7f7f, 0, 0x7f7f7f7f); asm volatile("" : "+v"(acc[ai][bj][m][n])); } } \
        else { _Pragma("unroll") for (int m = 0; m < 4; ++m) _Pragma("unroll") for (int n = 0; n < 2; ++n) _Pragma("unroll") for (int k = 0; k < 2; ++k) \
            acc[ai][bj][m][n] = __builtin_amdgcn_mfma_f32_16x16x32_bf16(Bt.v[n][k], At.v[m][k], acc[ai][bj][m][n], 0, 0, 0); } \
        __builtin_amdgcn_s_setprio(0); } while (0)
#define PG8_WAIT_V(n) asm volatile("s_waitcnt vmcnt(" #n ")" ::: "memory")
#define PG8_WAIT_L(n) asm volatile("s_waitcnt lgkmcnt(" #n ")" ::: "memory")
#define PG8_BAR __builtin_amdgcn_s_barrier()
#define PG8_SCHED __builtin_amdgcn_sched_barrier(0)
    Unit cur, nxt; int ui = 0;
    if (!S.next(0, cur)) return;
    f32x4 acc[2][2][4][2];
#pragma unroll
    for (int a = 0; a < 2; ++a)
#pragma unroll
        for (int b = 0; b < 2; ++b)
#pragma unroll
            for (int m = 0; m < 4; ++m)
#pragma unroll
                for (int n = 0; n < 2; ++n) acc[a][b][m][n] = (f32x4){0.f, 0.f, 0.f, 0.f};
    typename Frag<MX8>::A4 At; typename Frag<MX8>::B2 B0, B1;
    const char* cA = S.a_base(g, cur); const char* cB = (const char*)g.Bt + (size_t)cur.pn * tstep;
    S.a_ready(cur); S.a_off(g, cur, sR, sC, vA);
    unsigned rawN[2][2] = {{0u, 0u}, {0u, 0u}};
    if constexpr (Sched::PRE) { Unit n1; if (S.next(1, n1)) S.a_pre(g, n1, sR, rawN); }
    if constexpr (SP2) {
        PG8_STAGE(PG8_SB(0, 0), cB, voffB); PG8_STAGE(PG8_SB(0, 1), cB + hstep, voffB); PG8_STAGE(PG8_SA(0, 0), cA, vA[0]); PG8_STAGE(PG8_SA(0, 1), cA, vA[1]);
        if (wr == 1) PG8_BAR;
        PG8_WAIT_V(2); PG8_BAR;
        PG8_STAGE(PG8_SB(1, 0), cB + kstep, voffB); PG8_STAGE(PG8_SA(1, 0), cA + kstep, vA[0]); PG8_STAGE(PG8_SB(1, 1), cB + hstep + kstep, voffB);
        PG8_WAIT_V(6); PG8_BAR;
    } else { static_assert(SP2, "only the SP2 K-loop is kept in this file"); }
    for (;;) {
        const bool has_next = S.next(ui + 1, nxt);
        const char* nA = has_next ? S.a_base(g, nxt) : cA; const char* nB = has_next ? (const char*)g.Bt + (size_t)nxt.pn * tstep : cB;
        if (has_next) { if constexpr (Sched::PRE) S.a_cvt(g, sC, rawN, vN); else S.a_off(g, nxt, sR, sC, vN); } else { vN[0][0] = vA[0][0]; vN[0][1] = vA[0][1]; vN[1][0] = vA[1][0]; vN[1][1] = vA[1][1]; }
#pragma unroll 1
        for (int t = 0; t < nt; t += 2) {
            const bool last = (t == nt - 2);
            const char* a1 = cA + (size_t)(t + 1) * kstep;
            const char* a2 = last ? nA : cA + (size_t)(t + 2) * kstep; const char* b2 = last ? nB : cB + (size_t)(t + 2) * kstep;
            const char* a3 = a2 + kstep; const char* b3 = b2 + kstep;
            unsigned v2[2][2]; v2[0][0] = last ? vN[0][0] : vA[0][0]; v2[0][1] = last ? vN[0][1] : vA[0][1]; v2[1][0] = last ? vN[1][0] : vA[1][0]; v2[1][1] = last ? vN[1][1] : vA[1][1];
            if (last && has_next) S.a_ready(nxt);
            if constexpr (SP2) {
            PG8_LDB(B0, 0, 0); PG8_LDB(B1, 0, 1); PG8_SCHED; PG8_LDA(At, 0, 0); PG8_STAGE(PG8_SA(1, 1), a1, vA[1]);
            PG8_WAIT_V(8); PG8_WAIT_L(0); PG8_BAR; PG8_MMA(0, 0, At, B0); PG8_MMA(0, 1, At, B1); PG8_BAR; PG8_SCHED;
            PG8_LDA(At, 0, 1); PG8_STAGE(PG8_SB(0, 0), b2, voffB); PG8_STAGE(PG8_SB(0, 1), b2 + hstep, voffB); PG8_STAGE(PG8_SA(0, 0), a2, v2[0]);
            PG8_WAIT_V(8); PG8_WAIT_L(0); PG8_BAR; PG8_MMA(1, 0, At, B0); PG8_MMA(1, 1, At, B1); PG8_BAR; PG8_SCHED;
            PG8_LDB(B0, 1, 0); PG8_LDB(B1, 1, 1); PG8_SCHED; PG8_LDA(At, 1, 0); PG8_STAGE(PG8_SA(0, 1), a2, v2[1]);
            PG8_WAIT_V(8); PG8_WAIT_L(0); PG8_BAR; PG8_MMA(0, 0, At, B0); PG8_MMA(0, 1, At, B1); PG8_BAR; PG8_SCHED;
            PG8_LDA(At, 1, 1); PG8_STAGE(PG8_SB(1, 0), b3, voffB); PG8_STAGE(PG8_SB(1, 1), b3 + hstep, voffB); PG8_STAGE(PG8_SA(1, 0), a3, v2[0]);
            PG8_WAIT_V(8); PG8_WAIT_L(0); PG8_BAR; PG8_MMA(1, 0, At, B0); PG8_MMA(1, 1, At, B1); PG8_BAR; PG8_SCHED;
            }
        }
        if constexpr (Sched::PRE) { Unit n2; if (has_next && S.next(ui + 2, n2)) S.a_pre(g, n2, sR, rawN); }
        if constexpr (ALIGN_EPI) { if (wr == 0) PG8_BAR; }
        if constexpr (!Epi::AFTER_DRAIN) { E(acc, cur, wr, wc, fr, fq); S.done(cur); }
        if (!has_next) break;
#pragma unroll
        for (int a = 0; a < 2; ++a)
#pragma unroll
            for (int b = 0; b < 2; ++b)
#pragma unroll
                for (int m = 0; m < 4; ++m)
#pragma unroll
                    for (int n = 0; n < 2; ++n) acc[a][b][m][n] = (f32x4){0.f, 0.f, 0.f, 0.f};
        cur = nxt; cA = nA; cB = nB; ++ui; vA[0][0] = vN[0][0]; vA[0][1] = vN[0][1]; vA[1][0] = vN[1][0]; vA[1][1] = vN[1][1];
        if constexpr (ALIGN_EPI) { if (wr == 1) PG8_BAR; }
    }
    PG8_WAIT_V(0);
    if constexpr (!ALIGN_EPI) { if (wr == 0) PG8_BAR; }
    PG8_BAR;
    if constexpr (Epi::AFTER_DRAIN) { E.fused(acc, cur, wr, wc, fr, fq, lds, wid, lane); S.done(cur); }
#undef PG8_SA
#undef PG8_SB
#undef PG8_STAGE
#undef PG8_LDA
#undef PG8_LDB
#undef PG8_MMA
#undef PG8_WAIT_V
#undef PG8_WAIT_L
#undef PG8_BAR
#undef PG8_SCHED
}

__device__ __forceinline__ float fsig(float x) { return __builtin_amdgcn_rcpf(1.f + __expf(-x)); }
__device__ __forceinline__ float fsilu(float x) { return x * fsig(x); }
__device__ __forceinline__ float fgelu(float x) { return x * fsig(1.5957691216057308f * (x + 0.044715f * x * x * x)); }
__device__ __forceinline__ u32x4 pack8(const f32x4& v0, const f32x4& v1) { u32x4 w; w.x = cvt_pk_bf16(v0[0], v0[1]); w.y = cvt_pk_bf16(v0[2], v0[3]); w.z = cvt_pk_bf16(v1[0], v1[1]); w.w = cvt_pk_bf16(v1[2], v1[3]); return w; }
__device__ __forceinline__ void unpack8(const u32x4& w, f32x4& v0, f32x4& v1) {
    v0[0] = __uint_as_float(w.x << 16); v0[1] = __uint_as_float(w.x & 0xffff0000u); v0[2] = __uint_as_float(w.y << 16); v0[3] = __uint_as_float(w.y & 0xffff0000u);
    v1[0] = __uint_as_float(w.z << 16); v1[1] = __uint_as_float(w.z & 0xffff0000u); v1[2] = __uint_as_float(w.w << 16); v1[3] = __uint_as_float(w.w & 0xffff0000u); }

struct EpiLruIn {
    static constexpr bool PERM = true, AFTER_DRAIN = false;
    bf16_t* u; bf16_t* gl;
    __device__ __forceinline__ void operator()(const f32x4 (&acc)[2][2][4][2], const Unit& un, int wr, int wc, int fr, int fq) const {
        const int row0 = un.pm * BM + wr * 64 + fr; const bool isg = un.pn >= 6;
        bf16_t* base = (isg ? gl : u) + (isg ? un.pn - 6 : un.pn) * BM + wc * 32 + 8 * fq;
#pragma unroll
        for (int ai = 0; ai < 2; ++ai)
#pragma unroll
            for (int m = 0; m < 4; ++m) { bf16_t* rowp = base + (size_t)(row0 + ai * HALF + m * 16) * 1536;
#pragma unroll
                for (int bj = 0; bj < 2; ++bj) { f32x4 v0 = acc[ai][bj][m][0], v1 = acc[ai][bj][m][1];
                    if (isg) {
#pragma unroll
                        for (int e = 0; e < 4; ++e) { v0[e] = fgelu(v0[e]); v1[e] = fgelu(v1[e]); } }
                    *(u32x4*)(rowp + bj * HALF) = pack8(v0, v1); } }
    }
};
__device__ __forceinline__ float clamp448(float v) { return fminf(fmaxf(v, -448.f), 448.f); }
__device__ __forceinline__ unsigned pk4_fp8(float a, float b, float c, float d) { int p = __builtin_amdgcn_cvt_pk_fp8_f32(clamp448(a), clamp448(b), 0, false); p = __builtin_amdgcn_cvt_pk_fp8_f32(clamp448(c), clamp448(d), p, true); return (unsigned)p; }
struct EpiRetIn {
    static constexpr bool PERM = true, AFTER_DRAIN = false;
    bf16_t* q; bf16_t* k; bf16_t* v; bf16_t* g; const float* rope;
    __device__ __forceinline__ void operator()(const f32x4 (&acc)[2][2][4][2], const Unit& un, int wr, int wc, int fr, int fq) const {
        const int row0 = un.pm * BM + wr * 64 + fr;
        if (un.pn < 8) {
            const bool isk = un.pn >= 4; const int h = un.pn & 3;
            const float lg = __log2f(1.f - __builtin_amdgcn_exp2f(-5.f - (float)h));
            const int jb = wc * 32 + 8 * fq;
            bf16_t* base = (isk ? k : q) + h * 256 + jb;
#pragma unroll
            for (int ai = 0; ai < 2; ++ai)
#pragma unroll
                for (int m = 0; m < 4; ++m) { const int r = row0 + ai * HALF + m * 16, s = r & 8191, n = s & 127;
                    const float sc = isk ? __builtin_amdgcn_exp2f(-(float)n * lg) * 0.0625f : __builtin_amdgcn_exp2f((float)n * lg) * 64.f;
                    const f32x4* tp = (const f32x4*)(rope + ((size_t)s * 128 + jb) * 2);
                    f32x4 o1[2], o2[2];
#pragma unroll
                    for (int nn = 0; nn < 2; ++nn) { const f32x4 ta = tp[2 * nn], tb = tp[2 * nn + 1]; const f32x4 a = acc[ai][0][m][nn], b = acc[ai][1][m][nn];
                        o1[nn][0] = (a[0] * ta[0] - b[0] * ta[1]) * sc; o2[nn][0] = (a[0] * ta[1] + b[0] * ta[0]) * sc;
                        o1[nn][1] = (a[1] * ta[2] - b[1] * ta[3]) * sc; o2[nn][1] = (a[1] * ta[3] + b[1] * ta[2]) * sc;
                        o1[nn][2] = (a[2] * tb[0] - b[2] * tb[1]) * sc; o2[nn][2] = (a[2] * tb[1] + b[2] * tb[0]) * sc;
                        o1[nn][3] = (a[3] * tb[2] - b[3] * tb[3]) * sc; o2[nn][3] = (a[3] * tb[3] + b[3] * tb[2]) * sc; }
                    if (isk) { bf16_t* rowp = base + (size_t)r * 1024; *(u32x4*)(rowp) = pack8(o1[0], o1[1]); *(u32x4*)(rowp + HALF) = pack8(o2[0], o2[1]); }
                    else { unsigned char* qb = (unsigned char*)q + ((size_t)(r >> 7) * 4 + h) * 32768 + (size_t)(((wc >> 1) * 4 + fq) * 128 + n) * 16 + (wc & 1) * 8;
                        uint2 a, b; a.x = pk4_fp8(o1[0][0], o1[0][1], o1[0][2], o1[0][3]); a.y = pk4_fp8(o1[1][0], o1[1][1], o1[1][2], o1[1][3]);
                        b.x = pk4_fp8(o2[0][0], o2[0][1], o2[0][2], o2[0][3]); b.y = pk4_fp8(o2[1][0], o2[1][1], o2[1][2], o2[1][3]);
                        *(uint2*)qb = a; *(uint2*)(qb + 16384) = b; }
                    asm volatile("" ::: "memory"); }
        } else {
            const bool isg = un.pn >= 16;
            bf16_t* base = (isg ? g : v) + ((un.pn - 8) & 7) * BM + wc * 32 + 8 * fq;
#pragma unroll
            for (int ai = 0; ai < 2; ++ai)
#pragma unroll
                for (int m = 0; m < 4; ++m) { bf16_t* rowp = base + (size_t)(row0 + ai * HALF + m * 16) * 2048;
#pragma unroll
                    for (int bj = 0; bj < 2; ++bj) { f32x4 v0 = acc[ai][bj][m][0], v1 = acc[ai][bj][m][1];
                        if (isg) {
#pragma unroll
                            for (int e = 0; e < 4; ++e) { v0[e] = fsilu(v0[e]); v1[e] = fsilu(v1[e]); } }
                        *(u32x4*)(rowp + bj * HALF) = pack8(v0, v1); } }
        }
    }
};
struct EpiGates {
    static constexpr bool PERM = true, AFTER_DRAIN = false;
    const float* bm; bf16_t* gates;
    __device__ __forceinline__ void operator()(const f32x4 (&acc)[2][2][4][2], const Unit& un, int wr, int wc, int fr, int fq) const {
        const int row0 = un.pm * BM + wr * 64 + fr, col0 = un.pn * BM + wc * 32 + 8 * fq;
        f32x4 bv[2][2];
#pragma unroll
        for (int bj = 0; bj < 2; ++bj)
#pragma unroll
            for (int n = 0; n < 2; ++n) bv[bj][n] = *(const f32x4*)(bm + col0 + bj * HALF + 4 * n);
#pragma unroll
        for (int ai = 0; ai < 2; ++ai)
#pragma unroll
            for (int m = 0; m < 4; ++m) { unsigned char* rowp = (unsigned char*)gates + (size_t)(row0 + ai * HALF + m * 16) * 2048 + col0;
#pragma unroll
                for (int bj = 0; bj < 2; ++bj) { f32x4 v0 = acc[ai][bj][m][0] + bv[bj][0], v1 = acc[ai][bj][m][1] + bv[bj][1];
                    unsigned lo = 0u, hi = 0u;
                    lo = __builtin_amdgcn_cvt_pk_u8_f32(255.f * fsig(v0[0]), 0, lo); lo = __builtin_amdgcn_cvt_pk_u8_f32(255.f * fsig(v0[1]), 1, lo); lo = __builtin_amdgcn_cvt_pk_u8_f32(255.f * fsig(v0[2]), 2, lo); lo = __builtin_amdgcn_cvt_pk_u8_f32(255.f * fsig(v0[3]), 3, lo);
                    hi = __builtin_amdgcn_cvt_pk_u8_f32(255.f * fsig(v1[0]), 0, hi); hi = __builtin_amdgcn_cvt_pk_u8_f32(255.f * fsig(v1[1]), 1, hi); hi = __builtin_amdgcn_cvt_pk_u8_f32(255.f * fsig(v1[2]), 2, hi); hi = __builtin_amdgcn_cvt_pk_u8_f32(255.f * fsig(v1[3]), 3, hi);
                    uint2 o; o.x = lo; o.y = hi; *(uint2*)(rowp + bj * HALF) = o; } }
    }
};
template <int MODE> struct EpiMerge {
    static constexpr bool PERM = true, AFTER_DRAIN = false;
    const bf16_t* gates; const bf16_t* m1in; bf16_t* o; float ds;
    __device__ __forceinline__ void operator()(const f32x4 (&acc)[2][2][4][2], const Unit& un, int wr, int wc, int fr, int fq) const {
        const int row0 = un.pm * BM + wr * 64 + fr, col0 = un.pn * BM + wc * 32 + 8 * fq;
        uint2 gw[2][2]; u32x4 pm[2][2];
#define EPM_LD(g_, b_) do { const size_t r_ = (size_t)(row0 + ((g_) >> 2) * HALF + ((g_) & 3) * 16); \
            _Pragma("unroll") for (int bj = 0; bj < 2; ++bj) { gw[b_][bj] = *(const uint2*)((const unsigned char*)gates + r_ * 2048 + MODE * 1024 + col0 + bj * HALF);     \
                if (MODE == 1) pm[b_][bj] = *(const u32x4*)(m1in + r_ * 1024 + col0 + bj * HALF); } } while (0)
        EPM_LD(0, 0);
#pragma unroll
        for (int g = 0; g < 8; ++g) {
            if (g + 1 < 8) EPM_LD(g + 1, (g + 1) & 1);
            asm volatile("" ::: "memory");
            const int ai = g >> 2, m = g & 3; const size_t r = (size_t)(row0 + ai * HALF + m * 16);
#pragma unroll
            for (int bj = 0; bj < 2; ++bj) { const int c = col0 + bj * HALF; const uint2 w = gw[g & 1][bj];
                const float gs = ds * (1.f / 255.f);
                const f32x4 g0 = {(float)(w.x & 0xffu) * gs, (float)((w.x >> 8) & 0xffu) * gs, (float)((w.x >> 16) & 0xffu) * gs, (float)(w.x >> 24) * gs};
                const f32x4 g1 = {(float)(w.y & 0xffu) * gs, (float)((w.y >> 8) & 0xffu) * gs, (float)((w.y >> 16) & 0xffu) * gs, (float)(w.y >> 24) * gs};
                f32x4 v0 = acc[ai][bj][m][0] * g0, v1 = acc[ai][bj][m][1] * g1;
                if (MODE == 1) { f32x4 p0, p1; unpack8(pm[g & 1][bj], p0, p1); v0 += p0; v1 += p1; }
                *(u32x4*)(o + r * 1024 + c) = pack8(v0, v1); }
            asm volatile("" ::: "memory");
        }
#undef EPM_LD
    }
};
struct EpiOut {
    static constexpr bool PERM = true, AFTER_DRAIN = false;
    const float* x; bf16_t* y; float alpha;
    __device__ __forceinline__ void operator()(const f32x4 (&acc)[2][2][4][2], const Unit& un, int wr, int wc, int fr, int fq) const {
        const int row0 = un.pm * BM + wr * 64 + fr, col0 = un.pn * BM + wc * 32 + 8 * fq;
        f32x4 xr[2][4];
#define EPO_LD(g_, d_) do { const size_t o_ = (size_t)(row0 + ((g_) >> 2) * HALF + ((g_) & 3) * 16) * 1024 + col0; \
            d_[0] = *(const f32x4*)(x + o_); d_[1] = *(const f32x4*)(x + o_ + 4); d_[2] = *(const f32x4*)(x + o_ + HALF); d_[3] = *(const f32x4*)(x + o_ + HALF + 4); } while (0)
        EPO_LD(0, xr[0]);
#pragma unroll
        for (int g = 0; g < 8; ++g) {
            if (g + 1 < 8) EPO_LD(g + 1, xr[(g + 1) & 1]);
            asm volatile("" ::: "memory");
            const int ai = g >> 2, m = g & 3; const size_t off = (size_t)(row0 + ai * HALF + m * 16) * 1024 + col0;
#pragma unroll
            for (int bj = 0; bj < 2; ++bj) *(u32x4*)(y + off + bj * HALF) = pack8(xr[g & 1][2 * bj] * alpha + acc[ai][bj][m][0], xr[g & 1][2 * bj + 1] * alpha + acc[ai][bj][m][1]);
            asm volatile("" ::: "memory");
        }
#undef EPO_LD
    }
};
struct MoeTab { int tileStart[33]; int cnt[32]; int pad_[3]; int tileExp[320]; };
__device__ __forceinline__ void moe_build_tab(PG8_LAS MoeTab* tab, const int* cnt) {
    const int t_ = otid();
    if (t_ < 32) tab->cnt[t_] = cnt[t_ * 64];
    __syncthreads();
    if (t_ == 0) { int t = 0; for (int e = 0; e < 32; ++e) { const int c = tab->cnt[e], nt = (c + 255) >> 8; tab->tileStart[e] = t; for (int i = 0; i < nt; ++i) tab->tileExp[t + i] = e; t += nt; } tab->tileStart[32] = t; }
    __syncthreads();
}
template <bool GATHER> struct MoeOrder {
    int U, G, c; const PG8_LAS MoeTab* tab; const int* list;
    __device__ __forceinline__ bool next(int i, Unit& u) const {
        const long L = (long)i * G + c; if (L >= U) return false;
        int wgid = (int)L; { const int q = U / NXCD, r = U % NXCD, xcd = wgid % NXCD, off = wgid / NXCD; wgid = (xcd < r ? xcd * (q + 1) : r * (q + 1) + (xcd - r) * q) + off; }
        u.pm = wgid >> 2; u.pn = tab->tileExp[u.pm] * 4 + (wgid & 3); return true;
    }
    __device__ __forceinline__ void a_ready(const Unit&) const {}
    __device__ __forceinline__ void done(const Unit&) const {}
    static constexpr bool PRE = GATHER;
    __device__ __forceinline__ void a_pre(const Gemm&, const Unit& u, const int (&R)[2], unsigned (&raw)[2][2]) const {
        if (GATHER) { const int e = u.pn >> 2, base = (u.pm - tab->tileStart[e]) * BM, ce = tab->cnt[e];
            _Pragma("unroll") for (int hh = 0; hh < 2; ++hh) _Pragma("unroll") for (int i = 0; i < 2; ++i) { const int lr = base + hh * HALF + R[i]; raw[hh][i] = (unsigned)list[e * 32768 + ((lr < ce) ? lr : 0)]; } }
    }
    __device__ __forceinline__ void a_cvt(const Gemm& g, const int (&C)[2], const unsigned (&raw)[2][2], unsigned (&v)[2][2]) const {
        _Pragma("unroll") for (int hh = 0; hh < 2; ++hh) _Pragma("unroll") for (int i = 0; i < 2; ++i) v[hh][i] = (unsigned)((int)(raw[hh][i] >> 1) * g.K + C[i]) * 2u;
    }
    __device__ __forceinline__ const char* a_base(const Gemm& g, const Unit& u) const { return GATHER ? (const char*)g.A : (const char*)g.A + (size_t)u.pm * (size_t)(BM * g.K * 2); }
    __device__ __forceinline__ void a_off(const Gemm& g, const Unit& u, const int (&R)[2], const int (&C)[2], unsigned (&v)[2][2]) const {
        if (!GATHER) { _Pragma("unroll") for (int hh = 0; hh < 2; ++hh) _Pragma("unroll") for (int i = 0; i < 2; ++i) v[hh][i] = (unsigned)((hh * HALF + R[i]) * g.K + C[i]) * 2u; }
        else { const int e = u.pn >> 2, base = (u.pm - tab->tileStart[e]) * BM, ce = tab->cnt[e];
            _Pragma("unroll") for (int hh = 0; hh < 2; ++hh) _Pragma("unroll") for (int i = 0; i < 2; ++i) { const int lr = base + hh * HALF + R[i]; const int tok = (lr < ce) ? (list[e * 32768 + lr] >> 1) : 0; v[hh][i] = (unsigned)(tok * g.K + C[i]) * 2u; } }
    }
};
struct EpiSwiGLU {
    static constexpr bool PERM = true, AFTER_DRAIN = false;
    bf16_t* h;
    __device__ __forceinline__ void operator()(const f32x4 (&acc)[2][2][4][2], const Unit& un, int wr, int wc, int fr, int fq) const {
        const int row0 = un.pm * BM + wr * 64 + fr, col0 = (un.pn & 3) * 128 + wc * 32 + 8 * fq;
#pragma unroll
        for (int ai = 0; ai < 2; ++ai)
#pragma unroll
            for (int m = 0; m < 4; ++m) { f32x4 v0, v1;
#pragma unroll
                for (int e = 0; e < 4; ++e) { v0[e] = fsilu(acc[ai][0][m][0][e]) * acc[ai][1][m][0][e]; v1[e] = fsilu(acc[ai][0][m][1][e]) * acc[ai][1][m][1][e]; }
                *(u32x4*)(h + (size_t)(row0 + ai * HALF + m * 16) * 512 + col0) = pack8(v0, v1); }
    }
};
struct EpiMoeOut {
    static constexpr bool PERM = true, AFTER_DRAIN = false;
    const PG8_LAS MoeTab* tab; const int* list; const float* rw; bf16_t* ys;
    __device__ __forceinline__ void operator()(const f32x4 (&acc)[2][2][4][2], const Unit& un, int wr, int wc, int fr, int fq) const {
        const int e = un.pn >> 2, lrow0 = (un.pm - tab->tileStart[e]) * BM + wr * 64 + fr, ce = tab->cnt[e], col0 = (un.pn & 3) * BM + wc * 32 + 8 * fq;
        int slot[8]; float wgt[8];
#pragma unroll
        for (int i = 0; i < 8; ++i) { const int lr = lrow0 + (i >> 2) * HALF + (i & 3) * 16; slot[i] = (lr < ce) ? list[e * 32768 + lr] : -1; }
#pragma unroll
        for (int i = 0; i < 8; ++i) wgt[i] = (slot[i] >= 0) ? rw[slot[i]] : 0.f;
#pragma unroll
        for (int ai = 0; ai < 2; ++ai)
#pragma unroll
            for (int m = 0; m < 4; ++m) { const int i = ai * 4 + m;
                if (slot[i] >= 0) { const float w = wgt[i]; bf16_t* rowp = ys + (size_t)slot[i] * 1024 + col0;
#pragma unroll
                    for (int bj = 0; bj < 2; ++bj) *(u32x4*)(rowp + bj * HALF) = pack8(acc[ai][bj][m][0] * w, acc[ai][bj][m][1] * w); } }
    }
};

constexpr float FP8_SX = 4.f, FP8_SW = 64.f, FP8_SH = 8.f, FP8_SR = 16.f;
struct EpiSwiGLU8 {
    static constexpr bool PERM = true, AFTER_DRAIN = false;
    unsigned char* h;
    __device__ __forceinline__ void operator()(const f32x4 (&acc)[2][2][4][2], const Unit& un, int wr, int wc, int fr, int fq) const {
        const int row0 = un.pm * BM + wr * 64 + fr, col0 = (un.pn & 3) * 128 + wc * 32 + 8 * fq; const float ds = 1.f / (FP8_SX * FP8_SW);
#pragma unroll
        for (int ai = 0; ai < 2; ++ai)
#pragma unroll
            for (int m = 0; m < 4; ++m) { float v[8];
#pragma unroll
                for (int e = 0; e < 4; ++e) { v[e] = FP8_SH * fsilu(acc[ai][0][m][0][e] * ds) * (acc[ai][1][m][0][e] * ds); v[4 + e] = FP8_SH * fsilu(acc[ai][0][m][1][e] * ds) * (acc[ai][1][m][1][e] * ds); }
                uint2 o; o.x = pk4_fp8(v[0], v[1], v[2], v[3]); o.y = pk4_fp8(v[4], v[5], v[6], v[7]);
                *(uint2*)(h + (size_t)(row0 + ai * HALF + m * 16) * 512 + col0) = o; }
    }
};
struct EpiMoeOut8 {
    static constexpr bool PERM = true, AFTER_DRAIN = false;
    const PG8_LAS MoeTab* tab; const int* list; const float* rw; bf16_t* ys;
    __device__ __forceinline__ void operator()(const f32x4 (&acc)[2][2][4][2], const Unit& un, int wr, int wc, int fr, int fq) const {
        const int e = un.pn >> 2, lrow0 = (un.pm - tab->tileStart[e]) * BM + wr * 64 + fr, ce = tab->cnt[e], col0 = (un.pn & 3) * BM + wc * 32 + 8 * fq;
#pragma unroll
        for (int ai = 0; ai < 2; ++ai)
#pragma unroll
            for (int m = 0; m < 4; ++m) { const int lr = lrow0 + ai * HALF + m * 16;
                if (lr < ce) { const int slot = list[e * 32768 + lr]; const float w = rw[slot] * (1.f / (FP8_SH * FP8_SW)); bf16_t* rowp = ys + (size_t)slot * 1024 + col0;
#pragma unroll
                    for (int bj = 0; bj < 2; ++bj) *(u32x4*)(rowp + bj * HALF) = pack8(acc[ai][bj][m][0] * w, acc[ai][bj][m][1] * w); }
                asm volatile("" ::: "memory"); }
    }
};
}

DEV unsigned pk2(float lo, float hi) { return (unsigned)f2bf(lo) | ((unsigned)f2bf(hi) << 16); }
typedef unsigned v4u __attribute__((ext_vector_type(4)));
DEV void tr_load(const float* W, int N, int item, int lane, float (&wv)[32]) {
    const int nblk = N / 32, kb = item / nblk, nb = item % nblk, k0 = 64 * kb, n0 = 32 * nb;
#pragma unroll
    for (int i = 0; i < 32; ++i) wv[i] = __builtin_nontemporal_load(W + (size_t)(k0 + 2 * i + (lane >> 5)) * N + n0 + (lane & 31));
}
DEV void tr_store(const float (&wv)[32], int K, int N, bf16_t* WT, float* scr, int item, int lane, bool gatefrag) {
    const int nblk = N / 32, kb = item / nblk, nb = item % nblk, k0 = 64 * kb, n0 = 32 * nb;
#pragma unroll
    for (int i = 0; i < 32; ++i) scr[(2 * i + (lane >> 5)) * 33 + (lane & 31)] = wv[i];
    asm volatile("s_waitcnt lgkmcnt(0)" ::: "memory");
    const int c = lane & 7;
#pragma unroll
    for (int j = 0; j < 4; ++j) { const int n = (lane >> 3) + 8 * j; const float* s = scr + (8 * c) * 33 + n;
        v4u o; o.x = pk2(s[0 * 33], s[1 * 33]); o.y = pk2(s[2 * 33], s[3 * 33]); o.z = pk2(s[4 * 33], s[5 * 33]); o.w = pk2(s[6 * 33], s[7 * 33]);
        const int oc = n0 + n, kk = k0 + 8 * c;
        const size_t off = gatefrag ? (size_t)((((oc / 48) * 3 + (oc % 48) / 16) * 6 + (kk >> 5)) * 64 + ((kk >> 3) & 3) * 16 + (oc & 15)) * 8 : (size_t)oc * K + kk;
        *(v4u*)(WT + off) = o; }
    asm volatile("s_waitcnt lgkmcnt(0)" ::: "memory");
}
DEV void tr_store_fp8(const float (&wv)[32], int K, int N, unsigned char* WT, int row_off, float scale, float* scr, int item, int lane) {
    const int nblk = N / 32, kb = item / nblk, nb = item % nblk, k0 = 64 * kb, n0 = 32 * nb;
#pragma unroll
    for (int i = 0; i < 32; ++i) scr[(2 * i + (lane >> 5)) * 33 + (lane & 31)] = wv[i] * scale;
    asm volatile("s_waitcnt lgkmcnt(0)" ::: "memory");
    const int c = lane & 3;
#pragma unroll
    for (int j = 0; j < 2; ++j) { const int n = (lane >> 2) + 16 * j; const float* s = scr + (16 * c) * 33 + n;
        v4u o; o.x = pg8::pk4_fp8(s[0 * 33], s[1 * 33], s[2 * 33], s[3 * 33]); o.y = pg8::pk4_fp8(s[4 * 33], s[5 * 33], s[6 * 33], s[7 * 33]);
        o.z = pg8::pk4_fp8(s[8 * 33], s[9 * 33], s[10 * 33], s[11 * 33]); o.w = pg8::pk4_fp8(s[12 * 33], s[13 * 33], s[14 * 33], s[15 * 33]);
        *(v4u*)(WT + (size_t)(row_off + n0 + n) * K + k0 + 16 * c) = o; }
    asm volatile("s_waitcnt lgkmcnt(0)" ::: "memory");
}
DEV void p_weights(float* lds, const float* w_in, const float* w_ret_o, const float* w_lru_o, const float* w_out, const float* w_rg_r, const float* w_rg_i, bf16_t* w_in_t, bf16_t* w_ro_t, bf16_t* w_lo_t, bf16_t* w_out_t, bf16_t* wrg_t, int wave, int nwaves, const float* x, bf16_t* xb) {
    const int lane = otid() & 63;
    float* scr = lds + wave * 2304;
    constexpr int I0 = 16 * (WIN_N / 32), I1 = 32 * 32, I2 = 24 * 32, I3 = 16 * 32, I4 = 16 * 18, NIT = I0 + I1 + I2 + I3 + I4;
#define PW_DECODE(it_, W_, WT_, K_, N_, sub_, gf_) const float* W_; bf16_t* WT_; int K_, N_, sub_; bool gf_ = false; bool f8_##sub_ = false; { int r_ = (it_); \
        if (r_ < I0) { W_ = w_in; WT_ = w_in_t; K_ = 1024; N_ = WIN_N; sub_ = r_; } \
        else if ((r_ -= I0) < I1) { W_ = w_ret_o; WT_ = w_ro_t; K_ = 2048; N_ = 1024; sub_ = r_; f8_##sub_ = true; } \
        else if ((r_ -= I1) < I2) { W_ = w_lru_o; WT_ = w_lo_t; K_ = 1536; N_ = 1024; sub_ = r_; } \
        else if ((r_ -= I2) < I3) { W_ = w_out; WT_ = w_out_t; K_ = 1024; N_ = 1024; sub_ = r_; } \
        else { r_ -= I3; const int mi_ = r_ / 18; W_ = (mi_ < 8 ? w_rg_r + (size_t)mi_ * 192 * 192 : w_rg_i + (size_t)(mi_ - 8) * 192 * 192); WT_ = wrg_t + (size_t)mi_ * 192 * 192; K_ = 192; N_ = 192; sub_ = r_ - mi_ * 18; gf_ = true; } }
    const int step = gridDim.x * nwaves;
    int it = blockIdx.x * nwaves + wave;
    float wv[32], wn[32];
    const size_t n4 = (size_t)NTOK * DM / 4, cstride = (size_t)gridDim.x * NTHR;
    size_t ci = (size_t)blockIdx.x * NTHR + wave * 64 + lane;
    if (it < NIT) { PW_DECODE(it, W0, T0, K0, N0, s0, g0); (void)T0; (void)K0; (void)g0; (void)f8_s0; tr_load(W0, N0, s0, lane, wv); }
    for (; it < NIT || ci < n4; it += step) {
        const int nx = it + step;
        if (nx < NIT) { PW_DECODE(nx, W1, T1, K1, N1, s1, g1); (void)T1; (void)K1; (void)g1; (void)f8_s1; tr_load(W1, N1, s1, lane, wn); }
        if (ci < n4) {
            float4 t[16];
#pragma unroll
            for (int u = 0; u < 16; ++u) { const size_t i = ci + u * cstride; if (i < n4) { const pg8::f32x4 tv = __builtin_nontemporal_load((const pg8::f32x4*)x + i); t[u] = make_float4(tv[0], tv[1], tv[2], tv[3]); } else t[u] = make_float4(0.f, 0.f, 0.f, 0.f); }
#pragma unroll
            for (int u = 0; u < 16; ++u) { const size_t i = ci + u * cstride; if (i < n4) { uint2 o; o.x = pg8::cvt_pk_bf16(t[u].x, t[u].y); o.y = pg8::cvt_pk_bf16(t[u].z, t[u].w); ((uint2*)xb)[i] = o; } }
            ci += 16 * cstride;
        }
        if (it < NIT) { PW_DECODE(it, W2, T2, K2, N2, s2, g2); (void)W2;
          if (f8_s2) tr_store_fp8(wv, K2, N2, (unsigned char*)T2, 0, pg8::FP8_SW, scr, s2, lane);
          else tr_store(wv, K2, N2, T2, scr, s2, lane, g2); }
#pragma unroll
        for (int i = 0; i < 32; ++i) wv[i] = wn[i];
    }
#undef PW_DECODE
}
DEV void p_expert_weights(float* lds, const float* w_eg, const float* w_eu, const float* w_ed, unsigned char* wgu8, unsigned char* wd8) {
    const int wave = otid() >> 6, lane = otid() & 63;
    float* scr = lds + wave * 2304;
#define EW_SRC(it_) ((((it_) >> 13) == 0 ? w_eg : ((it_) >> 13) == 1 ? w_eu : w_ed) + (size_t)(((it_) & 8191) >> 8) * 1024 * 512)
    const int step = gridDim.x * 8;
    int it = blockIdx.x * 8 + wave;
    float wv[32], wn[32];
    if (it < 3 * 8192) tr_load(EW_SRC(it), (it >> 13) < 2 ? 512 : 1024, it & 255, lane, wv);
    for (; it < 3 * 8192; it += step) {
        const int nx = it + step;
        if (nx < 3 * 8192) tr_load(EW_SRC(nx), (nx >> 13) < 2 ? 512 : 1024, nx & 255, lane, wn);
        const int kind = it >> 13, e = (it & 8191) >> 8, sub = it & 255;
        if (kind < 2) { const int nb = sub & 15; tr_store_fp8(wv, 1024, 512, wgu8 + (size_t)e * 1024 * 1024, (nb >> 2) * 128 + kind * 128, pg8::FP8_SW, scr, sub, lane); }
        else tr_store_fp8(wv, 512, 1024, wd8 + (size_t)e * 1024 * 512, 0, pg8::FP8_SW, scr, sub, lane);
#pragma unroll
        for (int i = 0; i < 32; ++i) wv[i] = wn[i];
    }
#undef EW_SRC
}

DEV void p_router_table(const float* g1, const float* wg, const float* we, unsigned char* rtab, int tg, int nthr) {
    for (int p = (gridDim.x - 1 - blockIdx.x) * nthr + tg; p < 9216; p += gridDim.x * nthr) {
        int T, part, kq, stride; const float* srcp;
        if (p < 8192) { const int col = p & 15, nt = (p >> 6) & 1; kq = (p >> 4) & 3; part = (p >> 7) & 1; T = p >> 8; srcp = we + 16 * nt + col; stride = 32; }
        else { const int p2 = p - 8192, col = p2 & 3; kq = (p2 >> 2) & 3; part = (p2 >> 4) & 1; T = p2 >> 5; srcp = wg + col; stride = 4; }
        const int k0 = 32 * T + 8 * kq;
        unsigned o[4];
#pragma unroll
        for (int j2 = 0; j2 < 4; ++j2) { unsigned pr = 0;
#pragma unroll
            for (int e = 0; e < 2; ++e) { const int kk = k0 + 2 * j2 + e; const float wv_ = g1[kk] * srcp[(size_t)kk * stride];
                const bf16_t hi = f2bf(wv_); const bf16_t val = part ? f2bf(wv_ - bf2f(hi)) : hi; pr |= (unsigned)val << (16 * e); }
            o[j2] = pr; }
        *(u32x4_t*)(rtab + (size_t)p * 16) = (u32x4_t){o[0], o[1], o[2], o[3]};
    }
}
DEV void p_router_consts(float* lds, const float* g1, const float* b1, const float* wg, const float* bg, const float* we, const float* be, float* sb) {
    const int t = otid(), wv = t >> 6, lane = t & 63;
    for (int c = (int)blockIdx.x - 128; c < 36; c += gridDim.x) {
        if (c < 0) continue;
        float s = 0.f, q = 0.f;
#pragma unroll
        for (int kk = 0; kk < 2; ++kk) { const int k = t + 512 * kk; const float w = (c < 32) ? we[(size_t)k * 32 + c] : wg[(size_t)k * 4 + c - 32]; s += g1[k] * w; q += b1[k] * w; }
#pragma unroll
        for (int m = 1; m < 64; m <<= 1) { s += __shfl_xor(s, m); q += __shfl_xor(q, m); }
        if (lane == 0) { lds[wv * 2] = s; lds[wv * 2 + 1] = q; }
        __syncthreads();
        if (t == 0) { float S = 0.f, B = 0.f;
            for (int p = 0; p < 8; ++p) { S += lds[p * 2]; B += lds[p * 2 + 1]; }
            sb[c] = S; sb[48 + c] = B + ((c < 32) ? be[c] : bg[c - 32]);
            if (c == 0) { for (int z = 36; z < 48; ++z) { sb[z] = 0.f; sb[48 + z] = 0.f; } } }
        __syncthreads();
    }
}
DEV void p_cvt_x(const float* x, bf16_t* xb, int tg, int nthr) {
    const size_t n4 = (size_t)NTOK * DM / 4, stride = (size_t)gridDim.x * nthr;
    for (size_t i0 = (size_t)blockIdx.x * nthr + tg; i0 < n4; i0 += 16 * stride) {
        float4 t[16];
#pragma unroll
        for (int u = 0; u < 16; ++u) { const size_t i = i0 + u * stride; t[u] = (i < n4) ? ((const float4*)x)[i] : make_float4(0.f, 0.f, 0.f, 0.f); }
#pragma unroll
        for (int u = 0; u < 16; ++u) { const size_t i = i0 + u * stride; if (i < n4) { uint2 o; o.x = pg8::cvt_pk_bf16(t[u].x, t[u].y); o.y = pg8::cvt_pk_bf16(t[u].z, t[u].w); ((uint2*)xb)[i] = o; } }
    }
}
DEV void p_rope_table(float2* tab, int tg, int nthr) {
    const int i0 = blockIdx.x * nthr + tg, j = i0 & 127;
    const double r = 0.93057204092969897;
    double inv = 1.0; for (int t = 0; t < j; ++t) inv *= r;
    for (int i = i0; i < 8192 * 128; i += gridDim.x * nthr) {
        const int s = i >> 7;
        const double ang = (double)s * inv;
        const double twopi_hi = 6.283185307179586232, twopi_lo = 2.4492935982947064e-16;
        const double n = rint(ang * 0.15915494309189535);
        const double x = (ang - n * twopi_hi) - n * twopi_lo;
        const double x2 = x * x;
        double acc = 1.0 - x2 * (1.0 / (22.0 * 23.0));
#pragma unroll
        for (int k = 21; k >= 3; k -= 2) acc = 1.0 - x2 * (1.0 / ((double)(k - 1) * (double)k)) * acc;
        double acc2 = 1.0 - x2 * (1.0 / (21.0 * 22.0));
#pragma unroll
        for (int k = 20; k >= 2; k -= 2) acc2 = 1.0 - x2 * (1.0 / ((double)(k - 1) * (double)k)) * acc2;
        tab[i] = make_float2((float)acc2, (float)(x * acc));
    }
}

typedef float f32x4_t __attribute__((ext_vector_type(4)));
typedef short s16x4_t __attribute__((ext_vector_type(4)));
typedef short s16x4_lru __attribute__((ext_vector_type(4)));
constexpr int LRU_ROWB = 400;
DEV void p_lru_compute(unsigned char* lds, const bf16_t* ulru, const float* cw, const float* cb, const bf16_t* wrg_t,
                       const float* b_r, const float* b_i, const float* lam, bf16_t* epsb, bf16_t* xinb, float* segA, float* segH) {
    int tid_ = otid(); asm volatile("" : "+v"(tid_));
    const int tid = tid_, wave = tid >> 6, lane = tid & 63, fr = lane & 15, fq = lane >> 4, wr = wave >> 2, wc = wave & 3;
    unsigned char* stg = lds + 256 * LRU_ROWB + wave * 4096;
    for (int item = blockIdx.x; item < 1024; item += gridDim.x) {
        const int n = item & 7, b = (item >> 3) & 3, seg = item >> 5;
        const size_t t0 = (size_t)b * SEQ + seg * 256;
        {
            const int c8 = tid % 24, run = tid / 24, r0 = run * 13;
            if (run < 20) {
                const int ch0 = n * 192 + c8 * 8;
                float wj[4][8], bias[8];
#pragma unroll
                for (int j = 0; j < 4; ++j) { const float4 w0 = *(const float4*)(cw + j * 1536 + ch0), w1 = *(const float4*)(cw + j * 1536 + ch0 + 4);
                    wj[j][0] = w0.x; wj[j][1] = w0.y; wj[j][2] = w0.z; wj[j][3] = w0.w; wj[j][4] = w1.x; wj[j][5] = w1.y; wj[j][6] = w1.z; wj[j][7] = w1.w; }
                { const float4 c0 = *(const float4*)(cb + ch0), c1 = *(const float4*)(cb + ch0 + 4); bias[0] = c0.x; bias[1] = c0.y; bias[2] = c0.z; bias[3] = c0.w; bias[4] = c1.x; bias[5] = c1.y; bias[6] = c1.z; bias[7] = c1.w; }
                u32x4_t raw[16];
#pragma unroll
                for (int i = 0; i < 16; ++i) { const int r = r0 - 3 + i;
                    raw[i] = (r < 256 && seg * 256 + r >= 0) ? *(const u32x4_t*)(ulru + (t0 + r) * 1536 + ch0) : (u32x4_t){0u, 0u, 0u, 0u}; }
                float xw[4][8];
#pragma unroll
                for (int i = 0; i < 16; ++i) {
#pragma unroll
                    for (int e = 0; e < 4; ++e) { xw[i & 3][2 * e] = __uint_as_float(raw[i][e] << 16); xw[i & 3][2 * e + 1] = __uint_as_float(raw[i][e] & 0xffff0000u); }
                    if (i >= 3) {
                        const int r = r0 + i - 3;
                        float acc[8];
#pragma unroll
                        for (int e = 0; e < 8; ++e) acc[e] = bias[e] + wj[0][e] * xw[(i + 1) & 3][e] + wj[1][e] * xw[(i + 2) & 3][e] + wj[2][e] * xw[(i + 3) & 3][e] + wj[3][e] * xw[i & 3][e];
                        if (r < 256) { uint4 o; o.x = pg8::cvt_pk_bf16(acc[0], acc[1]); o.y = pg8::cvt_pk_bf16(acc[2], acc[3]); o.z = pg8::cvt_pk_bf16(acc[4], acc[5]); o.w = pg8::cvt_pk_bf16(acc[6], acc[7]);
                            *(uint4*)(lds + r * LRU_ROWB + c8 * 16) = o; }
                    }
                }
            }
        }
        __syncthreads();
        float cbr[3], cbi[3], csp[3], hrun[3], atot[3];
        const int sub = seg * 2 + wr;
#pragma unroll
        for (int tc = 0; tc < 3; ++tc) { const int ch = n * 192 + 48 * wc + 16 * tc + fr; cbr[tc] = b_r[ch]; cbi[tc] = b_i[ch]; csp[tc] = 8.f * 1.4426950408889634f * log1pf(__expf(-lam[ch])); atot[tc] = 1.f; hrun[tc] = 0.f; }
        const bf16_t* wrb = wrg_t + (size_t)n * 192 * 192 + (size_t)(wc * 18) * 512 + lane * 8;
        const bf16_t* wib = wrb + (size_t)8 * 192 * 192;
#pragma unroll
        for (int tc = 0; tc < 3; ++tc) {
            bf16x8_t bfr[6][2];
#pragma unroll
            for (int ks = 0; ks < 6; ++ks) { bfr[ks][0] = *(const bf16x8_t*)(wrb + (tc * 6 + ks) * 512); bfr[ks][1] = *(const bf16x8_t*)(wib + (tc * 6 + ks) * 512); }
#pragma unroll
            for (int p = 0; p < 2; ++p) {
                const int rowb = 128 * wr + 64 * p;
                f32x4_t acc[4][2];
#pragma unroll
                for (int m = 0; m < 4; ++m) { acc[m][0] = (f32x4_t){0.f, 0.f, 0.f, 0.f}; acc[m][1] = (f32x4_t){0.f, 0.f, 0.f, 0.f}; }
#pragma unroll
                for (int ks = 0; ks < 6; ++ks) {
                    bf16x8_t afr[4];
#pragma unroll
                    for (int m = 0; m < 4; ++m) afr[m] = *(const bf16x8_t*)(lds + (rowb + 16 * (fr >> 2) + 4 * m + (fr & 3)) * LRU_ROWB + ks * 64 + fq * 16);
#pragma unroll
                    for (int m = 0; m < 4; ++m) { acc[m][0] = __builtin_amdgcn_mfma_f32_16x16x32_bf16(afr[m], bfr[ks][0], acc[m][0], 0, 0, 0); acc[m][1] = __builtin_amdgcn_mfma_f32_16x16x32_bf16(afr[m], bfr[ks][1], acc[m][1], 0, 0, 0); }
                }
                const unsigned char* up = lds + (rowb + 16 * fq + (fr >> 2)) * LRU_ROWB + (48 * wc + 16 * tc + 4 * (fr & 3)) * 2;
                float Al = 1.f, Bl = 0.f;
                unsigned pe[8], px[8];
#pragma unroll
                for (int m = 0; m < 4; ++m) {
                    const s16x4_lru ut = __builtin_amdgcn_ds_read_tr16_b64_v4i16((LAS s16x4_lru*)(up + 4 * m * LRU_ROWB));
                    float ee[4], xx[4];
#pragma unroll
                    for (int j = 0; j < 4; ++j) {
                        const float rr = pg8::fsig(acc[m][0][j] + cbr[tc]), ii = pg8::fsig(acc[m][1][j] + cbi[tc]);
                        const float aa = __builtin_amdgcn_exp2f(-csp[tc] * rr);
                        const float u = bf2f((bf16_t)ut[j]);
                        const float om = 1.f - aa;
                        const float x = __builtin_amdgcn_sqrtf(fmaxf(om * (1.f + aa), 0.f)) * ii * u;
                        ee[j] = om; xx[j] = x; Bl = aa * Bl + x; Al *= aa;
                    }
                    pe[2 * m] = pg8::cvt_pk_bf16(ee[0], ee[1]); pe[2 * m + 1] = pg8::cvt_pk_bf16(ee[2], ee[3]);
                    px[2 * m] = pg8::cvt_pk_bf16(xx[0], xx[1]); px[2 * m + 1] = pg8::cvt_pk_bf16(xx[2], xx[3]);
                }
                { float h = hrun[tc], ap = 1.f;
#pragma unroll
                  for (int q = 0; q < 4; ++q) { const float Aq = __shfl(Al, fr + 16 * q), Bq = __shfl(Bl, fr + 16 * q); h = Aq * h + Bq; ap *= Aq; }
                  hrun[tc] = h; atot[tc] *= ap; }
                { const size_t go = ((((t0 + rowb + 16 * fq) >> 4) * 2) * 1536 + n * 192 + 48 * wc + 16 * tc + fr) * 8;
                  *(u32x4_t*)(epsb + go) = (u32x4_t){pe[0], pe[1], pe[2], pe[3]}; *(u32x4_t*)(epsb + go + 1536 * 8) = (u32x4_t){pe[4], pe[5], pe[6], pe[7]};
                  *(u32x4_t*)(xinb + go) = (u32x4_t){px[0], px[1], px[2], px[3]}; *(u32x4_t*)(xinb + go + 1536 * 8) = (u32x4_t){px[4], px[5], px[6], px[7]}; }
                asm volatile("s_waitcnt lgkmcnt(0)" ::: "memory");
            }
        }
        if (fq == 0) {
#pragma unroll
            for (int tc = 0; tc < 3; ++tc) { const size_t o = ((size_t)b * 64 + sub) * 1536 + n * 192 + 48 * wc + 16 * tc + fr; segA[o] = atot[tc]; segH[o] = hrun[tc]; }
        }
        __syncthreads();
    }
}
DEV void p_lru_scan(const bf16_t* epsb, const bf16_t* xinb, bf16_t* gl, const float* carry, float2* rope) {
    const int tid = otid();
    if (tid >= 384) { p_rope_table(rope, tid - 384, 128); return; }
    for (int item = blockIdx.x; item < 256; item += gridDim.x) {
        const int b = item >> 6, sub = item & 63;
        const size_t tok0 = (size_t)b * SEQ + sub * 128;
        const size_t base = tok0 * 1536 + tid * 4;
        const size_t bbase = ((tok0 >> 4) * 2 * 1536 + tid * 4) * 8;
        const float4 cin = *(const float4*)(carry + ((size_t)b * 64 + sub) * 1536 + tid * 4);
        float h[4] = {cin.x, cin.y, cin.z, cin.w};
        u32x4_t ev[4][2], xv[4][2]; unsigned gx[16], gy[16];
#pragma unroll
        for (int c = 0; c < 4; ++c)
#pragma unroll
            for (int q = 0; q < 2; ++q) { ev[c][q] = *(const u32x4_t*)(epsb + bbase + q * 12288 + c * 8); xv[c][q] = *(const u32x4_t*)(xinb + bbase + q * 12288 + c * 8); }
#pragma unroll
        for (int j = 0; j < 16; ++j) { const uint2 t_ = *(const uint2*)(gl + base + (size_t)j * 1536); gx[j] = t_.x; gy[j] = t_.y; }
#pragma unroll 1
        for (int blk = 0; blk < 8; ++blk) {
            u32x4_t ec[4][2], xc[4][2]; unsigned cx[16], cy[16];
#pragma unroll
            for (int c = 0; c < 4; ++c)
#pragma unroll
                for (int q = 0; q < 2; ++q) { ec[c][q] = ev[c][q]; xc[c][q] = xv[c][q]; }
#pragma unroll
            for (int j = 0; j < 16; ++j) { cx[j] = gx[j]; cy[j] = gy[j]; }
            if (blk + 1 < 8) { const size_t nb = bbase + (size_t)(blk + 1) * 24576;
#pragma unroll
                for (int c = 0; c < 4; ++c)
#pragma unroll
                    for (int q = 0; q < 2; ++q) { ev[c][q] = *(const u32x4_t*)(epsb + nb + q * 12288 + c * 8); xv[c][q] = *(const u32x4_t*)(xinb + nb + q * 12288 + c * 8); }
#pragma unroll
                for (int j = 0; j < 16; ++j) { const uint2 t_ = *(const uint2*)(gl + base + (size_t)((blk + 1) * 16 + j) * 1536); gx[j] = t_.x; gy[j] = t_.y; } }
#pragma unroll
            for (int j = 0; j < 16; ++j) {
#pragma unroll
                for (int c = 0; c < 4; ++c) { const unsigned ew = ec[c][j >> 3][(j >> 1) & 3], xw = xc[c][j >> 3][(j >> 1) & 3];
                    const float e = (j & 1) ? __uint_as_float(ew & 0xffff0000u) : __uint_as_float(ew << 16), xx = (j & 1) ? __uint_as_float(xw & 0xffff0000u) : __uint_as_float(xw << 16);
                    h[c] = (1.f - e) * h[c] + xx; }
                uint2 ov; ov.x = pg8::cvt_pk_bf16(h[0] * __uint_as_float(cx[j] << 16), h[1] * __uint_as_float(cx[j] & 0xffff0000u)); ov.y = pg8::cvt_pk_bf16(h[2] * __uint_as_float(cy[j] << 16), h[3] * __uint_as_float(cy[j] & 0xffff0000u));
                *(uint2*)(gl + base + (size_t)(blk * 16 + j) * 1536) = ov;
            }
        }
    }
}
DEV void p_lru_carry(float* lds, const float* segA, const float* segH, float* carry) {
    float* tA = lds; float* tH = lds + 64 * 65;
    for (int item = blockIdx.x; item < 96; item += gridDim.x) {
        const int b = item / 24, c0 = (item % 24) * 64;
        for (int i = otid(); i < 64 * 64; i += NTHR) { const int s = i >> 6, c = i & 63; const size_t o = ((size_t)b * 64 + s) * 1536 + c0 + c; tA[s * 65 + c] = segA[o]; tH[s * 65 + c] = segH[o]; }
        __syncthreads();
        if (otid() < 64) { const int c = otid(); float h = 0.f;
            for (int s = 0; s < 64; ++s) { const float a = tA[s * 65 + c], hh = tH[s * 65 + c]; tA[s * 65 + c] = h; h = a * h + hh; } }
        __syncthreads();
        for (int i = otid(); i < 64 * 64; i += NTHR) { const int s = i >> 6, c = i & 63; carry[((size_t)b * 64 + s) * 1536 + c0 + c] = tA[s * 65 + c]; }
        __syncthreads();
    }
}
DEV bf16x8_t fp8x8_to_bf16(unsigned d0, unsigned d1) {
    typedef __bf16 bf2_t __attribute__((ext_vector_type(2)));
    const unsigned a = __builtin_bit_cast(unsigned, __builtin_amdgcn_cvt_scalef32_pk_bf16_fp8(d0, 1.0f, false)), b = __builtin_bit_cast(unsigned, __builtin_amdgcn_cvt_scalef32_pk_bf16_fp8(d0, 1.0f, true));
    const unsigned c = __builtin_bit_cast(unsigned, __builtin_amdgcn_cvt_scalef32_pk_bf16_fp8(d1, 1.0f, false)), d = __builtin_bit_cast(unsigned, __builtin_amdgcn_cvt_scalef32_pk_bf16_fp8(d1, 1.0f, true));
    return __builtin_bit_cast(bf16x8_t, (u32x4_t){a, b, c, d});
}
#define LDS_BARRIER() do { asm volatile("s_waitcnt lgkmcnt(0)" ::: "memory"); __builtin_amdgcn_s_barrier(); asm volatile("" ::: "memory"); } while (0)
DEV void p_scores(unsigned char* lds, const bf16_t* q, const bf16_t* k, bf16_t* P) {
    int tid_ = otid(); asm volatile("" : "+v"(tid_));
    const int tid = tid_, w = tid >> 6, lane = tid & 63, fr = lane & 15, fq = lane >> 4;
    const int krow = tid >> 5, kch = tid & 31;
    u32x4_t kreg[8], qraw[4];
    int g = blockIdx.x;
    if (g < 1024) { const int c = g & 63, bh = g >> 6, b = bh >> 2, h = bh & 3; const size_t tok0 = (size_t)b * SEQ + c * 128;
        const bf16_t* kc = k + tok0 * 1024 + h * 256;
#pragma unroll
        for (int ii = 0; ii < 8; ++ii) kreg[ii] = *(const u32x4_t*)(kc + (size_t)(krow + 16 * ii) * 1024 + kch * 8);
        const unsigned char* qp = (const unsigned char*)q + ((tok0 >> 7) * 4 + h) * 32768 + (fq * 128 + 16 * w + fr) * 16;
#pragma unroll
        for (int i = 0; i < 4; ++i) qraw[i] = *(const u32x4_t*)(qp + i * 8192); }
    int par = 0;
    for (; g < 1024; g += gridDim.x, par ^= 1) {
        unsigned char* ldk = lds + par * (128 * 528);
#pragma unroll
        for (int ii = 0; ii < 8; ++ii) *(u32x4_t*)(ldk + (krow + 16 * ii) * 528 + kch * 16) = kreg[ii];
        bf16x8_t qc[8];
#pragma unroll
        for (int i = 0; i < 4; ++i) { qc[2 * i] = fp8x8_to_bf16(qraw[i][0], qraw[i][1]); qc[2 * i + 1] = fp8x8_to_bf16(qraw[i][2], qraw[i][3]); }
        const int gn = g + gridDim.x;
        if (gn < 1024) { const int c = gn & 63, bh = gn >> 6, b = bh >> 2, h = bh & 3; const size_t tok0 = (size_t)b * SEQ + c * 128;
            const bf16_t* kc = k + tok0 * 1024 + h * 256;
#pragma unroll
            for (int ii = 0; ii < 8; ++ii) kreg[ii] = *(const u32x4_t*)(kc + (size_t)(krow + 16 * ii) * 1024 + kch * 8);
            const unsigned char* qp = (const unsigned char*)q + ((tok0 >> 7) * 4 + h) * 32768 + (fq * 128 + 16 * w + fr) * 16;
#pragma unroll
            for (int i = 0; i < 4; ++i) qraw[i] = *(const u32x4_t*)(qp + i * 8192); }
        LDS_BARRIER();
        f32x4_t acc[8];
#pragma unroll
        for (int nt = 0; nt < 8; ++nt) acc[nt] = (f32x4_t){0.f, 0.f, 0.f, 0.f};
#pragma unroll
        for (int ks = 0; ks < 8; ++ks)
#pragma unroll
            for (int nt = 0; nt < 8; ++nt) { const bf16x8_t bb = *(const bf16x8_t*)(ldk + (16 * nt + fr) * 528 + ks * 64 + fq * 16); acc[nt] = __builtin_amdgcn_mfma_f32_16x16x32_bf16(bb, qc[ks], acc[nt], 0, 0, 0); }
        {
            const int c = g & 63, bh = g >> 6, b = bh >> 2, h = bh & 3;
            bf16_t* kt = const_cast<bf16_t*>(k) + ((size_t)b * SEQ + c * 128 + fq * 8 + w) * 1024 + h * 256 + fr * 8;
#pragma unroll
            for (int ks2 = 0; ks2 < 2; ++ks2)
#pragma unroll
                for (int di = 0; di < 2; ++di) {
                    unsigned o[4];
#pragma unroll
                    for (int e = 0; e < 2; ++e) {
                        const unsigned char* kp = ldk + (32 * (2 * ks2 + e) + 8 * fq + (fr >> 2)) * 528 + (16 * (2 * w + di) + 4 * (fr & 3)) * 2;
                        const s16x4_t t0 = __builtin_amdgcn_ds_read_tr16_b64_v4i16((LAS s16x4_t*)(kp));
                        const s16x4_t t1 = __builtin_amdgcn_ds_read_tr16_b64_v4i16((LAS s16x4_t*)(kp + 4 * 528));
                        o[2 * e] = pg8::pk4_fp8(16.f * bf2f((bf16_t)t0[0]), 16.f * bf2f((bf16_t)t0[1]), 16.f * bf2f((bf16_t)t0[2]), 16.f * bf2f((bf16_t)t0[3]));
                        o[2 * e + 1] = pg8::pk4_fp8(16.f * bf2f((bf16_t)t1[0]), 16.f * bf2f((bf16_t)t1[1]), 16.f * bf2f((bf16_t)t1[2]), 16.f * bf2f((bf16_t)t1[3]));
                    }
                    *(u32x4_t*)(kt + ks2 * 32768 + di * 128) = (u32x4_t){o[0], o[1], o[2], o[3]};
                }
        }
        bf16_t* Pg = P + (size_t)g * 16384 + ((fq >> 1) * 128 + 16 * w + fr) * 8 + 4 * (fq & 1);
        int mrow = 16 * w + fr - 4 * fq; asm volatile("" : "+v"(mrow));
#pragma unroll
        for (int nt = 0; nt < 8; ++nt) {
            uint2 o; o.x = pg8::cvt_pk_bf16((16 * nt <= mrow) ? acc[nt][0] * 0.015625f : 0.f, (16 * nt + 1 <= mrow) ? acc[nt][1] * 0.015625f : 0.f);
            o.y = pg8::cvt_pk_bf16((16 * nt + 2 <= mrow) ? acc[nt][2] * 0.015625f : 0.f, (16 * nt + 3 <= mrow) ? acc[nt][3] * 0.015625f : 0.f);
            *(uint2*)(Pg + ((nt >> 1) * 4 + 2 * (nt & 1)) * 1024) = o; }
    }
    __syncthreads();
}
constexpr int RT_KS = 528, RT_VS = 272, RT_V = 0, RT_U = 2 * 32 * RT_VS;
DEV void p_ret_mfma(unsigned char* lds, const bf16_t* q, const bf16_t* k, bf16_t* v, const bf16_t* P) {
    int tid_ = otid(); asm volatile("" : "+v"(tid_));
    const int tid = tid_, w = tid >> 6, lane = tid & 63, fr = lane & 15, fq = lane >> 4;
    for (int wk = blockIdx.x; wk < 256; wk += gridDim.x) {
        const int xcd = wk & 7, idx = wk >> 3, bh = xcd * 2 + (idx >> 4), sl = idx & 15, b = bh >> 2, h = bh & 3;
        float g128; { const double gam = 1.0 - exp2(-5.0 - (double)h); g128 = (float)exp2(128.0 * log2(gam)); }
        asm volatile("" : "+v"(g128));
        f32x4_t accU[2][2];
#pragma unroll
        for (int et = 0; et < 2; ++et)
#pragma unroll
            for (int di = 0; di < 2; ++di) accU[et][di] = (f32x4_t){0.f, 0.f, 0.f, 0.f};
        for (int i = tid; i < 32 * RT_KS / 4; i += NTHR) ((unsigned*)(lds + RT_U))[i] = 0u;
        const size_t tokb = (size_t)b * SEQ;
        const int vm = tid >> 2, ve = (tid & 3) * 8;
        const bf16_t* vsl = v + tokb * 2048 + h * 512 + sl * 32;
#define RT_STAGE_V(buf, vr) do { unsigned char* vp_ = lds + RT_V + (buf) * 32 * RT_VS + ve * RT_VS + vm * 2; \
            *(bf16_t*)(vp_ + 0 * RT_VS) = (bf16_t)((vr)[0] & 0xffff); *(bf16_t*)(vp_ + 1 * RT_VS) = (bf16_t)((vr)[0] >> 16); \
            *(bf16_t*)(vp_ + 2 * RT_VS) = (bf16_t)((vr)[1] & 0xffff); *(bf16_t*)(vp_ + 3 * RT_VS) = (bf16_t)((vr)[1] >> 16); \
            *(bf16_t*)(vp_ + 4 * RT_VS) = (bf16_t)((vr)[2] & 0xffff); *(bf16_t*)(vp_ + 5 * RT_VS) = (bf16_t)((vr)[2] >> 16); \
            *(bf16_t*)(vp_ + 6 * RT_VS) = (bf16_t)((vr)[3] & 0xffff); *(bf16_t*)(vp_ + 7 * RT_VS) = (bf16_t)((vr)[3] >> 16); } while (0)
        u32x4_t vreg = *(const u32x4_t*)(vsl + (size_t)vm * 2048 + ve);
        RT_STAGE_V(0, vreg);
        vreg = *(const u32x4_t*)(vsl + (size_t)(128 + vm) * 2048 + ve);
        u32x4_t qraw[4], kraw[2][2];
        bf16x8_t pa[4];
        const unsigned char* qp = (const unsigned char*)q + ((tokb >> 7) * 4 + h) * 32768 + (fq * 128 + 16 * w + fr) * 16;
        const bf16_t* pp = P + (size_t)(bh * 64) * 16384 + (fq * 128 + 16 * w + fr) * 8;
        const bf16_t* kp = k + (tokb + fq * 8 + w) * 1024 + h * 256 + fr * 8;
        {
#pragma unroll
            for (int i = 0; i < 4; ++i) qraw[i] = *(const u32x4_t*)(qp + i * 8192);
#pragma unroll
            for (int ks = 0; ks < 4; ++ks) { if (2 * ks <= w) pa[ks] = *(const bf16x8_t*)(pp + ks * 4096); else pa[ks] = (bf16x8_t){0, 0, 0, 0, 0, 0, 0, 0}; }
#pragma unroll
            for (int di = 0; di < 2; ++di)
#pragma unroll
                for (int i = 0; i < 2; ++i) kraw[di][i] = *(const u32x4_t*)(kp + i * 32768 + di * 128);
        }
        LDS_BARRIER();
#pragma unroll 1
        for (int c = 0; c < 64; ++c) {
            const size_t tok0 = tokb + c * 128;
            const unsigned char* ldsU = lds + RT_U + (c & 1) * 32 * RT_KS;
            const unsigned char* ldsV = lds + RT_V + (c & 1) * 32 * RT_VS;
            f32x4_t ao[2] = {(f32x4_t){0.f, 0.f, 0.f, 0.f}, (f32x4_t){0.f, 0.f, 0.f, 0.f}};
            {
                bf16x8_t qa[8];
#pragma unroll
                for (int i = 0; i < 4; ++i) { qa[2 * i] = fp8x8_to_bf16(qraw[i][0], qraw[i][1]); qa[2 * i + 1] = fp8x8_to_bf16(qraw[i][2], qraw[i][3]); }
                if (c + 1 < 64) {
                    const unsigned char* qn = qp + (size_t)(c + 1) * 131072;
#pragma unroll
                    for (int i = 0; i < 4; ++i) qraw[i] = *(const u32x4_t*)(qn + i * 8192);
                    asm volatile("" ::: "memory"); }
                bf16x8_t bu[8];
#pragma unroll
                for (int nt = 0; nt < 2; ++nt) {
#pragma unroll
                    for (int ks = 0; ks < 8; ++ks) bu[ks] = *(const bf16x8_t*)(ldsU + (16 * nt + fr) * RT_KS + ks * 64 + fq * 16);
#pragma unroll
                    for (int ks = 0; ks < 8; ++ks) ao[nt] = __builtin_amdgcn_mfma_f32_16x16x32_bf16(bu[ks], qa[ks], ao[nt], 0, 0, 0);
                }
            }
            bf16x8_t bv[2][4];
#pragma unroll
            for (int nt = 0; nt < 2; ++nt)
#pragma unroll
                for (int ks = 0; ks < 4; ++ks) bv[nt][ks] = *(const bf16x8_t*)(ldsV + (16 * nt + fr) * RT_VS + ks * 64 + fq * 16);
#pragma unroll
            for (int ks = 0; ks < 4; ++ks)
#pragma unroll
                for (int nt = 0; nt < 2; ++nt) ao[nt] = __builtin_amdgcn_mfma_f32_16x16x32_bf16(bv[nt][ks], pa[ks], ao[nt], 0, 0, 0);
            if (c + 1 < 64) {
                const bf16_t* pn = pp + (size_t)(c + 1) * 16384;
#pragma unroll
                for (int ks = 0; ks < 4; ++ks) if (2 * ks <= w) pa[ks] = *(const bf16x8_t*)(pn + ks * 4096);
            }
            {
                bf16_t* vc = v + (tok0 + 16 * w + fr) * 2048 + h * 512 + sl * 32 + 4 * fq;
#pragma unroll
                for (int nt = 0; nt < 2; ++nt) { uint2 o; o.x = pg8::cvt_pk_bf16(ao[nt][0], ao[nt][1]); o.y = pg8::cvt_pk_bf16(ao[nt][2], ao[nt][3]); *(uint2*)(vc + 16 * nt) = o; }
            }
#pragma unroll
            for (int ks = 0; ks < 4; ++ks)
#pragma unroll
                for (int di = 0; di < 2; ++di) { const bf16x8_t kb = fp8x8_to_bf16(kraw[di][ks >> 1][2 * (ks & 1)], kraw[di][ks >> 1][2 * (ks & 1) + 1]);
#pragma unroll
                    for (int et = 0; et < 2; ++et) accU[et][di] = __builtin_amdgcn_mfma_f32_16x16x32_bf16(kb, bv[et][ks], accU[et][di], 0, 0, 0); }
            if (c + 1 < 64) {
                const bf16_t* kn = kp + (size_t)(c + 1) * 131072;
#pragma unroll
                for (int di = 0; di < 2; ++di)
#pragma unroll
                    for (int i = 0; i < 2; ++i) kraw[di][i] = *(const u32x4_t*)(kn + i * 32768 + di * 128);
            }
#pragma unroll
            for (int et = 0; et < 2; ++et)
#pragma unroll
                for (int di = 0; di < 2; ++di) accU[et][di] = accU[et][di] * g128;
            {
                unsigned char* un = lds + RT_U + ((c + 1) & 1) * 32 * RT_KS;
#pragma unroll
                for (int et = 0; et < 2; ++et)
#pragma unroll
                    for (int di = 0; di < 2; ++di) { const float us = 1.f / 1024.f;
                        uint2 o; o.x = pg8::cvt_pk_bf16(accU[et][di][0] * us, accU[et][di][1] * us); o.y = pg8::cvt_pk_bf16(accU[et][di][2] * us, accU[et][di][3] * us);
                        *(uint2*)(un + (16 * et + fr) * RT_KS + (16 * (2 * w + di) + 4 * fq) * 2) = o; }
                if (c + 1 < 64) { RT_STAGE_V((c + 1) & 1, vreg); }
                if (c + 2 < 64) vreg = *(const u32x4_t*)(vsl + (size_t)((c + 2) * 128 + vm) * 2048 + ve);
            }
            LDS_BARRIER();
        }
#undef RT_STAGE_V
        __syncthreads();
    }
}
DEV void p_headnorm(const bf16_t* ret, const bf16_t* g, unsigned char* retn8) {
    const int lane = otid() & 63, l32 = lane & 31, hp = lane >> 5;
    for (int t = (blockIdx.x * NTHR + otid()) >> 6; t < NTOK; t += gridDim.x * (NTHR / 64)) {
        u32x4_t rv[2][2], gv[2][2];
#pragma unroll
        for (int hh = 0; hh < 2; ++hh) { const size_t o = (size_t)t * 2048 + (2 * hp + hh) * 512 + 16 * l32;
            rv[hh][0] = *(const u32x4_t*)(ret + o); rv[hh][1] = *(const u32x4_t*)(ret + o + 8); gv[hh][0] = *(const u32x4_t*)(g + o); gv[hh][1] = *(const u32x4_t*)(g + o + 8); }
        float x[2][16], s[2];
#pragma unroll
        for (int hh = 0; hh < 2; ++hh) { s[hh] = 0.f;
#pragma unroll
            for (int c = 0; c < 2; ++c)
#pragma unroll
                for (int j = 0; j < 4; ++j) { x[hh][8 * c + 2 * j] = __uint_as_float(rv[hh][c][j] << 16); x[hh][8 * c + 2 * j + 1] = __uint_as_float(rv[hh][c][j] & 0xffff0000u); }
#pragma unroll
            for (int j = 0; j < 16; ++j) s[hh] += x[hh][j]; }
#pragma unroll
        for (int m = 1; m < 32; m <<= 1) { s[0] += __shfl_xor(s[0], m); s[1] += __shfl_xor(s[1], m); }
        float q[2];
#pragma unroll
        for (int hh = 0; hh < 2; ++hh) { const float mu = s[hh] * (1.f / 512.f); q[hh] = 0.f;
#pragma unroll
            for (int j = 0; j < 16; ++j) { x[hh][j] -= mu; q[hh] += x[hh][j] * x[hh][j]; } }
#pragma unroll
        for (int m = 1; m < 32; m <<= 1) { q[0] += __shfl_xor(q[0], m); q[1] += __shfl_xor(q[1], m); }
#pragma unroll
        for (int hh = 0; hh < 2; ++hh) {
            const float rs = rsqrtf(q[hh] * (1.f / 512.f) + LN_EPS) * pg8::FP8_SR;
            float y[16];
#pragma unroll
            for (int c = 0; c < 2; ++c)
#pragma unroll
                for (int j = 0; j < 4; ++j) { y[8 * c + 2 * j] = x[hh][8 * c + 2 * j] * rs * __uint_as_float(gv[hh][c][j] << 16); y[8 * c + 2 * j + 1] = x[hh][8 * c + 2 * j + 1] * rs * __uint_as_float(gv[hh][c][j] & 0xffff0000u); }
            const size_t o = (size_t)t * 2048 + (2 * hp + hh) * 512 + 16 * l32;
            *(u32x4_t*)(retn8 + o) = (u32x4_t){pg8::pk4_fp8(y[0], y[1], y[2], y[3]), pg8::pk4_fp8(y[4], y[5], y[6], y[7]), pg8::pk4_fp8(y[8], y[9], y[10], y[11]), pg8::pk4_fp8(y[12], y[13], y[14], y[15])};
        }
    }
}

typedef float f32x4v __attribute__((ext_vector_type(4)));
DEV void p_ln1_route(float* lds, const bf16_t* y, bf16_t* x1b, unsigned char* x1q, const float* g1, const float* b1, const unsigned char* rtab,
                     int2* route_e, float2* route_w, int* cnt, int* list, const float* sb) {
    int tid_ = otid(); asm volatile("" : "+v"(tid_));
    const int tid = tid_, wv = tid >> 6, lane = tid & 63, r16 = lane & 15, kq = lane >> 4;
    const unsigned char* Wt = (const unsigned char*)lds;
    float* Sc = lds + 1024 * 36;
    float* Bc = Sc + 48;
    int* lcnt = (int*)(Bc + 48);
    int* rowE = lcnt + 32;
    int* rowP = rowE + 256;
#pragma unroll 6
    for (int i = tid; i < 9216; i += NTHR) ((u32x4_t*)lds)[i] = ((const u32x4_t*)rtab)[i];
    if (tid < 32) lcnt[tid] = 0;
    __syncthreads();
    if (tid < 96) Sc[tid] = sb[tid];
    __syncthreads();
    constexpr int rows_per_wg = 128;
    for (int blk = blockIdx.x; blk < NTOK / rows_per_wg; blk += gridDim.x) {
    { const int tile = wv;
        const int lrow0 = tile * 16, row0 = blk * rows_per_wg + lrow0;
        const bf16_t* yp = y + (size_t)(row0 + r16) * 1024 + 8 * kq;
        const unsigned char* tb = Wt + lane * 16;
        const unsigned char* tb2 = Wt + 131072 + (kq * 4 + (r16 & 3)) * 16;
        f32x4v acc[3] = {(f32x4v){0.f, 0.f, 0.f, 0.f}, (f32x4v){0.f, 0.f, 0.f, 0.f}, (f32x4v){0.f, 0.f, 0.f, 0.f}};
        float s1 = 0.f, s2 = 0.f;
#pragma unroll 4
        for (int T = 0; T < 32; ++T) {
            const u32x4_t yr = *(const u32x4_t*)(yp + 32 * T);
#pragma unroll
            for (int e = 0; e < 4; ++e) { const float lo = __uint_as_float(yr[e] << 16), hi = __uint_as_float(yr[e] & 0xffff0000u); s1 += lo + hi; s2 += lo * lo + hi * hi; }
            const bf16x8_t a = __builtin_bit_cast(bf16x8_t, yr);
#pragma unroll
            for (int part = 0; part < 2; ++part) {
#pragma unroll
                for (int nt = 0; nt < 2; ++nt) acc[nt] = __builtin_amdgcn_mfma_f32_16x16x32_bf16(a, *(const bf16x8_t*)(tb + ((T * 2 + part) * 2 + nt) * 1024), acc[nt], 0, 0, 0);
                acc[2] = __builtin_amdgcn_mfma_f32_16x16x32_bf16(a, *(const bf16x8_t*)(tb2 + (T * 2 + part) * 256), acc[2], 0, 0, 0);
            }
        }
        s1 += __shfl_xor(s1, 16); s1 += __shfl_xor(s1, 32); s2 += __shfl_xor(s2, 16); s2 += __shfl_xor(s2, 32);
        const float mu = s1 * (1.f / 1024.f), rstd = rsqrtf(fmaxf(s2 * (1.f / 1024.f) - mu * mu, 0.f) + LN_EPS);
        {
            float gA[8], bA[8], gB[8], bB[8];
#pragma unroll
            for (int e = 0; e < 2; ++e) { const float4 t0 = *(const float4*)(g1 + 8 * lane + 4 * e), t1 = *(const float4*)(b1 + 8 * lane + 4 * e), t2 = *(const float4*)(g1 + 512 + 8 * lane + 4 * e), t3 = *(const float4*)(b1 + 512 + 8 * lane + 4 * e);
                gA[4 * e] = t0.x; gA[4 * e + 1] = t0.y; gA[4 * e + 2] = t0.z; gA[4 * e + 3] = t0.w; bA[4 * e] = t1.x; bA[4 * e + 1] = t1.y; bA[4 * e + 2] = t1.z; bA[4 * e + 3] = t1.w;
                gB[4 * e] = t2.x; gB[4 * e + 1] = t2.y; gB[4 * e + 2] = t2.z; gB[4 * e + 3] = t2.w; bB[4 * e] = t3.x; bB[4 * e + 1] = t3.y; bB[4 * e + 2] = t3.z; bB[4 * e + 3] = t3.w; }
#pragma unroll 2
            for (int rr = 0; rr < 16; ++rr) {
                const float mur = __shfl(mu, rr), rsr = __shfl(rstd, rr);
                const size_t ro = (size_t)(row0 + rr) * 1024 + 8 * lane;
                const u32x4_t ya = *(const u32x4_t*)(y + ro), yb = *(const u32x4_t*)(y + ro + 512);
                float oa[8], ob[8];
#pragma unroll
                for (int e = 0; e < 4; ++e) {
                    oa[2 * e] = (__uint_as_float(ya[e] << 16) - mur) * rsr * gA[2 * e] + bA[2 * e]; oa[2 * e + 1] = (__uint_as_float(ya[e] & 0xffff0000u) - mur) * rsr * gA[2 * e + 1] + bA[2 * e + 1];
                    ob[2 * e] = (__uint_as_float(yb[e] << 16) - mur) * rsr * gB[2 * e] + bB[2 * e]; ob[2 * e + 1] = (__uint_as_float(yb[e] & 0xffff0000u) - mur) * rsr * gB[2 * e + 1] + bB[2 * e + 1]; }
                *(u32x4_t*)(x1b + ro) = (u32x4_t){pg8::cvt_pk_bf16(oa[0], oa[1]), pg8::cvt_pk_bf16(oa[2], oa[3]), pg8::cvt_pk_bf16(oa[4], oa[5]), pg8::cvt_pk_bf16(oa[6], oa[7])};
                *(u32x4_t*)(x1b + ro + 512) = (u32x4_t){pg8::cvt_pk_bf16(ob[0], ob[1]), pg8::cvt_pk_bf16(ob[2], ob[3]), pg8::cvt_pk_bf16(ob[4], ob[5]), pg8::cvt_pk_bf16(ob[6], ob[7])};
                uint2 qa_, qb_;
                qa_.x = pg8::pk4_fp8(oa[0] * pg8::FP8_SX, oa[1] * pg8::FP8_SX, oa[2] * pg8::FP8_SX, oa[3] * pg8::FP8_SX); qa_.y = pg8::pk4_fp8(oa[4] * pg8::FP8_SX, oa[5] * pg8::FP8_SX, oa[6] * pg8::FP8_SX, oa[7] * pg8::FP8_SX);
                qb_.x = pg8::pk4_fp8(ob[0] * pg8::FP8_SX, ob[1] * pg8::FP8_SX, ob[2] * pg8::FP8_SX, ob[3] * pg8::FP8_SX); qb_.y = pg8::pk4_fp8(ob[4] * pg8::FP8_SX, ob[5] * pg8::FP8_SX, ob[6] * pg8::FP8_SX, ob[7] * pg8::FP8_SX);
                *(uint2*)(x1q + ro) = qa_; *(uint2*)(x1q + ro + 512) = qb_;
            }
        }
#pragma unroll
        for (int j = 0; j < 4; ++j) {
            const int rl = 4 * kq + j;
            const float mur = __shfl(mu, rl), rsr = __shfl(rstd, rl);
            float lg[3];
#pragma unroll
            for (int nt = 0; nt < 3; ++nt) lg[nt] = rsr * (acc[nt][j] - mur * Sc[16 * nt + r16]) + Bc[16 * nt + r16];
            const int gb = 16 * kq;
            const float g0 = __shfl(lg[2], gb + 0), g1v = __shfl(lg[2], gb + 1), g2 = __shfl(lg[2], gb + 2), g3 = __shfl(lg[2], gb + 3);
            int gi = 0; float gm = g0; if (g1v > gm) { gm = g1v; gi = 1; } if (g2 > gm) { gm = g2; gi = 2; } if (g3 > gm) { gm = g3; gi = 3; }
            const float gw = 1.f / (expf(g0 - gm) + expf(g1v - gm) + expf(g2 - gm) + expf(g3 - gm));
            const float lsel = (gi & 2) ? lg[1] : lg[0];
            float ev[8];
#pragma unroll
            for (int t = 0; t < 8; ++t) ev[t] = __shfl(lsel, gb + (gi & 1) * 8 + t);
            int i1 = 0; float v1 = ev[0];
#pragma unroll
            for (int t = 1; t < 8; ++t) if (ev[t] > v1) { v1 = ev[t]; i1 = t; }
            int i2 = -1; float v2 = -INFINITY;
#pragma unroll
            for (int t = 0; t < 8; ++t) if (t != i1 && ev[t] > v2) { v2 = ev[t]; i2 = t; }
            const float w1 = 1.f / (1.f + expf(v2 - v1)), w2 = 1.f - w1;
            if (r16 == 0) {
                const int lr = lrow0 + rl, r = row0 + rl, e1 = gi * 8 + i1, e2 = gi * 8 + i2;
                route_e[r] = make_int2(e1, e2); route_w[r] = make_float2(gw * w1, gw * w2);
                rowE[2 * lr] = e1; rowP[2 * lr] = atomicAdd(&lcnt[e1], 1);
                rowE[2 * lr + 1] = e2; rowP[2 * lr + 1] = atomicAdd(&lcnt[e2], 1);
            }
        }
    }
    __syncthreads();
    if (tid < 32) lcnt[tid] = atomicAdd(&cnt[tid * 64], lcnt[tid]);
    __syncthreads();
    for (int i = tid; i < 2 * rows_per_wg; i += NTHR) { const int e = rowE[i]; list[e * 32768 + lcnt[e] + rowP[i]] = (blk * rows_per_wg + (i >> 1)) * 2 + (i & 1); }
    __syncthreads();
    if (tid < 32) lcnt[tid] = 0;
    __syncthreads();
    }
}

DEV void p_final(float* out, const bf16_t* x1b, const bf16_t* ys, const float* g2, const float* b2) {
    const int lane = otid() & 63;
    float gg[16], bb[16];
#pragma unroll
    for (int j = 0; j < 4; ++j) { const float4 gv = *(const float4*)(g2 + 16 * lane + 4 * j), bv = *(const float4*)(b2 + 16 * lane + 4 * j);
        gg[4 * j] = gv.x; gg[4 * j + 1] = gv.y; gg[4 * j + 2] = gv.z; gg[4 * j + 3] = gv.w; bb[4 * j] = bv.x; bb[4 * j + 1] = bv.y; bb[4 * j + 2] = bv.z; bb[4 * j + 3] = bv.w; }
    const int nw = gridDim.x * (NTHR / 64);
    for (int r0 = (blockIdx.x * NTHR + otid()) >> 6; r0 < NTOK; r0 += 2 * nw) {
        u32x4_t tv[2][2], av[2][2], bv2[2][2];
#pragma unroll
        for (int k = 0; k < 2; ++k) { const int r = r0 + k * nw; if (r < NTOK) { const size_t o = (size_t)r * 1024 + 16 * lane;
#pragma unroll
            for (int c = 0; c < 2; ++c) { tv[k][c] = *(const u32x4_t*)(x1b + o + 8 * c); av[k][c] = *(const u32x4_t*)(ys + 2 * (size_t)r * 1024 + 16 * lane + 8 * c); bv2[k][c] = *(const u32x4_t*)(ys + (2 * (size_t)r + 1) * 1024 + 16 * lane + 8 * c); } } }
#pragma unroll
        for (int k = 0; k < 2; ++k) { const int r = r0 + k * nw; if (r < NTOK) {
            float x[16]; float s = 0.f;
#pragma unroll
            for (int c = 0; c < 2; ++c)
#pragma unroll
                for (int j = 0; j < 4; ++j) { const unsigned t = tv[k][c][j], a = av[k][c][j], b = bv2[k][c][j];
                    x[8 * c + 2 * j] = ALPHA * __uint_as_float(t << 16) + __uint_as_float(a << 16) + __uint_as_float(b << 16);
                    x[8 * c + 2 * j + 1] = ALPHA * __uint_as_float(t & 0xffff0000u) + __uint_as_float(a & 0xffff0000u) + __uint_as_float(b & 0xffff0000u); }
#pragma unroll
            for (int j = 0; j < 16; ++j) s += x[j];
#pragma unroll
            for (int m = 1; m < 64; m <<= 1) s += __shfl_xor(s, m);
            const float mu = s * (1.f / 1024.f); float q = 0.f;
#pragma unroll
            for (int j = 0; j < 16; ++j) { x[j] -= mu; q += x[j] * x[j]; }
#pragma unroll
            for (int m = 1; m < 64; m <<= 1) q += __shfl_xor(q, m);
            const float rstd = rsqrtf(q * (1.f / 1024.f) + LN_EPS);
#pragma unroll
            for (int j = 0; j < 4; ++j) *(float4*)(out + (size_t)r * 1024 + 16 * lane + 4 * j) = make_float4(x[4 * j] * rstd * gg[4 * j] + bb[4 * j], x[4 * j + 1] * rstd * gg[4 * j + 1] + bb[4 * j + 1], x[4 * j + 2] * rstd * gg[4 * j + 2] + bb[4 * j + 2], x[4 * j + 3] * rstd * gg[4 * j + 3] + bb[4 * j + 3]);
        } }
    }
}

struct Args { const float* in[24]; float* out; unsigned char* ws; };
__global__ void __launch_bounds__(NTHR, 2) mega_fwd(Args a) {
    extern __shared__ __attribute__((aligned(16))) unsigned char lds_raw[];
    float* ldsf = (float*)lds_raw;
    PG8_LAS unsigned char* ldsl = (PG8_LAS unsigned char*)lds_raw;
    volatile LAS unsigned* MISC = (volatile LAS unsigned*)((LAS unsigned char*)lds_raw + LDS_MISC);
    for (int u = otid(); u < 128; u += NTHR) MISC[u] = 0u;
    __syncthreads();
    unsigned char* ws = a.ws;
    XcdBarrier bar = xcd_barrier_post((unsigned*)(ws + WS_CTL) + CW_BAR, MISC + 8);
#define GRID_BAR() xcd_barrier(bar)
    const float* x = a.in[0]; const float* w_in = a.in[1]; const float* b_merge = a.in[2];
    const float* conv_w = a.in[3]; const float* conv_b = a.in[4];
    const float* w_rg_r = a.in[5]; const float* b_rg_r = a.in[6]; const float* w_rg_i = a.in[7]; const float* b_rg_i = a.in[8];
    const float* lam = a.in[9]; const float* w_ret_o = a.in[10]; const float* w_lru_o = a.in[11]; const float* w_out = a.in[12];
    const float* ln1_g = a.in[13]; const float* ln1_b = a.in[14]; const float* w_group = a.in[15]; const float* b_group = a.in[16];
    const float* w_er = a.in[17]; const float* b_er = a.in[18]; const float* w_eg = a.in[19]; const float* w_eu = a.in[20];
    const float* w_ed = a.in[21]; const float* ln2_g = a.in[22]; const float* ln2_b = a.in[23];
    float* out = a.out;
    int* cnt = (int*)(ws + WS_CTL); float2* rope = (float2*)(ws + WS_ROPE); int2* route_e = (int2*)(ws + WS_ROUTE_E); float2* route_w = (float2*)(ws + WS_ROUTE_W); int* list = (int*)(ws + WS_LIST);
    bf16_t* xb = (bf16_t*)(ws + WS_XB); bf16_t* gl = (bf16_t*)(ws + WS_GL); bf16_t* ulru = (bf16_t*)(ws + WS_ULRU); bf16_t* uconv = (bf16_t*)(ws + WS_UCONV);
    bf16_t* epsb = (bf16_t*)(ws + WS_EPS); bf16_t* inp = (bf16_t*)out;
    bf16_t* q = (bf16_t*)(ws + WS_Q); bf16_t* k = (bf16_t*)(ws + WS_K); bf16_t* v = (bf16_t*)(ws + WS_V); bf16_t* gbuf = (bf16_t*)out;
    bf16_t* P = (bf16_t*)(ws + WS_P); bf16_t* gates = (bf16_t*)(ws + WS_GATES); bf16_t* m1 = (bf16_t*)out; bf16_t* merged = xb;
    bf16_t* w_in_t = (bf16_t*)(ws + WS_WIN_T); bf16_t* w_ro_t = (bf16_t*)(ws + WS_WRO_T); bf16_t* w_lo_t = (bf16_t*)(ws + WS_WLO_T); bf16_t* w_out_t = (bf16_t*)(ws + WS_WOUT_T);
    bf16_t* wrg_t = (bf16_t*)(ws + WS_WRG_T); float* segA = (float*)(ws + WS_SEGA); float* segH = (float*)(ws + WS_SEGH); float* carry = (float*)(ws + WS_CARRY);
    float* rsb = (float*)(ws + WS_RSB);
    unsigned char* wgu8 = ws + WS_WGU_T; unsigned char* wd8 = ws + WS_WD_T; unsigned char* x1q = ws + WS_X1Q;
    bf16_t* x1b = gl; bf16_t* hbuf = (bf16_t*)(ws + WS_H); bf16_t* ys = (bf16_t*)(ws + WS_YSLOT);

    { const int t0_ = otid();
      p_weights(ldsf, w_in, w_ret_o, w_lru_o, w_out, w_rg_r, w_rg_i, w_in_t, w_ro_t, w_lo_t, w_out_t, wrg_t, t0_ >> 6, 8, x, xb); }
    __syncthreads();
    GRID_BAR();
    { pg8::Gemm g{xb, w_in_t + (size_t)C_U * 1024, NTOK, 3072, 1024}; pg8::StaticOrder S; S.init(NTOK, 3072, (int)gridDim.x, (int)blockIdx.x);
      pg8::gemm_phase<pg8::EpiLruIn, pg8::StaticOrder, true, true>(ldsl, g, S, pg8::EpiLruIn{ulru, gl}); }
    GRID_BAR();
    p_lru_compute(lds_raw, ulru, conv_w, conv_b, wrg_t, b_rg_r, b_rg_i, lam, uconv, epsb, segA, segH);
    GRID_BAR();
    p_lru_carry(ldsf, segA, segH, carry);
    p_router_consts(ldsf, ln1_g, ln1_b, w_group, b_group, w_er, b_er, rsb);
    p_router_table(ln1_g, w_group, w_er, ws + WS_RTAB, otid(), NTHR);
    GRID_BAR();
    p_lru_scan(uconv, epsb, gl, carry, rope);
    GRID_BAR();
    { pg8::Gemm g{xb, w_in_t, NTOK, 6144, 1024}; pg8::StaticOrder S; S.init(NTOK, 6144, (int)gridDim.x, (int)blockIdx.x);
      pg8::gemm_phase<pg8::EpiRetIn, pg8::StaticOrder, true, true>(ldsl, g, S, pg8::EpiRetIn{q, k, v, gbuf, (const float*)rope}); }
    GRID_BAR();
    p_scores(lds_raw, q, k, P);
    GRID_BAR();
    p_ret_mfma(lds_raw, q, k, v, P);
    GRID_BAR();
    p_headnorm(v, gbuf, ws + WS_RETN8);
    { pg8::Gemm g{xb, w_in_t + (size_t)C_GATE * 1024, NTOK, 2048, 1024}; pg8::StaticOrder S; S.init(NTOK, 2048, (int)gridDim.x, (int)blockIdx.x);
      pg8::gemm_phase<pg8::EpiGates, pg8::StaticOrder, true, true>(ldsl, g, S, pg8::EpiGates{b_merge, gates}); }
    GRID_BAR();
    { pg8::Gemm g{(const bf16_t*)(ws + WS_RETN8), w_ro_t, NTOK, 1024, 1024};
      pg8::StaticOrder S; S.init(NTOK, 1024, (int)gridDim.x, (int)blockIdx.x);
      pg8::gemm_phase<pg8::EpiMerge<0>, pg8::StaticOrder, true, true, true>(ldsl, g, S, pg8::EpiMerge<0>{gates, nullptr, m1, 1.f / (pg8::FP8_SR * pg8::FP8_SW)}); }
    GRID_BAR();
    { pg8::Gemm g{gl, w_lo_t, NTOK, 1024, 1536}; pg8::StaticOrder S; S.init(NTOK, 1024, (int)gridDim.x, (int)blockIdx.x);
      pg8::gemm_phase<pg8::EpiMerge<1>, pg8::StaticOrder, true, true>(ldsl, g, S, pg8::EpiMerge<1>{gates, m1, merged, 1.f}); }
    GRID_BAR();
    { pg8::Gemm g{merged, w_out_t, NTOK, 1024, 1024}; pg8::StaticOrder S; S.init(NTOK, 1024, (int)gridDim.x, (int)blockIdx.x);
      pg8::gemm_phase<pg8::EpiOut, pg8::StaticOrder, true, true>(ldsl, g, S, pg8::EpiOut{x, (bf16_t*)out, ALPHA}); }
    GRID_BAR();
    p_ln1_route(ldsf, (const bf16_t*)out, x1b, x1q, ln1_g, ln1_b, ws + WS_RTAB, route_e, route_w, cnt, list, rsb);
    p_expert_weights(ldsf, w_eg, w_eu, w_ed, wgu8, wd8);
    GRID_BAR();
    {
        PG8_LAS pg8::MoeTab* tab = (PG8_LAS pg8::MoeTab*)(ldsl + LDS_TAB);
        pg8::moe_build_tab(tab, cnt);
        const int T = tab->tileStart[32];
        { pg8::Gemm g{(const bf16_t*)x1q, (const bf16_t*)wgu8, T * 256, 32 * 1024, 512}; pg8::MoeOrder<true> S{T * 4, (int)gridDim.x, (int)blockIdx.x, tab, list};
          pg8::gemm_phase<pg8::EpiSwiGLU8, pg8::MoeOrder<true>, true, true, true>(ldsl, g, S, pg8::EpiSwiGLU8{(unsigned char*)hbuf}); }
        GRID_BAR();
        { pg8::Gemm g{hbuf, (const bf16_t*)wd8, T * 256, 32 * 1024, 256}; pg8::MoeOrder<false> S{T * 4, (int)gridDim.x, (int)blockIdx.x, tab, list};
          pg8::gemm_phase<pg8::EpiMoeOut8, pg8::MoeOrder<false>, true, true, true>(ldsl, g, S, pg8::EpiMoeOut8{tab, list, (const float*)route_w, ys}); }
    }
    GRID_BAR();
    p_final(out, x1b, ys, ln2_g, ln2_b);
}

extern "C" void kernel_launch(void* const* d_in, const int* in_sizes, int n_in, void* d_out, int out_size, void* d_ws, size_t ws_size, hipStream_t stream) {
    static int grid = 0;
    if (grid == 0) {
        if (n_in != 24 || in_sizes[0] != NTOK * DM || out_size != NTOK * DM || ws_size < WS_END) {
            fprintf(stderr, "kernel_launch: unexpected shapes (n_in %d, in0 %d, out %d, ws %zu)\n", n_in, n_in > 0 ? in_sizes[0] : -1, out_size, ws_size); grid = -1; return; }
        int dev = 0, cus = 0, per_cu = 0;
        if (hipGetDevice(&dev) != hipSuccess || hipDeviceGetAttribute(&cus, hipDeviceAttributeMultiprocessorCount, dev) != hipSuccess) { fprintf(stderr, "kernel_launch: device query failed\n"); grid = -1; return; }
        if (hipFuncSetAttribute((const void*)mega_fwd, hipFuncAttributeMaxDynamicSharedMemorySize, LDS_BYTES) != hipSuccess) { fprintf(stderr, "kernel_launch: hipFuncSetAttribute failed\n"); grid = -1; return; }
        if (hipOccupancyMaxActiveBlocksPerMultiprocessor(&per_cu, (const void*)mega_fwd, NTHR, LDS_BYTES) != hipSuccess || per_cu < 1) {
            fprintf(stderr, "kernel_launch: occupancy query reports %d workgroups per CU\n", per_cu); (void)hipGetLastError(); grid = -1; return; }
        grid = cus;
    }
    if (grid < 0) return;
    if (hipMemsetAsync((char*)d_ws + WS_CTL, 0, CTL_ZERO_BYTES, stream) != hipSuccess) { fprintf(stderr, "kernel_launch: memset failed\n"); return; }
    Args a{};
    for (int i = 0; i < 24; ++i) a.in[i] = (const float*)d_in[i];
    a.out = (float*)d_out; a.ws = (unsigned char*)d_ws;
    hipLaunchKernelGGL(mega_fwd, dim3(grid), dim3(NTHR), LDS_BYTES, stream, a);
    const hipError_t le = hipPeekAtLastError();
    if (le != hipSuccess) fprintf(stderr, "kernel_launch: launch failed: %s\n", hipGetErrorName(le));
}
```
